# Optimizing an MI355X kernel written in HIP

```python
import jax, jax.numpy as jnp
from jax import lax
import numpy as np

D_MODEL = 1024
BATCH = 1
SEQ = 16384
DEPTH = 4

HEAD_DIM = 64
MIX_WIDTH = D_MODEL
ATTN_WIDTH = MIX_WIDTH // 2
ATTN_Q_HEADS = ATTN_WIDTH // HEAD_DIM
ATTN_KV_HEADS = 2
KV_WIDTH = ATTN_KV_HEADS * HEAD_DIM
WINDOW = 128
ATTN_BLOCK = 128
RWKV_WIDTH = MIX_WIDTH // 4
RWKV_HEADS = RWKV_WIDTH // HEAD_DIM
DECAY_LORA = 64
ICLR_LORA = 64
RWKV_LN_EPS = 64e-5
GLA_VAL_WIDTH = MIX_WIDTH // 4
GLA_HEADS = 4
GLA_VAL_DIM = GLA_VAL_WIDTH // GLA_HEADS
GLA_KEY_WIDTH = GLA_VAL_WIDTH // 2
GLA_KEY_DIM = GLA_KEY_WIDTH // GLA_HEADS
GLA_GATE_LORA = 16
GLA_GATE_NORMALIZER = 16.0
GLA_CHUNK = 64
IN_SPLITS = (ATTN_WIDTH, KV_WIDTH, KV_WIDTH, ATTN_WIDTH,
             3 * RWKV_WIDTH, RWKV_WIDTH,
             GLA_KEY_WIDTH, GLA_KEY_WIDTH, GLA_VAL_WIDTH, GLA_VAL_WIDTH)
IN_WIDTH = 2 * ATTN_WIDTH + 2 * KV_WIDTH + 4 * RWKV_WIDTH + 2 * GLA_KEY_WIDTH + 2 * GLA_VAL_WIDTH
NORM_EPS = 1e-6

kernel_name = "hybrid_swa_rwkv7_gla_parallel_heads"


def _rmsnorm(x, g):
    xf = x.astype(jnp.float32)
    y = xf * lax.rsqrt(jnp.mean(xf * xf, axis=-1, keepdims=True) + NORM_EPS)
    return (y * g.astype(jnp.float32)).astype(x.dtype)


def _shift(z):
    return jnp.pad(z, ((0, 0), (1, 0), (0, 0)))[:, :-1]


def _sliding_window_attention(q, k, v, sinks):
    B, T, Hq, D = q.shape
    Hkv = k.shape[2]
    G = Hq // Hkv
    nb = T // ATTN_BLOCK
    qb = q.reshape(B, nb, ATTN_BLOCK, Hkv, G, D)

    def band(z):
        zb = z.reshape(B, nb, ATTN_BLOCK, Hkv, D)
        prev = jnp.concatenate([jnp.zeros_like(zb[:, :1]), zb[:, :-1]], axis=1)
        return jnp.concatenate([prev, zb], axis=2)

    kb, vb = band(k), band(v)
    s = jnp.einsum('bnqhgd,bnkhd->bnhgqk', qb, kb,
                   preferred_element_type=jnp.float32) * (D ** -0.5)
    qi = jnp.arange(ATTN_BLOCK)[:, None]
    kj = jnp.arange(2 * ATTN_BLOCK)[None, :]
    dist = qi - kj + ATTN_BLOCK
    key_pos = jnp.arange(nb)[:, None, None] * ATTN_BLOCK + kj[None] - ATTN_BLOCK
    valid = (dist >= 0) & (dist < WINDOW) & (key_pos >= 0)
    slopes = 2.0 ** (-8.0 * jnp.arange(1, Hq + 1, dtype=jnp.float32) / Hq)
    s = s - slopes.reshape(Hkv, G)[:, :, None, None] * dist.astype(jnp.float32)
    s = jnp.where(valid[None, :, None, None], s, -jnp.inf)
    sink = jnp.broadcast_to(sinks.astype(jnp.float32).reshape(Hkv, G)[:, :, None, None],
                            s.shape[:-1] + (1,))
    p = jax.nn.softmax(jnp.concatenate([s, sink], axis=-1), axis=-1)[..., :-1]
    o = jnp.einsum('bnhgqk,bnkhd->bnqhgd', p.astype(v.dtype), vb)
    return o.reshape(B, T, Hq * D)


def _rwkv7_mixer(h, r, k, v, mu_w, mu_a, w0, w1, w2, a0, a1, a2, k_k, k_a, r_k, ln_w, ln_b):
    B, T, _ = h.shape
    f32 = jnp.float32
    h_prev = _shift(h)
    xw = h + (h_prev - h) * mu_w
    xa = h + (h_prev - h) * mu_a
    w = -jax.nn.softplus(-(w0 + jnp.tanh(xw @ w1) @ w2).astype(f32)) - 0.5
    decay = jnp.exp(-jnp.exp(w))
    a = jax.nn.sigmoid((a0 + (xa @ a1) @ a2).astype(f32))
    r, k, v = r.astype(f32), k.astype(f32), v.astype(f32)
    heads = lambda z: z.reshape(B, T, RWKV_HEADS, HEAD_DIM)
    kk = heads(k * k_k.astype(f32))
    kk = kk / jnp.maximum(jnp.linalg.norm(kk, axis=-1, keepdims=True), 1e-12)
    k = k * (1.0 + (a - 1.0) * k_a.astype(f32))

    def step(S, inp):
        r_t, w_t, k_t, v_t, kk_t, a_t = inp
        sa = jnp.einsum('bhvk,bhk->bhv', S, -kk_t)
        S = (S * w_t[:, :, None, :] + sa[..., None] * (kk_t * a_t)[:, :, None, :]
             + v_t[..., None] * k_t[:, :, None, :])
        return S, jnp.einsum('bhvk,bhk->bhv', S, r_t)

    tm = lambda z: jnp.moveaxis(z, 1, 0)
    S0 = jnp.zeros((B, RWKV_HEADS, HEAD_DIM, HEAD_DIM), f32)
    _, y = lax.scan(step, S0, (tm(heads(r)), tm(heads(decay)), tm(heads(k)), tm(heads(v)),
                               tm(kk), tm(heads(a))))
    y = jnp.moveaxis(y, 0, 1)
    mean = jnp.mean(y, axis=-1, keepdims=True)
    var = jnp.mean(jnp.square(y - mean), axis=-1, keepdims=True)
    y = ((y - mean) * lax.rsqrt(var + RWKV_LN_EPS)).reshape(B, T, RWKV_WIDTH)
    y = y * ln_w.astype(f32) + ln_b.astype(f32)
    bonus = jnp.sum(heads(r) * heads(k) * r_k.astype(f32), axis=-1, keepdims=True) * heads(v)
    return (y + bonus.reshape(B, T, RWKV_WIDTH)).astype(h.dtype)


def _gla_mixer(h, q, k, v, gk1, gk2, gk_b, norm_w):
    B, T, _ = h.shape
    f32 = jnp.float32
    n = T // GLA_CHUNK
    gk = jax.nn.log_sigmoid(((h @ gk1) @ gk2 + gk_b).astype(f32)) / GLA_GATE_NORMALIZER

    def chunks(z, d):
        return z.reshape(B, n, GLA_CHUNK, GLA_HEADS, d).transpose(1, 0, 3, 2, 4).astype(f32)

    qc = chunks(q, GLA_KEY_DIM) * (GLA_KEY_DIM ** -0.5)
    kc = chunks(k, GLA_KEY_DIM)
    vc = chunks(v, GLA_VAL_DIM)
    gc = chunks(gk, GLA_KEY_DIM)
    causal = jnp.tril(jnp.ones((GLA_CHUNK, GLA_CHUNK), bool))

    def step(S, inp):
        q_c, k_c, v_c, g_c = inp
        b = jnp.cumsum(g_c, axis=2)
        diff = b[:, :, :, None, :] - b[:, :, None, :, :]
        diff = jnp.where(causal[:, :, None], diff, -jnp.inf)
        A = jnp.einsum('bhid,bhjd,bhijd->bhij', q_c, k_c, jnp.exp(diff))
        o = A @ v_c + jnp.einsum('bhid,bhdv->bhiv', q_c * jnp.exp(b), S)
        b_last = b[:, :, -1:, :]
        S = (jnp.exp(b_last[:, :, 0, :])[..., None] * S
             + jnp.einsum('bhjd,bhjv->bhdv', k_c * jnp.exp(b_last - b), v_c))
        return S, o

    S0 = jnp.zeros((B, GLA_HEADS, GLA_KEY_DIM, GLA_VAL_DIM), f32)
    _, o = lax.scan(step, S0, (qc, kc, vc, gc))
    o = o.transpose(1, 0, 3, 2, 4).reshape(B, T, GLA_HEADS, GLA_VAL_DIM)
    o = o * lax.rsqrt(jnp.mean(o * o, axis=-1, keepdims=True) + 1e-5) * norm_w.astype(f32)
    return o.reshape(B, T, GLA_VAL_WIDTH).astype(h.dtype)


def _hybrid_layer(x, c_act, ada_w, ada_b, g_pre, g_post, w_in, w_out, sinks,
                  mu_rkv, mu_w, mu_a, w0, w1, w2, a0, a1, a2, k_k, k_a, r_k, ln_w, ln_b,
                  gk1, gk2, gk_b, gla_norm_w):
    B, T, _ = x.shape
    shift, scale, gate = jnp.split(c_act @ ada_w + ada_b, 3, axis=-1)
    h = _rmsnorm(x, g_pre) * (1.0 + scale[:, None]) + shift[:, None]
    proj = h @ w_in
    aq, ak, av, ag, rkv, rg, gq, gkk, gv, gg = jnp.split(proj, list(np.cumsum(IN_SPLITS)[:-1]), axis=-1)
    attn = _sliding_window_attention(aq.reshape(B, T, ATTN_Q_HEADS, HEAD_DIM),
                                     ak.reshape(B, T, ATTN_KV_HEADS, HEAD_DIM),
                                     av.reshape(B, T, ATTN_KV_HEADS, HEAD_DIM), sinks)
    attn = attn * jax.nn.silu(ag)
    rkv = rkv + (_shift(rkv) - rkv) * mu_rkv
    rr, rk, rv = jnp.split(rkv, 3, axis=-1)
    rwkv = _rwkv7_mixer(h, rr, rk, rv, mu_w, mu_a, w0, w1, w2, a0, a1, a2, k_k, k_a, r_k, ln_w, ln_b)
    rwkv = rwkv * jax.nn.silu(rg)
    gla = _gla_mixer(h, gq, gkk, gv, gk1, gk2, gk_b, gla_norm_w) * jax.nn.silu(gg)
    y = jnp.concatenate([attn, rwkv, gla], axis=-1) @ w_out
    return x + gate[:, None] * _rmsnorm(y, g_post)


def setup_inputs(seed: int = 0) -> dict:
    key = jax.random.key(seed)
    ks = jax.random.split(key, 32)
    nrm = lambda k, shape, s: s * jax.random.normal(k, shape, jnp.float32)
    uni = lambda k, shape, lo, hi: jax.random.uniform(k, shape, jnp.float32, lo, hi)
    D, L = D_MODEL, DEPTH
    return {
        "x": nrm(ks[0], (BATCH, SEQ, D), 1.0),
        "c": nrm(ks[1], (BATCH, D), 1.0),
        "ada_w": nrm(ks[2], (L, D, 3 * D), 0.5 * D ** -0.5),
        "ada_b": nrm(ks[3], (L, 3 * D), 0.02),
        "norm_pre": 1.0 + nrm(ks[4], (L, D), 0.05),
        "norm_post": 1.0 + nrm(ks[5], (L, D), 0.05),
        "w_in": nrm(ks[6], (L, D, IN_WIDTH), D ** -0.5),
        "w_out": nrm(ks[7], (L, MIX_WIDTH, D), MIX_WIDTH ** -0.5),
        "attn_sinks": nrm(ks[8], (L, ATTN_Q_HEADS), 0.5),
        "rwkv_mu_rkv": uni(ks[9], (L, 3 * RWKV_WIDTH), 0.0, 1.0),
        "rwkv_mu_w": uni(ks[10], (L, D), 0.0, 1.0),
        "rwkv_mu_a": uni(ks[11], (L, D), 0.0, 1.0),
        "rwkv_w0": uni(ks[12], (L, RWKV_WIDTH), -4.0, 1.0),
        "rwkv_w1": nrm(ks[13], (L, D, DECAY_LORA), D ** -0.5),
        "rwkv_w2": nrm(ks[14], (L, DECAY_LORA, RWKV_WIDTH), 0.5 * DECAY_LORA ** -0.5),
        "rwkv_a0": nrm(ks[15], (L, RWKV_WIDTH), 0.1),
        "rwkv_a1": nrm(ks[16], (L, D, ICLR_LORA), D ** -0.5),
        "rwkv_a2": nrm(ks[17], (L, ICLR_LORA, RWKV_WIDTH), 0.5 * ICLR_LORA ** -0.5),
        "rwkv_k_k": 0.85 + nrm(ks[18], (L, RWKV_WIDTH), 0.05),
        "rwkv_k_a": 1.0 + nrm(ks[19], (L, RWKV_WIDTH), 0.05),
        "rwkv_r_k": nrm(ks[20], (L, RWKV_HEADS, HEAD_DIM), 0.1),
        "rwkv_ln_w": 1.0 + nrm(ks[21], (L, RWKV_WIDTH), 0.05),
        "rwkv_ln_b": nrm(ks[22], (L, RWKV_WIDTH), 0.02),
        "gla_gk1": nrm(ks[23], (L, D, GLA_GATE_LORA), D ** -0.5),
        "gla_gk2": nrm(ks[24], (L, GLA_GATE_LORA, GLA_KEY_WIDTH), GLA_GATE_LORA ** -0.5),
        "gla_gk_b": nrm(ks[25], (L, GLA_KEY_WIDTH), 0.1),
        "gla_norm_w": 1.0 + nrm(ks[26], (L, GLA_VAL_DIM), 0.05),
    }


def reference(x, c, ada_w, ada_b, norm_pre, norm_post, w_in, w_out, attn_sinks,
              rwkv_mu_rkv, rwkv_mu_w, rwkv_mu_a, rwkv_w0, rwkv_w1, rwkv_w2,
              rwkv_a0, rwkv_a1, rwkv_a2, rwkv_k_k, rwkv_k_a, rwkv_r_k, rwkv_ln_w, rwkv_ln_b,
              gla_gk1, gla_gk2, gla_gk_b, gla_norm_w):
    c_act = jax.nn.silu(c)
    for l in range(DEPTH):
        x = _hybrid_layer(x, c_act, ada_w[l], ada_b[l], norm_pre[l], norm_post[l], w_in[l], w_out[l],
                          attn_sinks[l], rwkv_mu_rkv[l], rwkv_mu_w[l], rwkv_mu_a[l],
                          rwkv_w0[l], rwkv_w1[l], rwkv_w2[l], rwkv_a0[l], rwkv_a1[l], rwkv_a2[l],
                          rwkv_k_k[l], rwkv_k_a[l], rwkv_r_k[l], rwkv_ln_w[l], rwkv_ln_b[l],
                          gla_gk1[l], gla_gk2[l], gla_gk_b[l], gla_norm_w[l])
    return x
```

```cpp
#include <hip/hip_runtime.h>
#include <hip/hip_bf16.h>
#include <hip/hip_cooperative_groups.h>
#include <cstdio>
namespace cg = cooperative_groups;

typedef unsigned short u16;
using bf16x8 = __attribute__((ext_vector_type(8))) short;
using f32x4 = __attribute__((ext_vector_type(4))) float;
using f32x16 = __attribute__((ext_vector_type(16))) float;

#define T_ 16384
#define NALL 3456
#define NSEG 64
#define SL (T_ / NSEG)
#define PROJF 1728

#define OFF_WALL 0ull
#define OFF_WOUT 28311552ull
#define OFF_MOD 36700160ull
#define OFF_H 36749312ull
#define OFF_RWW OFF_H
#define OFF_RWKK (OFF_H + 16777216ull)
#define OFF_PROJ 70303744ull
#define OFF_MIX 183549952ull
#define OFF_RWB 217104384ull
#define OFF_GLAS 250658816ull
#define OFF_GLAD 259047424ull
#define OFF_BONUS 259178496ull
#define OFF_ZP 259440640ull
#define WS_END 267829248ull

#define SMEM_BYTES 59392

struct Params {
  const float *x, *c, *ada_w, *ada_b, *norm_pre, *norm_post, *w_in, *w_out, *sinks, *mu_rkv, *mu_w, *mu_a, *w0, *w1, *w2,
      *a0, *a1, *a2, *k_k, *k_a, *r_k, *ln_w, *ln_b, *gk1, *gk2, *gk_b, *gla_nw;
  float* out;
  unsigned char* ws;
};

__device__ __forceinline__ u16 f2bf(float f) {
  unsigned u = __float_as_uint(f);
  u += 0x7fffu + ((u >> 16) & 1u);
  return (u16)(u >> 16);
}
__device__ __forceinline__ float bf2f(u16 h) { return __uint_as_float(((unsigned)h) << 16); }
__device__ __forceinline__ unsigned pack2(float a, float b) { return (unsigned)f2bf(a) | ((unsigned)f2bf(b) << 16); }
__device__ __forceinline__ float bflo(unsigned u) { return __uint_as_float(u << 16); }
__device__ __forceinline__ float bfhi(unsigned u) { return __uint_as_float(u & 0xffff0000u); }
__device__ __forceinline__ float wave_sum(float v) {
#pragma unroll
  for (int o = 32; o > 0; o >>= 1) v += __shfl_xor(v, o);
  return v;
}
__device__ __forceinline__ float silu(float x) { return x / (1.f + __expf(-x)); }
__device__ __forceinline__ float sigmoidf_(float x) { return 1.f / (1.f + __expf(-x)); }
__device__ __forceinline__ float softplusf_(float z) { return fmaxf(z, 0.f) + log1pf(__expf(-fabsf(z))); }

template <int CTRL>
__device__ __forceinline__ float dpp_f(float x) {
  return __builtin_bit_cast(float, __builtin_amdgcn_update_dpp(0, __builtin_bit_cast(int, x), CTRL, 0xf, 0xf, false));
}
__device__ __forceinline__ float row16_allsum(float x) {
  x += dpp_f<0x128>(x);
  x += dpp_f<0x124>(x);
  x += dpp_f<0x122>(x);
  x += dpp_f<0x121>(x);
  return x;
}

__device__ void phase_mod(const Params& p, unsigned char* smem) {
  float* red = (float*)smem;
  const int tid = threadIdx.x, tx = tid & 31, ty = tid >> 5;
  float* mod = (float*)(p.ws + OFF_MOD);
  for (int it = blockIdx.x; it < 384; it += gridDim.x) {
    int l = it / 96;
    int j = (it % 96) * 32 + tx;
    const float* W = p.ada_w + (size_t)l * 1024 * 3072;
    float acc = 0.f;
    for (int i = 0; i < 128; ++i) {
      int k = ty * 128 + i;
      float cv = p.c[k];
      acc += silu(cv) * W[(size_t)k * 3072 + j];
    }
    red[ty * 32 + tx] = acc;
    __syncthreads();
    if (ty == 0) {
      float s = 0.f;
      for (int g = 0; g < 8; ++g) s += red[g * 32 + tx];
      mod[l * 3072 + j] = s + p.ada_b[l * 3072 + j];
    }
    __syncthreads();
  }
}

__device__ __forceinline__ float wall_src(const Params& p, int l, int k, int n) {
  size_t lk = (size_t)l * 1024 + k;
  if (n < 3072) return p.w_in[lk * 3072 + n];
  if (n < 3136) return (1.f - p.mu_w[lk]) * p.w1[lk * 64 + (n - 3072)];
  if (n < 3200) return p.mu_w[lk] * p.w1[lk * 64 + (n - 3136)];
  if (n < 3264) return (1.f - p.mu_a[lk]) * p.a1[lk * 64 + (n - 3200)];
  if (n < 3328) return p.mu_a[lk] * p.a1[lk * 64 + (n - 3264)];
  if (n < 3344) return p.gk1[lk * 16 + (n - 3328)];
  return 0.f;
}

__device__ void phase_wconv(const Params& p, unsigned char* smem) {
  float* tile = (float*)smem;
  const int tid = threadIdx.x;
  u16* WALL = (u16*)(p.ws + OFF_WALL);
  u16* WOUT = (u16*)(p.ws + OFF_WOUT);
  for (int it = blockIdx.x; it < 4480; it += gridDim.x) {
    bool isout = it >= 3456;
    int l, nt, kt;
    if (!isout) { l = it / 864; int r = it % 864; nt = r >> 4; kt = r & 15; }
    else { int r = it - 3456; l = r >> 8; r &= 255; nt = r >> 4; kt = r & 15; }
    int tx = tid & 63, ty = tid >> 6;
#pragma unroll 4
    for (int i = 0; i < 16; ++i) {
      int kl = ty + 4 * i;
      int k = kt * 64 + kl, n = nt * 64 + tx;
      float v = isout ? p.w_out[((size_t)l * 1024 + k) * 1024 + n] : wall_src(p, l, k, n);
      tile[kl * 65 + tx] = v;
    }
    __syncthreads();
    int nl = tid >> 2, kq = tid & 3;
    unsigned w[8];
#pragma unroll
    for (int j = 0; j < 8; ++j) w[j] = pack2(tile[(kq * 16 + 2 * j) * 65 + nl], tile[(kq * 16 + 2 * j + 1) * 65 + nl]);
    u16* dst = (isout ? WOUT + ((size_t)l * 1024 + nt * 64 + nl) * 1024 : WALL + ((size_t)l * NALL + nt * 64 + nl) * 1024) + kt * 64 + kq * 16;
    ((uint4*)dst)[0] = make_uint4(w[0], w[1], w[2], w[3]);
    ((uint4*)dst)[1] = make_uint4(w[4], w[5], w[6], w[7]);
    __syncthreads();
  }
}

__device__ __forceinline__ void write_h(const Params& p, int l, int row, int lane, const float4* v, float ss) {
  const float* mod = (const float*)(p.ws + OFF_MOD) + l * 3072;
  u16* H = (u16*)(p.ws + OFF_H);
  float rs = rsqrtf(ss * (1.f / 1024.f) + 1e-6f);
#pragma unroll
  for (int i = 0; i < 4; ++i) {
    int col = (lane + 64 * i) * 4;
    float4 g = *(const float4*)(p.norm_pre + l * 1024 + col);
    float4 sh = *(const float4*)(mod + col);
    float4 sc = *(const float4*)(mod + 1024 + col);
    float h0 = v[i].x * rs * g.x * (1.f + sc.x) + sh.x;
    float h1 = v[i].y * rs * g.y * (1.f + sc.y) + sh.y;
    float h2 = v[i].z * rs * g.z * (1.f + sc.z) + sh.z;
    float h3 = v[i].w * rs * g.w * (1.f + sc.w) + sh.w;
    *(uint2*)(H + (size_t)row * 1024 + col) = make_uint2(pack2(h0, h1), pack2(h2, h3));
  }
}

__device__ void phase_h0(const Params& p) {
  const int wave = threadIdx.x >> 6, lane = threadIdx.x & 63;
  for (int row = blockIdx.x * 4 + wave; row < T_; row += gridDim.x * 4) {
    const float4* xr = (const float4*)(p.x + (size_t)row * 1024);
    float4 v[4];
    float ss = 0.f;
#pragma unroll
    for (int i = 0; i < 4; ++i) {
      v[i] = xr[lane + 64 * i];
      ss += v[i].x * v[i].x + v[i].y * v[i].y + v[i].z * v[i].z + v[i].w * v[i].w;
    }
    ss = wave_sum(ss);
    write_h(p, 0, row, lane, v, ss);
  }
}

__device__ void phase_post(const Params& p, int l) {
  const int wave = threadIdx.x >> 6, lane = threadIdx.x & 63;
  const float* Y = (const float*)(p.ws + OFF_PROJ);
  const float* mod = (const float*)(p.ws + OFF_MOD) + l * 3072;
  const float* xold = (l == 0) ? p.x : p.out;
  for (int row = blockIdx.x * 4 + wave; row < T_; row += gridDim.x * 4) {
    const float4* yr = (const float4*)(Y + (size_t)row * 1024);
    const float4* xr = (const float4*)(xold + (size_t)row * 1024);
    float4 y[4], v[4];
    float ss = 0.f;
#pragma unroll
    for (int i = 0; i < 4; ++i) {
      y[i] = yr[lane + 64 * i];
      v[i] = xr[lane + 64 * i];
      ss += y[i].x * y[i].x + y[i].y * y[i].y + y[i].z * y[i].z + y[i].w * y[i].w;
    }
    ss = wave_sum(ss);
    float rs = rsqrtf(ss * (1.f / 1024.f) + 1e-6f);
    float s2 = 0.f;
#pragma unroll
    for (int i = 0; i < 4; ++i) {
      int col = (lane + 64 * i) * 4;
      float4 g = *(const float4*)(p.norm_post + l * 1024 + col);
      float4 gt = *(const float4*)(mod + 2048 + col);
      v[i].x += gt.x * (y[i].x * rs * g.x);
      v[i].y += gt.y * (y[i].y * rs * g.y);
      v[i].z += gt.z * (y[i].z * rs * g.z);
      v[i].w += gt.w * (y[i].w * rs * g.w);
      *(float4*)(p.out + (size_t)row * 1024 + col) = v[i];
      s2 += v[i].x * v[i].x + v[i].y * v[i].y + v[i].z * v[i].z + v[i].w * v[i].w;
    }
    if (l < 3) {
      s2 = wave_sum(s2);
      write_h(p, l + 1, row, lane, v, s2);
    }
  }
}

template <bool OUT_BF16>
__device__ void gemm_phase(const u16* __restrict__ A, const u16* __restrict__ Bt, void* Cv, int M, int N, int K, int ldc, unsigned char* smem) {
  u16* As = (u16*)smem;
  u16* Bs = As + 2 * 128 * 40;
  const int tid = threadIdx.x, wave = tid >> 6, lane = tid & 63;
  const int wr = wave >> 1, wc = wave & 1, fr = lane & 15, fq = lane >> 4;
  const int lrow = tid >> 2, lch = tid & 3;
  const int ntn = N / 128, ntiles = (M / 128) * ntn, nk = K / 32;
  for (int t = blockIdx.x; t < ntiles; t += gridDim.x) {
    const int m = t / ntn, n = t % ntn;
    f32x4 acc[4][4];
#pragma unroll
    for (int i = 0; i < 4; ++i)
#pragma unroll
      for (int j = 0; j < 4; ++j) acc[i][j] = (f32x4){0.f, 0.f, 0.f, 0.f};
    const u16* Ag = A + (size_t)(m * 128 + lrow) * K + lch * 8;
    const u16* Bg = Bt + (size_t)(n * 128 + lrow) * K + lch * 8;
    uint4 ra0 = *(const uint4*)(Ag), ra1 = *(const uint4*)(Ag + (size_t)64 * K);
    uint4 rb0 = *(const uint4*)(Bg), rb1 = *(const uint4*)(Bg + (size_t)64 * K);
    *(uint4*)(As + lrow * 40 + lch * 8) = ra0;
    *(uint4*)(As + (lrow + 64) * 40 + lch * 8) = ra1;
    *(uint4*)(Bs + lrow * 40 + lch * 8) = rb0;
    *(uint4*)(Bs + (lrow + 64) * 40 + lch * 8) = rb1;
    __syncthreads();
    for (int kt = 0; kt < nk; ++kt) {
      const int cur = kt & 1;
      if (kt + 1 < nk) {
        ra0 = *(const uint4*)(Ag + (kt + 1) * 32);
        ra1 = *(const uint4*)(Ag + (size_t)64 * K + (kt + 1) * 32);
        rb0 = *(const uint4*)(Bg + (kt + 1) * 32);
        rb1 = *(const uint4*)(Bg + (size_t)64 * K + (kt + 1) * 32);
      }
      const u16* Ac = As + cur * 5120;
      const u16* Bc = Bs + cur * 5120;
      bf16x8 af[4], bfr[4];
#pragma unroll
      for (int i = 0; i < 4; ++i) af[i] = *(const bf16x8*)(Ac + (wr * 64 + i * 16 + fr) * 40 + fq * 8);
#pragma unroll
      for (int i = 0; i < 4; ++i) bfr[i] = *(const bf16x8*)(Bc + (wc * 64 + i * 16 + fr) * 40 + fq * 8);
#pragma unroll
      for (int i = 0; i < 4; ++i)
#pragma unroll
        for (int j = 0; j < 4; ++j) acc[i][j] = __builtin_amdgcn_mfma_f32_16x16x32_bf16(af[i], bfr[j], acc[i][j], 0, 0, 0);
      if (kt + 1 < nk) {
        u16* An = As + (cur ^ 1) * 5120;
        u16* Bn = Bs + (cur ^ 1) * 5120;
        *(uint4*)(An + lrow * 40 + lch * 8) = ra0;
        *(uint4*)(An + (lrow + 64) * 40 + lch * 8) = ra1;
        *(uint4*)(Bn + lrow * 40 + lch * 8) = rb0;
        *(uint4*)(Bn + (lrow + 64) * 40 + lch * 8) = rb1;
      }
      __syncthreads();
    }
#pragma unroll
    for (int i = 0; i < 4; ++i)
#pragma unroll
      for (int j = 0; j < 4; ++j)
#pragma unroll
        for (int e = 0; e < 4; ++e) {
          int row = m * 128 + wr * 64 + i * 16 + fq * 4 + e;
          int col = n * 128 + wc * 64 + j * 16 + fr;
          if (OUT_BF16) ((u16*)Cv)[(size_t)row * ldc + col] = f2bf(acc[i][j][e]);
          else ((float*)Cv)[(size_t)row * ldc + col] = acc[i][j][e];
        }
  }
}

__device__ void attn_item(const Params& p, int l, int item, unsigned char* smem) {
  u16* Vt = (u16*)smem;
  const u16* PROJ = (const u16*)(p.ws + OFF_PROJ);
  u16* MIX = (u16*)(p.ws + OFF_MIX);
  const int tid = threadIdx.x, w = tid >> 6, lane = tid & 63, l31 = lane & 31, hf = lane >> 5;
  const int qb = item >> 3, head = item & 7, kvh = head >> 2;
  const int kpos0 = (qb - 1) * 128;
  {
    int kp = kpos0 + tid;
    if (kp < 0) kp = 0;
    const uint4* src = (const uint4*)(PROJ + (size_t)kp * NALL + 640 + kvh * 64);
#pragma unroll
    for (int c8 = 0; c8 < 8; ++c8) {
      uint4 v = src[c8];
      int d = c8 * 8;
      Vt[(d + 0) * 264 + tid] = (u16)(v.x & 0xffff);
      Vt[(d + 1) * 264 + tid] = (u16)(v.x >> 16);
      Vt[(d + 2) * 264 + tid] = (u16)(v.y & 0xffff);
      Vt[(d + 3) * 264 + tid] = (u16)(v.y >> 16);
      Vt[(d + 4) * 264 + tid] = (u16)(v.z & 0xffff);
      Vt[(d + 5) * 264 + tid] = (u16)(v.z >> 16);
      Vt[(d + 6) * 264 + tid] = (u16)(v.w & 0xffff);
      Vt[(d + 7) * 264 + tid] = (u16)(v.w >> 16);
    }
  }
  __syncthreads();
  const int tq = qb * 128 + 32 * w + l31;
  bf16x8 qf[4];
  {
    const u16* qp = PROJ + (size_t)tq * NALL + head * 64 + 8 * hf;
#pragma unroll
    for (int s = 0; s < 4; ++s) qf[s] = *(const bf16x8*)(qp + 16 * s);
  }
  const float slope = exp2f(-(float)(head + 1));
  const float sink = p.sinks[l * 8 + head];
  const int rq = 32 * w + l31;
  float mrun = -1e30f, lsum = 0.f;
  f32x16 o0, o1;
#pragma unroll
  for (int r = 0; r < 16; ++r) { o0[r] = 0.f; o1[r] = 0.f; }
#pragma unroll 1
  for (int i = 0; i < 5; ++i) {
    int kp = kpos0 + 32 * w + 32 * i + l31;
    if (kp < 0) kp = 0;
    const u16* kptr = PROJ + (size_t)kp * NALL + 512 + kvh * 64 + 8 * hf;
    f32x16 a;
#pragma unroll
    for (int r = 0; r < 16; ++r) a[r] = 0.f;
#pragma unroll
    for (int s = 0; s < 4; ++s) {
      bf16x8 kf = *(const bf16x8*)(kptr + 16 * s);
      a = __builtin_amdgcn_mfma_f32_32x32x16_bf16(kf, qf[s], a, 0, 0, 0);
    }
    float tmax = -1e30f;
#pragma unroll
    for (int r = 0; r < 16; ++r) {
      int kj = 32 * w + 32 * i + (r & 3) + 8 * (r >> 2) + 4 * hf;
      int dist = 128 + rq - kj;
      bool valid = (dist >= 0) && (dist < 128) && (kpos0 + kj >= 0);
      float sv = a[r] * 0.125f - slope * (float)dist;
      sv = valid ? sv : -1e30f;
      a[r] = sv;
      tmax = fmaxf(tmax, sv);
    }
    tmax = fmaxf(tmax, __shfl_xor(tmax, 32));
    const float mnew = fmaxf(mrun, tmax);
    const float alpha = __expf(mrun - mnew);
    float psum = 0.f;
#pragma unroll
    for (int r = 0; r < 16; ++r) {
      float e = (a[r] > -1e29f) ? __expf(a[r] - mnew) : 0.f;
      a[r] = e;
      psum += e;
    }
    lsum = lsum * alpha + psum;
    mrun = mnew;
#pragma unroll
    for (int r = 0; r < 16; ++r) { o0[r] *= alpha; o1[r] *= alpha; }
#pragma unroll
    for (int u = 0; u < 2; ++u) {
      bf16x8 pf;
#pragma unroll
      for (int j = 0; j < 8; ++j) pf[j] = (short)f2bf(a[8 * u + j]);
      const int kb = 32 * w + 32 * i + 16 * u + 4 * hf;
      const u16* v0 = Vt + l31 * 264 + kb;
      const u16* v1 = Vt + (32 + l31) * 264 + kb;
      uint2 a0 = *(const uint2*)(v0), a1 = *(const uint2*)(v0 + 8);
      uint2 b0 = *(const uint2*)(v1), b1 = *(const uint2*)(v1 + 8);
      uint4 A0 = make_uint4(a0.x, a0.y, a1.x, a1.y), A1 = make_uint4(b0.x, b0.y, b1.x, b1.y);
      o0 = __builtin_amdgcn_mfma_f32_32x32x16_bf16(__builtin_bit_cast(bf16x8, A0), pf, o0, 0, 0, 0);
      o1 = __builtin_amdgcn_mfma_f32_32x32x16_bf16(__builtin_bit_cast(bf16x8, A1), pf, o1, 0, 0, 0);
    }
  }
  {
    const float mf = fmaxf(mrun, sink);
    const float scl = __expf(mrun - mf);
    const float ltot = (lsum + __shfl_xor(lsum, 32)) * scl + __expf(sink - mf);
    const float fin = scl / ltot;
#pragma unroll
    for (int r = 0; r < 16; ++r) { o0[r] *= fin; o1[r] *= fin; }
  }
  const u16* gp = PROJ + (size_t)tq * NALL + 768 + head * 64;
  u16* op = MIX + (size_t)tq * 1024 + head * 64;
#pragma unroll
  for (int g = 0; g < 4; ++g) {
    int d0 = 8 * g + 4 * hf;
    uint2 gg = *(const uint2*)(gp + d0);
    float r0 = o0[4 * g + 0] * silu(bflo(gg.x)), r1 = o0[4 * g + 1] * silu(bfhi(gg.x));
    float r2 = o0[4 * g + 2] * silu(bflo(gg.y)), r3 = o0[4 * g + 3] * silu(bfhi(gg.y));
    *(uint2*)(op + d0) = make_uint2(pack2(r0, r1), pack2(r2, r3));
    uint2 g2 = *(const uint2*)(gp + 32 + d0);
    r0 = o1[4 * g + 0] * silu(bflo(g2.x)); r1 = o1[4 * g + 1] * silu(bfhi(g2.x));
    r2 = o1[4 * g + 2] * silu(bflo(g2.y)); r3 = o1[4 * g + 3] * silu(bfhi(g2.y));
    *(uint2*)(op + 32 + d0) = make_uint2(pack2(r0, r1), pack2(r2, r3));
  }
  __syncthreads();
}

__device__ void rwkv_prep_item(const Params& p, int l, int item, unsigned char* smem) {
  float* lw = (float*)smem;
  float* la = lw + 1024;
  const u16* PROJ = (const u16*)(p.ws + OFF_PROJ);
  const int tid = threadIdx.x, c = tid, head = tid >> 6, lane = tid & 63;
  const int t0 = item * 16;
#pragma unroll
  for (int i = 0; i < 8; ++i) {
    int idx = tid + 256 * i;
    int which = idx >> 10, tt = (idx >> 6) & 15, j = idx & 63;
    int t = t0 + tt;
    const u16* pr = PROJ + (size_t)t * NALL;
    float cur = bf2f(pr[(which ? 3200 : 3072) + j]);
    float prev = (t > 0) ? bf2f((pr - NALL)[(which ? 3264 : 3136) + j]) : 0.f;
    float s = cur + prev;
    if (!which) s = tanhf(s);
    (which ? la : lw)[tt * 64 + j] = s;
  }
  __syncthreads();
  float accw[16], acca[16];
#pragma unroll
  for (int tt = 0; tt < 16; ++tt) { accw[tt] = 0.f; acca[tt] = 0.f; }
  const float* w2 = p.w2 + (size_t)l * 64 * 256 + c;
  const float* a2 = p.a2 + (size_t)l * 64 * 256 + c;
  for (int j4 = 0; j4 < 16; ++j4) {
    float w20 = w2[(4 * j4 + 0) * 256], w21 = w2[(4 * j4 + 1) * 256], w22 = w2[(4 * j4 + 2) * 256], w23 = w2[(4 * j4 + 3) * 256];
    float a20 = a2[(4 * j4 + 0) * 256], a21 = a2[(4 * j4 + 1) * 256], a22 = a2[(4 * j4 + 2) * 256], a23 = a2[(4 * j4 + 3) * 256];
#pragma unroll
    for (int tt = 0; tt < 16; ++tt) {
      float4 lv = *(const float4*)(lw + tt * 64 + j4 * 4);
      float4 av = *(const float4*)(la + tt * 64 + j4 * 4);
      accw[tt] += lv.x * w20 + lv.y * w21 + lv.z * w22 + lv.w * w23;
      acca[tt] += av.x * a20 + av.y * a21 + av.z * a22 + av.w * a23;
    }
  }
  const float mur = p.mu_rkv[l * 768 + c], muk = p.mu_rkv[l * 768 + 256 + c], muv = p.mu_rkv[l * 768 + 512 + c];
  const float w0 = p.w0[l * 256 + c], a0 = p.a0[l * 256 + c], kkw = p.k_k[l * 256 + c], kaw = p.k_a[l * 256 + c], rkw = p.r_k[l * 256 + c];
  float* RWW = (float*)(p.ws + OFF_RWW);
  float* RWKK = (float*)(p.ws + OFF_RWKK);
  u16* RB = (u16*)(p.ws + OFF_RWB);
  float* BON = (float*)(p.ws + OFF_BONUS);
#pragma unroll
  for (int tt = 0; tt < 16; ++tt) {
    int t = t0 + tt;
    const u16* pr = PROJ + (size_t)t * NALL;
    float rc = bf2f(pr[1280 + c]), kc = bf2f(pr[1536 + c]), vc = bf2f(pr[1792 + c]);
    float rp = 0.f, kp = 0.f, vp = 0.f;
    if (t > 0) { rp = bf2f((pr - NALL)[1280 + c]); kp = bf2f((pr - NALL)[1536 + c]); vp = bf2f((pr - NALL)[1792 + c]); }
    float r = rc + (rp - rc) * mur, k = kc + (kp - kc) * muk, v = vc + (vp - vc) * muv;
    float wpre = w0 + accw[tt];
    float wl = -softplusf_(-wpre) - 0.5f;
    float decay = __expf(-__expf(wl));
    float a = sigmoidf_(a0 + acca[tt]);
    float kkc = k * kkw;
    float n2 = wave_sum(kkc * kkc);
    float kk = kkc / fmaxf(sqrtf(n2), 1e-12f);
    float kmod = k * (1.f + (a - 1.f) * kaw);
    float bb = kk * a;
    float bonus = wave_sum(r * kmod * rkw);
    size_t o = (size_t)t * 256 + c;
    RWW[o] = decay;
    RWKK[o] = kk;
    RB[o] = f2bf(r);
    RB[(size_t)T_ * 256 + o] = f2bf(kmod);
    RB[(size_t)2 * T_ * 256 + o] = f2bf(v);
    RB[(size_t)3 * T_ * 256 + o] = f2bf(bb);
    if (lane == 0) BON[t * 4 + head] = bonus;
  }
  __syncthreads();
}

__device__ __forceinline__ void gla_b(const Params& p, int l, int chunk, int head, float* tot, float* bl) {
  const u16* PROJ = (const u16*)(p.ws + OFF_PROJ);
  const int tid = threadIdx.x, d = tid & 31, ig = tid >> 5;
  float g2[16];
#pragma unroll
  for (int m = 0; m < 16; ++m) g2[m] = p.gk2[(size_t)l * 16 * 128 + m * 128 + head * 32 + d];
  const float bias = p.gk_b[l * 128 + head * 32 + d];
  float run = 0.f;
#pragma unroll
  for (int ii = 0; ii < 8; ++ii) {
    int t = chunk * 64 + ig * 8 + ii;
    const uint4* lp = (const uint4*)(PROJ + (size_t)t * NALL + 3328);
    uint4 u0 = lp[0], u1 = lp[1];
    float z = bias;
    z += bflo(u0.x) * g2[0] + bfhi(u0.x) * g2[1] + bflo(u0.y) * g2[2] + bfhi(u0.y) * g2[3];
    z += bflo(u0.z) * g2[4] + bfhi(u0.z) * g2[5] + bflo(u0.w) * g2[6] + bfhi(u0.w) * g2[7];
    z += bflo(u1.x) * g2[8] + bfhi(u1.x) * g2[9] + bflo(u1.y) * g2[10] + bfhi(u1.y) * g2[11];
    z += bflo(u1.z) * g2[12] + bfhi(u1.z) * g2[13] + bflo(u1.w) * g2[14] + bfhi(u1.w) * g2[15];
    float g = (fminf(z, 0.f) - log1pf(__expf(-fabsf(z)))) * (1.f / 16.f);
    run += g;
    bl[ii] = run;
  }
  tot[ig * 32 + d] = run;
  __syncthreads();
  float off = 0.f;
#pragma unroll
  for (int g = 0; g < 8; ++g) off += (g < ig) ? tot[g * 32 + d] : 0.f;
#pragma unroll
  for (int ii = 0; ii < 8; ++ii) bl[ii] += off;
}

__device__ void gla_local_item(const Params& p, int l, int item, unsigned char* smem) {
  float* tot = (float*)smem;
  float* Kp = tot + 256;
  float* Vs = Kp + 2048;
  const u16* PROJ = (const u16*)(p.ws + OFF_PROJ);
  const int tid = threadIdx.x, d = tid & 31, ig = tid >> 5;
  const int chunk = item >> 2, head = item & 3;
  float bl[8];
  gla_b(p, l, chunk, head, tot, bl);
  float blast = 0.f;
#pragma unroll
  for (int g = 0; g < 8; ++g) blast += tot[g * 32 + d];
#pragma unroll
  for (int ii = 0; ii < 8; ++ii) {
    int i = ig * 8 + ii;
    int t = chunk * 64 + i;
    float k = bf2f(PROJ[(size_t)t * NALL + 2432 + head * 32 + d]);
    Kp[i * 32 + d] = k * __expf(blast - bl[ii]);
  }
#pragma unroll
  for (int r = 0; r < 16; ++r) {
    int idx = tid + 256 * r;
    int i = idx >> 6, v = idx & 63;
    Vs[idx] = bf2f(PROJ[(size_t)(chunk * 64 + i) * NALL + 2560 + head * 64 + v]);
  }
  __syncthreads();
  const int v = tid & 63, dg = tid >> 6;
  float acc[8];
#pragma unroll
  for (int q = 0; q < 8; ++q) acc[q] = 0.f;
  for (int i = 0; i < 64; ++i) {
    float vv = Vs[i * 64 + v];
    float4 k0 = *(const float4*)(Kp + i * 32 + dg * 8), k1 = *(const float4*)(Kp + i * 32 + dg * 8 + 4);
    acc[0] += k0.x * vv; acc[1] += k0.y * vv; acc[2] += k0.z * vv; acc[3] += k0.w * vv;
    acc[4] += k1.x * vv; acc[5] += k1.y * vv; acc[6] += k1.z * vv; acc[7] += k1.w * vv;
  }
  float* GS = (float*)(p.ws + OFF_GLAS);
  float* GD = (float*)(p.ws + OFF_GLAD);
#pragma unroll
  for (int q = 0; q < 8; ++q) GS[((size_t)(chunk * 4 + head) * 32 + dg * 8 + q) * 64 + v] = acc[q];
  if (tid < 32) GD[(chunk * 4 + head) * 32 + tid] = __expf(blast);
  __syncthreads();
}

__device__ void gla_state_item(const Params& p, int item) {
  float* GS = (float*)(p.ws + OFF_GLAS);
  const float* GD = (const float*)(p.ws + OFF_GLAD);
  const int e = item * 256 + threadIdx.x;
  const int head = e >> 11, d = (e >> 6) & 31, v = e & 63;
  float S = 0.f;
  for (int c0 = 0; c0 < 256; c0 += 8) {
    float ds[8], dc[8];
#pragma unroll
    for (int u = 0; u < 8; ++u) {
      ds[u] = GS[((size_t)((c0 + u) * 4 + head) * 32 + d) * 64 + v];
      dc[u] = GD[((c0 + u) * 4 + head) * 32 + d];
    }
#pragma unroll
    for (int u = 0; u < 8; ++u) {
      GS[((size_t)((c0 + u) * 4 + head) * 32 + d) * 64 + v] = S;
      S = dc[u] * S + ds[u];
    }
  }
}

__device__ void gla_out_item(const Params& p, int l, int item, unsigned char* smem) {
  float* tot = (float*)smem;
  float* qt = tot + 256;
  float* kt = qt + 2112;
  float* Vs = kt + 2112;
  float* Am = Vs + 4096;
  float* Ss = Am + 4160;
  const u16* PROJ = (const u16*)(p.ws + OFF_PROJ);
  u16* MIX = (u16*)(p.ws + OFF_MIX);
  const float* GS = (const float*)(p.ws + OFF_GLAS);
  const int tid = threadIdx.x;
  const int chunk = item >> 2, head = item & 3;
  {
    const int d = tid & 31, ig = tid >> 5;
    float bl[8];
    gla_b(p, l, chunk, head, tot, bl);
#pragma unroll
    for (int ii = 0; ii < 8; ++ii) {
      int i = ig * 8 + ii;
      int t = chunk * 64 + i;
      float q = bf2f(PROJ[(size_t)t * NALL + 2304 + head * 32 + d]);
      float k = bf2f(PROJ[(size_t)t * NALL + 2432 + head * 32 + d]);
      qt[i * 33 + d] = q * 0.17677669529663687f * __expf(bl[ii]);
      kt[i * 33 + d] = k * __expf(-bl[ii]);
    }
  }
#pragma unroll
  for (int r = 0; r < 16; ++r) {
    int idx = tid + 256 * r;
    int i = idx >> 6, v = idx & 63;
    Vs[idx] = bf2f(PROJ[(size_t)(chunk * 64 + i) * NALL + 2560 + head * 64 + v]);
  }
#pragma unroll
  for (int r = 0; r < 8; ++r) {
    int idx = tid + 256 * r;
    Ss[idx] = GS[(size_t)(chunk * 4 + head) * 2048 + idx];
  }
  __syncthreads();
  const int j = tid & 63, ig = tid >> 6;
  {
    float acc[16];
#pragma unroll
    for (int ii = 0; ii < 16; ++ii) acc[ii] = 0.f;
    for (int d = 0; d < 32; ++d) {
      float kv = kt[j * 33 + d];
#pragma unroll
      for (int ii = 0; ii < 16; ++ii) acc[ii] += qt[(ig * 16 + ii) * 33 + d] * kv;
    }
#pragma unroll
    for (int ii = 0; ii < 16; ++ii) {
      int i = ig * 16 + ii;
      Am[i * 65 + j] = (j <= i) ? acc[ii] : 0.f;
    }
  }
  __syncthreads();
  {
    const int v = j;
    float acc[16];
#pragma unroll
    for (int ii = 0; ii < 16; ++ii) acc[ii] = 0.f;
    for (int jj = 0; jj < 64; ++jj) {
      float vv = Vs[jj * 64 + v];
#pragma unroll
      for (int ii = 0; ii < 16; ++ii) acc[ii] += Am[(ig * 16 + ii) * 65 + jj] * vv;
    }
    for (int d = 0; d < 32; ++d) {
      float sv = Ss[d * 64 + v];
#pragma unroll
      for (int ii = 0; ii < 16; ++ii) acc[ii] += qt[(ig * 16 + ii) * 33 + d] * sv;
    }
    const float nw = p.gla_nw[l * 64 + v];
#pragma unroll
    for (int ii = 0; ii < 16; ++ii) {
      int t = chunk * 64 + ig * 16 + ii;
      float o = acc[ii];
      float ms = wave_sum(o * o) * (1.f / 64.f);
      float gg = bf2f(PROJ[(size_t)t * NALL + 2816 + head * 64 + v]);
      float r = o * rsqrtf(ms + 1e-5f) * nw * silu(gg);
      MIX[(size_t)t * 1024 + 768 + head * 64 + v] = f2bf(r);
    }
  }
  __syncthreads();
}

__device__ void rwkv_scan_item(const Params& p, int item, unsigned char* smem) {
  float* st = (float*)smem;
  const int tid = threadIdx.x, wv = tid >> 6, lane = tid & 63, rl = lane >> 4, kl = lane & 15;
  const int rb = item & 7, head = (item >> 3) & 3, seg = item >> 5;
  const bool ident = rb >= 4;
  const int R = rb * 16 + wv * 4 + rl;
  const int vrow = R & 63;
  const float* RWW = (const float*)(p.ws + OFF_RWW);
  const float* RWKK = (const float*)(p.ws + OFF_RWKK);
  const u16* RB = (const u16*)(p.ws + OFF_RWB);
  float* PF = (float*)(p.ws + OFF_PROJ);
  float* ZP = (float*)(p.ws + OFF_ZP);
  const int tbase = seg * SL;
  const int ls = tid >> 4, lc4 = (tid & 15) * 4;
  float S0 = 0.f, S1 = 0.f, S2 = 0.f, S3 = 0.f;
  if (ident) {
    int i = vrow;
    if ((i >> 2) == kl) {
      int e = i & 3;
      S0 = (e == 0) ? 1.f : 0.f; S1 = (e == 1) ? 1.f : 0.f; S2 = (e == 2) ? 1.f : 0.f; S3 = (e == 3) ? 1.f : 0.f;
    }
  }
  float4 gw, gkk;
  uint2 gr, gk, gb, gv;
  auto gload = [&](int ch) {
    size_t o = (size_t)(tbase + ch * 16 + ls) * 256 + head * 64 + lc4;
    gw = *(const float4*)(RWW + o);
    gkk = *(const float4*)(RWKK + o);
    gr = *(const uint2*)(RB + o);
    gk = *(const uint2*)(RB + (size_t)T_ * 256 + o);
    gv = *(const uint2*)(RB + (size_t)2 * T_ * 256 + o);
    gb = *(const uint2*)(RB + (size_t)3 * T_ * 256 + o);
  };
  auto lstore = [&](int buf) {
    float* b = st + buf * 6144 + ls * 64 + lc4;
    *(float4*)(b) = gw;
    *(float4*)(b + 1024) = gkk;
    *(float4*)(b + 2048) = make_float4(bflo(gr.x), bfhi(gr.x), bflo(gr.y), bfhi(gr.y));
    *(float4*)(b + 3072) = make_float4(bflo(gk.x), bfhi(gk.x), bflo(gk.y), bfhi(gk.y));
    *(float4*)(b + 4096) = make_float4(bflo(gb.x), bfhi(gb.x), bflo(gb.y), bfhi(gb.y));
    *(float4*)(b + 5120) = make_float4(bflo(gv.x), bfhi(gv.x), bflo(gv.y), bfhi(gv.y));
  };
  gload(0);
  lstore(0);
  __syncthreads();
  const int nch = SL / 16;
  for (int ch = 0; ch < nch; ++ch) {
    const int cur = ch & 1;
    if (ch + 1 < nch) gload(ch + 1);
    const float* b = st + cur * 6144;
#pragma unroll 4
    for (int s = 0; s < 16; ++s) {
      float4 w4 = *(const float4*)(b + s * 64 + kl * 4);
      float4 kk4 = *(const float4*)(b + 1024 + s * 64 + kl * 4);
      float4 r4 = *(const float4*)(b + 2048 + s * 64 + kl * 4);
      float4 k4 = *(const float4*)(b + 3072 + s * 64 + kl * 4);
      float4 b4 = *(const float4*)(b + 4096 + s * 64 + kl * 4);
      float vv = ident ? 0.f : b[5120 + s * 64 + vrow];
      float sa = -(S0 * kk4.x + S1 * kk4.y + S2 * kk4.z + S3 * kk4.w);
      sa = row16_allsum(sa);
      S0 = S0 * w4.x + sa * b4.x + vv * k4.x;
      S1 = S1 * w4.y + sa * b4.y + vv * k4.y;
      S2 = S2 * w4.z + sa * b4.z + vv * k4.z;
      S3 = S3 * w4.w + sa * b4.w + vv * k4.w;
      float y = S0 * r4.x + S1 * r4.y + S2 * r4.z + S3 * r4.w;
      y = row16_allsum(y);
      if (kl == 0) PF[(size_t)(tbase + ch * 16 + s) * PROJF + (ident ? 256 : 0) + head * 64 + vrow] = y;
    }
    if (ch + 1 < nch) lstore(cur ^ 1);
    __syncthreads();
  }
  *(float4*)(ZP + ((size_t)((seg * 4 + head) * 128 + R)) * 64 + kl * 4) = make_float4(S0, S1, S2, S3);
}

__device__ void rwkv_combine(const Params& p) {
  float* ZP = (float*)(p.ws + OFF_ZP);
  const int b = blockIdx.x, wv = threadIdx.x >> 6, lane = threadIdx.x & 63;
  const int head = b >> 4, v = (b & 15) * 4 + wv;
  float s = 0.f;
  for (int seg = 0; seg < NSEG; ++seg) {
    float* base = ZP + (size_t)((seg * 4 + head) * 128) * 64;
    const float* P = base + 64 * 64;
    float z = base[v * 64 + lane];
    base[v * 64 + lane] = s;
    float ns = z;
#pragma unroll 16
    for (int i = 0; i < 64; ++i) {
      float si = __builtin_bit_cast(float, __builtin_amdgcn_readlane(__builtin_bit_cast(int, s), i));
      ns += si * P[i * 64 + lane];
    }
    s = ns;
  }
}

__device__ void rwkv_final_item(const Params& p, int l, int item, unsigned char* smem) {
  float* Ss = (float*)smem;
  float* rho = Ss + 4160;
  const int tid = threadIdx.x, v = tid & 63, tg = tid >> 6;
  const int tiles = SL / 64;
  const int q = item % tiles, head = (item / tiles) & 3, seg = item / (tiles * 4);
  const int t0 = seg * SL + q * 64;
  const float* ZP = (const float*)(p.ws + OFF_ZP);
  const float* PF = (const float*)(p.ws + OFF_PROJ);
  const u16* PROJ = (const u16*)(p.ws + OFF_PROJ);
  const u16* RBv = (const u16*)(p.ws + OFF_RWB) + (size_t)2 * T_ * 256;
  const float* BON = (const float*)(p.ws + OFF_BONUS);
  u16* MIX = (u16*)(p.ws + OFF_MIX);
#pragma unroll
  for (int r = 0; r < 16; ++r) {
    int idx = tid + 256 * r;
    int row = idx >> 6, col = idx & 63;
    Ss[row * 65 + col] = ZP[((size_t)((seg * 4 + head) * 128 + row)) * 64 + col];
    rho[idx] = PF[(size_t)(t0 + row) * PROJF + 256 + head * 64 + col];
  }
  __syncthreads();
  float acc[16];
#pragma unroll
  for (int tt = 0; tt < 16; ++tt) acc[tt] = PF[(size_t)(t0 + tg * 16 + tt) * PROJF + head * 64 + v];
  for (int i4 = 0; i4 < 16; ++i4) {
    float s0 = Ss[v * 65 + 4 * i4], s1 = Ss[v * 65 + 4 * i4 + 1], s2 = Ss[v * 65 + 4 * i4 + 2], s3 = Ss[v * 65 + 4 * i4 + 3];
#pragma unroll
    for (int tt = 0; tt < 16; ++tt) {
      float4 rv = *(const float4*)(rho + (tg * 16 + tt) * 64 + 4 * i4);
      acc[tt] += s0 * rv.x + s1 * rv.y + s2 * rv.z + s3 * rv.w;
    }
  }
  const int c = head * 64 + v;
  const float lnw = p.ln_w[l * 256 + c], lnb = p.ln_b[l * 256 + c];
#pragma unroll
  for (int tt = 0; tt < 16; ++tt) {
    int t = t0 + tg * 16 + tt;
    float y = acc[tt];
    float mean = wave_sum(y) * (1.f / 64.f);
    float dlt = y - mean;
    float var = wave_sum(dlt * dlt) * (1.f / 64.f);
    float o = dlt * rsqrtf(var + 64e-5f) * lnw + lnb;
    o += BON[t * 4 + head] * bf2f(RBv[(size_t)t * 256 + c]);
    float g = bf2f(PROJ[(size_t)t * NALL + 2048 + c]);
    MIX[(size_t)t * 1024 + 512 + c] = f2bf(o * silu(g));
  }
  __syncthreads();
}

__global__ void __launch_bounds__(256) fwd_megakernel(Params p) {
  cg::grid_group grid = cg::this_grid();
  __shared__ __attribute__((aligned(16))) unsigned char smem[SMEM_BYTES];
  const int nb = gridDim.x;
#ifndef PH
#define PH 0xffff
#endif
  if (PH & 1) phase_mod(p, smem);
  if (PH & 2) phase_wconv(p, smem);
  grid.sync();
  if (PH & 4) phase_h0(p);
  grid.sync();
  for (int l = 0; l < 4; ++l) {
    if (PH & 8) gemm_phase<true>((const u16*)(p.ws + OFF_H), (const u16*)(p.ws + OFF_WALL) + (size_t)l * NALL * 1024, p.ws + OFF_PROJ, T_, NALL, 1024, NALL, smem);
    grid.sync();
    for (int it = blockIdx.x; it < 3072; it += nb) {
      if (it < 1024) { if (PH & 16) attn_item(p, l, it, smem); }
      else if (it < 2048) { if (PH & 32) rwkv_prep_item(p, l, it - 1024, smem); }
      else { if (PH & 64) gla_local_item(p, l, it - 2048, smem); }
    }
    grid.sync();
    for (int it = blockIdx.x; it < 32 + NSEG * 32; it += nb) {
      if (it < 32) { if (PH & 128) gla_state_item(p, it); }
      else { if (PH & 256) rwkv_scan_item(p, it - 32, smem); }
    }
    grid.sync();
    if (blockIdx.x < 64) { if (PH & 512) rwkv_combine(p); }
    for (int it = blockIdx.x; it < 1024; it += nb) { if (PH & 1024) gla_out_item(p, l, it, smem); }
    grid.sync();
    for (int it = blockIdx.x; it < NSEG * 4 * (SL / 64); it += nb) { if (PH & 2048) rwkv_final_item(p, l, it, smem); }
    grid.sync();
    if (PH & 4096) gemm_phase<false>((const u16*)(p.ws + OFF_MIX), (const u16*)(p.ws + OFF_WOUT) + (size_t)l * 1024 * 1024, p.ws + OFF_PROJ, T_, 1024, 1024, 1024, smem);
    grid.sync();
    if (PH & 8192) phase_post(p, l);
    if (l < 3) grid.sync();
  }
}

extern "C" void kernel_launch(void* const* d_in, const int* in_sizes, int n_in, void* d_out, int out_size, void* d_ws, size_t ws_size,
                              hipStream_t stream) {
  static int grid_blocks = 0;
  if (!grid_blocks) {
    int dev = 0, cus = 0, per_cu = 0;
    hipGetDevice(&dev);
    hipDeviceGetAttribute(&cus, hipDeviceAttributeMultiprocessorCount, dev);
    hipOccupancyMaxActiveBlocksPerMultiprocessor(&per_cu, fwd_megakernel, 256, 0);
    if (per_cu < 1) per_cu = 1;
    if (per_cu > 4) per_cu = 4;
    grid_blocks = cus * per_cu;
    if (grid_blocks < 64) grid_blocks = 64;
  }
  if (n_in != 27 || ws_size < WS_END) {
    fprintf(stderr, "kernel_launch: unexpected n_in %d / ws %zu\n", n_in, ws_size);
    return;
  }
  Params p{};
  const float** pp = (const float**)&p;
  for (int i = 0; i < 27; ++i) pp[i] = (const float*)d_in[i];
  p.out = (float*)d_out;
  p.ws = (unsigned char*)d_ws;
  void* args[] = {&p};
  hipError_t e = hipLaunchCooperativeKernel((void*)fwd_megakernel, dim3(grid_blocks), dim3(256), args, 0, stream);
  if (e != hipSuccess) fprintf(stderr, "cooperative launch failed: %s (grid %d)\n", hipGetErrorString(e), grid_blocks);
}
```

```cpp
#include <hip/hip_runtime.h>
#include <hip/hip_bf16.h>
#include <hip/hip_cooperative_groups.h>
#include <cstdio>
namespace cg = cooperative_groups;

typedef unsigned short u16;
using bf16x8 = __attribute__((ext_vector_type(8))) short;
using f32x4 = __attribute__((ext_vector_type(4))) float;
using f32x16 = __attribute__((ext_vector_type(16))) float;

#define T_ 16384
#define NALL 3456
#define NSEG 64
#define SL (T_ / NSEG)
#define PROJF 1728

#define OFF_WALL 0ull
#define OFF_WOUT 28311552ull
#define OFF_MOD 36700160ull
#define OFF_H 36749312ull
#define OFF_RWW OFF_H
#define OFF_RWKK (OFF_H + 16777216ull)
#define OFF_PROJ 70303744ull
#define OFF_MIX 183549952ull
#define OFF_RWB 217104384ull
#define OFF_GLAS 250658816ull
#define OFF_GLAD 259047424ull
#define OFF_BONUS 259178496ull
#define OFF_ZP 259440640ull
#define WS_END 267829248ull

#define SMEM_BYTES 59392

struct Params {
  const float *x, *c, *ada_w, *ada_b, *norm_pre, *norm_post, *w_in, *w_out, *sinks, *mu_rkv, *mu_w, *mu_a, *w0, *w1, *w2,
      *a0, *a1, *a2, *k_k, *k_a, *r_k, *ln_w, *ln_b, *gk1, *gk2, *gk_b, *gla_nw;
  float* out;
  unsigned char* ws;
};

__device__ __forceinline__ u16 f2bf(float f) {
  unsigned u = __float_as_uint(f);
  u += 0x7fffu + ((u >> 16) & 1u);
  return (u16)(u >> 16);
}
__device__ __forceinline__ float bf2f(u16 h) { return __uint_as_float(((unsigned)h) << 16); }
__device__ __forceinline__ unsigned pack2(float a, float b) { return (unsigned)f2bf(a) | ((unsigned)f2bf(b) << 16); }
__device__ __forceinline__ float bflo(unsigned u) { return __uint_as_float(u << 16); }
__device__ __forceinline__ float bfhi(unsigned u) { return __uint_as_float(u & 0xffff0000u); }
__device__ __forceinline__ float wave_sum(float v) {
#pragma unroll
  for (int o = 32; o > 0; o >>= 1) v += __shfl_xor(v, o);
  return v;
}
__device__ __forceinline__ float silu(float x) { return x / (1.f + __expf(-x)); }
__device__ __forceinline__ float sigmoidf_(float x) { return 1.f / (1.f + __expf(-x)); }
__device__ __forceinline__ float softplusf_(float z) { return fmaxf(z, 0.f) + log1pf(__expf(-fabsf(z))); }

__device__ __forceinline__ int opq(int x) { asm volatile("" : "+s"(x)); return x; }
__device__ __forceinline__ int opaque_tid() { int t = threadIdx.x; asm volatile("" : "+v"(t)); return t; }
template <int CTRL>
__device__ __forceinline__ float dpp_f(float x) {
  return __builtin_bit_cast(float, __builtin_amdgcn_update_dpp(0, __builtin_bit_cast(int, x), CTRL, 0xf, 0xf, false));
}
__device__ __forceinline__ float row16_allsum(float x) {
  x += dpp_f<0x128>(x);
  x += dpp_f<0x124>(x);
  x += dpp_f<0x122>(x);
  x += dpp_f<0x121>(x);
  return x;
}

__device__ void phase_mod(const Params& p, unsigned char* smem) {
  float* red = (float*)smem;
  const int tid = opaque_tid(), tx = tid & 31, ty = tid >> 5;
  float* mod = (float*)(p.ws + OFF_MOD);
  for (int it = blockIdx.x; it < 384; it += gridDim.x) {
    int l = it / 96;
    int j = (it % 96) * 32 + tx;
    const float* W = p.ada_w + (size_t)l * 1024 * 3072;
    float acc = 0.f;
    for (int i = 0; i < 128; ++i) {
      int k = ty * 128 + i;
      float cv = p.c[k];
      acc += silu(cv) * W[(size_t)k * 3072 + j];
    }
    red[ty * 32 + tx] = acc;
    __syncthreads();
    if (ty == 0) {
      float s = 0.f;
      for (int g = 0; g < 8; ++g) s += red[g * 32 + tx];
      mod[l * 3072 + j] = s + p.ada_b[l * 3072 + j];
    }
    __syncthreads();
  }
}

__device__ __forceinline__ float wall_src(const Params& p, int l, int k, int n) {
  size_t lk = (size_t)l * 1024 + k;
  if (n < 3072) return p.w_in[lk * 3072 + n];
  if (n < 3136) return (1.f - p.mu_w[lk]) * p.w1[lk * 64 + (n - 3072)];
  if (n < 3200) return p.mu_w[lk] * p.w1[lk * 64 + (n - 3136)];
  if (n < 3264) return (1.f - p.mu_a[lk]) * p.a1[lk * 64 + (n - 3200)];
  if (n < 3328) return p.mu_a[lk] * p.a1[lk * 64 + (n - 3264)];
  if (n < 3344) return p.gk1[lk * 16 + (n - 3328)];
  return 0.f;
}

__device__ void phase_wconv(const Params& p, unsigned char* smem) {
  float* tile = (float*)smem;
  const int tid = opaque_tid();
  u16* WALL = (u16*)(p.ws + OFF_WALL);
  u16* WOUT = (u16*)(p.ws + OFF_WOUT);
  for (int it = blockIdx.x; it < 4480; it += gridDim.x) {
    bool isout = it >= 3456;
    int l, nt, kt;
    if (!isout) { l = it / 864; int r = it % 864; nt = r >> 4; kt = r & 15; }
    else { int r = it - 3456; l = r >> 8; r &= 255; nt = r >> 4; kt = r & 15; }
    int tx = tid & 63, ty = tid >> 6;
#pragma unroll 4
    for (int i = 0; i < 16; ++i) {
      int kl = ty + 4 * i;
      int k = kt * 64 + kl, n = nt * 64 + tx;
      float v = isout ? p.w_out[((size_t)l * 1024 + k) * 1024 + n] : wall_src(p, l, k, n);
      tile[kl * 65 + tx] = v;
    }
    __syncthreads();
    int nl = tid >> 2, kq = tid & 3;
    unsigned w[8];
#pragma unroll
    for (int j = 0; j < 8; ++j) w[j] = pack2(tile[(kq * 16 + 2 * j) * 65 + nl], tile[(kq * 16 + 2 * j + 1) * 65 + nl]);
    u16* dst = (isout ? WOUT + ((size_t)l * 1024 + nt * 64 + nl) * 1024 : WALL + ((size_t)l * NALL + nt * 64 + nl) * 1024) + kt * 64 + kq * 16;
    ((uint4*)dst)[0] = make_uint4(w[0], w[1], w[2], w[3]);
    ((uint4*)dst)[1] = make_uint4(w[4], w[5], w[6], w[7]);
    __syncthreads();
  }
}

__device__ __forceinline__ void write_h(const Params& p, int l, int row, int lane, const float4* v, float ss) {
  const float* mod = (const float*)(p.ws + OFF_MOD) + l * 3072;
  u16* H = (u16*)(p.ws + OFF_H);
  float rs = rsqrtf(ss * (1.f / 1024.f) + 1e-6f);
#pragma unroll
  for (int i = 0; i < 4; ++i) {
    int col = (lane + 64 * i) * 4;
    float4 g = *(const float4*)(p.norm_pre + l * 1024 + col);
    float4 sh = *(const float4*)(mod + col);
    float4 sc = *(const float4*)(mod + 1024 + col);
    float h0 = v[i].x * rs * g.x * (1.f + sc.x) + sh.x;
    float h1 = v[i].y * rs * g.y * (1.f + sc.y) + sh.y;
    float h2 = v[i].z * rs * g.z * (1.f + sc.z) + sh.z;
    float h3 = v[i].w * rs * g.w * (1.f + sc.w) + sh.w;
    *(uint2*)(H + (size_t)row * 1024 + col) = make_uint2(pack2(h0, h1), pack2(h2, h3));
  }
}

__device__ void phase_h0(const Params& p) {
  const int tid = opaque_tid(); const int wave = tid >> 6, lane = tid & 63;
  for (int row = blockIdx.x * 4 + wave; row < T_; row += gridDim.x * 4) {
    const float4* xr = (const float4*)(p.x + (size_t)row * 1024);
    float4 v[4];
    float ss = 0.f;
#pragma unroll
    for (int i = 0; i < 4; ++i) {
      v[i] = xr[lane + 64 * i];
      ss += v[i].x * v[i].x + v[i].y * v[i].y + v[i].z * v[i].z + v[i].w * v[i].w;
    }
    ss = wave_sum(ss);
    write_h(p, 0, row, lane, v, ss);
  }
}

__device__ void phase_post(const Params& p, int l) {
  l = opq(l);
  const int tid = opaque_tid(); const int wave = tid >> 6, lane = tid & 63;
  const float* Y = (const float*)(p.ws + OFF_PROJ);
  const float* mod = (const float*)(p.ws + OFF_MOD) + l * 3072;
  const float* xold = (l == 0) ? p.x : p.out;
  for (int row = blockIdx.x * 4 + wave; row < T_; row += gridDim.x * 4) {
    const float4* yr = (const float4*)(Y + (size_t)row * 1024);
    const float4* xr = (const float4*)(xold + (size_t)row * 1024);
    float4 y[4], v[4];
    float ss = 0.f;
#pragma unroll
    for (int i = 0; i < 4; ++i) {
      y[i] = yr[lane + 64 * i];
      v[i] = xr[lane + 64 * i];
      ss += y[i].x * y[i].x + y[i].y * y[i].y + y[i].z * y[i].z + y[i].w * y[i].w;
    }
    ss = wave_sum(ss);
    float rs = rsqrtf(ss * (1.f / 1024.f) + 1e-6f);
    float s2 = 0.f;
#pragma unroll
    for (int i = 0; i < 4; ++i) {
      int col = (lane + 64 * i) * 4;
      float4 g = *(const float4*)(p.norm_post + l * 1024 + col);
      float4 gt = *(const float4*)(mod + 2048 + col);
      v[i].x += gt.x * (y[i].x * rs * g.x);
      v[i].y += gt.y * (y[i].y * rs * g.y);
      v[i].z += gt.z * (y[i].z * rs * g.z);
      v[i].w += gt.w * (y[i].w * rs * g.w);
      *(float4*)(p.out + (size_t)row * 1024 + col) = v[i];
      s2 += v[i].x * v[i].x + v[i].y * v[i].y + v[i].z * v[i].z + v[i].w * v[i].w;
    }
    if (l < 3) {
      s2 = wave_sum(s2);
      write_h(p, l + 1, row, lane, v, s2);
    }
  }
}

template <bool OUT_BF16>
__device__ void gemm_phase(const u16* __restrict__ A, const u16* __restrict__ Bt, void* Cv, int M, int N, int K, int ldc, unsigned char* smem) {
  u16* As = (u16*)smem;
  u16* Bs = As + 2 * 128 * 40;
  const int tid = opaque_tid(), wave = tid >> 6, lane = tid & 63;
  const int wr = wave >> 1, wc = wave & 1, fr = lane & 15, fq = lane >> 4;
  const int lrow = tid >> 2, lch = tid & 3;
  const int ntn = N / 128, ntiles = (M / 128) * ntn, nk = K / 32;
  for (int t = blockIdx.x; t < ntiles; t += gridDim.x) {
    const int m = t / ntn, n = t % ntn;
    f32x4 acc[4][4];
#pragma unroll
    for (int i = 0; i < 4; ++i)
#pragma unroll
      for (int j = 0; j < 4; ++j) acc[i][j] = (f32x4){0.f, 0.f, 0.f, 0.f};
    const u16* Ag = A + (size_t)(m * 128 + lrow) * K + lch * 8;
    const u16* Bg = Bt + (size_t)(n * 128 + lrow) * K + lch * 8;
    uint4 ra0 = *(const uint4*)(Ag), ra1 = *(const uint4*)(Ag + (size_t)64 * K);
    uint4 rb0 = *(const uint4*)(Bg), rb1 = *(const uint4*)(Bg + (size_t)64 * K);
    *(uint4*)(As + lrow * 40 + lch * 8) = ra0;
    *(uint4*)(As + (lrow + 64) * 40 + lch * 8) = ra1;
    *(uint4*)(Bs + lrow * 40 + lch * 8) = rb0;
    *(uint4*)(Bs + (lrow + 64) * 40 + lch * 8) = rb1;
    __syncthreads();
    for (int kt = 0; kt < nk; ++kt) {
      const int cur = kt & 1;
      if (kt + 1 < nk) {
        ra0 = *(const uint4*)(Ag + (kt + 1) * 32);
        ra1 = *(const uint4*)(Ag + (size_t)64 * K + (kt + 1) * 32);
        rb0 = *(const uint4*)(Bg + (kt + 1) * 32);
        rb1 = *(const uint4*)(Bg + (size_t)64 * K + (kt + 1) * 32);
      }
      const u16* Ac = As + cur * 5120;
      const u16* Bc = Bs + cur * 5120;
      bf16x8 af[4], bfr[4];
#pragma unroll
      for (int i = 0; i < 4; ++i) af[i] = *(const bf16x8*)(Ac + (wr * 64 + i * 16 + fr) * 40 + fq * 8);
#pragma unroll
      for (int i = 0; i < 4; ++i) bfr[i] = *(const bf16x8*)(Bc + (wc * 64 + i * 16 + fr) * 40 + fq * 8);
#pragma unroll
      for (int i = 0; i < 4; ++i)
#pragma unroll
        for (int j = 0; j < 4; ++j) acc[i][j] = __builtin_amdgcn_mfma_f32_16x16x32_bf16(af[i], bfr[j], acc[i][j], 0, 0, 0);
      if (kt + 1 < nk) {
        u16* An = As + (cur ^ 1) * 5120;
        u16* Bn = Bs + (cur ^ 1) * 5120;
        *(uint4*)(An + lrow * 40 + lch * 8) = ra0;
        *(uint4*)(An + (lrow + 64) * 40 + lch * 8) = ra1;
        *(uint4*)(Bn + lrow * 40 + lch * 8) = rb0;
        *(uint4*)(Bn + (lrow + 64) * 40 + lch * 8) = rb1;
      }
      __syncthreads();
    }
#pragma unroll
    for (int i = 0; i < 4; ++i)
#pragma unroll
      for (int j = 0; j < 4; ++j)
#pragma unroll
        for (int e = 0; e < 4; ++e) {
          int row = m * 128 + wr * 64 + i * 16 + fq * 4 + e;
          int col = n * 128 + wc * 64 + j * 16 + fr;
          if (OUT_BF16) ((u16*)Cv)[(size_t)row * ldc + col] = f2bf(acc[i][j][e]);
          else ((float*)Cv)[(size_t)row * ldc + col] = acc[i][j][e];
        }
  }
}

__device__ void attn_item(const Params& p, int l, int item, unsigned char* smem) {
  l = opq(l); item = opq(item);
  u16* Vt = (u16*)smem;
  const u16* PROJ = (const u16*)(p.ws + OFF_PROJ);
  u16* MIX = (u16*)(p.ws + OFF_MIX);
  const int tid = opaque_tid(), w = tid >> 6, lane = tid & 63, l31 = lane & 31, hf = lane >> 5;
  const int qb = item >> 3, head = item & 7, kvh = head >> 2;
  const int kpos0 = (qb - 1) * 128;
  {
    int kp = kpos0 + tid;
    if (kp < 0) kp = 0;
    const uint4* src = (const uint4*)(PROJ + (size_t)kp * NALL + 640 + kvh * 64);
#pragma unroll
    for (int c8 = 0; c8 < 8; ++c8) {
      uint4 v = src[c8];
      int d = c8 * 8;
      Vt[(d + 0) * 264 + tid] = (u16)(v.x & 0xffff);
      Vt[(d + 1) * 264 + tid] = (u16)(v.x >> 16);
      Vt[(d + 2) * 264 + tid] = (u16)(v.y & 0xffff);
      Vt[(d + 3) * 264 + tid] = (u16)(v.y >> 16);
      Vt[(d + 4) * 264 + tid] = (u16)(v.z & 0xffff);
      Vt[(d + 5) * 264 + tid] = (u16)(v.z >> 16);
      Vt[(d + 6) * 264 + tid] = (u16)(v.w & 0xffff);
      Vt[(d + 7) * 264 + tid] = (u16)(v.w >> 16);
    }
  }
  __syncthreads();
  const int tq = qb * 128 + 32 * w + l31;
  bf16x8 qf[4];
  {
    const u16* qp = PROJ + (size_t)tq * NALL + head * 64 + 8 * hf;
#pragma unroll
    for (int s = 0; s < 4; ++s) qf[s] = *(const bf16x8*)(qp + 16 * s);
  }
  const float slope = exp2f(-(float)(head + 1));
  const float sink = p.sinks[l * 8 + head];
  const int rq = 32 * w + l31;
  float mrun = -1e30f, lsum = 0.f;
  f32x16 o0, o1;
#pragma unroll
  for (int r = 0; r < 16; ++r) { o0[r] = 0.f; o1[r] = 0.f; }
#pragma unroll 1
  for (int i = 0; i < 5; ++i) {
    int kp = kpos0 + 32 * w + 32 * i + l31;
    if (kp < 0) kp = 0;
    const u16* kptr = PROJ + (size_t)kp * NALL + 512 + kvh * 64 + 8 * hf;
    f32x16 a;
#pragma unroll
    for (int r = 0; r < 16; ++r) a[r] = 0.f;
#pragma unroll
    for (int s = 0; s < 4; ++s) {
      bf16x8 kf = *(const bf16x8*)(kptr + 16 * s);
      a = __builtin_amdgcn_mfma_f32_32x32x16_bf16(kf, qf[s], a, 0, 0, 0);
    }
    float tmax = -1e30f;
#pragma unroll
    for (int r = 0; r < 16; ++r) {
      int kj = 32 * w + 32 * i + (r & 3) + 8 * (r >> 2) + 4 * hf;
      int dist = 128 + rq - kj;
      bool valid = (dist >= 0) && (dist < 128) && (kpos0 + kj >= 0);
      float sv = a[r] * 0.125f - slope * (float)dist;
      sv = valid ? sv : -1e30f;
      a[r] = sv;
      tmax = fmaxf(tmax, sv);
    }
    tmax = fmaxf(tmax, __shfl_xor(tmax, 32));
    const float mnew = fmaxf(mrun, tmax);
    const float alpha = __expf(mrun - mnew);
    float psum = 0.f;
#pragma unroll
    for (int r = 0; r < 16; ++r) {
      float e = (a[r] > -1e29f) ? __expf(a[r] - mnew) : 0.f;
      a[r] = e;
      psum += e;
    }
    lsum = lsum * alpha + psum;
    mrun = mnew;
#pragma unroll
    for (int r = 0; r < 16; ++r) { o0[r] *= alpha; o1[r] *= alpha; }
#pragma unroll
    for (int u = 0; u < 2; ++u) {
      bf16x8 pf;
#pragma unroll
      for (int j = 0; j < 8; ++j) pf[j] = (short)f2bf(a[8 * u + j]);
      const int kb = 32 * w + 32 * i + 16 * u + 4 * hf;
      const u16* v0 = Vt + l31 * 264 + kb;
      const u16* v1 = Vt + (32 + l31) * 264 + kb;
      uint2 a0 = *(const uint2*)(v0), a1 = *(const uint2*)(v0 + 8);
      uint2 b0 = *(const uint2*)(v1), b1 = *(const uint2*)(v1 + 8);
      uint4 A0 = make_uint4(a0.x, a0.y, a1.x, a1.y), A1 = make_uint4(b0.x, b0.y, b1.x, b1.y);
      o0 = __builtin_amdgcn_mfma_f32_32x32x16_bf16(__builtin_bit_cast(bf16x8, A0), pf, o0, 0, 0, 0);
      o1 = __builtin_amdgcn_mfma_f32_32x32x16_bf16(__builtin_bit_cast(bf16x8, A1), pf, o1, 0, 0, 0);
    }
  }
  {
    const float mf = fmaxf(mrun, sink);
    const float scl = __expf(mrun - mf);
    const float ltot = (lsum + __shfl_xor(lsum, 32)) * scl + __expf(sink - mf);
    const float fin = scl / ltot;
#pragma unroll
    for (int r = 0; r < 16; ++r) { o0[r] *= fin; o1[r] *= fin; }
  }
  const u16* gp = PROJ + (size_t)tq * NALL + 768 + head * 64;
  u16* op = MIX + (size_t)tq * 1024 + head * 64;
#pragma unroll
  for (int g = 0; g < 4; ++g) {
    int d0 = 8 * g + 4 * hf;
    uint2 gg = *(const uint2*)(gp + d0);
    float r0 = o0[4 * g + 0] * silu(bflo(gg.x)), r1 = o0[4 * g + 1] * silu(bfhi(gg.x));
    float r2 = o0[4 * g + 2] * silu(bflo(gg.y)), r3 = o0[4 * g + 3] * silu(bfhi(gg.y));
    *(uint2*)(op + d0) = make_uint2(pack2(r0, r1), pack2(r2, r3));
    uint2 g2 = *(const uint2*)(gp + 32 + d0);
    r0 = o1[4 * g + 0] * silu(bflo(g2.x)); r1 = o1[4 * g + 1] * silu(bfhi(g2.x));
    r2 = o1[4 * g + 2] * silu(bflo(g2.y)); r3 = o1[4 * g + 3] * silu(bfhi(g2.y));
    *(uint2*)(op + 32 + d0) = make_uint2(pack2(r0, r1), pack2(r2, r3));
  }
  __syncthreads();
}

__device__ void rwkv_prep_item(const Params& p, int l, int item, unsigned char* smem) {
  l = opq(l); item = opq(item);
  float* lw = (float*)smem;
  float* la = lw + 1024;
  const u16* PROJ = (const u16*)(p.ws + OFF_PROJ);
  const int tid = opaque_tid(), c = tid, head = tid >> 6, lane = tid & 63;
  const int t0 = item * 16;
#pragma unroll
  for (int i = 0; i < 8; ++i) {
    int idx = tid + 256 * i;
    int which = idx >> 10, tt = (idx >> 6) & 15, j = idx & 63;
    int t = t0 + tt;
    const u16* pr = PROJ + (size_t)t * NALL;
    float cur = bf2f(pr[(which ? 3200 : 3072) + j]);
    float prev = (t > 0) ? bf2f((pr - NALL)[(which ? 3264 : 3136) + j]) : 0.f;
    float s = cur + prev;
    if (!which) s = tanhf(s);
    (which ? la : lw)[tt * 64 + j] = s;
  }
  __syncthreads();
  float accw[16], acca[16];
#pragma unroll
  for (int tt = 0; tt < 16; ++tt) { accw[tt] = 0.f; acca[tt] = 0.f; }
  const float* w2 = p.w2 + (size_t)l * 64 * 256 + c;
  const float* a2 = p.a2 + (size_t)l * 64 * 256 + c;
  for (int j4 = 0; j4 < 16; ++j4) {
    float w20 = w2[(4 * j4 + 0) * 256], w21 = w2[(4 * j4 + 1) * 256], w22 = w2[(4 * j4 + 2) * 256], w23 = w2[(4 * j4 + 3) * 256];
    float a20 = a2[(4 * j4 + 0) * 256], a21 = a2[(4 * j4 + 1) * 256], a22 = a2[(4 * j4 + 2) * 256], a23 = a2[(4 * j4 + 3) * 256];
#pragma unroll
    for (int tt = 0; tt < 16; ++tt) {
      float4 lv = *(const float4*)(lw + tt * 64 + j4 * 4);
      float4 av = *(const float4*)(la + tt * 64 + j4 * 4);
      accw[tt] += lv.x * w20 + lv.y * w21 + lv.z * w22 + lv.w * w23;
      acca[tt] += av.x * a20 + av.y * a21 + av.z * a22 + av.w * a23;
    }
  }
  const float mur = p.mu_rkv[l * 768 + c], muk = p.mu_rkv[l * 768 + 256 + c], muv = p.mu_rkv[l * 768 + 512 + c];
  const float w0 = p.w0[l * 256 + c], a0 = p.a0[l * 256 + c], kkw = p.k_k[l * 256 + c], kaw = p.k_a[l * 256 + c], rkw = p.r_k[l * 256 + c];
  float* RWW = (float*)(p.ws + OFF_RWW);
  float* RWKK = (float*)(p.ws + OFF_RWKK);
  u16* RB = (u16*)(p.ws + OFF_RWB);
  float* BON = (float*)(p.ws + OFF_BONUS);
#pragma unroll
  for (int tt = 0; tt < 16; ++tt) {
    int t = t0 + tt;
    const u16* pr = PROJ + (size_t)t * NALL;
    float rc = bf2f(pr[1280 + c]), kc = bf2f(pr[1536 + c]), vc = bf2f(pr[1792 + c]);
    float rp = 0.f, kp = 0.f, vp = 0.f;
    if (t > 0) { rp = bf2f((pr - NALL)[1280 + c]); kp = bf2f((pr - NALL)[1536 + c]); vp = bf2f((pr - NALL)[1792 + c]); }
    float r = rc + (rp - rc) * mur, k = kc + (kp - kc) * muk, v = vc + (vp - vc) * muv;
    float wpre = w0 + accw[tt];
    float wl = -softplusf_(-wpre) - 0.5f;
    float decay = __expf(-__expf(wl));
    float a = sigmoidf_(a0 + acca[tt]);
    float kkc = k * kkw;
    float n2 = wave_sum(kkc * kkc);
    float kk = kkc / fmaxf(sqrtf(n2), 1e-12f);
    float kmod = k * (1.f + (a - 1.f) * kaw);
    float bb = kk * a;
    float bonus = wave_sum(r * kmod * rkw);
    size_t o = (size_t)t * 256 + c;
    RWW[o] = decay;
    RWKK[o] = kk;
    RB[o] = f2bf(r);
    RB[(size_t)T_ * 256 + o] = f2bf(kmod);
    RB[(size_t)2 * T_ * 256 + o] = f2bf(v);
    RB[(size_t)3 * T_ * 256 + o] = f2bf(bb);
    if (lane == 0) BON[t * 4 + head] = bonus;
  }
  __syncthreads();
}

__device__ __forceinline__ void gla_b(const Params& p, int l, int chunk, int head, float* tot, float* bl) {
  const u16* PROJ = (const u16*)(p.ws + OFF_PROJ);
  const int tid = opaque_tid(), d = tid & 31, ig = tid >> 5;
  float g2[16];
#pragma unroll
  for (int m = 0; m < 16; ++m) g2[m] = p.gk2[(size_t)l * 16 * 128 + m * 128 + head * 32 + d];
  const float bias = p.gk_b[l * 128 + head * 32 + d];
  float run = 0.f;
#pragma unroll
  for (int ii = 0; ii < 8; ++ii) {
    int t = chunk * 64 + ig * 8 + ii;
    const uint4* lp = (const uint4*)(PROJ + (size_t)t * NALL + 3328);
    uint4 u0 = lp[0], u1 = lp[1];
    float z = bias;
    z += bflo(u0.x) * g2[0] + bfhi(u0.x) * g2[1] + bflo(u0.y) * g2[2] + bfhi(u0.y) * g2[3];
    z += bflo(u0.z) * g2[4] + bfhi(u0.z) * g2[5] + bflo(u0.w) * g2[6] + bfhi(u0.w) * g2[7];
    z += bflo(u1.x) * g2[8] + bfhi(u1.x) * g2[9] + bflo(u1.y) * g2[10] + bfhi(u1.y) * g2[11];
    z += bflo(u1.z) * g2[12] + bfhi(u1.z) * g2[13] + bflo(u1.w) * g2[14] + bfhi(u1.w) * g2[15];
    float g = (fminf(z, 0.f) - log1pf(__expf(-fabsf(z)))) * (1.f / 16.f);
    run += g;
    bl[ii] = run;
  }
  tot[ig * 32 + d] = run;
  __syncthreads();
  float off = 0.f;
#pragma unroll
  for (int g = 0; g < 8; ++g) off += (g < ig) ? tot[g * 32 + d] : 0.f;
#pragma unroll
  for (int ii = 0; ii < 8; ++ii) bl[ii] += off;
}

__device__ void gla_local_item(const Params& p, int l, int item, unsigned char* smem) {
  l = opq(l); item = opq(item);
  float* tot = (float*)smem;
  float* Kp = tot + 256;
  float* Vs = Kp + 2048;
  const u16* PROJ = (const u16*)(p.ws + OFF_PROJ);
  const int tid = opaque_tid(), d = tid & 31, ig = tid >> 5;
  const int chunk = item >> 2, head = item & 3;
  float bl[8];
  gla_b(p, l, chunk, head, tot, bl);
  float blast = 0.f;
#pragma unroll
  for (int g = 0; g < 8; ++g) blast += tot[g * 32 + d];
#pragma unroll
  for (int ii = 0; ii < 8; ++ii) {
    int i = ig * 8 + ii;
    int t = chunk * 64 + i;
    float k = bf2f(PROJ[(size_t)t * NALL + 2432 + head * 32 + d]);
    Kp[i * 32 + d] = k * __expf(blast - bl[ii]);
  }
#pragma unroll
  for (int r = 0; r < 16; ++r) {
    int idx = tid + 256 * r;
    int i = idx >> 6, v = idx & 63;
    Vs[idx] = bf2f(PROJ[(size_t)(chunk * 64 + i) * NALL + 2560 + head * 64 + v]);
  }
  __syncthreads();
  const int v = tid & 63, dg = tid >> 6;
  float acc[8];
#pragma unroll
  for (int q = 0; q < 8; ++q) acc[q] = 0.f;
  for (int i = 0; i < 64; ++i) {
    float vv = Vs[i * 64 + v];
    float4 k0 = *(const float4*)(Kp + i * 32 + dg * 8), k1 = *(const float4*)(Kp + i * 32 + dg * 8 + 4);
    acc[0] += k0.x * vv; acc[1] += k0.y * vv; acc[2] += k0.z * vv; acc[3] += k0.w * vv;
    acc[4] += k1.x * vv; acc[5] += k1.y * vv; acc[6] += k1.z * vv; acc[7] += k1.w * vv;
  }
  float* GS = (float*)(p.ws + OFF_GLAS);
  float* GD = (float*)(p.ws + OFF_GLAD);
#pragma unroll
  for (int q = 0; q < 8; ++q) GS[((size_t)(chunk * 4 + head) * 32 + dg * 8 + q) * 64 + v] = acc[q];
  if (tid < 32) GD[(chunk * 4 + head) * 32 + tid] = __expf(blast);
  __syncthreads();
}

__device__ void gla_state_item(const Params& p, int item) {
  item = opq(item);
  float* GS = (float*)(p.ws + OFF_GLAS);
  const float* GD = (const float*)(p.ws + OFF_GLAD);
  const int e = item * 256 + opaque_tid();
  const int head = e >> 11, d = (e >> 6) & 31, v = e & 63;
  float S = 0.f;
  for (int c0 = 0; c0 < 256; c0 += 8) {
    float ds[8], dc[8];
#pragma unroll
    for (int u = 0; u < 8; ++u) {
      ds[u] = GS[((size_t)((c0 + u) * 4 + head) * 32 + d) * 64 + v];
      dc[u] = GD[((c0 + u) * 4 + head) * 32 + d];
    }
#pragma unroll
    for (int u = 0; u < 8; ++u) {
      GS[((size_t)((c0 + u) * 4 + head) * 32 + d) * 64 + v] = S;
      S = dc[u] * S + ds[u];
    }
  }
}

__device__ void gla_out_item(const Params& p, int l, int item, unsigned char* smem) {
  l = opq(l); item = opq(item);
  float* tot = (float*)smem;
  float* qt = tot + 256;
  float* kt = qt + 2112;
  float* Vs = kt + 2112;
  float* Am = Vs + 4096;
  float* Ss = Am + 4160;
  const u16* PROJ = (const u16*)(p.ws + OFF_PROJ);
  u16* MIX = (u16*)(p.ws + OFF_MIX);
  const float* GS = (const float*)(p.ws + OFF_GLAS);
  const int tid = opaque_tid();
  const int chunk = item >> 2, head = item & 3;
  {
    const int d = tid & 31, ig = tid >> 5;
    float bl[8];
    gla_b(p, l, chunk, head, tot, bl);
#pragma unroll
    for (int ii = 0; ii < 8; ++ii) {
      int i = ig * 8 + ii;
      int t = chunk * 64 + i;
      float q = bf2f(PROJ[(size_t)t * NALL + 2304 + head * 32 + d]);
      float k = bf2f(PROJ[(size_t)t * NALL + 2432 + head * 32 + d]);
      qt[i * 33 + d] = q * 0.17677669529663687f * __expf(bl[ii]);
      kt[i * 33 + d] = k * __expf(-bl[ii]);
    }
  }
#pragma unroll
  for (int r = 0; r < 16; ++r) {
    int idx = tid + 256 * r;
    int i = idx >> 6, v = idx & 63;
    Vs[idx] = bf2f(PROJ[(size_t)(chunk * 64 + i) * NALL + 2560 + head * 64 + v]);
  }
#pragma unroll
  for (int r = 0; r < 8; ++r) {
    int idx = tid + 256 * r;
    Ss[idx] = GS[(size_t)(chunk * 4 + head) * 2048 + idx];
  }
  __syncthreads();
  const int j = tid & 63, ig = tid >> 6;
  {
    float acc[16];
#pragma unroll
    for (int ii = 0; ii < 16; ++ii) acc[ii] = 0.f;
    for (int d = 0; d < 32; ++d) {
      float kv = kt[j * 33 + d];
#pragma unroll
      for (int ii = 0; ii < 16; ++ii) acc[ii] += qt[(ig * 16 + ii) * 33 + d] * kv;
    }
#pragma unroll
    for (int ii = 0; ii < 16; ++ii) {
      int i = ig * 16 + ii;
      Am[i * 65 + j] = (j <= i) ? acc[ii] : 0.f;
    }
  }
  __syncthreads();
  {
    const int v = j;
    float acc[16];
#pragma unroll
    for (int ii = 0; ii < 16; ++ii) acc[ii] = 0.f;
    for (int jj = 0; jj < 64; ++jj) {
      float vv = Vs[jj * 64 + v];
#pragma unroll
      for (int ii = 0; ii < 16; ++ii) acc[ii] += Am[(ig * 16 + ii) * 65 + jj] * vv;
    }
    for (int d = 0; d < 32; ++d) {
      float sv = Ss[d * 64 + v];
#pragma unroll
      for (int ii = 0; ii < 16; ++ii) acc[ii] += qt[(ig * 16 + ii) * 33 + d] * sv;
    }
    const float nw = p.gla_nw[l * 64 + v];
#pragma unroll
    for (int ii = 0; ii < 16; ++ii) {
      int t = chunk * 64 + ig * 16 + ii;
      float o = acc[ii];
      float ms = wave_sum(o * o) * (1.f / 64.f);
      float gg = bf2f(PROJ[(size_t)t * NALL + 2816 + head * 64 + v]);
      float r = o * rsqrtf(ms + 1e-5f) * nw * silu(gg);
      MIX[(size_t)t * 1024 + 768 + head * 64 + v] = f2bf(r);
    }
  }
  __syncthreads();
}

__device__ void rwkv_scan_item(const Params& p, int item, unsigned char* smem) {
  item = opq(item);
  float* st = (float*)smem;
  const int tid = opaque_tid(), wv = tid >> 6, lane = tid & 63, rl = lane >> 4, kl = lane & 15;
  const int rb = item & 7, head = (item >> 3) & 3, seg = item >> 5;
  const bool ident = rb >= 4;
  const int R = rb * 16 + wv * 4 + rl;
  const int vrow = R & 63;
  const float* RWW = (const float*)(p.ws + OFF_RWW);
  const float* RWKK = (const float*)(p.ws + OFF_RWKK);
  const u16* RB = (const u16*)(p.ws + OFF_RWB);
  float* PF = (float*)(p.ws + OFF_PROJ);
  float* ZP = (float*)(p.ws + OFF_ZP);
  const int tbase = seg * SL;
  const int ls = tid >> 4, lc4 = (tid & 15) * 4;
  float S0 = 0.f, S1 = 0.f, S2 = 0.f, S3 = 0.f;
  if (ident) {
    int i = vrow;
    if ((i >> 2) == kl) {
      int e = i & 3;
      S0 = (e == 0) ? 1.f : 0.f; S1 = (e == 1) ? 1.f : 0.f; S2 = (e == 2) ? 1.f : 0.f; S3 = (e == 3) ? 1.f : 0.f;
    }
  }
  float4 gw, gkk;
  uint2 gr, gk, gb, gv;
  auto gload = [&](int ch) {
    size_t o = (size_t)(tbase + ch * 16 + ls) * 256 + head * 64 + lc4;
    gw = *(const float4*)(RWW + o);
    gkk = *(const float4*)(RWKK + o);
    gr = *(const uint2*)(RB + o);
    gk = *(const uint2*)(RB + (size_t)T_ * 256 + o);
    gv = *(const uint2*)(RB + (size_t)2 * T_ * 256 + o);
    gb = *(const uint2*)(RB + (size_t)3 * T_ * 256 + o);
  };
  auto lstore = [&](int buf) {
    float* b = st + buf * 6144 + ls * 64 + lc4;
    *(float4*)(b) = gw;
    *(float4*)(b + 1024) = gkk;
    *(float4*)(b + 2048) = make_float4(bflo(gr.x), bfhi(gr.x), bflo(gr.y), bfhi(gr.y));
    *(float4*)(b + 3072) = make_float4(bflo(gk.x), bfhi(gk.x), bflo(gk.y), bfhi(gk.y));
    *(float4*)(b + 4096) = make_float4(bflo(gb.x), bfhi(gb.x), bflo(gb.y), bfhi(gb.y));
    *(float4*)(b + 5120) = make_float4(bflo(gv.x), bfhi(gv.x), bflo(gv.y), bfhi(gv.y));
  };
  gload(0);
  lstore(0);
  __syncthreads();
  const int nch = SL / 16;
  for (int ch = 0; ch < nch; ++ch) {
    const int cur = ch & 1;
    if (ch + 1 < nch) gload(ch + 1);
    const float* b = st + cur * 6144;
#pragma unroll 4
    for (int s = 0; s < 16; ++s) {
      float4 w4 = *(const float4*)(b + s * 64 + kl * 4);
      float4 kk4 = *(const float4*)(b + 1024 + s * 64 + kl * 4);
      float4 r4 = *(const float4*)(b + 2048 + s * 64 + kl * 4);
      float4 k4 = *(const float4*)(b + 3072 + s * 64 + kl * 4);
      float4 b4 = *(const float4*)(b + 4096 + s * 64 + kl * 4);
      float vv = ident ? 0.f : b[5120 + s * 64 + vrow];
      float sa = -(S0 * kk4.x + S1 * kk4.y + S2 * kk4.z + S3 * kk4.w);
      sa = row16_allsum(sa);
      S0 = S0 * w4.x + sa * b4.x + vv * k4.x;
      S1 = S1 * w4.y + sa * b4.y + vv * k4.y;
      S2 = S2 * w4.z + sa * b4.z + vv * k4.z;
      S3 = S3 * w4.w + sa * b4.w + vv * k4.w;
      float y = S0 * r4.x + S1 * r4.y + S2 * r4.z + S3 * r4.w;
      y = row16_allsum(y);
      if (kl == 0) PF[(size_t)(tbase + ch * 16 + s) * PROJF + (ident ? 256 : 0) + head * 64 + vrow] = y;
    }
    if (ch + 1 < nch) lstore(cur ^ 1);
    __syncthreads();
  }
  *(float4*)(ZP + ((size_t)((seg * 4 + head) * 128 + R)) * 64 + kl * 4) = make_float4(S0, S1, S2, S3);
}

__device__ void rwkv_combine(const Params& p) {
  float* ZP = (float*)(p.ws + OFF_ZP);
  const int tid = opaque_tid(); const int b = blockIdx.x, wv = tid >> 6, lane = tid & 63;
  const int head = b >> 4, v = (b & 15) * 4 + wv;
  float s = 0.f;
  for (int seg = 0; seg < NSEG; ++seg) {
    float* base = ZP + (size_t)((seg * 4 + head) * 128) * 64;
    const float* P = base + 64 * 64;
    float z = base[v * 64 + lane];
    base[v * 64 + lane] = s;
    float ns = z;
#pragma unroll 16
    for (int i = 0; i < 64; ++i) {
      float si = __builtin_bit_cast(float, __builtin_amdgcn_readlane(__builtin_bit_cast(int, s), i));
      ns += si * P[i * 64 + lane];
    }
    s = ns;
  }
}

__device__ void rwkv_final_item(const Params& p, int l, int item, unsigned char* smem) {
  l = opq(l); item = opq(item);
  float* Ss = (float*)smem;
  float* rho = Ss + 4160;
  const int tid = opaque_tid(), v = tid & 63, tg = tid >> 6;
  const int tiles = SL / 64;
  const int q = item % tiles, head = (item / tiles) & 3, seg = item / (tiles * 4);
  const int t0 = seg * SL + q * 64;
  const float* ZP = (const float*)(p.ws + OFF_ZP);
  const float* PF = (const float*)(p.ws + OFF_PROJ);
  const u16* PROJ = (const u16*)(p.ws + OFF_PROJ);
  const u16* RBv = (const u16*)(p.ws + OFF_RWB) + (size_t)2 * T_ * 256;
  const float* BON = (const float*)(p.ws + OFF_BONUS);
  u16* MIX = (u16*)(p.ws + OFF_MIX);
#pragma unroll
  for (int r = 0; r < 16; ++r) {
    int idx = tid + 256 * r;
    int row = idx >> 6, col = idx & 63;
    Ss[row * 65 + col] = ZP[((size_t)((seg * 4 + head) * 128 + row)) * 64 + col];
    rho[idx] = PF[(size_t)(t0 + row) * PROJF + 256 + head * 64 + col];
  }
  __syncthreads();
  const int c = head * 64 + v;
  const float lnw = p.ln_w[l * 256 + c], lnb = p.ln_b[l * 256 + c];
#pragma unroll 1
  for (int hh = 0; hh < 2; ++hh) {
    const int tb = tg * 16 + hh * 8;
    float acc[8];
#pragma unroll
    for (int tt = 0; tt < 8; ++tt) acc[tt] = PF[(size_t)(t0 + tb + tt) * PROJF + head * 64 + v];
#pragma unroll 2
    for (int i4 = 0; i4 < 16; ++i4) {
      float s0 = Ss[v * 65 + 4 * i4], s1 = Ss[v * 65 + 4 * i4 + 1], s2 = Ss[v * 65 + 4 * i4 + 2], s3 = Ss[v * 65 + 4 * i4 + 3];
#pragma unroll
      for (int tt = 0; tt < 8; ++tt) {
        float4 rv = *(const float4*)(rho + (tb + tt) * 64 + 4 * i4);
        acc[tt] += s0 * rv.x + s1 * rv.y + s2 * rv.z + s3 * rv.w;
      }
    }
#pragma unroll
    for (int tt = 0; tt < 8; ++tt) {
      int t = t0 + tb + tt;
      float y = acc[tt];
      float mean = wave_sum(y) * (1.f / 64.f);
      float dlt = y - mean;
      float var = wave_sum(dlt * dlt) * (1.f / 64.f);
      float o = dlt * rsqrtf(var + 64e-5f) * lnw + lnb;
      o += BON[t * 4 + head] * bf2f(RBv[(size_t)t * 256 + c]);
      float g = bf2f(PROJ[(size_t)t * NALL + 2048 + c]);
      MIX[(size_t)t * 1024 + 512 + c] = f2bf(o * silu(g));
    }
  }
  __syncthreads();
}

__global__ void __launch_bounds__(256) fwd_megakernel(Params p) {
  cg::grid_group grid = cg::this_grid();
  __shared__ __attribute__((aligned(16))) unsigned char smem[SMEM_BYTES];
  const int nb = gridDim.x;
#ifndef PH
#define PH 0xffff
#endif
  if (PH & 1) phase_mod(p, smem);
  if (PH & 2) phase_wconv(p, smem);
  grid.sync();
  if (PH & 4) phase_h0(p);
  grid.sync();
  for (int l = 0; l < 4; ++l) {
    if (PH & 8) gemm_phase<true>((const u16*)(p.ws + OFF_H), (const u16*)(p.ws + OFF_WALL) + (size_t)l * NALL * 1024, p.ws + OFF_PROJ, T_, NALL, 1024, NALL, smem);
    grid.sync();
    for (int it = blockIdx.x; it < 3072; it += nb) {
      if (it < 1024) { if (PH & 16) attn_item(p, l, it, smem); }
      else if (it < 2048) { if (PH & 32) rwkv_prep_item(p, l, it - 1024, smem); }
      else { if (PH & 64) gla_local_item(p, l, it - 2048, smem); }
    }
    grid.sync();
    for (int it = blockIdx.x; it < 32 + NSEG * 32; it += nb) {
      if (it < 32) { if (PH & 128) gla_state_item(p, it); }
      else { if (PH & 256) rwkv_scan_item(p, it - 32, smem); }
    }
    grid.sync();
    if (blockIdx.x < 64) { if (PH & 512) rwkv_combine(p); }
    for (int it = blockIdx.x; it < 1024; it += nb) { if (PH & 1024) gla_out_item(p, l, it, smem); }
    grid.sync();
    for (int it = blockIdx.x; it < NSEG * 4 * (SL / 64); it += nb) { if (PH & 2048) rwkv_final_item(p, l, it, smem); }
    grid.sync();
    if (PH & 4096) gemm_phase<false>((const u16*)(p.ws + OFF_MIX), (const u16*)(p.ws + OFF_WOUT) + (size_t)l * 1024 * 1024, p.ws + OFF_PROJ, T_, 1024, 1024, 1024, smem);
    grid.sync();
    if (PH & 8192) phase_post(p, l);
    if (l < 3) grid.sync();
  }
}

extern "C" void kernel_launch(void* const* d_in, const int* in_sizes, int n_in, void* d_out, int out_size, void* d_ws, size_t ws_size,
                              hipStream_t stream) {
  static int grid_blocks = 0;
  if (!grid_blocks) {
    int dev = 0, cus = 0, per_cu = 0;
    hipGetDevice(&dev);
    hipDeviceGetAttribute(&cus, hipDeviceAttributeMultiprocessorCount, dev);
    hipOccupancyMaxActiveBlocksPerMultiprocessor(&per_cu, fwd_megakernel, 256, 0);
    if (per_cu < 1) per_cu = 1;
    if (per_cu > 4) per_cu = 4;
    grid_blocks = cus * per_cu;
    if (grid_blocks < 64) grid_blocks = 64;
  }
  if (n_in != 27 || ws_size < WS_END) {
    fprintf(stderr, "kernel_launch: unexpected n_in %d / ws %zu\n", n_in, ws_size);
    return;
  }
  Params p{};
  const float** pp = (const float**)&p;
  for (int i = 0; i < 27; ++i) pp[i] = (const float*)d_in[i];
  p.out = (float*)d_out;
  p.ws = (unsigned char*)d_ws;
  void* args[] = {&p};
  hipError_t e = hipLaunchCooperativeKernel((void*)fwd_megakernel, dim3(grid_blocks), dim3(256), args, 0, stream);
  if (e != hipSuccess) fprintf(stderr, "cooperative launch failed: %s (grid %d)\n", hipGetErrorString(e), grid_blocks);
}
```

```cpp
#include <hip/hip_runtime.h>
#include <hip/hip_bf16.h>
#include <hip/hip_cooperative_groups.h>
#include <cstdio>
namespace cg = cooperative_groups;

typedef unsigned short u16;
using bf16x8 = __attribute__((ext_vector_type(8))) short;
using f32x4 = __attribute__((ext_vector_type(4))) float;
using f32x16 = __attribute__((ext_vector_type(16))) float;

#define T_ 16384
#define NALL 3456
#define NSEG 64
#define SL (T_ / NSEG)
#define PROJF 1728

#define OFF_WALL 0ull
#define OFF_WOUT 28311552ull
#define OFF_MOD 36700160ull
#define OFF_H 36749312ull
#define OFF_RWW OFF_H
#define OFF_RWKK (OFF_H + 16777216ull)
#define OFF_PROJ 70303744ull
#define OFF_MIX 183549952ull
#define OFF_RWB 217104384ull
#define OFF_GLAS 250658816ull
#define OFF_GLAD 259047424ull
#define OFF_BONUS 259178496ull
#define OFF_ZP 259440640ull
#define WS_END 267829248ull


struct Params {
  const float *x, *c, *ada_w, *ada_b, *norm_pre, *norm_post, *w_in, *w_out, *sinks, *mu_rkv, *mu_w, *mu_a, *w0, *w1, *w2,
      *a0, *a1, *a2, *k_k, *k_a, *r_k, *ln_w, *ln_b, *gk1, *gk2, *gk_b, *gla_nw;
  float* out;
  unsigned char* ws;
};

__device__ __forceinline__ u16 f2bf(float f) {
  unsigned u = __float_as_uint(f);
  u += 0x7fffu + ((u >> 16) & 1u);
  return (u16)(u >> 16);
}
__device__ __forceinline__ float bf2f(u16 h) { return __uint_as_float(((unsigned)h) << 16); }
__device__ __forceinline__ unsigned pack2(float a, float b) { return (unsigned)f2bf(a) | ((unsigned)f2bf(b) << 16); }
__device__ __forceinline__ float bflo(unsigned u) { return __uint_as_float(u << 16); }
__device__ __forceinline__ float bfhi(unsigned u) { return __uint_as_float(u & 0xffff0000u); }
__device__ __forceinline__ float wave_sum(float v) {
#pragma unroll
  for (int o = 32; o > 0; o >>= 1) v += __shfl_xor(v, o);
  return v;
}
__device__ __forceinline__ float silu(float x) { return x / (1.f + __expf(-x)); }
__device__ __forceinline__ float sigmoidf_(float x) { return 1.f / (1.f + __expf(-x)); }
__device__ __forceinline__ float softplusf_(float z) { return fmaxf(z, 0.f) + log1pf(__expf(-fabsf(z))); }

__device__ __forceinline__ int opq(int x) { asm volatile("" : "+s"(x)); return x; }
__device__ __forceinline__ int opaque_tid() { int t = threadIdx.x & 255; asm volatile("" : "+v"(t)); return t; }
__device__ __forceinline__ int opaque_tid512() { int t = threadIdx.x; asm volatile("" : "+v"(t)); return t; }
template <int CTRL>
__device__ __forceinline__ float dpp_f(float x) {
  return __builtin_bit_cast(float, __builtin_amdgcn_update_dpp(0, __builtin_bit_cast(int, x), CTRL, 0xf, 0xf, false));
}
__device__ __forceinline__ float row16_allsum(float x) {
  x += dpp_f<0x128>(x);
  x += dpp_f<0x124>(x);
  x += dpp_f<0x122>(x);
  x += dpp_f<0x121>(x);
  return x;
}

namespace pg8 {
#define PG8_LAS __attribute__((address_space(3)))
typedef unsigned short bf16_t;
typedef short bf16x8 __attribute__((ext_vector_type(8)));
typedef float f32x4 __attribute__((ext_vector_type(4)));
typedef unsigned u32x4 __attribute__((ext_vector_type(4)));
constexpr int BM = 256, BK = 64, HALF = 128, HTB = HALF * BK * 2  , STAGE_BYTES = 8 * HTB, NXCD = 8, WGM = 8;

__host__ __device__ __forceinline__ int lds_byte(int r, int c) { const int st = (r >> 4) * 2 + (c >> 5), rr = r & 15, cc = c & 31, ob = rr * 64 + cc * 2; return st * 1024 + (ob ^ (((ob >> 9) & 1) << 5)); }
__host__ __device__ __forceinline__ void stage_rc(int b, int& R, int& C) { const int st = b / 1024, sb = b % 1024, swz = sb ^ (((sb >> 9) & 1) << 5); R = (st >> 1) * 16 + swz / 64; C = (st & 1) * 32 + (swz % 64) / 2; }
__host__ __device__ __forceinline__ int perm32(int rho) { const int n = rho >> 4, i = rho & 15; return 8 * (i >> 2) + 4 * n + (i & 3); }

struct Unit { int pm, pn; };
struct Gemm { const bf16_t* A; const bf16_t* Bt; int M, N, K; };

struct StaticOrder {
    int nM, nN, nwg, G, c;
    __host__ __device__ void init(int M, int N, int G_, int c_) { nM = M / BM; nN = N / BM; nwg = nM * nN; G = G_; c = c_; }
    __host__ __device__ bool next(int i, Unit& u) const {
        const long L = (long)i * G + c; if (L >= nwg) return false;
        int wgid = (int)L; { const int q = nwg / NXCD, r = nwg % NXCD, xcd = wgid % NXCD, off = wgid / NXCD; wgid = (xcd < r ? xcd * (q + 1) : r * (q + 1) + (xcd - r) * q) + off; }
        const int nig = WGM * nN, gid = wgid / nig, fm = gid * WGM, gsz = (nM - fm) < WGM ? (nM - fm) : WGM;
        u.pm = fm + ((wgid % nig) % gsz); u.pn = (wgid % nig) / gsz; return true;
    }
    __device__ __forceinline__ void a_ready(const Unit&) const {}
    __device__ __forceinline__ void done(const Unit&) const {}
};
__device__ __forceinline__ unsigned cvt_pk_bf16(float lo, float hi) { unsigned r; asm volatile("v_cvt_pk_bf16_f32 %0, %1, %2" : "=v"(r) : "v"(lo), "v"(hi)); return r; }
template <class Epi, class Sched, bool STAMP = false>
__device__ __forceinline__ void gemm_phase(PG8_LAS unsigned char* lds, const Gemm g, const Sched& S, const Epi& E, unsigned long long* stamps) {
    const int tid = threadIdx.x, wid = __builtin_amdgcn_readfirstlane(tid >> 6), lane = tid & 63, wr = wid >> 2, wc = wid & 3, fr = lane & 15, fq = lane >> 4;
    const int K = g.K, nt = K / BK;
    int ts_lo = 0, ts_hi = 0, nts = 0; const unsigned long long rt_entry = STAMP ? (unsigned long long)wall_clock64() : 0ull;
#define PG8_STAMP() do { if (STAMP && wid == 0 && nts < 64) { const unsigned long long _c = (unsigned long long)clock64(); \
        ts_lo = (lane == nts) ? (int)(unsigned)_c : ts_lo; ts_hi = (lane == nts) ? (int)(unsigned)(_c >> 32) : ts_hi; ++nts; } } while (0)
    PG8_STAMP();
    unsigned voffA[2], voffB[2];
#pragma unroll
    for (int i = 0; i < 2; ++i) { int R, C; stage_rc(tid * 16 + i * 8192, R, C); const int Rb = Epi::PERM ? ((R & ~31) + perm32(R & 31)) : R;
        voffA[i] = (unsigned)(R * K + C) * 2u; voffB[i] = (unsigned)(Rb * K + C) * 2u; }
    const size_t kstep = (size_t)(BK * 2);
    const size_t hstep = (size_t)HALF * K * 2;
    const size_t tstep = 2 * hstep;
    const unsigned ldsw = (unsigned)wid * 1024u;
    const int aoff = lds_byte(wr * 64 + fr, fq * 8), boff = lds_byte(wc * 32 + fr, fq * 8);
#define PG8_SA(b, h) (((b) * 2 + (h)) * HTB)
#define PG8_SB(b, h) ((4 + (b) * 2 + (h)) * HTB)
#define PG8_STAGE(bufoff, gbase, voff) do { _Pragma("unroll") for (int _i = 0; _i < 2; ++_i) \
        __builtin_amdgcn_global_load_lds((const unsigned*)((const char*)(gbase) + (voff)[_i]), (PG8_LAS unsigned*)(lds + (bufoff) + ldsw + _i * 8192), 16, 0, 0); } while (0)
#define PG8_LDA(dst, b, h) do { _Pragma("unroll") for (int m = 0; m < 4; ++m) _Pragma("unroll") for (int k = 0; k < 2; ++k) dst[m][k] = *(const PG8_LAS bf16x8*)(lds + PG8_SA(b, h) + aoff + m * 2048 + k * 1024); } while (0)
#define PG8_LDB(dst, b, h) do { _Pragma("unroll") for (int n = 0; n < 2; ++n) _Pragma("unroll") for (int k = 0; k < 2; ++k) dst[n][k] = *(const PG8_LAS bf16x8*)(lds + PG8_SB(b, h) + boff + n * 2048 + k * 1024); } while (0)
#define PG8_MMA(ai, bj, At, Bt) do { __builtin_amdgcn_s_setprio(1); _Pragma("unroll") for (int m = 0; m < 4; ++m) _Pragma("unroll") for (int n = 0; n < 2; ++n) _Pragma("unroll") for (int k = 0; k < 2; ++k) \
        acc[ai][bj][m][n] = __builtin_amdgcn_mfma_f32_16x16x32_bf16(Bt[n][k], At[m][k], acc[ai][bj][m][n], 0, 0, 0); __builtin_amdgcn_s_setprio(0); } while (0)
#define PG8_WAIT_V(n) asm volatile("s_waitcnt vmcnt(" #n ")" ::: "memory")
#define PG8_WAIT_L(n) asm volatile("s_waitcnt lgkmcnt(" #n ")" ::: "memory")
#define PG8_BAR __builtin_amdgcn_s_barrier()
#define PG8_SCHED __builtin_amdgcn_sched_barrier(0)
    Unit cur, nxt; int ui = 0;
    if (!S.next(0, cur)) return;
    f32x4 acc[2][2][4][2];
#pragma unroll
    for (int a = 0; a < 2; ++a)
#pragma unroll
        for (int b = 0; b < 2; ++b)
#pragma unroll
            for (int m = 0; m < 4; ++m)
#pragma unroll
                for (int n = 0; n < 2; ++n) acc[a][b][m][n] = (f32x4){0.f, 0.f, 0.f, 0.f};
    bf16x8 At[4][2], B0[2][2], B1[2][2];
    const char* cA = (const char*)g.A + (size_t)cur.pm * tstep; const char* cB = (const char*)g.Bt + (size_t)cur.pn * tstep;
    S.a_ready(cur);
    PG8_STAGE(PG8_SB(0, 0), cB, voffB); PG8_STAGE(PG8_SA(0, 0), cA, voffA); PG8_STAGE(PG8_SB(0, 1), cB + hstep, voffB); PG8_STAGE(PG8_SA(0, 1), cA + hstep, voffA);
    if (wr == 1) PG8_BAR;
    PG8_WAIT_V(4); PG8_BAR;
    PG8_STAGE(PG8_SB(1, 0), cB + kstep, voffB); PG8_STAGE(PG8_SA(1, 0), cA + kstep, voffA); PG8_STAGE(PG8_SB(1, 1), cB + hstep + kstep, voffB);
    PG8_WAIT_V(6); PG8_BAR;
    PG8_STAMP();
    for (;;) {
        const bool has_next = S.next(ui + 1, nxt);
        const char* nA = has_next ? (const char*)g.A + (size_t)nxt.pm * tstep : cA; const char* nB = has_next ? (const char*)g.Bt + (size_t)nxt.pn * tstep : cB;
        for (int t = 0; t < nt; t += 2) {
            const bool last = (t == nt - 2);
            const char* a1 = cA + (size_t)(t + 1) * kstep;
            const char* a2 = last ? nA : cA + (size_t)(t + 2) * kstep; const char* b2 = last ? nB : cB + (size_t)(t + 2) * kstep;
            const char* a3 = a2 + kstep; const char* b3 = b2 + kstep;
            if (last && has_next) S.a_ready(nxt);
            PG8_LDB(B0, 0, 0); PG8_SCHED; PG8_LDA(At, 0, 0); PG8_STAGE(PG8_SA(1, 1), a1 + hstep, voffA);
            PG8_WAIT_L(8); PG8_BAR; PG8_WAIT_L(0); PG8_MMA(0, 0, At, B0); PG8_BAR; PG8_SCHED;
            PG8_LDB(B1, 0, 1); PG8_STAGE(PG8_SB(0, 0), b2, voffB);
            PG8_BAR; PG8_WAIT_L(0); PG8_MMA(0, 1, At, B1); PG8_BAR;
            PG8_LDA(At, 0, 1); PG8_STAGE(PG8_SA(0, 0), a2, voffA);
            PG8_BAR; PG8_WAIT_L(0); PG8_MMA(1, 0, At, B0); PG8_BAR; PG8_SCHED;
            PG8_STAGE(PG8_SB(0, 1), b2 + hstep, voffB);
            PG8_WAIT_V(6); PG8_BAR; PG8_MMA(1, 1, At, B1); PG8_BAR;
            PG8_LDB(B0, 1, 0); PG8_SCHED; PG8_LDA(At, 1, 0); PG8_STAGE(PG8_SA(0, 1), a2 + hstep, voffA);
            PG8_WAIT_L(8); PG8_BAR; PG8_WAIT_L(0); PG8_MMA(0, 0, At, B0); PG8_BAR; PG8_SCHED;
            PG8_LDB(B1, 1, 1); PG8_STAGE(PG8_SB(1, 0), b3, voffB);
            PG8_BAR; PG8_WAIT_L(0); PG8_MMA(0, 1, At, B1); PG8_BAR;
            PG8_LDA(At, 1, 1); PG8_STAGE(PG8_SA(1, 0), a3, voffA);
            PG8_BAR; PG8_WAIT_L(0); PG8_MMA(1, 0, At, B0); PG8_BAR; PG8_SCHED;
            PG8_STAGE(PG8_SB(1, 1), b3 + hstep, voffB);
            PG8_WAIT_V(6); PG8_BAR; PG8_MMA(1, 1, At, B1); PG8_BAR;
        }
        PG8_STAMP();
        if constexpr (!Epi::AFTER_DRAIN) { E(acc, cur, wr, wc, fr, fq); S.done(cur); }
        PG8_STAMP();
        if (!has_next) break;
#pragma unroll
        for (int a = 0; a < 2; ++a)
#pragma unroll
            for (int b = 0; b < 2; ++b)
#pragma unroll
                for (int m = 0; m < 4; ++m)
#pragma unroll
                    for (int n = 0; n < 2; ++n) acc[a][b][m][n] = (f32x4){0.f, 0.f, 0.f, 0.f};
        cur = nxt; cA = nA; cB = nB; ++ui;
    }
    PG8_WAIT_V(0);
    if (wr == 0) PG8_BAR;
    PG8_BAR;
    if constexpr (Epi::AFTER_DRAIN) { E.fused(acc, cur, wr, wc, fr, fq, lds, wid, lane); S.done(cur); }
    PG8_STAMP();
    if (STAMP && wid == 0) { stamps[lane] = lane < nts ? (((unsigned long long)(unsigned)ts_hi << 32) | (unsigned)ts_lo) : 0ull;
        if (lane == 62) stamps[62] = rt_entry; if (lane == 63) stamps[63] = (unsigned long long)wall_clock64(); }
#undef PG8_STAMP
#undef PG8_SA
#undef PG8_SB
#undef PG8_STAGE
#undef PG8_LDA
#undef PG8_LDB
#undef PG8_MMA
#undef PG8_WAIT_V
#undef PG8_WAIT_L
#undef PG8_BAR
#undef PG8_SCHED
}
}

namespace pg8 {
struct EpiProj {
    static constexpr bool PERM = true, AFTER_DRAIN = false;
    bf16_t* O; int ldc; int ncols;
    __device__ __forceinline__ void operator()(const f32x4 (&acc)[2][2][4][2], const Unit& u, int wr, int wc, int fr, int fq) const {
        const int row0 = u.pm * BM + wr * 64 + fr; const int col0 = u.pn * BM + wc * 32 + 8 * fq;
#pragma unroll
        for (int ai = 0; ai < 2; ++ai)
#pragma unroll
            for (int m = 0; m < 4; ++m) { bf16_t* rowp = O + (size_t)(row0 + ai * HALF + m * 16) * ldc + col0;
#pragma unroll
                for (int bj = 0; bj < 2; ++bj) { const f32x4 v0 = acc[ai][bj][m][0], v1 = acc[ai][bj][m][1];
                    u32x4 w; w.x = cvt_pk_bf16(v0[0], v0[1]); w.y = cvt_pk_bf16(v0[2], v0[3]); w.z = cvt_pk_bf16(v1[0], v1[1]); w.w = cvt_pk_bf16(v1[2], v1[3]);
                    if (col0 + bj * HALF < ncols) *(u32x4*)(rowp + bj * HALF) = w; } }
    }
};
struct EpiU {
    static constexpr bool PERM = true, AFTER_DRAIN = false;
    void* O; int ldc; int ncols; int f32out;
    __device__ __forceinline__ void operator()(const f32x4 (&acc)[2][2][4][2], const Unit& u, int wr, int wc, int fr, int fq) const {
        const int row0 = u.pm * BM + wr * 64 + fr; const int col0 = u.pn * BM + wc * 32 + 8 * fq;
        if (f32out) {
#pragma unroll
            for (int ai = 0; ai < 2; ++ai)
#pragma unroll
                for (int m = 0; m < 4; ++m) { float* rowp = (float*)O + (size_t)(row0 + ai * HALF + m * 16) * ldc + col0;
#pragma unroll
                    for (int bj = 0; bj < 2; ++bj) { *(f32x4*)(rowp + bj * HALF) = acc[ai][bj][m][0]; *(f32x4*)(rowp + bj * HALF + 4) = acc[ai][bj][m][1]; } }
        } else {
#pragma unroll
            for (int ai = 0; ai < 2; ++ai)
#pragma unroll
                for (int m = 0; m < 4; ++m) { bf16_t* rowp = (bf16_t*)O + (size_t)(row0 + ai * HALF + m * 16) * ldc + col0;
#pragma unroll
                    for (int bj = 0; bj < 2; ++bj) { const f32x4 v0 = acc[ai][bj][m][0], v1 = acc[ai][bj][m][1];
                        u32x4 w; w.x = cvt_pk_bf16(v0[0], v0[1]); w.y = cvt_pk_bf16(v0[2], v0[3]); w.z = cvt_pk_bf16(v1[0], v1[1]); w.w = cvt_pk_bf16(v1[2], v1[3]);
                        if (col0 + bj * HALF < ncols) *(u32x4*)(rowp + bj * HALF) = w; } }
        }
    }
};
}

__device__ void phase_mod_item(const Params& p, int it, unsigned char* smem) {
  float* red = (float*)smem;
  const int tid = opaque_tid(), tx = tid & 31, ty = tid >> 5;
  float* mod = (float*)(p.ws + OFF_MOD);
  it = opq(it);
  {
    int l = it / 96;
    int j = (it % 96) * 32 + tx;
    const float* W = p.ada_w + (size_t)l * 1024 * 3072;
    float acc = 0.f;
    for (int i = 0; i < 128; ++i) {
      int k = ty * 128 + i;
      float cv = p.c[k];
      acc += silu(cv) * W[(size_t)k * 3072 + j];
    }
    red[ty * 32 + tx] = acc;
    __syncthreads();
    if (ty == 0) {
      float s = 0.f;
      for (int g = 0; g < 8; ++g) s += red[g * 32 + tx];
      mod[l * 3072 + j] = s + p.ada_b[l * 3072 + j];
    }
    __syncthreads();
  }
}

__device__ __forceinline__ float wall_src(const Params& p, int l, int k, int n) {
  size_t lk = (size_t)l * 1024 + k;
  if (n < 3072) return p.w_in[lk * 3072 + n];
  if (n < 3136) return (1.f - p.mu_w[lk]) * p.w1[lk * 64 + (n - 3072)];
  if (n < 3200) return p.mu_w[lk] * p.w1[lk * 64 + (n - 3136)];
  if (n < 3264) return (1.f - p.mu_a[lk]) * p.a1[lk * 64 + (n - 3200)];
  if (n < 3328) return p.mu_a[lk] * p.a1[lk * 64 + (n - 3264)];
  if (n < 3344) return p.gk1[lk * 16 + (n - 3328)];
  return 0.f;
}

__device__ void phase_wconv_item(const Params& p, int it, unsigned char* smem) {
  float* tile = (float*)smem;
  const int tid = opaque_tid();
  u16* WALL = (u16*)(p.ws + OFF_WALL);
  u16* WOUT = (u16*)(p.ws + OFF_WOUT);
  it = opq(it);
  {
    bool isout = it >= 3456;
    int l, nt, kt;
    if (!isout) { l = it / 864; int r = it % 864; nt = r >> 4; kt = r & 15; }
    else { int r = it - 3456; l = r >> 8; r &= 255; nt = r >> 4; kt = r & 15; }
    int tx = tid & 63, ty = tid >> 6;
#pragma unroll 4
    for (int i = 0; i < 16; ++i) {
      int kl = ty + 4 * i;
      int k = kt * 64 + kl, n = nt * 64 + tx;
      float v = isout ? p.w_out[((size_t)l * 1024 + k) * 1024 + n] : wall_src(p, l, k, n);
      tile[kl * 65 + tx] = v;
    }
    __syncthreads();
    int nl = tid >> 2, kq = tid & 3;
    unsigned w[8];
#pragma unroll
    for (int j = 0; j < 8; ++j) w[j] = pack2(tile[(kq * 16 + 2 * j) * 65 + nl], tile[(kq * 16 + 2 * j + 1) * 65 + nl]);
    u16* dst = (isout ? WOUT + ((size_t)l * 1024 + nt * 64 + nl) * 1024 : WALL + ((size_t)l * NALL + nt * 64 + nl) * 1024) + kt * 64 + kq * 16;
    ((uint4*)dst)[0] = make_uint4(w[0], w[1], w[2], w[3]);
    ((uint4*)dst)[1] = make_uint4(w[4], w[5], w[6], w[7]);
    __syncthreads();
  }
}

__device__ __forceinline__ void write_h(const Params& p, int l, int row, int lane, const float4* v, float ss) {
  const float* mod = (const float*)(p.ws + OFF_MOD) + l * 3072;
  u16* H = (u16*)(p.ws + OFF_H);
  float rs = rsqrtf(ss * (1.f / 1024.f) + 1e-6f);
#pragma unroll
  for (int i = 0; i < 4; ++i) {
    int col = (lane + 64 * i) * 4;
    float4 g = *(const float4*)(p.norm_pre + l * 1024 + col);
    float4 sh = *(const float4*)(mod + col);
    float4 sc = *(const float4*)(mod + 1024 + col);
    float h0 = v[i].x * rs * g.x * (1.f + sc.x) + sh.x;
    float h1 = v[i].y * rs * g.y * (1.f + sc.y) + sh.y;
    float h2 = v[i].z * rs * g.z * (1.f + sc.z) + sh.z;
    float h3 = v[i].w * rs * g.w * (1.f + sc.w) + sh.w;
    *(uint2*)(H + (size_t)row * 1024 + col) = make_uint2(pack2(h0, h1), pack2(h2, h3));
  }
}

__device__ void phase_h0(const Params& p) {
  const int tid = opaque_tid512(); const int wave = tid >> 6, lane = tid & 63;
  for (int row = blockIdx.x * 8 + wave; row < T_; row += gridDim.x * 8) {
    const float4* xr = (const float4*)(p.x + (size_t)row * 1024);
    float4 v[4];
    float ss = 0.f;
#pragma unroll
    for (int i = 0; i < 4; ++i) {
      v[i] = xr[lane + 64 * i];
      ss += v[i].x * v[i].x + v[i].y * v[i].y + v[i].z * v[i].z + v[i].w * v[i].w;
    }
    ss = wave_sum(ss);
    write_h(p, 0, row, lane, v, ss);
  }
}

__device__ void phase_post(const Params& p, int l) {
  l = opq(l);
  const int tid = opaque_tid512(); const int wave = tid >> 6, lane = tid & 63;
  const float* Y = (const float*)(p.ws + OFF_PROJ);
  const float* mod = (const float*)(p.ws + OFF_MOD) + l * 3072;
  const float* xold = (l == 0) ? p.x : p.out;
  for (int row = blockIdx.x * 8 + wave; row < T_; row += gridDim.x * 8) {
    const float4* yr = (const float4*)(Y + (size_t)row * 1024);
    const float4* xr = (const float4*)(xold + (size_t)row * 1024);
    float4 y[4], v[4];
    float ss = 0.f;
#pragma unroll
    for (int i = 0; i < 4; ++i) {
      y[i] = yr[lane + 64 * i];
      v[i] = xr[lane + 64 * i];
      ss += y[i].x * y[i].x + y[i].y * y[i].y + y[i].z * y[i].z + y[i].w * y[i].w;
    }
    ss = wave_sum(ss);
    float rs = rsqrtf(ss * (1.f / 1024.f) + 1e-6f);
    float s2 = 0.f;
#pragma unroll
    for (int i = 0; i < 4; ++i) {
      int col = (lane + 64 * i) * 4;
      float4 g = *(const float4*)(p.norm_post + l * 1024 + col);
      float4 gt = *(const float4*)(mod + 2048 + col);
      v[i].x += gt.x * (y[i].x * rs * g.x);
      v[i].y += gt.y * (y[i].y * rs * g.y);
      v[i].z += gt.z * (y[i].z * rs * g.z);
      v[i].w += gt.w * (y[i].w * rs * g.w);
      *(float4*)(p.out + (size_t)row * 1024 + col) = v[i];
      s2 += v[i].x * v[i].x + v[i].y * v[i].y + v[i].z * v[i].z + v[i].w * v[i].w;
    }
    if (l < 3) {
      s2 = wave_sum(s2);
      write_h(p, l + 1, row, lane, v, s2);
    }
  }
}

__device__ void attn_item(const Params& p, int l, int item, unsigned char* smem) {
  l = opq(l); item = opq(item);
  u16* Vt = (u16*)smem;
  const u16* PROJ = (const u16*)(p.ws + OFF_PROJ);
  u16* MIX = (u16*)(p.ws + OFF_MIX);
  const int tid = opaque_tid(), w = tid >> 6, lane = tid & 63, l31 = lane & 31, hf = lane >> 5;
  const int qb = item >> 3, head = item & 7, kvh = head >> 2;
  const int kpos0 = (qb - 1) * 128;
  {
    int kp = kpos0 + tid;
    if (kp < 0) kp = 0;
    const uint4* src = (const uint4*)(PROJ + (size_t)kp * NALL + 640 + kvh * 64);
#pragma unroll
    for (int c8 = 0; c8 < 8; ++c8) {
      uint4 v = src[c8];
      int d = c8 * 8;
      Vt[(d + 0) * 264 + tid] = (u16)(v.x & 0xffff);
      Vt[(d + 1) * 264 + tid] = (u16)(v.x >> 16);
      Vt[(d + 2) * 264 + tid] = (u16)(v.y & 0xffff);
      Vt[(d + 3) * 264 + tid] = (u16)(v.y >> 16);
      Vt[(d + 4) * 264 + tid] = (u16)(v.z & 0xffff);
      Vt[(d + 5) * 264 + tid] = (u16)(v.z >> 16);
      Vt[(d + 6) * 264 + tid] = (u16)(v.w & 0xffff);
      Vt[(d + 7) * 264 + tid] = (u16)(v.w >> 16);
    }
  }
  __syncthreads();
  const int tq = qb * 128 + 32 * w + l31;
  bf16x8 qf[4];
  {
    const u16* qp = PROJ + (size_t)tq * NALL + head * 64 + 8 * hf;
#pragma unroll
    for (int s = 0; s < 4; ++s) qf[s] = *(const bf16x8*)(qp + 16 * s);
  }
  const float slope = exp2f(-(float)(head + 1));
  const float sink = p.sinks[l * 8 + head];
  const int rq = 32 * w + l31;
  float mrun = -1e30f, lsum = 0.f;
  f32x16 o0, o1;
#pragma unroll
  for (int r = 0; r < 16; ++r) { o0[r] = 0.f; o1[r] = 0.f; }
#pragma unroll 1
  for (int i = 0; i < 5; ++i) {
    int kp = kpos0 + 32 * w + 32 * i + l31;
    if (kp < 0) kp = 0;
    const u16* kptr = PROJ + (size_t)kp * NALL + 512 + kvh * 64 + 8 * hf;
    f32x16 a;
#pragma unroll
    for (int r = 0; r < 16; ++r) a[r] = 0.f;
#pragma unroll
    for (int s = 0; s < 4; ++s) {
      bf16x8 kf = *(const bf16x8*)(kptr + 16 * s);
      a = __builtin_amdgcn_mfma_f32_32x32x16_bf16(kf, qf[s], a, 0, 0, 0);
    }
    float tmax = -1e30f;
#pragma unroll
    for (int r = 0; r < 16; ++r) {
      int kj = 32 * w + 32 * i + (r & 3) + 8 * (r >> 2) + 4 * hf;
      int dist = 128 + rq - kj;
      bool valid = (dist >= 0) && (dist < 128) && (kpos0 + kj >= 0);
      float sv = a[r] * 0.125f - slope * (float)dist;
      sv = valid ? sv : -1e30f;
      a[r] = sv;
      tmax = fmaxf(tmax, sv);
    }
    tmax = fmaxf(tmax, __shfl_xor(tmax, 32));
    const float mnew = fmaxf(mrun, tmax);
    const float alpha = __expf(mrun - mnew);
    float psum = 0.f;
#pragma unroll
    for (int r = 0; r < 16; ++r) {
      float e = (a[r] > -1e29f) ? __expf(a[r] - mnew) : 0.f;
      a[r] = e;
      psum += e;
    }
    lsum = lsum * alpha + psum;
    mrun = mnew;
#pragma unroll
    for (int r = 0; r < 16; ++r) { o0[r] *= alpha; o1[r] *= alpha; }
#pragma unroll
    for (int u = 0; u < 2; ++u) {
      bf16x8 pf;
#pragma unroll
      for (int j = 0; j < 8; ++j) pf[j] = (short)f2bf(a[8 * u + j]);
      const int kb = 32 * w + 32 * i + 16 * u + 4 * hf;
      const u16* v0 = Vt + l31 * 264 + kb;
      const u16* v1 = Vt + (32 + l31) * 264 + kb;
      uint2 a0 = *(const uint2*)(v0), a1 = *(const uint2*)(v0 + 8);
      uint2 b0 = *(const uint2*)(v1), b1 = *(const uint2*)(v1 + 8);
      uint4 A0 = make_uint4(a0.x, a0.y, a1.x, a1.y), A1 = make_uint4(b0.x, b0.y, b1.x, b1.y);
      o0 = __builtin_amdgcn_mfma_f32_32x32x16_bf16(__builtin_bit_cast(bf16x8, A0), pf, o0, 0, 0, 0);
      o1 = __builtin_amdgcn_mfma_f32_32x32x16_bf16(__builtin_bit_cast(bf16x8, A1), pf, o1, 0, 0, 0);
    }
  }
  {
    const float mf = fmaxf(mrun, sink);
    const float scl = __expf(mrun - mf);
    const float ltot = (lsum + __shfl_xor(lsum, 32)) * scl + __expf(sink - mf);
    const float fin = scl / ltot;
#pragma unroll
    for (int r = 0; r < 16; ++r) { o0[r] *= fin; o1[r] *= fin; }
  }
  const u16* gp = PROJ + (size_t)tq * NALL + 768 + head * 64;
  u16* op = MIX + (size_t)tq * 1024 + head * 64;
#pragma unroll
  for (int g = 0; g < 4; ++g) {
    int d0 = 8 * g + 4 * hf;
    uint2 gg = *(const uint2*)(gp + d0);
    float r0 = o0[4 * g + 0] * silu(bflo(gg.x)), r1 = o0[4 * g + 1] * silu(bfhi(gg.x));
    float r2 = o0[4 * g + 2] * silu(bflo(gg.y)), r3 = o0[4 * g + 3] * silu(bfhi(gg.y));
    *(uint2*)(op + d0) = make_uint2(pack2(r0, r1), pack2(r2, r3));
    uint2 g2 = *(const uint2*)(gp + 32 + d0);
    r0 = o1[4 * g + 0] * silu(bflo(g2.x)); r1 = o1[4 * g + 1] * silu(bfhi(g2.x));
    r2 = o1[4 * g + 2] * silu(bflo(g2.y)); r3 = o1[4 * g + 3] * silu(bfhi(g2.y));
    *(uint2*)(op + 32 + d0) = make_uint2(pack2(r0, r1), pack2(r2, r3));
  }
  __syncthreads();
}

__device__ void rwkv_prep_item(const Params& p, int l, int item, unsigned char* smem) {
  l = opq(l); item = opq(item);
  float* lw = (float*)smem;
  float* la = lw + 1024;
  const u16* PROJ = (const u16*)(p.ws + OFF_PROJ);
  const int tid = opaque_tid(), c = tid, head = tid >> 6, lane = tid & 63;
  const int t0 = item * 16;
#pragma unroll
  for (int i = 0; i < 8; ++i) {
    int idx = tid + 256 * i;
    int which = idx >> 10, tt = (idx >> 6) & 15, j = idx & 63;
    int t = t0 + tt;
    const u16* pr = PROJ + (size_t)t * NALL;
    float cur = bf2f(pr[(which ? 3200 : 3072) + j]);
    float prev = (t > 0) ? bf2f((pr - NALL)[(which ? 3264 : 3136) + j]) : 0.f;
    float s = cur + prev;
    if (!which) s = tanhf(s);
    (which ? la : lw)[tt * 64 + j] = s;
  }
  __syncthreads();
  float accw[16], acca[16];
#pragma unroll
  for (int tt = 0; tt < 16; ++tt) { accw[tt] = 0.f; acca[tt] = 0.f; }
  const float* w2 = p.w2 + (size_t)l * 64 * 256 + c;
  const float* a2 = p.a2 + (size_t)l * 64 * 256 + c;
  for (int j4 = 0; j4 < 16; ++j4) {
    float w20 = w2[(4 * j4 + 0) * 256], w21 = w2[(4 * j4 + 1) * 256], w22 = w2[(4 * j4 + 2) * 256], w23 = w2[(4 * j4 + 3) * 256];
    float a20 = a2[(4 * j4 + 0) * 256], a21 = a2[(4 * j4 + 1) * 256], a22 = a2[(4 * j4 + 2) * 256], a23 = a2[(4 * j4 + 3) * 256];
#pragma unroll
    for (int tt = 0; tt < 16; ++tt) {
      float4 lv = *(const float4*)(lw + tt * 64 + j4 * 4);
      float4 av = *(const float4*)(la + tt * 64 + j4 * 4);
      accw[tt] += lv.x * w20 + lv.y * w21 + lv.z * w22 + lv.w * w23;
      acca[tt] += av.x * a20 + av.y * a21 + av.z * a22 + av.w * a23;
    }
  }
  const float mur = p.mu_rkv[l * 768 + c], muk = p.mu_rkv[l * 768 + 256 + c], muv = p.mu_rkv[l * 768 + 512 + c];
  const float w0 = p.w0[l * 256 + c], a0 = p.a0[l * 256 + c], kkw = p.k_k[l * 256 + c], kaw = p.k_a[l * 256 + c], rkw = p.r_k[l * 256 + c];
  float* RWW = (float*)(p.ws + OFF_RWW);
  float* RWKK = (float*)(p.ws + OFF_RWKK);
  u16* RB = (u16*)(p.ws + OFF_RWB);
  float* BON = (float*)(p.ws + OFF_BONUS);
#pragma unroll
  for (int tt = 0; tt < 16; ++tt) {
    int t = t0 + tt;
    const u16* pr = PROJ + (size_t)t * NALL;
    float rc = bf2f(pr[1280 + c]), kc = bf2f(pr[1536 + c]), vc = bf2f(pr[1792 + c]);
    float rp = 0.f, kp = 0.f, vp = 0.f;
    if (t > 0) { rp = bf2f((pr - NALL)[1280 + c]); kp = bf2f((pr - NALL)[1536 + c]); vp = bf2f((pr - NALL)[1792 + c]); }
    float r = rc + (rp - rc) * mur, k = kc + (kp - kc) * muk, v = vc + (vp - vc) * muv;
    float wpre = w0 + accw[tt];
    float wl = -softplusf_(-wpre) - 0.5f;
    float decay = __expf(-__expf(wl));
    float a = sigmoidf_(a0 + acca[tt]);
    float kkc = k * kkw;
    float n2 = wave_sum(kkc * kkc);
    float kk = kkc / fmaxf(sqrtf(n2), 1e-12f);
    float kmod = k * (1.f + (a - 1.f) * kaw);
    float bb = kk * a;
    float bonus = wave_sum(r * kmod * rkw);
    size_t o = (size_t)t * 256 + c;
    RWW[o] = decay;
    RWKK[o] = kk;
    RB[o] = f2bf(r);
    RB[(size_t)T_ * 256 + o] = f2bf(kmod);
    RB[(size_t)2 * T_ * 256 + o] = f2bf(v);
    RB[(size_t)3 * T_ * 256 + o] = f2bf(bb);
    if (lane == 0) BON[t * 4 + head] = bonus;
  }
  __syncthreads();
}

__device__ __forceinline__ void gla_b(const Params& p, int l, int chunk, int head, float* tot, float* bl) {
  const u16* PROJ = (const u16*)(p.ws + OFF_PROJ);
  const int tid = opaque_tid(), d = tid & 31, ig = tid >> 5;
  float g2[16];
#pragma unroll
  for (int m = 0; m < 16; ++m) g2[m] = p.gk2[(size_t)l * 16 * 128 + m * 128 + head * 32 + d];
  const float bias = p.gk_b[l * 128 + head * 32 + d];
  float run = 0.f;
#pragma unroll
  for (int ii = 0; ii < 8; ++ii) {
    int t = chunk * 64 + ig * 8 + ii;
    const uint4* lp = (const uint4*)(PROJ + (size_t)t * NALL + 3328);
    uint4 u0 = lp[0], u1 = lp[1];
    float z = bias;
    z += bflo(u0.x) * g2[0] + bfhi(u0.x) * g2[1] + bflo(u0.y) * g2[2] + bfhi(u0.y) * g2[3];
    z += bflo(u0.z) * g2[4] + bfhi(u0.z) * g2[5] + bflo(u0.w) * g2[6] + bfhi(u0.w) * g2[7];
    z += bflo(u1.x) * g2[8] + bfhi(u1.x) * g2[9] + bflo(u1.y) * g2[10] + bfhi(u1.y) * g2[11];
    z += bflo(u1.z) * g2[12] + bfhi(u1.z) * g2[13] + bflo(u1.w) * g2[14] + bfhi(u1.w) * g2[15];
    float g = (fminf(z, 0.f) - log1pf(__expf(-fabsf(z)))) * (1.f / 16.f);
    run += g;
    bl[ii] = run;
  }
  tot[ig * 32 + d] = run;
  __syncthreads();
  float off = 0.f;
#pragma unroll
  for (int g = 0; g < 8; ++g) off += (g < ig) ? tot[g * 32 + d] : 0.f;
#pragma unroll
  for (int ii = 0; ii < 8; ++ii) bl[ii] += off;
}

__device__ void gla_local_item(const Params& p, int l, int item, unsigned char* smem) {
  l = opq(l); item = opq(item);
  float* tot = (float*)smem;
  float* Kp = tot + 256;
  float* Vs = Kp + 2048;
  const u16* PROJ = (const u16*)(p.ws + OFF_PROJ);
  const int tid = opaque_tid(), d = tid & 31, ig = tid >> 5;
  const int chunk = item >> 2, head = item & 3;
  float bl[8];
  gla_b(p, l, chunk, head, tot, bl);
  float blast = 0.f;
#pragma unroll
  for (int g = 0; g < 8; ++g) blast += tot[g * 32 + d];
#pragma unroll
  for (int ii = 0; ii < 8; ++ii) {
    int i = ig * 8 + ii;
    int t = chunk * 64 + i;
    float k = bf2f(PROJ[(size_t)t * NALL + 2432 + head * 32 + d]);
    Kp[i * 32 + d] = k * __expf(blast - bl[ii]);
  }
#pragma unroll
  for (int r = 0; r < 16; ++r) {
    int idx = tid + 256 * r;
    int i = idx >> 6, v = idx & 63;
    Vs[idx] = bf2f(PROJ[(size_t)(chunk * 64 + i) * NALL + 2560 + head * 64 + v]);
  }
  __syncthreads();
  const int v = tid & 63, dg = tid >> 6;
  float acc[8];
#pragma unroll
  for (int q = 0; q < 8; ++q) acc[q] = 0.f;
  for (int i = 0; i < 64; ++i) {
    float vv = Vs[i * 64 + v];
    float4 k0 = *(const float4*)(Kp + i * 32 + dg * 8), k1 = *(const float4*)(Kp + i * 32 + dg * 8 + 4);
    acc[0] += k0.x * vv; acc[1] += k0.y * vv; acc[2] += k0.z * vv; acc[3] += k0.w * vv;
    acc[4] += k1.x * vv; acc[5] += k1.y * vv; acc[6] += k1.z * vv; acc[7] += k1.w * vv;
  }
  float* GS = (float*)(p.ws + OFF_GLAS);
  float* GD = (float*)(p.ws + OFF_GLAD);
#pragma unroll
  for (int q = 0; q < 8; ++q) GS[((size_t)(chunk * 4 + head) * 32 + dg * 8 + q) * 64 + v] = acc[q];
  if (tid < 32) GD[(chunk * 4 + head) * 32 + tid] = __expf(blast);
  __syncthreads();
}

__device__ void gla_state_block(const Params& p, int eb, unsigned char* dsm_) {
  float* comp = (float*)dsm_;
  float* GS = (float*)(p.ws + OFF_GLAS);
  const float* GD = (const float*)(p.ws + OFF_GLAD);
  eb = opq(eb);
  const int tid = opaque_tid512();
  const int ei = tid & 31, g = tid >> 5;
  const int e = eb * 32 + ei;
  const int head = e >> 11, d = (e >> 6) & 31, v = e & 63;
  float ds[16], dc[16];
#pragma unroll
  for (int i = 0; i < 16; ++i) {
    const int c = g * 16 + i;
    ds[i] = GS[((size_t)(c * 4 + head) * 32 + d) * 64 + v];
    dc[i] = GD[(c * 4 + head) * 32 + d];
  }
  float S = 0.f, P = 1.f;
#pragma unroll
  for (int i = 0; i < 16; ++i) { S = dc[i] * S + ds[i]; P *= dc[i]; }
  comp[(g * 32 + ei) * 2] = P;
  comp[(g * 32 + ei) * 2 + 1] = S;
  __syncthreads();
  float G = 0.f;
  for (int gg = 0; gg < g; ++gg) G = comp[(gg * 32 + ei) * 2] * G + comp[(gg * 32 + ei) * 2 + 1];
#pragma unroll
  for (int i = 0; i < 16; ++i) {
    const int c = g * 16 + i;
    GS[((size_t)(c * 4 + head) * 32 + d) * 64 + v] = G;
    G = dc[i] * G + ds[i];
  }
  __syncthreads();
}

__device__ void gla_out_item(const Params& p, int l, int item, unsigned char* smem) {
  l = opq(l); item = opq(item);
  float* tot = (float*)smem;
  float* qt = tot + 256;
  float* kt = qt + 2112;
  float* Vs = kt + 2112;
  float* Am = Vs + 4096;
  float* Ss = Am + 4160;
  const u16* PROJ = (const u16*)(p.ws + OFF_PROJ);
  u16* MIX = (u16*)(p.ws + OFF_MIX);
  const float* GS = (const float*)(p.ws + OFF_GLAS);
  const int tid = opaque_tid();
  const int chunk = item >> 2, head = item & 3;
  {
    const int d = tid & 31, ig = tid >> 5;
    float bl[8];
    gla_b(p, l, chunk, head, tot, bl);
#pragma unroll
    for (int ii = 0; ii < 8; ++ii) {
      int i = ig * 8 + ii;
      int t = chunk * 64 + i;
      float q = bf2f(PROJ[(size_t)t * NALL + 2304 + head * 32 + d]);
      float k = bf2f(PROJ[(size_t)t * NALL + 2432 + head * 32 + d]);
      qt[i * 33 + d] = q * 0.17677669529663687f * __expf(bl[ii]);
      kt[i * 33 + d] = k * __expf(-bl[ii]);
    }
  }
#pragma unroll
  for (int r = 0; r < 16; ++r) {
    int idx = tid + 256 * r;
    int i = idx >> 6, v = idx & 63;
    Vs[idx] = bf2f(PROJ[(size_t)(chunk * 64 + i) * NALL + 2560 + head * 64 + v]);
  }
#pragma unroll
  for (int r = 0; r < 8; ++r) {
    int idx = tid + 256 * r;
    Ss[idx] = GS[(size_t)(chunk * 4 + head) * 2048 + idx];
  }
  __syncthreads();
  const int j = tid & 63, ig = tid >> 6;
  {
    float acc[16];
#pragma unroll
    for (int ii = 0; ii < 16; ++ii) acc[ii] = 0.f;
    for (int d = 0; d < 32; ++d) {
      float kv = kt[j * 33 + d];
#pragma unroll
      for (int ii = 0; ii < 16; ++ii) acc[ii] += qt[(ig * 16 + ii) * 33 + d] * kv;
    }
#pragma unroll
    for (int ii = 0; ii < 16; ++ii) {
      int i = ig * 16 + ii;
      Am[i * 65 + j] = (j <= i) ? acc[ii] : 0.f;
    }
  }
  __syncthreads();
  {
    const int v = j;
    float acc[16];
#pragma unroll
    for (int ii = 0; ii < 16; ++ii) acc[ii] = 0.f;
    for (int jj = 0; jj < 64; ++jj) {
      float vv = Vs[jj * 64 + v];
#pragma unroll
      for (int ii = 0; ii < 16; ++ii) acc[ii] += Am[(ig * 16 + ii) * 65 + jj] * vv;
    }
    for (int d = 0; d < 32; ++d) {
      float sv = Ss[d * 64 + v];
#pragma unroll
      for (int ii = 0; ii < 16; ++ii) acc[ii] += qt[(ig * 16 + ii) * 33 + d] * sv;
    }
    const float nw = p.gla_nw[l * 64 + v];
#pragma unroll
    for (int ii = 0; ii < 16; ++ii) {
      int t = chunk * 64 + ig * 16 + ii;
      float o = acc[ii];
      float ms = wave_sum(o * o) * (1.f / 64.f);
      float gg = bf2f(PROJ[(size_t)t * NALL + 2816 + head * 64 + v]);
      float r = o * rsqrtf(ms + 1e-5f) * nw * silu(gg);
      MIX[(size_t)t * 1024 + 768 + head * 64 + v] = f2bf(r);
    }
  }
  __syncthreads();
}

typedef float f32x2 __attribute__((ext_vector_type(2)));
__device__ void rwkv_scan_item(const Params& p, int item, unsigned char* dsm_) {
  item = opq(item);
  float* st = (float*)dsm_;
  const int tid = opaque_tid512(), wv = tid >> 6, lane = tid & 63, rl = lane >> 4, kl = lane & 15;
  const int head = item & 3, seg = item >> 2;
  const bool ident = wv >= 4;
  const int R0 = wv * 16 + rl * 4;
  const int v0 = R0 & 63;
  const float* RWW = (const float*)(p.ws + OFF_RWW);
  const float* RWKK = (const float*)(p.ws + OFF_RWKK);
  const u16* RB = (const u16*)(p.ws + OFF_RWB);
  float* PF = (float*)(p.ws + OFF_PROJ);
  float* ZP = (float*)(p.ws + OFF_ZP);
  const int tbase = seg * SL;
  const int half = tid >> 8, ls = (tid & 255) >> 4, lc4 = (tid & 15) * 4;
  f32x2 Sa[4], Sb[4];
#pragma unroll
  for (int j = 0; j < 4; ++j) {
    Sa[j] = (f32x2){0.f, 0.f}; Sb[j] = (f32x2){0.f, 0.f};
    if (ident) {
      const int i = v0 + j;
      if ((i >> 2) == kl) {
        const int e = i & 3;
        Sa[j] = (f32x2){e == 0 ? 1.f : 0.f, e == 1 ? 1.f : 0.f};
        Sb[j] = (f32x2){e == 2 ? 1.f : 0.f, e == 3 ? 1.f : 0.f};
      }
    }
  }
  float4 g0 = make_float4(0.f, 0.f, 0.f, 0.f), g1 = g0;
  uint2 h0 = make_uint2(0u, 0u), h1 = h0, h2 = h0;
  const float* gp0 = (half == 0 ? RWW : RWKK) + (size_t)(tbase + ls) * 256 + head * 64 + lc4;
  const u16* hp = RB + (size_t)(tbase + ls) * 256 + head * 64 + lc4;
#define SCAN_GLOAD(ch) do { const size_t _o = (size_t)(ch) * 16 * 256; g0 = *(const float4*)(gp0 + _o); \
    if (half == 0) { h0 = *(const uint2*)(hp + _o); } \
    else { h0 = *(const uint2*)(hp + (size_t)T_ * 256 + _o); h1 = *(const uint2*)(hp + (size_t)3 * T_ * 256 + _o); h2 = *(const uint2*)(hp + (size_t)2 * T_ * 256 + _o); } } while (0)
#define SCAN_LSTORE(buf) do { float* _b = st + (buf) * 6144 + ls * 64 + lc4; \
    if (half == 0) { *(float4*)(_b) = g0; *(float4*)(_b + 2048) = make_float4(bflo(h0.x), bfhi(h0.x), bflo(h0.y), bfhi(h0.y)); } \
    else { *(float4*)(_b + 1024) = g0; *(float4*)(_b + 3072) = make_float4(bflo(h0.x), bfhi(h0.x), bflo(h0.y), bfhi(h0.y)); \
           *(float4*)(_b + 4096) = make_float4(bflo(h1.x), bfhi(h1.x), bflo(h1.y), bfhi(h1.y)); *(float4*)(_b + 5120) = make_float4(bflo(h2.x), bfhi(h2.x), bflo(h2.y), bfhi(h2.y)); } } while (0)
  (void)g1;
  SCAN_GLOAD(0);
  SCAN_LSTORE(0);
  __syncthreads();
  const int nch = SL / 16;
  float* yout = PF + (size_t)tbase * PROJF + (ident ? 256 : 0) + head * 64 + v0;
  for (int ch = 0; ch < nch; ++ch) {
    const int cur = ch & 1;
    if (ch + 1 < nch) SCAN_GLOAD(ch + 1);
    const float* b = st + cur * 6144;
#pragma unroll 2
    for (int s = 0; s < 16; ++s) {
      const float4 w4 = *(const float4*)(b + s * 64 + kl * 4);
      const float4 kk4 = *(const float4*)(b + 1024 + s * 64 + kl * 4);
      const float4 r4 = *(const float4*)(b + 2048 + s * 64 + kl * 4);
      const float4 k4 = *(const float4*)(b + 3072 + s * 64 + kl * 4);
      const float4 b4 = *(const float4*)(b + 4096 + s * 64 + kl * 4);
      float4 vv = make_float4(0.f, 0.f, 0.f, 0.f);
      if (!ident) vv = *(const float4*)(b + 5120 + s * 64 + v0);
      const f32x2 wa = {w4.x, w4.y}, wb = {w4.z, w4.w}, ka = {kk4.x, kk4.y}, kb = {kk4.z, kk4.w};
      const f32x2 ra = {r4.x, r4.y}, rb = {r4.z, r4.w}, ca = {k4.x, k4.y}, cb = {k4.z, k4.w}, ba = {b4.x, b4.y}, bb = {b4.z, b4.w};
      const float vj[4] = {vv.x, vv.y, vv.z, vv.w};
      float sa[4];
#pragma unroll
      for (int j = 0; j < 4; ++j) { f32x2 t = Sa[j] * ka + Sb[j] * kb; sa[j] = -(t.x + t.y); }
#pragma unroll
      for (int j = 0; j < 4; ++j) sa[j] += dpp_f<0x128>(sa[j]);
#pragma unroll
      for (int j = 0; j < 4; ++j) sa[j] += dpp_f<0x124>(sa[j]);
#pragma unroll
      for (int j = 0; j < 4; ++j) sa[j] += dpp_f<0x122>(sa[j]);
#pragma unroll
      for (int j = 0; j < 4; ++j) sa[j] += dpp_f<0x121>(sa[j]);
      float y[4];
#pragma unroll
      for (int j = 0; j < 4; ++j) {
        const f32x2 s2 = {sa[j], sa[j]}, v2 = {vj[j], vj[j]};
        Sa[j] = Sa[j] * wa + s2 * ba + v2 * ca;
        Sb[j] = Sb[j] * wb + s2 * bb + v2 * cb;
        f32x2 t = Sa[j] * ra + Sb[j] * rb;
        y[j] = t.x + t.y;
      }
#pragma unroll
      for (int j = 0; j < 4; ++j) y[j] += dpp_f<0x128>(y[j]);
#pragma unroll
      for (int j = 0; j < 4; ++j) y[j] += dpp_f<0x124>(y[j]);
#pragma unroll
      for (int j = 0; j < 4; ++j) y[j] += dpp_f<0x122>(y[j]);
#pragma unroll
      for (int j = 0; j < 4; ++j) y[j] += dpp_f<0x121>(y[j]);
      if (kl == 0) *(float4*)(yout + (size_t)(ch * 16 + s) * PROJF) = make_float4(y[0], y[1], y[2], y[3]);
    }
    if (ch + 1 < nch) SCAN_LSTORE(cur ^ 1);
    __syncthreads();
  }
#pragma unroll
  for (int j = 0; j < 4; ++j)
    *(float4*)(ZP + ((size_t)((seg * 4 + head) * 128 + R0 + j)) * 64 + kl * 4) = make_float4(Sa[j].x, Sa[j].y, Sb[j].x, Sb[j].y);
}

__device__ void rwkv_combine(const Params& p, unsigned char* dsm_) {
  float* ring = (float*)dsm_;
  float* ZP = (float*)(p.ws + OFF_ZP);
  const int tid = opaque_tid512(); const int lane = tid & 63;
  const int rowi = blockIdx.x * 8 + (tid >> 6);
  const int head = rowi >> 6, v = rowi & 63;
  float4 pa0, pa1, pa2, pa3, pb0, pb1, pb2, pb3;
  float z0, z1, z2, z3;
#define COMB_ONE(stg_, q, PA, PB, Z) do { const float* base = ZP + (size_t)((((stg_) * 4 + q) * 4 + head) * 128) * 64; \
      PA = ((const float4*)(base + 4096))[tid]; PB = ((const float4*)(base + 4096))[tid + 512]; Z = base[v * 64 + lane]; } while (0)
#define COMB_ISSUE(stg_) do { COMB_ONE(stg_, 0, pa0, pb0, z0); COMB_ONE(stg_, 1, pa1, pb1, z1); COMB_ONE(stg_, 2, pa2, pb2, z2); COMB_ONE(stg_, 3, pa3, pb3, z3); } while (0)
#define COMB_SEG(q, ZC) do { const int seg = stg * 4 + q; \
      ZP[((size_t)((seg * 4 + head) * 128 + v)) * 64 + lane] = s; \
      float ns0 = ZC, ns1 = 0.f; const float* P = buf + q * 4096 + lane; \
      _Pragma("unroll") for (int i = 0; i < 64; i += 2) { \
        float s0 = __builtin_bit_cast(float, __builtin_amdgcn_readlane(__builtin_bit_cast(int, s), i)); \
        float s1 = __builtin_bit_cast(float, __builtin_amdgcn_readlane(__builtin_bit_cast(int, s), i + 1)); \
        ns0 += s0 * P[i * 64]; ns1 += s1 * P[(i + 1) * 64]; } \
      s = ns0 + ns1; } while (0)
  COMB_ISSUE(0);
  float s = 0.f;
#pragma unroll 1
  for (int stg = 0; stg < NSEG / 4; ++stg) {
    float* buf = ring + (stg & 1) * 16384;
    ((float4*)(buf))[tid] = pa0; ((float4*)(buf))[tid + 512] = pb0;
    ((float4*)(buf + 4096))[tid] = pa1; ((float4*)(buf + 4096))[tid + 512] = pb1;
    ((float4*)(buf + 8192))[tid] = pa2; ((float4*)(buf + 8192))[tid + 512] = pb2;
    ((float4*)(buf + 12288))[tid] = pa3; ((float4*)(buf + 12288))[tid + 512] = pb3;
    const float c0 = z0, c1 = z1, c2 = z2, c3 = z3;
    __syncthreads();
    if (stg + 1 < NSEG / 4) COMB_ISSUE(stg + 1);
    COMB_SEG(0, c0); COMB_SEG(1, c1); COMB_SEG(2, c2); COMB_SEG(3, c3);
  }
  __syncthreads();
}

__device__ void rwkv_final_item(const Params& p, int l, int item, unsigned char* smem) {
  l = opq(l); item = opq(item);
  float* Ss = (float*)smem;
  float* rho = Ss + 4160;
  const int tid = opaque_tid(), v = tid & 63, tg = tid >> 6;
  const int tiles = SL / 64;
  const int q = item % tiles, head = (item / tiles) & 3, seg = item / (tiles * 4);
  const int t0 = seg * SL + q * 64;
  const float* ZP = (const float*)(p.ws + OFF_ZP);
  const float* PF = (const float*)(p.ws + OFF_PROJ);
  const u16* PROJ = (const u16*)(p.ws + OFF_PROJ);
  const u16* RBv = (const u16*)(p.ws + OFF_RWB) + (size_t)2 * T_ * 256;
  const float* BON = (const float*)(p.ws + OFF_BONUS);
  u16* MIX = (u16*)(p.ws + OFF_MIX);
#pragma unroll
  for (int r = 0; r < 16; ++r) {
    int idx = tid + 256 * r;
    int row = idx >> 6, col = idx & 63;
    Ss[row * 65 + col] = ZP[((size_t)((seg * 4 + head) * 128 + row)) * 64 + col];
    rho[idx] = PF[(size_t)(t0 + row) * PROJF + 256 + head * 64 + col];
  }
  __syncthreads();
  const int c = head * 64 + v;
  const float lnw = p.ln_w[l * 256 + c], lnb = p.ln_b[l * 256 + c];
#pragma unroll 1
  for (int hh = 0; hh < 2; ++hh) {
    const int tb = tg * 16 + hh * 8;
    float acc[8];
#pragma unroll
    for (int tt = 0; tt < 8; ++tt) acc[tt] = PF[(size_t)(t0 + tb + tt) * PROJF + head * 64 + v];
#pragma unroll 2
    for (int i4 = 0; i4 < 16; ++i4) {
      float s0 = Ss[v * 65 + 4 * i4], s1 = Ss[v * 65 + 4 * i4 + 1], s2 = Ss[v * 65 + 4 * i4 + 2], s3 = Ss[v * 65 + 4 * i4 + 3];
#pragma unroll
      for (int tt = 0; tt < 8; ++tt) {
        float4 rv = *(const float4*)(rho + (tb + tt) * 64 + 4 * i4);
        acc[tt] += s0 * rv.x + s1 * rv.y + s2 * rv.z + s3 * rv.w;
      }
    }
#pragma unroll
    for (int tt = 0; tt < 8; ++tt) {
      int t = t0 + tb + tt;
      float y = acc[tt];
      float mean = wave_sum(y) * (1.f / 64.f);
      float dlt = y - mean;
      float var = wave_sum(dlt * dlt) * (1.f / 64.f);
      float o = dlt * rsqrtf(var + 64e-5f) * lnw + lnb;
      o += BON[t * 4 + head] * bf2f(RBv[(size_t)t * 256 + c]);
      float g = bf2f(PROJ[(size_t)t * NALL + 2048 + c]);
      MIX[(size_t)t * 1024 + 512 + c] = f2bf(o * silu(g));
    }
  }
  __syncthreads();
}

#define LDS_BYTES 131072
#ifndef REP_G1
#define REP_G1 1
#endif
#ifndef REP_G2
#define REP_G2 1
#endif
#ifndef REP_P3
#define REP_P3 1
#endif
#ifndef REP_SCAN
#define REP_SCAN 1
#endif
#ifndef REP_GO
#define REP_GO 1
#endif
#ifndef REP_FIN
#define REP_FIN 1
#endif
#define PAIR_LOOP(N, BODY) for (int _pr = blockIdx.x; _pr < (N) / 2; _pr += gridDim.x) { const int it = 2 * _pr + vb; BODY }
__global__ void __launch_bounds__(512) fwd_megakernel(Params p) {
  cg::grid_group grid = cg::this_grid();
  extern __shared__ __attribute__((aligned(16))) unsigned char dsm[];
  const int vb = __builtin_amdgcn_readfirstlane(threadIdx.x >> 8);
  unsigned char* smem = dsm + vb * 65536;
#ifndef PH
#define PH 0xffff
#endif
  if (PH & 1) PAIR_LOOP(384, phase_mod_item(p, it, smem);)
  if (PH & 2) PAIR_LOOP(4480, phase_wconv_item(p, it, smem);)
  grid.sync();
  if (PH & 4) phase_h0(p);
  grid.sync();
#pragma unroll 1
  for (int hl = 0; hl < 8; ++hl) {
    const int l = hl >> 1;
    const bool second = hl & 1;
    if (PH & 8) {
      pg8::Gemm g; g.M = T_; g.K = 1024;
      pg8::EpiU E; E.O = (void*)(p.ws + OFF_PROJ);
      if (!second) { g.A = (const u16*)(p.ws + OFF_H); g.Bt = (const u16*)(p.ws + OFF_WALL) + (size_t)l * NALL * 1024; g.N = 3584; E.ldc = NALL; E.ncols = NALL; E.f32out = 0; }
      else { g.A = (const u16*)(p.ws + OFF_MIX); g.Bt = (const u16*)(p.ws + OFF_WOUT) + (size_t)l * 1024 * 1024; g.N = 1024; E.ldc = 1024; E.ncols = 1024; E.f32out = 1; }
      pg8::StaticOrder S; S.init(T_, g.N, gridDim.x, blockIdx.x);
      const int nrep = second ? REP_G2 : REP_G1;
#pragma unroll 1
      for (int rep = 0; rep < nrep; ++rep)
      pg8::gemm_phase<pg8::EpiU, pg8::StaticOrder, false>((PG8_LAS unsigned char*)dsm, g, S, E, nullptr);
    }
    grid.sync();
    if (!second) {
#pragma unroll 1
      for (int rep = 0; rep < REP_P3; ++rep)
      PAIR_LOOP(3072,
        if (it < 1024) { if (PH & 16) attn_item(p, l, it, smem); }
        else if (it < 2048) { if (PH & 32) rwkv_prep_item(p, l, it - 1024, smem); }
        else { if (PH & 64) gla_local_item(p, l, it - 2048, smem); }
      )
      grid.sync();
      if (PH & 128) for (int eb = blockIdx.x; eb < 256; eb += gridDim.x) gla_state_block(p, eb, dsm);
#pragma unroll 1
      for (int rep = 0; rep < REP_SCAN; ++rep)
      if (PH & 256) for (int it = blockIdx.x; it < NSEG * 4; it += gridDim.x) rwkv_scan_item(p, it, dsm);
      grid.sync();
      if (blockIdx.x < 32) { if (PH & 512) rwkv_combine(p, dsm); }
#pragma unroll 1
      for (int rep = 0; rep < REP_GO; ++rep)
      if (PH & 1024) PAIR_LOOP(1024, gla_out_item(p, l, it, smem);)
      grid.sync();
#pragma unroll 1
      for (int rep = 0; rep < REP_FIN; ++rep)
      if (PH & 2048) PAIR_LOOP(NSEG * 4 * (SL / 64), rwkv_final_item(p, l, it, smem);)
      grid.sync();
    } else {
      if (PH & 8192) phase_post(p, l);
      if (hl < 7) grid.sync();
    }
  }
}

extern "C" void kernel_launch(void* const* d_in, const int* in_sizes, int n_in, void* d_out, int out_size, void* d_ws, size_t ws_size,
                              hipStream_t stream) {
  static int grid_blocks = 0;
  if (!grid_blocks) {
    int dev = 0, cus = 0, per_cu = 0;
    (void)hipGetDevice(&dev);
    (void)hipDeviceGetAttribute(&cus, hipDeviceAttributeMultiprocessorCount, dev);
    (void)hipFuncSetAttribute((const void*)fwd_megakernel, hipFuncAttributeMaxDynamicSharedMemorySize, LDS_BYTES);
    (void)hipOccupancyMaxActiveBlocksPerMultiprocessor(&per_cu, fwd_megakernel, 512, LDS_BYTES);
    if (per_cu < 1) per_cu = 1;
    grid_blocks = cus;
    if (grid_blocks < 32) grid_blocks = 32;
  }
  if (n_in != 27 || ws_size < WS_END) {
    fprintf(stderr, "kernel_launch: unexpected n_in %d / ws %zu\n", n_in, ws_size);
    return;
  }
  Params p{};
  const float** pp = (const float**)&p;
  for (int i = 0; i < 27; ++i) pp[i] = (const float*)d_in[i];
  p.out = (float*)d_out;
  p.ws = (unsigned char*)d_ws;
  void* args[] = {&p};
  hipError_t e = hipLaunchCooperativeKernel((void*)fwd_megakernel, dim3(grid_blocks), dim3(512), args, LDS_BYTES, stream);
  if (e != hipSuccess) fprintf(stderr, "cooperative launch failed: %s (grid %d)\n", hipGetErrorString(e), grid_blocks);
}
```

```cpp
#include <hip/hip_runtime.h>
#include <hip/hip_bf16.h>
#include <hip/hip_cooperative_groups.h>
#include <cstdio>
namespace cg = cooperative_groups;

typedef unsigned short u16;
using bf16x8 = __attribute__((ext_vector_type(8))) short;
using f32x4 = __attribute__((ext_vector_type(4))) float;
using f32x16 = __attribute__((ext_vector_type(16))) float;

#define T_ 16384
#define NALL 3456
#define NSEG 64
#define SL (T_ / NSEG)
#define PROJF 1728

#define OFF_WALL 0ull
#define OFF_WOUT 28311552ull
#define OFF_MOD 36700160ull
#define OFF_H 36749312ull
#define OFF_RWW OFF_H
#define OFF_RWKK (OFF_H + 16777216ull)
#define OFF_PROJ 70303744ull
#define OFF_MIX 183549952ull
#define OFF_RWB 217104384ull
#define OFF_GLAS 250658816ull
#define OFF_GLAD 259047424ull
#define OFF_BONUS 259178496ull
#define OFF_ZP 259440640ull
#define OFF_BAR 267829248ull
#define WS_END 267845632ull


struct Params {
  const float *x, *c, *ada_w, *ada_b, *norm_pre, *norm_post, *w_in, *w_out, *sinks, *mu_rkv, *mu_w, *mu_a, *w0, *w1, *w2,
      *a0, *a1, *a2, *k_k, *k_a, *r_k, *ln_w, *ln_b, *gk1, *gk2, *gk_b, *gla_nw;
  float* out;
  unsigned char* ws;
};

__device__ __forceinline__ u16 f2bf(float f) {
  unsigned u = __float_as_uint(f);
  u += 0x7fffu + ((u >> 16) & 1u);
  return (u16)(u >> 16);
}
__device__ __forceinline__ float bf2f(u16 h) { return __uint_as_float(((unsigned)h) << 16); }
__device__ __forceinline__ unsigned pack2(float a, float b) { return (unsigned)f2bf(a) | ((unsigned)f2bf(b) << 16); }
__device__ __forceinline__ float bflo(unsigned u) { return __uint_as_float(u << 16); }
__device__ __forceinline__ float bfhi(unsigned u) { return __uint_as_float(u & 0xffff0000u); }
__device__ __forceinline__ float wave_sum(float v) {
#pragma unroll
  for (int o = 32; o > 0; o >>= 1) v += __shfl_xor(v, o);
  return v;
}
__device__ __forceinline__ float silu(float x) { return x / (1.f + __expf(-x)); }
__device__ __forceinline__ float sigmoidf_(float x) { return 1.f / (1.f + __expf(-x)); }
__device__ __forceinline__ float softplusf_(float z) { return fmaxf(z, 0.f) + log1pf(__expf(-fabsf(z))); }

__device__ __forceinline__ int opq(int x) { asm volatile("" : "+s"(x)); return x; }
__device__ __forceinline__ int opaque_tid() { int t = threadIdx.x & 255; asm volatile("" : "+v"(t)); return t; }
__device__ __forceinline__ int opaque_tid512() { int t = threadIdx.x; asm volatile("" : "+v"(t)); return t; }
template <int CTRL>
__device__ __forceinline__ float dpp_f(float x) {
  return __builtin_bit_cast(float, __builtin_amdgcn_update_dpp(0, __builtin_bit_cast(int, x), CTRL, 0xf, 0xf, false));
}
__device__ __forceinline__ float row16_allsum(float x) {
  x += dpp_f<0x128>(x);
  x += dpp_f<0x124>(x);
  x += dpp_f<0x122>(x);
  x += dpp_f<0x121>(x);
  return x;
}

namespace pg8 {
#define PG8_LAS __attribute__((address_space(3)))
typedef unsigned short bf16_t;
typedef short bf16x8 __attribute__((ext_vector_type(8)));
typedef float f32x4 __attribute__((ext_vector_type(4)));
typedef unsigned u32x4 __attribute__((ext_vector_type(4)));
constexpr int BM = 256, BK = 64, HALF = 128, HTB = HALF * BK * 2  , STAGE_BYTES = 8 * HTB, NXCD = 8, WGM = 8;

__host__ __device__ __forceinline__ int lds_byte(int r, int c) { const int st = (r >> 4) * 2 + (c >> 5), rr = r & 15, cc = c & 31, ob = rr * 64 + cc * 2; return st * 1024 + (ob ^ (((ob >> 9) & 1) << 5)); }
__host__ __device__ __forceinline__ void stage_rc(int b, int& R, int& C) { const int st = b / 1024, sb = b % 1024, swz = sb ^ (((sb >> 9) & 1) << 5); R = (st >> 1) * 16 + swz / 64; C = (st & 1) * 32 + (swz % 64) / 2; }
__host__ __device__ __forceinline__ int perm32(int rho) { const int n = rho >> 4, i = rho & 15; return 8 * (i >> 2) + 4 * n + (i & 3); }

struct Unit { int pm, pn; };
struct Gemm { const bf16_t* A; const bf16_t* Bt; int M, N, K; };

struct StaticOrder {
    int nM, nN, nwg, G, c;
    __host__ __device__ void init(int M, int N, int G_, int c_) { nM = M / BM; nN = N / BM; nwg = nM * nN; G = G_; c = c_; }
    __host__ __device__ bool next(int i, Unit& u) const {
        const long L = (long)i * G + c; if (L >= nwg) return false;
        int wgid = (int)L; { const int q = nwg / NXCD, r = nwg % NXCD, xcd = wgid % NXCD, off = wgid / NXCD; wgid = (xcd < r ? xcd * (q + 1) : r * (q + 1) + (xcd - r) * q) + off; }
        const int nig = WGM * nN, gid = wgid / nig, fm = gid * WGM, gsz = (nM - fm) < WGM ? (nM - fm) : WGM;
        u.pm = fm + ((wgid % nig) % gsz); u.pn = (wgid % nig) / gsz; return true;
    }
    __device__ __forceinline__ void a_ready(const Unit&) const {}
    __device__ __forceinline__ void done(const Unit&) const {}
};
__device__ __forceinline__ unsigned cvt_pk_bf16(float lo, float hi) { unsigned r; asm volatile("v_cvt_pk_bf16_f32 %0, %1, %2" : "=v"(r) : "v"(lo), "v"(hi)); return r; }
template <class Epi, class Sched, bool STAMP = false>
__device__ __forceinline__ void gemm_phase(PG8_LAS unsigned char* lds, const Gemm g, const Sched& S, const Epi& E, unsigned long long* stamps) {
    const int tid = threadIdx.x, wid = __builtin_amdgcn_readfirstlane(tid >> 6), lane = tid & 63, wr = wid >> 2, wc = wid & 3, fr = lane & 15, fq = lane >> 4;
    const int K = g.K, nt = K / BK;
    int ts_lo = 0, ts_hi = 0, nts = 0; const unsigned long long rt_entry = STAMP ? (unsigned long long)wall_clock64() : 0ull;
#define PG8_STAMP() do { if (STAMP && wid == 0 && nts < 64) { const unsigned long long _c = (unsigned long long)clock64(); \
        ts_lo = (lane == nts) ? (int)(unsigned)_c : ts_lo; ts_hi = (lane == nts) ? (int)(unsigned)(_c >> 32) : ts_hi; ++nts; } } while (0)
    PG8_STAMP();
    unsigned voffA[2], voffB[2];
#pragma unroll
    for (int i = 0; i < 2; ++i) { int R, C; stage_rc(tid * 16 + i * 8192, R, C); const int Rb = Epi::PERM ? ((R & ~31) + perm32(R & 31)) : R;
        voffA[i] = (unsigned)(R * K + C) * 2u; voffB[i] = (unsigned)(Rb * K + C) * 2u; }
    const size_t kstep = (size_t)(BK * 2);
    const size_t hstep = (size_t)HALF * K * 2;
    const size_t tstep = 2 * hstep;
    const unsigned ldsw = (unsigned)wid * 1024u;
    const int aoff = lds_byte(wr * 64 + fr, fq * 8), boff = lds_byte(wc * 32 + fr, fq * 8);
#define PG8_SA(b, h) (((b) * 2 + (h)) * HTB)
#define PG8_SB(b, h) ((4 + (b) * 2 + (h)) * HTB)
#define PG8_STAGE(bufoff, gbase, voff) do { _Pragma("unroll") for (int _i = 0; _i < 2; ++_i) \
        __builtin_amdgcn_global_load_lds((const unsigned*)((const char*)(gbase) + (voff)[_i]), (PG8_LAS unsigned*)(lds + (bufoff) + ldsw + _i * 8192), 16, 0, 0); } while (0)
#define PG8_LDA(dst, b, h) do { _Pragma("unroll") for (int m = 0; m < 4; ++m) _Pragma("unroll") for (int k = 0; k < 2; ++k) dst[m][k] = *(const PG8_LAS bf16x8*)(lds + PG8_SA(b, h) + aoff + m * 2048 + k * 1024); } while (0)
#define PG8_LDB(dst, b, h) do { _Pragma("unroll") for (int n = 0; n < 2; ++n) _Pragma("unroll") for (int k = 0; k < 2; ++k) dst[n][k] = *(const PG8_LAS bf16x8*)(lds + PG8_SB(b, h) + boff + n * 2048 + k * 1024); } while (0)
#define PG8_MMA(ai, bj, At, Bt) do { __builtin_amdgcn_s_setprio(1); _Pragma("unroll") for (int m = 0; m < 4; ++m) _Pragma("unroll") for (int n = 0; n < 2; ++n) _Pragma("unroll") for (int k = 0; k < 2; ++k) \
        acc[ai][bj][m][n] = __builtin_amdgcn_mfma_f32_16x16x32_bf16(Bt[n][k], At[m][k], acc[ai][bj][m][n], 0, 0, 0); __builtin_amdgcn_s_setprio(0); } while (0)
#define PG8_WAIT_V(n) asm volatile("s_waitcnt vmcnt(" #n ")" ::: "memory")
#define PG8_WAIT_L(n) asm volatile("s_waitcnt lgkmcnt(" #n ")" ::: "memory")
#define PG8_BAR __builtin_amdgcn_s_barrier()
#define PG8_SCHED __builtin_amdgcn_sched_barrier(0)
    Unit cur, nxt; int ui = 0;
    if (!S.next(0, cur)) return;
    f32x4 acc[2][2][4][2];
#pragma unroll
    for (int a = 0; a < 2; ++a)
#pragma unroll
        for (int b = 0; b < 2; ++b)
#pragma unroll
            for (int m = 0; m < 4; ++m)
#pragma unroll
                for (int n = 0; n < 2; ++n) acc[a][b][m][n] = (f32x4){0.f, 0.f, 0.f, 0.f};
    bf16x8 At[4][2], B0[2][2], B1[2][2];
    const char* cA = (const char*)g.A + (size_t)cur.pm * tstep; const char* cB = (const char*)g.Bt + (size_t)cur.pn * tstep;
    S.a_ready(cur);
    PG8_STAGE(PG8_SB(0, 0), cB, voffB); PG8_STAGE(PG8_SA(0, 0), cA, voffA); PG8_STAGE(PG8_SB(0, 1), cB + hstep, voffB); PG8_STAGE(PG8_SA(0, 1), cA + hstep, voffA);
    if (wr == 1) PG8_BAR;
    PG8_WAIT_V(4); PG8_BAR;
    PG8_STAGE(PG8_SB(1, 0), cB + kstep, voffB); PG8_STAGE(PG8_SA(1, 0), cA + kstep, voffA); PG8_STAGE(PG8_SB(1, 1), cB + hstep + kstep, voffB);
    PG8_WAIT_V(6); PG8_BAR;
    PG8_STAMP();
    for (;;) {
        const bool has_next = S.next(ui + 1, nxt);
        const char* nA = has_next ? (const char*)g.A + (size_t)nxt.pm * tstep : cA; const char* nB = has_next ? (const char*)g.Bt + (size_t)nxt.pn * tstep : cB;
        for (int t = 0; t < nt; t += 2) {
            const bool last = (t == nt - 2);
            const char* a1 = cA + (size_t)(t + 1) * kstep;
            const char* a2 = last ? nA : cA + (size_t)(t + 2) * kstep; const char* b2 = last ? nB : cB + (size_t)(t + 2) * kstep;
            const char* a3 = a2 + kstep; const char* b3 = b2 + kstep;
            if (last && has_next) S.a_ready(nxt);
            PG8_LDB(B0, 0, 0); PG8_SCHED; PG8_LDA(At, 0, 0); PG8_STAGE(PG8_SA(1, 1), a1 + hstep, voffA);
            PG8_WAIT_L(8); PG8_BAR; PG8_WAIT_L(0); PG8_MMA(0, 0, At, B0); PG8_BAR; PG8_SCHED;
            PG8_LDB(B1, 0, 1); PG8_STAGE(PG8_SB(0, 0), b2, voffB);
            PG8_BAR; PG8_WAIT_L(0); PG8_MMA(0, 1, At, B1); PG8_BAR;
            PG8_LDA(At, 0, 1); PG8_STAGE(PG8_SA(0, 0), a2, voffA);
            PG8_BAR; PG8_WAIT_L(0); PG8_MMA(1, 0, At, B0); PG8_BAR; PG8_SCHED;
            PG8_STAGE(PG8_SB(0, 1), b2 + hstep, voffB);
            PG8_WAIT_V(6); PG8_BAR; PG8_MMA(1, 1, At, B1); PG8_BAR;
            PG8_LDB(B0, 1, 0); PG8_SCHED; PG8_LDA(At, 1, 0); PG8_STAGE(PG8_SA(0, 1), a2 + hstep, voffA);
            PG8_WAIT_L(8); PG8_BAR; PG8_WAIT_L(0); PG8_MMA(0, 0, At, B0); PG8_BAR; PG8_SCHED;
            PG8_LDB(B1, 1, 1); PG8_STAGE(PG8_SB(1, 0), b3, voffB);
            PG8_BAR; PG8_WAIT_L(0); PG8_MMA(0, 1, At, B1); PG8_BAR;
            PG8_LDA(At, 1, 1); PG8_STAGE(PG8_SA(1, 0), a3, voffA);
            PG8_BAR; PG8_WAIT_L(0); PG8_MMA(1, 0, At, B0); PG8_BAR; PG8_SCHED;
            PG8_STAGE(PG8_SB(1, 1), b3 + hstep, voffB);
            PG8_WAIT_V(6); PG8_BAR; PG8_MMA(1, 1, At, B1); PG8_BAR;
        }
        PG8_STAMP();
        if constexpr (!Epi::AFTER_DRAIN) { E(acc, cur, wr, wc, fr, fq); S.done(cur); }
        PG8_STAMP();
        if (!has_next) break;
#pragma unroll
        for (int a = 0; a < 2; ++a)
#pragma unroll
            for (int b = 0; b < 2; ++b)
#pragma unroll
                for (int m = 0; m < 4; ++m)
#pragma unroll
                    for (int n = 0; n < 2; ++n) acc[a][b][m][n] = (f32x4){0.f, 0.f, 0.f, 0.f};
        cur = nxt; cA = nA; cB = nB; ++ui;
    }
    PG8_WAIT_V(0);
    if (wr == 0) PG8_BAR;
    PG8_BAR;
    if constexpr (Epi::AFTER_DRAIN) { E.fused(acc, cur, wr, wc, fr, fq, lds, wid, lane); S.done(cur); }
    PG8_STAMP();
    if (STAMP && wid == 0) { stamps[lane] = lane < nts ? (((unsigned long long)(unsigned)ts_hi << 32) | (unsigned)ts_lo) : 0ull;
        if (lane == 62) stamps[62] = rt_entry; if (lane == 63) stamps[63] = (unsigned long long)wall_clock64(); }
#undef PG8_STAMP
#undef PG8_SA
#undef PG8_SB
#undef PG8_STAGE
#undef PG8_LDA
#undef PG8_LDB
#undef PG8_MMA
#undef PG8_WAIT_V
#undef PG8_WAIT_L
#undef PG8_BAR
#undef PG8_SCHED
}
}

namespace pg8 {
struct EpiProj {
    static constexpr bool PERM = true, AFTER_DRAIN = false;
    bf16_t* O; int ldc; int ncols;
    __device__ __forceinline__ void operator()(const f32x4 (&acc)[2][2][4][2], const Unit& u, int wr, int wc, int fr, int fq) const {
        const int row0 = u.pm * BM + wr * 64 + fr; const int col0 = u.pn * BM + wc * 32 + 8 * fq;
#pragma unroll
        for (int ai = 0; ai < 2; ++ai)
#pragma unroll
            for (int m = 0; m < 4; ++m) { bf16_t* rowp = O + (size_t)(row0 + ai * HALF + m * 16) * ldc + col0;
#pragma unroll
                for (int bj = 0; bj < 2; ++bj) { const f32x4 v0 = acc[ai][bj][m][0], v1 = acc[ai][bj][m][1];
                    u32x4 w; w.x = cvt_pk_bf16(v0[0], v0[1]); w.y = cvt_pk_bf16(v0[2], v0[3]); w.z = cvt_pk_bf16(v1[0], v1[1]); w.w = cvt_pk_bf16(v1[2], v1[3]);
                    if (col0 + bj * HALF < ncols) *(u32x4*)(rowp + bj * HALF) = w; } }
    }
};
struct EpiU {
    static constexpr bool PERM = true, AFTER_DRAIN = false;
    void* O; int ldc; int ncols; int f32out;
    __device__ __forceinline__ void operator()(const f32x4 (&acc)[2][2][4][2], const Unit& u, int wr, int wc, int fr, int fq) const {
        const int row0 = u.pm * BM + wr * 64 + fr; const int col0 = u.pn * BM + wc * 32 + 8 * fq;
        if (f32out) {
#pragma unroll
            for (int ai = 0; ai < 2; ++ai)
#pragma unroll
                for (int m = 0; m < 4; ++m) { float* rowp = (float*)O + (size_t)(row0 + ai * HALF + m * 16) * ldc + col0;
#pragma unroll
                    for (int bj = 0; bj < 2; ++bj) { *(f32x4*)(rowp + bj * HALF) = acc[ai][bj][m][0]; *(f32x4*)(rowp + bj * HALF + 4) = acc[ai][bj][m][1]; } }
        } else {
#pragma unroll
            for (int ai = 0; ai < 2; ++ai)
#pragma unroll
                for (int m = 0; m < 4; ++m) { bf16_t* rowp = (bf16_t*)O + (size_t)(row0 + ai * HALF + m * 16) * ldc + col0;
#pragma unroll
                    for (int bj = 0; bj < 2; ++bj) { const f32x4 v0 = acc[ai][bj][m][0], v1 = acc[ai][bj][m][1];
                        u32x4 w; w.x = cvt_pk_bf16(v0[0], v0[1]); w.y = cvt_pk_bf16(v0[2], v0[3]); w.z = cvt_pk_bf16(v1[0], v1[1]); w.w = cvt_pk_bf16(v1[2], v1[3]);
                        if (col0 + bj * HALF < ncols) *(u32x4*)(rowp + bj * HALF) = w; } }
        }
    }
};
}

#define XB_TMO      128
#define XB_XCNT(j)  (256  + 64 * (j))
#define XB_XSUB(j)  (1280 + 64 * (j))
#define XB_XGEN(j)  (2304 + 64 * (j))
#define XB_TOP      3328
#define XB_TOPGEN   3392
#define XCD_BAR_WORDS 3456
#define XB_SPIN_CAP (1u << 18)
#define LAS __attribute__((address_space(3)))

__device__ __forceinline__ unsigned xb_ld(unsigned* p)              { return __hip_atomic_load(p, __ATOMIC_RELAXED, __HIP_MEMORY_SCOPE_AGENT); }
__device__ __forceinline__ unsigned xb_add(unsigned* p, unsigned v) { return __hip_atomic_fetch_add(p, v, __ATOMIC_RELAXED, __HIP_MEMORY_SCOPE_AGENT); }
__device__ __forceinline__ unsigned xb_xcc_id() { return (unsigned)__builtin_amdgcn_s_getreg((3 << 11) | 20) & 0xFu; }
#define XB_SPIN(cond, bar) do { unsigned _sp = 0; while (cond) { __builtin_amdgcn_s_sleep(1); \
    if ((++_sp & 255u) == 0u) { if (xb_ld(&(bar)[XB_TMO])) break; if (_sp > XB_SPIN_CAP) { atomicAdd(&(bar)[XB_TMO], 1u); break; } } } } while (0)

struct XcdBarrier {
    unsigned* bar; unsigned x;
    volatile LAS unsigned* st;
};

__device__ __forceinline__ XcdBarrier xcd_barrier_post(unsigned* bar, volatile LAS unsigned* st) {
    XcdBarrier b; b.bar = bar; b.x = xb_xcc_id(); b.st = st;
    if (threadIdx.x == 0) (void)xb_add(&bar[XB_XCNT(b.x)], 1u);
    return b;
}
__device__ __forceinline__ void xcd_barrier_complete(unsigned* bar, unsigned x, unsigned& nloc, unsigned& nx) {
    const unsigned G = gridDim.x * gridDim.y * gridDim.z;
    unsigned sum, cnt, mine, sp = 0u;
    for (;;) {
        sum = 0u; cnt = 0u; mine = 0u;
#pragma unroll
        for (unsigned j = 0; j < 16; ++j) { const unsigned c = xb_ld(&bar[XB_XCNT(j)]); sum += c; cnt += (c > 0u) ? 1u : 0u; mine = (j == x) ? c : mine; }
        if (sum == G) break;
        __builtin_amdgcn_s_sleep(1);
        if ((++sp & 255u) == 0u) { if (xb_ld(&bar[XB_TMO])) break; if (sp > XB_SPIN_CAP) { atomicAdd(&bar[XB_TMO], 1u); break; } }
    }
    nloc = mine > 0u ? mine : 1u; nx = cnt > 0u ? cnt : 1u;
}

__device__ __forceinline__ void xcd_barrier(const XcdBarrier& b) {
    asm volatile("s_waitcnt vmcnt(0)" ::: "memory");
    __syncthreads();
    if (threadIdx.x == 0) {
        unsigned* bar = b.bar;
        __builtin_amdgcn_s_waitcnt(0);
        unsigned nloc = b.st[0], nx = b.st[1];
        if (nloc == 0u) { xcd_barrier_complete(bar, b.x, nloc, nx); b.st[0] = nloc; b.st[1] = nx; }
        const unsigned old = xb_add(&bar[XB_XSUB(b.x)], 1u);
        const unsigned gen = old / nloc;
        if (old + 1u == (gen + 1u) * nloc) {
            __builtin_amdgcn_fence(__ATOMIC_RELEASE, "agent");
            asm volatile("s_waitcnt vmcnt(0)" ::: "memory");
            const unsigned og = xb_add(&bar[XB_TOP], 1u);
            const unsigned tg = og / nx;
            if (og + 1u == (tg + 1u) * nx) xb_add(&bar[XB_TOPGEN], 1u);
            else XB_SPIN(xb_ld(&bar[XB_TOPGEN]) == tg, bar);
            __builtin_amdgcn_fence(__ATOMIC_ACQUIRE, "agent");
            xb_add(&bar[XB_XGEN(b.x)], 1u);
            asm volatile("s_waitcnt vmcnt(0)" ::: "memory");
        } else {
            XB_SPIN(xb_ld(&bar[XB_XGEN(b.x)]) == gen, bar);
            __builtin_amdgcn_fence(__ATOMIC_ACQUIRE, "agent");
            asm volatile("s_waitcnt vmcnt(0)" ::: "memory");
        }
    }
    __syncthreads();
}

__device__ void phase_mod_item(const Params& p, int it, unsigned char* smem) {
  float* red = (float*)smem;
  const int tid = opaque_tid(), tx = tid & 31, ty = tid >> 5;
  float* mod = (float*)(p.ws + OFF_MOD);
  it = opq(it);
  {
    int l = it / 96;
    int j = (it % 96) * 32 + tx;
    const float* W = p.ada_w + (size_t)l * 1024 * 3072;
    float acc = 0.f;
    for (int i = 0; i < 128; ++i) {
      int k = ty * 128 + i;
      float cv = p.c[k];
      acc += silu(cv) * W[(size_t)k * 3072 + j];
    }
    red[ty * 32 + tx] = acc;
    __syncthreads();
    if (ty == 0) {
      float s = 0.f;
      for (int g = 0; g < 8; ++g) s += red[g * 32 + tx];
      mod[l * 3072 + j] = s + p.ada_b[l * 3072 + j];
    }
    __syncthreads();
  }
}

__device__ __forceinline__ float wall_src(const Params& p, int l, int k, int n) {
  size_t lk = (size_t)l * 1024 + k;
  if (n < 3072) return p.w_in[lk * 3072 + n];
  if (n < 3136) return (1.f - p.mu_w[lk]) * p.w1[lk * 64 + (n - 3072)];
  if (n < 3200) return p.mu_w[lk] * p.w1[lk * 64 + (n - 3136)];
  if (n < 3264) return (1.f - p.mu_a[lk]) * p.a1[lk * 64 + (n - 3200)];
  if (n < 3328) return p.mu_a[lk] * p.a1[lk * 64 + (n - 3264)];
  if (n < 3344) return p.gk1[lk * 16 + (n - 3328)];
  return 0.f;
}

__device__ void phase_wconv_item(const Params& p, int it, unsigned char* smem) {
  float* tile = (float*)smem;
  const int tid = opaque_tid();
  u16* WALL = (u16*)(p.ws + OFF_WALL);
  u16* WOUT = (u16*)(p.ws + OFF_WOUT);
  it = opq(it);
  {
    bool isout = it >= 3456;
    int l, nt, kt;
    if (!isout) { l = it / 864; int r = it % 864; nt = r >> 4; kt = r & 15; }
    else { int r = it - 3456; l = r >> 8; r &= 255; nt = r >> 4; kt = r & 15; }
    int tx = tid & 63, ty = tid >> 6;
#pragma unroll 4
    for (int i = 0; i < 16; ++i) {
      int kl = ty + 4 * i;
      int k = kt * 64 + kl, n = nt * 64 + tx;
      float v = isout ? p.w_out[((size_t)l * 1024 + k) * 1024 + n] : wall_src(p, l, k, n);
      tile[kl * 65 + tx] = v;
    }
    __syncthreads();
    int nl = tid >> 2, kq = tid & 3;
    unsigned w[8];
#pragma unroll
    for (int j = 0; j < 8; ++j) w[j] = pack2(tile[(kq * 16 + 2 * j) * 65 + nl], tile[(kq * 16 + 2 * j + 1) * 65 + nl]);
    u16* dst = (isout ? WOUT + ((size_t)l * 1024 + nt * 64 + nl) * 1024 : WALL + ((size_t)l * NALL + nt * 64 + nl) * 1024) + kt * 64 + kq * 16;
    ((uint4*)dst)[0] = make_uint4(w[0], w[1], w[2], w[3]);
    ((uint4*)dst)[1] = make_uint4(w[4], w[5], w[6], w[7]);
    __syncthreads();
  }
}

__device__ __forceinline__ void write_h(const Params& p, int l, int row, int lane, const float4* v, float ss) {
  const float* mod = (const float*)(p.ws + OFF_MOD) + l * 3072;
  u16* H = (u16*)(p.ws + OFF_H);
  float rs = rsqrtf(ss * (1.f / 1024.f) + 1e-6f);
#pragma unroll
  for (int i = 0; i < 4; ++i) {
    int col = (lane + 64 * i) * 4;
    float4 g = *(const float4*)(p.norm_pre + l * 1024 + col);
    float4 sh = *(const float4*)(mod + col);
    float4 sc = *(const float4*)(mod + 1024 + col);
    float h0 = v[i].x * rs * g.x * (1.f + sc.x) + sh.x;
    float h1 = v[i].y * rs * g.y * (1.f + sc.y) + sh.y;
    float h2 = v[i].z * rs * g.z * (1.f + sc.z) + sh.z;
    float h3 = v[i].w * rs * g.w * (1.f + sc.w) + sh.w;
    *(uint2*)(H + (size_t)row * 1024 + col) = make_uint2(pack2(h0, h1), pack2(h2, h3));
  }
}

__device__ void phase_h0(const Params& p) {
  const int tid = opaque_tid512(); const int wave = tid >> 6, lane = tid & 63;
  for (int row = blockIdx.x * 8 + wave; row < T_; row += gridDim.x * 8) {
    const float4* xr = (const float4*)(p.x + (size_t)row * 1024);
    float4 v[4];
    float ss = 0.f;
#pragma unroll
    for (int i = 0; i < 4; ++i) {
      v[i] = xr[lane + 64 * i];
      ss += v[i].x * v[i].x + v[i].y * v[i].y + v[i].z * v[i].z + v[i].w * v[i].w;
    }
    ss = wave_sum(ss);
    write_h(p, 0, row, lane, v, ss);
  }
}

__device__ void phase_post(const Params& p, int l) {
  l = opq(l);
  const int tid = opaque_tid512(); const int wave = tid >> 6, lane = tid & 63;
  const float* Y = (const float*)(p.ws + OFF_PROJ);
  const float* mod = (const float*)(p.ws + OFF_MOD) + l * 3072;
  const float* xold = (l == 0) ? p.x : p.out;
  for (int row = blockIdx.x * 8 + wave; row < T_; row += gridDim.x * 8) {
    const float4* yr = (const float4*)(Y + (size_t)row * 1024);
    const float4* xr = (const float4*)(xold + (size_t)row * 1024);
    float4 y[4], v[4];
    float ss = 0.f;
#pragma unroll
    for (int i = 0; i < 4; ++i) {
      y[i] = yr[lane + 64 * i];
      v[i] = xr[lane + 64 * i];
      ss += y[i].x * y[i].x + y[i].y * y[i].y + y[i].z * y[i].z + y[i].w * y[i].w;
    }
    ss = wave_sum(ss);
    float rs = rsqrtf(ss * (1.f / 1024.f) + 1e-6f);
    float s2 = 0.f;
#pragma unroll
    for (int i = 0; i < 4; ++i) {
      int col = (lane + 64 * i) * 4;
      float4 g = *(const float4*)(p.norm_post + l * 1024 + col);
      float4 gt = *(const float4*)(mod + 2048 + col);
      v[i].x += gt.x * (y[i].x * rs * g.x);
      v[i].y += gt.y * (y[i].y * rs * g.y);
      v[i].z += gt.z * (y[i].z * rs * g.z);
      v[i].w += gt.w * (y[i].w * rs * g.w);
      *(float4*)(p.out + (size_t)row * 1024 + col) = v[i];
      s2 += v[i].x * v[i].x + v[i].y * v[i].y + v[i].z * v[i].z + v[i].w * v[i].w;
    }
    if (l < 3) {
      s2 = wave_sum(s2);
      write_h(p, l + 1, row, lane, v, s2);
    }
  }
}

__device__ void attn_item(const Params& p, int l, int item, unsigned char* smem) {
  l = opq(l); item = opq(item);
  u16* Vt = (u16*)smem;
  const u16* PROJ = (const u16*)(p.ws + OFF_PROJ);
  u16* MIX = (u16*)(p.ws + OFF_MIX);
  const int tid = opaque_tid(), w = tid >> 6, lane = tid & 63, l31 = lane & 31, hf = lane >> 5;
  const int qb = item >> 3, head = item & 7, kvh = head >> 2;
  const int kpos0 = (qb - 1) * 128;
  {
    int kp = kpos0 + tid;
    if (kp < 0) kp = 0;
    const uint4* src = (const uint4*)(PROJ + (size_t)kp * NALL + 640 + kvh * 64);
#pragma unroll
    for (int c8 = 0; c8 < 8; ++c8) {
      uint4 v = src[c8];
      int d = c8 * 8;
      Vt[(d + 0) * 264 + tid] = (u16)(v.x & 0xffff);
      Vt[(d + 1) * 264 + tid] = (u16)(v.x >> 16);
      Vt[(d + 2) * 264 + tid] = (u16)(v.y & 0xffff);
      Vt[(d + 3) * 264 + tid] = (u16)(v.y >> 16);
      Vt[(d + 4) * 264 + tid] = (u16)(v.z & 0xffff);
      Vt[(d + 5) * 264 + tid] = (u16)(v.z >> 16);
      Vt[(d + 6) * 264 + tid] = (u16)(v.w & 0xffff);
      Vt[(d + 7) * 264 + tid] = (u16)(v.w >> 16);
    }
  }
  __syncthreads();
  const int tq = qb * 128 + 32 * w + l31;
  bf16x8 qf[4];
  {
    const u16* qp = PROJ + (size_t)tq * NALL + head * 64 + 8 * hf;
#pragma unroll
    for (int s = 0; s < 4; ++s) qf[s] = *(const bf16x8*)(qp + 16 * s);
  }
  const float slope = exp2f(-(float)(head + 1));
  const float sink = p.sinks[l * 8 + head];
  const int rq = 32 * w + l31;
  float mrun = -1e30f, lsum = 0.f;
  f32x16 o0, o1;
#pragma unroll
  for (int r = 0; r < 16; ++r) { o0[r] = 0.f; o1[r] = 0.f; }
#pragma unroll 1
  for (int i = 0; i < 5; ++i) {
    int kp = kpos0 + 32 * w + 32 * i + l31;
    if (kp < 0) kp = 0;
    const u16* kptr = PROJ + (size_t)kp * NALL + 512 + kvh * 64 + 8 * hf;
    f32x16 a;
#pragma unroll
    for (int r = 0; r < 16; ++r) a[r] = 0.f;
#pragma unroll
    for (int s = 0; s < 4; ++s) {
      bf16x8 kf = *(const bf16x8*)(kptr + 16 * s);
      a = __builtin_amdgcn_mfma_f32_32x32x16_bf16(kf, qf[s], a, 0, 0, 0);
    }
    float tmax = -1e30f;
#pragma unroll
    for (int r = 0; r < 16; ++r) {
      int kj = 32 * w + 32 * i + (r & 3) + 8 * (r >> 2) + 4 * hf;
      int dist = 128 + rq - kj;
      bool valid = (dist >= 0) && (dist < 128) && (kpos0 + kj >= 0);
      float sv = a[r] * 0.125f - slope * (float)dist;
      sv = valid ? sv : -1e30f;
      a[r] = sv;
      tmax = fmaxf(tmax, sv);
    }
    tmax = fmaxf(tmax, __shfl_xor(tmax, 32));
    const float mnew = fmaxf(mrun, tmax);
    const float alpha = __expf(mrun - mnew);
    float psum = 0.f;
#pragma unroll
    for (int r = 0; r < 16; ++r) {
      float e = (a[r] > -1e29f) ? __expf(a[r] - mnew) : 0.f;
      a[r] = e;
      psum += e;
    }
    lsum = lsum * alpha + psum;
    mrun = mnew;
#pragma unroll
    for (int r = 0; r < 16; ++r) { o0[r] *= alpha; o1[r] *= alpha; }
#pragma unroll
    for (int u = 0; u < 2; ++u) {
      bf16x8 pf;
#pragma unroll
      for (int j = 0; j < 8; ++j) pf[j] = (short)f2bf(a[8 * u + j]);
      const int kb = 32 * w + 32 * i + 16 * u + 4 * hf;
      const u16* v0 = Vt + l31 * 264 + kb;
      const u16* v1 = Vt + (32 + l31) * 264 + kb;
      uint2 a0 = *(const uint2*)(v0), a1 = *(const uint2*)(v0 + 8);
      uint2 b0 = *(const uint2*)(v1), b1 = *(const uint2*)(v1 + 8);
      uint4 A0 = make_uint4(a0.x, a0.y, a1.x, a1.y), A1 = make_uint4(b0.x, b0.y, b1.x, b1.y);
      o0 = __builtin_amdgcn_mfma_f32_32x32x16_bf16(__builtin_bit_cast(bf16x8, A0), pf, o0, 0, 0, 0);
      o1 = __builtin_amdgcn_mfma_f32_32x32x16_bf16(__builtin_bit_cast(bf16x8, A1), pf, o1, 0, 0, 0);
    }
  }
  {
    const float mf = fmaxf(mrun, sink);
    const float scl = __expf(mrun - mf);
    const float ltot = (lsum + __shfl_xor(lsum, 32)) * scl + __expf(sink - mf);
    const float fin = scl / ltot;
#pragma unroll
    for (int r = 0; r < 16; ++r) { o0[r] *= fin; o1[r] *= fin; }
  }
  const u16* gp = PROJ + (size_t)tq * NALL + 768 + head * 64;
  u16* op = MIX + (size_t)tq * 1024 + head * 64;
#pragma unroll
  for (int g = 0; g < 4; ++g) {
    int d0 = 8 * g + 4 * hf;
    uint2 gg = *(const uint2*)(gp + d0);
    float r0 = o0[4 * g + 0] * silu(bflo(gg.x)), r1 = o0[4 * g + 1] * silu(bfhi(gg.x));
    float r2 = o0[4 * g + 2] * silu(bflo(gg.y)), r3 = o0[4 * g + 3] * silu(bfhi(gg.y));
    *(uint2*)(op + d0) = make_uint2(pack2(r0, r1), pack2(r2, r3));
    uint2 g2 = *(const uint2*)(gp + 32 + d0);
    r0 = o1[4 * g + 0] * silu(bflo(g2.x)); r1 = o1[4 * g + 1] * silu(bfhi(g2.x));
    r2 = o1[4 * g + 2] * silu(bflo(g2.y)); r3 = o1[4 * g + 3] * silu(bfhi(g2.y));
    *(uint2*)(op + 32 + d0) = make_uint2(pack2(r0, r1), pack2(r2, r3));
  }
  __syncthreads();
}

__device__ void rwkv_prep_item(const Params& p, int l, int item, unsigned char* smem) {
  l = opq(l); item = opq(item);
  float* lw = (float*)smem;
  float* la = lw + 1024;
  const u16* PROJ = (const u16*)(p.ws + OFF_PROJ);
  const int tid = opaque_tid(), c = tid, head = tid >> 6, lane = tid & 63;
  const int t0 = item * 16;
#pragma unroll
  for (int i = 0; i < 8; ++i) {
    int idx = tid + 256 * i;
    int which = idx >> 10, tt = (idx >> 6) & 15, j = idx & 63;
    int t = t0 + tt;
    const u16* pr = PROJ + (size_t)t * NALL;
    float cur = bf2f(pr[(which ? 3200 : 3072) + j]);
    float prev = (t > 0) ? bf2f((pr - NALL)[(which ? 3264 : 3136) + j]) : 0.f;
    float s = cur + prev;
    if (!which) s = tanhf(s);
    (which ? la : lw)[tt * 64 + j] = s;
  }
  __syncthreads();
  float accw[16], acca[16];
#pragma unroll
  for (int tt = 0; tt < 16; ++tt) { accw[tt] = 0.f; acca[tt] = 0.f; }
  const float* w2 = p.w2 + (size_t)l * 64 * 256 + c;
  const float* a2 = p.a2 + (size_t)l * 64 * 256 + c;
  for (int j4 = 0; j4 < 16; ++j4) {
    float w20 = w2[(4 * j4 + 0) * 256], w21 = w2[(4 * j4 + 1) * 256], w22 = w2[(4 * j4 + 2) * 256], w23 = w2[(4 * j4 + 3) * 256];
    float a20 = a2[(4 * j4 + 0) * 256], a21 = a2[(4 * j4 + 1) * 256], a22 = a2[(4 * j4 + 2) * 256], a23 = a2[(4 * j4 + 3) * 256];
#pragma unroll
    for (int tt = 0; tt < 16; ++tt) {
      float4 lv = *(const float4*)(lw + tt * 64 + j4 * 4);
      float4 av = *(const float4*)(la + tt * 64 + j4 * 4);
      accw[tt] += lv.x * w20 + lv.y * w21 + lv.z * w22 + lv.w * w23;
      acca[tt] += av.x * a20 + av.y * a21 + av.z * a22 + av.w * a23;
    }
  }
  const float mur = p.mu_rkv[l * 768 + c], muk = p.mu_rkv[l * 768 + 256 + c], muv = p.mu_rkv[l * 768 + 512 + c];
  const float w0 = p.w0[l * 256 + c], a0 = p.a0[l * 256 + c], kkw = p.k_k[l * 256 + c], kaw = p.k_a[l * 256 + c], rkw = p.r_k[l * 256 + c];
  float* RWW = (float*)(p.ws + OFF_RWW);
  float* RWKK = (float*)(p.ws + OFF_RWKK);
  u16* RB = (u16*)(p.ws + OFF_RWB);
  float* BON = (float*)(p.ws + OFF_BONUS);
#pragma unroll
  for (int tt = 0; tt < 16; ++tt) {
    int t = t0 + tt;
    const u16* pr = PROJ + (size_t)t * NALL;
    float rc = bf2f(pr[1280 + c]), kc = bf2f(pr[1536 + c]), vc = bf2f(pr[1792 + c]);
    float rp = 0.f, kp = 0.f, vp = 0.f;
    if (t > 0) { rp = bf2f((pr - NALL)[1280 + c]); kp = bf2f((pr - NALL)[1536 + c]); vp = bf2f((pr - NALL)[1792 + c]); }
    float r = rc + (rp - rc) * mur, k = kc + (kp - kc) * muk, v = vc + (vp - vc) * muv;
    float wpre = w0 + accw[tt];
    float wl = -softplusf_(-wpre) - 0.5f;
    float decay = __expf(-__expf(wl));
    float a = sigmoidf_(a0 + acca[tt]);
    float kkc = k * kkw;
    float n2 = wave_sum(kkc * kkc);
    float kk = kkc / fmaxf(sqrtf(n2), 1e-12f);
    float kmod = k * (1.f + (a - 1.f) * kaw);
    float bb = kk * a;
    float bonus = wave_sum(r * kmod * rkw);
    size_t o = (size_t)t * 256 + c;
    RWW[o] = decay;
    RWKK[o] = kk;
    RB[o] = f2bf(r);
    RB[(size_t)T_ * 256 + o] = f2bf(kmod);
    RB[(size_t)2 * T_ * 256 + o] = f2bf(v);
    RB[(size_t)3 * T_ * 256 + o] = f2bf(bb);
    if (lane == 0) BON[t * 4 + head] = bonus;
  }
  __syncthreads();
}

__device__ __forceinline__ void gla_b(const Params& p, int l, int chunk, int head, float* tot, float* bl) {
  const u16* PROJ = (const u16*)(p.ws + OFF_PROJ);
  const int tid = opaque_tid(), d = tid & 31, ig = tid >> 5;
  float g2[16];
#pragma unroll
  for (int m = 0; m < 16; ++m) g2[m] = p.gk2[(size_t)l * 16 * 128 + m * 128 + head * 32 + d];
  const float bias = p.gk_b[l * 128 + head * 32 + d];
  float run = 0.f;
#pragma unroll
  for (int ii = 0; ii < 8; ++ii) {
    int t = chunk * 64 + ig * 8 + ii;
    const uint4* lp = (const uint4*)(PROJ + (size_t)t * NALL + 3328);
    uint4 u0 = lp[0], u1 = lp[1];
    float z = bias;
    z += bflo(u0.x) * g2[0] + bfhi(u0.x) * g2[1] + bflo(u0.y) * g2[2] + bfhi(u0.y) * g2[3];
    z += bflo(u0.z) * g2[4] + bfhi(u0.z) * g2[5] + bflo(u0.w) * g2[6] + bfhi(u0.w) * g2[7];
    z += bflo(u1.x) * g2[8] + bfhi(u1.x) * g2[9] + bflo(u1.y) * g2[10] + bfhi(u1.y) * g2[11];
    z += bflo(u1.z) * g2[12] + bfhi(u1.z) * g2[13] + bflo(u1.w) * g2[14] + bfhi(u1.w) * g2[15];
    float g = (fminf(z, 0.f) - log1pf(__expf(-fabsf(z)))) * (1.f / 16.f);
    run += g;
    bl[ii] = run;
  }
  tot[ig * 32 + d] = run;
  __syncthreads();
  float off = 0.f;
#pragma unroll
  for (int g = 0; g < 8; ++g) off += (g < ig) ? tot[g * 32 + d] : 0.f;
#pragma unroll
  for (int ii = 0; ii < 8; ++ii) bl[ii] += off;
}

__device__ void gla_local_item(const Params& p, int l, int item, unsigned char* smem) {
  l = opq(l); item = opq(item);
  float* tot = (float*)smem;
  float* Kp = tot + 256;
  float* Vs = Kp + 2048;
  const u16* PROJ = (const u16*)(p.ws + OFF_PROJ);
  const int tid = opaque_tid(), d = tid & 31, ig = tid >> 5;
  const int chunk = item >> 2, head = item & 3;
  float bl[8];
  gla_b(p, l, chunk, head, tot, bl);
  float blast = 0.f;
#pragma unroll
  for (int g = 0; g < 8; ++g) blast += tot[g * 32 + d];
#pragma unroll
  for (int ii = 0; ii < 8; ++ii) {
    int i = ig * 8 + ii;
    int t = chunk * 64 + i;
    float k = bf2f(PROJ[(size_t)t * NALL + 2432 + head * 32 + d]);
    Kp[i * 32 + d] = k * __expf(blast - bl[ii]);
  }
#pragma unroll
  for (int r = 0; r < 16; ++r) {
    int idx = tid + 256 * r;
    int i = idx >> 6, v = idx & 63;
    Vs[idx] = bf2f(PROJ[(size_t)(chunk * 64 + i) * NALL + 2560 + head * 64 + v]);
  }
  __syncthreads();
  const int v = tid & 63, dg = tid >> 6;
  float acc[8];
#pragma unroll
  for (int q = 0; q < 8; ++q) acc[q] = 0.f;
  for (int i = 0; i < 64; ++i) {
    float vv = Vs[i * 64 + v];
    float4 k0 = *(const float4*)(Kp + i * 32 + dg * 8), k1 = *(const float4*)(Kp + i * 32 + dg * 8 + 4);
    acc[0] += k0.x * vv; acc[1] += k0.y * vv; acc[2] += k0.z * vv; acc[3] += k0.w * vv;
    acc[4] += k1.x * vv; acc[5] += k1.y * vv; acc[6] += k1.z * vv; acc[7] += k1.w * vv;
  }
  float* GS = (float*)(p.ws + OFF_GLAS);
  float* GD = (float*)(p.ws + OFF_GLAD);
#pragma unroll
  for (int q = 0; q < 8; ++q) GS[((size_t)(chunk * 4 + head) * 32 + dg * 8 + q) * 64 + v] = acc[q];
  if (tid < 32) GD[(chunk * 4 + head) * 32 + tid] = __expf(blast);
  __syncthreads();
}

__device__ void gla_state_block(const Params& p, int eb, unsigned char* dsm_) {
  float* comp = (float*)dsm_;
  float* GS = (float*)(p.ws + OFF_GLAS);
  const float* GD = (const float*)(p.ws + OFF_GLAD);
  eb = opq(eb);
  const int tid = opaque_tid512();
  const int ei = tid & 31, g = tid >> 5;
  const int e = eb * 32 + ei;
  const int head = e >> 11, d = (e >> 6) & 31, v = e & 63;
  float ds[16], dc[16];
#pragma unroll
  for (int i = 0; i < 16; ++i) {
    const int c = g * 16 + i;
    ds[i] = GS[((size_t)(c * 4 + head) * 32 + d) * 64 + v];
    dc[i] = GD[(c * 4 + head) * 32 + d];
  }
  float S = 0.f, P = 1.f;
#pragma unroll
  for (int i = 0; i < 16; ++i) { S = dc[i] * S + ds[i]; P *= dc[i]; }
  comp[(g * 32 + ei) * 2] = P;
  comp[(g * 32 + ei) * 2 + 1] = S;
  __syncthreads();
  float G = 0.f;
  for (int gg = 0; gg < g; ++gg) G = comp[(gg * 32 + ei) * 2] * G + comp[(gg * 32 + ei) * 2 + 1];
#pragma unroll
  for (int i = 0; i < 16; ++i) {
    const int c = g * 16 + i;
    GS[((size_t)(c * 4 + head) * 32 + d) * 64 + v] = G;
    G = dc[i] * G + ds[i];
  }
  __syncthreads();
}

__device__ void gla_out_item(const Params& p, int l, int item, unsigned char* smem) {
  l = opq(l); item = opq(item);
  float* tot = (float*)smem;
  float* qt = tot + 256;
  float* kt = qt + 2112;
  float* Vs = kt + 2112;
  float* Am = Vs + 4096;
  float* Ss = Am + 4160;
  const u16* PROJ = (const u16*)(p.ws + OFF_PROJ);
  u16* MIX = (u16*)(p.ws + OFF_MIX);
  const float* GS = (const float*)(p.ws + OFF_GLAS);
  const int tid = opaque_tid();
  const int chunk = item >> 2, head = item & 3;
  {
    const int d = tid & 31, ig = tid >> 5;
    float bl[8];
    gla_b(p, l, chunk, head, tot, bl);
#pragma unroll
    for (int ii = 0; ii < 8; ++ii) {
      int i = ig * 8 + ii;
      int t = chunk * 64 + i;
      float q = bf2f(PROJ[(size_t)t * NALL + 2304 + head * 32 + d]);
      float k = bf2f(PROJ[(size_t)t * NALL + 2432 + head * 32 + d]);
      qt[i * 33 + d] = q * 0.17677669529663687f * __expf(bl[ii]);
      kt[i * 33 + d] = k * __expf(-bl[ii]);
    }
  }
#pragma unroll
  for (int r = 0; r < 16; ++r) {
    int idx = tid + 256 * r;
    int i = idx >> 6, v = idx & 63;
    Vs[idx] = bf2f(PROJ[(size_t)(chunk * 64 + i) * NALL + 2560 + head * 64 + v]);
  }
#pragma unroll
  for (int r = 0; r < 8; ++r) {
    int idx = tid + 256 * r;
    Ss[idx] = GS[(size_t)(chunk * 4 + head) * 2048 + idx];
  }
  __syncthreads();
  const int j = tid & 63, ig = tid >> 6;
  {
    float acc[16];
#pragma unroll
    for (int ii = 0; ii < 16; ++ii) acc[ii] = 0.f;
    for (int d = 0; d < 32; ++d) {
      float kv = kt[j * 33 + d];
#pragma unroll
      for (int ii = 0; ii < 16; ++ii) acc[ii] += qt[(ig * 16 + ii) * 33 + d] * kv;
    }
#pragma unroll
    for (int ii = 0; ii < 16; ++ii) {
      int i = ig * 16 + ii;
      Am[i * 65 + j] = (j <= i) ? acc[ii] : 0.f;
    }
  }
  __syncthreads();
  {
    const int v = j;
    float acc[16];
#pragma unroll
    for (int ii = 0; ii < 16; ++ii) acc[ii] = 0.f;
    for (int jj = 0; jj < 64; ++jj) {
      float vv = Vs[jj * 64 + v];
#pragma unroll
      for (int ii = 0; ii < 16; ++ii) acc[ii] += Am[(ig * 16 + ii) * 65 + jj] * vv;
    }
    for (int d = 0; d < 32; ++d) {
      float sv = Ss[d * 64 + v];
#pragma unroll
      for (int ii = 0; ii < 16; ++ii) acc[ii] += qt[(ig * 16 + ii) * 33 + d] * sv;
    }
    const float nw = p.gla_nw[l * 64 + v];
#pragma unroll
    for (int ii = 0; ii < 16; ++ii) {
      int t = chunk * 64 + ig * 16 + ii;
      float o = acc[ii];
      float ms = wave_sum(o * o) * (1.f / 64.f);
      float gg = bf2f(PROJ[(size_t)t * NALL + 2816 + head * 64 + v]);
      float r = o * rsqrtf(ms + 1e-5f) * nw * silu(gg);
      MIX[(size_t)t * 1024 + 768 + head * 64 + v] = f2bf(r);
    }
  }
  __syncthreads();
}

typedef float f32x2 __attribute__((ext_vector_type(2)));
__device__ void rwkv_scan_item(const Params& p, int item, unsigned char* dsm_) {
  item = opq(item);
  float* st = (float*)dsm_;
  const int tid = opaque_tid512(), wv = tid >> 6, lane = tid & 63, rl = lane >> 4, kl = lane & 15;
  const int head = item & 3, seg = item >> 2;
  const bool ident = wv >= 4;
  const int R0 = wv * 16 + rl * 4;
  const int v0 = R0 & 63;
  const float* RWW = (const float*)(p.ws + OFF_RWW);
  const float* RWKK = (const float*)(p.ws + OFF_RWKK);
  const u16* RB = (const u16*)(p.ws + OFF_RWB);
  float* PF = (float*)(p.ws + OFF_PROJ);
  float* ZP = (float*)(p.ws + OFF_ZP);
  const int tbase = seg * SL;
  const int half = tid >> 8, ls = (tid & 255) >> 4, lc4 = (tid & 15) * 4;
  f32x2 Sa[4], Sb[4];
#pragma unroll
  for (int j = 0; j < 4; ++j) {
    Sa[j] = (f32x2){0.f, 0.f}; Sb[j] = (f32x2){0.f, 0.f};
    if (ident) {
      const int i = v0 + j;
      if ((i >> 2) == kl) {
        const int e = i & 3;
        Sa[j] = (f32x2){e == 0 ? 1.f : 0.f, e == 1 ? 1.f : 0.f};
        Sb[j] = (f32x2){e == 2 ? 1.f : 0.f, e == 3 ? 1.f : 0.f};
      }
    }
  }
  float4 g0 = make_float4(0.f, 0.f, 0.f, 0.f), g1 = g0;
  uint2 h0 = make_uint2(0u, 0u), h1 = h0, h2 = h0;
  const float* gp0 = (half == 0 ? RWW : RWKK) + (size_t)(tbase + ls) * 256 + head * 64 + lc4;
  const u16* hp = RB + (size_t)(tbase + ls) * 256 + head * 64 + lc4;
#define SCAN_GLOAD(ch) do { const size_t _o = (size_t)(ch) * 16 * 256; g0 = *(const float4*)(gp0 + _o); \
    if (half == 0) { h0 = *(const uint2*)(hp + _o); } \
    else { h0 = *(const uint2*)(hp + (size_t)T_ * 256 + _o); h1 = *(const uint2*)(hp + (size_t)3 * T_ * 256 + _o); h2 = *(const uint2*)(hp + (size_t)2 * T_ * 256 + _o); } } while (0)
#define SCAN_LSTORE(buf) do { float* _b = st + (buf) * 6144 + ls * 64 + lc4; \
    if (half == 0) { *(float4*)(_b) = g0; *(float4*)(_b + 2048) = make_float4(bflo(h0.x), bfhi(h0.x), bflo(h0.y), bfhi(h0.y)); } \
    else { *(float4*)(_b + 1024) = g0; *(float4*)(_b + 3072) = make_float4(bflo(h0.x), bfhi(h0.x), bflo(h0.y), bfhi(h0.y)); \
           *(float4*)(_b + 4096) = make_float4(bflo(h1.x), bfhi(h1.x), bflo(h1.y), bfhi(h1.y)); *(float4*)(_b + 5120) = make_float4(bflo(h2.x), bfhi(h2.x), bflo(h2.y), bfhi(h2.y)); } } while (0)
  (void)g1;
  SCAN_GLOAD(0);
  SCAN_LSTORE(0);
  __syncthreads();
  const int nch = SL / 16;
  float* yout = PF + (size_t)tbase * PROJF + (ident ? 256 : 0) + head * 64 + v0;
  for (int ch = 0; ch < nch; ++ch) {
    const int cur = ch & 1;
    if (ch + 1 < nch) SCAN_GLOAD(ch + 1);
    const float* b = st + cur * 6144;
#pragma unroll 2
    for (int s = 0; s < 16; ++s) {
      const float4 w4 = *(const float4*)(b + s * 64 + kl * 4);
      const float4 kk4 = *(const float4*)(b + 1024 + s * 64 + kl * 4);
      const float4 r4 = *(const float4*)(b + 2048 + s * 64 + kl * 4);
      const float4 k4 = *(const float4*)(b + 3072 + s * 64 + kl * 4);
      const float4 b4 = *(const float4*)(b + 4096 + s * 64 + kl * 4);
      float4 vv = make_float4(0.f, 0.f, 0.f, 0.f);
      if (!ident) vv = *(const float4*)(b + 5120 + s * 64 + v0);
      const f32x2 wa = {w4.x, w4.y}, wb = {w4.z, w4.w}, ka = {kk4.x, kk4.y}, kb = {kk4.z, kk4.w};
      const f32x2 ra = {r4.x, r4.y}, rb = {r4.z, r4.w}, ca = {k4.x, k4.y}, cb = {k4.z, k4.w}, ba = {b4.x, b4.y}, bb = {b4.z, b4.w};
      const float vj[4] = {vv.x, vv.y, vv.z, vv.w};
      float sa[4];
#pragma unroll
      for (int j = 0; j < 4; ++j) { f32x2 t = Sa[j] * ka + Sb[j] * kb; sa[j] = -(t.x + t.y); }
#pragma unroll
      for (int j = 0; j < 4; ++j) sa[j] += dpp_f<0x128>(sa[j]);
#pragma unroll
      for (int j = 0; j < 4; ++j) sa[j] += dpp_f<0x124>(sa[j]);
#pragma unroll
      for (int j = 0; j < 4; ++j) sa[j] += dpp_f<0x122>(sa[j]);
#pragma unroll
      for (int j = 0; j < 4; ++j) sa[j] += dpp_f<0x121>(sa[j]);
      float y[4];
#pragma unroll
      for (int j = 0; j < 4; ++j) {
        const f32x2 s2 = {sa[j], sa[j]}, v2 = {vj[j], vj[j]};
        Sa[j] = Sa[j] * wa + s2 * ba + v2 * ca;
        Sb[j] = Sb[j] * wb + s2 * bb + v2 * cb;
        f32x2 t = Sa[j] * ra + Sb[j] * rb;
        y[j] = t.x + t.y;
      }
#pragma unroll
      for (int j = 0; j < 4; ++j) y[j] += dpp_f<0x128>(y[j]);
#pragma unroll
      for (int j = 0; j < 4; ++j) y[j] += dpp_f<0x124>(y[j]);
#pragma unroll
      for (int j = 0; j < 4; ++j) y[j] += dpp_f<0x122>(y[j]);
#pragma unroll
      for (int j = 0; j < 4; ++j) y[j] += dpp_f<0x121>(y[j]);
      if (kl == 0) *(float4*)(yout + (size_t)(ch * 16 + s) * PROJF) = make_float4(y[0], y[1], y[2], y[3]);
    }
    if (ch + 1 < nch) SCAN_LSTORE(cur ^ 1);
    __syncthreads();
  }
#pragma unroll
  for (int j = 0; j < 4; ++j)
    *(float4*)(ZP + ((size_t)((seg * 4 + head) * 128 + R0 + j)) * 64 + kl * 4) = make_float4(Sa[j].x, Sa[j].y, Sb[j].x, Sb[j].y);
}

__device__ void rwkv_combine(const Params& p, unsigned char* dsm_) {
  float* ring = (float*)dsm_;
  float* ZP = (float*)(p.ws + OFF_ZP);
  const int tid = opaque_tid512(); const int lane = tid & 63;
  const int rowi = blockIdx.x * 8 + (tid >> 6);
  const int head = rowi >> 6, v = rowi & 63;
  float4 pa0, pa1, pa2, pa3, pb0, pb1, pb2, pb3;
  float z0, z1, z2, z3;
#define COMB_ONE(stg_, q, PA, PB, Z) do { const float* base = ZP + (size_t)((((stg_) * 4 + q) * 4 + head) * 128) * 64; \
      PA = ((const float4*)(base + 4096))[tid]; PB = ((const float4*)(base + 4096))[tid + 512]; Z = base[v * 64 + lane]; } while (0)
#define COMB_ISSUE(stg_) do { COMB_ONE(stg_, 0, pa0, pb0, z0); COMB_ONE(stg_, 1, pa1, pb1, z1); COMB_ONE(stg_, 2, pa2, pb2, z2); COMB_ONE(stg_, 3, pa3, pb3, z3); } while (0)
#define COMB_SEG(q, ZC) do { const int seg = stg * 4 + q; \
      ZP[((size_t)((seg * 4 + head) * 128 + v)) * 64 + lane] = s; \
      float ns0 = ZC, ns1 = 0.f; const float* P = buf + q * 4096 + lane; \
      _Pragma("unroll") for (int i = 0; i < 64; i += 2) { \
        float s0 = __builtin_bit_cast(float, __builtin_amdgcn_readlane(__builtin_bit_cast(int, s), i)); \
        float s1 = __builtin_bit_cast(float, __builtin_amdgcn_readlane(__builtin_bit_cast(int, s), i + 1)); \
        ns0 += s0 * P[i * 64]; ns1 += s1 * P[(i + 1) * 64]; } \
      s = ns0 + ns1; } while (0)
  COMB_ISSUE(0);
  float s = 0.f;
#pragma unroll 1
  for (int stg = 0; stg < NSEG / 4; ++stg) {
    float* buf = ring + (stg & 1) * 16384;
    ((float4*)(buf))[tid] = pa0; ((float4*)(buf))[tid + 512] = pb0;
    ((float4*)(buf + 4096))[tid] = pa1; ((float4*)(buf + 4096))[tid + 512] = pb1;
    ((float4*)(buf + 8192))[tid] = pa2; ((float4*)(buf + 8192))[tid + 512] = pb2;
    ((float4*)(buf + 12288))[tid] = pa3; ((float4*)(buf + 12288))[tid + 512] = pb3;
    const float c0 = z0, c1 = z1, c2 = z2, c3 = z3;
    __syncthreads();
    if (stg + 1 < NSEG / 4) COMB_ISSUE(stg + 1);
    COMB_SEG(0, c0); COMB_SEG(1, c1); COMB_SEG(2, c2); COMB_SEG(3, c3);
  }
  __syncthreads();
}

__device__ void rwkv_final_item(const Params& p, int l, int item, unsigned char* smem) {
  l = opq(l); item = opq(item);
  float* Ss = (float*)smem;
  float* rho = Ss + 4160;
  const int tid = opaque_tid(), v = tid & 63, tg = tid >> 6;
  const int tiles = SL / 64;
  const int q = item % tiles, head = (item / tiles) & 3, seg = item / (tiles * 4);
  const int t0 = seg * SL + q * 64;
  const float* ZP = (const float*)(p.ws + OFF_ZP);
  const float* PF = (const float*)(p.ws + OFF_PROJ);
  const u16* PROJ = (const u16*)(p.ws + OFF_PROJ);
  const u16* RBv = (const u16*)(p.ws + OFF_RWB) + (size_t)2 * T_ * 256;
  const float* BON = (const float*)(p.ws + OFF_BONUS);
  u16* MIX = (u16*)(p.ws + OFF_MIX);
#pragma unroll
  for (int r = 0; r < 16; ++r) {
    int idx = tid + 256 * r;
    int row = idx >> 6, col = idx & 63;
    Ss[row * 65 + col] = ZP[((size_t)((seg * 4 + head) * 128 + row)) * 64 + col];
    rho[idx] = PF[(size_t)(t0 + row) * PROJF + 256 + head * 64 + col];
  }
  __syncthreads();
  const int c = head * 64 + v;
  const float lnw = p.ln_w[l * 256 + c], lnb = p.ln_b[l * 256 + c];
#pragma unroll 1
  for (int hh = 0; hh < 2; ++hh) {
    const int tb = tg * 16 + hh * 8;
    float acc[8];
#pragma unroll
    for (int tt = 0; tt < 8; ++tt) acc[tt] = PF[(size_t)(t0 + tb + tt) * PROJF + head * 64 + v];
#pragma unroll 2
    for (int i4 = 0; i4 < 16; ++i4) {
      float s0 = Ss[v * 65 + 4 * i4], s1 = Ss[v * 65 + 4 * i4 + 1], s2 = Ss[v * 65 + 4 * i4 + 2], s3 = Ss[v * 65 + 4 * i4 + 3];
#pragma unroll
      for (int tt = 0; tt < 8; ++tt) {
        float4 rv = *(const float4*)(rho + (tb + tt) * 64 + 4 * i4);
        acc[tt] += s0 * rv.x + s1 * rv.y + s2 * rv.z + s3 * rv.w;
      }
    }
#pragma unroll
    for (int tt = 0; tt < 8; ++tt) {
      int t = t0 + tb + tt;
      float y = acc[tt];
      float mean = wave_sum(y) * (1.f / 64.f);
      float dlt = y - mean;
      float var = wave_sum(dlt * dlt) * (1.f / 64.f);
      float o = dlt * rsqrtf(var + 64e-5f) * lnw + lnb;
      o += BON[t * 4 + head] * bf2f(RBv[(size_t)t * 256 + c]);
      float g = bf2f(PROJ[(size_t)t * NALL + 2048 + c]);
      MIX[(size_t)t * 1024 + 512 + c] = f2bf(o * silu(g));
    }
  }
  __syncthreads();
}

#define LDS_BYTES (131072 + 16)
#ifndef REP_G1
#define REP_G1 1
#endif
#ifndef REP_G2
#define REP_G2 1
#endif
#ifndef REP_P3
#define REP_P3 1
#endif
#ifndef REP_SCAN
#define REP_SCAN 1
#endif
#ifndef REP_GO
#define REP_GO 1
#endif
#ifndef REP_FIN
#define REP_FIN 1
#endif
#define PAIR_LOOP(N, BODY) for (int _pr = blockIdx.x; _pr < (N) / 2; _pr += gridDim.x) { const int it = 2 * _pr + vb; BODY }
__global__ void __launch_bounds__(512) fwd_megakernel(Params p) {
  cg::grid_group grid = cg::this_grid();
  extern __shared__ __attribute__((aligned(16))) unsigned char dsm[];
  const int vb = __builtin_amdgcn_readfirstlane(threadIdx.x >> 8);
  unsigned char* smem = dsm + vb * 65536;
  if (threadIdx.x == 0) *(uint4*)(dsm + 131072) = make_uint4(0u, 0u, 0u, 0u);
  __syncthreads();
  const XcdBarrier xb = xcd_barrier_post((unsigned*)(p.ws + OFF_BAR), (volatile LAS unsigned*)(dsm + 131072));
#define GSYNC() xcd_barrier(xb)
#ifndef PH
#define PH 0xffff
#endif
  if (PH & 1) PAIR_LOOP(384, phase_mod_item(p, it, smem);)
  if (PH & 2) PAIR_LOOP(4480, phase_wconv_item(p, it, smem);)
  grid.sync();
  if (PH & 4) phase_h0(p);
  GSYNC();
#pragma unroll 1
  for (int hl = 0; hl < 8; ++hl) {
    const int l = hl >> 1;
    const bool second = hl & 1;
    if (PH & 8) {
      pg8::Gemm g; g.M = T_; g.K = 1024;
      pg8::EpiU E; E.O = (void*)(p.ws + OFF_PROJ);
      if (!second) { g.A = (const u16*)(p.ws + OFF_H); g.Bt = (const u16*)(p.ws + OFF_WALL) + (size_t)l * NALL * 1024; g.N = 3584; E.ldc = NALL; E.ncols = NALL; E.f32out = 0; }
      else { g.A = (const u16*)(p.ws + OFF_MIX); g.Bt = (const u16*)(p.ws + OFF_WOUT) + (size_t)l * 1024 * 1024; g.N = 1024; E.ldc = 1024; E.ncols = 1024; E.f32out = 1; }
      pg8::StaticOrder S; S.init(T_, g.N, gridDim.x, blockIdx.x);
      const int nrep = second ? REP_G2 : REP_G1;
#pragma unroll 1
      for (int rep = 0; rep < nrep; ++rep)
      pg8::gemm_phase<pg8::EpiU, pg8::StaticOrder, false>((PG8_LAS unsigned char*)dsm, g, S, E, nullptr);
    }
    GSYNC();
    if (!second) {
#pragma unroll 1
      for (int rep = 0; rep < REP_P3; ++rep)
      PAIR_LOOP(3072,
        if (it < 1024) { if (PH & 16) attn_item(p, l, it, smem); }
        else if (it < 2048) { if (PH & 32) rwkv_prep_item(p, l, it - 1024, smem); }
        else { if (PH & 64) gla_local_item(p, l, it - 2048, smem); }
      )
      GSYNC();
      if (PH & 128) for (int eb = blockIdx.x; eb < 256; eb += gridDim.x) gla_state_block(p, eb, dsm);
#pragma unroll 1
      for (int rep = 0; rep < REP_SCAN; ++rep)
      if (PH & 256) for (int it = blockIdx.x; it < NSEG * 4; it += gridDim.x) rwkv_scan_item(p, it, dsm);
      GSYNC();
      if (blockIdx.x < 32) { if (PH & 512) rwkv_combine(p, dsm); }
#pragma unroll 1
      for (int rep = 0; rep < REP_GO; ++rep)
      if (PH & 1024) PAIR_LOOP(1024, gla_out_item(p, l, it, smem);)
      GSYNC();
#pragma unroll 1
      for (int rep = 0; rep < REP_FIN; ++rep)
      if (PH & 2048) PAIR_LOOP(NSEG * 4 * (SL / 64), rwkv_final_item(p, l, it, smem);)
      GSYNC();
    } else {
      if (PH & 8192) phase_post(p, l);
      if (hl < 7) GSYNC();
    }
  }
}

extern "C" void kernel_launch(void* const* d_in, const int* in_sizes, int n_in, void* d_out, int out_size, void* d_ws, size_t ws_size,
                              hipStream_t stream) {
  static int grid_blocks = 0;
  if (!grid_blocks) {
    int dev = 0, cus = 0, per_cu = 0;
    (void)hipGetDevice(&dev);
    (void)hipDeviceGetAttribute(&cus, hipDeviceAttributeMultiprocessorCount, dev);
    (void)hipFuncSetAttribute((const void*)fwd_megakernel, hipFuncAttributeMaxDynamicSharedMemorySize, LDS_BYTES);
    (void)hipOccupancyMaxActiveBlocksPerMultiprocessor(&per_cu, fwd_megakernel, 512, LDS_BYTES);
    if (per_cu < 1) per_cu = 1;
    grid_blocks = cus;
    if (grid_blocks < 32) grid_blocks = 32;
  }
  if (n_in != 27 || ws_size < WS_END) {
    fprintf(stderr, "kernel_launch: unexpected n_in %d / ws %zu\n", n_in, ws_size);
    return;
  }
  Params p{};
  const float** pp = (const float**)&p;
  for (int i = 0; i < 27; ++i) pp[i] = (const float*)d_in[i];
  p.out = (float*)d_out;
  p.ws = (unsigned char*)d_ws;
  (void)hipMemsetAsync((unsigned char*)d_ws + OFF_BAR, 0, XCD_BAR_WORDS * 4, stream);
  void* args[] = {&p};
  hipError_t e = hipLaunchCooperativeKernel((void*)fwd_megakernel, dim3(grid_blocks), dim3(512), args, LDS_BYTES, stream);
  if (e != hipSuccess) fprintf(stderr, "cooperative launch failed: %s (grid %d)\n", hipGetErrorString(e), grid_blocks);
}
```

```cpp
#include <hip/hip_runtime.h>
#include <hip/hip_bf16.h>
#include <hip/hip_cooperative_groups.h>
#include <cstdio>
namespace cg = cooperative_groups;

typedef unsigned short u16;
using bf16x8 = __attribute__((ext_vector_type(8))) short;
using f32x4 = __attribute__((ext_vector_type(4))) float;
using f32x16 = __attribute__((ext_vector_type(16))) float;

#define T_ 16384
#define NALL 3456
#define NSEG 64
#define SL (T_ / NSEG)
#define PROJF 1728

#define OFF_WALL 0ull
#define OFF_WOUT 28311552ull
#define OFF_MOD 36700160ull
#define OFF_H 36749312ull
#define OFF_RWW OFF_H
#define OFF_RWKK (OFF_H + 16777216ull)
#define OFF_PROJ 70303744ull
#define OFF_MIX 183549952ull
#define OFF_RWB 217104384ull
#define OFF_GLAS 250658816ull
#define OFF_GLAD 259047424ull
#define OFF_BONUS 259178496ull
#define OFF_ZP 259440640ull
#define OFF_BAR 267829248ull
#define WS_END 267845632ull


struct Params {
  const float *x, *c, *ada_w, *ada_b, *norm_pre, *norm_post, *w_in, *w_out, *sinks, *mu_rkv, *mu_w, *mu_a, *w0, *w1, *w2,
      *a0, *a1, *a2, *k_k, *k_a, *r_k, *ln_w, *ln_b, *gk1, *gk2, *gk_b, *gla_nw;
  float* out;
  unsigned char* ws;
};

__device__ __forceinline__ u16 f2bf(float f) {
  unsigned u = __float_as_uint(f);
  u += 0x7fffu + ((u >> 16) & 1u);
  return (u16)(u >> 16);
}
__device__ __forceinline__ float bf2f(u16 h) { return __uint_as_float(((unsigned)h) << 16); }
__device__ __forceinline__ unsigned pack2(float a, float b) { return (unsigned)f2bf(a) | ((unsigned)f2bf(b) << 16); }
__device__ __forceinline__ float bflo(unsigned u) { return __uint_as_float(u << 16); }
__device__ __forceinline__ float bfhi(unsigned u) { return __uint_as_float(u & 0xffff0000u); }
__device__ __forceinline__ float wave_sum(float v) {
#pragma unroll
  for (int o = 32; o > 0; o >>= 1) v += __shfl_xor(v, o);
  return v;
}
__device__ __forceinline__ float silu(float x) { return x / (1.f + __expf(-x)); }
__device__ __forceinline__ float sigmoidf_(float x) { return 1.f / (1.f + __expf(-x)); }
__device__ __forceinline__ float softplusf_(float z) { return fmaxf(z, 0.f) + log1pf(__expf(-fabsf(z))); }

__device__ __forceinline__ int opq(int x) { asm volatile("" : "+s"(x)); return x; }
__device__ __forceinline__ int opaque_tid() { int t = threadIdx.x & 255; asm volatile("" : "+v"(t)); return t; }
__device__ __forceinline__ int opaque_tid512() { int t = threadIdx.x; asm volatile("" : "+v"(t)); return t; }
template <int CTRL>
__device__ __forceinline__ float dpp_f(float x) {
  return __builtin_bit_cast(float, __builtin_amdgcn_update_dpp(0, __builtin_bit_cast(int, x), CTRL, 0xf, 0xf, true));
}
__device__ __forceinline__ float row16_allsum(float x) {
  x += dpp_f<0x128>(x);
  x += dpp_f<0x124>(x);
  x += dpp_f<0x122>(x);
  x += dpp_f<0x121>(x);
  return x;
}

namespace pg8 {
#define PG8_LAS __attribute__((address_space(3)))
typedef unsigned short bf16_t;
typedef short bf16x8 __attribute__((ext_vector_type(8)));
typedef float f32x4 __attribute__((ext_vector_type(4)));
typedef unsigned u32x4 __attribute__((ext_vector_type(4)));
constexpr int BM = 256, BK = 64, HALF = 128, HTB = HALF * BK * 2  , STAGE_BYTES = 8 * HTB, NXCD = 8, WGM = 8;

__host__ __device__ __forceinline__ int lds_byte(int r, int c) { const int st = (r >> 4) * 2 + (c >> 5), rr = r & 15, cc = c & 31, ob = rr * 64 + cc * 2; return st * 1024 + (ob ^ (((ob >> 9) & 1) << 5)); }
__host__ __device__ __forceinline__ void stage_rc(int b, int& R, int& C) { const int st = b / 1024, sb = b % 1024, swz = sb ^ (((sb >> 9) & 1) << 5); R = (st >> 1) * 16 + swz / 64; C = (st & 1) * 32 + (swz % 64) / 2; }
__host__ __device__ __forceinline__ int perm32(int rho) { const int n = rho >> 4, i = rho & 15; return 8 * (i >> 2) + 4 * n + (i & 3); }

struct Unit { int pm, pn; };
struct Gemm { const bf16_t* A; const bf16_t* Bt; int M, N, K; };

struct StaticOrder {
    int nM, nN, nwg, G, c;
    __host__ __device__ void init(int M, int N, int G_, int c_) { nM = M / BM; nN = N / BM; nwg = nM * nN; G = G_; c = c_; }
    __host__ __device__ bool next(int i, Unit& u) const {
        const long L = (long)i * G + c; if (L >= nwg) return false;
        int wgid = (int)L; { const int q = nwg / NXCD, r = nwg % NXCD, xcd = wgid % NXCD, off = wgid / NXCD; wgid = (xcd < r ? xcd * (q + 1) : r * (q + 1) + (xcd - r) * q) + off; }
        const int nig = WGM * nN, gid = wgid / nig, fm = gid * WGM, gsz = (nM - fm) < WGM ? (nM - fm) : WGM;
        u.pm = fm + ((wgid % nig) % gsz); u.pn = (wgid % nig) / gsz; return true;
    }
    __device__ __forceinline__ void a_ready(const Unit&) const {}
    __device__ __forceinline__ void done(const Unit&) const {}
};
__device__ __forceinline__ unsigned cvt_pk_bf16(float lo, float hi) { unsigned r; asm volatile("v_cvt_pk_bf16_f32 %0, %1, %2" : "=v"(r) : "v"(lo), "v"(hi)); return r; }
template <class Epi, class Sched, bool STAMP = false>
__device__ __forceinline__ void gemm_phase(PG8_LAS unsigned char* lds, const Gemm g, const Sched& S, const Epi& E, unsigned long long* stamps) {
    const int tid = threadIdx.x, wid = __builtin_amdgcn_readfirstlane(tid >> 6), lane = tid & 63, wr = wid >> 2, wc = wid & 3, fr = lane & 15, fq = lane >> 4;
    const int K = g.K, nt = K / BK;
    int ts_lo = 0, ts_hi = 0, nts = 0; const unsigned long long rt_entry = STAMP ? (unsigned long long)wall_clock64() : 0ull;
#define PG8_STAMP() do { if (STAMP && wid == 0 && nts < 64) { const unsigned long long _c = (unsigned long long)clock64(); \
        ts_lo = (lane == nts) ? (int)(unsigned)_c : ts_lo; ts_hi = (lane == nts) ? (int)(unsigned)(_c >> 32) : ts_hi; ++nts; } } while (0)
    PG8_STAMP();
    unsigned voffA[2], voffB[2];
#pragma unroll
    for (int i = 0; i < 2; ++i) { int R, C; stage_rc(tid * 16 + i * 8192, R, C); const int Rb = Epi::PERM ? ((R & ~31) + perm32(R & 31)) : R;
        voffA[i] = (unsigned)(R * K + C) * 2u; voffB[i] = (unsigned)(Rb * K + C) * 2u; }
    const size_t kstep = (size_t)(BK * 2);
    const size_t hstep = (size_t)HALF * K * 2;
    const size_t tstep = 2 * hstep;
    const unsigned ldsw = (unsigned)wid * 1024u;
    const int aoff = lds_byte(wr * 64 + fr, fq * 8), boff = lds_byte(wc * 32 + fr, fq * 8);
#define PG8_SA(b, h) (((b) * 2 + (h)) * HTB)
#define PG8_SB(b, h) ((4 + (b) * 2 + (h)) * HTB)
#define PG8_STAGE(bufoff, gbase, voff) do { _Pragma("unroll") for (int _i = 0; _i < 2; ++_i) \
        __builtin_amdgcn_global_load_lds((const unsigned*)((const char*)(gbase) + (voff)[_i]), (PG8_LAS unsigned*)(lds + (bufoff) + ldsw + _i * 8192), 16, 0, 0); } while (0)
#define PG8_LDA(dst, b, h) do { _Pragma("unroll") for (int m = 0; m < 4; ++m) _Pragma("unroll") for (int k = 0; k < 2; ++k) dst[m][k] = *(const PG8_LAS bf16x8*)(lds + PG8_SA(b, h) + aoff + m * 2048 + k * 1024); } while (0)
#define PG8_LDB(dst, b, h) do { _Pragma("unroll") for (int n = 0; n < 2; ++n) _Pragma("unroll") for (int k = 0; k < 2; ++k) dst[n][k] = *(const PG8_LAS bf16x8*)(lds + PG8_SB(b, h) + boff + n * 2048 + k * 1024); } while (0)
#define PG8_MMA(ai, bj, At, Bt) do { __builtin_amdgcn_s_setprio(1); _Pragma("unroll") for (int m = 0; m < 4; ++m) _Pragma("unroll") for (int n = 0; n < 2; ++n) _Pragma("unroll") for (int k = 0; k < 2; ++k) \
        acc[ai][bj][m][n] = __builtin_amdgcn_mfma_f32_16x16x32_bf16(Bt[n][k], At[m][k], acc[ai][bj][m][n], 0, 0, 0); __builtin_amdgcn_s_setprio(0); } while (0)
#define PG8_WAIT_V(n) asm volatile("s_waitcnt vmcnt(" #n ")" ::: "memory")
#define PG8_WAIT_L(n) asm volatile("s_waitcnt lgkmcnt(" #n ")" ::: "memory")
#define PG8_BAR __builtin_amdgcn_s_barrier()
#define PG8_SCHED __builtin_amdgcn_sched_barrier(0)
    Unit cur, nxt; int ui = 0;
    if (!S.next(0, cur)) return;
    f32x4 acc[2][2][4][2];
#pragma unroll
    for (int a = 0; a < 2; ++a)
#pragma unroll
        for (int b = 0; b < 2; ++b)
#pragma unroll
            for (int m = 0; m < 4; ++m)
#pragma unroll
                for (int n = 0; n < 2; ++n) acc[a][b][m][n] = (f32x4){0.f, 0.f, 0.f, 0.f};
    bf16x8 At[4][2], B0[2][2], B1[2][2];
    const char* cA = (const char*)g.A + (size_t)cur.pm * tstep; const char* cB = (const char*)g.Bt + (size_t)cur.pn * tstep;
    S.a_ready(cur);
    PG8_STAGE(PG8_SB(0, 0), cB, voffB); PG8_STAGE(PG8_SA(0, 0), cA, voffA); PG8_STAGE(PG8_SB(0, 1), cB + hstep, voffB); PG8_STAGE(PG8_SA(0, 1), cA + hstep, voffA);
    if (wr == 1) PG8_BAR;
    PG8_WAIT_V(4); PG8_BAR;
    PG8_STAGE(PG8_SB(1, 0), cB + kstep, voffB); PG8_STAGE(PG8_SA(1, 0), cA + kstep, voffA); PG8_STAGE(PG8_SB(1, 1), cB + hstep + kstep, voffB);
    PG8_WAIT_V(6); PG8_BAR;
    PG8_STAMP();
    for (;;) {
        const bool has_next = S.next(ui + 1, nxt);
        const char* nA = has_next ? (const char*)g.A + (size_t)nxt.pm * tstep : cA; const char* nB = has_next ? (const char*)g.Bt + (size_t)nxt.pn * tstep : cB;
        for (int t = 0; t < nt; t += 2) {
            const bool last = (t == nt - 2);
            const char* a1 = cA + (size_t)(t + 1) * kstep;
            const char* a2 = last ? nA : cA + (size_t)(t + 2) * kstep; const char* b2 = last ? nB : cB + (size_t)(t + 2) * kstep;
            const char* a3 = a2 + kstep; const char* b3 = b2 + kstep;
            if (last && has_next) S.a_ready(nxt);
            PG8_LDB(B0, 0, 0); PG8_SCHED; PG8_LDA(At, 0, 0); PG8_STAGE(PG8_SA(1, 1), a1 + hstep, voffA);
            PG8_WAIT_L(8); PG8_BAR; PG8_WAIT_L(0); PG8_MMA(0, 0, At, B0); PG8_BAR; PG8_SCHED;
            PG8_LDB(B1, 0, 1); PG8_STAGE(PG8_SB(0, 0), b2, voffB);
            PG8_BAR; PG8_WAIT_L(0); PG8_MMA(0, 1, At, B1); PG8_BAR;
            PG8_LDA(At, 0, 1); PG8_STAGE(PG8_SA(0, 0), a2, voffA);
            PG8_BAR; PG8_WAIT_L(0); PG8_MMA(1, 0, At, B0); PG8_BAR; PG8_SCHED;
            PG8_STAGE(PG8_SB(0, 1), b2 + hstep, voffB);
            PG8_WAIT_V(6); PG8_BAR; PG8_MMA(1, 1, At, B1); PG8_BAR;
            PG8_LDB(B0, 1, 0); PG8_SCHED; PG8_LDA(At, 1, 0); PG8_STAGE(PG8_SA(0, 1), a2 + hstep, voffA);
            PG8_WAIT_L(8); PG8_BAR; PG8_WAIT_L(0); PG8_MMA(0, 0, At, B0); PG8_BAR; PG8_SCHED;
            PG8_LDB(B1, 1, 1); PG8_STAGE(PG8_SB(1, 0), b3, voffB);
            PG8_BAR; PG8_WAIT_L(0); PG8_MMA(0, 1, At, B1); PG8_BAR;
            PG8_LDA(At, 1, 1); PG8_STAGE(PG8_SA(1, 0), a3, voffA);
            PG8_BAR; PG8_WAIT_L(0); PG8_MMA(1, 0, At, B0); PG8_BAR; PG8_SCHED;
            PG8_STAGE(PG8_SB(1, 1), b3 + hstep, voffB);
            PG8_WAIT_V(6); PG8_BAR; PG8_MMA(1, 1, At, B1); PG8_BAR;
        }
        PG8_STAMP();
        if constexpr (!Epi::AFTER_DRAIN) { E(acc, cur, wr, wc, fr, fq); S.done(cur); }
        PG8_STAMP();
        if (!has_next) break;
#pragma unroll
        for (int a = 0; a < 2; ++a)
#pragma unroll
            for (int b = 0; b < 2; ++b)
#pragma unroll
                for (int m = 0; m < 4; ++m)
#pragma unroll
                    for (int n = 0; n < 2; ++n) acc[a][b][m][n] = (f32x4){0.f, 0.f, 0.f, 0.f};
        cur = nxt; cA = nA; cB = nB; ++ui;
    }
    PG8_WAIT_V(0);
    if (wr == 0) PG8_BAR;
    PG8_BAR;
    if constexpr (Epi::AFTER_DRAIN) { E.fused(acc, cur, wr, wc, fr, fq, lds, wid, lane); S.done(cur); }
    PG8_STAMP();
    if (STAMP && wid == 0) { stamps[lane] = lane < nts ? (((unsigned long long)(unsigned)ts_hi << 32) | (unsigned)ts_lo) : 0ull;
        if (lane == 62) stamps[62] = rt_entry; if (lane == 63) stamps[63] = (unsigned long long)wall_clock64(); }
#undef PG8_STAMP
#undef PG8_SA
#undef PG8_SB
#undef PG8_STAGE
#undef PG8_LDA
#undef PG8_LDB
#undef PG8_MMA
#undef PG8_WAIT_V
#undef PG8_WAIT_L
#undef PG8_BAR
#undef PG8_SCHED
}
}

namespace pg8 {
struct EpiProj {
    static constexpr bool PERM = true, AFTER_DRAIN = false;
    bf16_t* O; int ldc; int ncols;
    __device__ __forceinline__ void operator()(const f32x4 (&acc)[2][2][4][2], const Unit& u, int wr, int wc, int fr, int fq) const {
        const int row0 = u.pm * BM + wr * 64 + fr; const int col0 = u.pn * BM + wc * 32 + 8 * fq;
#pragma unroll
        for (int ai = 0; ai < 2; ++ai)
#pragma unroll
            for (int m = 0; m < 4; ++m) { bf16_t* rowp = O + (size_t)(row0 + ai * HALF + m * 16) * ldc + col0;
#pragma unroll
                for (int bj = 0; bj < 2; ++bj) { const f32x4 v0 = acc[ai][bj][m][0], v1 = acc[ai][bj][m][1];
                    u32x4 w; w.x = cvt_pk_bf16(v0[0], v0[1]); w.y = cvt_pk_bf16(v0[2], v0[3]); w.z = cvt_pk_bf16(v1[0], v1[1]); w.w = cvt_pk_bf16(v1[2], v1[3]);
                    if (col0 + bj * HALF < ncols) *(u32x4*)(rowp + bj * HALF) = w; } }
    }
};
struct EpiU {
    static constexpr bool PERM = true, AFTER_DRAIN = false;
    void* O; int ldc; int ncols; int f32out;
    __device__ __forceinline__ void operator()(const f32x4 (&acc)[2][2][4][2], const Unit& u, int wr, int wc, int fr, int fq) const {
        const int row0 = u.pm * BM + wr * 64 + fr; const int col0 = u.pn * BM + wc * 32 + 8 * fq;
        if (f32out) {
#pragma unroll
            for (int ai = 0; ai < 2; ++ai)
#pragma unroll
                for (int m = 0; m < 4; ++m) { float* rowp = (float*)O + (size_t)(row0 + ai * HALF + m * 16) * ldc + col0;
#pragma unroll
                    for (int bj = 0; bj < 2; ++bj) { *(f32x4*)(rowp + bj * HALF) = acc[ai][bj][m][0]; *(f32x4*)(rowp + bj * HALF + 4) = acc[ai][bj][m][1]; } }
        } else {
#pragma unroll
            for (int ai = 0; ai < 2; ++ai)
#pragma unroll
                for (int m = 0; m < 4; ++m) { bf16_t* rowp = (bf16_t*)O + (size_t)(row0 + ai * HALF + m * 16) * ldc + col0;
#pragma unroll
                    for (int bj = 0; bj < 2; ++bj) { const f32x4 v0 = acc[ai][bj][m][0], v1 = acc[ai][bj][m][1];
                        u32x4 w; w.x = cvt_pk_bf16(v0[0], v0[1]); w.y = cvt_pk_bf16(v0[2], v0[3]); w.z = cvt_pk_bf16(v1[0], v1[1]); w.w = cvt_pk_bf16(v1[2], v1[3]);
                        if (col0 + bj * HALF < ncols) *(u32x4*)(rowp + bj * HALF) = w; } }
        }
    }
};
}

#define XB_TMO      128
#define XB_XCNT(j)  (256  + 64 * (j))
#define XB_XSUB(j)  (1280 + 64 * (j))
#define XB_XGEN(j)  (2304 + 64 * (j))
#define XB_TOP      3328
#define XB_TOPGEN   3392
#define XCD_BAR_WORDS 3456
#define XB_SPIN_CAP (1u << 18)
#define LAS __attribute__((address_space(3)))

__device__ __forceinline__ unsigned xb_ld(unsigned* p)              { return __hip_atomic_load(p, __ATOMIC_RELAXED, __HIP_MEMORY_SCOPE_AGENT); }
__device__ __forceinline__ unsigned xb_add(unsigned* p, unsigned v) { return __hip_atomic_fetch_add(p, v, __ATOMIC_RELAXED, __HIP_MEMORY_SCOPE_AGENT); }
__device__ __forceinline__ unsigned xb_xcc_id() { return (unsigned)__builtin_amdgcn_s_getreg((3 << 11) | 20) & 0xFu; }
#define XB_SPIN(cond, bar) do { unsigned _sp = 0; while (cond) { __builtin_amdgcn_s_sleep(1); \
    if ((++_sp & 255u) == 0u) { if (xb_ld(&(bar)[XB_TMO])) break; if (_sp > XB_SPIN_CAP) { atomicAdd(&(bar)[XB_TMO], 1u); break; } } } } while (0)

struct XcdBarrier {
    unsigned* bar; unsigned x;
    volatile LAS unsigned* st;
};

__device__ __forceinline__ XcdBarrier xcd_barrier_post(unsigned* bar, volatile LAS unsigned* st) {
    XcdBarrier b; b.bar = bar; b.x = xb_xcc_id(); b.st = st;
    if (threadIdx.x == 0) (void)xb_add(&bar[XB_XCNT(b.x)], 1u);
    return b;
}
__device__ __forceinline__ void xcd_barrier_complete(unsigned* bar, unsigned x, unsigned& nloc, unsigned& nx) {
    const unsigned G = gridDim.x * gridDim.y * gridDim.z;
    unsigned sum, cnt, mine, sp = 0u;
    for (;;) {
        sum = 0u; cnt = 0u; mine = 0u;
#pragma unroll
        for (unsigned j = 0; j < 16; ++j) { const unsigned c = xb_ld(&bar[XB_XCNT(j)]); sum += c; cnt += (c > 0u) ? 1u : 0u; mine = (j == x) ? c : mine; }
        if (sum == G) break;
        __builtin_amdgcn_s_sleep(1);
        if ((++sp & 255u) == 0u) { if (xb_ld(&bar[XB_TMO])) break; if (sp > XB_SPIN_CAP) { atomicAdd(&bar[XB_TMO], 1u); break; } }
    }
    nloc = mine > 0u ? mine : 1u; nx = cnt > 0u ? cnt : 1u;
}

__device__ __forceinline__ void xcd_barrier(const XcdBarrier& b) {
    asm volatile("s_waitcnt vmcnt(0)" ::: "memory");
    __syncthreads();
    if (threadIdx.x == 0) {
        unsigned* bar = b.bar;
        __builtin_amdgcn_s_waitcnt(0);
        unsigned nloc = b.st[0], nx = b.st[1];
        if (nloc == 0u) { xcd_barrier_complete(bar, b.x, nloc, nx); b.st[0] = nloc; b.st[1] = nx; }
        const unsigned old = xb_add(&bar[XB_XSUB(b.x)], 1u);
        const unsigned gen = old / nloc;
        if (old + 1u == (gen + 1u) * nloc) {
            __builtin_amdgcn_fence(__ATOMIC_RELEASE, "agent");
            asm volatile("s_waitcnt vmcnt(0)" ::: "memory");
            const unsigned og = xb_add(&bar[XB_TOP], 1u);
            const unsigned tg = og / nx;
            if (og + 1u == (tg + 1u) * nx) xb_add(&bar[XB_TOPGEN], 1u);
            else XB_SPIN(xb_ld(&bar[XB_TOPGEN]) == tg, bar);
            __builtin_amdgcn_fence(__ATOMIC_ACQUIRE, "agent");
            xb_add(&bar[XB_XGEN(b.x)], 1u);
            asm volatile("s_waitcnt vmcnt(0)" ::: "memory");
        } else {
            XB_SPIN(xb_ld(&bar[XB_XGEN(b.x)]) == gen, bar);
            __builtin_amdgcn_fence(__ATOMIC_ACQUIRE, "agent");
            asm volatile("s_waitcnt vmcnt(0)" ::: "memory");
        }
    }
    __syncthreads();
}

__device__ void phase_mod_item(const Params& p, int it, unsigned char* smem) {
  float* red = (float*)smem;
  const int tid = opaque_tid(), tx = tid & 31, ty = tid >> 5;
  float* mod = (float*)(p.ws + OFF_MOD);
  it = opq(it);
  {
    int l = it / 96;
    int j = (it % 96) * 32 + tx;
    const float* W = p.ada_w + (size_t)l * 1024 * 3072;
    float acc = 0.f;
    for (int i = 0; i < 128; ++i) {
      int k = ty * 128 + i;
      float cv = p.c[k];
      acc += silu(cv) * W[(size_t)k * 3072 + j];
    }
    red[ty * 32 + tx] = acc;
    __syncthreads();
    if (ty == 0) {
      float s = 0.f;
      for (int g = 0; g < 8; ++g) s += red[g * 32 + tx];
      mod[l * 3072 + j] = s + p.ada_b[l * 3072 + j];
    }
    __syncthreads();
  }
}

__device__ __forceinline__ float wall_src(const Params& p, int l, int k, int n) {
  size_t lk = (size_t)l * 1024 + k;
  if (n < 3072) return p.w_in[lk * 3072 + n];
  if (n < 3136) return (1.f - p.mu_w[lk]) * p.w1[lk * 64 + (n - 3072)];
  if (n < 3200) return p.mu_w[lk] * p.w1[lk * 64 + (n - 3136)];
  if (n < 3264) return (1.f - p.mu_a[lk]) * p.a1[lk * 64 + (n - 3200)];
  if (n < 3328) return p.mu_a[lk] * p.a1[lk * 64 + (n - 3264)];
  if (n < 3344) return p.gk1[lk * 16 + (n - 3328)];
  return 0.f;
}

__device__ void phase_wconv_item(const Params& p, int it, unsigned char* smem) {
  float* tile = (float*)smem;
  const int tid = opaque_tid();
  u16* WALL = (u16*)(p.ws + OFF_WALL);
  u16* WOUT = (u16*)(p.ws + OFF_WOUT);
  it = opq(it);
  {
    bool isout = it >= 3456;
    int l, nt, kt;
    if (!isout) { l = it / 864; int r = it % 864; nt = r >> 4; kt = r & 15; }
    else { int r = it - 3456; l = r >> 8; r &= 255; nt = r >> 4; kt = r & 15; }
    int tx = tid & 63, ty = tid >> 6;
#pragma unroll 4
    for (int i = 0; i < 16; ++i) {
      int kl = ty + 4 * i;
      int k = kt * 64 + kl, n = nt * 64 + tx;
      float v = isout ? p.w_out[((size_t)l * 1024 + k) * 1024 + n] : wall_src(p, l, k, n);
      tile[kl * 65 + tx] = v;
    }
    __syncthreads();
    int nl = tid >> 2, kq = tid & 3;
    unsigned w[8];
#pragma unroll
    for (int j = 0; j < 8; ++j) w[j] = pack2(tile[(kq * 16 + 2 * j) * 65 + nl], tile[(kq * 16 + 2 * j + 1) * 65 + nl]);
    u16* dst = (isout ? WOUT + ((size_t)l * 1024 + nt * 64 + nl) * 1024 : WALL + ((size_t)l * NALL + nt * 64 + nl) * 1024) + kt * 64 + kq * 16;
    ((uint4*)dst)[0] = make_uint4(w[0], w[1], w[2], w[3]);
    ((uint4*)dst)[1] = make_uint4(w[4], w[5], w[6], w[7]);
    __syncthreads();
  }
}

__device__ __forceinline__ void write_h(const Params& p, int l, int row, int lane, const float4* v, float ss) {
  const float* mod = (const float*)(p.ws + OFF_MOD) + l * 3072;
  u16* H = (u16*)(p.ws + OFF_H);
  float rs = rsqrtf(ss * (1.f / 1024.f) + 1e-6f);
#pragma unroll
  for (int i = 0; i < 4; ++i) {
    int col = (lane + 64 * i) * 4;
    float4 g = *(const float4*)(p.norm_pre + l * 1024 + col);
    float4 sh = *(const float4*)(mod + col);
    float4 sc = *(const float4*)(mod + 1024 + col);
    float h0 = v[i].x * rs * g.x * (1.f + sc.x) + sh.x;
    float h1 = v[i].y * rs * g.y * (1.f + sc.y) + sh.y;
    float h2 = v[i].z * rs * g.z * (1.f + sc.z) + sh.z;
    float h3 = v[i].w * rs * g.w * (1.f + sc.w) + sh.w;
    *(uint2*)(H + (size_t)row * 1024 + col) = make_uint2(pack2(h0, h1), pack2(h2, h3));
  }
}

__device__ void phase_h0(const Params& p) {
  const int tid = opaque_tid512(); const int wave = tid >> 6, lane = tid & 63;
  for (int row = blockIdx.x * 8 + wave; row < T_; row += gridDim.x * 8) {
    const float4* xr = (const float4*)(p.x + (size_t)row * 1024);
    float4 v[4];
    float ss = 0.f;
#pragma unroll
    for (int i = 0; i < 4; ++i) {
      v[i] = xr[lane + 64 * i];
      ss += v[i].x * v[i].x + v[i].y * v[i].y + v[i].z * v[i].z + v[i].w * v[i].w;
    }
    ss = wave_sum(ss);
    write_h(p, 0, row, lane, v, ss);
  }
}

__device__ void phase_post(const Params& p, int l) {
  l = opq(l);
  const int tid = opaque_tid512(); const int wave = tid >> 6, lane = tid & 63;
  const float* Y = (const float*)(p.ws + OFF_PROJ);
  const float* mod = (const float*)(p.ws + OFF_MOD) + l * 3072;
  const float* xold = (l == 0) ? p.x : p.out;
  for (int row = blockIdx.x * 8 + wave; row < T_; row += gridDim.x * 8) {
    const float4* yr = (const float4*)(Y + (size_t)row * 1024);
    const float4* xr = (const float4*)(xold + (size_t)row * 1024);
    float4 y[4], v[4];
    float ss = 0.f;
#pragma unroll
    for (int i = 0; i < 4; ++i) {
      y[i] = yr[lane + 64 * i];
      v[i] = xr[lane + 64 * i];
      ss += y[i].x * y[i].x + y[i].y * y[i].y + y[i].z * y[i].z + y[i].w * y[i].w;
    }
    ss = wave_sum(ss);
    float rs = rsqrtf(ss * (1.f / 1024.f) + 1e-6f);
    float s2 = 0.f;
#pragma unroll
    for (int i = 0; i < 4; ++i) {
      int col = (lane + 64 * i) * 4;
      float4 g = *(const float4*)(p.norm_post + l * 1024 + col);
      float4 gt = *(const float4*)(mod + 2048 + col);
      v[i].x += gt.x * (y[i].x * rs * g.x);
      v[i].y += gt.y * (y[i].y * rs * g.y);
      v[i].z += gt.z * (y[i].z * rs * g.z);
      v[i].w += gt.w * (y[i].w * rs * g.w);
      *(float4*)(p.out + (size_t)row * 1024 + col) = v[i];
      s2 += v[i].x * v[i].x + v[i].y * v[i].y + v[i].z * v[i].z + v[i].w * v[i].w;
    }
    if (l < 3) {
      s2 = wave_sum(s2);
      write_h(p, l + 1, row, lane, v, s2);
    }
  }
}

__device__ void attn_item(const Params& p, int l, int item, unsigned char* smem) {
  l = opq(l); item = opq(item);
  u16* Vt = (u16*)smem;
  const u16* PROJ = (const u16*)(p.ws + OFF_PROJ);
  u16* MIX = (u16*)(p.ws + OFF_MIX);
  const int tid = opaque_tid(), w = tid >> 6, lane = tid & 63, l31 = lane & 31, hf = lane >> 5;
  const int qb = item >> 3, head = item & 7, kvh = head >> 2;
  const int kpos0 = (qb - 1) * 128;
  {
    int kp = kpos0 + tid;
    if (kp < 0) kp = 0;
    const uint4* src = (const uint4*)(PROJ + (size_t)kp * NALL + 640 + kvh * 64);
#pragma unroll
    for (int c8 = 0; c8 < 8; ++c8) {
      uint4 v = src[c8];
      int d = c8 * 8;
      Vt[(d + 0) * 264 + tid] = (u16)(v.x & 0xffff);
      Vt[(d + 1) * 264 + tid] = (u16)(v.x >> 16);
      Vt[(d + 2) * 264 + tid] = (u16)(v.y & 0xffff);
      Vt[(d + 3) * 264 + tid] = (u16)(v.y >> 16);
      Vt[(d + 4) * 264 + tid] = (u16)(v.z & 0xffff);
      Vt[(d + 5) * 264 + tid] = (u16)(v.z >> 16);
      Vt[(d + 6) * 264 + tid] = (u16)(v.w & 0xffff);
      Vt[(d + 7) * 264 + tid] = (u16)(v.w >> 16);
    }
  }
  __syncthreads();
  const int tq = qb * 128 + 32 * w + l31;
  bf16x8 qf[4];
  {
    const u16* qp = PROJ + (size_t)tq * NALL + head * 64 + 8 * hf;
#pragma unroll
    for (int s = 0; s < 4; ++s) qf[s] = *(const bf16x8*)(qp + 16 * s);
  }
  const float slope = exp2f(-(float)(head + 1));
  const float sink = p.sinks[l * 8 + head];
  const int rq = 32 * w + l31;
  float mrun = -1e30f, lsum = 0.f;
  f32x16 o0, o1;
#pragma unroll
  for (int r = 0; r < 16; ++r) { o0[r] = 0.f; o1[r] = 0.f; }
#pragma unroll 1
  for (int i = 0; i < 5; ++i) {
    int kp = kpos0 + 32 * w + 32 * i + l31;
    if (kp < 0) kp = 0;
    const u16* kptr = PROJ + (size_t)kp * NALL + 512 + kvh * 64 + 8 * hf;
    f32x16 a;
#pragma unroll
    for (int r = 0; r < 16; ++r) a[r] = 0.f;
#pragma unroll
    for (int s = 0; s < 4; ++s) {
      bf16x8 kf = *(const bf16x8*)(kptr + 16 * s);
      a = __builtin_amdgcn_mfma_f32_32x32x16_bf16(kf, qf[s], a, 0, 0, 0);
    }
    float tmax = -1e30f;
#pragma unroll
    for (int r = 0; r < 16; ++r) {
      int kj = 32 * w + 32 * i + (r & 3) + 8 * (r >> 2) + 4 * hf;
      int dist = 128 + rq - kj;
      bool valid = (dist >= 0) && (dist < 128) && (kpos0 + kj >= 0);
      float sv = a[r] * 0.125f - slope * (float)dist;
      sv = valid ? sv : -1e30f;
      a[r] = sv;
      tmax = fmaxf(tmax, sv);
    }
    tmax = fmaxf(tmax, __shfl_xor(tmax, 32));
    const float mnew = fmaxf(mrun, tmax);
    const float alpha = __expf(mrun - mnew);
    float psum = 0.f;
#pragma unroll
    for (int r = 0; r < 16; ++r) {
      float e = (a[r] > -1e29f) ? __expf(a[r] - mnew) : 0.f;
      a[r] = e;
      psum += e;
    }
    lsum = lsum * alpha + psum;
    mrun = mnew;
#pragma unroll
    for (int r = 0; r < 16; ++r) { o0[r] *= alpha; o1[r] *= alpha; }
#pragma unroll
    for (int u = 0; u < 2; ++u) {
      bf16x8 pf;
#pragma unroll
      for (int j = 0; j < 8; ++j) pf[j] = (short)f2bf(a[8 * u + j]);
      const int kb = 32 * w + 32 * i + 16 * u + 4 * hf;
      const u16* v0 = Vt + l31 * 264 + kb;
      const u16* v1 = Vt + (32 + l31) * 264 + kb;
      uint2 a0 = *(const uint2*)(v0), a1 = *(const uint2*)(v0 + 8);
      uint2 b0 = *(const uint2*)(v1), b1 = *(const uint2*)(v1 + 8);
      uint4 A0 = make_uint4(a0.x, a0.y, a1.x, a1.y), A1 = make_uint4(b0.x, b0.y, b1.x, b1.y);
      o0 = __builtin_amdgcn_mfma_f32_32x32x16_bf16(__builtin_bit_cast(bf16x8, A0), pf, o0, 0, 0, 0);
      o1 = __builtin_amdgcn_mfma_f32_32x32x16_bf16(__builtin_bit_cast(bf16x8, A1), pf, o1, 0, 0, 0);
    }
  }
  {
    const float mf = fmaxf(mrun, sink);
    const float scl = __expf(mrun - mf);
    const float ltot = (lsum + __shfl_xor(lsum, 32)) * scl + __expf(sink - mf);
    const float fin = scl / ltot;
#pragma unroll
    for (int r = 0; r < 16; ++r) { o0[r] *= fin; o1[r] *= fin; }
  }
  const u16* gp = PROJ + (size_t)tq * NALL + 768 + head * 64;
  u16* op = MIX + (size_t)tq * 1024 + head * 64;
#pragma unroll
  for (int g = 0; g < 4; ++g) {
    int d0 = 8 * g + 4 * hf;
    uint2 gg = *(const uint2*)(gp + d0);
    float r0 = o0[4 * g + 0] * silu(bflo(gg.x)), r1 = o0[4 * g + 1] * silu(bfhi(gg.x));
    float r2 = o0[4 * g + 2] * silu(bflo(gg.y)), r3 = o0[4 * g + 3] * silu(bfhi(gg.y));
    *(uint2*)(op + d0) = make_uint2(pack2(r0, r1), pack2(r2, r3));
    uint2 g2 = *(const uint2*)(gp + 32 + d0);
    r0 = o1[4 * g + 0] * silu(bflo(g2.x)); r1 = o1[4 * g + 1] * silu(bfhi(g2.x));
    r2 = o1[4 * g + 2] * silu(bflo(g2.y)); r3 = o1[4 * g + 3] * silu(bfhi(g2.y));
    *(uint2*)(op + 32 + d0) = make_uint2(pack2(r0, r1), pack2(r2, r3));
  }
  __syncthreads();
}

__device__ void rwkv_prep_item(const Params& p, int l, int item, unsigned char* smem) {
  l = opq(l); item = opq(item);
  float* lw = (float*)smem;
  float* la = lw + 1024;
  const u16* PROJ = (const u16*)(p.ws + OFF_PROJ);
  const int tid = opaque_tid(), c = tid, head = tid >> 6, lane = tid & 63;
  const int t0 = item * 16;
#pragma unroll
  for (int i = 0; i < 8; ++i) {
    int idx = tid + 256 * i;
    int which = idx >> 10, tt = (idx >> 6) & 15, j = idx & 63;
    int t = t0 + tt;
    const u16* pr = PROJ + (size_t)t * NALL;
    float cur = bf2f(pr[(which ? 3200 : 3072) + j]);
    float prev = (t > 0) ? bf2f((pr - NALL)[(which ? 3264 : 3136) + j]) : 0.f;
    float s = cur + prev;
    if (!which) s = tanhf(s);
    (which ? la : lw)[tt * 64 + j] = s;
  }
  __syncthreads();
  float accw[16], acca[16];
#pragma unroll
  for (int tt = 0; tt < 16; ++tt) { accw[tt] = 0.f; acca[tt] = 0.f; }
  const float* w2 = p.w2 + (size_t)l * 64 * 256 + c;
  const float* a2 = p.a2 + (size_t)l * 64 * 256 + c;
  for (int j4 = 0; j4 < 16; ++j4) {
    float w20 = w2[(4 * j4 + 0) * 256], w21 = w2[(4 * j4 + 1) * 256], w22 = w2[(4 * j4 + 2) * 256], w23 = w2[(4 * j4 + 3) * 256];
    float a20 = a2[(4 * j4 + 0) * 256], a21 = a2[(4 * j4 + 1) * 256], a22 = a2[(4 * j4 + 2) * 256], a23 = a2[(4 * j4 + 3) * 256];
#pragma unroll
    for (int tt = 0; tt < 16; ++tt) {
      float4 lv = *(const float4*)(lw + tt * 64 + j4 * 4);
      float4 av = *(const float4*)(la + tt * 64 + j4 * 4);
      accw[tt] += lv.x * w20 + lv.y * w21 + lv.z * w22 + lv.w * w23;
      acca[tt] += av.x * a20 + av.y * a21 + av.z * a22 + av.w * a23;
    }
  }
  const float mur = p.mu_rkv[l * 768 + c], muk = p.mu_rkv[l * 768 + 256 + c], muv = p.mu_rkv[l * 768 + 512 + c];
  const float w0 = p.w0[l * 256 + c], a0 = p.a0[l * 256 + c], kkw = p.k_k[l * 256 + c], kaw = p.k_a[l * 256 + c], rkw = p.r_k[l * 256 + c];
  float* RWW = (float*)(p.ws + OFF_RWW);
  float* RWKK = (float*)(p.ws + OFF_RWKK);
  u16* RB = (u16*)(p.ws + OFF_RWB);
  float* BON = (float*)(p.ws + OFF_BONUS);
#pragma unroll
  for (int tt = 0; tt < 16; ++tt) {
    int t = t0 + tt;
    const u16* pr = PROJ + (size_t)t * NALL;
    float rc = bf2f(pr[1280 + c]), kc = bf2f(pr[1536 + c]), vc = bf2f(pr[1792 + c]);
    float rp = 0.f, kp = 0.f, vp = 0.f;
    if (t > 0) { rp = bf2f((pr - NALL)[1280 + c]); kp = bf2f((pr - NALL)[1536 + c]); vp = bf2f((pr - NALL)[1792 + c]); }
    float r = rc + (rp - rc) * mur, k = kc + (kp - kc) * muk, v = vc + (vp - vc) * muv;
    float wpre = w0 + accw[tt];
    float wl = -softplusf_(-wpre) - 0.5f;
    float decay = __expf(-__expf(wl));
    float a = sigmoidf_(a0 + acca[tt]);
    float kkc = k * kkw;
    float n2 = wave_sum(kkc * kkc);
    float kk = kkc / fmaxf(sqrtf(n2), 1e-12f);
    float kmod = k * (1.f + (a - 1.f) * kaw);
    float bb = kk * a;
    float bonus = wave_sum(r * kmod * rkw);
    size_t o = (size_t)t * 256 + c;
    RWW[o] = decay;
    RWKK[o] = kk;
    RB[o] = f2bf(r);
    RB[(size_t)T_ * 256 + o] = f2bf(kmod);
    RB[(size_t)2 * T_ * 256 + o] = f2bf(v);
    RB[(size_t)3 * T_ * 256 + o] = f2bf(bb);
    if (lane == 0) BON[t * 4 + head] = bonus;
  }
  __syncthreads();
}

__device__ __forceinline__ void gla_b(const Params& p, int l, int chunk, int head, float* tot, float* bl) {
  const u16* PROJ = (const u16*)(p.ws + OFF_PROJ);
  const int tid = opaque_tid(), d = tid & 31, ig = tid >> 5;
  float g2[16];
#pragma unroll
  for (int m = 0; m < 16; ++m) g2[m] = p.gk2[(size_t)l * 16 * 128 + m * 128 + head * 32 + d];
  const float bias = p.gk_b[l * 128 + head * 32 + d];
  float run = 0.f;
#pragma unroll
  for (int ii = 0; ii < 8; ++ii) {
    int t = chunk * 64 + ig * 8 + ii;
    const uint4* lp = (const uint4*)(PROJ + (size_t)t * NALL + 3328);
    uint4 u0 = lp[0], u1 = lp[1];
    float z = bias;
    z += bflo(u0.x) * g2[0] + bfhi(u0.x) * g2[1] + bflo(u0.y) * g2[2] + bfhi(u0.y) * g2[3];
    z += bflo(u0.z) * g2[4] + bfhi(u0.z) * g2[5] + bflo(u0.w) * g2[6] + bfhi(u0.w) * g2[7];
    z += bflo(u1.x) * g2[8] + bfhi(u1.x) * g2[9] + bflo(u1.y) * g2[10] + bfhi(u1.y) * g2[11];
    z += bflo(u1.z) * g2[12] + bfhi(u1.z) * g2[13] + bflo(u1.w) * g2[14] + bfhi(u1.w) * g2[15];
    float g = (fminf(z, 0.f) - log1pf(__expf(-fabsf(z)))) * (1.f / 16.f);
    run += g;
    bl[ii] = run;
  }
  tot[ig * 32 + d] = run;
  __syncthreads();
  float off = 0.f;
#pragma unroll
  for (int g = 0; g < 8; ++g) off += (g < ig) ? tot[g * 32 + d] : 0.f;
#pragma unroll
  for (int ii = 0; ii < 8; ++ii) bl[ii] += off;
}

__device__ void gla_local_item(const Params& p, int l, int item, unsigned char* smem) {
  l = opq(l); item = opq(item);
  float* tot = (float*)smem;
  float* Kp = tot + 256;
  float* Vs = Kp + 2048;
  const u16* PROJ = (const u16*)(p.ws + OFF_PROJ);
  const int tid = opaque_tid(), d = tid & 31, ig = tid >> 5;
  const int chunk = item >> 2, head = item & 3;
  float bl[8];
  gla_b(p, l, chunk, head, tot, bl);
  float blast = 0.f;
#pragma unroll
  for (int g = 0; g < 8; ++g) blast += tot[g * 32 + d];
#pragma unroll
  for (int ii = 0; ii < 8; ++ii) {
    int i = ig * 8 + ii;
    int t = chunk * 64 + i;
    float k = bf2f(PROJ[(size_t)t * NALL + 2432 + head * 32 + d]);
    Kp[i * 32 + d] = k * __expf(blast - bl[ii]);
  }
#pragma unroll
  for (int r = 0; r < 16; ++r) {
    int idx = tid + 256 * r;
    int i = idx >> 6, v = idx & 63;
    Vs[idx] = bf2f(PROJ[(size_t)(chunk * 64 + i) * NALL + 2560 + head * 64 + v]);
  }
  __syncthreads();
  const int v = tid & 63, dg = tid >> 6;
  float acc[8];
#pragma unroll
  for (int q = 0; q < 8; ++q) acc[q] = 0.f;
  for (int i = 0; i < 64; ++i) {
    float vv = Vs[i * 64 + v];
    float4 k0 = *(const float4*)(Kp + i * 32 + dg * 8), k1 = *(const float4*)(Kp + i * 32 + dg * 8 + 4);
    acc[0] += k0.x * vv; acc[1] += k0.y * vv; acc[2] += k0.z * vv; acc[3] += k0.w * vv;
    acc[4] += k1.x * vv; acc[5] += k1.y * vv; acc[6] += k1.z * vv; acc[7] += k1.w * vv;
  }
  float* GS = (float*)(p.ws + OFF_GLAS);
  float* GD = (float*)(p.ws + OFF_GLAD);
#pragma unroll
  for (int q = 0; q < 8; ++q) GS[((size_t)(chunk * 4 + head) * 32 + dg * 8 + q) * 64 + v] = acc[q];
  if (tid < 32) GD[(chunk * 4 + head) * 32 + tid] = __expf(blast);
  __syncthreads();
}

__device__ void gla_state_block(const Params& p, int eb, unsigned char* dsm_) {
  float* comp = (float*)dsm_;
  float* GS = (float*)(p.ws + OFF_GLAS);
  const float* GD = (const float*)(p.ws + OFF_GLAD);
  eb = opq(eb);
  const int tid = opaque_tid512();
  const int ei = tid & 31, g = tid >> 5;
  const int e = eb * 32 + ei;
  const int head = e >> 11, d = (e >> 6) & 31, v = e & 63;
  float ds[16], dc[16];
#pragma unroll
  for (int i = 0; i < 16; ++i) {
    const int c = g * 16 + i;
    ds[i] = GS[((size_t)(c * 4 + head) * 32 + d) * 64 + v];
    dc[i] = GD[(c * 4 + head) * 32 + d];
  }
  float S = 0.f, P = 1.f;
#pragma unroll
  for (int i = 0; i < 16; ++i) { S = dc[i] * S + ds[i]; P *= dc[i]; }
  comp[(g * 32 + ei) * 2] = P;
  comp[(g * 32 + ei) * 2 + 1] = S;
  __syncthreads();
  float G = 0.f;
  for (int gg = 0; gg < g; ++gg) G = comp[(gg * 32 + ei) * 2] * G + comp[(gg * 32 + ei) * 2 + 1];
#pragma unroll
  for (int i = 0; i < 16; ++i) {
    const int c = g * 16 + i;
    GS[((size_t)(c * 4 + head) * 32 + d) * 64 + v] = G;
    G = dc[i] * G + ds[i];
  }
  __syncthreads();
}

__device__ void gla_out_item(const Params& p, int l, int item, unsigned char* smem) {
  l = opq(l); item = opq(item);
  float* tot = (float*)smem;
  float* qt = tot + 256;
  float* kt = qt + 2112;
  float* Vs = kt + 2112;
  float* Am = Vs + 4096;
  float* Ss = Am + 4160;
  const u16* PROJ = (const u16*)(p.ws + OFF_PROJ);
  u16* MIX = (u16*)(p.ws + OFF_MIX);
  const float* GS = (const float*)(p.ws + OFF_GLAS);
  const int tid = opaque_tid();
  const int chunk = item >> 2, head = item & 3;
  {
    const int d = tid & 31, ig = tid >> 5;
    float bl[8];
    gla_b(p, l, chunk, head, tot, bl);
#pragma unroll
    for (int ii = 0; ii < 8; ++ii) {
      int i = ig * 8 + ii;
      int t = chunk * 64 + i;
      float q = bf2f(PROJ[(size_t)t * NALL + 2304 + head * 32 + d]);
      float k = bf2f(PROJ[(size_t)t * NALL + 2432 + head * 32 + d]);
      qt[i * 33 + d] = q * 0.17677669529663687f * __expf(bl[ii]);
      kt[i * 33 + d] = k * __expf(-bl[ii]);
    }
  }
#pragma unroll
  for (int r = 0; r < 16; ++r) {
    int idx = tid + 256 * r;
    int i = idx >> 6, v = idx & 63;
    Vs[idx] = bf2f(PROJ[(size_t)(chunk * 64 + i) * NALL + 2560 + head * 64 + v]);
  }
#pragma unroll
  for (int r = 0; r < 8; ++r) {
    int idx = tid + 256 * r;
    Ss[idx] = GS[(size_t)(chunk * 4 + head) * 2048 + idx];
  }
  __syncthreads();
  const int j = tid & 63, ig = tid >> 6;
  {
    float acc[16];
#pragma unroll
    for (int ii = 0; ii < 16; ++ii) acc[ii] = 0.f;
    for (int d = 0; d < 32; ++d) {
      float kv = kt[j * 33 + d];
#pragma unroll
      for (int ii = 0; ii < 16; ++ii) acc[ii] += qt[(ig * 16 + ii) * 33 + d] * kv;
    }
#pragma unroll
    for (int ii = 0; ii < 16; ++ii) {
      int i = ig * 16 + ii;
      Am[i * 65 + j] = (j <= i) ? acc[ii] : 0.f;
    }
  }
  __syncthreads();
  {
    const int v = j;
    float acc[16];
#pragma unroll
    for (int ii = 0; ii < 16; ++ii) acc[ii] = 0.f;
    for (int jj = 0; jj < 64; ++jj) {
      float vv = Vs[jj * 64 + v];
#pragma unroll
      for (int ii = 0; ii < 16; ++ii) acc[ii] += Am[(ig * 16 + ii) * 65 + jj] * vv;
    }
    for (int d = 0; d < 32; ++d) {
      float sv = Ss[d * 64 + v];
#pragma unroll
      for (int ii = 0; ii < 16; ++ii) acc[ii] += qt[(ig * 16 + ii) * 33 + d] * sv;
    }
    const float nw = p.gla_nw[l * 64 + v];
#pragma unroll
    for (int ii = 0; ii < 16; ++ii) {
      int t = chunk * 64 + ig * 16 + ii;
      float o = acc[ii];
      float ms = wave_sum(o * o) * (1.f / 64.f);
      float gg = bf2f(PROJ[(size_t)t * NALL + 2816 + head * 64 + v]);
      float r = o * rsqrtf(ms + 1e-5f) * nw * silu(gg);
      MIX[(size_t)t * 1024 + 768 + head * 64 + v] = f2bf(r);
    }
  }
  __syncthreads();
}

typedef float f32x2 __attribute__((ext_vector_type(2)));
__device__ __forceinline__ float oct_allsum(float x) {
  x += dpp_f<0xB1>(x);
  x += dpp_f<0x4E>(x);
  x += dpp_f<0x141>(x);
  return x;
}
__device__ void rwkv_scan_item(const Params& p, int item, unsigned char* dsm_) {
  item = opq(item);
  float* st = (float*)dsm_;
  const int tid = opaque_tid512(), wv = tid >> 6, lane = tid & 63, rs = lane >> 3, kl = lane & 7;
  const int head = item & 3, seg = item >> 2;
  const bool ident = wv >= 4;
  const int R0 = wv * 16 + rs * 2;
  const int v0 = R0 & 63;
  const float* RWW = (const float*)(p.ws + OFF_RWW);
  const float* RWKK = (const float*)(p.ws + OFF_RWKK);
  const u16* RB = (const u16*)(p.ws + OFF_RWB);
  float* PF = (float*)(p.ws + OFF_PROJ);
  float* ZP = (float*)(p.ws + OFF_ZP);
  const int tbase = seg * SL;
  const int half = tid >> 8, ls = (tid & 255) >> 4, lc4 = (tid & 15) * 4;
  f32x2 S0[4], S1[4];
#pragma unroll
  for (int e = 0; e < 4; ++e) { S0[e] = (f32x2){0.f, 0.f}; S1[e] = (f32x2){0.f, 0.f}; }
  if (ident) {
#pragma unroll
    for (int e = 0; e < 4; ++e) {
      const int k0 = kl * 8 + 2 * e;
      S0[e] = (f32x2){(v0 == k0) ? 1.f : 0.f, (v0 == k0 + 1) ? 1.f : 0.f};
      S1[e] = (f32x2){(v0 + 1 == k0) ? 1.f : 0.f, (v0 + 1 == k0 + 1) ? 1.f : 0.f};
    }
  }
  float4 g0 = make_float4(0.f, 0.f, 0.f, 0.f);
  uint2 h0 = make_uint2(0u, 0u), h1 = h0, h2 = h0;
  const float* gp0 = (half == 0 ? RWW : RWKK) + (size_t)(tbase + ls) * 256 + head * 64 + lc4;
  const u16* hp = RB + (size_t)(tbase + ls) * 256 + head * 64 + lc4;
#define SCAN_GLOAD(ch) do { const size_t _o = (size_t)(ch) * 16 * 256; g0 = *(const float4*)(gp0 + _o); \
    if (half == 0) { h0 = *(const uint2*)(hp + _o); } \
    else { h0 = *(const uint2*)(hp + (size_t)T_ * 256 + _o); h1 = *(const uint2*)(hp + (size_t)3 * T_ * 256 + _o); h2 = *(const uint2*)(hp + (size_t)2 * T_ * 256 + _o); } } while (0)
#define SCAN_LSTORE(buf) do { float* _b = st + (buf) * 6144 + ls * 64 + lc4; \
    if (half == 0) { *(float4*)(_b) = g0; *(float4*)(_b + 2048) = make_float4(bflo(h0.x), bfhi(h0.x), bflo(h0.y), bfhi(h0.y)); } \
    else { *(float4*)(_b + 1024) = g0; *(float4*)(_b + 3072) = make_float4(bflo(h0.x), bfhi(h0.x), bflo(h0.y), bfhi(h0.y)); \
           *(float4*)(_b + 4096) = make_float4(bflo(h1.x), bfhi(h1.x), bflo(h1.y), bfhi(h1.y)); *(float4*)(_b + 5120) = make_float4(bflo(h2.x), bfhi(h2.x), bflo(h2.y), bfhi(h2.y)); } } while (0)
  if (tid < 16) st[2 * 6144 + tid] = 0.f;
  SCAN_GLOAD(0);
  SCAN_LSTORE(0);
  __syncthreads();
  const int nch = SL / 16;
  float* yout = PF + (size_t)tbase * PROJF + (ident ? 256 : 0) + head * 64 + v0;
  const int voff = ident ? (2 * 6144) : (5120 + v0);
  const int vstep = ident ? 0 : 64, vbuf = ident ? 0 : 6144;
#define V2(a, i) ((f32x2){(i) ? a.z : a.x, (i) ? a.w : a.y})
#define SCAN_STEP(s_) do { \
    const float* bp = b + (s_) * 64 + kl * 8; \
    const float4 wl = *(const float4*)(bp), wh = *(const float4*)(bp + 4); \
    const float4 kkl = *(const float4*)(bp + 1024), kkh = *(const float4*)(bp + 1028); \
    const float4 rl4 = *(const float4*)(bp + 2048), rh4 = *(const float4*)(bp + 2052); \
    const float4 kl4 = *(const float4*)(bp + 3072), kh4 = *(const float4*)(bp + 3076); \
    const float4 bl4 = *(const float4*)(bp + 4096), bh4 = *(const float4*)(bp + 4100); \
    const f32x2 vv = *(const f32x2*)(vsrc + (s_) * vstep); \
    const f32x2 W[4] = {V2(wl, 0), V2(wl, 1), V2(wh, 0), V2(wh, 1)}, KK[4] = {V2(kkl, 0), V2(kkl, 1), V2(kkh, 0), V2(kkh, 1)}; \
    const f32x2 RR[4] = {V2(rl4, 0), V2(rl4, 1), V2(rh4, 0), V2(rh4, 1)}, KV[4] = {V2(kl4, 0), V2(kl4, 1), V2(kh4, 0), V2(kh4, 1)}; \
    const f32x2 BB[4] = {V2(bl4, 0), V2(bl4, 1), V2(bh4, 0), V2(bh4, 1)}; \
    f32x2 t0 = S0[0] * KK[0] + S0[1] * KK[1] + S0[2] * KK[2] + S0[3] * KK[3]; \
    f32x2 t1 = S1[0] * KK[0] + S1[1] * KK[1] + S1[2] * KK[2] + S1[3] * KK[3]; \
    float sa0 = -(t0.x + t0.y), sa1 = -(t1.x + t1.y); \
    sa0 += dpp_f<0xB1>(sa0); sa1 += dpp_f<0xB1>(sa1); sa0 += dpp_f<0x4E>(sa0); sa1 += dpp_f<0x4E>(sa1); sa0 += dpp_f<0x141>(sa0); sa1 += dpp_f<0x141>(sa1); \
    const f32x2 a0 = {sa0, sa0}, a1 = {sa1, sa1}, u0 = {vv.x, vv.x}, u1 = {vv.y, vv.y}; \
    _Pragma("unroll") for (int e = 0; e < 4; ++e) { S0[e] = S0[e] * W[e] + a0 * BB[e] + u0 * KV[e]; S1[e] = S1[e] * W[e] + a1 * BB[e] + u1 * KV[e]; } \
    f32x2 q0 = S0[0] * RR[0] + S0[1] * RR[1] + S0[2] * RR[2] + S0[3] * RR[3]; \
    f32x2 q1 = S1[0] * RR[0] + S1[1] * RR[1] + S1[2] * RR[2] + S1[3] * RR[3]; \
    float y0 = q0.x + q0.y, y1 = q1.x + q1.y; \
    y0 += dpp_f<0xB1>(y0); y1 += dpp_f<0xB1>(y1); y0 += dpp_f<0x4E>(y0); y1 += dpp_f<0x4E>(y1); y0 += dpp_f<0x141>(y0); y1 += dpp_f<0x141>(y1); \
    const bool mine = (kl == ((s_) & 7)); \
    if ((s_) < 8) { ya.x = mine ? y0 : ya.x; ya.y = mine ? y1 : ya.y; } else { yb.x = mine ? y0 : yb.x; yb.y = mine ? y1 : yb.y; } } while (0)
  for (int ch = 0; ch < nch; ++ch) {
    const int cur = ch & 1;
    if (ch + 1 < nch) SCAN_GLOAD(ch + 1);
    const float* b = st + cur * 6144;
    const float* vsrc = st + voff + cur * vbuf;
    f32x2 ya = {0.f, 0.f}, yb = {0.f, 0.f};
#pragma unroll 2
    for (int s = 0; s < 8; ++s) SCAN_STEP(s);
#pragma unroll 2
    for (int s = 8; s < 16; ++s) SCAN_STEP(s);
    *(f32x2*)(yout + (size_t)(ch * 16 + kl) * PROJF) = ya;
    *(f32x2*)(yout + (size_t)(ch * 16 + 8 + kl) * PROJF) = yb;
    if (ch + 1 < nch) SCAN_LSTORE(cur ^ 1);
    __syncthreads();
  }
#pragma unroll
  for (int j = 0; j < 2; ++j) {
    float* zp = ZP + ((size_t)((seg * 4 + head) * 128 + R0 + j)) * 64 + kl * 8;
    if (j == 0) { *(float4*)(zp) = make_float4(S0[0].x, S0[0].y, S0[1].x, S0[1].y); *(float4*)(zp + 4) = make_float4(S0[2].x, S0[2].y, S0[3].x, S0[3].y); }
    else { *(float4*)(zp) = make_float4(S1[0].x, S1[0].y, S1[1].x, S1[1].y); *(float4*)(zp + 4) = make_float4(S1[2].x, S1[2].y, S1[3].x, S1[3].y); }
  }
}

__device__ void rwkv_combine(const Params& p, unsigned char* dsm_) {
  float* ring = (float*)dsm_;
  float* ZP = (float*)(p.ws + OFF_ZP);
  const int tid = opaque_tid512(); const int lane = tid & 63;
  const int rowi = blockIdx.x * 8 + (tid >> 6);
  const int head = rowi >> 6, v = rowi & 63;
  float4 pa0, pa1, pa2, pa3, pb0, pb1, pb2, pb3;
  float z0, z1, z2, z3;
#define COMB_ONE(stg_, q, PA, PB, Z) do { const float* base = ZP + (size_t)((((stg_) * 4 + q) * 4 + head) * 128) * 64; \
      PA = ((const float4*)(base + 4096))[tid]; PB = ((const float4*)(base + 4096))[tid + 512]; Z = base[v * 64 + lane]; } while (0)
#define COMB_ISSUE(stg_) do { COMB_ONE(stg_, 0, pa0, pb0, z0); COMB_ONE(stg_, 1, pa1, pb1, z1); COMB_ONE(stg_, 2, pa2, pb2, z2); COMB_ONE(stg_, 3, pa3, pb3, z3); } while (0)
#define COMB_SEG(q, ZC) do { const int seg = stg * 4 + q; \
      ZP[((size_t)((seg * 4 + head) * 128 + v)) * 64 + lane] = s; \
      float ns0 = ZC, ns1 = 0.f; const float* P = buf + q * 4096 + lane; \
      _Pragma("unroll") for (int i = 0; i < 64; i += 2) { \
        float s0 = __builtin_bit_cast(float, __builtin_amdgcn_readlane(__builtin_bit_cast(int, s), i)); \
        float s1 = __builtin_bit_cast(float, __builtin_amdgcn_readlane(__builtin_bit_cast(int, s), i + 1)); \
        ns0 += s0 * P[i * 64]; ns1 += s1 * P[(i + 1) * 64]; } \
      s = ns0 + ns1; } while (0)
  COMB_ISSUE(0);
  float s = 0.f;
#pragma unroll 1
  for (int stg = 0; stg < NSEG / 4; ++stg) {
    float* buf = ring + (stg & 1) * 16384;
    ((float4*)(buf))[tid] = pa0; ((float4*)(buf))[tid + 512] = pb0;
    ((float4*)(buf + 4096))[tid] = pa1; ((float4*)(buf + 4096))[tid + 512] = pb1;
    ((float4*)(buf + 8192))[tid] = pa2; ((float4*)(buf + 8192))[tid + 512] = pb2;
    ((float4*)(buf + 12288))[tid] = pa3; ((float4*)(buf + 12288))[tid + 512] = pb3;
    const float c0 = z0, c1 = z1, c2 = z2, c3 = z3;
    __syncthreads();
    if (stg + 1 < NSEG / 4) COMB_ISSUE(stg + 1);
    COMB_SEG(0, c0); COMB_SEG(1, c1); COMB_SEG(2, c2); COMB_SEG(3, c3);
  }
  __syncthreads();
}

__device__ void rwkv_final_item(const Params& p, int l, int item, unsigned char* smem) {
  l = opq(l); item = opq(item);
  float* Ss = (float*)smem;
  float* rho = Ss + 4160;
  const int tid = opaque_tid(), v = tid & 63, tg = tid >> 6;
  const int tiles = SL / 64;
  const int q = item % tiles, head = (item / tiles) & 3, seg = item / (tiles * 4);
  const int t0 = seg * SL + q * 64;
  const float* ZP = (const float*)(p.ws + OFF_ZP);
  const float* PF = (const float*)(p.ws + OFF_PROJ);
  const u16* PROJ = (const u16*)(p.ws + OFF_PROJ);
  const u16* RBv = (const u16*)(p.ws + OFF_RWB) + (size_t)2 * T_ * 256;
  const float* BON = (const float*)(p.ws + OFF_BONUS);
  u16* MIX = (u16*)(p.ws + OFF_MIX);
#pragma unroll
  for (int r = 0; r < 16; ++r) {
    int idx = tid + 256 * r;
    int row = idx >> 6, col = idx & 63;
    Ss[row * 65 + col] = ZP[((size_t)((seg * 4 + head) * 128 + row)) * 64 + col];
    rho[idx] = PF[(size_t)(t0 + row) * PROJF + 256 + head * 64 + col];
  }
  __syncthreads();
  const int c = head * 64 + v;
  const float lnw = p.ln_w[l * 256 + c], lnb = p.ln_b[l * 256 + c];
#pragma unroll 1
  for (int hh = 0; hh < 2; ++hh) {
    const int tb = tg * 16 + hh * 8;
    float acc[8];
#pragma unroll
    for (int tt = 0; tt < 8; ++tt) acc[tt] = PF[(size_t)(t0 + tb + tt) * PROJF + head * 64 + v];
#pragma unroll 2
    for (int i4 = 0; i4 < 16; ++i4) {
      float s0 = Ss[v * 65 + 4 * i4], s1 = Ss[v * 65 + 4 * i4 + 1], s2 = Ss[v * 65 + 4 * i4 + 2], s3 = Ss[v * 65 + 4 * i4 + 3];
#pragma unroll
      for (int tt = 0; tt < 8; ++tt) {
        float4 rv = *(const float4*)(rho + (tb + tt) * 64 + 4 * i4);
        acc[tt] += s0 * rv.x + s1 * rv.y + s2 * rv.z + s3 * rv.w;
      }
    }
#pragma unroll
    for (int tt = 0; tt < 8; ++tt) {
      int t = t0 + tb + tt;
      float y = acc[tt];
      float mean = wave_sum(y) * (1.f / 64.f);
      float dlt = y - mean;
      float var = wave_sum(dlt * dlt) * (1.f / 64.f);
      float o = dlt * rsqrtf(var + 64e-5f) * lnw + lnb;
      o += BON[t * 4 + head] * bf2f(RBv[(size_t)t * 256 + c]);
      float g = bf2f(PROJ[(size_t)t * NALL + 2048 + c]);
      MIX[(size_t)t * 1024 + 512 + c] = f2bf(o * silu(g));
    }
  }
  __syncthreads();
}

#define LDS_BYTES (131072 + 16)
#ifndef REP_G1
#define REP_G1 1
#endif
#ifndef REP_G2
#define REP_G2 1
#endif
#ifndef REP_P3
#define REP_P3 1
#endif
#ifndef REP_SCAN
#define REP_SCAN 1
#endif
#ifndef REP_GO
#define REP_GO 1
#endif
#ifndef REP_FIN
#define REP_FIN 1
#endif
#define PAIR_LOOP(N, BODY) for (int _pr = blockIdx.x; _pr < (N) / 2; _pr += gridDim.x) { const int it = 2 * _pr + vb; BODY }
__global__ void __launch_bounds__(512) fwd_megakernel(Params p) {
  cg::grid_group grid = cg::this_grid();
  extern __shared__ __attribute__((aligned(16))) unsigned char dsm[];
  const int vb = __builtin_amdgcn_readfirstlane(threadIdx.x >> 8);
  unsigned char* smem = dsm + vb * 65536;
  if (threadIdx.x == 0) *(uint4*)(dsm + 131072) = make_uint4(0u, 0u, 0u, 0u);
  __syncthreads();
  const XcdBarrier xb = xcd_barrier_post((unsigned*)(p.ws + OFF_BAR), (volatile LAS unsigned*)(dsm + 131072));
#define GSYNC() xcd_barrier(xb)
#ifndef PH
#define PH 0xffff
#endif
  if (PH & 1) PAIR_LOOP(384, phase_mod_item(p, it, smem);)
  if (PH & 2) PAIR_LOOP(4480, phase_wconv_item(p, it, smem);)
  grid.sync();
  if (PH & 4) phase_h0(p);
  GSYNC();
#pragma unroll 1
  for (int hl = 0; hl < 8; ++hl) {
    const int l = hl >> 1;
    const bool second = hl & 1;
    if (PH & 8) {
      pg8::Gemm g; g.M = T_; g.K = 1024;
      pg8::EpiU E; E.O = (void*)(p.ws + OFF_PROJ);
      if (!second) { g.A = (const u16*)(p.ws + OFF_H); g.Bt = (const u16*)(p.ws + OFF_WALL) + (size_t)l * NALL * 1024; g.N = 3584; E.ldc = NALL; E.ncols = NALL; E.f32out = 0; }
      else { g.A = (const u16*)(p.ws + OFF_MIX); g.Bt = (const u16*)(p.ws + OFF_WOUT) + (size_t)l * 1024 * 1024; g.N = 1024; E.ldc = 1024; E.ncols = 1024; E.f32out = 1; }
      pg8::StaticOrder S; S.init(T_, g.N, gridDim.x, blockIdx.x);
      const int nrep = second ? REP_G2 : REP_G1;
#pragma unroll 1
      for (int rep = 0; rep < nrep; ++rep)
      pg8::gemm_phase<pg8::EpiU, pg8::StaticOrder, false>((PG8_LAS unsigned char*)dsm, g, S, E, nullptr);
    }
    GSYNC();
    if (!second) {
#pragma unroll 1
      for (int rep = 0; rep < REP_P3; ++rep)
      PAIR_LOOP(3072,
        if (it < 1024) { if (PH & 16) attn_item(p, l, it, smem); }
        else if (it < 2048) { if (PH & 32) rwkv_prep_item(p, l, it - 1024, smem); }
        else { if (PH & 64) gla_local_item(p, l, it - 2048, smem); }
      )
      GSYNC();
      if (PH & 128) for (int eb = blockIdx.x; eb < 256; eb += gridDim.x) gla_state_block(p, eb, dsm);
#pragma unroll 1
      for (int rep = 0; rep < REP_SCAN; ++rep)
      if (PH & 256) for (int it = blockIdx.x; it < NSEG * 4; it += gridDim.x) rwkv_scan_item(p, it, dsm);
      GSYNC();
      if (blockIdx.x < 32) { if (PH & 512) rwkv_combine(p, dsm); }
#pragma unroll 1
      for (int rep = 0; rep < REP_GO; ++rep)
      if (PH & 1024) PAIR_LOOP(1024, gla_out_item(p, l, it, smem);)
      GSYNC();
#pragma unroll 1
      for (int rep = 0; rep < REP_FIN; ++rep)
      if (PH & 2048) PAIR_LOOP(NSEG * 4 * (SL / 64), rwkv_final_item(p, l, it, smem);)
      GSYNC();
    } else {
      if (PH & 8192) phase_post(p, l);
      if (hl < 7) GSYNC();
    }
  }
}

extern "C" void kernel_launch(void* const* d_in, const int* in_sizes, int n_in, void* d_out, int out_size, void* d_ws, size_t ws_size,
                              hipStream_t stream) {
  static int grid_blocks = 0;
  if (!grid_blocks) {
    int dev = 0, cus = 0, per_cu = 0;
    (void)hipGetDevice(&dev);
    (void)hipDeviceGetAttribute(&cus, hipDeviceAttributeMultiprocessorCount, dev);
    (void)hipFuncSetAttribute((const void*)fwd_megakernel, hipFuncAttributeMaxDynamicSharedMemorySize, LDS_BYTES);
    (void)hipOccupancyMaxActiveBlocksPerMultiprocessor(&per_cu, fwd_megakernel, 512, LDS_BYTES);
    if (per_cu < 1) per_cu = 1;
    grid_blocks = cus;
    if (grid_blocks < 32) grid_blocks = 32;
  }
  if (n_in != 27 || ws_size < WS_END) {
    fprintf(stderr, "kernel_launch: unexpected n_in %d / ws %zu\n", n_in, ws_size);
    return;
  }
  Params p{};
  const float** pp = (const float**)&p;
  for (int i = 0; i < 27; ++i) pp[i] = (const float*)d_in[i];
  p.out = (float*)d_out;
  p.ws = (unsigned char*)d_ws;
  (void)hipMemsetAsync((unsigned char*)d_ws + OFF_BAR, 0, XCD_BAR_WORDS * 4, stream);
  void* args[] = {&p};
  hipError_t e = hipLaunchCooperativeKernel((void*)fwd_megakernel, dim3(grid_blocks), dim3(512), args, LDS_BYTES, stream);
  if (e != hipSuccess) fprintf(stderr, "cooperative launch failed: %s (grid %d)\n", hipGetErrorString(e), grid_blocks);
}
```

```cpp
#include <hip/hip_runtime.h>
#include <hip/hip_bf16.h>
#include <hip/hip_cooperative_groups.h>
#include <cstdio>
namespace cg = cooperative_groups;

typedef unsigned short u16;
using bf16x8 = __attribute__((ext_vector_type(8))) short;
using f32x4 = __attribute__((ext_vector_type(4))) float;
using f32x16 = __attribute__((ext_vector_type(16))) float;

#define T_ 16384
#define NALL 3456
#define NSEG 64
#define SL (T_ / NSEG)
#define PROJF 1728

#define OFF_WALL 0ull
#define OFF_WOUT 28311552ull
#define OFF_MOD 36700160ull
#define OFF_H 36749312ull
#define OFF_RWW OFF_H
#define OFF_RWKK (OFF_H + 16777216ull)
#define OFF_PROJ 70303744ull
#define OFF_MIX 183549952ull
#define OFF_RWB 217104384ull
#define OFF_GLAS 250658816ull
#define OFF_GLAD 259047424ull
#define OFF_BONUS 259178496ull
#define OFF_ZP 259440640ull
#define OFF_BAR 267829248ull
#define OFF_W2T 267845632ull
#define OFF_A2T 267976704ull
#define WS_END 268107776ull


struct Params {
  const float *x, *c, *ada_w, *ada_b, *norm_pre, *norm_post, *w_in, *w_out, *sinks, *mu_rkv, *mu_w, *mu_a, *w0, *w1, *w2,
      *a0, *a1, *a2, *k_k, *k_a, *r_k, *ln_w, *ln_b, *gk1, *gk2, *gk_b, *gla_nw;
  float* out;
  unsigned char* ws;
};

__device__ __forceinline__ u16 f2bf(float f) {
  unsigned u = __float_as_uint(f);
  u += 0x7fffu + ((u >> 16) & 1u);
  return (u16)(u >> 16);
}
__device__ __forceinline__ float bf2f(u16 h) { return __uint_as_float(((unsigned)h) << 16); }
__device__ __forceinline__ unsigned pack2(float a, float b) { return (unsigned)f2bf(a) | ((unsigned)f2bf(b) << 16); }
__device__ __forceinline__ float bflo(unsigned u) { return __uint_as_float(u << 16); }
__device__ __forceinline__ float bfhi(unsigned u) { return __uint_as_float(u & 0xffff0000u); }
__device__ __forceinline__ float wave_sum(float v) {
#pragma unroll
  for (int o = 32; o > 0; o >>= 1) v += __shfl_xor(v, o);
  return v;
}
__device__ __forceinline__ float silu(float x) { return x / (1.f + __expf(-x)); }
__device__ __forceinline__ float sigmoidf_(float x) { return 1.f / (1.f + __expf(-x)); }
__device__ __forceinline__ float softplusf_(float z) { return fmaxf(z, 0.f) + log1pf(__expf(-fabsf(z))); }

__device__ __forceinline__ int opq(int x) { asm volatile("" : "+s"(x)); return x; }
__device__ __forceinline__ int opaque_tid() { int t = threadIdx.x & 255; asm volatile("" : "+v"(t)); return t; }
__device__ __forceinline__ int opaque_tid512() { int t = threadIdx.x; asm volatile("" : "+v"(t)); return t; }
template <int CTRL>
__device__ __forceinline__ float dpp_f(float x) {
  return __builtin_bit_cast(float, __builtin_amdgcn_update_dpp(0, __builtin_bit_cast(int, x), CTRL, 0xf, 0xf, true));
}
__device__ __forceinline__ float row16_allsum(float x) {
  x += dpp_f<0x128>(x);
  x += dpp_f<0x124>(x);
  x += dpp_f<0x122>(x);
  x += dpp_f<0x121>(x);
  return x;
}

namespace pg8 {
#define PG8_LAS __attribute__((address_space(3)))
typedef unsigned short bf16_t;
typedef short bf16x8 __attribute__((ext_vector_type(8)));
typedef float f32x4 __attribute__((ext_vector_type(4)));
typedef unsigned u32x4 __attribute__((ext_vector_type(4)));
constexpr int BM = 256, BK = 64, HALF = 128, HTB = HALF * BK * 2  , STAGE_BYTES = 8 * HTB, NXCD = 8, WGM = 8;

__host__ __device__ __forceinline__ int lds_byte(int r, int c) { const int st = (r >> 4) * 2 + (c >> 5), rr = r & 15, cc = c & 31, ob = rr * 64 + cc * 2; return st * 1024 + (ob ^ (((ob >> 9) & 1) << 5)); }
__host__ __device__ __forceinline__ void stage_rc(int b, int& R, int& C) { const int st = b / 1024, sb = b % 1024, swz = sb ^ (((sb >> 9) & 1) << 5); R = (st >> 1) * 16 + swz / 64; C = (st & 1) * 32 + (swz % 64) / 2; }
__host__ __device__ __forceinline__ int perm32(int rho) { const int n = rho >> 4, i = rho & 15; return 8 * (i >> 2) + 4 * n + (i & 3); }

struct Unit { int pm, pn; };
struct Gemm { const bf16_t* A; const bf16_t* Bt; int M, N, K; };

struct StaticOrder {
    int nM, nN, nwg, G, c;
    __host__ __device__ void init(int M, int N, int G_, int c_) { nM = M / BM; nN = N / BM; nwg = nM * nN; G = G_; c = c_; }
    __host__ __device__ bool next(int i, Unit& u) const {
        const long L = (long)i * G + c; if (L >= nwg) return false;
        int wgid = (int)L; { const int q = nwg / NXCD, r = nwg % NXCD, xcd = wgid % NXCD, off = wgid / NXCD; wgid = (xcd < r ? xcd * (q + 1) : r * (q + 1) + (xcd - r) * q) + off; }
        const int nig = WGM * nN, gid = wgid / nig, fm = gid * WGM, gsz = (nM - fm) < WGM ? (nM - fm) : WGM;
        u.pm = fm + ((wgid % nig) % gsz); u.pn = (wgid % nig) / gsz; return true;
    }
    __device__ __forceinline__ void a_ready(const Unit&) const {}
    __device__ __forceinline__ void done(const Unit&) const {}
};
__device__ __forceinline__ unsigned cvt_pk_bf16(float lo, float hi) { unsigned r; asm volatile("v_cvt_pk_bf16_f32 %0, %1, %2" : "=v"(r) : "v"(lo), "v"(hi)); return r; }
template <class Epi, class Sched, bool STAMP = false>
__device__ __forceinline__ void gemm_phase(PG8_LAS unsigned char* lds, const Gemm g, const Sched& S, const Epi& E, unsigned long long* stamps) {
    const int tid = threadIdx.x, wid = __builtin_amdgcn_readfirstlane(tid >> 6), lane = tid & 63, wr = wid >> 2, wc = wid & 3, fr = lane & 15, fq = lane >> 4;
    const int K = g.K, nt = K / BK;
    int ts_lo = 0, ts_hi = 0, nts = 0; const unsigned long long rt_entry = STAMP ? (unsigned long long)wall_clock64() : 0ull;
#define PG8_STAMP() do { if (STAMP && wid == 0 && nts < 64) { const unsigned long long _c = (unsigned long long)clock64(); \
        ts_lo = (lane == nts) ? (int)(unsigned)_c : ts_lo; ts_hi = (lane == nts) ? (int)(unsigned)(_c >> 32) : ts_hi; ++nts; } } while (0)
    PG8_STAMP();
    unsigned voffA[2], voffB[2];
#pragma unroll
    for (int i = 0; i < 2; ++i) { int R, C; stage_rc(tid * 16 + i * 8192, R, C); const int Rb = Epi::PERM ? ((R & ~31) + perm32(R & 31)) : R;
        voffA[i] = (unsigned)(R * K + C) * 2u; voffB[i] = (unsigned)(Rb * K + C) * 2u; }
    const size_t kstep = (size_t)(BK * 2);
    const size_t hstep = (size_t)HALF * K * 2;
    const size_t tstep = 2 * hstep;
    const unsigned ldsw = (unsigned)wid * 1024u;
    const int aoff = lds_byte(wr * 64 + fr, fq * 8), boff = lds_byte(wc * 32 + fr, fq * 8);
#define PG8_SA(b, h) (((b) * 2 + (h)) * HTB)
#define PG8_SB(b, h) ((4 + (b) * 2 + (h)) * HTB)
#define PG8_STAGE(bufoff, gbase, voff) do { _Pragma("unroll") for (int _i = 0; _i < 2; ++_i) \
        __builtin_amdgcn_global_load_lds((const unsigned*)((const char*)(gbase) + (voff)[_i]), (PG8_LAS unsigned*)(lds + (bufoff) + ldsw + _i * 8192), 16, 0, 0); } while (0)
#define PG8_LDA(dst, b, h) do { _Pragma("unroll") for (int m = 0; m < 4; ++m) _Pragma("unroll") for (int k = 0; k < 2; ++k) dst[m][k] = *(const PG8_LAS bf16x8*)(lds + PG8_SA(b, h) + aoff + m * 2048 + k * 1024); } while (0)
#define PG8_LDB(dst, b, h) do { _Pragma("unroll") for (int n = 0; n < 2; ++n) _Pragma("unroll") for (int k = 0; k < 2; ++k) dst[n][k] = *(const PG8_LAS bf16x8*)(lds + PG8_SB(b, h) + boff + n * 2048 + k * 1024); } while (0)
#define PG8_MMA(ai, bj, At, Bt) do { __builtin_amdgcn_s_setprio(1); _Pragma("unroll") for (int m = 0; m < 4; ++m) _Pragma("unroll") for (int n = 0; n < 2; ++n) _Pragma("unroll") for (int k = 0; k < 2; ++k) \
        acc[ai][bj][m][n] = __builtin_amdgcn_mfma_f32_16x16x32_bf16(Bt[n][k], At[m][k], acc[ai][bj][m][n], 0, 0, 0); __builtin_amdgcn_s_setprio(0); } while (0)
#define PG8_WAIT_V(n) asm volatile("s_waitcnt vmcnt(" #n ")" ::: "memory")
#define PG8_WAIT_L(n) asm volatile("s_waitcnt lgkmcnt(" #n ")" ::: "memory")
#define PG8_BAR __builtin_amdgcn_s_barrier()
#define PG8_SCHED __builtin_amdgcn_sched_barrier(0)
    Unit cur, nxt; int ui = 0;
    if (!S.next(0, cur)) return;
    f32x4 acc[2][2][4][2];
#pragma unroll
    for (int a = 0; a < 2; ++a)
#pragma unroll
        for (int b = 0; b < 2; ++b)
#pragma unroll
            for (int m = 0; m < 4; ++m)
#pragma unroll
                for (int n = 0; n < 2; ++n) acc[a][b][m][n] = (f32x4){0.f, 0.f, 0.f, 0.f};
    bf16x8 At[4][2], B0[2][2], B1[2][2];
    const char* cA = (const char*)g.A + (size_t)cur.pm * tstep; const char* cB = (const char*)g.Bt + (size_t)cur.pn * tstep;
    S.a_ready(cur);
    PG8_STAGE(PG8_SB(0, 0), cB, voffB); PG8_STAGE(PG8_SA(0, 0), cA, voffA); PG8_STAGE(PG8_SB(0, 1), cB + hstep, voffB); PG8_STAGE(PG8_SA(0, 1), cA + hstep, voffA);
    if (wr == 1) PG8_BAR;
    PG8_WAIT_V(4); PG8_BAR;
    PG8_STAGE(PG8_SB(1, 0), cB + kstep, voffB); PG8_STAGE(PG8_SA(1, 0), cA + kstep, voffA); PG8_STAGE(PG8_SB(1, 1), cB + hstep + kstep, voffB);
    PG8_WAIT_V(6); PG8_BAR;
    PG8_STAMP();
    for (;;) {
        const bool has_next = S.next(ui + 1, nxt);
        const char* nA = has_next ? (const char*)g.A + (size_t)nxt.pm * tstep : cA; const char* nB = has_next ? (const char*)g.Bt + (size_t)nxt.pn * tstep : cB;
        for (int t = 0; t < nt; t += 2) {
            const bool last = (t == nt - 2);
            const char* a1 = cA + (size_t)(t + 1) * kstep;
            const char* a2 = last ? nA : cA + (size_t)(t + 2) * kstep; const char* b2 = last ? nB : cB + (size_t)(t + 2) * kstep;
            const char* a3 = a2 + kstep; const char* b3 = b2 + kstep;
            if (last && has_next) S.a_ready(nxt);
            PG8_LDB(B0, 0, 0); PG8_SCHED; PG8_LDA(At, 0, 0); PG8_STAGE(PG8_SA(1, 1), a1 + hstep, voffA);
            PG8_WAIT_L(8); PG8_BAR; PG8_WAIT_L(0); PG8_MMA(0, 0, At, B0); PG8_BAR; PG8_SCHED;
            PG8_LDB(B1, 0, 1); PG8_STAGE(PG8_SB(0, 0), b2, voffB);
            PG8_BAR; PG8_WAIT_L(0); PG8_MMA(0, 1, At, B1); PG8_BAR;
            PG8_LDA(At, 0, 1); PG8_STAGE(PG8_SA(0, 0), a2, voffA);
            PG8_BAR; PG8_WAIT_L(0); PG8_MMA(1, 0, At, B0); PG8_BAR; PG8_SCHED;
            PG8_STAGE(PG8_SB(0, 1), b2 + hstep, voffB);
            PG8_WAIT_V(6); PG8_BAR; PG8_MMA(1, 1, At, B1); PG8_BAR;
            PG8_LDB(B0, 1, 0); PG8_SCHED; PG8_LDA(At, 1, 0); PG8_STAGE(PG8_SA(0, 1), a2 + hstep, voffA);
            PG8_WAIT_L(8); PG8_BAR; PG8_WAIT_L(0); PG8_MMA(0, 0, At, B0); PG8_BAR; PG8_SCHED;
            PG8_LDB(B1, 1, 1); PG8_STAGE(PG8_SB(1, 0), b3, voffB);
            PG8_BAR; PG8_WAIT_L(0); PG8_MMA(0, 1, At, B1); PG8_BAR;
            PG8_LDA(At, 1, 1); PG8_STAGE(PG8_SA(1, 0), a3, voffA);
            PG8_BAR; PG8_WAIT_L(0); PG8_MMA(1, 0, At, B0); PG8_BAR; PG8_SCHED;
            PG8_STAGE(PG8_SB(1, 1), b3 + hstep, voffB);
            PG8_WAIT_V(6); PG8_BAR; PG8_MMA(1, 1, At, B1); PG8_BAR;
        }
        PG8_STAMP();
        if constexpr (!Epi::AFTER_DRAIN) { E(acc, cur, wr, wc, fr, fq); S.done(cur); }
        PG8_STAMP();
        if (!has_next) break;
#pragma unroll
        for (int a = 0; a < 2; ++a)
#pragma unroll
            for (int b = 0; b < 2; ++b)
#pragma unroll
                for (int m = 0; m < 4; ++m)
#pragma unroll
                    for (int n = 0; n < 2; ++n) acc[a][b][m][n] = (f32x4){0.f, 0.f, 0.f, 0.f};
        cur = nxt; cA = nA; cB = nB; ++ui;
    }
    PG8_WAIT_V(0);
    if (wr == 0) PG8_BAR;
    PG8_BAR;
    if constexpr (Epi::AFTER_DRAIN) { E.fused(acc, cur, wr, wc, fr, fq, lds, wid, lane); S.done(cur); }
    PG8_STAMP();
    if (STAMP && wid == 0) { stamps[lane] = lane < nts ? (((unsigned long long)(unsigned)ts_hi << 32) | (unsigned)ts_lo) : 0ull;
        if (lane == 62) stamps[62] = rt_entry; if (lane == 63) stamps[63] = (unsigned long long)wall_clock64(); }
#undef PG8_STAMP
#undef PG8_SA
#undef PG8_SB
#undef PG8_STAGE
#undef PG8_LDA
#undef PG8_LDB
#undef PG8_MMA
#undef PG8_WAIT_V
#undef PG8_WAIT_L
#undef PG8_BAR
#undef PG8_SCHED
}
}

namespace pg8 {
struct EpiProj {
    static constexpr bool PERM = true, AFTER_DRAIN = false;
    bf16_t* O; int ldc; int ncols;
    __device__ __forceinline__ void operator()(const f32x4 (&acc)[2][2][4][2], const Unit& u, int wr, int wc, int fr, int fq) const {
        const int row0 = u.pm * BM + wr * 64 + fr; const int col0 = u.pn * BM + wc * 32 + 8 * fq;
#pragma unroll
        for (int ai = 0; ai < 2; ++ai)
#pragma unroll
            for (int m = 0; m < 4; ++m) { bf16_t* rowp = O + (size_t)(row0 + ai * HALF + m * 16) * ldc + col0;
#pragma unroll
                for (int bj = 0; bj < 2; ++bj) { const f32x4 v0 = acc[ai][bj][m][0], v1 = acc[ai][bj][m][1];
                    u32x4 w; w.x = cvt_pk_bf16(v0[0], v0[1]); w.y = cvt_pk_bf16(v0[2], v0[3]); w.z = cvt_pk_bf16(v1[0], v1[1]); w.w = cvt_pk_bf16(v1[2], v1[3]);
                    if (col0 + bj * HALF < ncols) *(u32x4*)(rowp + bj * HALF) = w; } }
    }
};
struct EpiU {
    static constexpr bool PERM = true, AFTER_DRAIN = false;
    void* O; int ldc; int ncols; int f32out;
    __device__ __forceinline__ void operator()(const f32x4 (&acc)[2][2][4][2], const Unit& u, int wr, int wc, int fr, int fq) const {
        const int row0 = u.pm * BM + wr * 64 + fr; const int col0 = u.pn * BM + wc * 32 + 8 * fq;
        if (f32out) {
#pragma unroll
            for (int ai = 0; ai < 2; ++ai)
#pragma unroll
                for (int m = 0; m < 4; ++m) { float* rowp = (float*)O + (size_t)(row0 + ai * HALF + m * 16) * ldc + col0;
#pragma unroll
                    for (int bj = 0; bj < 2; ++bj) { *(f32x4*)(rowp + bj * HALF) = acc[ai][bj][m][0]; *(f32x4*)(rowp + bj * HALF + 4) = acc[ai][bj][m][1]; } }
        } else {
#pragma unroll
            for (int ai = 0; ai < 2; ++ai)
#pragma unroll
                for (int m = 0; m < 4; ++m) { bf16_t* rowp = (bf16_t*)O + (size_t)(row0 + ai * HALF + m * 16) * ldc + col0;
#pragma unroll
                    for (int bj = 0; bj < 2; ++bj) { const f32x4 v0 = acc[ai][bj][m][0], v1 = acc[ai][bj][m][1];
                        u32x4 w; w.x = cvt_pk_bf16(v0[0], v0[1]); w.y = cvt_pk_bf16(v0[2], v0[3]); w.z = cvt_pk_bf16(v1[0], v1[1]); w.w = cvt_pk_bf16(v1[2], v1[3]);
                        if (col0 + bj * HALF < ncols) *(u32x4*)(rowp + bj * HALF) = w; } }
        }
    }
};
}

#define XB_TMO      128
#define XB_XCNT(j)  (256  + 64 * (j))
#define XB_XSUB(j)  (1280 + 64 * (j))
#define XB_XGEN(j)  (2304 + 64 * (j))
#define XB_TOP      3328
#define XB_TOPGEN   3392
#define XCD_BAR_WORDS 3456
#define XB_SPIN_CAP (1u << 18)
#define LAS __attribute__((address_space(3)))

__device__ __forceinline__ unsigned xb_ld(unsigned* p)              { return __hip_atomic_load(p, __ATOMIC_RELAXED, __HIP_MEMORY_SCOPE_AGENT); }
__device__ __forceinline__ unsigned xb_add(unsigned* p, unsigned v) { return __hip_atomic_fetch_add(p, v, __ATOMIC_RELAXED, __HIP_MEMORY_SCOPE_AGENT); }
__device__ __forceinline__ unsigned xb_xcc_id() { return (unsigned)__builtin_amdgcn_s_getreg((3 << 11) | 20) & 0xFu; }
#define XB_SPIN(cond, bar) do { unsigned _sp = 0; while (cond) { __builtin_amdgcn_s_sleep(1); \
    if ((++_sp & 255u) == 0u) { if (xb_ld(&(bar)[XB_TMO])) break; if (_sp > XB_SPIN_CAP) { atomicAdd(&(bar)[XB_TMO], 1u); break; } } } } while (0)

struct XcdBarrier {
    unsigned* bar; unsigned x;
    volatile LAS unsigned* st;
};

__device__ __forceinline__ XcdBarrier xcd_barrier_post(unsigned* bar, volatile LAS unsigned* st) {
    XcdBarrier b; b.bar = bar; b.x = xb_xcc_id(); b.st = st;
    if (threadIdx.x == 0) (void)xb_add(&bar[XB_XCNT(b.x)], 1u);
    return b;
}
__device__ __forceinline__ void xcd_barrier_complete(unsigned* bar, unsigned x, unsigned& nloc, unsigned& nx) {
    const unsigned G = gridDim.x * gridDim.y * gridDim.z;
    unsigned sum, cnt, mine, sp = 0u;
    for (;;) {
        sum = 0u; cnt = 0u; mine = 0u;
#pragma unroll
        for (unsigned j = 0; j < 16; ++j) { const unsigned c = xb_ld(&bar[XB_XCNT(j)]); sum += c; cnt += (c > 0u) ? 1u : 0u; mine = (j == x) ? c : mine; }
        if (sum == G) break;
        __builtin_amdgcn_s_sleep(1);
        if ((++sp & 255u) == 0u) { if (xb_ld(&bar[XB_TMO])) break; if (sp > XB_SPIN_CAP) { atomicAdd(&bar[XB_TMO], 1u); break; } }
    }
    nloc = mine > 0u ? mine : 1u; nx = cnt > 0u ? cnt : 1u;
}

__device__ __forceinline__ void xcd_barrier(const XcdBarrier& b) {
    asm volatile("s_waitcnt vmcnt(0)" ::: "memory");
    __syncthreads();
    if (threadIdx.x == 0) {
        unsigned* bar = b.bar;
        __builtin_amdgcn_s_waitcnt(0);
        unsigned nloc = b.st[0], nx = b.st[1];
        if (nloc == 0u) { xcd_barrier_complete(bar, b.x, nloc, nx); b.st[0] = nloc; b.st[1] = nx; }
        const unsigned old = xb_add(&bar[XB_XSUB(b.x)], 1u);
        const unsigned gen = old / nloc;
        if (old + 1u == (gen + 1u) * nloc) {
            __builtin_amdgcn_fence(__ATOMIC_RELEASE, "agent");
            asm volatile("s_waitcnt vmcnt(0)" ::: "memory");
            const unsigned og = xb_add(&bar[XB_TOP], 1u);
            const unsigned tg = og / nx;
            if (og + 1u == (tg + 1u) * nx) xb_add(&bar[XB_TOPGEN], 1u);
            else XB_SPIN(xb_ld(&bar[XB_TOPGEN]) == tg, bar);
            __builtin_amdgcn_fence(__ATOMIC_ACQUIRE, "agent");
            xb_add(&bar[XB_XGEN(b.x)], 1u);
            asm volatile("s_waitcnt vmcnt(0)" ::: "memory");
        } else {
            XB_SPIN(xb_ld(&bar[XB_XGEN(b.x)]) == gen, bar);
            __builtin_amdgcn_fence(__ATOMIC_ACQUIRE, "agent");
            asm volatile("s_waitcnt vmcnt(0)" ::: "memory");
        }
    }
    __syncthreads();
}

__device__ void phase_mod_item(const Params& p, int it, unsigned char* smem) {
  float* red = (float*)smem;
  const int tid = opaque_tid(), tx = tid & 31, ty = tid >> 5;
  float* mod = (float*)(p.ws + OFF_MOD);
  it = opq(it);
  {
    int l = it / 96;
    int j = (it % 96) * 32 + tx;
    const float* W = p.ada_w + (size_t)l * 1024 * 3072;
    float acc = 0.f;
    for (int i = 0; i < 128; ++i) {
      int k = ty * 128 + i;
      float cv = p.c[k];
      acc += silu(cv) * W[(size_t)k * 3072 + j];
    }
    red[ty * 32 + tx] = acc;
    __syncthreads();
    if (ty == 0) {
      float s = 0.f;
      for (int g = 0; g < 8; ++g) s += red[g * 32 + tx];
      mod[l * 3072 + j] = s + p.ada_b[l * 3072 + j];
    }
    __syncthreads();
  }
}

__device__ __forceinline__ float wall_src(const Params& p, int l, int k, int n) {
  size_t lk = (size_t)l * 1024 + k;
  if (n < 3072) return p.w_in[lk * 3072 + n];
  if (n < 3136) return (1.f - p.mu_w[lk]) * p.w1[lk * 64 + (n - 3072)];
  if (n < 3200) return p.mu_w[lk] * p.w1[lk * 64 + (n - 3136)];
  if (n < 3264) return (1.f - p.mu_a[lk]) * p.a1[lk * 64 + (n - 3200)];
  if (n < 3328) return p.mu_a[lk] * p.a1[lk * 64 + (n - 3264)];
  if (n < 3344) return p.gk1[lk * 16 + (n - 3328)];
  return 0.f;
}

__device__ void phase_wconv_item(const Params& p, int it, unsigned char* smem) {
  float* tile = (float*)smem;
  const int tid = opaque_tid();
  u16* WALL = (u16*)(p.ws + OFF_WALL);
  u16* WOUT = (u16*)(p.ws + OFF_WOUT);
  it = opq(it);
  {
    bool isout = it >= 3456;
    int l, nt, kt;
    if (!isout) { l = it / 864; int r = it % 864; nt = r >> 4; kt = r & 15; }
    else { int r = it - 3456; l = r >> 8; r &= 255; nt = r >> 4; kt = r & 15; }
    int tx = tid & 63, ty = tid >> 6;
#pragma unroll 4
    for (int i = 0; i < 16; ++i) {
      int kl = ty + 4 * i;
      int k = kt * 64 + kl, n = nt * 64 + tx;
      float v = isout ? p.w_out[((size_t)l * 1024 + k) * 1024 + n] : wall_src(p, l, k, n);
      tile[kl * 65 + tx] = v;
    }
    __syncthreads();
    int nl = tid >> 2, kq = tid & 3;
    unsigned w[8];
#pragma unroll
    for (int j = 0; j < 8; ++j) w[j] = pack2(tile[(kq * 16 + 2 * j) * 65 + nl], tile[(kq * 16 + 2 * j + 1) * 65 + nl]);
    u16* dst = (isout ? WOUT + ((size_t)l * 1024 + nt * 64 + nl) * 1024 : WALL + ((size_t)l * NALL + nt * 64 + nl) * 1024) + kt * 64 + kq * 16;
    ((uint4*)dst)[0] = make_uint4(w[0], w[1], w[2], w[3]);
    ((uint4*)dst)[1] = make_uint4(w[4], w[5], w[6], w[7]);
    __syncthreads();
  }
}

__device__ void phase_w2t_item(const Params& p, int it) {
  it = opq(it);
  const int c = opaque_tid();
  const int l = it >> 1, which = it & 1;
  const float* src = (which ? p.a2 : p.w2) + (size_t)l * 64 * 256 + c;
  u16* dst = (u16*)(p.ws + (which ? OFF_A2T : OFF_W2T)) + ((size_t)l * 256 + c) * 64;
#pragma unroll
  for (int j8 = 0; j8 < 8; ++j8) {
    float f[8];
#pragma unroll
    for (int q = 0; q < 8; ++q) f[q] = src[(j8 * 8 + q) * 256];
    *(uint4*)(dst + j8 * 8) = make_uint4(pack2(f[0], f[1]), pack2(f[2], f[3]), pack2(f[4], f[5]), pack2(f[6], f[7]));
  }
}

__device__ __forceinline__ void write_h(const Params& p, int l, int row, int lane, const float4* v, float ss) {
  const float* mod = (const float*)(p.ws + OFF_MOD) + l * 3072;
  u16* H = (u16*)(p.ws + OFF_H);
  float rs = rsqrtf(ss * (1.f / 1024.f) + 1e-6f);
#pragma unroll
  for (int i = 0; i < 4; ++i) {
    int col = (lane + 64 * i) * 4;
    float4 g = *(const float4*)(p.norm_pre + l * 1024 + col);
    float4 sh = *(const float4*)(mod + col);
    float4 sc = *(const float4*)(mod + 1024 + col);
    float h0 = v[i].x * rs * g.x * (1.f + sc.x) + sh.x;
    float h1 = v[i].y * rs * g.y * (1.f + sc.y) + sh.y;
    float h2 = v[i].z * rs * g.z * (1.f + sc.z) + sh.z;
    float h3 = v[i].w * rs * g.w * (1.f + sc.w) + sh.w;
    *(uint2*)(H + (size_t)row * 1024 + col) = make_uint2(pack2(h0, h1), pack2(h2, h3));
  }
}

__device__ void phase_h0(const Params& p) {
  const int tid = opaque_tid512(); const int wave = tid >> 6, lane = tid & 63;
  for (int row = blockIdx.x * 8 + wave; row < T_; row += gridDim.x * 8) {
    const float4* xr = (const float4*)(p.x + (size_t)row * 1024);
    float4 v[4];
    float ss = 0.f;
#pragma unroll
    for (int i = 0; i < 4; ++i) {
      v[i] = xr[lane + 64 * i];
      ss += v[i].x * v[i].x + v[i].y * v[i].y + v[i].z * v[i].z + v[i].w * v[i].w;
    }
    ss = wave_sum(ss);
    write_h(p, 0, row, lane, v, ss);
  }
}

__device__ void phase_post(const Params& p, int l) {
  l = opq(l);
  const int tid = opaque_tid512(); const int wave = tid >> 6, lane = tid & 63;
  const float* Y = (const float*)(p.ws + OFF_PROJ);
  const float* mod = (const float*)(p.ws + OFF_MOD) + l * 3072;
  const float* xold = (l == 0) ? p.x : p.out;
  for (int row = blockIdx.x * 8 + wave; row < T_; row += gridDim.x * 8) {
    const float4* yr = (const float4*)(Y + (size_t)row * 1024);
    const float4* xr = (const float4*)(xold + (size_t)row * 1024);
    float4 y[4], v[4];
    float ss = 0.f;
#pragma unroll
    for (int i = 0; i < 4; ++i) {
      y[i] = yr[lane + 64 * i];
      v[i] = xr[lane + 64 * i];
      ss += y[i].x * y[i].x + y[i].y * y[i].y + y[i].z * y[i].z + y[i].w * y[i].w;
    }
    ss = wave_sum(ss);
    float rs = rsqrtf(ss * (1.f / 1024.f) + 1e-6f);
    float s2 = 0.f;
#pragma unroll
    for (int i = 0; i < 4; ++i) {
      int col = (lane + 64 * i) * 4;
      float4 g = *(const float4*)(p.norm_post + l * 1024 + col);
      float4 gt = *(const float4*)(mod + 2048 + col);
      v[i].x += gt.x * (y[i].x * rs * g.x);
      v[i].y += gt.y * (y[i].y * rs * g.y);
      v[i].z += gt.z * (y[i].z * rs * g.z);
      v[i].w += gt.w * (y[i].w * rs * g.w);
      *(float4*)(p.out + (size_t)row * 1024 + col) = v[i];
      s2 += v[i].x * v[i].x + v[i].y * v[i].y + v[i].z * v[i].z + v[i].w * v[i].w;
    }
    if (l < 3) {
      s2 = wave_sum(s2);
      write_h(p, l + 1, row, lane, v, s2);
    }
  }
}

__device__ void attn_item(const Params& p, int l, int item, unsigned char* smem) {
  l = opq(l); item = opq(item);
  u16* Vt = (u16*)smem;
  const u16* PROJ = (const u16*)(p.ws + OFF_PROJ);
  u16* MIX = (u16*)(p.ws + OFF_MIX);
  const int tid = opaque_tid(), w = tid >> 6, lane = tid & 63, l31 = lane & 31, hf = lane >> 5;
  const int qb = item >> 3, head = item & 7, kvh = head >> 2;
  const int kpos0 = (qb - 1) * 128;
  {
    int kp = kpos0 + tid;
    if (kp < 0) kp = 0;
    const uint4* src = (const uint4*)(PROJ + (size_t)kp * NALL + 640 + kvh * 64);
#pragma unroll
    for (int c8 = 0; c8 < 8; ++c8) {
      uint4 v = src[c8];
      int d = c8 * 8;
      Vt[(d + 0) * 264 + tid] = (u16)(v.x & 0xffff);
      Vt[(d + 1) * 264 + tid] = (u16)(v.x >> 16);
      Vt[(d + 2) * 264 + tid] = (u16)(v.y & 0xffff);
      Vt[(d + 3) * 264 + tid] = (u16)(v.y >> 16);
      Vt[(d + 4) * 264 + tid] = (u16)(v.z & 0xffff);
      Vt[(d + 5) * 264 + tid] = (u16)(v.z >> 16);
      Vt[(d + 6) * 264 + tid] = (u16)(v.w & 0xffff);
      Vt[(d + 7) * 264 + tid] = (u16)(v.w >> 16);
    }
  }
  __syncthreads();
  const int tq = qb * 128 + 32 * w + l31;
  bf16x8 qf[4];
  {
    const u16* qp = PROJ + (size_t)tq * NALL + head * 64 + 8 * hf;
#pragma unroll
    for (int s = 0; s < 4; ++s) qf[s] = *(const bf16x8*)(qp + 16 * s);
  }
  const float slope = exp2f(-(float)(head + 1));
  const float sink = p.sinks[l * 8 + head];
  const int rq = 32 * w + l31;
  float mrun = -1e30f, lsum = 0.f;
  f32x16 o0, o1;
#pragma unroll
  for (int r = 0; r < 16; ++r) { o0[r] = 0.f; o1[r] = 0.f; }
#pragma unroll 1
  for (int i = 0; i < 5; ++i) {
    int kp = kpos0 + 32 * w + 32 * i + l31;
    if (kp < 0) kp = 0;
    const u16* kptr = PROJ + (size_t)kp * NALL + 512 + kvh * 64 + 8 * hf;
    f32x16 a;
#pragma unroll
    for (int r = 0; r < 16; ++r) a[r] = 0.f;
#pragma unroll
    for (int s = 0; s < 4; ++s) {
      bf16x8 kf = *(const bf16x8*)(kptr + 16 * s);
      a = __builtin_amdgcn_mfma_f32_32x32x16_bf16(kf, qf[s], a, 0, 0, 0);
    }
    float tmax = -1e30f;
#pragma unroll
    for (int r = 0; r < 16; ++r) {
      int kj = 32 * w + 32 * i + (r & 3) + 8 * (r >> 2) + 4 * hf;
      int dist = 128 + rq - kj;
      bool valid = (dist >= 0) && (dist < 128) && (kpos0 + kj >= 0);
      float sv = a[r] * 0.125f - slope * (float)dist;
      sv = valid ? sv : -1e30f;
      a[r] = sv;
      tmax = fmaxf(tmax, sv);
    }
    tmax = fmaxf(tmax, __shfl_xor(tmax, 32));
    const float mnew = fmaxf(mrun, tmax);
    const float alpha = __expf(mrun - mnew);
    float psum = 0.f;
#pragma unroll
    for (int r = 0; r < 16; ++r) {
      float e = (a[r] > -1e29f) ? __expf(a[r] - mnew) : 0.f;
      a[r] = e;
      psum += e;
    }
    lsum = lsum * alpha + psum;
    mrun = mnew;
#pragma unroll
    for (int r = 0; r < 16; ++r) { o0[r] *= alpha; o1[r] *= alpha; }
#pragma unroll
    for (int u = 0; u < 2; ++u) {
      bf16x8 pf;
#pragma unroll
      for (int j = 0; j < 8; ++j) pf[j] = (short)f2bf(a[8 * u + j]);
      const int kb = 32 * w + 32 * i + 16 * u + 4 * hf;
      const u16* v0 = Vt + l31 * 264 + kb;
      const u16* v1 = Vt + (32 + l31) * 264 + kb;
      uint2 a0 = *(const uint2*)(v0), a1 = *(const uint2*)(v0 + 8);
      uint2 b0 = *(const uint2*)(v1), b1 = *(const uint2*)(v1 + 8);
      uint4 A0 = make_uint4(a0.x, a0.y, a1.x, a1.y), A1 = make_uint4(b0.x, b0.y, b1.x, b1.y);
      o0 = __builtin_amdgcn_mfma_f32_32x32x16_bf16(__builtin_bit_cast(bf16x8, A0), pf, o0, 0, 0, 0);
      o1 = __builtin_amdgcn_mfma_f32_32x32x16_bf16(__builtin_bit_cast(bf16x8, A1), pf, o1, 0, 0, 0);
    }
  }
  {
    const float mf = fmaxf(mrun, sink);
    const float scl = __expf(mrun - mf);
    const float ltot = (lsum + __shfl_xor(lsum, 32)) * scl + __expf(sink - mf);
    const float fin = scl / ltot;
#pragma unroll
    for (int r = 0; r < 16; ++r) { o0[r] *= fin; o1[r] *= fin; }
  }
  const u16* gp = PROJ + (size_t)tq * NALL + 768 + head * 64;
  u16* op = MIX + (size_t)tq * 1024 + head * 64;
#pragma unroll
  for (int g = 0; g < 4; ++g) {
    int d0 = 8 * g + 4 * hf;
    uint2 gg = *(const uint2*)(gp + d0);
    float r0 = o0[4 * g + 0] * silu(bflo(gg.x)), r1 = o0[4 * g + 1] * silu(bfhi(gg.x));
    float r2 = o0[4 * g + 2] * silu(bflo(gg.y)), r3 = o0[4 * g + 3] * silu(bfhi(gg.y));
    *(uint2*)(op + d0) = make_uint2(pack2(r0, r1), pack2(r2, r3));
    uint2 g2 = *(const uint2*)(gp + 32 + d0);
    r0 = o1[4 * g + 0] * silu(bflo(g2.x)); r1 = o1[4 * g + 1] * silu(bfhi(g2.x));
    r2 = o1[4 * g + 2] * silu(bflo(g2.y)); r3 = o1[4 * g + 3] * silu(bfhi(g2.y));
    *(uint2*)(op + 32 + d0) = make_uint2(pack2(r0, r1), pack2(r2, r3));
  }
  __syncthreads();
}

__device__ void rwkv_prep_item(const Params& p, int l, int item, unsigned char* smem) {
  l = opq(l); item = opq(item);
  u16* lwb = (u16*)smem;
  u16* lab = lwb + 16 * 72;
  const u16* PROJ = (const u16*)(p.ws + OFF_PROJ);
  const int tid = opaque_tid(), head = tid >> 6, lane = tid & 63, fr = lane & 15, fq = lane >> 4;
  const int t0 = item * 16;
#pragma unroll
  for (int i = 0; i < 8; ++i) {
    int idx = tid + 256 * i;
    int which = idx >> 10, tt = (idx >> 6) & 15, j = idx & 63;
    int t = t0 + tt;
    const u16* pr = PROJ + (size_t)t * NALL;
    float cur = bf2f(pr[(which ? 3200 : 3072) + j]);
    float prev = (t > 0) ? bf2f((pr - NALL)[(which ? 3264 : 3136) + j]) : 0.f;
    float sv = cur + prev;
    if (!which) sv = tanhf(sv);
    (which ? lab : lwb)[tt * 72 + j] = f2bf(sv);
  }
  __syncthreads();
  f32x4 accw[4], acca[4];
#pragma unroll
  for (int nt = 0; nt < 4; ++nt) { accw[nt] = (f32x4){0.f, 0.f, 0.f, 0.f}; acca[nt] = (f32x4){0.f, 0.f, 0.f, 0.f}; }
  {
    const u16* W2T = (const u16*)(p.ws + OFF_W2T) + ((size_t)l * 256 + head * 64 + fr) * 64 + fq * 8;
    const u16* A2T = (const u16*)(p.ws + OFF_A2T) + ((size_t)l * 256 + head * 64 + fr) * 64 + fq * 8;
#pragma unroll
    for (int ks = 0; ks < 2; ++ks) {
      const bf16x8 aw = *(const bf16x8*)(lwb + fr * 72 + ks * 32 + fq * 8);
      const bf16x8 aa = *(const bf16x8*)(lab + fr * 72 + ks * 32 + fq * 8);
#pragma unroll
      for (int nt = 0; nt < 4; ++nt) {
        const bf16x8 bw = *(const bf16x8*)(W2T + nt * 16 * 64 + ks * 32);
        const bf16x8 ba = *(const bf16x8*)(A2T + nt * 16 * 64 + ks * 32);
        accw[nt] = __builtin_amdgcn_mfma_f32_16x16x32_bf16(aw, bw, accw[nt], 0, 0, 0);
        acca[nt] = __builtin_amdgcn_mfma_f32_16x16x32_bf16(aa, ba, acca[nt], 0, 0, 0);
      }
    }
  }
  float mur[4], muk[4], muv[4], w0[4], a0[4], kkw[4], kaw[4], rkw[4];
#pragma unroll
  for (int nt = 0; nt < 4; ++nt) {
    const int c = head * 64 + nt * 16 + fr;
    mur[nt] = p.mu_rkv[l * 768 + c]; muk[nt] = p.mu_rkv[l * 768 + 256 + c]; muv[nt] = p.mu_rkv[l * 768 + 512 + c];
    w0[nt] = p.w0[l * 256 + c]; a0[nt] = p.a0[l * 256 + c]; kkw[nt] = p.k_k[l * 256 + c]; kaw[nt] = p.k_a[l * 256 + c]; rkw[nt] = p.r_k[l * 256 + c];
  }
  float* RWW = (float*)(p.ws + OFF_RWW);
  float* RWKK = (float*)(p.ws + OFF_RWKK);
  u16* RB = (u16*)(p.ws + OFF_RWB);
  float* BON = (float*)(p.ws + OFF_BONUS);
#pragma unroll
  for (int rg = 0; rg < 4; ++rg) {
    const int t = t0 + fq * 4 + rg;
    const u16* pr = PROJ + (size_t)t * NALL;
    float kkc[4], av[4];
    float n2 = 0.f, bonus = 0.f;
#pragma unroll
    for (int nt = 0; nt < 4; ++nt) {
      const int c = head * 64 + nt * 16 + fr;
      float rc = bf2f(pr[1280 + c]), kc = bf2f(pr[1536 + c]), vc = bf2f(pr[1792 + c]);
      float rp = 0.f, kp = 0.f, vp = 0.f;
      if (t > 0) { rp = bf2f((pr - NALL)[1280 + c]); kp = bf2f((pr - NALL)[1536 + c]); vp = bf2f((pr - NALL)[1792 + c]); }
      const float r = rc + (rp - rc) * mur[nt], k = kc + (kp - kc) * muk[nt], v = vc + (vp - vc) * muv[nt];
      const float wpre = w0[nt] + accw[nt][rg];
      const float wl = -softplusf_(-wpre) - 0.5f;
      const float decay = __expf(-__expf(wl));
      const float a = sigmoidf_(a0[nt] + acca[nt][rg]);
      const float kc2 = k * kkw[nt];
      const float kmod = k * (1.f + (a - 1.f) * kaw[nt]);
      kkc[nt] = kc2; av[nt] = a;
      n2 += kc2 * kc2;
      bonus += r * kmod * rkw[nt];
      const size_t o = (size_t)t * 256 + c;
      RWW[o] = decay;
      RB[o] = f2bf(r);
      RB[(size_t)T_ * 256 + o] = f2bf(kmod);
      RB[(size_t)2 * T_ * 256 + o] = f2bf(v);
    }
    n2 = row16_allsum(n2);
    bonus = row16_allsum(bonus);
    const float inv = 1.f / fmaxf(sqrtf(n2), 1e-12f);
#pragma unroll
    for (int nt = 0; nt < 4; ++nt) {
      const int c = head * 64 + nt * 16 + fr;
      const size_t o = (size_t)t * 256 + c;
      const float kk = kkc[nt] * inv;
      RWKK[o] = kk;
      RB[(size_t)3 * T_ * 256 + o] = f2bf(kk * av[nt]);
    }
    if (fr == 0) BON[t * 4 + head] = bonus;
  }
  __syncthreads();
}

__device__ __forceinline__ void gla_b(const Params& p, int l, int chunk, int head, float* tot, float* bl) {
  const u16* PROJ = (const u16*)(p.ws + OFF_PROJ);
  const int tid = opaque_tid(), d = tid & 31, ig = tid >> 5;
  float g2[16];
#pragma unroll
  for (int m = 0; m < 16; ++m) g2[m] = p.gk2[(size_t)l * 16 * 128 + m * 128 + head * 32 + d];
  const float bias = p.gk_b[l * 128 + head * 32 + d];
  float run = 0.f;
#pragma unroll
  for (int ii = 0; ii < 8; ++ii) {
    int t = chunk * 64 + ig * 8 + ii;
    const uint4* lp = (const uint4*)(PROJ + (size_t)t * NALL + 3328);
    uint4 u0 = lp[0], u1 = lp[1];
    float z = bias;
    z += bflo(u0.x) * g2[0] + bfhi(u0.x) * g2[1] + bflo(u0.y) * g2[2] + bfhi(u0.y) * g2[3];
    z += bflo(u0.z) * g2[4] + bfhi(u0.z) * g2[5] + bflo(u0.w) * g2[6] + bfhi(u0.w) * g2[7];
    z += bflo(u1.x) * g2[8] + bfhi(u1.x) * g2[9] + bflo(u1.y) * g2[10] + bfhi(u1.y) * g2[11];
    z += bflo(u1.z) * g2[12] + bfhi(u1.z) * g2[13] + bflo(u1.w) * g2[14] + bfhi(u1.w) * g2[15];
    float g = (fminf(z, 0.f) - log1pf(__expf(-fabsf(z)))) * (1.f / 16.f);
    run += g;
    bl[ii] = run;
  }
  tot[ig * 32 + d] = run;
  __syncthreads();
  float off = 0.f;
#pragma unroll
  for (int g = 0; g < 8; ++g) off += (g < ig) ? tot[g * 32 + d] : 0.f;
#pragma unroll
  for (int ii = 0; ii < 8; ++ii) bl[ii] += off;
}

__device__ void gla_local_item(const Params& p, int l, int item, unsigned char* smem) {
  l = opq(l); item = opq(item);
  float* tot = (float*)smem;
  float* Kp = tot + 256;
  float* Vs = Kp + 2048;
  const u16* PROJ = (const u16*)(p.ws + OFF_PROJ);
  const int tid = opaque_tid(), d = tid & 31, ig = tid >> 5;
  const int chunk = item >> 2, head = item & 3;
  float bl[8];
  gla_b(p, l, chunk, head, tot, bl);
  float blast = 0.f;
#pragma unroll
  for (int g = 0; g < 8; ++g) blast += tot[g * 32 + d];
#pragma unroll
  for (int ii = 0; ii < 8; ++ii) {
    int i = ig * 8 + ii;
    int t = chunk * 64 + i;
    float k = bf2f(PROJ[(size_t)t * NALL + 2432 + head * 32 + d]);
    Kp[i * 32 + d] = k * __expf(blast - bl[ii]);
  }
#pragma unroll
  for (int r = 0; r < 16; ++r) {
    int idx = tid + 256 * r;
    int i = idx >> 6, v = idx & 63;
    Vs[idx] = bf2f(PROJ[(size_t)(chunk * 64 + i) * NALL + 2560 + head * 64 + v]);
  }
  __syncthreads();
  const int v = tid & 63, dg = tid >> 6;
  float acc[8];
#pragma unroll
  for (int q = 0; q < 8; ++q) acc[q] = 0.f;
  for (int i = 0; i < 64; ++i) {
    float vv = Vs[i * 64 + v];
    float4 k0 = *(const float4*)(Kp + i * 32 + dg * 8), k1 = *(const float4*)(Kp + i * 32 + dg * 8 + 4);
    acc[0] += k0.x * vv; acc[1] += k0.y * vv; acc[2] += k0.z * vv; acc[3] += k0.w * vv;
    acc[4] += k1.x * vv; acc[5] += k1.y * vv; acc[6] += k1.z * vv; acc[7] += k1.w * vv;
  }
  float* GS = (float*)(p.ws + OFF_GLAS);
  float* GD = (float*)(p.ws + OFF_GLAD);
#pragma unroll
  for (int q = 0; q < 8; ++q) GS[((size_t)(chunk * 4 + head) * 32 + dg * 8 + q) * 64 + v] = acc[q];
  if (tid < 32) GD[(chunk * 4 + head) * 32 + tid] = __expf(blast);
  __syncthreads();
}

__device__ void gla_state_block(const Params& p, int eb, unsigned char* dsm_) {
  float* comp = (float*)dsm_;
  float* GS = (float*)(p.ws + OFF_GLAS);
  const float* GD = (const float*)(p.ws + OFF_GLAD);
  eb = opq(eb);
  const int tid = opaque_tid512();
  const int ei = tid & 31, g = tid >> 5;
  const int e = eb * 32 + ei;
  const int head = e >> 11, d = (e >> 6) & 31, v = e & 63;
  float ds[16], dc[16];
#pragma unroll
  for (int i = 0; i < 16; ++i) {
    const int c = g * 16 + i;
    ds[i] = GS[((size_t)(c * 4 + head) * 32 + d) * 64 + v];
    dc[i] = GD[(c * 4 + head) * 32 + d];
  }
  float S = 0.f, P = 1.f;
#pragma unroll
  for (int i = 0; i < 16; ++i) { S = dc[i] * S + ds[i]; P *= dc[i]; }
  comp[(g * 32 + ei) * 2] = P;
  comp[(g * 32 + ei) * 2 + 1] = S;
  __syncthreads();
  float G = 0.f;
  for (int gg = 0; gg < g; ++gg) G = comp[(gg * 32 + ei) * 2] * G + comp[(gg * 32 + ei) * 2 + 1];
#pragma unroll
  for (int i = 0; i < 16; ++i) {
    const int c = g * 16 + i;
    GS[((size_t)(c * 4 + head) * 32 + d) * 64 + v] = G;
    G = dc[i] * G + ds[i];
  }
  __syncthreads();
}

__device__ void gla_out_item(const Params& p, int l, int item, unsigned char* smem) {
  l = opq(l); item = opq(item);
  float* tot = (float*)smem;
  float* qt = tot + 256;
  float* kt = qt + 2304;
  float* Vs = kt + 2304;
  float* Am = Vs + 4096;
  float* Ss = Am + 4352;
  const u16* PROJ = (const u16*)(p.ws + OFF_PROJ);
  u16* MIX = (u16*)(p.ws + OFF_MIX);
  const float* GS = (const float*)(p.ws + OFF_GLAS);
  const int tid = opaque_tid();
  const int chunk = item >> 2, head = item & 3;
  {
    const int d = tid & 31, ig = tid >> 5;
    float bl[8];
    gla_b(p, l, chunk, head, tot, bl);
#pragma unroll
    for (int ii = 0; ii < 8; ++ii) {
      int i = ig * 8 + ii;
      int t = chunk * 64 + i;
      float q = bf2f(PROJ[(size_t)t * NALL + 2304 + head * 32 + d]);
      float k = bf2f(PROJ[(size_t)t * NALL + 2432 + head * 32 + d]);
      qt[i * 36 + d] = q * 0.17677669529663687f * __expf(bl[ii]);
      kt[i * 36 + d] = k * __expf(-bl[ii]);
    }
  }
#pragma unroll
  for (int r = 0; r < 16; ++r) {
    int idx = tid + 256 * r;
    int i = idx >> 6, v = idx & 63;
    Vs[idx] = bf2f(PROJ[(size_t)(chunk * 64 + i) * NALL + 2560 + head * 64 + v]);
  }
#pragma unroll
  for (int r = 0; r < 8; ++r) {
    int idx = tid + 256 * r;
    Ss[idx] = GS[(size_t)(chunk * 4 + head) * 2048 + idx];
  }
  __syncthreads();
  const int j = tid & 63, ig = tid >> 6;
  {
    float acc[16];
#pragma unroll
    for (int ii = 0; ii < 16; ++ii) acc[ii] = 0.f;
#pragma unroll 2
    for (int d4 = 0; d4 < 8; ++d4) {
      const float4 kv = *(const float4*)(kt + j * 36 + d4 * 4);
#pragma unroll
      for (int ii = 0; ii < 16; ++ii) {
        const float4 qv = *(const float4*)(qt + (ig * 16 + ii) * 36 + d4 * 4);
        acc[ii] += qv.x * kv.x + qv.y * kv.y + qv.z * kv.z + qv.w * kv.w;
      }
    }
#pragma unroll
    for (int ii = 0; ii < 16; ++ii) {
      int i = ig * 16 + ii;
      Am[i * 68 + j] = (j <= i) ? acc[ii] : 0.f;
    }
  }
  __syncthreads();
  {
    const int v = j;
    float acc[16];
#pragma unroll
    for (int ii = 0; ii < 16; ++ii) acc[ii] = 0.f;
    const int jmax = (ig + 1) * 4;
    for (int j4 = 0; j4 < jmax; ++j4) {
      const float v0 = Vs[(j4 * 4 + 0) * 64 + v], v1 = Vs[(j4 * 4 + 1) * 64 + v], v2 = Vs[(j4 * 4 + 2) * 64 + v], v3 = Vs[(j4 * 4 + 3) * 64 + v];
#pragma unroll
      for (int ii = 0; ii < 16; ++ii) {
        const float4 av = *(const float4*)(Am + (ig * 16 + ii) * 68 + j4 * 4);
        acc[ii] += av.x * v0 + av.y * v1 + av.z * v2 + av.w * v3;
      }
    }
#pragma unroll 2
    for (int d4 = 0; d4 < 8; ++d4) {
      const float s0 = Ss[(d4 * 4 + 0) * 64 + v], s1 = Ss[(d4 * 4 + 1) * 64 + v], s2 = Ss[(d4 * 4 + 2) * 64 + v], s3 = Ss[(d4 * 4 + 3) * 64 + v];
#pragma unroll
      for (int ii = 0; ii < 16; ++ii) {
        const float4 qv = *(const float4*)(qt + (ig * 16 + ii) * 36 + d4 * 4);
        acc[ii] += qv.x * s0 + qv.y * s1 + qv.z * s2 + qv.w * s3;
      }
    }
    const float nw = p.gla_nw[l * 64 + v];
#pragma unroll
    for (int ii = 0; ii < 16; ++ii) {
      int t = chunk * 64 + ig * 16 + ii;
      float o = acc[ii];
      float ms = wave_sum(o * o) * (1.f / 64.f);
      float gg = bf2f(PROJ[(size_t)t * NALL + 2816 + head * 64 + v]);
      float r = o * rsqrtf(ms + 1e-5f) * nw * silu(gg);
      MIX[(size_t)t * 1024 + 768 + head * 64 + v] = f2bf(r);
    }
  }
  __syncthreads();
}

typedef float f32x2 __attribute__((ext_vector_type(2)));
__device__ __forceinline__ float oct_allsum(float x) {
  x += dpp_f<0xB1>(x);
  x += dpp_f<0x4E>(x);
  x += dpp_f<0x141>(x);
  return x;
}
__device__ void rwkv_scan_item(const Params& p, int item, unsigned char* dsm_) {
  item = opq(item);
  float* st = (float*)dsm_;
  const int tid = opaque_tid512(), wv = tid >> 6, lane = tid & 63, rs = lane >> 3, kl = lane & 7;
  const int head = item & 3, seg = item >> 2;
  const bool ident = wv >= 4;
  const int R0 = wv * 16 + rs * 2;
  const int v0 = R0 & 63;
  const float* RWW = (const float*)(p.ws + OFF_RWW);
  const float* RWKK = (const float*)(p.ws + OFF_RWKK);
  const u16* RB = (const u16*)(p.ws + OFF_RWB);
  float* PF = (float*)(p.ws + OFF_PROJ);
  float* ZP = (float*)(p.ws + OFF_ZP);
  const int tbase = seg * SL;
  const int half = tid >> 8, ls = (tid & 255) >> 4, lc4 = (tid & 15) * 4;
  f32x2 S0[4], S1[4];
#pragma unroll
  for (int e = 0; e < 4; ++e) { S0[e] = (f32x2){0.f, 0.f}; S1[e] = (f32x2){0.f, 0.f}; }
  if (ident) {
#pragma unroll
    for (int e = 0; e < 4; ++e) {
      const int k0 = kl * 8 + 2 * e;
      S0[e] = (f32x2){(v0 == k0) ? 1.f : 0.f, (v0 == k0 + 1) ? 1.f : 0.f};
      S1[e] = (f32x2){(v0 + 1 == k0) ? 1.f : 0.f, (v0 + 1 == k0 + 1) ? 1.f : 0.f};
    }
  }
  float4 g0 = make_float4(0.f, 0.f, 0.f, 0.f);
  uint2 h0 = make_uint2(0u, 0u), h1 = h0, h2 = h0;
  const float* gp0 = (half == 0 ? RWW : RWKK) + (size_t)(tbase + ls) * 256 + head * 64 + lc4;
  const u16* hp = RB + (size_t)(tbase + ls) * 256 + head * 64 + lc4;
#define SCAN_GLOAD(ch) do { const size_t _o = (size_t)(ch) * 16 * 256; g0 = *(const float4*)(gp0 + _o); \
    if (half == 0) { h0 = *(const uint2*)(hp + _o); } \
    else { h0 = *(const uint2*)(hp + (size_t)T_ * 256 + _o); h1 = *(const uint2*)(hp + (size_t)3 * T_ * 256 + _o); h2 = *(const uint2*)(hp + (size_t)2 * T_ * 256 + _o); } } while (0)
#define SCAN_LSTORE(buf) do { float* _b = st + (buf) * 6144 + ls * 64 + lc4; \
    if (half == 0) { *(float4*)(_b) = g0; *(float4*)(_b + 2048) = make_float4(bflo(h0.x), bfhi(h0.x), bflo(h0.y), bfhi(h0.y)); } \
    else { *(float4*)(_b + 1024) = g0; *(float4*)(_b + 3072) = make_float4(bflo(h0.x), bfhi(h0.x), bflo(h0.y), bfhi(h0.y)); \
           *(float4*)(_b + 4096) = make_float4(bflo(h1.x), bfhi(h1.x), bflo(h1.y), bfhi(h1.y)); *(float4*)(_b + 5120) = make_float4(bflo(h2.x), bfhi(h2.x), bflo(h2.y), bfhi(h2.y)); } } while (0)
  if (tid < 16) st[2 * 6144 + tid] = 0.f;
  SCAN_GLOAD(0);
  SCAN_LSTORE(0);
  __syncthreads();
  const int nch = SL / 16;
  float* yout = PF + (size_t)tbase * PROJF + (ident ? 256 : 0) + head * 64 + v0;
  const int voff = ident ? (2 * 6144) : (5120 + v0);
  const int vstep = ident ? 0 : 64, vbuf = ident ? 0 : 6144;
#define V2(a, i) ((f32x2){(i) ? a.z : a.x, (i) ? a.w : a.y})
#define SCAN_STEP(s_) do { \
    const float* bp = b + (s_) * 64 + kl * 8; \
    const float4 wl = *(const float4*)(bp), wh = *(const float4*)(bp + 4); \
    const float4 kkl = *(const float4*)(bp + 1024), kkh = *(const float4*)(bp + 1028); \
    const float4 rl4 = *(const float4*)(bp + 2048), rh4 = *(const float4*)(bp + 2052); \
    const float4 kl4 = *(const float4*)(bp + 3072), kh4 = *(const float4*)(bp + 3076); \
    const float4 bl4 = *(const float4*)(bp + 4096), bh4 = *(const float4*)(bp + 4100); \
    const f32x2 vv = *(const f32x2*)(vsrc + (s_) * vstep); \
    const f32x2 W[4] = {V2(wl, 0), V2(wl, 1), V2(wh, 0), V2(wh, 1)}, KK[4] = {V2(kkl, 0), V2(kkl, 1), V2(kkh, 0), V2(kkh, 1)}; \
    const f32x2 RR[4] = {V2(rl4, 0), V2(rl4, 1), V2(rh4, 0), V2(rh4, 1)}, KV[4] = {V2(kl4, 0), V2(kl4, 1), V2(kh4, 0), V2(kh4, 1)}; \
    const f32x2 BB[4] = {V2(bl4, 0), V2(bl4, 1), V2(bh4, 0), V2(bh4, 1)}; \
    f32x2 t0 = S0[0] * KK[0] + S0[1] * KK[1] + S0[2] * KK[2] + S0[3] * KK[3]; \
    f32x2 t1 = S1[0] * KK[0] + S1[1] * KK[1] + S1[2] * KK[2] + S1[3] * KK[3]; \
    float sa0 = -(t0.x + t0.y), sa1 = -(t1.x + t1.y); \
    sa0 += dpp_f<0xB1>(sa0); sa1 += dpp_f<0xB1>(sa1); sa0 += dpp_f<0x4E>(sa0); sa1 += dpp_f<0x4E>(sa1); sa0 += dpp_f<0x141>(sa0); sa1 += dpp_f<0x141>(sa1); \
    const f32x2 a0 = {sa0, sa0}, a1 = {sa1, sa1}, u0 = {vv.x, vv.x}, u1 = {vv.y, vv.y}; \
    _Pragma("unroll") for (int e = 0; e < 4; ++e) { S0[e] = S0[e] * W[e] + a0 * BB[e] + u0 * KV[e]; S1[e] = S1[e] * W[e] + a1 * BB[e] + u1 * KV[e]; } \
    f32x2 q0 = S0[0] * RR[0] + S0[1] * RR[1] + S0[2] * RR[2] + S0[3] * RR[3]; \
    f32x2 q1 = S1[0] * RR[0] + S1[1] * RR[1] + S1[2] * RR[2] + S1[3] * RR[3]; \
    float y0 = q0.x + q0.y, y1 = q1.x + q1.y; \
    y0 += dpp_f<0xB1>(y0); y1 += dpp_f<0xB1>(y1); y0 += dpp_f<0x4E>(y0); y1 += dpp_f<0x4E>(y1); y0 += dpp_f<0x141>(y0); y1 += dpp_f<0x141>(y1); \
    const bool mine = (kl == ((s_) & 7)); \
    if ((s_) < 8) { ya.x = mine ? y0 : ya.x; ya.y = mine ? y1 : ya.y; } else { yb.x = mine ? y0 : yb.x; yb.y = mine ? y1 : yb.y; } } while (0)
  for (int ch = 0; ch < nch; ++ch) {
    const int cur = ch & 1;
    if (ch + 1 < nch) SCAN_GLOAD(ch + 1);
    const float* b = st + cur * 6144;
    const float* vsrc = st + voff + cur * vbuf;
    f32x2 ya = {0.f, 0.f}, yb = {0.f, 0.f};
#pragma unroll 2
    for (int s = 0; s < 8; ++s) SCAN_STEP(s);
#pragma unroll 2
    for (int s = 8; s < 16; ++s) SCAN_STEP(s);
    *(f32x2*)(yout + (size_t)(ch * 16 + kl) * PROJF) = ya;
    *(f32x2*)(yout + (size_t)(ch * 16 + 8 + kl) * PROJF) = yb;
    if (ch + 1 < nch) SCAN_LSTORE(cur ^ 1);
    __syncthreads();
  }
#pragma unroll
  for (int j = 0; j < 2; ++j) {
    float* zp = ZP + ((size_t)((seg * 4 + head) * 128 + R0 + j)) * 64 + kl * 8;
    if (j == 0) { *(float4*)(zp) = make_float4(S0[0].x, S0[0].y, S0[1].x, S0[1].y); *(float4*)(zp + 4) = make_float4(S0[2].x, S0[2].y, S0[3].x, S0[3].y); }
    else { *(float4*)(zp) = make_float4(S1[0].x, S1[0].y, S1[1].x, S1[1].y); *(float4*)(zp + 4) = make_float4(S1[2].x, S1[2].y, S1[3].x, S1[3].y); }
  }
}

__device__ void rwkv_combine(const Params& p, unsigned char* dsm_) {
  float* ring = (float*)dsm_;
  float* ZP = (float*)(p.ws + OFF_ZP);
  const int tid = opaque_tid512(); const int lane = tid & 63;
  const int rowi = blockIdx.x * 8 + (tid >> 6);
  const int head = rowi >> 6, v = rowi & 63;
  float4 pa0, pa1, pa2, pa3, pb0, pb1, pb2, pb3;
  float z0, z1, z2, z3;
#define COMB_ONE(stg_, q, PA, PB, Z) do { const float* base = ZP + (size_t)((((stg_) * 4 + q) * 4 + head) * 128) * 64; \
      PA = ((const float4*)(base + 4096))[tid]; PB = ((const float4*)(base + 4096))[tid + 512]; Z = base[v * 64 + lane]; } while (0)
#define COMB_ISSUE(stg_) do { COMB_ONE(stg_, 0, pa0, pb0, z0); COMB_ONE(stg_, 1, pa1, pb1, z1); COMB_ONE(stg_, 2, pa2, pb2, z2); COMB_ONE(stg_, 3, pa3, pb3, z3); } while (0)
#define COMB_SEG(q, ZC) do { const int seg = stg * 4 + q; \
      ZP[((size_t)((seg * 4 + head) * 128 + v)) * 64 + lane] = s; \
      float ns0 = ZC, ns1 = 0.f; const float* P = buf + q * 4096 + lane; \
      _Pragma("unroll") for (int i = 0; i < 64; i += 2) { \
        float s0 = __builtin_bit_cast(float, __builtin_amdgcn_readlane(__builtin_bit_cast(int, s), i)); \
        float s1 = __builtin_bit_cast(float, __builtin_amdgcn_readlane(__builtin_bit_cast(int, s), i + 1)); \
        ns0 += s0 * P[i * 64]; ns1 += s1 * P[(i + 1) * 64]; } \
      s = ns0 + ns1; } while (0)
  COMB_ISSUE(0);
  float s = 0.f;
#pragma unroll 1
  for (int stg = 0; stg < NSEG / 4; ++stg) {
    float* buf = ring + (stg & 1) * 16384;
    ((float4*)(buf))[tid] = pa0; ((float4*)(buf))[tid + 512] = pb0;
    ((float4*)(buf + 4096))[tid] = pa1; ((float4*)(buf + 4096))[tid + 512] = pb1;
    ((float4*)(buf + 8192))[tid] = pa2; ((float4*)(buf + 8192))[tid + 512] = pb2;
    ((float4*)(buf + 12288))[tid] = pa3; ((float4*)(buf + 12288))[tid + 512] = pb3;
    const float c0 = z0, c1 = z1, c2 = z2, c3 = z3;
    __syncthreads();
    if (stg + 1 < NSEG / 4) COMB_ISSUE(stg + 1);
    COMB_SEG(0, c0); COMB_SEG(1, c1); COMB_SEG(2, c2); COMB_SEG(3, c3);
  }
  __syncthreads();
}

__device__ void rwkv_final_item(const Params& p, int l, int item, unsigned char* smem) {
  l = opq(l); item = opq(item);
  float* Ss = (float*)smem;
  float* rho = Ss + 4160;
  const int tid = opaque_tid(), v = tid & 63, tg = tid >> 6;
  const int tiles = SL / 64;
  const int q = item % tiles, head = (item / tiles) & 3, seg = item / (tiles * 4);
  const int t0 = seg * SL + q * 64;
  const float* ZP = (const float*)(p.ws + OFF_ZP);
  const float* PF = (const float*)(p.ws + OFF_PROJ);
  const u16* PROJ = (const u16*)(p.ws + OFF_PROJ);
  const u16* RBv = (const u16*)(p.ws + OFF_RWB) + (size_t)2 * T_ * 256;
  const float* BON = (const float*)(p.ws + OFF_BONUS);
  u16* MIX = (u16*)(p.ws + OFF_MIX);
#pragma unroll
  for (int r = 0; r < 16; ++r) {
    int idx = tid + 256 * r;
    int row = idx >> 6, col = idx & 63;
    Ss[row * 65 + col] = ZP[((size_t)((seg * 4 + head) * 128 + row)) * 64 + col];
    rho[idx] = PF[(size_t)(t0 + row) * PROJF + 256 + head * 64 + col];
  }
  __syncthreads();
  const int c = head * 64 + v;
  const float lnw = p.ln_w[l * 256 + c], lnb = p.ln_b[l * 256 + c];
#pragma unroll 1
  for (int hh = 0; hh < 2; ++hh) {
    const int tb = tg * 16 + hh * 8;
    float acc[8];
#pragma unroll
    for (int tt = 0; tt < 8; ++tt) acc[tt] = PF[(size_t)(t0 + tb + tt) * PROJF + head * 64 + v];
#pragma unroll 2
    for (int i4 = 0; i4 < 16; ++i4) {
      float s0 = Ss[v * 65 + 4 * i4], s1 = Ss[v * 65 + 4 * i4 + 1], s2 = Ss[v * 65 + 4 * i4 + 2], s3 = Ss[v * 65 + 4 * i4 + 3];
#pragma unroll
      for (int tt = 0; tt < 8; ++tt) {
        float4 rv = *(const float4*)(rho + (tb + tt) * 64 + 4 * i4);
        acc[tt] += s0 * rv.x + s1 * rv.y + s2 * rv.z + s3 * rv.w;
      }
    }
#pragma unroll
    for (int tt = 0; tt < 8; ++tt) {
      int t = t0 + tb + tt;
      float y = acc[tt];
      float mean = wave_sum(y) * (1.f / 64.f);
      float dlt = y - mean;
      float var = wave_sum(dlt * dlt) * (1.f / 64.f);
      float o = dlt * rsqrtf(var + 64e-5f) * lnw + lnb;
      o += BON[t * 4 + head] * bf2f(RBv[(size_t)t * 256 + c]);
      float g = bf2f(PROJ[(size_t)t * NALL + 2048 + c]);
      MIX[(size_t)t * 1024 + 512 + c] = f2bf(o * silu(g));
    }
  }
  __syncthreads();
}

#define LDS_BYTES (131072 + 16)
#ifndef REP_G1
#define REP_G1 1
#endif
#ifndef REP_G2
#define REP_G2 1
#endif
#ifndef REP_P3
#define REP_P3 1
#endif
#ifndef REP_SCAN
#define REP_SCAN 1
#endif
#ifndef REP_GO
#define REP_GO 1
#endif
#ifndef REP_FIN
#define REP_FIN 1
#endif
#define PAIR_LOOP(N, BODY) for (int _pr = blockIdx.x; _pr < (N) / 2; _pr += gridDim.x) { const int it = 2 * _pr + vb; BODY }
__global__ void __launch_bounds__(512) fwd_megakernel(Params p) {
  cg::grid_group grid = cg::this_grid();
  extern __shared__ __attribute__((aligned(16))) unsigned char dsm[];
  const int vb = __builtin_amdgcn_readfirstlane(threadIdx.x >> 8);
  unsigned char* smem = dsm + vb * 65536;
  if (threadIdx.x == 0) *(uint4*)(dsm + 131072) = make_uint4(0u, 0u, 0u, 0u);
  __syncthreads();
  const XcdBarrier xb = xcd_barrier_post((unsigned*)(p.ws + OFF_BAR), (volatile LAS unsigned*)(dsm + 131072));
#define GSYNC() xcd_barrier(xb)
#ifndef PH
#define PH 0xffff
#endif
  if (PH & 1) PAIR_LOOP(384, phase_mod_item(p, it, smem);)
  if (PH & 2) PAIR_LOOP(4480, phase_wconv_item(p, it, smem);)
  if (PH & 2) PAIR_LOOP(8, phase_w2t_item(p, it);)
  grid.sync();
  if (PH & 4) phase_h0(p);
  GSYNC();
#pragma unroll 1
  for (int hl = 0; hl < 8; ++hl) {
    const int l = hl >> 1;
    const bool second = hl & 1;
    if (PH & 8) {
      pg8::Gemm g; g.M = T_; g.K = 1024;
      pg8::EpiU E; E.O = (void*)(p.ws + OFF_PROJ);
      if (!second) { g.A = (const u16*)(p.ws + OFF_H); g.Bt = (const u16*)(p.ws + OFF_WALL) + (size_t)l * NALL * 1024; g.N = 3584; E.ldc = NALL; E.ncols = NALL; E.f32out = 0; }
      else { g.A = (const u16*)(p.ws + OFF_MIX); g.Bt = (const u16*)(p.ws + OFF_WOUT) + (size_t)l * 1024 * 1024; g.N = 1024; E.ldc = 1024; E.ncols = 1024; E.f32out = 1; }
      pg8::StaticOrder S; S.init(T_, g.N, gridDim.x, blockIdx.x);
      const int nrep = second ? REP_G2 : REP_G1;
#pragma unroll 1
      for (int rep = 0; rep < nrep; ++rep)
      pg8::gemm_phase<pg8::EpiU, pg8::StaticOrder, false>((PG8_LAS unsigned char*)dsm, g, S, E, nullptr);
    }
    GSYNC();
    if (!second) {
#pragma unroll 1
      for (int rep = 0; rep < REP_P3; ++rep)
      PAIR_LOOP(3072,
        if (it < 1024) { if (PH & 16) attn_item(p, l, it, smem); }
        else if (it < 2048) { if (PH & 32) rwkv_prep_item(p, l, it - 1024, smem); }
        else { if (PH & 64) gla_local_item(p, l, it - 2048, smem); }
      )
      GSYNC();
      if (PH & 128) for (int eb = blockIdx.x; eb < 256; eb += gridDim.x) gla_state_block(p, eb, dsm);
#pragma unroll 1
      for (int rep = 0; rep < REP_SCAN; ++rep)
      if (PH & 256) for (int it = blockIdx.x; it < NSEG * 4; it += gridDim.x) rwkv_scan_item(p, it, dsm);
      GSYNC();
      if (blockIdx.x < 32) { if (PH & 512) rwkv_combine(p, dsm); }
#pragma unroll 1
      for (int rep = 0; rep < REP_GO; ++rep)
      if (PH & 1024) { if (blockIdx.x >= 32) for (int _pr = blockIdx.x - 32; _pr < 512; _pr += gridDim.x - 32) { const int it = 2 * _pr + vb; gla_out_item(p, l, it, smem); } }
      GSYNC();
#pragma unroll 1
      for (int rep = 0; rep < REP_FIN; ++rep)
      if (PH & 2048) PAIR_LOOP(NSEG * 4 * (SL / 64), rwkv_final_item(p, l, it, smem);)
      GSYNC();
    } else {
      if (PH & 8192) phase_post(p, l);
      if (hl < 7) GSYNC();
    }
  }
}

extern "C" void kernel_launch(void* const* d_in, const int* in_sizes, int n_in, void* d_out, int out_size, void* d_ws, size_t ws_size,
                              hipStream_t stream) {
  static int grid_blocks = 0;
  if (!grid_blocks) {
    int dev = 0, cus = 0, per_cu = 0;
    (void)hipGetDevice(&dev);
    (void)hipDeviceGetAttribute(&cus, hipDeviceAttributeMultiprocessorCount, dev);
    (void)hipFuncSetAttribute((const void*)fwd_megakernel, hipFuncAttributeMaxDynamicSharedMemorySize, LDS_BYTES);
    (void)hipOccupancyMaxActiveBlocksPerMultiprocessor(&per_cu, fwd_megakernel, 512, LDS_BYTES);
    if (per_cu < 1) per_cu = 1;
    grid_blocks = cus;
    if (grid_blocks < 32) grid_blocks = 32;
  }
  if (n_in != 27 || ws_size < WS_END) {
    fprintf(stderr, "kernel_launch: unexpected n_in %d / ws %zu\n", n_in, ws_size);
    return;
  }
  Params p{};
  const float** pp = (const float**)&p;
  for (int i = 0; i < 27; ++i) pp[i] = (const float*)d_in[i];
  p.out = (float*)d_out;
  p.ws = (unsigned char*)d_ws;
  (void)hipMemsetAsync((unsigned char*)d_ws + OFF_BAR, 0, XCD_BAR_WORDS * 4, stream);
  void* args[] = {&p};
  hipError_t e = hipLaunchCooperativeKernel((void*)fwd_megakernel, dim3(grid_blocks), dim3(512), args, LDS_BYTES, stream);
  if (e != hipSuccess) fprintf(stderr, "cooperative launch failed: %s (grid %d)\n", hipGetErrorString(e), grid_blocks);
}
```

```cpp
#include <hip/hip_runtime.h>
#include <hip/hip_bf16.h>
#include <hip/hip_cooperative_groups.h>
#include <cstdio>
namespace cg = cooperative_groups;

typedef unsigned short u16;
using bf16x8 = __attribute__((ext_vector_type(8))) short;
using f32x4 = __attribute__((ext_vector_type(4))) float;
using f32x16 = __attribute__((ext_vector_type(16))) float;

#define T_ 16384
#define NALL 3456
#define NSEG 64
#define SL (T_ / NSEG)
#define PROJF 1728

#define OFF_WALL 0ull
#define OFF_WOUT 28311552ull
#define OFF_MOD 36700160ull
#define OFF_H 36749312ull
#define OFF_RWW OFF_H
#define OFF_RWKK (OFF_H + 16777216ull)
#define OFF_PROJ 70303744ull
#define OFF_MIX 183549952ull
#define OFF_RWB 217104384ull
#define OFF_GLAS 250658816ull
#define OFF_GLAD 259047424ull
#define OFF_BONUS 259178496ull
#define OFF_ZP 259440640ull
#define OFF_BAR 267829248ull
#define OFF_W2T 267845632ull
#define OFF_A2T 267976704ull
#define WS_END 268107776ull


struct Params {
  const float *x, *c, *ada_w, *ada_b, *norm_pre, *norm_post, *w_in, *w_out, *sinks, *mu_rkv, *mu_w, *mu_a, *w0, *w1, *w2,
      *a0, *a1, *a2, *k_k, *k_a, *r_k, *ln_w, *ln_b, *gk1, *gk2, *gk_b, *gla_nw;
  float* out;
  unsigned char* ws;
};

__device__ __forceinline__ u16 f2bf(float f) {
  unsigned u = __float_as_uint(f);
  u += 0x7fffu + ((u >> 16) & 1u);
  return (u16)(u >> 16);
}
__device__ __forceinline__ float bf2f(u16 h) { return __uint_as_float(((unsigned)h) << 16); }
__device__ __forceinline__ unsigned pack2(float a, float b) { return (unsigned)f2bf(a) | ((unsigned)f2bf(b) << 16); }
__device__ __forceinline__ float bflo(unsigned u) { return __uint_as_float(u << 16); }
__device__ __forceinline__ float bfhi(unsigned u) { return __uint_as_float(u & 0xffff0000u); }
__device__ __forceinline__ float wave_sum(float v) {
#pragma unroll
  for (int o = 32; o > 0; o >>= 1) v += __shfl_xor(v, o);
  return v;
}
__device__ __forceinline__ float silu(float x) { return x / (1.f + __expf(-x)); }
__device__ __forceinline__ float sigmoidf_(float x) { return 1.f / (1.f + __expf(-x)); }
__device__ __forceinline__ float softplusf_(float z) { return fmaxf(z, 0.f) + log1pf(__expf(-fabsf(z))); }

__device__ __forceinline__ int opq(int x) { asm volatile("" : "+s"(x)); return x; }
__device__ __forceinline__ int opaque_tid() { int t = threadIdx.x & 255; asm volatile("" : "+v"(t)); return t; }
__device__ __forceinline__ int opaque_tid512() { int t = threadIdx.x; asm volatile("" : "+v"(t)); return t; }
template <int CTRL>
__device__ __forceinline__ float dpp_f(float x) {
  return __builtin_bit_cast(float, __builtin_amdgcn_update_dpp(0, __builtin_bit_cast(int, x), CTRL, 0xf, 0xf, true));
}
__device__ __forceinline__ float row16_allsum(float x) {
  x += dpp_f<0x128>(x);
  x += dpp_f<0x124>(x);
  x += dpp_f<0x122>(x);
  x += dpp_f<0x121>(x);
  return x;
}

namespace pg8 {
#define PG8_LAS __attribute__((address_space(3)))
typedef unsigned short bf16_t;
typedef short bf16x8 __attribute__((ext_vector_type(8)));
typedef float f32x4 __attribute__((ext_vector_type(4)));
typedef unsigned u32x4 __attribute__((ext_vector_type(4)));
constexpr int BM = 256, BK = 64, HALF = 128, HTB = HALF * BK * 2  , STAGE_BYTES = 8 * HTB, NXCD = 8, WGM = 8;

__host__ __device__ __forceinline__ int lds_byte(int r, int c) { const int st = (r >> 4) * 2 + (c >> 5), rr = r & 15, cc = c & 31, ob = rr * 64 + cc * 2; return st * 1024 + (ob ^ (((ob >> 9) & 1) << 5)); }
__host__ __device__ __forceinline__ void stage_rc(int b, int& R, int& C) { const int st = b / 1024, sb = b % 1024, swz = sb ^ (((sb >> 9) & 1) << 5); R = (st >> 1) * 16 + swz / 64; C = (st & 1) * 32 + (swz % 64) / 2; }
__host__ __device__ __forceinline__ int perm32(int rho) { const int n = rho >> 4, i = rho & 15; return 8 * (i >> 2) + 4 * n + (i & 3); }

struct Unit { int pm, pn; };
struct Gemm { const bf16_t* A; const bf16_t* Bt; int M, N, K; };

struct StaticOrder {
    int nM, nN, nwg, G, c;
    __host__ __device__ void init(int M, int N, int G_, int c_) { nM = M / BM; nN = N / BM; nwg = nM * nN; G = G_; c = c_; }
    __host__ __device__ bool next(int i, Unit& u) const {
        const long L = (long)i * G + c; if (L >= nwg) return false;
        int wgid = (int)L; { const int q = nwg / NXCD, r = nwg % NXCD, xcd = wgid % NXCD, off = wgid / NXCD; wgid = (xcd < r ? xcd * (q + 1) : r * (q + 1) + (xcd - r) * q) + off; }
        const int nig = WGM * nN, gid = wgid / nig, fm = gid * WGM, gsz = (nM - fm) < WGM ? (nM - fm) : WGM;
        u.pm = fm + ((wgid % nig) % gsz); u.pn = (wgid % nig) / gsz; return true;
    }
    __device__ __forceinline__ void a_ready(const Unit&) const {}
    __device__ __forceinline__ void done(const Unit&) const {}
};
__device__ __forceinline__ unsigned cvt_pk_bf16(float lo, float hi) { unsigned r; asm volatile("v_cvt_pk_bf16_f32 %0, %1, %2" : "=v"(r) : "v"(lo), "v"(hi)); return r; }
template <class Epi, class Sched, bool STAMP = false>
__device__ __forceinline__ void gemm_phase(PG8_LAS unsigned char* lds, const Gemm g, const Sched& S, const Epi& E, unsigned long long* stamps) {
    const int tid = threadIdx.x, wid = __builtin_amdgcn_readfirstlane(tid >> 6), lane = tid & 63, wr = wid >> 2, wc = wid & 3, fr = lane & 15, fq = lane >> 4;
    const int K = g.K, nt = K / BK;
    int ts_lo = 0, ts_hi = 0, nts = 0; const unsigned long long rt_entry = STAMP ? (unsigned long long)wall_clock64() : 0ull;
#define PG8_STAMP() do { if (STAMP && wid == 0 && nts < 64) { const unsigned long long _c = (unsigned long long)clock64(); \
        ts_lo = (lane == nts) ? (int)(unsigned)_c : ts_lo; ts_hi = (lane == nts) ? (int)(unsigned)(_c >> 32) : ts_hi; ++nts; } } while (0)
    PG8_STAMP();
    unsigned voffA[2], voffB[2];
#pragma unroll
    for (int i = 0; i < 2; ++i) { int R, C; stage_rc(tid * 16 + i * 8192, R, C); const int Rb = Epi::PERM ? ((R & ~31) + perm32(R & 31)) : R;
        voffA[i] = (unsigned)(R * K + C) * 2u; voffB[i] = (unsigned)(Rb * K + C) * 2u; }
    const size_t kstep = (size_t)(BK * 2);
    const size_t hstep = (size_t)HALF * K * 2;
    const size_t tstep = 2 * hstep;
    const unsigned ldsw = (unsigned)wid * 1024u;
    const int aoff = lds_byte(wr * 64 + fr, fq * 8), boff = lds_byte(wc * 32 + fr, fq * 8);
#define PG8_SA(b, h) (((b) * 2 + (h)) * HTB)
#define PG8_SB(b, h) ((4 + (b) * 2 + (h)) * HTB)
#define PG8_STAGE(bufoff, gbase, voff) do { _Pragma("unroll") for (int _i = 0; _i < 2; ++_i) \
        __builtin_amdgcn_global_load_lds((const unsigned*)((const char*)(gbase) + (voff)[_i]), (PG8_LAS unsigned*)(lds + (bufoff) + ldsw + _i * 8192), 16, 0, 0); } while (0)
#define PG8_LDA(dst, b, h) do { _Pragma("unroll") for (int m = 0; m < 4; ++m) _Pragma("unroll") for (int k = 0; k < 2; ++k) dst[m][k] = *(const PG8_LAS bf16x8*)(lds + PG8_SA(b, h) + aoff + m * 2048 + k * 1024); } while (0)
#define PG8_LDB(dst, b, h) do { _Pragma("unroll") for (int n = 0; n < 2; ++n) _Pragma("unroll") for (int k = 0; k < 2; ++k) dst[n][k] = *(const PG8_LAS bf16x8*)(lds + PG8_SB(b, h) + boff + n * 2048 + k * 1024); } while (0)
#define PG8_MMA(ai, bj, At, Bt) do { __builtin_amdgcn_s_setprio(1); _Pragma("unroll") for (int m = 0; m < 4; ++m) _Pragma("unroll") for (int n = 0; n < 2; ++n) _Pragma("unroll") for (int k = 0; k < 2; ++k) \
        acc[ai][bj][m][n] = __builtin_amdgcn_mfma_f32_16x16x32_bf16(Bt[n][k], At[m][k], acc[ai][bj][m][n], 0, 0, 0); __builtin_amdgcn_s_setprio(0); } while (0)
#define PG8_WAIT_V(n) asm volatile("s_waitcnt vmcnt(" #n ")" ::: "memory")
#define PG8_WAIT_L(n) asm volatile("s_waitcnt lgkmcnt(" #n ")" ::: "memory")
#define PG8_BAR __builtin_amdgcn_s_barrier()
#define PG8_SCHED __builtin_amdgcn_sched_barrier(0)
    Unit cur, nxt; int ui = 0;
    if (!S.next(0, cur)) return;
    f32x4 acc[2][2][4][2];
#pragma unroll
    for (int a = 0; a < 2; ++a)
#pragma unroll
        for (int b = 0; b < 2; ++b)
#pragma unroll
            for (int m = 0; m < 4; ++m)
#pragma unroll
                for (int n = 0; n < 2; ++n) acc[a][b][m][n] = (f32x4){0.f, 0.f, 0.f, 0.f};
    bf16x8 At[4][2], B0[2][2], B1[2][2];
    const char* cA = (const char*)g.A + (size_t)cur.pm * tstep; const char* cB = (const char*)g.Bt + (size_t)cur.pn * tstep;
    S.a_ready(cur);
    PG8_STAGE(PG8_SB(0, 0), cB, voffB); PG8_STAGE(PG8_SA(0, 0), cA, voffA); PG8_STAGE(PG8_SB(0, 1), cB + hstep, voffB); PG8_STAGE(PG8_SA(0, 1), cA + hstep, voffA);
    if (wr == 1) PG8_BAR;
    PG8_WAIT_V(4); PG8_BAR;
    PG8_STAGE(PG8_SB(1, 0), cB + kstep, voffB); PG8_STAGE(PG8_SA(1, 0), cA + kstep, voffA); PG8_STAGE(PG8_SB(1, 1), cB + hstep + kstep, voffB);
    PG8_WAIT_V(6); PG8_BAR;
    PG8_STAMP();
    for (;;) {
        const bool has_next = S.next(ui + 1, nxt);
        const char* nA = has_next ? (const char*)g.A + (size_t)nxt.pm * tstep : cA; const char* nB = has_next ? (const char*)g.Bt + (size_t)nxt.pn * tstep : cB;
        for (int t = 0; t < nt; t += 2) {
            const bool last = (t == nt - 2);
            const char* a1 = cA + (size_t)(t + 1) * kstep;
            const char* a2 = last ? nA : cA + (size_t)(t + 2) * kstep; const char* b2 = last ? nB : cB + (size_t)(t + 2) * kstep;
            const char* a3 = a2 + kstep; const char* b3 = b2 + kstep;
            if (last && has_next) S.a_ready(nxt);
            PG8_LDB(B0, 0, 0); PG8_SCHED; PG8_LDA(At, 0, 0); PG8_STAGE(PG8_SA(1, 1), a1 + hstep, voffA);
            PG8_WAIT_L(8); PG8_BAR; PG8_WAIT_L(0); PG8_MMA(0, 0, At, B0); PG8_BAR; PG8_SCHED;
            PG8_LDB(B1, 0, 1); PG8_STAGE(PG8_SB(0, 0), b2, voffB);
            PG8_BAR; PG8_WAIT_L(0); PG8_MMA(0, 1, At, B1); PG8_BAR;
            PG8_LDA(At, 0, 1); PG8_STAGE(PG8_SA(0, 0), a2, voffA);
            PG8_BAR; PG8_WAIT_L(0); PG8_MMA(1, 0, At, B0); PG8_BAR; PG8_SCHED;
            PG8_STAGE(PG8_SB(0, 1), b2 + hstep, voffB);
            PG8_WAIT_V(6); PG8_BAR; PG8_MMA(1, 1, At, B1); PG8_BAR;
            PG8_LDB(B0, 1, 0); PG8_SCHED; PG8_LDA(At, 1, 0); PG8_STAGE(PG8_SA(0, 1), a2 + hstep, voffA);
            PG8_WAIT_L(8); PG8_BAR; PG8_WAIT_L(0); PG8_MMA(0, 0, At, B0); PG8_BAR; PG8_SCHED;
            PG8_LDB(B1, 1, 1); PG8_STAGE(PG8_SB(1, 0), b3, voffB);
            PG8_BAR; PG8_WAIT_L(0); PG8_MMA(0, 1, At, B1); PG8_BAR;
            PG8_LDA(At, 1, 1); PG8_STAGE(PG8_SA(1, 0), a3, voffA);
            PG8_BAR; PG8_WAIT_L(0); PG8_MMA(1, 0, At, B0); PG8_BAR; PG8_SCHED;
            PG8_STAGE(PG8_SB(1, 1), b3 + hstep, voffB);
            PG8_WAIT_V(6); PG8_BAR; PG8_MMA(1, 1, At, B1); PG8_BAR;
        }
        PG8_STAMP();
        if constexpr (!Epi::AFTER_DRAIN) { E(acc, cur, wr, wc, fr, fq); S.done(cur); }
        PG8_STAMP();
        if (!has_next) break;
#pragma unroll
        for (int a = 0; a < 2; ++a)
#pragma unroll
            for (int b = 0; b < 2; ++b)
#pragma unroll
                for (int m = 0; m < 4; ++m)
#pragma unroll
                    for (int n = 0; n < 2; ++n) acc[a][b][m][n] = (f32x4){0.f, 0.f, 0.f, 0.f};
        cur = nxt; cA = nA; cB = nB; ++ui;
    }
    PG8_WAIT_V(0);
    if (wr == 0) PG8_BAR;
    PG8_BAR;
    if constexpr (Epi::AFTER_DRAIN) { E.fused(acc, cur, wr, wc, fr, fq, lds, wid, lane); S.done(cur); }
    PG8_STAMP();
    if (STAMP && wid == 0) { stamps[lane] = lane < nts ? (((unsigned long long)(unsigned)ts_hi << 32) | (unsigned)ts_lo) : 0ull;
        if (lane == 62) stamps[62] = rt_entry; if (lane == 63) stamps[63] = (unsigned long long)wall_clock64(); }
#undef PG8_STAMP
#undef PG8_SA
#undef PG8_SB
#undef PG8_STAGE
#undef PG8_LDA
#undef PG8_LDB
#undef PG8_MMA
#undef PG8_WAIT_V
#undef PG8_WAIT_L
#undef PG8_BAR
#undef PG8_SCHED
}
}

namespace pg8 {
struct EpiProj {
    static constexpr bool PERM = true, AFTER_DRAIN = false;
    bf16_t* O; int ldc; int ncols;
    __device__ __forceinline__ void operator()(const f32x4 (&acc)[2][2][4][2], const Unit& u, int wr, int wc, int fr, int fq) const {
        const int row0 = u.pm * BM + wr * 64 + fr; const int col0 = u.pn * BM + wc * 32 + 8 * fq;
#pragma unroll
        for (int ai = 0; ai < 2; ++ai)
#pragma unroll
            for (int m = 0; m < 4; ++m) { bf16_t* rowp = O + (size_t)(row0 + ai * HALF + m * 16) * ldc + col0;
#pragma unroll
                for (int bj = 0; bj < 2; ++bj) { const f32x4 v0 = acc[ai][bj][m][0], v1 = acc[ai][bj][m][1];
                    u32x4 w; w.x = cvt_pk_bf16(v0[0], v0[1]); w.y = cvt_pk_bf16(v0[2], v0[3]); w.z = cvt_pk_bf16(v1[0], v1[1]); w.w = cvt_pk_bf16(v1[2], v1[3]);
                    if (col0 + bj * HALF < ncols) *(u32x4*)(rowp + bj * HALF) = w; } }
    }
};
struct EpiU {
    static constexpr bool PERM = true, AFTER_DRAIN = false;
    void* O; int ldc; int ncols; int f32out;
    __device__ __forceinline__ void operator()(const f32x4 (&acc)[2][2][4][2], const Unit& u, int wr, int wc, int fr, int fq) const {
        const int row0 = u.pm * BM + wr * 64 + fr; const int col0 = u.pn * BM + wc * 32 + 8 * fq;
        if (f32out) {
#pragma unroll
            for (int ai = 0; ai < 2; ++ai)
#pragma unroll
                for (int m = 0; m < 4; ++m) { float* rowp = (float*)O + (size_t)(row0 + ai * HALF + m * 16) * ldc + col0;
#pragma unroll
                    for (int bj = 0; bj < 2; ++bj) { *(f32x4*)(rowp + bj * HALF) = acc[ai][bj][m][0]; *(f32x4*)(rowp + bj * HALF + 4) = acc[ai][bj][m][1]; } }
        } else {
#pragma unroll
            for (int ai = 0; ai < 2; ++ai)
#pragma unroll
                for (int m = 0; m < 4; ++m) { bf16_t* rowp = (bf16_t*)O + (size_t)(row0 + ai * HALF + m * 16) * ldc + col0;
#pragma unroll
                    for (int bj = 0; bj < 2; ++bj) { const f32x4 v0 = acc[ai][bj][m][0], v1 = acc[ai][bj][m][1];
                        u32x4 w; w.x = cvt_pk_bf16(v0[0], v0[1]); w.y = cvt_pk_bf16(v0[2], v0[3]); w.z = cvt_pk_bf16(v1[0], v1[1]); w.w = cvt_pk_bf16(v1[2], v1[3]);
                        if (col0 + bj * HALF < ncols) *(u32x4*)(rowp + bj * HALF) = w; } }
        }
    }
};
}

#define XB_TMO      128
#define XB_XCNT(j)  (256  + 64 * (j))
#define XB_XSUB(j)  (1280 + 64 * (j))
#define XB_XGEN(j)  (2304 + 64 * (j))
#define XB_TOP      3328
#define XB_TOPGEN   3392
#define XCD_BAR_WORDS 3456
#define XB_SPIN_CAP (1u << 18)
#define LAS __attribute__((address_space(3)))

__device__ __forceinline__ unsigned xb_ld(unsigned* p)              { return __hip_atomic_load(p, __ATOMIC_RELAXED, __HIP_MEMORY_SCOPE_AGENT); }
__device__ __forceinline__ unsigned xb_add(unsigned* p, unsigned v) { return __hip_atomic_fetch_add(p, v, __ATOMIC_RELAXED, __HIP_MEMORY_SCOPE_AGENT); }
__device__ __forceinline__ unsigned xb_xcc_id() { return (unsigned)__builtin_amdgcn_s_getreg((3 << 11) | 20) & 0xFu; }
#define XB_SPIN(cond, bar) do { unsigned _sp = 0; while (cond) { __builtin_amdgcn_s_sleep(1); \
    if ((++_sp & 255u) == 0u) { if (xb_ld(&(bar)[XB_TMO])) break; if (_sp > XB_SPIN_CAP) { atomicAdd(&(bar)[XB_TMO], 1u); break; } } } } while (0)

struct XcdBarrier {
    unsigned* bar; unsigned x;
    volatile LAS unsigned* st;
};

__device__ __forceinline__ XcdBarrier xcd_barrier_post(unsigned* bar, volatile LAS unsigned* st) {
    XcdBarrier b; b.bar = bar; b.x = xb_xcc_id(); b.st = st;
    if (threadIdx.x == 0) (void)xb_add(&bar[XB_XCNT(b.x)], 1u);
    return b;
}
__device__ __forceinline__ void xcd_barrier_complete(unsigned* bar, unsigned x, unsigned& nloc, unsigned& nx) {
    const unsigned G = gridDim.x * gridDim.y * gridDim.z;
    unsigned sum, cnt, mine, sp = 0u;
    for (;;) {
        sum = 0u; cnt = 0u; mine = 0u;
#pragma unroll
        for (unsigned j = 0; j < 16; ++j) { const unsigned c = xb_ld(&bar[XB_XCNT(j)]); sum += c; cnt += (c > 0u) ? 1u : 0u; mine = (j == x) ? c : mine; }
        if (sum == G) break;
        __builtin_amdgcn_s_sleep(1);
        if ((++sp & 255u) == 0u) { if (xb_ld(&bar[XB_TMO])) break; if (sp > XB_SPIN_CAP) { atomicAdd(&bar[XB_TMO], 1u); break; } }
    }
    nloc = mine > 0u ? mine : 1u; nx = cnt > 0u ? cnt : 1u;
}

__device__ __forceinline__ void xcd_barrier(const XcdBarrier& b) {
    asm volatile("s_waitcnt vmcnt(0)" ::: "memory");
    __syncthreads();
    if (threadIdx.x == 0) {
        unsigned* bar = b.bar;
        __builtin_amdgcn_s_waitcnt(0);
        unsigned nloc = b.st[0], nx = b.st[1];
        if (nloc == 0u) { xcd_barrier_complete(bar, b.x, nloc, nx); b.st[0] = nloc; b.st[1] = nx; }
        const unsigned old = xb_add(&bar[XB_XSUB(b.x)], 1u);
        const unsigned gen = old / nloc;
        if (old + 1u == (gen + 1u) * nloc) {
            __builtin_amdgcn_fence(__ATOMIC_RELEASE, "agent");
            asm volatile("s_waitcnt vmcnt(0)" ::: "memory");
            const unsigned og = xb_add(&bar[XB_TOP], 1u);
            const unsigned tg = og / nx;
            if (og + 1u == (tg + 1u) * nx) xb_add(&bar[XB_TOPGEN], 1u);
            else XB_SPIN(xb_ld(&bar[XB_TOPGEN]) == tg, bar);
            __builtin_amdgcn_fence(__ATOMIC_ACQUIRE, "agent");
            xb_add(&bar[XB_XGEN(b.x)], 1u);
            asm volatile("s_waitcnt vmcnt(0)" ::: "memory");
        } else {
            XB_SPIN(xb_ld(&bar[XB_XGEN(b.x)]) == gen, bar);
            __builtin_amdgcn_fence(__ATOMIC_ACQUIRE, "agent");
            asm volatile("s_waitcnt vmcnt(0)" ::: "memory");
        }
    }
    __syncthreads();
}

__device__ void phase_mod_item(const Params& p, int it, unsigned char* smem) {
  float* red = (float*)smem;
  const int tid = opaque_tid(), tx = tid & 31, ty = tid >> 5;
  float* mod = (float*)(p.ws + OFF_MOD);
  it = opq(it);
  {
    int l = it / 96;
    int j = (it % 96) * 32 + tx;
    const float* W = p.ada_w + (size_t)l * 1024 * 3072;
    float acc = 0.f;
    for (int i = 0; i < 128; ++i) {
      int k = ty * 128 + i;
      float cv = p.c[k];
      acc += silu(cv) * W[(size_t)k * 3072 + j];
    }
    red[ty * 32 + tx] = acc;
    __syncthreads();
    if (ty == 0) {
      float s = 0.f;
      for (int g = 0; g < 8; ++g) s += red[g * 32 + tx];
      mod[l * 3072 + j] = s + p.ada_b[l * 3072 + j];
    }
    __syncthreads();
  }
}

__device__ __forceinline__ float wall_src(const Params& p, int l, int k, int n) {
  size_t lk = (size_t)l * 1024 + k;
  if (n < 3072) return p.w_in[lk * 3072 + n];
  if (n < 3136) return (1.f - p.mu_w[lk]) * p.w1[lk * 64 + (n - 3072)];
  if (n < 3200) return p.mu_w[lk] * p.w1[lk * 64 + (n - 3136)];
  if (n < 3264) return (1.f - p.mu_a[lk]) * p.a1[lk * 64 + (n - 3200)];
  if (n < 3328) return p.mu_a[lk] * p.a1[lk * 64 + (n - 3264)];
  if (n < 3344) return p.gk1[lk * 16 + (n - 3328)];
  return 0.f;
}

__device__ void phase_wconv_item(const Params& p, int it, unsigned char* smem) {
  float* tile = (float*)smem;
  const int tid = opaque_tid();
  u16* WALL = (u16*)(p.ws + OFF_WALL);
  u16* WOUT = (u16*)(p.ws + OFF_WOUT);
  it = opq(it);
  {
    bool isout = it >= 3456;
    int l, nt, kt;
    if (!isout) { l = it / 864; int r = it % 864; nt = r >> 4; kt = r & 15; }
    else { int r = it - 3456; l = r >> 8; r &= 255; nt = r >> 4; kt = r & 15; }
    int tx = tid & 63, ty = tid >> 6;
#pragma unroll 4
    for (int i = 0; i < 16; ++i) {
      int kl = ty + 4 * i;
      int k = kt * 64 + kl, n = nt * 64 + tx;
      float v = isout ? p.w_out[((size_t)l * 1024 + k) * 1024 + n] : wall_src(p, l, k, n);
      tile[kl * 65 + tx] = v;
    }
    __syncthreads();
    int nl = tid >> 2, kq = tid & 3;
    unsigned w[8];
#pragma unroll
    for (int j = 0; j < 8; ++j) w[j] = pack2(tile[(kq * 16 + 2 * j) * 65 + nl], tile[(kq * 16 + 2 * j + 1) * 65 + nl]);
    u16* dst = (isout ? WOUT + ((size_t)l * 1024 + nt * 64 + nl) * 1024 : WALL + ((size_t)l * NALL + nt * 64 + nl) * 1024) + kt * 64 + kq * 16;
    ((uint4*)dst)[0] = make_uint4(w[0], w[1], w[2], w[3]);
    ((uint4*)dst)[1] = make_uint4(w[4], w[5], w[6], w[7]);
    __syncthreads();
  }
}

__device__ void phase_w2t_item(const Params& p, int it) {
  it = opq(it);
  const int c = opaque_tid();
  const int l = it >> 1, which = it & 1;
  const float* src = (which ? p.a2 : p.w2) + (size_t)l * 64 * 256 + c;
  u16* dst = (u16*)(p.ws + (which ? OFF_A2T : OFF_W2T)) + ((size_t)l * 256 + c) * 64;
#pragma unroll
  for (int j8 = 0; j8 < 8; ++j8) {
    float f[8];
#pragma unroll
    for (int q = 0; q < 8; ++q) f[q] = src[(j8 * 8 + q) * 256];
    *(uint4*)(dst + j8 * 8) = make_uint4(pack2(f[0], f[1]), pack2(f[2], f[3]), pack2(f[4], f[5]), pack2(f[6], f[7]));
  }
}

__device__ __forceinline__ void write_h(const Params& p, int l, int row, int lane, const float4* v, float ss) {
  const float* mod = (const float*)(p.ws + OFF_MOD) + l * 3072;
  u16* H = (u16*)(p.ws + OFF_H);
  float rs = rsqrtf(ss * (1.f / 1024.f) + 1e-6f);
#pragma unroll
  for (int i = 0; i < 4; ++i) {
    int col = (lane + 64 * i) * 4;
    float4 g = *(const float4*)(p.norm_pre + l * 1024 + col);
    float4 sh = *(const float4*)(mod + col);
    float4 sc = *(const float4*)(mod + 1024 + col);
    float h0 = v[i].x * rs * g.x * (1.f + sc.x) + sh.x;
    float h1 = v[i].y * rs * g.y * (1.f + sc.y) + sh.y;
    float h2 = v[i].z * rs * g.z * (1.f + sc.z) + sh.z;
    float h3 = v[i].w * rs * g.w * (1.f + sc.w) + sh.w;
    *(uint2*)(H + (size_t)row * 1024 + col) = make_uint2(pack2(h0, h1), pack2(h2, h3));
  }
}

__device__ void phase_h0(const Params& p) {
  const int tid = opaque_tid512(); const int wave = tid >> 6, lane = tid & 63;
  for (int row = blockIdx.x * 8 + wave; row < T_; row += gridDim.x * 8) {
    const float4* xr = (const float4*)(p.x + (size_t)row * 1024);
    float4 v[4];
    float ss = 0.f;
#pragma unroll
    for (int i = 0; i < 4; ++i) {
      v[i] = xr[lane + 64 * i];
      ss += v[i].x * v[i].x + v[i].y * v[i].y + v[i].z * v[i].z + v[i].w * v[i].w;
    }
    ss = wave_sum(ss);
    write_h(p, 0, row, lane, v, ss);
  }
}

__device__ void phase_post(const Params& p, int l) {
  l = opq(l);
  const int tid = opaque_tid512(); const int wave = tid >> 6, lane = tid & 63;
  const float* Y = (const float*)(p.ws + OFF_PROJ);
  const float* mod = (const float*)(p.ws + OFF_MOD) + l * 3072;
  const float* xold = (l == 0) ? p.x : p.out;
  for (int row = blockIdx.x * 8 + wave; row < T_; row += gridDim.x * 8) {
    const float4* yr = (const float4*)(Y + (size_t)row * 1024);
    const float4* xr = (const float4*)(xold + (size_t)row * 1024);
    float4 y[4], v[4];
    float ss = 0.f;
#pragma unroll
    for (int i = 0; i < 4; ++i) {
      y[i] = yr[lane + 64 * i];
      v[i] = xr[lane + 64 * i];
      ss += y[i].x * y[i].x + y[i].y * y[i].y + y[i].z * y[i].z + y[i].w * y[i].w;
    }
    ss = wave_sum(ss);
    float rs = rsqrtf(ss * (1.f / 1024.f) + 1e-6f);
    float s2 = 0.f;
#pragma unroll
    for (int i = 0; i < 4; ++i) {
      int col = (lane + 64 * i) * 4;
      float4 g = *(const float4*)(p.norm_post + l * 1024 + col);
      float4 gt = *(const float4*)(mod + 2048 + col);
      v[i].x += gt.x * (y[i].x * rs * g.x);
      v[i].y += gt.y * (y[i].y * rs * g.y);
      v[i].z += gt.z * (y[i].z * rs * g.z);
      v[i].w += gt.w * (y[i].w * rs * g.w);
      *(float4*)(p.out + (size_t)row * 1024 + col) = v[i];
      s2 += v[i].x * v[i].x + v[i].y * v[i].y + v[i].z * v[i].z + v[i].w * v[i].w;
    }
    if (l < 3) {
      s2 = wave_sum(s2);
      write_h(p, l + 1, row, lane, v, s2);
    }
  }
}

__device__ void attn_item(const Params& p, int l, int item, unsigned char* smem) {
  l = opq(l); item = opq(item);
  u16* Vt = (u16*)smem;
  const u16* PROJ = (const u16*)(p.ws + OFF_PROJ);
  u16* MIX = (u16*)(p.ws + OFF_MIX);
  const int tid = opaque_tid(), w = tid >> 6, lane = tid & 63, l31 = lane & 31, hf = lane >> 5;
  const int qb = item >> 3, head = item & 7, kvh = head >> 2;
  const int kpos0 = (qb - 1) * 128;
  {
    int kp = kpos0 + tid;
    if (kp < 0) kp = 0;
    const uint4* src = (const uint4*)(PROJ + (size_t)kp * NALL + 640 + kvh * 64);
#pragma unroll
    for (int c8 = 0; c8 < 8; ++c8) {
      uint4 v = src[c8];
      int d = c8 * 8;
      Vt[(d + 0) * 264 + tid] = (u16)(v.x & 0xffff);
      Vt[(d + 1) * 264 + tid] = (u16)(v.x >> 16);
      Vt[(d + 2) * 264 + tid] = (u16)(v.y & 0xffff);
      Vt[(d + 3) * 264 + tid] = (u16)(v.y >> 16);
      Vt[(d + 4) * 264 + tid] = (u16)(v.z & 0xffff);
      Vt[(d + 5) * 264 + tid] = (u16)(v.z >> 16);
      Vt[(d + 6) * 264 + tid] = (u16)(v.w & 0xffff);
      Vt[(d + 7) * 264 + tid] = (u16)(v.w >> 16);
    }
  }
  __syncthreads();
  const int tq = qb * 128 + 32 * w + l31;
  bf16x8 qf[4];
  {
    const u16* qp = PROJ + (size_t)tq * NALL + head * 64 + 8 * hf;
#pragma unroll
    for (int s = 0; s < 4; ++s) qf[s] = *(const bf16x8*)(qp + 16 * s);
  }
  const float slope = exp2f(-(float)(head + 1));
  const float sink = p.sinks[l * 8 + head];
  const int rq = 32 * w + l31;
  float mrun = -1e30f, lsum = 0.f;
  f32x16 o0, o1;
#pragma unroll
  for (int r = 0; r < 16; ++r) { o0[r] = 0.f; o1[r] = 0.f; }
#pragma unroll 1
  for (int i = 0; i < 5; ++i) {
    int kp = kpos0 + 32 * w + 32 * i + l31;
    if (kp < 0) kp = 0;
    const u16* kptr = PROJ + (size_t)kp * NALL + 512 + kvh * 64 + 8 * hf;
    f32x16 a;
#pragma unroll
    for (int r = 0; r < 16; ++r) a[r] = 0.f;
#pragma unroll
    for (int s = 0; s < 4; ++s) {
      bf16x8 kf = *(const bf16x8*)(kptr + 16 * s);
      a = __builtin_amdgcn_mfma_f32_32x32x16_bf16(kf, qf[s], a, 0, 0, 0);
    }
    float tmax = -1e30f;
#pragma unroll
    for (int r = 0; r < 16; ++r) {
      int kj = 32 * w + 32 * i + (r & 3) + 8 * (r >> 2) + 4 * hf;
      int dist = 128 + rq - kj;
      bool valid = (dist >= 0) && (dist < 128) && (kpos0 + kj >= 0);
      float sv = a[r] * 0.125f - slope * (float)dist;
      sv = valid ? sv : -1e30f;
      a[r] = sv;
      tmax = fmaxf(tmax, sv);
    }
    tmax = fmaxf(tmax, __shfl_xor(tmax, 32));
    const float mnew = fmaxf(mrun, tmax);
    const float alpha = __expf(mrun - mnew);
    float psum = 0.f;
#pragma unroll
    for (int r = 0; r < 16; ++r) {
      float e = (a[r] > -1e29f) ? __expf(a[r] - mnew) : 0.f;
      a[r] = e;
      psum += e;
    }
    lsum = lsum * alpha + psum;
    mrun = mnew;
#pragma unroll
    for (int r = 0; r < 16; ++r) { o0[r] *= alpha; o1[r] *= alpha; }
#pragma unroll
    for (int u = 0; u < 2; ++u) {
      bf16x8 pf;
#pragma unroll
      for (int j = 0; j < 8; ++j) pf[j] = (short)f2bf(a[8 * u + j]);
      const int kb = 32 * w + 32 * i + 16 * u + 4 * hf;
      const u16* v0 = Vt + l31 * 264 + kb;
      const u16* v1 = Vt + (32 + l31) * 264 + kb;
      uint2 a0 = *(const uint2*)(v0), a1 = *(const uint2*)(v0 + 8);
      uint2 b0 = *(const uint2*)(v1), b1 = *(const uint2*)(v1 + 8);
      uint4 A0 = make_uint4(a0.x, a0.y, a1.x, a1.y), A1 = make_uint4(b0.x, b0.y, b1.x, b1.y);
      o0 = __builtin_amdgcn_mfma_f32_32x32x16_bf16(__builtin_bit_cast(bf16x8, A0), pf, o0, 0, 0, 0);
      o1 = __builtin_amdgcn_mfma_f32_32x32x16_bf16(__builtin_bit_cast(bf16x8, A1), pf, o1, 0, 0, 0);
    }
  }
  {
    const float mf = fmaxf(mrun, sink);
    const float scl = __expf(mrun - mf);
    const float ltot = (lsum + __shfl_xor(lsum, 32)) * scl + __expf(sink - mf);
    const float fin = scl / ltot;
#pragma unroll
    for (int r = 0; r < 16; ++r) { o0[r] *= fin; o1[r] *= fin; }
  }
  const u16* gp = PROJ + (size_t)tq * NALL + 768 + head * 64;
  u16* op = MIX + (size_t)tq * 1024 + head * 64;
#pragma unroll
  for (int g = 0; g < 4; ++g) {
    int d0 = 8 * g + 4 * hf;
    uint2 gg = *(const uint2*)(gp + d0);
    float r0 = o0[4 * g + 0] * silu(bflo(gg.x)), r1 = o0[4 * g + 1] * silu(bfhi(gg.x));
    float r2 = o0[4 * g + 2] * silu(bflo(gg.y)), r3 = o0[4 * g + 3] * silu(bfhi(gg.y));
    *(uint2*)(op + d0) = make_uint2(pack2(r0, r1), pack2(r2, r3));
    uint2 g2 = *(const uint2*)(gp + 32 + d0);
    r0 = o1[4 * g + 0] * silu(bflo(g2.x)); r1 = o1[4 * g + 1] * silu(bfhi(g2.x));
    r2 = o1[4 * g + 2] * silu(bflo(g2.y)); r3 = o1[4 * g + 3] * silu(bfhi(g2.y));
    *(uint2*)(op + 32 + d0) = make_uint2(pack2(r0, r1), pack2(r2, r3));
  }
  __syncthreads();
}

__device__ void rwkv_prep_item(const Params& p, int l, int item, unsigned char* smem) {
  l = opq(l); item = opq(item);
  u16* lwb = (u16*)smem;
  u16* lab = lwb + 16 * 72;
  const u16* PROJ = (const u16*)(p.ws + OFF_PROJ);
  const int tid = opaque_tid(), head = tid >> 6, lane = tid & 63, fr = lane & 15, fq = lane >> 4;
  const int t0 = item * 16;
#pragma unroll
  for (int i = 0; i < 8; ++i) {
    int idx = tid + 256 * i;
    int which = idx >> 10, tt = (idx >> 6) & 15, j = idx & 63;
    int t = t0 + tt;
    const u16* pr = PROJ + (size_t)t * NALL;
    float cur = bf2f(pr[(which ? 3200 : 3072) + j]);
    float prev = (t > 0) ? bf2f((pr - NALL)[(which ? 3264 : 3136) + j]) : 0.f;
    float sv = cur + prev;
    if (!which) sv = tanhf(sv);
    (which ? lab : lwb)[tt * 72 + j] = f2bf(sv);
  }
  __syncthreads();
  f32x4 accw[4], acca[4];
#pragma unroll
  for (int nt = 0; nt < 4; ++nt) { accw[nt] = (f32x4){0.f, 0.f, 0.f, 0.f}; acca[nt] = (f32x4){0.f, 0.f, 0.f, 0.f}; }
  {
    const u16* W2T = (const u16*)(p.ws + OFF_W2T) + ((size_t)l * 256 + head * 64 + fr) * 64 + fq * 8;
    const u16* A2T = (const u16*)(p.ws + OFF_A2T) + ((size_t)l * 256 + head * 64 + fr) * 64 + fq * 8;
#pragma unroll
    for (int ks = 0; ks < 2; ++ks) {
      const bf16x8 aw = *(const bf16x8*)(lwb + fr * 72 + ks * 32 + fq * 8);
      const bf16x8 aa = *(const bf16x8*)(lab + fr * 72 + ks * 32 + fq * 8);
#pragma unroll
      for (int nt = 0; nt < 4; ++nt) {
        const bf16x8 bw = *(const bf16x8*)(W2T + nt * 16 * 64 + ks * 32);
        const bf16x8 ba = *(const bf16x8*)(A2T + nt * 16 * 64 + ks * 32);
        accw[nt] = __builtin_amdgcn_mfma_f32_16x16x32_bf16(aw, bw, accw[nt], 0, 0, 0);
        acca[nt] = __builtin_amdgcn_mfma_f32_16x16x32_bf16(aa, ba, acca[nt], 0, 0, 0);
      }
    }
  }
  float mur[4], muk[4], muv[4], w0[4], a0[4], kkw[4], kaw[4], rkw[4];
#pragma unroll
  for (int nt = 0; nt < 4; ++nt) {
    const int c = head * 64 + nt * 16 + fr;
    mur[nt] = p.mu_rkv[l * 768 + c]; muk[nt] = p.mu_rkv[l * 768 + 256 + c]; muv[nt] = p.mu_rkv[l * 768 + 512 + c];
    w0[nt] = p.w0[l * 256 + c]; a0[nt] = p.a0[l * 256 + c]; kkw[nt] = p.k_k[l * 256 + c]; kaw[nt] = p.k_a[l * 256 + c]; rkw[nt] = p.r_k[l * 256 + c];
  }
  float* RWW = (float*)(p.ws + OFF_RWW);
  float* RWKK = (float*)(p.ws + OFF_RWKK);
  u16* RB = (u16*)(p.ws + OFF_RWB);
  float* BON = (float*)(p.ws + OFF_BONUS);
#pragma unroll
  for (int rg = 0; rg < 4; ++rg) {
    const int t = t0 + fq * 4 + rg;
    const u16* pr = PROJ + (size_t)t * NALL;
    float kkc[4], av[4];
    float n2 = 0.f, bonus = 0.f;
#pragma unroll
    for (int nt = 0; nt < 4; ++nt) {
      const int c = head * 64 + nt * 16 + fr;
      float rc = bf2f(pr[1280 + c]), kc = bf2f(pr[1536 + c]), vc = bf2f(pr[1792 + c]);
      float rp = 0.f, kp = 0.f, vp = 0.f;
      if (t > 0) { rp = bf2f((pr - NALL)[1280 + c]); kp = bf2f((pr - NALL)[1536 + c]); vp = bf2f((pr - NALL)[1792 + c]); }
      const float r = rc + (rp - rc) * mur[nt], k = kc + (kp - kc) * muk[nt], v = vc + (vp - vc) * muv[nt];
      const float wpre = w0[nt] + accw[nt][rg];
      const float wl = -softplusf_(-wpre) - 0.5f;
      const float decay = __expf(-__expf(wl));
      const float a = sigmoidf_(a0[nt] + acca[nt][rg]);
      const float kc2 = k * kkw[nt];
      const float kmod = k * (1.f + (a - 1.f) * kaw[nt]);
      kkc[nt] = kc2; av[nt] = a;
      n2 += kc2 * kc2;
      bonus += r * kmod * rkw[nt];
      const size_t o = (size_t)t * 256 + c;
      RWW[o] = decay;
      RB[o] = f2bf(r);
      RB[(size_t)T_ * 256 + o] = f2bf(kmod);
      RB[(size_t)2 * T_ * 256 + o] = f2bf(v);
    }
    n2 = row16_allsum(n2);
    bonus = row16_allsum(bonus);
    const float inv = 1.f / fmaxf(sqrtf(n2), 1e-12f);
#pragma unroll
    for (int nt = 0; nt < 4; ++nt) {
      const int c = head * 64 + nt * 16 + fr;
      const size_t o = (size_t)t * 256 + c;
      const float kk = kkc[nt] * inv;
      RWKK[o] = kk;
      RB[(size_t)3 * T_ * 256 + o] = f2bf(kk * av[nt]);
    }
    if (fr == 0) BON[t * 4 + head] = bonus;
  }
  __syncthreads();
}

__device__ __forceinline__ void gla_b(const Params& p, int l, int chunk, int head, float* tot, float* bl) {
  const u16* PROJ = (const u16*)(p.ws + OFF_PROJ);
  const int tid = opaque_tid(), d = tid & 31, ig = tid >> 5;
  float g2[16];
#pragma unroll
  for (int m = 0; m < 16; ++m) g2[m] = p.gk2[(size_t)l * 16 * 128 + m * 128 + head * 32 + d];
  const float bias = p.gk_b[l * 128 + head * 32 + d];
  float run = 0.f;
#pragma unroll
  for (int ii = 0; ii < 8; ++ii) {
    int t = chunk * 64 + ig * 8 + ii;
    const uint4* lp = (const uint4*)(PROJ + (size_t)t * NALL + 3328);
    uint4 u0 = lp[0], u1 = lp[1];
    float z = bias;
    z += bflo(u0.x) * g2[0] + bfhi(u0.x) * g2[1] + bflo(u0.y) * g2[2] + bfhi(u0.y) * g2[3];
    z += bflo(u0.z) * g2[4] + bfhi(u0.z) * g2[5] + bflo(u0.w) * g2[6] + bfhi(u0.w) * g2[7];
    z += bflo(u1.x) * g2[8] + bfhi(u1.x) * g2[9] + bflo(u1.y) * g2[10] + bfhi(u1.y) * g2[11];
    z += bflo(u1.z) * g2[12] + bfhi(u1.z) * g2[13] + bflo(u1.w) * g2[14] + bfhi(u1.w) * g2[15];
    float g = (fminf(z, 0.f) - log1pf(__expf(-fabsf(z)))) * (1.f / 16.f);
    run += g;
    bl[ii] = run;
  }
  tot[ig * 32 + d] = run;
  __syncthreads();
  float off = 0.f;
#pragma unroll
  for (int g = 0; g < 8; ++g) off += (g < ig) ? tot[g * 32 + d] : 0.f;
#pragma unroll
  for (int ii = 0; ii < 8; ++ii) bl[ii] += off;
}

__device__ void gla_local_item(const Params& p, int l, int item, unsigned char* smem) {
  l = opq(l); item = opq(item);
  float* tot = (float*)smem;
  float* Kp = tot + 256;
  float* Vs = Kp + 2048;
  const u16* PROJ = (const u16*)(p.ws + OFF_PROJ);
  const int tid = opaque_tid(), d = tid & 31, ig = tid >> 5;
  const int chunk = item >> 2, head = item & 3;
  float bl[8];
  gla_b(p, l, chunk, head, tot, bl);
  float blast = 0.f;
#pragma unroll
  for (int g = 0; g < 8; ++g) blast += tot[g * 32 + d];
#pragma unroll
  for (int ii = 0; ii < 8; ++ii) {
    int i = ig * 8 + ii;
    int t = chunk * 64 + i;
    float k = bf2f(PROJ[(size_t)t * NALL + 2432 + head * 32 + d]);
    Kp[i * 32 + d] = k * __expf(blast - bl[ii]);
  }
#pragma unroll
  for (int r = 0; r < 16; ++r) {
    int idx = tid + 256 * r;
    int i = idx >> 6, v = idx & 63;
    Vs[idx] = bf2f(PROJ[(size_t)(chunk * 64 + i) * NALL + 2560 + head * 64 + v]);
  }
  __syncthreads();
  const int v = tid & 63, dg = tid >> 6;
  float acc[8];
#pragma unroll
  for (int q = 0; q < 8; ++q) acc[q] = 0.f;
  for (int i = 0; i < 64; ++i) {
    float vv = Vs[i * 64 + v];
    float4 k0 = *(const float4*)(Kp + i * 32 + dg * 8), k1 = *(const float4*)(Kp + i * 32 + dg * 8 + 4);
    acc[0] += k0.x * vv; acc[1] += k0.y * vv; acc[2] += k0.z * vv; acc[3] += k0.w * vv;
    acc[4] += k1.x * vv; acc[5] += k1.y * vv; acc[6] += k1.z * vv; acc[7] += k1.w * vv;
  }
  float* GS = (float*)(p.ws + OFF_GLAS);
  float* GD = (float*)(p.ws + OFF_GLAD);
#pragma unroll
  for (int q = 0; q < 8; ++q) GS[((size_t)(chunk * 4 + head) * 32 + dg * 8 + q) * 64 + v] = acc[q];
  if (tid < 32) GD[(chunk * 4 + head) * 32 + tid] = __expf(blast);
  __syncthreads();
}

__device__ void gla_state_block(const Params& p, int eb, unsigned char* dsm_) {
  float* comp = (float*)dsm_;
  float* GS = (float*)(p.ws + OFF_GLAS);
  const float* GD = (const float*)(p.ws + OFF_GLAD);
  eb = opq(eb);
  const int tid = opaque_tid512();
  const int ei = tid & 31, g = tid >> 5;
  const int e = eb * 32 + ei;
  const int head = e >> 11, d = (e >> 6) & 31, v = e & 63;
  float ds[16], dc[16];
#pragma unroll
  for (int i = 0; i < 16; ++i) {
    const int c = g * 16 + i;
    ds[i] = GS[((size_t)(c * 4 + head) * 32 + d) * 64 + v];
    dc[i] = GD[(c * 4 + head) * 32 + d];
  }
  float S = 0.f, P = 1.f;
#pragma unroll
  for (int i = 0; i < 16; ++i) { S = dc[i] * S + ds[i]; P *= dc[i]; }
  comp[(g * 32 + ei) * 2] = P;
  comp[(g * 32 + ei) * 2 + 1] = S;
  __syncthreads();
  float G = 0.f;
  for (int gg = 0; gg < g; ++gg) G = comp[(gg * 32 + ei) * 2] * G + comp[(gg * 32 + ei) * 2 + 1];
#pragma unroll
  for (int i = 0; i < 16; ++i) {
    const int c = g * 16 + i;
    GS[((size_t)(c * 4 + head) * 32 + d) * 64 + v] = G;
    G = dc[i] * G + ds[i];
  }
  __syncthreads();
}

__device__ void gla_out_item(const Params& p, int l, int item, unsigned char* smem) {
  l = opq(l); item = opq(item);
  float* tot = (float*)smem;
  float* qt = tot + 256;
  float* kt = qt + 2304;
  float* Vs = kt + 2304;
  float* Am = Vs + 4096;
  float* Ss = Am + 4352;
  const u16* PROJ = (const u16*)(p.ws + OFF_PROJ);
  u16* MIX = (u16*)(p.ws + OFF_MIX);
  const float* GS = (const float*)(p.ws + OFF_GLAS);
  const int tid = opaque_tid();
  const int chunk = item >> 2, head = item & 3;
  {
    const int d = tid & 31, ig = tid >> 5;
    float bl[8];
    gla_b(p, l, chunk, head, tot, bl);
#pragma unroll
    for (int ii = 0; ii < 8; ++ii) {
      int i = ig * 8 + ii;
      int t = chunk * 64 + i;
      float q = bf2f(PROJ[(size_t)t * NALL + 2304 + head * 32 + d]);
      float k = bf2f(PROJ[(size_t)t * NALL + 2432 + head * 32 + d]);
      qt[i * 36 + d] = q * 0.17677669529663687f * __expf(bl[ii]);
      kt[i * 36 + d] = k * __expf(-bl[ii]);
    }
  }
#pragma unroll
  for (int r = 0; r < 16; ++r) {
    int idx = tid + 256 * r;
    int i = idx >> 6, v = idx & 63;
    Vs[idx] = bf2f(PROJ[(size_t)(chunk * 64 + i) * NALL + 2560 + head * 64 + v]);
  }
#pragma unroll
  for (int r = 0; r < 8; ++r) {
    int idx = tid + 256 * r;
    Ss[idx] = GS[(size_t)(chunk * 4 + head) * 2048 + idx];
  }
  __syncthreads();
  const int j = tid & 63, ig = tid >> 6;
  {
    float acc[16];
#pragma unroll
    for (int ii = 0; ii < 16; ++ii) acc[ii] = 0.f;
#pragma unroll 2
    for (int d4 = 0; d4 < 8; ++d4) {
      const float4 kv = *(const float4*)(kt + j * 36 + d4 * 4);
#pragma unroll
      for (int ii = 0; ii < 16; ++ii) {
        const float4 qv = *(const float4*)(qt + (ig * 16 + ii) * 36 + d4 * 4);
        acc[ii] += qv.x * kv.x + qv.y * kv.y + qv.z * kv.z + qv.w * kv.w;
      }
    }
#pragma unroll
    for (int ii = 0; ii < 16; ++ii) {
      int i = ig * 16 + ii;
      Am[i * 68 + j] = (j <= i) ? acc[ii] : 0.f;
    }
  }
  __syncthreads();
  {
    const int v = j;
    float acc[16];
#pragma unroll
    for (int ii = 0; ii < 16; ++ii) acc[ii] = 0.f;
    const int jmax = (ig + 1) * 4;
    for (int j4 = 0; j4 < jmax; ++j4) {
      const float v0 = Vs[(j4 * 4 + 0) * 64 + v], v1 = Vs[(j4 * 4 + 1) * 64 + v], v2 = Vs[(j4 * 4 + 2) * 64 + v], v3 = Vs[(j4 * 4 + 3) * 64 + v];
#pragma unroll
      for (int ii = 0; ii < 16; ++ii) {
        const float4 av = *(const float4*)(Am + (ig * 16 + ii) * 68 + j4 * 4);
        acc[ii] += av.x * v0 + av.y * v1 + av.z * v2 + av.w * v3;
      }
    }
#pragma unroll 2
    for (int d4 = 0; d4 < 8; ++d4) {
      const float s0 = Ss[(d4 * 4 + 0) * 64 + v], s1 = Ss[(d4 * 4 + 1) * 64 + v], s2 = Ss[(d4 * 4 + 2) * 64 + v], s3 = Ss[(d4 * 4 + 3) * 64 + v];
#pragma unroll
      for (int ii = 0; ii < 16; ++ii) {
        const float4 qv = *(const float4*)(qt + (ig * 16 + ii) * 36 + d4 * 4);
        acc[ii] += qv.x * s0 + qv.y * s1 + qv.z * s2 + qv.w * s3;
      }
    }
    const float nw = p.gla_nw[l * 64 + v];
#pragma unroll
    for (int ii = 0; ii < 16; ++ii) {
      int t = chunk * 64 + ig * 16 + ii;
      float o = acc[ii];
      float ms = wave_sum(o * o) * (1.f / 64.f);
      float gg = bf2f(PROJ[(size_t)t * NALL + 2816 + head * 64 + v]);
      float r = o * rsqrtf(ms + 1e-5f) * nw * silu(gg);
      MIX[(size_t)t * 1024 + 768 + head * 64 + v] = f2bf(r);
    }
  }
  __syncthreads();
}

typedef float f32x2 __attribute__((ext_vector_type(2)));
__device__ __forceinline__ float oct_allsum(float x) {
  x += dpp_f<0xB1>(x);
  x += dpp_f<0x4E>(x);
  x += dpp_f<0x141>(x);
  return x;
}
__device__ void rwkv_scan_item(const Params& p, int item, unsigned char* dsm_) {
  item = opq(item);
  float* st = (float*)dsm_;
  const int tid = opaque_tid512(), wv = tid >> 6, lane = tid & 63, rs = lane >> 3, kl = lane & 7;
  const int head = item & 3, seg = item >> 2;
  const bool ident = wv >= 4;
  const int R0 = wv * 16 + rs * 2;
  const int v0 = R0 & 63;
  const float* RWW = (const float*)(p.ws + OFF_RWW);
  const float* RWKK = (const float*)(p.ws + OFF_RWKK);
  const u16* RB = (const u16*)(p.ws + OFF_RWB);
  float* PF = (float*)(p.ws + OFF_PROJ);
  float* ZP = (float*)(p.ws + OFF_ZP);
  const int tbase = seg * SL;
  const int half = tid >> 8, ls = (tid & 255) >> 4, lc4 = (tid & 15) * 4;
  f32x2 S0[4], S1[4];
#pragma unroll
  for (int e = 0; e < 4; ++e) { S0[e] = (f32x2){0.f, 0.f}; S1[e] = (f32x2){0.f, 0.f}; }
  if (ident) {
#pragma unroll
    for (int e = 0; e < 4; ++e) {
      const int k0 = kl * 8 + 2 * e;
      S0[e] = (f32x2){(v0 == k0) ? 1.f : 0.f, (v0 == k0 + 1) ? 1.f : 0.f};
      S1[e] = (f32x2){(v0 + 1 == k0) ? 1.f : 0.f, (v0 + 1 == k0 + 1) ? 1.f : 0.f};
    }
  }
  float4 g0 = make_float4(0.f, 0.f, 0.f, 0.f);
  uint2 h0 = make_uint2(0u, 0u), h1 = h0, h2 = h0;
  const float* gp0 = (half == 0 ? RWW : RWKK) + (size_t)(tbase + ls) * 256 + head * 64 + lc4;
  const u16* hp = RB + (size_t)(tbase + ls) * 256 + head * 64 + lc4;
#define SCAN_GLOAD(ch) do { const size_t _o = (size_t)(ch) * 16 * 256; g0 = *(const float4*)(gp0 + _o); \
    if (half == 0) { h0 = *(const uint2*)(hp + _o); } \
    else { h0 = *(const uint2*)(hp + (size_t)T_ * 256 + _o); h1 = *(const uint2*)(hp + (size_t)3 * T_ * 256 + _o); h2 = *(const uint2*)(hp + (size_t)2 * T_ * 256 + _o); } } while (0)
#define SCAN_LSTORE(buf) do { float* _b = st + (buf) * 6144 + ls * 64 + lc4; \
    if (half == 0) { *(float4*)(_b) = g0; *(float4*)(_b + 2048) = make_float4(bflo(h0.x), bfhi(h0.x), bflo(h0.y), bfhi(h0.y)); } \
    else { *(float4*)(_b + 1024) = g0; *(float4*)(_b + 3072) = make_float4(bflo(h0.x), bfhi(h0.x), bflo(h0.y), bfhi(h0.y)); \
           *(float4*)(_b + 4096) = make_float4(bflo(h1.x), bfhi(h1.x), bflo(h1.y), bfhi(h1.y)); *(float4*)(_b + 5120) = make_float4(bflo(h2.x), bfhi(h2.x), bflo(h2.y), bfhi(h2.y)); } } while (0)
  if (tid < 16) st[2 * 6144 + tid] = 0.f;
  SCAN_GLOAD(0);
  SCAN_LSTORE(0);
  __syncthreads();
  const int nch = SL / 16;
  float* yout = PF + (size_t)tbase * PROJF + (ident ? 256 : 0) + head * 64 + v0;
  const int voff = ident ? (2 * 6144) : (5120 + v0);
  const int vstep = ident ? 0 : 64, vbuf = ident ? 0 : 6144;
#define V2(a, i) ((f32x2){(i) ? a.z : a.x, (i) ? a.w : a.y})
#define SCAN_STEP(s_) do { \
    const float* bp = b + (s_) * 64 + kl * 8; \
    const float4 wl = *(const float4*)(bp), wh = *(const float4*)(bp + 4); \
    const float4 kkl = *(const float4*)(bp + 1024), kkh = *(const float4*)(bp + 1028); \
    const float4 rl4 = *(const float4*)(bp + 2048), rh4 = *(const float4*)(bp + 2052); \
    const float4 kl4 = *(const float4*)(bp + 3072), kh4 = *(const float4*)(bp + 3076); \
    const float4 bl4 = *(const float4*)(bp + 4096), bh4 = *(const float4*)(bp + 4100); \
    const f32x2 vv = *(const f32x2*)(vsrc + (s_) * vstep); \
    const f32x2 W[4] = {V2(wl, 0), V2(wl, 1), V2(wh, 0), V2(wh, 1)}, KK[4] = {V2(kkl, 0), V2(kkl, 1), V2(kkh, 0), V2(kkh, 1)}; \
    const f32x2 RR[4] = {V2(rl4, 0), V2(rl4, 1), V2(rh4, 0), V2(rh4, 1)}, KV[4] = {V2(kl4, 0), V2(kl4, 1), V2(kh4, 0), V2(kh4, 1)}; \
    const f32x2 BB[4] = {V2(bl4, 0), V2(bl4, 1), V2(bh4, 0), V2(bh4, 1)}; \
    f32x2 t0 = S0[0] * KK[0] + S0[1] * KK[1] + S0[2] * KK[2] + S0[3] * KK[3]; \
    f32x2 t1 = S1[0] * KK[0] + S1[1] * KK[1] + S1[2] * KK[2] + S1[3] * KK[3]; \
    float sa0 = -(t0.x + t0.y), sa1 = -(t1.x + t1.y); \
    sa0 += dpp_f<0xB1>(sa0); sa1 += dpp_f<0xB1>(sa1); sa0 += dpp_f<0x4E>(sa0); sa1 += dpp_f<0x4E>(sa1); sa0 += dpp_f<0x141>(sa0); sa1 += dpp_f<0x141>(sa1); \
    const f32x2 a0 = {sa0, sa0}, a1 = {sa1, sa1}, u0 = {vv.x, vv.x}, u1 = {vv.y, vv.y}; \
    _Pragma("unroll") for (int e = 0; e < 4; ++e) { S0[e] = S0[e] * W[e] + a0 * BB[e] + u0 * KV[e]; S1[e] = S1[e] * W[e] + a1 * BB[e] + u1 * KV[e]; } \
    f32x2 q0 = S0[0] * RR[0] + S0[1] * RR[1] + S0[2] * RR[2] + S0[3] * RR[3]; \
    f32x2 q1 = S1[0] * RR[0] + S1[1] * RR[1] + S1[2] * RR[2] + S1[3] * RR[3]; \
    float y0 = q0.x + q0.y, y1 = q1.x + q1.y; \
    y0 += dpp_f<0xB1>(y0); y1 += dpp_f<0xB1>(y1); y0 += dpp_f<0x4E>(y0); y1 += dpp_f<0x4E>(y1); y0 += dpp_f<0x141>(y0); y1 += dpp_f<0x141>(y1); \
    const bool mine = (kl == ((s_) & 7)); \
    if ((s_) < 8) { ya.x = mine ? y0 : ya.x; ya.y = mine ? y1 : ya.y; } else { yb.x = mine ? y0 : yb.x; yb.y = mine ? y1 : yb.y; } } while (0)
  for (int ch = 0; ch < nch; ++ch) {
    const int cur = ch & 1;
    if (ch + 1 < nch) SCAN_GLOAD(ch + 1);
    const float* b = st + cur * 6144;
    const float* vsrc = st + voff + cur * vbuf;
    f32x2 ya = {0.f, 0.f}, yb = {0.f, 0.f};
#pragma unroll 2
    for (int s = 0; s < 8; ++s) SCAN_STEP(s);
#pragma unroll 2
    for (int s = 8; s < 16; ++s) SCAN_STEP(s);
    *(f32x2*)(yout + (size_t)(ch * 16 + kl) * PROJF) = ya;
    *(f32x2*)(yout + (size_t)(ch * 16 + 8 + kl) * PROJF) = yb;
    if (ch + 1 < nch) SCAN_LSTORE(cur ^ 1);
    __syncthreads();
  }
#pragma unroll
  for (int j = 0; j < 2; ++j) {
    float* zp = ZP + ((size_t)((seg * 4 + head) * 128 + R0 + j)) * 64 + kl * 8;
    if (j == 0) { *(float4*)(zp) = make_float4(S0[0].x, S0[0].y, S0[1].x, S0[1].y); *(float4*)(zp + 4) = make_float4(S0[2].x, S0[2].y, S0[3].x, S0[3].y); }
    else { *(float4*)(zp) = make_float4(S1[0].x, S1[0].y, S1[1].x, S1[1].y); *(float4*)(zp + 4) = make_float4(S1[2].x, S1[2].y, S1[3].x, S1[3].y); }
  }
}

__device__ void rwkv_combine(const Params& p, unsigned char* dsm_) {
  float* ring = (float*)dsm_;
  float* ZP = (float*)(p.ws + OFF_ZP);
  const int tid = opaque_tid512(); const int lane = tid & 63;
  const int rowi = blockIdx.x * 8 + (tid >> 6);
  const int head = rowi >> 6, v = rowi & 63;
  float4 pa0, pa1, pa2, pa3, pb0, pb1, pb2, pb3;
  float z0, z1, z2, z3;
#define COMB_ONE(stg_, q, PA, PB, Z) do { const float* base = ZP + (size_t)((((stg_) * 4 + q) * 4 + head) * 128) * 64; \
      PA = ((const float4*)(base + 4096))[tid]; PB = ((const float4*)(base + 4096))[tid + 512]; Z = base[v * 64 + lane]; } while (0)
#define COMB_ISSUE(stg_) do { COMB_ONE(stg_, 0, pa0, pb0, z0); COMB_ONE(stg_, 1, pa1, pb1, z1); COMB_ONE(stg_, 2, pa2, pb2, z2); COMB_ONE(stg_, 3, pa3, pb3, z3); } while (0)
#define COMB_SEG(q, ZC) do { const int seg = stg * 4 + q; \
      ZP[((size_t)((seg * 4 + head) * 128 + v)) * 64 + lane] = s; \
      float ns0 = ZC, ns1 = 0.f; const float* P = buf + q * 4096 + lane; \
      _Pragma("unroll") for (int i = 0; i < 64; i += 2) { \
        float s0 = __builtin_bit_cast(float, __builtin_amdgcn_readlane(__builtin_bit_cast(int, s), i)); \
        float s1 = __builtin_bit_cast(float, __builtin_amdgcn_readlane(__builtin_bit_cast(int, s), i + 1)); \
        ns0 += s0 * P[i * 64]; ns1 += s1 * P[(i + 1) * 64]; } \
      s = ns0 + ns1; } while (0)
  COMB_ISSUE(0);
  float s = 0.f;
#pragma unroll 1
  for (int stg = 0; stg < NSEG / 4; ++stg) {
    float* buf = ring + (stg & 1) * 16384;
    ((float4*)(buf))[tid] = pa0; ((float4*)(buf))[tid + 512] = pb0;
    ((float4*)(buf + 4096))[tid] = pa1; ((float4*)(buf + 4096))[tid + 512] = pb1;
    ((float4*)(buf + 8192))[tid] = pa2; ((float4*)(buf + 8192))[tid + 512] = pb2;
    ((float4*)(buf + 12288))[tid] = pa3; ((float4*)(buf + 12288))[tid + 512] = pb3;
    const float c0 = z0, c1 = z1, c2 = z2, c3 = z3;
    __syncthreads();
    if (stg + 1 < NSEG / 4) COMB_ISSUE(stg + 1);
    COMB_SEG(0, c0); COMB_SEG(1, c1); COMB_SEG(2, c2); COMB_SEG(3, c3);
  }
  __syncthreads();
}

__device__ __forceinline__ bf16x8 pack8(const float4 a, const float4 b) {
  uint4 u = make_uint4(pack2(a.x, a.y), pack2(a.z, a.w), pack2(b.x, b.y), pack2(b.z, b.w));
  return __builtin_bit_cast(bf16x8, u);
}
__device__ void rwkv_final_item(const Params& p, int l, int item, unsigned char* smem) {
  l = opq(l); item = opq(item);
  const int tid = opaque_tid(), w = tid >> 6, lane = tid & 63, l31 = lane & 31, hf = lane >> 5;
  const int parts = SL / 128;
  const int q = item % parts, head = (item / parts) & 3, seg = item / (parts * 4);
  const int t = seg * SL + q * 128 + w * 32 + l31;
  const float* ZP = (const float*)(p.ws + OFF_ZP);
  const float* PF = (const float*)(p.ws + OFF_PROJ);
  const u16* PROJ = (const u16*)(p.ws + OFF_PROJ);
  const u16* RBv = (const u16*)(p.ws + OFF_RWB) + (size_t)2 * T_ * 256;
  const float* BON = (const float*)(p.ws + OFF_BONUS);
  u16* MIX = (u16*)(p.ws + OFF_MIX);
  f32x16 acc0, acc1;
#pragma unroll
  for (int r = 0; r < 16; ++r) { acc0[r] = 0.f; acc1[r] = 0.f; }
  {
    const float* sp = ZP + ((size_t)((seg * 4 + head) * 128 + l31)) * 64 + 8 * hf;
    const float* rp = PF + (size_t)t * PROJF + 256 + head * 64 + 8 * hf;
#pragma unroll
    for (int ks = 0; ks < 4; ++ks) {
      const bf16x8 bfrag = pack8(*(const float4*)(rp + 16 * ks), *(const float4*)(rp + 16 * ks + 4));
      const bf16x8 a0 = pack8(*(const float4*)(sp + 16 * ks), *(const float4*)(sp + 16 * ks + 4));
      const bf16x8 a1 = pack8(*(const float4*)(sp + 32 * 64 + 16 * ks), *(const float4*)(sp + 32 * 64 + 16 * ks + 4));
      acc0 = __builtin_amdgcn_mfma_f32_32x32x16_bf16(a0, bfrag, acc0, 0, 0, 0);
      acc1 = __builtin_amdgcn_mfma_f32_32x32x16_bf16(a1, bfrag, acc1, 0, 0, 0);
    }
  }
  const float* y0p = PF + (size_t)t * PROJF + head * 64 + 4 * hf;
  float sum = 0.f;
#pragma unroll
  for (int g = 0; g < 4; ++g) {
    const float4 ya = *(const float4*)(y0p + 8 * g), yb = *(const float4*)(y0p + 32 + 8 * g);
    acc0[4 * g + 0] += ya.x; acc0[4 * g + 1] += ya.y; acc0[4 * g + 2] += ya.z; acc0[4 * g + 3] += ya.w;
    acc1[4 * g + 0] += yb.x; acc1[4 * g + 1] += yb.y; acc1[4 * g + 2] += yb.z; acc1[4 * g + 3] += yb.w;
  }
#pragma unroll
  for (int r = 0; r < 16; ++r) sum += acc0[r] + acc1[r];
  sum += __shfl_xor(sum, 32);
  const float mean = sum * (1.f / 64.f);
  float var = 0.f;
#pragma unroll
  for (int r = 0; r < 16; ++r) { const float d0 = acc0[r] - mean, d1 = acc1[r] - mean; var += d0 * d0 + d1 * d1; }
  var += __shfl_xor(var, 32);
  const float rstd = rsqrtf(var * (1.f / 64.f) + 64e-5f);
  const float bon = BON[t * 4 + head];
  const int cb = head * 64 + 4 * hf;
#pragma unroll
  for (int mt = 0; mt < 2; ++mt)
#pragma unroll
    for (int g = 0; g < 4; ++g) {
      const int c = cb + mt * 32 + 8 * g;
      const float4 lw = *(const float4*)(p.ln_w + l * 256 + c), lb = *(const float4*)(p.ln_b + l * 256 + c);
      const uint2 vv = *(const uint2*)(RBv + (size_t)t * 256 + c);
      const uint2 gg = *(const uint2*)(PROJ + (size_t)t * NALL + 2048 + c);
      float o0 = (mt ? acc1[4 * g + 0] : acc0[4 * g + 0]), o1 = (mt ? acc1[4 * g + 1] : acc0[4 * g + 1]);
      float o2 = (mt ? acc1[4 * g + 2] : acc0[4 * g + 2]), o3 = (mt ? acc1[4 * g + 3] : acc0[4 * g + 3]);
      o0 = (o0 - mean) * rstd * lw.x + lb.x + bon * bflo(vv.x);
      o1 = (o1 - mean) * rstd * lw.y + lb.y + bon * bfhi(vv.x);
      o2 = (o2 - mean) * rstd * lw.z + lb.z + bon * bflo(vv.y);
      o3 = (o3 - mean) * rstd * lw.w + lb.w + bon * bfhi(vv.y);
      o0 *= silu(bflo(gg.x)); o1 *= silu(bfhi(gg.x)); o2 *= silu(bflo(gg.y)); o3 *= silu(bfhi(gg.y));
      *(uint2*)(MIX + (size_t)t * 1024 + 512 + c) = make_uint2(pack2(o0, o1), pack2(o2, o3));
    }
}

#define LDS_BYTES (131072 + 16)
#ifndef REP_G1
#define REP_G1 1
#endif
#ifndef REP_G2
#define REP_G2 1
#endif
#ifndef REP_P3
#define REP_P3 1
#endif
#ifndef REP_SCAN
#define REP_SCAN 1
#endif
#ifndef REP_GO
#define REP_GO 1
#endif
#ifndef REP_FIN
#define REP_FIN 1
#endif
#define PAIR_LOOP(N, BODY) for (int _pr = blockIdx.x; _pr < (N) / 2; _pr += gridDim.x) { const int it = 2 * _pr + vb; BODY }
__global__ void __launch_bounds__(512) fwd_megakernel(Params p) {
  cg::grid_group grid = cg::this_grid();
  extern __shared__ __attribute__((aligned(16))) unsigned char dsm[];
  const int vb = __builtin_amdgcn_readfirstlane(threadIdx.x >> 8);
  unsigned char* smem = dsm + vb * 65536;
  if (threadIdx.x == 0) *(uint4*)(dsm + 131072) = make_uint4(0u, 0u, 0u, 0u);
  __syncthreads();
  const XcdBarrier xb = xcd_barrier_post((unsigned*)(p.ws + OFF_BAR), (volatile LAS unsigned*)(dsm + 131072));
#define GSYNC() xcd_barrier(xb)
#ifndef PH
#define PH 0xffff
#endif
  if (PH & 1) PAIR_LOOP(384, phase_mod_item(p, it, smem);)
  if (PH & 2) PAIR_LOOP(4480, phase_wconv_item(p, it, smem);)
  if (PH & 2) PAIR_LOOP(8, phase_w2t_item(p, it);)
  grid.sync();
  if (PH & 4) phase_h0(p);
  GSYNC();
#pragma unroll 1
  for (int hl = 0; hl < 8; ++hl) {
    const int l = hl >> 1;
    const bool second = hl & 1;
    if (PH & 8) {
      pg8::Gemm g; g.M = T_; g.K = 1024;
      pg8::EpiU E; E.O = (void*)(p.ws + OFF_PROJ);
      if (!second) { g.A = (const u16*)(p.ws + OFF_H); g.Bt = (const u16*)(p.ws + OFF_WALL) + (size_t)l * NALL * 1024; g.N = 3584; E.ldc = NALL; E.ncols = NALL; E.f32out = 0; }
      else { g.A = (const u16*)(p.ws + OFF_MIX); g.Bt = (const u16*)(p.ws + OFF_WOUT) + (size_t)l * 1024 * 1024; g.N = 1024; E.ldc = 1024; E.ncols = 1024; E.f32out = 1; }
      pg8::StaticOrder S; S.init(T_, g.N, gridDim.x, blockIdx.x);
      const int nrep = second ? REP_G2 : REP_G1;
#pragma unroll 1
      for (int rep = 0; rep < nrep; ++rep)
      pg8::gemm_phase<pg8::EpiU, pg8::StaticOrder, false>((PG8_LAS unsigned char*)dsm, g, S, E, nullptr);
    }
    GSYNC();
    if (!second) {
#pragma unroll 1
      for (int rep = 0; rep < REP_P3; ++rep)
      PAIR_LOOP(3072,
        if (it < 1024) { if (PH & 16) attn_item(p, l, it, smem); }
        else if (it < 2048) { if (PH & 32) rwkv_prep_item(p, l, it - 1024, smem); }
        else { if (PH & 64) gla_local_item(p, l, it - 2048, smem); }
      )
      GSYNC();
      if (PH & 128) for (int eb = blockIdx.x; eb < 256; eb += gridDim.x) gla_state_block(p, eb, dsm);
#pragma unroll 1
      for (int rep = 0; rep < REP_SCAN; ++rep)
      if (PH & 256) for (int it = blockIdx.x; it < NSEG * 4; it += gridDim.x) rwkv_scan_item(p, it, dsm);
      GSYNC();
      if (blockIdx.x < 32) { if (PH & 512) rwkv_combine(p, dsm); }
#pragma unroll 1
      for (int rep = 0; rep < REP_GO; ++rep)
      if (PH & 1024) { if (blockIdx.x >= 32) for (int _pr = blockIdx.x - 32; _pr < 512; _pr += gridDim.x - 32) { const int it = 2 * _pr + vb; gla_out_item(p, l, it, smem); } }
      GSYNC();
#pragma unroll 1
      for (int rep = 0; rep < REP_FIN; ++rep)
      if (PH & 2048) PAIR_LOOP(NSEG * 4 * (SL / 128), rwkv_final_item(p, l, it, smem);)
      GSYNC();
    } else {
      if (PH & 8192) phase_post(p, l);
      if (hl < 7) GSYNC();
    }
  }
}

extern "C" void kernel_launch(void* const* d_in, const int* in_sizes, int n_in, void* d_out, int out_size, void* d_ws, size_t ws_size,
                              hipStream_t stream) {
  static int grid_blocks = 0;
  if (!grid_blocks) {
    int dev = 0, cus = 0, per_cu = 0;
    (void)hipGetDevice(&dev);
    (void)hipDeviceGetAttribute(&cus, hipDeviceAttributeMultiprocessorCount, dev);
    (void)hipFuncSetAttribute((const void*)fwd_megakernel, hipFuncAttributeMaxDynamicSharedMemorySize, LDS_BYTES);
    (void)hipOccupancyMaxActiveBlocksPerMultiprocessor(&per_cu, fwd_megakernel, 512, LDS_BYTES);
    if (per_cu < 1) per_cu = 1;
    grid_blocks = cus;
    if (grid_blocks < 32) grid_blocks = 32;
  }
  if (n_in != 27 || ws_size < WS_END) {
    fprintf(stderr, "kernel_launch: unexpected n_in %d / ws %zu\n", n_in, ws_size);
    return;
  }
  Params p{};
  const float** pp = (const float**)&p;
  for (int i = 0; i < 27; ++i) pp[i] = (const float*)d_in[i];
  p.out = (float*)d_out;
  p.ws = (unsigned char*)d_ws;
  (void)hipMemsetAsync((unsigned char*)d_ws + OFF_BAR, 0, XCD_BAR_WORDS * 4, stream);
  void* args[] = {&p};
  hipError_t e = hipLaunchCooperativeKernel((void*)fwd_megakernel, dim3(grid_blocks), dim3(512), args, LDS_BYTES, stream);
  if (e != hipSuccess) fprintf(stderr, "cooperative launch failed: %s (grid %d)\n", hipGetErrorString(e), grid_blocks);
}
```

```cpp
#include <hip/hip_runtime.h>
#include <hip/hip_bf16.h>
#include <hip/hip_cooperative_groups.h>
#include <cstdio>
namespace cg = cooperative_groups;

typedef unsigned short u16;
using bf16x8 = __attribute__((ext_vector_type(8))) short;
using f32x4 = __attribute__((ext_vector_type(4))) float;
using f32x16 = __attribute__((ext_vector_type(16))) float;

#define T_ 16384
#define NALL 3456
#define NSEG 64
#define SL (T_ / NSEG)
#define PROJF 1728

#define OFF_WALL 0ull
#define OFF_WOUT 28311552ull
#define OFF_MOD 36700160ull
#define OFF_H 36749312ull
#define OFF_RWW OFF_H
#define OFF_RWKK (OFF_H + 16777216ull)
#define OFF_PROJ 70303744ull
#define OFF_MIX 183549952ull
#define OFF_RWB 217104384ull
#define OFF_GLAS 250658816ull
#define OFF_GLAD 259047424ull
#define OFF_BONUS 259178496ull
#define OFF_ZP 259440640ull
#define OFF_BAR 267829248ull
#define OFF_W2T 267845632ull
#define OFF_A2T 267976704ull
#define WS_END 268107776ull


struct Params {
  const float *x, *c, *ada_w, *ada_b, *norm_pre, *norm_post, *w_in, *w_out, *sinks, *mu_rkv, *mu_w, *mu_a, *w0, *w1, *w2,
      *a0, *a1, *a2, *k_k, *k_a, *r_k, *ln_w, *ln_b, *gk1, *gk2, *gk_b, *gla_nw;
  float* out;
  unsigned char* ws;
};

__device__ __forceinline__ u16 f2bf(float f) {
  unsigned u = __float_as_uint(f);
  u += 0x7fffu + ((u >> 16) & 1u);
  return (u16)(u >> 16);
}
__device__ __forceinline__ float bf2f(u16 h) { return __uint_as_float(((unsigned)h) << 16); }
__device__ __forceinline__ unsigned pack2(float a, float b) { return (unsigned)f2bf(a) | ((unsigned)f2bf(b) << 16); }
__device__ __forceinline__ float bflo(unsigned u) { return __uint_as_float(u << 16); }
__device__ __forceinline__ float bfhi(unsigned u) { return __uint_as_float(u & 0xffff0000u); }
__device__ __forceinline__ float wave_sum(float v) {
#pragma unroll
  for (int o = 32; o > 0; o >>= 1) v += __shfl_xor(v, o);
  return v;
}
__device__ __forceinline__ float silu(float x) { return x / (1.f + __expf(-x)); }
__device__ __forceinline__ float sigmoidf_(float x) { return 1.f / (1.f + __expf(-x)); }
__device__ __forceinline__ float softplusf_(float z) { return fmaxf(z, 0.f) + log1pf(__expf(-fabsf(z))); }

__device__ __forceinline__ int opq(int x) { asm volatile("" : "+s"(x)); return x; }
__device__ __forceinline__ int opaque_tid() { int t = threadIdx.x & 255; asm volatile("" : "+v"(t)); return t; }
__device__ __forceinline__ int opaque_tid512() { int t = threadIdx.x; asm volatile("" : "+v"(t)); return t; }
template <int CTRL>
__device__ __forceinline__ float dpp_f(float x) {
  return __builtin_bit_cast(float, __builtin_amdgcn_update_dpp(0, __builtin_bit_cast(int, x), CTRL, 0xf, 0xf, true));
}
__device__ __forceinline__ float row16_allsum(float x) {
  x += dpp_f<0x128>(x);
  x += dpp_f<0x124>(x);
  x += dpp_f<0x122>(x);
  x += dpp_f<0x121>(x);
  return x;
}

namespace pg8 {
#define PG8_LAS __attribute__((address_space(3)))
typedef unsigned short bf16_t;
typedef short bf16x8 __attribute__((ext_vector_type(8)));
typedef float f32x4 __attribute__((ext_vector_type(4)));
typedef unsigned u32x4 __attribute__((ext_vector_type(4)));
constexpr int BM = 256, BK = 64, HALF = 128, HTB = HALF * BK * 2  , STAGE_BYTES = 8 * HTB, NXCD = 8, WGM = 8;

__host__ __device__ __forceinline__ int lds_byte(int r, int c) { const int st = (r >> 4) * 2 + (c >> 5), rr = r & 15, cc = c & 31, ob = rr * 64 + cc * 2; return st * 1024 + (ob ^ (((ob >> 9) & 1) << 5)); }
__host__ __device__ __forceinline__ void stage_rc(int b, int& R, int& C) { const int st = b / 1024, sb = b % 1024, swz = sb ^ (((sb >> 9) & 1) << 5); R = (st >> 1) * 16 + swz / 64; C = (st & 1) * 32 + (swz % 64) / 2; }
__host__ __device__ __forceinline__ int perm32(int rho) { const int n = rho >> 4, i = rho & 15; return 8 * (i >> 2) + 4 * n + (i & 3); }

struct Unit { int pm, pn; };
struct Gemm { const bf16_t* A; const bf16_t* Bt; int M, N, K; };

struct StaticOrder {
    int nM, nN, nwg, G, c;
    __host__ __device__ void init(int M, int N, int G_, int c_) { nM = M / BM; nN = N / BM; nwg = nM * nN; G = G_; c = c_; }
    __host__ __device__ bool next(int i, Unit& u) const {
        const long L = (long)i * G + c; if (L >= nwg) return false;
        int wgid = (int)L; { const int q = nwg / NXCD, r = nwg % NXCD, xcd = wgid % NXCD, off = wgid / NXCD; wgid = (xcd < r ? xcd * (q + 1) : r * (q + 1) + (xcd - r) * q) + off; }
        const int nig = WGM * nN, gid = wgid / nig, fm = gid * WGM, gsz = (nM - fm) < WGM ? (nM - fm) : WGM;
        u.pm = fm + ((wgid % nig) % gsz); u.pn = (wgid % nig) / gsz; return true;
    }
    __device__ __forceinline__ void a_ready(const Unit&) const {}
    __device__ __forceinline__ void done(const Unit&) const {}
};
__device__ __forceinline__ unsigned cvt_pk_bf16(float lo, float hi) { unsigned r; asm volatile("v_cvt_pk_bf16_f32 %0, %1, %2" : "=v"(r) : "v"(lo), "v"(hi)); return r; }
template <class Epi, class Sched, bool STAMP = false>
__device__ __forceinline__ void gemm_phase(PG8_LAS unsigned char* lds, const Gemm g, const Sched& S, const Epi& E, unsigned long long* stamps) {
    const int tid = threadIdx.x, wid = __builtin_amdgcn_readfirstlane(tid >> 6), lane = tid & 63, wr = wid >> 2, wc = wid & 3, fr = lane & 15, fq = lane >> 4;
    const int K = g.K, nt = K / BK;
    int ts_lo = 0, ts_hi = 0, nts = 0; const unsigned long long rt_entry = STAMP ? (unsigned long long)wall_clock64() : 0ull;
#define PG8_STAMP() do { if (STAMP && wid == 0 && nts < 64) { const unsigned long long _c = (unsigned long long)clock64(); \
        ts_lo = (lane == nts) ? (int)(unsigned)_c : ts_lo; ts_hi = (lane == nts) ? (int)(unsigned)(_c >> 32) : ts_hi; ++nts; } } while (0)
    PG8_STAMP();
    unsigned voffA[2], voffB[2];
#pragma unroll
    for (int i = 0; i < 2; ++i) { int R, C; stage_rc(tid * 16 + i * 8192, R, C); const int Rb = Epi::PERM ? ((R & ~31) + perm32(R & 31)) : R;
        voffA[i] = (unsigned)(R * K + C) * 2u; voffB[i] = (unsigned)(Rb * K + C) * 2u; }
    const size_t kstep = (size_t)(BK * 2);
    const size_t hstep = (size_t)HALF * K * 2;
    const size_t tstep = 2 * hstep;
    const unsigned ldsw = (unsigned)wid * 1024u;
    const int aoff = lds_byte(wr * 64 + fr, fq * 8), boff = lds_byte(wc * 32 + fr, fq * 8);
#define PG8_SA(b, h) (((b) * 2 + (h)) * HTB)
#define PG8_SB(b, h) ((4 + (b) * 2 + (h)) * HTB)
#define PG8_STAGE(bufoff, gbase, voff) do { _Pragma("unroll") for (int _i = 0; _i < 2; ++_i) \
        __builtin_amdgcn_global_load_lds((const unsigned*)((const char*)(gbase) + (voff)[_i]), (PG8_LAS unsigned*)(lds + (bufoff) + ldsw + _i * 8192), 16, 0, 0); } while (0)
#define PG8_LDA(dst, b, h) do { _Pragma("unroll") for (int m = 0; m < 4; ++m) _Pragma("unroll") for (int k = 0; k < 2; ++k) dst[m][k] = *(const PG8_LAS bf16x8*)(lds + PG8_SA(b, h) + aoff + m * 2048 + k * 1024); } while (0)
#define PG8_LDB(dst, b, h) do { _Pragma("unroll") for (int n = 0; n < 2; ++n) _Pragma("unroll") for (int k = 0; k < 2; ++k) dst[n][k] = *(const PG8_LAS bf16x8*)(lds + PG8_SB(b, h) + boff + n * 2048 + k * 1024); } while (0)
#define PG8_MMA(ai, bj, At, Bt) do { __builtin_amdgcn_s_setprio(1); _Pragma("unroll") for (int m = 0; m < 4; ++m) _Pragma("unroll") for (int n = 0; n < 2; ++n) _Pragma("unroll") for (int k = 0; k < 2; ++k) \
        acc[ai][bj][m][n] = __builtin_amdgcn_mfma_f32_16x16x32_bf16(Bt[n][k], At[m][k], acc[ai][bj][m][n], 0, 0, 0); __builtin_amdgcn_s_setprio(0); } while (0)
#define PG8_WAIT_V(n) asm volatile("s_waitcnt vmcnt(" #n ")" ::: "memory")
#define PG8_WAIT_L(n) asm volatile("s_waitcnt lgkmcnt(" #n ")" ::: "memory")
#define PG8_BAR __builtin_amdgcn_s_barrier()
#define PG8_SCHED __builtin_amdgcn_sched_barrier(0)
    Unit cur, nxt; int ui = 0;
    if (!S.next(0, cur)) return;
    f32x4 acc[2][2][4][2];
#pragma unroll
    for (int a = 0; a < 2; ++a)
#pragma unroll
        for (int b = 0; b < 2; ++b)
#pragma unroll
            for (int m = 0; m < 4; ++m)
#pragma unroll
                for (int n = 0; n < 2; ++n) acc[a][b][m][n] = (f32x4){0.f, 0.f, 0.f, 0.f};
    bf16x8 At[4][2], B0[2][2], B1[2][2];
    const char* cA = (const char*)g.A + (size_t)cur.pm * tstep; const char* cB = (const char*)g.Bt + (size_t)cur.pn * tstep;
    S.a_ready(cur);
    PG8_STAGE(PG8_SB(0, 0), cB, voffB); PG8_STAGE(PG8_SA(0, 0), cA, voffA); PG8_STAGE(PG8_SB(0, 1), cB + hstep, voffB); PG8_STAGE(PG8_SA(0, 1), cA + hstep, voffA);
    if (wr == 1) PG8_BAR;
    PG8_WAIT_V(4); PG8_BAR;
    PG8_STAGE(PG8_SB(1, 0), cB + kstep, voffB); PG8_STAGE(PG8_SA(1, 0), cA + kstep, voffA); PG8_STAGE(PG8_SB(1, 1), cB + hstep + kstep, voffB);
    PG8_WAIT_V(6); PG8_BAR;
    PG8_STAMP();
    for (;;) {
        const bool has_next = S.next(ui + 1, nxt);
        const char* nA = has_next ? (const char*)g.A + (size_t)nxt.pm * tstep : cA; const char* nB = has_next ? (const char*)g.Bt + (size_t)nxt.pn * tstep : cB;
        for (int t = 0; t < nt; t += 2) {
            const bool last = (t == nt - 2);
            const char* a1 = cA + (size_t)(t + 1) * kstep;
            const char* a2 = last ? nA : cA + (size_t)(t + 2) * kstep; const char* b2 = last ? nB : cB + (size_t)(t + 2) * kstep;
            const char* a3 = a2 + kstep; const char* b3 = b2 + kstep;
            if (last && has_next) S.a_ready(nxt);
            PG8_LDB(B0, 0, 0); PG8_SCHED; PG8_LDA(At, 0, 0); PG8_STAGE(PG8_SA(1, 1), a1 + hstep, voffA);
            PG8_WAIT_L(8); PG8_BAR; PG8_WAIT_L(0); PG8_MMA(0, 0, At, B0); PG8_BAR; PG8_SCHED;
            PG8_LDB(B1, 0, 1); PG8_STAGE(PG8_SB(0, 0), b2, voffB);
            PG8_BAR; PG8_WAIT_L(0); PG8_MMA(0, 1, At, B1); PG8_BAR;
            PG8_LDA(At, 0, 1); PG8_STAGE(PG8_SA(0, 0), a2, voffA);
            PG8_BAR; PG8_WAIT_L(0); PG8_MMA(1, 0, At, B0); PG8_BAR; PG8_SCHED;
            PG8_STAGE(PG8_SB(0, 1), b2 + hstep, voffB);
            PG8_WAIT_V(6); PG8_BAR; PG8_MMA(1, 1, At, B1); PG8_BAR;
            PG8_LDB(B0, 1, 0); PG8_SCHED; PG8_LDA(At, 1, 0); PG8_STAGE(PG8_SA(0, 1), a2 + hstep, voffA);
            PG8_WAIT_L(8); PG8_BAR; PG8_WAIT_L(0); PG8_MMA(0, 0, At, B0); PG8_BAR; PG8_SCHED;
            PG8_LDB(B1, 1, 1); PG8_STAGE(PG8_SB(1, 0), b3, voffB);
            PG8_BAR; PG8_WAIT_L(0); PG8_MMA(0, 1, At, B1); PG8_BAR;
            PG8_LDA(At, 1, 1); PG8_STAGE(PG8_SA(1, 0), a3, voffA);
            PG8_BAR; PG8_WAIT_L(0); PG8_MMA(1, 0, At, B0); PG8_BAR; PG8_SCHED;
            PG8_STAGE(PG8_SB(1, 1), b3 + hstep, voffB);
            PG8_WAIT_V(6); PG8_BAR; PG8_MMA(1, 1, At, B1); PG8_BAR;
        }
        PG8_STAMP();
        if constexpr (!Epi::AFTER_DRAIN) { E(acc, cur, wr, wc, fr, fq); S.done(cur); }
        PG8_STAMP();
        if (!has_next) break;
#pragma unroll
        for (int a = 0; a < 2; ++a)
#pragma unroll
            for (int b = 0; b < 2; ++b)
#pragma unroll
                for (int m = 0; m < 4; ++m)
#pragma unroll
                    for (int n = 0; n < 2; ++n) acc[a][b][m][n] = (f32x4){0.f, 0.f, 0.f, 0.f};
        cur = nxt; cA = nA; cB = nB; ++ui;
    }
    PG8_WAIT_V(0);
    if (wr == 0) PG8_BAR;
    PG8_BAR;
    if constexpr (Epi::AFTER_DRAIN) { E.fused(acc, cur, wr, wc, fr, fq, lds, wid, lane); S.done(cur); }
    PG8_STAMP();
    if (STAMP && wid == 0) { stamps[lane] = lane < nts ? (((unsigned long long)(unsigned)ts_hi << 32) | (unsigned)ts_lo) : 0ull;
        if (lane == 62) stamps[62] = rt_entry; if (lane == 63) stamps[63] = (unsigned long long)wall_clock64(); }
#undef PG8_STAMP
#undef PG8_SA
#undef PG8_SB
#undef PG8_STAGE
#undef PG8_LDA
#undef PG8_LDB
#undef PG8_MMA
#undef PG8_WAIT_V
#undef PG8_WAIT_L
#undef PG8_BAR
#undef PG8_SCHED
}
}

namespace pg8 {
struct EpiProj {
    static constexpr bool PERM = true, AFTER_DRAIN = false;
    bf16_t* O; int ldc; int ncols;
    __device__ __forceinline__ void operator()(const f32x4 (&acc)[2][2][4][2], const Unit& u, int wr, int wc, int fr, int fq) const {
        const int row0 = u.pm * BM + wr * 64 + fr; const int col0 = u.pn * BM + wc * 32 + 8 * fq;
#pragma unroll
        for (int ai = 0; ai < 2; ++ai)
#pragma unroll
            for (int m = 0; m < 4; ++m) { bf16_t* rowp = O + (size_t)(row0 + ai * HALF + m * 16) * ldc + col0;
#pragma unroll
                for (int bj = 0; bj < 2; ++bj) { const f32x4 v0 = acc[ai][bj][m][0], v1 = acc[ai][bj][m][1];
                    u32x4 w; w.x = cvt_pk_bf16(v0[0], v0[1]); w.y = cvt_pk_bf16(v0[2], v0[3]); w.z = cvt_pk_bf16(v1[0], v1[1]); w.w = cvt_pk_bf16(v1[2], v1[3]);
                    if (col0 + bj * HALF < ncols) *(u32x4*)(rowp + bj * HALF) = w; } }
    }
};
struct EpiU {
    static constexpr bool PERM = true, AFTER_DRAIN = false;
    void* O; int ldc; int ncols; int f32out;
    __device__ __forceinline__ void operator()(const f32x4 (&acc)[2][2][4][2], const Unit& u, int wr, int wc, int fr, int fq) const {
        const int row0 = u.pm * BM + wr * 64 + fr; const int col0 = u.pn * BM + wc * 32 + 8 * fq;
        if (f32out) {
#pragma unroll
            for (int ai = 0; ai < 2; ++ai)
#pragma unroll
                for (int m = 0; m < 4; ++m) { float* rowp = (float*)O + (size_t)(row0 + ai * HALF + m * 16) * ldc + col0;
#pragma unroll
                    for (int bj = 0; bj < 2; ++bj) { *(f32x4*)(rowp + bj * HALF) = acc[ai][bj][m][0]; *(f32x4*)(rowp + bj * HALF + 4) = acc[ai][bj][m][1]; } }
        } else {
#pragma unroll
            for (int ai = 0; ai < 2; ++ai)
#pragma unroll
                for (int m = 0; m < 4; ++m) { bf16_t* rowp = (bf16_t*)O + (size_t)(row0 + ai * HALF + m * 16) * ldc + col0;
#pragma unroll
                    for (int bj = 0; bj < 2; ++bj) { const f32x4 v0 = acc[ai][bj][m][0], v1 = acc[ai][bj][m][1];
                        u32x4 w; w.x = cvt_pk_bf16(v0[0], v0[1]); w.y = cvt_pk_bf16(v0[2], v0[3]); w.z = cvt_pk_bf16(v1[0], v1[1]); w.w = cvt_pk_bf16(v1[2], v1[3]);
                        if (col0 + bj * HALF < ncols) *(u32x4*)(rowp + bj * HALF) = w; } }
        }
    }
};
}

#define XB_TMO      128
#define XB_XCNT(j)  (256  + 64 * (j))
#define XB_XSUB(j)  (1280 + 64 * (j))
#define XB_XGEN(j)  (2304 + 64 * (j))
#define XB_TOP      3328
#define XB_TOPGEN   3392
#define XCD_BAR_WORDS 3456
#define XB_SPIN_CAP (1u << 18)
#define LAS __attribute__((address_space(3)))

__device__ __forceinline__ unsigned xb_ld(unsigned* p)              { return __hip_atomic_load(p, __ATOMIC_RELAXED, __HIP_MEMORY_SCOPE_AGENT); }
__device__ __forceinline__ unsigned xb_add(unsigned* p, unsigned v) { return __hip_atomic_fetch_add(p, v, __ATOMIC_RELAXED, __HIP_MEMORY_SCOPE_AGENT); }
__device__ __forceinline__ unsigned xb_xcc_id() { return (unsigned)__builtin_amdgcn_s_getreg((3 << 11) | 20) & 0xFu; }
#define XB_SPIN(cond, bar) do { unsigned _sp = 0; while (cond) { __builtin_amdgcn_s_sleep(1); \
    if ((++_sp & 255u) == 0u) { if (xb_ld(&(bar)[XB_TMO])) break; if (_sp > XB_SPIN_CAP) { atomicAdd(&(bar)[XB_TMO], 1u); break; } } } } while (0)

struct XcdBarrier {
    unsigned* bar; unsigned x;
    volatile LAS unsigned* st;
};

__device__ __forceinline__ XcdBarrier xcd_barrier_post(unsigned* bar, volatile LAS unsigned* st) {
    XcdBarrier b; b.bar = bar; b.x = xb_xcc_id(); b.st = st;
    if (threadIdx.x == 0) (void)xb_add(&bar[XB_XCNT(b.x)], 1u);
    return b;
}
__device__ __forceinline__ void xcd_barrier_complete(unsigned* bar, unsigned x, unsigned& nloc, unsigned& nx) {
    const unsigned G = gridDim.x * gridDim.y * gridDim.z;
    unsigned sum, cnt, mine, sp = 0u;
    for (;;) {
        sum = 0u; cnt = 0u; mine = 0u;
#pragma unroll
        for (unsigned j = 0; j < 16; ++j) { const unsigned c = xb_ld(&bar[XB_XCNT(j)]); sum += c; cnt += (c > 0u) ? 1u : 0u; mine = (j == x) ? c : mine; }
        if (sum == G) break;
        __builtin_amdgcn_s_sleep(1);
        if ((++sp & 255u) == 0u) { if (xb_ld(&bar[XB_TMO])) break; if (sp > XB_SPIN_CAP) { atomicAdd(&bar[XB_TMO], 1u); break; } }
    }
    nloc = mine > 0u ? mine : 1u; nx = cnt > 0u ? cnt : 1u;
}

__device__ __forceinline__ void xcd_barrier(const XcdBarrier& b) {
    asm volatile("s_waitcnt vmcnt(0)" ::: "memory");
    __syncthreads();
    if (threadIdx.x == 0) {
        unsigned* bar = b.bar;
        __builtin_amdgcn_s_waitcnt(0);
        unsigned nloc = b.st[0], nx = b.st[1];
        if (nloc == 0u) { xcd_barrier_complete(bar, b.x, nloc, nx); b.st[0] = nloc; b.st[1] = nx; }
        const unsigned old = xb_add(&bar[XB_XSUB(b.x)], 1u);
        const unsigned gen = old / nloc;
        if (old + 1u == (gen + 1u) * nloc) {
            __builtin_amdgcn_fence(__ATOMIC_RELEASE, "agent");
            asm volatile("s_waitcnt vmcnt(0)" ::: "memory");
            const unsigned og = xb_add(&bar[XB_TOP], 1u);
            const unsigned tg = og / nx;
            if (og + 1u == (tg + 1u) * nx) xb_add(&bar[XB_TOPGEN], 1u);
            else XB_SPIN(xb_ld(&bar[XB_TOPGEN]) == tg, bar);
            __builtin_amdgcn_fence(__ATOMIC_ACQUIRE, "agent");
            xb_add(&bar[XB_XGEN(b.x)], 1u);
            asm volatile("s_waitcnt vmcnt(0)" ::: "memory");
        } else {
            XB_SPIN(xb_ld(&bar[XB_XGEN(b.x)]) == gen, bar);
            __builtin_amdgcn_fence(__ATOMIC_ACQUIRE, "agent");
            asm volatile("s_waitcnt vmcnt(0)" ::: "memory");
        }
    }
    __syncthreads();
}

__device__ void phase_mod_item(const Params& p, int it, unsigned char* smem) {
  float* red = (float*)smem;
  const int tid = opaque_tid(), tx = tid & 31, ty = tid >> 5;
  float* mod = (float*)(p.ws + OFF_MOD);
  it = opq(it);
  {
    int l = it / 96;
    int j = (it % 96) * 32 + tx;
    const float* W = p.ada_w + (size_t)l * 1024 * 3072;
    float acc = 0.f;
    for (int i = 0; i < 128; ++i) {
      int k = ty * 128 + i;
      float cv = p.c[k];
      acc += silu(cv) * W[(size_t)k * 3072 + j];
    }
    red[ty * 32 + tx] = acc;
    __syncthreads();
    if (ty == 0) {
      float s = 0.f;
      for (int g = 0; g < 8; ++g) s += red[g * 32 + tx];
      mod[l * 3072 + j] = s + p.ada_b[l * 3072 + j];
    }
    __syncthreads();
  }
}

__device__ __forceinline__ float wall_src(const Params& p, int l, int k, int n) {
  size_t lk = (size_t)l * 1024 + k;
  if (n < 3072) return p.w_in[lk * 3072 + n];
  if (n < 3136) return (1.f - p.mu_w[lk]) * p.w1[lk * 64 + (n - 3072)];
  if (n < 3200) return p.mu_w[lk] * p.w1[lk * 64 + (n - 3136)];
  if (n < 3264) return (1.f - p.mu_a[lk]) * p.a1[lk * 64 + (n - 3200)];
  if (n < 3328) return p.mu_a[lk] * p.a1[lk * 64 + (n - 3264)];
  if (n < 3344) return p.gk1[lk * 16 + (n - 3328)];
  return 0.f;
}

__device__ void phase_wconv_item(const Params& p, int it, unsigned char* smem) {
  float* tile = (float*)smem;
  const int tid = opaque_tid();
  u16* WALL = (u16*)(p.ws + OFF_WALL);
  u16* WOUT = (u16*)(p.ws + OFF_WOUT);
  it = opq(it);
  {
    bool isout = it >= 3456;
    int l, nt, kt;
    if (!isout) { l = it / 864; int r = it % 864; nt = r >> 4; kt = r & 15; }
    else { int r = it - 3456; l = r >> 8; r &= 255; nt = r >> 4; kt = r & 15; }
    int tx = tid & 63, ty = tid >> 6;
#pragma unroll 4
    for (int i = 0; i < 16; ++i) {
      int kl = ty + 4 * i;
      int k = kt * 64 + kl, n = nt * 64 + tx;
      float v = isout ? p.w_out[((size_t)l * 1024 + k) * 1024 + n] : wall_src(p, l, k, n);
      tile[kl * 65 + tx] = v;
    }
    __syncthreads();
    int nl = tid >> 2, kq = tid & 3;
    unsigned w[8];
#pragma unroll
    for (int j = 0; j < 8; ++j) w[j] = pack2(tile[(kq * 16 + 2 * j) * 65 + nl], tile[(kq * 16 + 2 * j + 1) * 65 + nl]);
    u16* dst = (isout ? WOUT + ((size_t)l * 1024 + nt * 64 + nl) * 1024 : WALL + ((size_t)l * NALL + nt * 64 + nl) * 1024) + kt * 64 + kq * 16;
    ((uint4*)dst)[0] = make_uint4(w[0], w[1], w[2], w[3]);
    ((uint4*)dst)[1] = make_uint4(w[4], w[5], w[6], w[7]);
    __syncthreads();
  }
}

__device__ void phase_w2t_item(const Params& p, int it) {
  it = opq(it);
  const int c = opaque_tid();
  const int l = it >> 1, which = it & 1;
  const float* src = (which ? p.a2 : p.w2) + (size_t)l * 64 * 256 + c;
  u16* dst = (u16*)(p.ws + (which ? OFF_A2T : OFF_W2T)) + ((size_t)l * 256 + c) * 64;
#pragma unroll
  for (int j8 = 0; j8 < 8; ++j8) {
    float f[8];
#pragma unroll
    for (int q = 0; q < 8; ++q) f[q] = src[(j8 * 8 + q) * 256];
    *(uint4*)(dst + j8 * 8) = make_uint4(pack2(f[0], f[1]), pack2(f[2], f[3]), pack2(f[4], f[5]), pack2(f[6], f[7]));
  }
}

__device__ __forceinline__ void write_h(const Params& p, int l, int row, int lane, const float4* v, float ss) {
  const float* mod = (const float*)(p.ws + OFF_MOD) + l * 3072;
  u16* H = (u16*)(p.ws + OFF_H);
  float rs = rsqrtf(ss * (1.f / 1024.f) + 1e-6f);
#pragma unroll
  for (int i = 0; i < 4; ++i) {
    int col = (lane + 64 * i) * 4;
    float4 g = *(const float4*)(p.norm_pre + l * 1024 + col);
    float4 sh = *(const float4*)(mod + col);
    float4 sc = *(const float4*)(mod + 1024 + col);
    float h0 = v[i].x * rs * g.x * (1.f + sc.x) + sh.x;
    float h1 = v[i].y * rs * g.y * (1.f + sc.y) + sh.y;
    float h2 = v[i].z * rs * g.z * (1.f + sc.z) + sh.z;
    float h3 = v[i].w * rs * g.w * (1.f + sc.w) + sh.w;
    *(uint2*)(H + (size_t)row * 1024 + col) = make_uint2(pack2(h0, h1), pack2(h2, h3));
  }
}

__device__ void phase_h0(const Params& p) {
  const int tid = opaque_tid512(); const int wave = tid >> 6, lane = tid & 63;
  for (int row = blockIdx.x * 8 + wave; row < T_; row += gridDim.x * 8) {
    const float4* xr = (const float4*)(p.x + (size_t)row * 1024);
    float4 v[4];
    float ss = 0.f;
#pragma unroll
    for (int i = 0; i < 4; ++i) {
      v[i] = xr[lane + 64 * i];
      ss += v[i].x * v[i].x + v[i].y * v[i].y + v[i].z * v[i].z + v[i].w * v[i].w;
    }
    ss = wave_sum(ss);
    write_h(p, 0, row, lane, v, ss);
  }
}

__device__ void phase_post(const Params& p, int l) {
  l = opq(l);
  const int tid = opaque_tid512(); const int wave = tid >> 6, lane = tid & 63;
  const u16* Y = (const u16*)(p.ws + OFF_PROJ);
  const float* mod = (const float*)(p.ws + OFF_MOD) + l * 3072;
  const float* xold = (l == 0) ? p.x : p.out;
  for (int row = blockIdx.x * 8 + wave; row < T_; row += gridDim.x * 8) {
    const uint2* yr = (const uint2*)(Y + (size_t)row * 1024);
    const float4* xr = (const float4*)(xold + (size_t)row * 1024);
    float4 y[4], v[4];
    float ss = 0.f;
#pragma unroll
    for (int i = 0; i < 4; ++i) {
      const uint2 u = yr[lane + 64 * i];
      y[i] = make_float4(bflo(u.x), bfhi(u.x), bflo(u.y), bfhi(u.y));
      v[i] = xr[lane + 64 * i];
      ss += y[i].x * y[i].x + y[i].y * y[i].y + y[i].z * y[i].z + y[i].w * y[i].w;
    }
    ss = wave_sum(ss);
    float rs = rsqrtf(ss * (1.f / 1024.f) + 1e-6f);
    float s2 = 0.f;
#pragma unroll
    for (int i = 0; i < 4; ++i) {
      int col = (lane + 64 * i) * 4;
      float4 g = *(const float4*)(p.norm_post + l * 1024 + col);
      float4 gt = *(const float4*)(mod + 2048 + col);
      v[i].x += gt.x * (y[i].x * rs * g.x);
      v[i].y += gt.y * (y[i].y * rs * g.y);
      v[i].z += gt.z * (y[i].z * rs * g.z);
      v[i].w += gt.w * (y[i].w * rs * g.w);
      *(float4*)(p.out + (size_t)row * 1024 + col) = v[i];
      s2 += v[i].x * v[i].x + v[i].y * v[i].y + v[i].z * v[i].z + v[i].w * v[i].w;
    }
    if (l < 3) {
      s2 = wave_sum(s2);
      write_h(p, l + 1, row, lane, v, s2);
    }
  }
}

__device__ void attn_item(const Params& p, int l, int item, unsigned char* smem) {
  l = opq(l); item = opq(item);
  u16* Vt = (u16*)smem;
  const u16* PROJ = (const u16*)(p.ws + OFF_PROJ);
  u16* MIX = (u16*)(p.ws + OFF_MIX);
  const int tid = opaque_tid(), w = tid >> 6, lane = tid & 63, l31 = lane & 31, hf = lane >> 5;
  const int qb = item >> 3, head = item & 7, kvh = head >> 2;
  const int kpos0 = (qb - 1) * 128;
  {
    int kp = kpos0 + tid;
    if (kp < 0) kp = 0;
    const uint4* src = (const uint4*)(PROJ + (size_t)kp * NALL + 640 + kvh * 64);
#pragma unroll
    for (int c8 = 0; c8 < 8; ++c8) {
      uint4 v = src[c8];
      int d = c8 * 8;
      Vt[(d + 0) * 264 + tid] = (u16)(v.x & 0xffff);
      Vt[(d + 1) * 264 + tid] = (u16)(v.x >> 16);
      Vt[(d + 2) * 264 + tid] = (u16)(v.y & 0xffff);
      Vt[(d + 3) * 264 + tid] = (u16)(v.y >> 16);
      Vt[(d + 4) * 264 + tid] = (u16)(v.z & 0xffff);
      Vt[(d + 5) * 264 + tid] = (u16)(v.z >> 16);
      Vt[(d + 6) * 264 + tid] = (u16)(v.w & 0xffff);
      Vt[(d + 7) * 264 + tid] = (u16)(v.w >> 16);
    }
  }
  __syncthreads();
  const int tq = qb * 128 + 32 * w + l31;
  bf16x8 qf[4];
  {
    const u16* qp = PROJ + (size_t)tq * NALL + head * 64 + 8 * hf;
#pragma unroll
    for (int s = 0; s < 4; ++s) qf[s] = *(const bf16x8*)(qp + 16 * s);
  }
  const float slope = exp2f(-(float)(head + 1));
  const float sink = p.sinks[l * 8 + head];
  const int rq = 32 * w + l31;
  float mrun = -1e30f, lsum = 0.f;
  f32x16 o0, o1;
#pragma unroll
  for (int r = 0; r < 16; ++r) { o0[r] = 0.f; o1[r] = 0.f; }
#pragma unroll 1
  for (int i = 0; i < 5; ++i) {
    int kp = kpos0 + 32 * w + 32 * i + l31;
    if (kp < 0) kp = 0;
    const u16* kptr = PROJ + (size_t)kp * NALL + 512 + kvh * 64 + 8 * hf;
    f32x16 a;
#pragma unroll
    for (int r = 0; r < 16; ++r) a[r] = 0.f;
#pragma unroll
    for (int s = 0; s < 4; ++s) {
      bf16x8 kf = *(const bf16x8*)(kptr + 16 * s);
      a = __builtin_amdgcn_mfma_f32_32x32x16_bf16(kf, qf[s], a, 0, 0, 0);
    }
    float tmax = -1e30f;
#pragma unroll
    for (int r = 0; r < 16; ++r) {
      int kj = 32 * w + 32 * i + (r & 3) + 8 * (r >> 2) + 4 * hf;
      int dist = 128 + rq - kj;
      bool valid = (dist >= 0) && (dist < 128) && (kpos0 + kj >= 0);
      float sv = a[r] * 0.125f - slope * (float)dist;
      sv = valid ? sv : -1e30f;
      a[r] = sv;
      tmax = fmaxf(tmax, sv);
    }
    tmax = fmaxf(tmax, __shfl_xor(tmax, 32));
    const float mnew = fmaxf(mrun, tmax);
    const float alpha = __expf(mrun - mnew);
    float psum = 0.f;
#pragma unroll
    for (int r = 0; r < 16; ++r) {
      float e = (a[r] > -1e29f) ? __expf(a[r] - mnew) : 0.f;
      a[r] = e;
      psum += e;
    }
    lsum = lsum * alpha + psum;
    mrun = mnew;
#pragma unroll
    for (int r = 0; r < 16; ++r) { o0[r] *= alpha; o1[r] *= alpha; }
#pragma unroll
    for (int u = 0; u < 2; ++u) {
      bf16x8 pf;
#pragma unroll
      for (int j = 0; j < 8; ++j) pf[j] = (short)f2bf(a[8 * u + j]);
      const int kb = 32 * w + 32 * i + 16 * u + 4 * hf;
      const u16* v0 = Vt + l31 * 264 + kb;
      const u16* v1 = Vt + (32 + l31) * 264 + kb;
      uint2 a0 = *(const uint2*)(v0), a1 = *(const uint2*)(v0 + 8);
      uint2 b0 = *(const uint2*)(v1), b1 = *(const uint2*)(v1 + 8);
      uint4 A0 = make_uint4(a0.x, a0.y, a1.x, a1.y), A1 = make_uint4(b0.x, b0.y, b1.x, b1.y);
      o0 = __builtin_amdgcn_mfma_f32_32x32x16_bf16(__builtin_bit_cast(bf16x8, A0), pf, o0, 0, 0, 0);
      o1 = __builtin_amdgcn_mfma_f32_32x32x16_bf16(__builtin_bit_cast(bf16x8, A1), pf, o1, 0, 0, 0);
    }
  }
  {
    const float mf = fmaxf(mrun, sink);
    const float scl = __expf(mrun - mf);
    const float ltot = (lsum + __shfl_xor(lsum, 32)) * scl + __expf(sink - mf);
    const float fin = scl / ltot;
#pragma unroll
    for (int r = 0; r < 16; ++r) { o0[r] *= fin; o1[r] *= fin; }
  }
  const u16* gp = PROJ + (size_t)tq * NALL + 768 + head * 64;
  u16* op = MIX + (size_t)tq * 1024 + head * 64;
#pragma unroll
  for (int g = 0; g < 4; ++g) {
    int d0 = 8 * g + 4 * hf;
    uint2 gg = *(const uint2*)(gp + d0);
    float r0 = o0[4 * g + 0] * silu(bflo(gg.x)), r1 = o0[4 * g + 1] * silu(bfhi(gg.x));
    float r2 = o0[4 * g + 2] * silu(bflo(gg.y)), r3 = o0[4 * g + 3] * silu(bfhi(gg.y));
    *(uint2*)(op + d0) = make_uint2(pack2(r0, r1), pack2(r2, r3));
    uint2 g2 = *(const uint2*)(gp + 32 + d0);
    r0 = o1[4 * g + 0] * silu(bflo(g2.x)); r1 = o1[4 * g + 1] * silu(bfhi(g2.x));
    r2 = o1[4 * g + 2] * silu(bflo(g2.y)); r3 = o1[4 * g + 3] * silu(bfhi(g2.y));
    *(uint2*)(op + 32 + d0) = make_uint2(pack2(r0, r1), pack2(r2, r3));
  }
  __syncthreads();
}

__device__ void rwkv_prep_item(const Params& p, int l, int item, unsigned char* smem) {
  l = opq(l); item = opq(item);
  u16* lwb = (u16*)smem;
  u16* lab = lwb + 16 * 72;
  const u16* PROJ = (const u16*)(p.ws + OFF_PROJ);
  const int tid = opaque_tid(), head = tid >> 6, lane = tid & 63, fr = lane & 15, fq = lane >> 4;
  const int t0 = item * 16;
#pragma unroll
  for (int i = 0; i < 8; ++i) {
    int idx = tid + 256 * i;
    int which = idx >> 10, tt = (idx >> 6) & 15, j = idx & 63;
    int t = t0 + tt;
    const u16* pr = PROJ + (size_t)t * NALL;
    float cur = bf2f(pr[(which ? 3200 : 3072) + j]);
    float prev = (t > 0) ? bf2f((pr - NALL)[(which ? 3264 : 3136) + j]) : 0.f;
    float sv = cur + prev;
    if (!which) sv = tanhf(sv);
    (which ? lab : lwb)[tt * 72 + j] = f2bf(sv);
  }
  __syncthreads();
  f32x4 accw[4], acca[4];
#pragma unroll
  for (int nt = 0; nt < 4; ++nt) { accw[nt] = (f32x4){0.f, 0.f, 0.f, 0.f}; acca[nt] = (f32x4){0.f, 0.f, 0.f, 0.f}; }
  {
    const u16* W2T = (const u16*)(p.ws + OFF_W2T) + ((size_t)l * 256 + head * 64 + fr) * 64 + fq * 8;
    const u16* A2T = (const u16*)(p.ws + OFF_A2T) + ((size_t)l * 256 + head * 64 + fr) * 64 + fq * 8;
#pragma unroll
    for (int ks = 0; ks < 2; ++ks) {
      const bf16x8 aw = *(const bf16x8*)(lwb + fr * 72 + ks * 32 + fq * 8);
      const bf16x8 aa = *(const bf16x8*)(lab + fr * 72 + ks * 32 + fq * 8);
#pragma unroll
      for (int nt = 0; nt < 4; ++nt) {
        const bf16x8 bw = *(const bf16x8*)(W2T + nt * 16 * 64 + ks * 32);
        const bf16x8 ba = *(const bf16x8*)(A2T + nt * 16 * 64 + ks * 32);
        accw[nt] = __builtin_amdgcn_mfma_f32_16x16x32_bf16(aw, bw, accw[nt], 0, 0, 0);
        acca[nt] = __builtin_amdgcn_mfma_f32_16x16x32_bf16(aa, ba, acca[nt], 0, 0, 0);
      }
    }
  }
  float mur[4], muk[4], muv[4], w0[4], a0[4], kkw[4], kaw[4], rkw[4];
#pragma unroll
  for (int nt = 0; nt < 4; ++nt) {
    const int c = head * 64 + nt * 16 + fr;
    mur[nt] = p.mu_rkv[l * 768 + c]; muk[nt] = p.mu_rkv[l * 768 + 256 + c]; muv[nt] = p.mu_rkv[l * 768 + 512 + c];
    w0[nt] = p.w0[l * 256 + c]; a0[nt] = p.a0[l * 256 + c]; kkw[nt] = p.k_k[l * 256 + c]; kaw[nt] = p.k_a[l * 256 + c]; rkw[nt] = p.r_k[l * 256 + c];
  }
  float* RWW = (float*)(p.ws + OFF_RWW);
  float* RWKK = (float*)(p.ws + OFF_RWKK);
  u16* RB = (u16*)(p.ws + OFF_RWB);
  float* BON = (float*)(p.ws + OFF_BONUS);
#pragma unroll
  for (int rg = 0; rg < 4; ++rg) {
    const int t = t0 + fq * 4 + rg;
    const u16* pr = PROJ + (size_t)t * NALL;
    float kkc[4], av[4];
    float n2 = 0.f, bonus = 0.f;
#pragma unroll
    for (int nt = 0; nt < 4; ++nt) {
      const int c = head * 64 + nt * 16 + fr;
      float rc = bf2f(pr[1280 + c]), kc = bf2f(pr[1536 + c]), vc = bf2f(pr[1792 + c]);
      float rp = 0.f, kp = 0.f, vp = 0.f;
      if (t > 0) { rp = bf2f((pr - NALL)[1280 + c]); kp = bf2f((pr - NALL)[1536 + c]); vp = bf2f((pr - NALL)[1792 + c]); }
      const float r = rc + (rp - rc) * mur[nt], k = kc + (kp - kc) * muk[nt], v = vc + (vp - vc) * muv[nt];
      const float wpre = w0[nt] + accw[nt][rg];
      const float wl = -softplusf_(-wpre) - 0.5f;
      const float decay = __expf(-__expf(wl));
      const float a = sigmoidf_(a0[nt] + acca[nt][rg]);
      const float kc2 = k * kkw[nt];
      const float kmod = k * (1.f + (a - 1.f) * kaw[nt]);
      kkc[nt] = kc2; av[nt] = a;
      n2 += kc2 * kc2;
      bonus += r * kmod * rkw[nt];
      const size_t o = (size_t)t * 256 + c;
      RWW[o] = decay;
      RB[o] = f2bf(r);
      RB[(size_t)T_ * 256 + o] = f2bf(kmod);
      RB[(size_t)2 * T_ * 256 + o] = f2bf(v);
    }
    n2 = row16_allsum(n2);
    bonus = row16_allsum(bonus);
    const float inv = 1.f / fmaxf(sqrtf(n2), 1e-12f);
#pragma unroll
    for (int nt = 0; nt < 4; ++nt) {
      const int c = head * 64 + nt * 16 + fr;
      const size_t o = (size_t)t * 256 + c;
      const float kk = kkc[nt] * inv;
      RWKK[o] = kk;
      RB[(size_t)3 * T_ * 256 + o] = f2bf(kk * av[nt]);
    }
    if (fr == 0) BON[t * 4 + head] = bonus;
  }
  __syncthreads();
}

__device__ __forceinline__ void gla_b(const Params& p, int l, int chunk, int head, float* tot, float* bl) {
  const u16* PROJ = (const u16*)(p.ws + OFF_PROJ);
  const int tid = opaque_tid(), d = tid & 31, ig = tid >> 5;
  float g2[16];
#pragma unroll
  for (int m = 0; m < 16; ++m) g2[m] = p.gk2[(size_t)l * 16 * 128 + m * 128 + head * 32 + d];
  const float bias = p.gk_b[l * 128 + head * 32 + d];
  float run = 0.f;
#pragma unroll
  for (int ii = 0; ii < 8; ++ii) {
    int t = chunk * 64 + ig * 8 + ii;
    const uint4* lp = (const uint4*)(PROJ + (size_t)t * NALL + 3328);
    uint4 u0 = lp[0], u1 = lp[1];
    float z = bias;
    z += bflo(u0.x) * g2[0] + bfhi(u0.x) * g2[1] + bflo(u0.y) * g2[2] + bfhi(u0.y) * g2[3];
    z += bflo(u0.z) * g2[4] + bfhi(u0.z) * g2[5] + bflo(u0.w) * g2[6] + bfhi(u0.w) * g2[7];
    z += bflo(u1.x) * g2[8] + bfhi(u1.x) * g2[9] + bflo(u1.y) * g2[10] + bfhi(u1.y) * g2[11];
    z += bflo(u1.z) * g2[12] + bfhi(u1.z) * g2[13] + bflo(u1.w) * g2[14] + bfhi(u1.w) * g2[15];
    float g = (fminf(z, 0.f) - log1pf(__expf(-fabsf(z)))) * (1.f / 16.f);
    run += g;
    bl[ii] = run;
  }
  tot[ig * 32 + d] = run;
  __syncthreads();
  float off = 0.f;
#pragma unroll
  for (int g = 0; g < 8; ++g) off += (g < ig) ? tot[g * 32 + d] : 0.f;
#pragma unroll
  for (int ii = 0; ii < 8; ++ii) bl[ii] += off;
}

__device__ void gla_local_item(const Params& p, int l, int item, unsigned char* smem) {
  l = opq(l); item = opq(item);
  float* tot = (float*)smem;
  float* Kp = tot + 256;
  float* Vs = Kp + 2048;
  const u16* PROJ = (const u16*)(p.ws + OFF_PROJ);
  const int tid = opaque_tid(), d = tid & 31, ig = tid >> 5;
  const int chunk = item >> 2, head = item & 3;
  float bl[8];
  gla_b(p, l, chunk, head, tot, bl);
  float blast = 0.f;
#pragma unroll
  for (int g = 0; g < 8; ++g) blast += tot[g * 32 + d];
#pragma unroll
  for (int ii = 0; ii < 8; ++ii) {
    int i = ig * 8 + ii;
    int t = chunk * 64 + i;
    float k = bf2f(PROJ[(size_t)t * NALL + 2432 + head * 32 + d]);
    Kp[i * 32 + d] = k * __expf(blast - bl[ii]);
  }
#pragma unroll
  for (int r = 0; r < 16; ++r) {
    int idx = tid + 256 * r;
    int i = idx >> 6, v = idx & 63;
    Vs[idx] = bf2f(PROJ[(size_t)(chunk * 64 + i) * NALL + 2560 + head * 64 + v]);
  }
  __syncthreads();
  const int v = tid & 63, dg = tid >> 6;
  float acc[8];
#pragma unroll
  for (int q = 0; q < 8; ++q) acc[q] = 0.f;
  for (int i = 0; i < 64; ++i) {
    float vv = Vs[i * 64 + v];
    float4 k0 = *(const float4*)(Kp + i * 32 + dg * 8), k1 = *(const float4*)(Kp + i * 32 + dg * 8 + 4);
    acc[0] += k0.x * vv; acc[1] += k0.y * vv; acc[2] += k0.z * vv; acc[3] += k0.w * vv;
    acc[4] += k1.x * vv; acc[5] += k1.y * vv; acc[6] += k1.z * vv; acc[7] += k1.w * vv;
  }
  float* GS = (float*)(p.ws + OFF_GLAS);
  float* GD = (float*)(p.ws + OFF_GLAD);
#pragma unroll
  for (int q = 0; q < 8; ++q) GS[((size_t)(chunk * 4 + head) * 32 + dg * 8 + q) * 64 + v] = acc[q];
  if (tid < 32) GD[(chunk * 4 + head) * 32 + tid] = __expf(blast);
  __syncthreads();
}

__device__ void gla_state_block(const Params& p, int eb, unsigned char* dsm_) {
  float* comp = (float*)dsm_;
  float* GS = (float*)(p.ws + OFF_GLAS);
  const float* GD = (const float*)(p.ws + OFF_GLAD);
  eb = opq(eb);
  const int tid = opaque_tid512();
  const int ei = tid & 31, g = tid >> 5;
  const int e = eb * 32 + ei;
  const int head = e >> 11, d = (e >> 6) & 31, v = e & 63;
  float ds[16], dc[16];
#pragma unroll
  for (int i = 0; i < 16; ++i) {
    const int c = g * 16 + i;
    ds[i] = GS[((size_t)(c * 4 + head) * 32 + d) * 64 + v];
    dc[i] = GD[(c * 4 + head) * 32 + d];
  }
  float S = 0.f, P = 1.f;
#pragma unroll
  for (int i = 0; i < 16; ++i) { S = dc[i] * S + ds[i]; P *= dc[i]; }
  comp[(g * 32 + ei) * 2] = P;
  comp[(g * 32 + ei) * 2 + 1] = S;
  __syncthreads();
  float G = 0.f;
  for (int gg = 0; gg < g; ++gg) G = comp[(gg * 32 + ei) * 2] * G + comp[(gg * 32 + ei) * 2 + 1];
#pragma unroll
  for (int i = 0; i < 16; ++i) {
    const int c = g * 16 + i;
    GS[((size_t)(c * 4 + head) * 32 + d) * 64 + v] = G;
    G = dc[i] * G + ds[i];
  }
  __syncthreads();
}

__device__ void gla_out_item(const Params& p, int l, int item, unsigned char* smem) {
  l = opq(l); item = opq(item);
  float* tot = (float*)smem;
  float* qt = tot + 256;
  float* kt = qt + 2304;
  float* Vs = kt + 2304;
  float* Am = Vs + 4096;
  float* Ss = Am + 4352;
  const u16* PROJ = (const u16*)(p.ws + OFF_PROJ);
  u16* MIX = (u16*)(p.ws + OFF_MIX);
  const float* GS = (const float*)(p.ws + OFF_GLAS);
  const int tid = opaque_tid();
  const int chunk = item >> 2, head = item & 3;
  {
    const int d = tid & 31, ig = tid >> 5;
    float bl[8];
    gla_b(p, l, chunk, head, tot, bl);
#pragma unroll
    for (int ii = 0; ii < 8; ++ii) {
      int i = ig * 8 + ii;
      int t = chunk * 64 + i;
      float q = bf2f(PROJ[(size_t)t * NALL + 2304 + head * 32 + d]);
      float k = bf2f(PROJ[(size_t)t * NALL + 2432 + head * 32 + d]);
      qt[i * 36 + d] = q * 0.17677669529663687f * __expf(bl[ii]);
      kt[i * 36 + d] = k * __expf(-bl[ii]);
    }
  }
#pragma unroll
  for (int r = 0; r < 16; ++r) {
    int idx = tid + 256 * r;
    int i = idx >> 6, v = idx & 63;
    Vs[idx] = bf2f(PROJ[(size_t)(chunk * 64 + i) * NALL + 2560 + head * 64 + v]);
  }
#pragma unroll
  for (int r = 0; r < 8; ++r) {
    int idx = tid + 256 * r;
    Ss[idx] = GS[(size_t)(chunk * 4 + head) * 2048 + idx];
  }
  __syncthreads();
  const int j = tid & 63, ig = tid >> 6;
  {
    float acc[16];
#pragma unroll
    for (int ii = 0; ii < 16; ++ii) acc[ii] = 0.f;
#pragma unroll 2
    for (int d4 = 0; d4 < 8; ++d4) {
      const float4 kv = *(const float4*)(kt + j * 36 + d4 * 4);
#pragma unroll
      for (int ii = 0; ii < 16; ++ii) {
        const float4 qv = *(const float4*)(qt + (ig * 16 + ii) * 36 + d4 * 4);
        acc[ii] += qv.x * kv.x + qv.y * kv.y + qv.z * kv.z + qv.w * kv.w;
      }
    }
#pragma unroll
    for (int ii = 0; ii < 16; ++ii) {
      int i = ig * 16 + ii;
      Am[i * 68 + j] = (j <= i) ? acc[ii] : 0.f;
    }
  }
  __syncthreads();
  {
    const int v = j;
    float acc[16];
#pragma unroll
    for (int ii = 0; ii < 16; ++ii) acc[ii] = 0.f;
    const int jmax = (ig + 1) * 4;
    for (int j4 = 0; j4 < jmax; ++j4) {
      const float v0 = Vs[(j4 * 4 + 0) * 64 + v], v1 = Vs[(j4 * 4 + 1) * 64 + v], v2 = Vs[(j4 * 4 + 2) * 64 + v], v3 = Vs[(j4 * 4 + 3) * 64 + v];
#pragma unroll
      for (int ii = 0; ii < 16; ++ii) {
        const float4 av = *(const float4*)(Am + (ig * 16 + ii) * 68 + j4 * 4);
        acc[ii] += av.x * v0 + av.y * v1 + av.z * v2 + av.w * v3;
      }
    }
#pragma unroll 2
    for (int d4 = 0; d4 < 8; ++d4) {
      const float s0 = Ss[(d4 * 4 + 0) * 64 + v], s1 = Ss[(d4 * 4 + 1) * 64 + v], s2 = Ss[(d4 * 4 + 2) * 64 + v], s3 = Ss[(d4 * 4 + 3) * 64 + v];
#pragma unroll
      for (int ii = 0; ii < 16; ++ii) {
        const float4 qv = *(const float4*)(qt + (ig * 16 + ii) * 36 + d4 * 4);
        acc[ii] += qv.x * s0 + qv.y * s1 + qv.z * s2 + qv.w * s3;
      }
    }
    const float nw = p.gla_nw[l * 64 + v];
#pragma unroll
    for (int ii = 0; ii < 16; ++ii) {
      int t = chunk * 64 + ig * 16 + ii;
      float o = acc[ii];
      float ms = wave_sum(o * o) * (1.f / 64.f);
      float gg = bf2f(PROJ[(size_t)t * NALL + 2816 + head * 64 + v]);
      float r = o * rsqrtf(ms + 1e-5f) * nw * silu(gg);
      MIX[(size_t)t * 1024 + 768 + head * 64 + v] = f2bf(r);
    }
  }
  __syncthreads();
}

typedef float f32x2 __attribute__((ext_vector_type(2)));
__device__ __forceinline__ float oct_allsum(float x) {
  x += dpp_f<0xB1>(x);
  x += dpp_f<0x4E>(x);
  x += dpp_f<0x141>(x);
  return x;
}
__device__ void rwkv_scan_item(const Params& p, int item, unsigned char* dsm_) {
  item = opq(item);
  float* st = (float*)dsm_;
  const int tid = opaque_tid512(), wv = tid >> 6, lane = tid & 63, rs = lane >> 3, kl = lane & 7;
  const int head = item & 3, seg = item >> 2;
  const bool ident = wv >= 4;
  const int R0 = wv * 16 + rs * 2;
  const int v0 = R0 & 63;
  const float* RWW = (const float*)(p.ws + OFF_RWW);
  const float* RWKK = (const float*)(p.ws + OFF_RWKK);
  const u16* RB = (const u16*)(p.ws + OFF_RWB);
  float* PF = (float*)(p.ws + OFF_PROJ);
  float* ZP = (float*)(p.ws + OFF_ZP);
  const int tbase = seg * SL;
  const int half = tid >> 8, ls = (tid & 255) >> 4, lc4 = (tid & 15) * 4;
  f32x2 S0[4], S1[4];
#pragma unroll
  for (int e = 0; e < 4; ++e) { S0[e] = (f32x2){0.f, 0.f}; S1[e] = (f32x2){0.f, 0.f}; }
  if (ident) {
#pragma unroll
    for (int e = 0; e < 4; ++e) {
      const int k0 = kl * 8 + 2 * e;
      S0[e] = (f32x2){(v0 == k0) ? 1.f : 0.f, (v0 == k0 + 1) ? 1.f : 0.f};
      S1[e] = (f32x2){(v0 + 1 == k0) ? 1.f : 0.f, (v0 + 1 == k0 + 1) ? 1.f : 0.f};
    }
  }
  float4 g0 = make_float4(0.f, 0.f, 0.f, 0.f);
  uint2 h0 = make_uint2(0u, 0u), h1 = h0, h2 = h0;
  const float* gp0 = (half == 0 ? RWW : RWKK) + (size_t)(tbase + ls) * 256 + head * 64 + lc4;
  const u16* hp = RB + (size_t)(tbase + ls) * 256 + head * 64 + lc4;
#define SCAN_GLOAD(ch) do { const size_t _o = (size_t)(ch) * 16 * 256; g0 = *(const float4*)(gp0 + _o); \
    if (half == 0) { h0 = *(const uint2*)(hp + _o); } \
    else { h0 = *(const uint2*)(hp + (size_t)T_ * 256 + _o); h1 = *(const uint2*)(hp + (size_t)3 * T_ * 256 + _o); h2 = *(const uint2*)(hp + (size_t)2 * T_ * 256 + _o); } } while (0)
#define SCAN_LSTORE(buf) do { float* _b = st + (buf) * 6144 + ls * 64 + lc4; \
    if (half == 0) { *(float4*)(_b) = g0; *(float4*)(_b + 2048) = make_float4(bflo(h0.x), bfhi(h0.x), bflo(h0.y), bfhi(h0.y)); } \
    else { *(float4*)(_b + 1024) = g0; *(float4*)(_b + 3072) = make_float4(bflo(h0.x), bfhi(h0.x), bflo(h0.y), bfhi(h0.y)); \
           *(float4*)(_b + 4096) = make_float4(bflo(h1.x), bfhi(h1.x), bflo(h1.y), bfhi(h1.y)); *(float4*)(_b + 5120) = make_float4(bflo(h2.x), bfhi(h2.x), bflo(h2.y), bfhi(h2.y)); } } while (0)
  if (tid < 16) st[2 * 6144 + tid] = 0.f;
  SCAN_GLOAD(0);
  SCAN_LSTORE(0);
  __syncthreads();
  const int nch = SL / 16;
  float* yout = PF + (size_t)tbase * PROJF + (ident ? 256 : 0) + head * 64 + v0;
  const int voff = ident ? (2 * 6144) : (5120 + v0);
  const int vstep = ident ? 0 : 64, vbuf = ident ? 0 : 6144;
#define V2(a, i) ((f32x2){(i) ? a.z : a.x, (i) ? a.w : a.y})
#define SCAN_STEP(s_) do { \
    const float* bp = b + (s_) * 64 + kl * 8; \
    const float4 wl = *(const float4*)(bp), wh = *(const float4*)(bp + 4); \
    const float4 kkl = *(const float4*)(bp + 1024), kkh = *(const float4*)(bp + 1028); \
    const float4 rl4 = *(const float4*)(bp + 2048), rh4 = *(const float4*)(bp + 2052); \
    const float4 kl4 = *(const float4*)(bp + 3072), kh4 = *(const float4*)(bp + 3076); \
    const float4 bl4 = *(const float4*)(bp + 4096), bh4 = *(const float4*)(bp + 4100); \
    const f32x2 vv = *(const f32x2*)(vsrc + (s_) * vstep); \
    const f32x2 W[4] = {V2(wl, 0), V2(wl, 1), V2(wh, 0), V2(wh, 1)}, KK[4] = {V2(kkl, 0), V2(kkl, 1), V2(kkh, 0), V2(kkh, 1)}; \
    const f32x2 RR[4] = {V2(rl4, 0), V2(rl4, 1), V2(rh4, 0), V2(rh4, 1)}, KV[4] = {V2(kl4, 0), V2(kl4, 1), V2(kh4, 0), V2(kh4, 1)}; \
    const f32x2 BB[4] = {V2(bl4, 0), V2(bl4, 1), V2(bh4, 0), V2(bh4, 1)}; \
    f32x2 t0 = S0[0] * KK[0] + S0[1] * KK[1] + S0[2] * KK[2] + S0[3] * KK[3]; \
    f32x2 t1 = S1[0] * KK[0] + S1[1] * KK[1] + S1[2] * KK[2] + S1[3] * KK[3]; \
    float sa0 = -(t0.x + t0.y), sa1 = -(t1.x + t1.y); \
    sa0 += dpp_f<0xB1>(sa0); sa1 += dpp_f<0xB1>(sa1); sa0 += dpp_f<0x4E>(sa0); sa1 += dpp_f<0x4E>(sa1); sa0 += dpp_f<0x141>(sa0); sa1 += dpp_f<0x141>(sa1); \
    const f32x2 a0 = {sa0, sa0}, a1 = {sa1, sa1}, u0 = {vv.x, vv.x}, u1 = {vv.y, vv.y}; \
    _Pragma("unroll") for (int e = 0; e < 4; ++e) { S0[e] = S0[e] * W[e] + a0 * BB[e] + u0 * KV[e]; S1[e] = S1[e] * W[e] + a1 * BB[e] + u1 * KV[e]; } \
    f32x2 q0 = S0[0] * RR[0] + S0[1] * RR[1] + S0[2] * RR[2] + S0[3] * RR[3]; \
    f32x2 q1 = S1[0] * RR[0] + S1[1] * RR[1] + S1[2] * RR[2] + S1[3] * RR[3]; \
    float y0 = q0.x + q0.y, y1 = q1.x + q1.y; \
    y0 += dpp_f<0xB1>(y0); y1 += dpp_f<0xB1>(y1); y0 += dpp_f<0x4E>(y0); y1 += dpp_f<0x4E>(y1); y0 += dpp_f<0x141>(y0); y1 += dpp_f<0x141>(y1); \
    const bool mine = (kl == ((s_) & 7)); \
    if ((s_) < 8) { ya.x = mine ? y0 : ya.x; ya.y = mine ? y1 : ya.y; } else { yb.x = mine ? y0 : yb.x; yb.y = mine ? y1 : yb.y; } } while (0)
  for (int ch = 0; ch < nch; ++ch) {
    const int cur = ch & 1;
    if (ch + 1 < nch) SCAN_GLOAD(ch + 1);
    const float* b = st + cur * 6144;
    const float* vsrc = st + voff + cur * vbuf;
    f32x2 ya = {0.f, 0.f}, yb = {0.f, 0.f};
#pragma unroll 2
    for (int s = 0; s < 8; ++s) SCAN_STEP(s);
#pragma unroll 2
    for (int s = 8; s < 16; ++s) SCAN_STEP(s);
    *(f32x2*)(yout + (size_t)(ch * 16 + kl) * PROJF) = ya;
    *(f32x2*)(yout + (size_t)(ch * 16 + 8 + kl) * PROJF) = yb;
    if (ch + 1 < nch) SCAN_LSTORE(cur ^ 1);
    __syncthreads();
  }
#pragma unroll
  for (int j = 0; j < 2; ++j) {
    float* zp = ZP + ((size_t)((seg * 4 + head) * 128 + R0 + j)) * 64 + kl * 8;
    if (j == 0) { *(float4*)(zp) = make_float4(S0[0].x, S0[0].y, S0[1].x, S0[1].y); *(float4*)(zp + 4) = make_float4(S0[2].x, S0[2].y, S0[3].x, S0[3].y); }
    else { *(float4*)(zp) = make_float4(S1[0].x, S1[0].y, S1[1].x, S1[1].y); *(float4*)(zp + 4) = make_float4(S1[2].x, S1[2].y, S1[3].x, S1[3].y); }
  }
}

__device__ void rwkv_combine(const Params& p, unsigned char* dsm_) {
  float* ring = (float*)dsm_;
  float* ZP = (float*)(p.ws + OFF_ZP);
  const int tid = opaque_tid512(); const int lane = tid & 63;
  const int rowi = blockIdx.x * 8 + (tid >> 6);
  const int head = rowi >> 6, v = rowi & 63;
  float4 pa0, pa1, pa2, pa3, pb0, pb1, pb2, pb3;
  float z0, z1, z2, z3;
#define COMB_ONE(stg_, q, PA, PB, Z) do { const float* base = ZP + (size_t)((((stg_) * 4 + q) * 4 + head) * 128) * 64; \
      PA = ((const float4*)(base + 4096))[tid]; PB = ((const float4*)(base + 4096))[tid + 512]; Z = base[v * 64 + lane]; } while (0)
#define COMB_ISSUE(stg_) do { COMB_ONE(stg_, 0, pa0, pb0, z0); COMB_ONE(stg_, 1, pa1, pb1, z1); COMB_ONE(stg_, 2, pa2, pb2, z2); COMB_ONE(stg_, 3, pa3, pb3, z3); } while (0)
#define COMB_SEG(q, ZC) do { const int seg = stg * 4 + q; \
      ZP[((size_t)((seg * 4 + head) * 128 + v)) * 64 + lane] = s; \
      float ns0 = ZC, ns1 = 0.f; const float* P = buf + q * 4096 + lane; \
      _Pragma("unroll") for (int i = 0; i < 64; i += 2) { \
        float s0 = __builtin_bit_cast(float, __builtin_amdgcn_readlane(__builtin_bit_cast(int, s), i)); \
        float s1 = __builtin_bit_cast(float, __builtin_amdgcn_readlane(__builtin_bit_cast(int, s), i + 1)); \
        ns0 += s0 * P[i * 64]; ns1 += s1 * P[(i + 1) * 64]; } \
      s = ns0 + ns1; } while (0)
  COMB_ISSUE(0);
  float s = 0.f;
#pragma unroll 1
  for (int stg = 0; stg < NSEG / 4; ++stg) {
    float* buf = ring + (stg & 1) * 16384;
    ((float4*)(buf))[tid] = pa0; ((float4*)(buf))[tid + 512] = pb0;
    ((float4*)(buf + 4096))[tid] = pa1; ((float4*)(buf + 4096))[tid + 512] = pb1;
    ((float4*)(buf + 8192))[tid] = pa2; ((float4*)(buf + 8192))[tid + 512] = pb2;
    ((float4*)(buf + 12288))[tid] = pa3; ((float4*)(buf + 12288))[tid + 512] = pb3;
    const float c0 = z0, c1 = z1, c2 = z2, c3 = z3;
    __syncthreads();
    if (stg + 1 < NSEG / 4) COMB_ISSUE(stg + 1);
    COMB_SEG(0, c0); COMB_SEG(1, c1); COMB_SEG(2, c2); COMB_SEG(3, c3);
  }
  __syncthreads();
}

__device__ __forceinline__ bf16x8 pack8(const float4 a, const float4 b) {
  uint4 u = make_uint4(pack2(a.x, a.y), pack2(a.z, a.w), pack2(b.x, b.y), pack2(b.z, b.w));
  return __builtin_bit_cast(bf16x8, u);
}
__device__ void rwkv_final_item(const Params& p, int l, int item, unsigned char* smem) {
  l = opq(l); item = opq(item);
  const int tid = opaque_tid(), w = tid >> 6, lane = tid & 63, l31 = lane & 31, hf = lane >> 5;
  const int parts = SL / 128;
  const int q = item % parts, head = (item / parts) & 3, seg = item / (parts * 4);
  const int t = seg * SL + q * 128 + w * 32 + l31;
  const float* ZP = (const float*)(p.ws + OFF_ZP);
  const float* PF = (const float*)(p.ws + OFF_PROJ);
  const u16* PROJ = (const u16*)(p.ws + OFF_PROJ);
  const u16* RBv = (const u16*)(p.ws + OFF_RWB) + (size_t)2 * T_ * 256;
  const float* BON = (const float*)(p.ws + OFF_BONUS);
  u16* MIX = (u16*)(p.ws + OFF_MIX);
  f32x16 acc0, acc1;
#pragma unroll
  for (int r = 0; r < 16; ++r) { acc0[r] = 0.f; acc1[r] = 0.f; }
  {
    const float* sp = ZP + ((size_t)((seg * 4 + head) * 128 + l31)) * 64 + 8 * hf;
    const float* rp = PF + (size_t)t * PROJF + 256 + head * 64 + 8 * hf;
#pragma unroll
    for (int ks = 0; ks < 4; ++ks) {
      const bf16x8 bfrag = pack8(*(const float4*)(rp + 16 * ks), *(const float4*)(rp + 16 * ks + 4));
      const bf16x8 a0 = pack8(*(const float4*)(sp + 16 * ks), *(const float4*)(sp + 16 * ks + 4));
      const bf16x8 a1 = pack8(*(const float4*)(sp + 32 * 64 + 16 * ks), *(const float4*)(sp + 32 * 64 + 16 * ks + 4));
      acc0 = __builtin_amdgcn_mfma_f32_32x32x16_bf16(a0, bfrag, acc0, 0, 0, 0);
      acc1 = __builtin_amdgcn_mfma_f32_32x32x16_bf16(a1, bfrag, acc1, 0, 0, 0);
    }
  }
  const float* y0p = PF + (size_t)t * PROJF + head * 64 + 4 * hf;
  float sum = 0.f;
#pragma unroll
  for (int g = 0; g < 4; ++g) {
    const float4 ya = *(const float4*)(y0p + 8 * g), yb = *(const float4*)(y0p + 32 + 8 * g);
    acc0[4 * g + 0] += ya.x; acc0[4 * g + 1] += ya.y; acc0[4 * g + 2] += ya.z; acc0[4 * g + 3] += ya.w;
    acc1[4 * g + 0] += yb.x; acc1[4 * g + 1] += yb.y; acc1[4 * g + 2] += yb.z; acc1[4 * g + 3] += yb.w;
  }
#pragma unroll
  for (int r = 0; r < 16; ++r) sum += acc0[r] + acc1[r];
  sum += __shfl_xor(sum, 32);
  const float mean = sum * (1.f / 64.f);
  float var = 0.f;
#pragma unroll
  for (int r = 0; r < 16; ++r) { const float d0 = acc0[r] - mean, d1 = acc1[r] - mean; var += d0 * d0 + d1 * d1; }
  var += __shfl_xor(var, 32);
  const float rstd = rsqrtf(var * (1.f / 64.f) + 64e-5f);
  const float bon = BON[t * 4 + head];
  const int cb = head * 64 + 4 * hf;
#pragma unroll
  for (int mt = 0; mt < 2; ++mt)
#pragma unroll
    for (int g = 0; g < 4; ++g) {
      const int c = cb + mt * 32 + 8 * g;
      const float4 lw = *(const float4*)(p.ln_w + l * 256 + c), lb = *(const float4*)(p.ln_b + l * 256 + c);
      const uint2 vv = *(const uint2*)(RBv + (size_t)t * 256 + c);
      const uint2 gg = *(const uint2*)(PROJ + (size_t)t * NALL + 2048 + c);
      float o0 = (mt ? acc1[4 * g + 0] : acc0[4 * g + 0]), o1 = (mt ? acc1[4 * g + 1] : acc0[4 * g + 1]);
      float o2 = (mt ? acc1[4 * g + 2] : acc0[4 * g + 2]), o3 = (mt ? acc1[4 * g + 3] : acc0[4 * g + 3]);
      o0 = (o0 - mean) * rstd * lw.x + lb.x + bon * bflo(vv.x);
      o1 = (o1 - mean) * rstd * lw.y + lb.y + bon * bfhi(vv.x);
      o2 = (o2 - mean) * rstd * lw.z + lb.z + bon * bflo(vv.y);
      o3 = (o3 - mean) * rstd * lw.w + lb.w + bon * bfhi(vv.y);
      o0 *= silu(bflo(gg.x)); o1 *= silu(bfhi(gg.x)); o2 *= silu(bflo(gg.y)); o3 *= silu(bfhi(gg.y));
      *(uint2*)(MIX + (size_t)t * 1024 + 512 + c) = make_uint2(pack2(o0, o1), pack2(o2, o3));
    }
}

#define LDS_BYTES (131072 + 16)
#ifndef REP_G1
#define REP_G1 1
#endif
#ifndef REP_G2
#define REP_G2 1
#endif
#ifndef REP_P3
#define REP_P3 1
#endif
#ifndef REP_SCAN
#define REP_SCAN 1
#endif
#ifndef REP_GO
#define REP_GO 1
#endif
#ifndef REP_FIN
#define REP_FIN 1
#endif
#define PAIR_LOOP(N, BODY) for (int _pr = blockIdx.x; _pr < (N) / 2; _pr += gridDim.x) { const int it = 2 * _pr + vb; BODY }
__global__ void __launch_bounds__(512) fwd_megakernel(Params p) {
  cg::grid_group grid = cg::this_grid();
  extern __shared__ __attribute__((aligned(16))) unsigned char dsm[];
  const int vb = __builtin_amdgcn_readfirstlane(threadIdx.x >> 8);
  unsigned char* smem = dsm + vb * 65536;
  if (threadIdx.x == 0) *(uint4*)(dsm + 131072) = make_uint4(0u, 0u, 0u, 0u);
  __syncthreads();
  const XcdBarrier xb = xcd_barrier_post((unsigned*)(p.ws + OFF_BAR), (volatile LAS unsigned*)(dsm + 131072));
#define GSYNC() xcd_barrier(xb)
#ifndef PH
#define PH 0xffff
#endif
  if (PH & 1) PAIR_LOOP(384, phase_mod_item(p, it, smem);)
  if (PH & 2) PAIR_LOOP(4480, phase_wconv_item(p, it, smem);)
  if (PH & 2) PAIR_LOOP(8, phase_w2t_item(p, it);)
  grid.sync();
  if (PH & 4) phase_h0(p);
  GSYNC();
#pragma unroll 1
  for (int hl = 0; hl < 8; ++hl) {
    const int l = hl >> 1;
    const bool second = hl & 1;
    if (PH & 8) {
      pg8::Gemm g; g.M = T_; g.K = 1024;
      pg8::EpiU E; E.O = (void*)(p.ws + OFF_PROJ);
      if (!second) { g.A = (const u16*)(p.ws + OFF_H); g.Bt = (const u16*)(p.ws + OFF_WALL) + (size_t)l * NALL * 1024; g.N = 3584; E.ldc = NALL; E.ncols = NALL; E.f32out = 0; }
      else { g.A = (const u16*)(p.ws + OFF_MIX); g.Bt = (const u16*)(p.ws + OFF_WOUT) + (size_t)l * 1024 * 1024; g.N = 1024; E.ldc = 1024; E.ncols = 1024; E.f32out = 0; }
      pg8::StaticOrder S; S.init(T_, g.N, gridDim.x, blockIdx.x);
      const int nrep = second ? REP_G2 : REP_G1;
#pragma unroll 1
      for (int rep = 0; rep < nrep; ++rep)
      pg8::gemm_phase<pg8::EpiU, pg8::StaticOrder, false>((PG8_LAS unsigned char*)dsm, g, S, E, nullptr);
    }
    GSYNC();
    if (!second) {
#pragma unroll 1
      for (int rep = 0; rep < REP_P3; ++rep)
      PAIR_LOOP(3072,
        if (it < 1024) { if (PH & 16) attn_item(p, l, it, smem); }
        else if (it < 2048) { if (PH & 32) rwkv_prep_item(p, l, it - 1024, smem); }
        else { if (PH & 64) gla_local_item(p, l, it - 2048, smem); }
      )
      GSYNC();
      if (PH & 128) for (int eb = blockIdx.x; eb < 256; eb += gridDim.x) gla_state_block(p, eb, dsm);
#pragma unroll 1
      for (int rep = 0; rep < REP_SCAN; ++rep)
      if (PH & 256) for (int it = blockIdx.x; it < NSEG * 4; it += gridDim.x) rwkv_scan_item(p, it, dsm);
      GSYNC();
      if (blockIdx.x < 32) { if (PH & 512) rwkv_combine(p, dsm); }
#pragma unroll 1
      for (int rep = 0; rep < REP_GO; ++rep)
      if (PH & 1024) { if (blockIdx.x >= 32) for (int _pr = blockIdx.x - 32; _pr < 512; _pr += gridDim.x - 32) { const int it = 2 * _pr + vb; gla_out_item(p, l, it, smem); } }
      GSYNC();
#pragma unroll 1
      for (int rep = 0; rep < REP_FIN; ++rep)
      if (PH & 2048) PAIR_LOOP(NSEG * 4 * (SL / 128), rwkv_final_item(p, l, it, smem);)
      GSYNC();
    } else {
      if (PH & 8192) phase_post(p, l);
      if (hl < 7) GSYNC();
    }
  }
}

extern "C" void kernel_launch(void* const* d_in, const int* in_sizes, int n_in, void* d_out, int out_size, void* d_ws, size_t ws_size,
                              hipStream_t stream) {
  static int grid_blocks = 0;
  if (!grid_blocks) {
    int dev = 0, cus = 0, per_cu = 0;
    (void)hipGetDevice(&dev);
    (void)hipDeviceGetAttribute(&cus, hipDeviceAttributeMultiprocessorCount, dev);
    (void)hipFuncSetAttribute((const void*)fwd_megakernel, hipFuncAttributeMaxDynamicSharedMemorySize, LDS_BYTES);
    (void)hipOccupancyMaxActiveBlocksPerMultiprocessor(&per_cu, fwd_megakernel, 512, LDS_BYTES);
    if (per_cu < 1) per_cu = 1;
    grid_blocks = cus;
    if (grid_blocks < 32) grid_blocks = 32;
  }
  if (n_in != 27 || ws_size < WS_END) {
    fprintf(stderr, "kernel_launch: unexpected n_in %d / ws %zu\n", n_in, ws_size);
    return;
  }
  Params p{};
  const float** pp = (const float**)&p;
  for (int i = 0; i < 27; ++i) pp[i] = (const float*)d_in[i];
  p.out = (float*)d_out;
  p.ws = (unsigned char*)d_ws;
  (void)hipMemsetAsync((unsigned char*)d_ws + OFF_BAR, 0, XCD_BAR_WORDS * 4, stream);
  void* args[] = {&p};
  hipError_t e = hipLaunchCooperativeKernel((void*)fwd_megakernel, dim3(grid_blocks), dim3(512), args, LDS_BYTES, stream);
  if (e != hipSuccess) fprintf(stderr, "cooperative launch failed: %s (grid %d)\n", hipGetErrorString(e), grid_blocks);
}
```

```cpp
#include <hip/hip_runtime.h>
#include <hip/hip_bf16.h>
#include <hip/hip_cooperative_groups.h>
#include <cstdio>
namespace cg = cooperative_groups;

typedef unsigned short u16;
using bf16x8 = __attribute__((ext_vector_type(8))) short;
using f32x4 = __attribute__((ext_vector_type(4))) float;
using f32x16 = __attribute__((ext_vector_type(16))) float;

#define T_ 16384
#define NALL 3456
#define NSEG 64
#define SL (T_ / NSEG)
#define PROJF 1728

#define OFF_WALL 0ull
#define OFF_WOUT 28311552ull
#define OFF_MOD 36700160ull
#define OFF_H 36749312ull
#define OFF_RWW OFF_H
#define OFF_RWKK (OFF_H + 16777216ull)
#define OFF_PROJ 70303744ull
#define OFF_MIX 183549952ull
#define OFF_RWB 217104384ull
#define OFF_GLAS 250658816ull
#define OFF_GLAD 259047424ull
#define OFF_BONUS 259178496ull
#define OFF_ZP 259440640ull
#define OFF_BAR 267829248ull
#define OFF_W2T 267845632ull
#define OFF_A2T 267976704ull
#define WS_END 268107776ull


struct Params {
  const float *x, *c, *ada_w, *ada_b, *norm_pre, *norm_post, *w_in, *w_out, *sinks, *mu_rkv, *mu_w, *mu_a, *w0, *w1, *w2,
      *a0, *a1, *a2, *k_k, *k_a, *r_k, *ln_w, *ln_b, *gk1, *gk2, *gk_b, *gla_nw;
  float* out;
  unsigned char* ws;
};

__device__ __forceinline__ u16 f2bf(float f) {
  unsigned u = __float_as_uint(f);
  u += 0x7fffu + ((u >> 16) & 1u);
  return (u16)(u >> 16);
}
__device__ __forceinline__ float bf2f(u16 h) { return __uint_as_float(((unsigned)h) << 16); }
__device__ __forceinline__ unsigned pack2(float a, float b) { return (unsigned)f2bf(a) | ((unsigned)f2bf(b) << 16); }
__device__ __forceinline__ float bflo(unsigned u) { return __uint_as_float(u << 16); }
__device__ __forceinline__ float bfhi(unsigned u) { return __uint_as_float(u & 0xffff0000u); }
__device__ __forceinline__ float wave_sum(float v) {
#pragma unroll
  for (int o = 32; o > 0; o >>= 1) v += __shfl_xor(v, o);
  return v;
}
__device__ __forceinline__ float silu(float x) { return x / (1.f + __expf(-x)); }
__device__ __forceinline__ float sigmoidf_(float x) { return 1.f / (1.f + __expf(-x)); }
__device__ __forceinline__ float softplusf_(float z) { return fmaxf(z, 0.f) + log1pf(__expf(-fabsf(z))); }

__device__ __forceinline__ int opq(int x) { asm volatile("" : "+s"(x)); return x; }
__device__ __forceinline__ int opaque_tid() { int t = threadIdx.x & 255; asm volatile("" : "+v"(t)); return t; }
__device__ __forceinline__ int opaque_tid512() { int t = threadIdx.x; asm volatile("" : "+v"(t)); return t; }
template <int CTRL>
__device__ __forceinline__ float dpp_f(float x) {
  return __builtin_bit_cast(float, __builtin_amdgcn_update_dpp(0, __builtin_bit_cast(int, x), CTRL, 0xf, 0xf, true));
}
__device__ __forceinline__ float row16_allsum(float x) {
  x += dpp_f<0x128>(x);
  x += dpp_f<0x124>(x);
  x += dpp_f<0x122>(x);
  x += dpp_f<0x121>(x);
  return x;
}

namespace pg8 {
#define PG8_LAS __attribute__((address_space(3)))
typedef unsigned short bf16_t;
typedef short bf16x8 __attribute__((ext_vector_type(8)));
typedef float f32x4 __attribute__((ext_vector_type(4)));
typedef unsigned u32x4 __attribute__((ext_vector_type(4)));
constexpr int BM = 256, BK = 64, HALF = 128, HTB = HALF * BK * 2  , STAGE_BYTES = 8 * HTB, NXCD = 8, WGM = 8;

__host__ __device__ __forceinline__ int lds_byte(int r, int c) { const int st = (r >> 4) * 2 + (c >> 5), rr = r & 15, cc = c & 31, ob = rr * 64 + cc * 2; return st * 1024 + (ob ^ (((ob >> 9) & 1) << 5)); }
__host__ __device__ __forceinline__ void stage_rc(int b, int& R, int& C) { const int st = b / 1024, sb = b % 1024, swz = sb ^ (((sb >> 9) & 1) << 5); R = (st >> 1) * 16 + swz / 64; C = (st & 1) * 32 + (swz % 64) / 2; }
__host__ __device__ __forceinline__ int perm32(int rho) { const int n = rho >> 4, i = rho & 15; return 8 * (i >> 2) + 4 * n + (i & 3); }

struct Unit { int pm, pn; };
struct Gemm { const bf16_t* A; const bf16_t* Bt; int M, N, K; };

struct StaticOrder {
    int nM, nN, nwg, G, c;
    __host__ __device__ void init(int M, int N, int G_, int c_) { nM = M / BM; nN = N / BM; nwg = nM * nN; G = G_; c = c_; }
    __host__ __device__ bool next(int i, Unit& u) const {
        const long L = (long)i * G + c; if (L >= nwg) return false;
        int wgid = (int)L; { const int q = nwg / NXCD, r = nwg % NXCD, xcd = wgid % NXCD, off = wgid / NXCD; wgid = (xcd < r ? xcd * (q + 1) : r * (q + 1) + (xcd - r) * q) + off; }
        const int nig = WGM * nN, gid = wgid / nig, fm = gid * WGM, gsz = (nM - fm) < WGM ? (nM - fm) : WGM;
        u.pm = fm + ((wgid % nig) % gsz); u.pn = (wgid % nig) / gsz; return true;
    }
    __device__ __forceinline__ void a_ready(const Unit&) const {}
    __device__ __forceinline__ void done(const Unit&) const {}
};
__device__ __forceinline__ unsigned cvt_pk_bf16(float lo, float hi) { unsigned r; asm volatile("v_cvt_pk_bf16_f32 %0, %1, %2" : "=v"(r) : "v"(lo), "v"(hi)); return r; }
template <class Epi, class Sched, bool STAMP = false>
__device__ __forceinline__ void gemm_phase(PG8_LAS unsigned char* lds, const Gemm g, const Sched& S, const Epi& E, unsigned long long* stamps) {
    const int tid = threadIdx.x, wid = __builtin_amdgcn_readfirstlane(tid >> 6), lane = tid & 63, wr = wid >> 2, wc = wid & 3, fr = lane & 15, fq = lane >> 4;
    const int K = g.K, nt = K / BK;
    int ts_lo = 0, ts_hi = 0, nts = 0; const unsigned long long rt_entry = STAMP ? (unsigned long long)wall_clock64() : 0ull;
#define PG8_STAMP() do { if (STAMP && wid == 0 && nts < 64) { const unsigned long long _c = (unsigned long long)clock64(); \
        ts_lo = (lane == nts) ? (int)(unsigned)_c : ts_lo; ts_hi = (lane == nts) ? (int)(unsigned)(_c >> 32) : ts_hi; ++nts; } } while (0)
    PG8_STAMP();
    unsigned voffA[2], voffB[2];
#pragma unroll
    for (int i = 0; i < 2; ++i) { int R, C; stage_rc(tid * 16 + i * 8192, R, C); const int Rb = Epi::PERM ? ((R & ~31) + perm32(R & 31)) : R;
        voffA[i] = (unsigned)(R * K + C) * 2u; voffB[i] = (unsigned)(Rb * K + C) * 2u; }
    const size_t kstep = (size_t)(BK * 2);
    const size_t hstep = (size_t)HALF * K * 2;
    const size_t tstep = 2 * hstep;
    const unsigned ldsw = (unsigned)wid * 1024u;
    const int aoff = lds_byte(wr * 64 + fr, fq * 8), boff = lds_byte(wc * 32 + fr, fq * 8);
#define PG8_SA(b, h) (((b) * 2 + (h)) * HTB)
#define PG8_SB(b, h) ((4 + (b) * 2 + (h)) * HTB)
#define PG8_STAGE(bufoff, gbase, voff) do { _Pragma("unroll") for (int _i = 0; _i < 2; ++_i) \
        __builtin_amdgcn_global_load_lds((const unsigned*)((const char*)(gbase) + (voff)[_i]), (PG8_LAS unsigned*)(lds + (bufoff) + ldsw + _i * 8192), 16, 0, 0); } while (0)
#define PG8_LDA(dst, b, h) do { _Pragma("unroll") for (int m = 0; m < 4; ++m) _Pragma("unroll") for (int k = 0; k < 2; ++k) dst[m][k] = *(const PG8_LAS bf16x8*)(lds + PG8_SA(b, h) + aoff + m * 2048 + k * 1024); } while (0)
#define PG8_LDB(dst, b, h) do { _Pragma("unroll") for (int n = 0; n < 2; ++n) _Pragma("unroll") for (int k = 0; k < 2; ++k) dst[n][k] = *(const PG8_LAS bf16x8*)(lds + PG8_SB(b, h) + boff + n * 2048 + k * 1024); } while (0)
#define PG8_MMA(ai, bj, At, Bt) do { __builtin_amdgcn_s_setprio(1); _Pragma("unroll") for (int m = 0; m < 4; ++m) _Pragma("unroll") for (int n = 0; n < 2; ++n) _Pragma("unroll") for (int k = 0; k < 2; ++k) \
        acc[ai][bj][m][n] = __builtin_amdgcn_mfma_f32_16x16x32_bf16(Bt[n][k], At[m][k], acc[ai][bj][m][n], 0, 0, 0); __builtin_amdgcn_s_setprio(0); } while (0)
#define PG8_WAIT_V(n) asm volatile("s_waitcnt vmcnt(" #n ")" ::: "memory")
#define PG8_WAIT_L(n) asm volatile("s_waitcnt lgkmcnt(" #n ")" ::: "memory")
#define PG8_BAR __builtin_amdgcn_s_barrier()
#define PG8_SCHED __builtin_amdgcn_sched_barrier(0)
    Unit cur, nxt; int ui = 0;
    if (!S.next(0, cur)) return;
    f32x4 acc[2][2][4][2];
#pragma unroll
    for (int a = 0; a < 2; ++a)
#pragma unroll
        for (int b = 0; b < 2; ++b)
#pragma unroll
            for (int m = 0; m < 4; ++m)
#pragma unroll
                for (int n = 0; n < 2; ++n) acc[a][b][m][n] = (f32x4){0.f, 0.f, 0.f, 0.f};
    bf16x8 At[4][2], B0[2][2], B1[2][2];
    const char* cA = (const char*)g.A + (size_t)cur.pm * tstep; const char* cB = (const char*)g.Bt + (size_t)cur.pn * tstep;
    S.a_ready(cur);
    PG8_STAGE(PG8_SB(0, 0), cB, voffB); PG8_STAGE(PG8_SA(0, 0), cA, voffA); PG8_STAGE(PG8_SB(0, 1), cB + hstep, voffB); PG8_STAGE(PG8_SA(0, 1), cA + hstep, voffA);
    if (wr == 1) PG8_BAR;
    PG8_WAIT_V(4); PG8_BAR;
    PG8_STAGE(PG8_SB(1, 0), cB + kstep, voffB); PG8_STAGE(PG8_SA(1, 0), cA + kstep, voffA); PG8_STAGE(PG8_SB(1, 1), cB + hstep + kstep, voffB);
    PG8_WAIT_V(6); PG8_BAR;
    PG8_STAMP();
    for (;;) {
        const bool has_next = S.next(ui + 1, nxt);
        const char* nA = has_next ? (const char*)g.A + (size_t)nxt.pm * tstep : cA; const char* nB = has_next ? (const char*)g.Bt + (size_t)nxt.pn * tstep : cB;
        for (int t = 0; t < nt; t += 2) {
            const bool last = (t == nt - 2);
            const char* a1 = cA + (size_t)(t + 1) * kstep;
            const char* a2 = last ? nA : cA + (size_t)(t + 2) * kstep; const char* b2 = last ? nB : cB + (size_t)(t + 2) * kstep;
            const char* a3 = a2 + kstep; const char* b3 = b2 + kstep;
            if (last && has_next) S.a_ready(nxt);
            PG8_LDB(B0, 0, 0); PG8_SCHED; PG8_LDA(At, 0, 0); PG8_STAGE(PG8_SA(1, 1), a1 + hstep, voffA);
            PG8_WAIT_L(8); PG8_BAR; PG8_WAIT_L(0); PG8_MMA(0, 0, At, B0); PG8_BAR; PG8_SCHED;
            PG8_LDB(B1, 0, 1); PG8_STAGE(PG8_SB(0, 0), b2, voffB);
            PG8_BAR; PG8_WAIT_L(0); PG8_MMA(0, 1, At, B1); PG8_BAR;
            PG8_LDA(At, 0, 1); PG8_STAGE(PG8_SA(0, 0), a2, voffA);
            PG8_BAR; PG8_WAIT_L(0); PG8_MMA(1, 0, At, B0); PG8_BAR; PG8_SCHED;
            PG8_STAGE(PG8_SB(0, 1), b2 + hstep, voffB);
            PG8_WAIT_V(6); PG8_BAR; PG8_MMA(1, 1, At, B1); PG8_BAR;
            PG8_LDB(B0, 1, 0); PG8_SCHED; PG8_LDA(At, 1, 0); PG8_STAGE(PG8_SA(0, 1), a2 + hstep, voffA);
            PG8_WAIT_L(8); PG8_BAR; PG8_WAIT_L(0); PG8_MMA(0, 0, At, B0); PG8_BAR; PG8_SCHED;
            PG8_LDB(B1, 1, 1); PG8_STAGE(PG8_SB(1, 0), b3, voffB);
            PG8_BAR; PG8_WAIT_L(0); PG8_MMA(0, 1, At, B1); PG8_BAR;
            PG8_LDA(At, 1, 1); PG8_STAGE(PG8_SA(1, 0), a3, voffA);
            PG8_BAR; PG8_WAIT_L(0); PG8_MMA(1, 0, At, B0); PG8_BAR; PG8_SCHED;
            PG8_STAGE(PG8_SB(1, 1), b3 + hstep, voffB);
            PG8_WAIT_V(6); PG8_BAR; PG8_MMA(1, 1, At, B1); PG8_BAR;
        }
        PG8_STAMP();
        if constexpr (!Epi::AFTER_DRAIN) { E(acc, cur, wr, wc, fr, fq); S.done(cur); }
        PG8_STAMP();
        if (!has_next) break;
#pragma unroll
        for (int a = 0; a < 2; ++a)
#pragma unroll
            for (int b = 0; b < 2; ++b)
#pragma unroll
                for (int m = 0; m < 4; ++m)
#pragma unroll
                    for (int n = 0; n < 2; ++n) acc[a][b][m][n] = (f32x4){0.f, 0.f, 0.f, 0.f};
        cur = nxt; cA = nA; cB = nB; ++ui;
    }
    PG8_WAIT_V(0);
    if (wr == 0) PG8_BAR;
    PG8_BAR;
    if constexpr (Epi::AFTER_DRAIN) { E.fused(acc, cur, wr, wc, fr, fq, lds, wid, lane); S.done(cur); }
    PG8_STAMP();
    if (STAMP && wid == 0) { stamps[lane] = lane < nts ? (((unsigned long long)(unsigned)ts_hi << 32) | (unsigned)ts_lo) : 0ull;
        if (lane == 62) stamps[62] = rt_entry; if (lane == 63) stamps[63] = (unsigned long long)wall_clock64(); }
#undef PG8_STAMP
#undef PG8_SA
#undef PG8_SB
#undef PG8_STAGE
#undef PG8_LDA
#undef PG8_LDB
#undef PG8_MMA
#undef PG8_WAIT_V
#undef PG8_WAIT_L
#undef PG8_BAR
#undef PG8_SCHED
}
}

namespace pg8 {
struct EpiProj {
    static constexpr bool PERM = true, AFTER_DRAIN = false;
    bf16_t* O; int ldc; int ncols;
    __device__ __forceinline__ void operator()(const f32x4 (&acc)[2][2][4][2], const Unit& u, int wr, int wc, int fr, int fq) const {
        const int row0 = u.pm * BM + wr * 64 + fr; const int col0 = u.pn * BM + wc * 32 + 8 * fq;
#pragma unroll
        for (int ai = 0; ai < 2; ++ai)
#pragma unroll
            for (int m = 0; m < 4; ++m) { bf16_t* rowp = O + (size_t)(row0 + ai * HALF + m * 16) * ldc + col0;
#pragma unroll
                for (int bj = 0; bj < 2; ++bj) { const f32x4 v0 = acc[ai][bj][m][0], v1 = acc[ai][bj][m][1];
                    u32x4 w; w.x = cvt_pk_bf16(v0[0], v0[1]); w.y = cvt_pk_bf16(v0[2], v0[3]); w.z = cvt_pk_bf16(v1[0], v1[1]); w.w = cvt_pk_bf16(v1[2], v1[3]);
                    if (col0 + bj * HALF < ncols) *(u32x4*)(rowp + bj * HALF) = w; } }
    }
};
struct EpiU {
    static constexpr bool PERM = true, AFTER_DRAIN = false;
    void* O; int ldc; int ncols; int f32out;
    __device__ __forceinline__ void operator()(const f32x4 (&acc)[2][2][4][2], const Unit& u, int wr, int wc, int fr, int fq) const {
        const int row0 = u.pm * BM + wr * 64 + fr; const int col0 = u.pn * BM + wc * 32 + 8 * fq;
        if (f32out) {
#pragma unroll
            for (int ai = 0; ai < 2; ++ai)
#pragma unroll
                for (int m = 0; m < 4; ++m) { float* rowp = (float*)O + (size_t)(row0 + ai * HALF + m * 16) * ldc + col0;
#pragma unroll
                    for (int bj = 0; bj < 2; ++bj) { *(f32x4*)(rowp + bj * HALF) = acc[ai][bj][m][0]; *(f32x4*)(rowp + bj * HALF + 4) = acc[ai][bj][m][1]; } }
        } else {
#pragma unroll
            for (int ai = 0; ai < 2; ++ai)
#pragma unroll
                for (int m = 0; m < 4; ++m) { bf16_t* rowp = (bf16_t*)O + (size_t)(row0 + ai * HALF + m * 16) * ldc + col0;
#pragma unroll
                    for (int bj = 0; bj < 2; ++bj) { const f32x4 v0 = acc[ai][bj][m][0], v1 = acc[ai][bj][m][1];
                        u32x4 w; w.x = cvt_pk_bf16(v0[0], v0[1]); w.y = cvt_pk_bf16(v0[2], v0[3]); w.z = cvt_pk_bf16(v1[0], v1[1]); w.w = cvt_pk_bf16(v1[2], v1[3]);
                        if (col0 + bj * HALF < ncols) *(u32x4*)(rowp + bj * HALF) = w; } }
        }
    }
};
}

#define XB_TMO      128
#define XB_XCNT(j)  (256  + 64 * (j))
#define XB_XSUB(j)  (1280 + 64 * (j))
#define XB_XGEN(j)  (2304 + 64 * (j))
#define XB_TOP      3328
#define XB_TOPGEN   3392
#define XCD_BAR_WORDS 3456
#define XB_SPIN_CAP (1u << 18)
#define LAS __attribute__((address_space(3)))

__device__ __forceinline__ unsigned xb_ld(unsigned* p)              { return __hip_atomic_load(p, __ATOMIC_RELAXED, __HIP_MEMORY_SCOPE_AGENT); }
__device__ __forceinline__ unsigned xb_add(unsigned* p, unsigned v) { return __hip_atomic_fetch_add(p, v, __ATOMIC_RELAXED, __HIP_MEMORY_SCOPE_AGENT); }
__device__ __forceinline__ unsigned xb_xcc_id() { return (unsigned)__builtin_amdgcn_s_getreg((3 << 11) | 20) & 0xFu; }
#define XB_SPIN(cond, bar) do { unsigned _sp = 0; while (cond) { __builtin_amdgcn_s_sleep(1); \
    if ((++_sp & 255u) == 0u) { if (xb_ld(&(bar)[XB_TMO])) break; if (_sp > XB_SPIN_CAP) { atomicAdd(&(bar)[XB_TMO], 1u); break; } } } } while (0)

struct XcdBarrier {
    unsigned* bar; unsigned x;
    volatile LAS unsigned* st;
};

__device__ __forceinline__ XcdBarrier xcd_barrier_post(unsigned* bar, volatile LAS unsigned* st) {
    XcdBarrier b; b.bar = bar; b.x = xb_xcc_id(); b.st = st;
    if (threadIdx.x == 0) (void)xb_add(&bar[XB_XCNT(b.x)], 1u);
    return b;
}
__device__ __forceinline__ void xcd_barrier_complete(unsigned* bar, unsigned x, unsigned& nloc, unsigned& nx) {
    const unsigned G = gridDim.x * gridDim.y * gridDim.z;
    unsigned sum, cnt, mine, sp = 0u;
    for (;;) {
        sum = 0u; cnt = 0u; mine = 0u;
#pragma unroll
        for (unsigned j = 0; j < 16; ++j) { const unsigned c = xb_ld(&bar[XB_XCNT(j)]); sum += c; cnt += (c > 0u) ? 1u : 0u; mine = (j == x) ? c : mine; }
        if (sum == G) break;
        __builtin_amdgcn_s_sleep(1);
        if ((++sp & 255u) == 0u) { if (xb_ld(&bar[XB_TMO])) break; if (sp > XB_SPIN_CAP) { atomicAdd(&bar[XB_TMO], 1u); break; } }
    }
    nloc = mine > 0u ? mine : 1u; nx = cnt > 0u ? cnt : 1u;
}

__device__ __forceinline__ void xcd_barrier(const XcdBarrier& b) {
    asm volatile("s_waitcnt vmcnt(0)" ::: "memory");
    __syncthreads();
    if (threadIdx.x == 0) {
        unsigned* bar = b.bar;
        __builtin_amdgcn_s_waitcnt(0);
        unsigned nloc = b.st[0], nx = b.st[1];
        if (nloc == 0u) { xcd_barrier_complete(bar, b.x, nloc, nx); b.st[0] = nloc; b.st[1] = nx; }
        const unsigned old = xb_add(&bar[XB_XSUB(b.x)], 1u);
        const unsigned gen = old / nloc;
        if (old + 1u == (gen + 1u) * nloc) {
            __builtin_amdgcn_fence(__ATOMIC_RELEASE, "agent");
            asm volatile("s_waitcnt vmcnt(0)" ::: "memory");
            const unsigned og = xb_add(&bar[XB_TOP], 1u);
            const unsigned tg = og / nx;
            if (og + 1u == (tg + 1u) * nx) xb_add(&bar[XB_TOPGEN], 1u);
            else XB_SPIN(xb_ld(&bar[XB_TOPGEN]) == tg, bar);
            __builtin_amdgcn_fence(__ATOMIC_ACQUIRE, "agent");
            xb_add(&bar[XB_XGEN(b.x)], 1u);
            asm volatile("s_waitcnt vmcnt(0)" ::: "memory");
        } else {
            XB_SPIN(xb_ld(&bar[XB_XGEN(b.x)]) == gen, bar);
            __builtin_amdgcn_fence(__ATOMIC_ACQUIRE, "agent");
            asm volatile("s_waitcnt vmcnt(0)" ::: "memory");
        }
    }
    __syncthreads();
}

__device__ void phase_mod_item(const Params& p, int it, unsigned char* smem) {
  float* red = (float*)smem;
  const int tid = opaque_tid(), tx = tid & 31, ty = tid >> 5;
  float* mod = (float*)(p.ws + OFF_MOD);
  it = opq(it);
  {
    int l = it / 96;
    int j = (it % 96) * 32 + tx;
    const float* W = p.ada_w + (size_t)l * 1024 * 3072;
    float* cs = red + 256;
#pragma unroll
    for (int i = 0; i < 4; ++i) cs[tid + 256 * i] = silu(p.c[tid + 256 * i]);
    __syncthreads();
    float acc = 0.f;
#pragma unroll 1
    for (int i0 = 0; i0 < 128; i0 += 16) {
      float wv[16];
#pragma unroll
      for (int i = 0; i < 16; ++i) wv[i] = W[(size_t)(ty * 128 + i0 + i) * 3072 + j];
#pragma unroll
      for (int i = 0; i < 16; ++i) acc += cs[ty * 128 + i0 + i] * wv[i];
    }
    red[ty * 32 + tx] = acc;
    __syncthreads();
    if (ty == 0) {
      float s = 0.f;
      for (int g = 0; g < 8; ++g) s += red[g * 32 + tx];
      mod[l * 3072 + j] = s + p.ada_b[l * 3072 + j];
    }
    __syncthreads();
  }
}

__device__ __forceinline__ float wall_src(const Params& p, int l, int k, int n) {
  size_t lk = (size_t)l * 1024 + k;
  if (n < 3072) return p.w_in[lk * 3072 + n];
  if (n < 3136) return (1.f - p.mu_w[lk]) * p.w1[lk * 64 + (n - 3072)];
  if (n < 3200) return p.mu_w[lk] * p.w1[lk * 64 + (n - 3136)];
  if (n < 3264) return (1.f - p.mu_a[lk]) * p.a1[lk * 64 + (n - 3200)];
  if (n < 3328) return p.mu_a[lk] * p.a1[lk * 64 + (n - 3264)];
  if (n < 3344) return p.gk1[lk * 16 + (n - 3328)];
  return 0.f;
}

__device__ void phase_wconv_item(const Params& p, int it, unsigned char* smem) {
  float* tile = (float*)smem;
  const int tid = opaque_tid();
  u16* WALL = (u16*)(p.ws + OFF_WALL);
  u16* WOUT = (u16*)(p.ws + OFF_WOUT);
  it = opq(it);
  {
    bool isout = it >= 3456;
    int l, nt, kt;
    if (!isout) { l = it / 864; int r = it % 864; nt = r >> 4; kt = r & 15; }
    else { int r = it - 3456; l = r >> 8; r &= 255; nt = r >> 4; kt = r & 15; }
    int tx = tid & 63, ty = tid >> 6;
#pragma unroll
    for (int i = 0; i < 16; ++i) {
      int kl = ty + 4 * i;
      int k = kt * 64 + kl, n = nt * 64 + tx;
      float v = isout ? p.w_out[((size_t)l * 1024 + k) * 1024 + n] : wall_src(p, l, k, n);
      tile[kl * 65 + tx] = v;
    }
    __syncthreads();
    int nl = tid >> 2, kq = tid & 3;
    unsigned w[8];
#pragma unroll
    for (int j = 0; j < 8; ++j) w[j] = pack2(tile[(kq * 16 + 2 * j) * 65 + nl], tile[(kq * 16 + 2 * j + 1) * 65 + nl]);
    u16* dst = (isout ? WOUT + ((size_t)l * 1024 + nt * 64 + nl) * 1024 : WALL + ((size_t)l * NALL + nt * 64 + nl) * 1024) + kt * 64 + kq * 16;
    ((uint4*)dst)[0] = make_uint4(w[0], w[1], w[2], w[3]);
    ((uint4*)dst)[1] = make_uint4(w[4], w[5], w[6], w[7]);
    __syncthreads();
  }
}

__device__ void phase_w2t_item(const Params& p, int it) {
  it = opq(it);
  const int c = opaque_tid();
  const int l = it >> 1, which = it & 1;
  const float* src = (which ? p.a2 : p.w2) + (size_t)l * 64 * 256 + c;
  u16* dst = (u16*)(p.ws + (which ? OFF_A2T : OFF_W2T)) + ((size_t)l * 256 + c) * 64;
#pragma unroll
  for (int j8 = 0; j8 < 8; ++j8) {
    float f[8];
#pragma unroll
    for (int q = 0; q < 8; ++q) f[q] = src[(j8 * 8 + q) * 256];
    *(uint4*)(dst + j8 * 8) = make_uint4(pack2(f[0], f[1]), pack2(f[2], f[3]), pack2(f[4], f[5]), pack2(f[6], f[7]));
  }
}

__device__ __forceinline__ void write_h(const Params& p, int l, int row, int lane, const float4* v, float ss) {
  const float* mod = (const float*)(p.ws + OFF_MOD) + l * 3072;
  u16* H = (u16*)(p.ws + OFF_H);
  float rs = rsqrtf(ss * (1.f / 1024.f) + 1e-6f);
#pragma unroll
  for (int i = 0; i < 4; ++i) {
    int col = (lane + 64 * i) * 4;
    float4 g = *(const float4*)(p.norm_pre + l * 1024 + col);
    float4 sh = *(const float4*)(mod + col);
    float4 sc = *(const float4*)(mod + 1024 + col);
    float h0 = v[i].x * rs * g.x * (1.f + sc.x) + sh.x;
    float h1 = v[i].y * rs * g.y * (1.f + sc.y) + sh.y;
    float h2 = v[i].z * rs * g.z * (1.f + sc.z) + sh.z;
    float h3 = v[i].w * rs * g.w * (1.f + sc.w) + sh.w;
    *(uint2*)(H + (size_t)row * 1024 + col) = make_uint2(pack2(h0, h1), pack2(h2, h3));
  }
}

__device__ void phase_h0(const Params& p) {
  const int tid = opaque_tid512(); const int wave = tid >> 6, lane = tid & 63;
  for (int row = blockIdx.x * 8 + wave; row < T_; row += gridDim.x * 8) {
    const float4* xr = (const float4*)(p.x + (size_t)row * 1024);
    float4 v[4];
    float ss = 0.f;
#pragma unroll
    for (int i = 0; i < 4; ++i) {
      v[i] = xr[lane + 64 * i];
      ss += v[i].x * v[i].x + v[i].y * v[i].y + v[i].z * v[i].z + v[i].w * v[i].w;
    }
    ss = wave_sum(ss);
    write_h(p, 0, row, lane, v, ss);
  }
}

__device__ void phase_post(const Params& p, int l) {
  l = opq(l);
  const int tid = opaque_tid512(); const int wave = tid >> 6, lane = tid & 63;
  const u16* Y = (const u16*)(p.ws + OFF_PROJ);
  const float* mod = (const float*)(p.ws + OFF_MOD) + l * 3072;
  const float* xold = (l == 0) ? p.x : p.out;
  for (int row = blockIdx.x * 8 + wave; row < T_; row += gridDim.x * 8) {
    const uint2* yr = (const uint2*)(Y + (size_t)row * 1024);
    const float4* xr = (const float4*)(xold + (size_t)row * 1024);
    float4 y[4], v[4];
    float ss = 0.f;
#pragma unroll
    for (int i = 0; i < 4; ++i) {
      const uint2 u = yr[lane + 64 * i];
      y[i] = make_float4(bflo(u.x), bfhi(u.x), bflo(u.y), bfhi(u.y));
      v[i] = xr[lane + 64 * i];
      ss += y[i].x * y[i].x + y[i].y * y[i].y + y[i].z * y[i].z + y[i].w * y[i].w;
    }
    ss = wave_sum(ss);
    float rs = rsqrtf(ss * (1.f / 1024.f) + 1e-6f);
    float s2 = 0.f;
#pragma unroll
    for (int i = 0; i < 4; ++i) {
      int col = (lane + 64 * i) * 4;
      float4 g = *(const float4*)(p.norm_post + l * 1024 + col);
      float4 gt = *(const float4*)(mod + 2048 + col);
      v[i].x += gt.x * (y[i].x * rs * g.x);
      v[i].y += gt.y * (y[i].y * rs * g.y);
      v[i].z += gt.z * (y[i].z * rs * g.z);
      v[i].w += gt.w * (y[i].w * rs * g.w);
      *(float4*)(p.out + (size_t)row * 1024 + col) = v[i];
      s2 += v[i].x * v[i].x + v[i].y * v[i].y + v[i].z * v[i].z + v[i].w * v[i].w;
    }
    if (l < 3) {
      s2 = wave_sum(s2);
      write_h(p, l + 1, row, lane, v, s2);
    }
  }
}

__device__ void attn_item(const Params& p, int l, int item, unsigned char* smem) {
  l = opq(l); item = opq(item);
  u16* Vt = (u16*)smem;
  const u16* PROJ = (const u16*)(p.ws + OFF_PROJ);
  u16* MIX = (u16*)(p.ws + OFF_MIX);
  const int tid = opaque_tid(), w = tid >> 6, lane = tid & 63, l31 = lane & 31, hf = lane >> 5;
  const int qb = item >> 3, head = item & 7, kvh = head >> 2;
  const int kpos0 = (qb - 1) * 128;
  {
    int kp = kpos0 + tid;
    if (kp < 0) kp = 0;
    const uint4* src = (const uint4*)(PROJ + (size_t)kp * NALL + 640 + kvh * 64);
#pragma unroll
    for (int c8 = 0; c8 < 8; ++c8) {
      uint4 v = src[c8];
      int d = c8 * 8;
      Vt[(d + 0) * 264 + tid] = (u16)(v.x & 0xffff);
      Vt[(d + 1) * 264 + tid] = (u16)(v.x >> 16);
      Vt[(d + 2) * 264 + tid] = (u16)(v.y & 0xffff);
      Vt[(d + 3) * 264 + tid] = (u16)(v.y >> 16);
      Vt[(d + 4) * 264 + tid] = (u16)(v.z & 0xffff);
      Vt[(d + 5) * 264 + tid] = (u16)(v.z >> 16);
      Vt[(d + 6) * 264 + tid] = (u16)(v.w & 0xffff);
      Vt[(d + 7) * 264 + tid] = (u16)(v.w >> 16);
    }
  }
  const int tq = qb * 128 + 32 * w + l31;
  bf16x8 qf[4], kc[4];
  {
    const u16* qp = PROJ + (size_t)tq * NALL + head * 64 + 8 * hf;
#pragma unroll
    for (int s = 0; s < 4; ++s) qf[s] = *(const bf16x8*)(qp + 16 * s);
    int kp = kpos0 + 32 * w + l31;
    if (kp < 0) kp = 0;
    const u16* kptr = PROJ + (size_t)kp * NALL + 512 + kvh * 64 + 8 * hf;
#pragma unroll
    for (int s = 0; s < 4; ++s) kc[s] = *(const bf16x8*)(kptr + 16 * s);
  }
  __syncthreads();
  const float slope = exp2f(-(float)(head + 1));
  const float sink = p.sinks[l * 8 + head];
  const int rq = 32 * w + l31;
  float mrun = -1e30f, lsum = 0.f;
  f32x16 o0, o1;
#pragma unroll
  for (int r = 0; r < 16; ++r) { o0[r] = 0.f; o1[r] = 0.f; }
#pragma unroll 1
  for (int i = 0; i < 5; ++i) {
    bf16x8 kn[4];
    {
      const int in_ = (i < 4) ? i + 1 : 4;
      int kp = kpos0 + 32 * w + 32 * in_ + l31;
      if (kp < 0) kp = 0;
      const u16* kptr = PROJ + (size_t)kp * NALL + 512 + kvh * 64 + 8 * hf;
#pragma unroll
      for (int s = 0; s < 4; ++s) kn[s] = *(const bf16x8*)(kptr + 16 * s);
    }
    f32x16 a;
#pragma unroll
    for (int r = 0; r < 16; ++r) a[r] = 0.f;
#pragma unroll
    for (int s = 0; s < 4; ++s) a = __builtin_amdgcn_mfma_f32_32x32x16_bf16(kc[s], qf[s], a, 0, 0, 0);
#pragma unroll
    for (int s = 0; s < 4; ++s) kc[s] = kn[s];
    float tmax = -1e30f;
#pragma unroll
    for (int r = 0; r < 16; ++r) {
      int kj = 32 * w + 32 * i + (r & 3) + 8 * (r >> 2) + 4 * hf;
      int dist = 128 + rq - kj;
      bool valid = (dist >= 0) && (dist < 128) && (kpos0 + kj >= 0);
      float sv = a[r] * 0.125f - slope * (float)dist;
      sv = valid ? sv : -1e30f;
      a[r] = sv;
      tmax = fmaxf(tmax, sv);
    }
    tmax = fmaxf(tmax, __shfl_xor(tmax, 32));
    const float mnew = fmaxf(mrun, tmax);
    const float alpha = __expf(mrun - mnew);
    float psum = 0.f;
#pragma unroll
    for (int r = 0; r < 16; ++r) {
      float e = (a[r] > -1e29f) ? __expf(a[r] - mnew) : 0.f;
      a[r] = e;
      psum += e;
    }
    lsum = lsum * alpha + psum;
    mrun = mnew;
#pragma unroll
    for (int r = 0; r < 16; ++r) { o0[r] *= alpha; o1[r] *= alpha; }
#pragma unroll
    for (int u = 0; u < 2; ++u) {
      bf16x8 pf;
#pragma unroll
      for (int j = 0; j < 8; ++j) pf[j] = (short)f2bf(a[8 * u + j]);
      const int kb = 32 * w + 32 * i + 16 * u + 4 * hf;
      const u16* v0 = Vt + l31 * 264 + kb;
      const u16* v1 = Vt + (32 + l31) * 264 + kb;
      uint2 a0 = *(const uint2*)(v0), a1 = *(const uint2*)(v0 + 8);
      uint2 b0 = *(const uint2*)(v1), b1 = *(const uint2*)(v1 + 8);
      uint4 A0 = make_uint4(a0.x, a0.y, a1.x, a1.y), A1 = make_uint4(b0.x, b0.y, b1.x, b1.y);
      o0 = __builtin_amdgcn_mfma_f32_32x32x16_bf16(__builtin_bit_cast(bf16x8, A0), pf, o0, 0, 0, 0);
      o1 = __builtin_amdgcn_mfma_f32_32x32x16_bf16(__builtin_bit_cast(bf16x8, A1), pf, o1, 0, 0, 0);
    }
  }
  {
    const float mf = fmaxf(mrun, sink);
    const float scl = __expf(mrun - mf);
    const float ltot = (lsum + __shfl_xor(lsum, 32)) * scl + __expf(sink - mf);
    const float fin = scl / ltot;
#pragma unroll
    for (int r = 0; r < 16; ++r) { o0[r] *= fin; o1[r] *= fin; }
  }
  const u16* gp = PROJ + (size_t)tq * NALL + 768 + head * 64;
  u16* op = MIX + (size_t)tq * 1024 + head * 64;
#pragma unroll
  for (int g = 0; g < 4; ++g) {
    int d0 = 8 * g + 4 * hf;
    uint2 gg = *(const uint2*)(gp + d0);
    float r0 = o0[4 * g + 0] * silu(bflo(gg.x)), r1 = o0[4 * g + 1] * silu(bfhi(gg.x));
    float r2 = o0[4 * g + 2] * silu(bflo(gg.y)), r3 = o0[4 * g + 3] * silu(bfhi(gg.y));
    *(uint2*)(op + d0) = make_uint2(pack2(r0, r1), pack2(r2, r3));
    uint2 g2 = *(const uint2*)(gp + 32 + d0);
    r0 = o1[4 * g + 0] * silu(bflo(g2.x)); r1 = o1[4 * g + 1] * silu(bfhi(g2.x));
    r2 = o1[4 * g + 2] * silu(bflo(g2.y)); r3 = o1[4 * g + 3] * silu(bfhi(g2.y));
    *(uint2*)(op + 32 + d0) = make_uint2(pack2(r0, r1), pack2(r2, r3));
  }
  __syncthreads();
}

__device__ void rwkv_prep_item(const Params& p, int l, int item, unsigned char* smem) {
  l = opq(l); item = opq(item);
  u16* lwb = (u16*)smem;
  u16* lab = lwb + 16 * 72;
  const u16* PROJ = (const u16*)(p.ws + OFF_PROJ);
  const int tid = opaque_tid(), head = tid >> 6, lane = tid & 63, fr = lane & 15, fq = lane >> 4;
  const int t0 = item * 16;
#pragma unroll
  for (int i = 0; i < 8; ++i) {
    int idx = tid + 256 * i;
    int which = idx >> 10, tt = (idx >> 6) & 15, j = idx & 63;
    int t = t0 + tt;
    const u16* pr = PROJ + (size_t)t * NALL;
    float cur = bf2f(pr[(which ? 3200 : 3072) + j]);
    float prev = (t > 0) ? bf2f((pr - NALL)[(which ? 3264 : 3136) + j]) : 0.f;
    float sv = cur + prev;
    if (!which) sv = tanhf(sv);
    (which ? lab : lwb)[tt * 72 + j] = f2bf(sv);
  }
  __syncthreads();
  f32x4 accw[4], acca[4];
#pragma unroll
  for (int nt = 0; nt < 4; ++nt) { accw[nt] = (f32x4){0.f, 0.f, 0.f, 0.f}; acca[nt] = (f32x4){0.f, 0.f, 0.f, 0.f}; }
  {
    const u16* W2T = (const u16*)(p.ws + OFF_W2T) + ((size_t)l * 256 + head * 64 + fr) * 64 + fq * 8;
    const u16* A2T = (const u16*)(p.ws + OFF_A2T) + ((size_t)l * 256 + head * 64 + fr) * 64 + fq * 8;
#pragma unroll
    for (int ks = 0; ks < 2; ++ks) {
      const bf16x8 aw = *(const bf16x8*)(lwb + fr * 72 + ks * 32 + fq * 8);
      const bf16x8 aa = *(const bf16x8*)(lab + fr * 72 + ks * 32 + fq * 8);
#pragma unroll
      for (int nt = 0; nt < 4; ++nt) {
        const bf16x8 bw = *(const bf16x8*)(W2T + nt * 16 * 64 + ks * 32);
        const bf16x8 ba = *(const bf16x8*)(A2T + nt * 16 * 64 + ks * 32);
        accw[nt] = __builtin_amdgcn_mfma_f32_16x16x32_bf16(aw, bw, accw[nt], 0, 0, 0);
        acca[nt] = __builtin_amdgcn_mfma_f32_16x16x32_bf16(aa, ba, acca[nt], 0, 0, 0);
      }
    }
  }
  float mur[4], muk[4], muv[4], w0[4], a0[4], kkw[4], kaw[4], rkw[4];
#pragma unroll
  for (int nt = 0; nt < 4; ++nt) {
    const int c = head * 64 + nt * 16 + fr;
    mur[nt] = p.mu_rkv[l * 768 + c]; muk[nt] = p.mu_rkv[l * 768 + 256 + c]; muv[nt] = p.mu_rkv[l * 768 + 512 + c];
    w0[nt] = p.w0[l * 256 + c]; a0[nt] = p.a0[l * 256 + c]; kkw[nt] = p.k_k[l * 256 + c]; kaw[nt] = p.k_a[l * 256 + c]; rkw[nt] = p.r_k[l * 256 + c];
  }
  float* RWW = (float*)(p.ws + OFF_RWW);
  float* RWKK = (float*)(p.ws + OFF_RWKK);
  u16* RB = (u16*)(p.ws + OFF_RWB);
  float* BON = (float*)(p.ws + OFF_BONUS);
#pragma unroll
  for (int rg = 0; rg < 4; ++rg) {
    const int t = t0 + fq * 4 + rg;
    const u16* pr = PROJ + (size_t)t * NALL;
    float kkc[4], av[4];
    float n2 = 0.f, bonus = 0.f;
#pragma unroll
    for (int nt = 0; nt < 4; ++nt) {
      const int c = head * 64 + nt * 16 + fr;
      float rc = bf2f(pr[1280 + c]), kc = bf2f(pr[1536 + c]), vc = bf2f(pr[1792 + c]);
      float rp = 0.f, kp = 0.f, vp = 0.f;
      if (t > 0) { rp = bf2f((pr - NALL)[1280 + c]); kp = bf2f((pr - NALL)[1536 + c]); vp = bf2f((pr - NALL)[1792 + c]); }
      const float r = rc + (rp - rc) * mur[nt], k = kc + (kp - kc) * muk[nt], v = vc + (vp - vc) * muv[nt];
      const float wpre = w0[nt] + accw[nt][rg];
      const float wl = -softplusf_(-wpre) - 0.5f;
      const float decay = __expf(-__expf(wl));
      const float a = sigmoidf_(a0[nt] + acca[nt][rg]);
      const float kc2 = k * kkw[nt];
      const float kmod = k * (1.f + (a - 1.f) * kaw[nt]);
      kkc[nt] = kc2; av[nt] = a;
      n2 += kc2 * kc2;
      bonus += r * kmod * rkw[nt];
      const size_t o = (size_t)t * 256 + c;
      RWW[o] = decay;
      RB[o] = f2bf(r);
      RB[(size_t)T_ * 256 + o] = f2bf(kmod);
      RB[(size_t)2 * T_ * 256 + o] = f2bf(v);
    }
    n2 = row16_allsum(n2);
    bonus = row16_allsum(bonus);
    const float inv = 1.f / fmaxf(sqrtf(n2), 1e-12f);
#pragma unroll
    for (int nt = 0; nt < 4; ++nt) {
      const int c = head * 64 + nt * 16 + fr;
      const size_t o = (size_t)t * 256 + c;
      const float kk = kkc[nt] * inv;
      RWKK[o] = kk;
      RB[(size_t)3 * T_ * 256 + o] = f2bf(kk * av[nt]);
    }
    if (fr == 0) BON[t * 4 + head] = bonus;
  }
  __syncthreads();
}

__device__ __forceinline__ void gla_b(const Params& p, int l, int chunk, int head, float* tot, float* bl) {
  const u16* PROJ = (const u16*)(p.ws + OFF_PROJ);
  const int tid = opaque_tid(), d = tid & 31, ig = tid >> 5;
  float g2[16];
#pragma unroll
  for (int m = 0; m < 16; ++m) g2[m] = p.gk2[(size_t)l * 16 * 128 + m * 128 + head * 32 + d];
  const float bias = p.gk_b[l * 128 + head * 32 + d];
  float run = 0.f;
#pragma unroll
  for (int ii = 0; ii < 8; ++ii) {
    int t = chunk * 64 + ig * 8 + ii;
    const uint4* lp = (const uint4*)(PROJ + (size_t)t * NALL + 3328);
    uint4 u0 = lp[0], u1 = lp[1];
    float z = bias;
    z += bflo(u0.x) * g2[0] + bfhi(u0.x) * g2[1] + bflo(u0.y) * g2[2] + bfhi(u0.y) * g2[3];
    z += bflo(u0.z) * g2[4] + bfhi(u0.z) * g2[5] + bflo(u0.w) * g2[6] + bfhi(u0.w) * g2[7];
    z += bflo(u1.x) * g2[8] + bfhi(u1.x) * g2[9] + bflo(u1.y) * g2[10] + bfhi(u1.y) * g2[11];
    z += bflo(u1.z) * g2[12] + bfhi(u1.z) * g2[13] + bflo(u1.w) * g2[14] + bfhi(u1.w) * g2[15];
    float g = (fminf(z, 0.f) - log1pf(__expf(-fabsf(z)))) * (1.f / 16.f);
    run += g;
    bl[ii] = run;
  }
  tot[ig * 32 + d] = run;
  __syncthreads();
  float off = 0.f;
#pragma unroll
  for (int g = 0; g < 8; ++g) off += (g < ig) ? tot[g * 32 + d] : 0.f;
#pragma unroll
  for (int ii = 0; ii < 8; ++ii) bl[ii] += off;
}

__device__ void gla_local_item(const Params& p, int l, int item, unsigned char* smem) {
  l = opq(l); item = opq(item);
  float* tot = (float*)smem;
  float* Kp = tot + 256;
  float* Vs = Kp + 2048;
  const u16* PROJ = (const u16*)(p.ws + OFF_PROJ);
  const int tid = opaque_tid(), d = tid & 31, ig = tid >> 5;
  const int chunk = item >> 2, head = item & 3;
  float bl[8];
  gla_b(p, l, chunk, head, tot, bl);
  float blast = 0.f;
#pragma unroll
  for (int g = 0; g < 8; ++g) blast += tot[g * 32 + d];
#pragma unroll
  for (int ii = 0; ii < 8; ++ii) {
    int i = ig * 8 + ii;
    int t = chunk * 64 + i;
    float k = bf2f(PROJ[(size_t)t * NALL + 2432 + head * 32 + d]);
    Kp[i * 32 + d] = k * __expf(blast - bl[ii]);
  }
#pragma unroll
  for (int r = 0; r < 16; ++r) {
    int idx = tid + 256 * r;
    int i = idx >> 6, v = idx & 63;
    Vs[idx] = bf2f(PROJ[(size_t)(chunk * 64 + i) * NALL + 2560 + head * 64 + v]);
  }
  __syncthreads();
  const int v = tid & 63, dg = tid >> 6;
  float acc[8];
#pragma unroll
  for (int q = 0; q < 8; ++q) acc[q] = 0.f;
  for (int i = 0; i < 64; ++i) {
    float vv = Vs[i * 64 + v];
    float4 k0 = *(const float4*)(Kp + i * 32 + dg * 8), k1 = *(const float4*)(Kp + i * 32 + dg * 8 + 4);
    acc[0] += k0.x * vv; acc[1] += k0.y * vv; acc[2] += k0.z * vv; acc[3] += k0.w * vv;
    acc[4] += k1.x * vv; acc[5] += k1.y * vv; acc[6] += k1.z * vv; acc[7] += k1.w * vv;
  }
  float* GS = (float*)(p.ws + OFF_GLAS);
  float* GD = (float*)(p.ws + OFF_GLAD);
#pragma unroll
  for (int q = 0; q < 8; ++q) GS[((size_t)(chunk * 4 + head) * 32 + dg * 8 + q) * 64 + v] = acc[q];
  if (tid < 32) GD[(chunk * 4 + head) * 32 + tid] = __expf(blast);
  __syncthreads();
}

__device__ void gla_state_block(const Params& p, int eb, unsigned char* dsm_) {
  float* comp = (float*)dsm_;
  float* GS = (float*)(p.ws + OFF_GLAS);
  const float* GD = (const float*)(p.ws + OFF_GLAD);
  eb = opq(eb);
  const int tid = opaque_tid512();
  const int ei = tid & 31, g = tid >> 5;
  const int e = eb * 32 + ei;
  const int head = e >> 11, d = (e >> 6) & 31, v = e & 63;
  float ds[16], dc[16];
#pragma unroll
  for (int i = 0; i < 16; ++i) {
    const int c = g * 16 + i;
    ds[i] = GS[((size_t)(c * 4 + head) * 32 + d) * 64 + v];
    dc[i] = GD[(c * 4 + head) * 32 + d];
  }
  float S = 0.f, P = 1.f;
#pragma unroll
  for (int i = 0; i < 16; ++i) { S = dc[i] * S + ds[i]; P *= dc[i]; }
  comp[(g * 32 + ei) * 2] = P;
  comp[(g * 32 + ei) * 2 + 1] = S;
  __syncthreads();
  float G = 0.f;
  for (int gg = 0; gg < g; ++gg) G = comp[(gg * 32 + ei) * 2] * G + comp[(gg * 32 + ei) * 2 + 1];
#pragma unroll
  for (int i = 0; i < 16; ++i) {
    const int c = g * 16 + i;
    GS[((size_t)(c * 4 + head) * 32 + d) * 64 + v] = G;
    G = dc[i] * G + ds[i];
  }
  __syncthreads();
}

__device__ void gla_out_item(const Params& p, int l, int item, unsigned char* smem) {
  l = opq(l); item = opq(item);
  float* tot = (float*)smem;
  float* qt = tot + 256;
  float* kt = qt + 2304;
  float* Vs = kt + 2304;
  float* Am = Vs + 4096;
  float* Ss = Am + 4352;
  const u16* PROJ = (const u16*)(p.ws + OFF_PROJ);
  u16* MIX = (u16*)(p.ws + OFF_MIX);
  const float* GS = (const float*)(p.ws + OFF_GLAS);
  const int tid = opaque_tid();
  const int chunk = item >> 2, head = item & 3;
  {
    const int d = tid & 31, ig = tid >> 5;
    float bl[8];
    gla_b(p, l, chunk, head, tot, bl);
#pragma unroll
    for (int ii = 0; ii < 8; ++ii) {
      int i = ig * 8 + ii;
      int t = chunk * 64 + i;
      float q = bf2f(PROJ[(size_t)t * NALL + 2304 + head * 32 + d]);
      float k = bf2f(PROJ[(size_t)t * NALL + 2432 + head * 32 + d]);
      qt[i * 36 + d] = q * 0.17677669529663687f * __expf(bl[ii]);
      kt[i * 36 + d] = k * __expf(-bl[ii]);
    }
  }
#pragma unroll
  for (int r = 0; r < 16; ++r) {
    int idx = tid + 256 * r;
    int i = idx >> 6, v = idx & 63;
    Vs[idx] = bf2f(PROJ[(size_t)(chunk * 64 + i) * NALL + 2560 + head * 64 + v]);
  }
#pragma unroll
  for (int r = 0; r < 8; ++r) {
    int idx = tid + 256 * r;
    Ss[idx] = GS[(size_t)(chunk * 4 + head) * 2048 + idx];
  }
  __syncthreads();
  const int j = tid & 63, ig = tid >> 6;
  {
    float acc[16];
#pragma unroll
    for (int ii = 0; ii < 16; ++ii) acc[ii] = 0.f;
#pragma unroll 2
    for (int d4 = 0; d4 < 8; ++d4) {
      const float4 kv = *(const float4*)(kt + j * 36 + d4 * 4);
#pragma unroll
      for (int ii = 0; ii < 16; ++ii) {
        const float4 qv = *(const float4*)(qt + (ig * 16 + ii) * 36 + d4 * 4);
        acc[ii] += qv.x * kv.x + qv.y * kv.y + qv.z * kv.z + qv.w * kv.w;
      }
    }
#pragma unroll
    for (int ii = 0; ii < 16; ++ii) {
      int i = ig * 16 + ii;
      Am[i * 68 + j] = (j <= i) ? acc[ii] : 0.f;
    }
  }
  __syncthreads();
  {
    const int v = j;
    float acc[16];
#pragma unroll
    for (int ii = 0; ii < 16; ++ii) acc[ii] = 0.f;
    const int jmax = (ig + 1) * 4;
    for (int j4 = 0; j4 < jmax; ++j4) {
      const float v0 = Vs[(j4 * 4 + 0) * 64 + v], v1 = Vs[(j4 * 4 + 1) * 64 + v], v2 = Vs[(j4 * 4 + 2) * 64 + v], v3 = Vs[(j4 * 4 + 3) * 64 + v];
#pragma unroll
      for (int ii = 0; ii < 16; ++ii) {
        const float4 av = *(const float4*)(Am + (ig * 16 + ii) * 68 + j4 * 4);
        acc[ii] += av.x * v0 + av.y * v1 + av.z * v2 + av.w * v3;
      }
    }
#pragma unroll 2
    for (int d4 = 0; d4 < 8; ++d4) {
      const float s0 = Ss[(d4 * 4 + 0) * 64 + v], s1 = Ss[(d4 * 4 + 1) * 64 + v], s2 = Ss[(d4 * 4 + 2) * 64 + v], s3 = Ss[(d4 * 4 + 3) * 64 + v];
#pragma unroll
      for (int ii = 0; ii < 16; ++ii) {
        const float4 qv = *(const float4*)(qt + (ig * 16 + ii) * 36 + d4 * 4);
        acc[ii] += qv.x * s0 + qv.y * s1 + qv.z * s2 + qv.w * s3;
      }
    }
    const float nw = p.gla_nw[l * 64 + v];
#pragma unroll
    for (int ii = 0; ii < 16; ++ii) {
      int t = chunk * 64 + ig * 16 + ii;
      float o = acc[ii];
      float ms = wave_sum(o * o) * (1.f / 64.f);
      float gg = bf2f(PROJ[(size_t)t * NALL + 2816 + head * 64 + v]);
      float r = o * rsqrtf(ms + 1e-5f) * nw * silu(gg);
      MIX[(size_t)t * 1024 + 768 + head * 64 + v] = f2bf(r);
    }
  }
  __syncthreads();
}

typedef float f32x2 __attribute__((ext_vector_type(2)));
__device__ __forceinline__ float oct_allsum(float x) {
  x += dpp_f<0xB1>(x);
  x += dpp_f<0x4E>(x);
  x += dpp_f<0x141>(x);
  return x;
}
__device__ void rwkv_scan_item(const Params& p, int item, unsigned char* dsm_) {
  item = opq(item);
  float* st = (float*)dsm_;
  const int tid = opaque_tid512(), wv = tid >> 6, lane = tid & 63, rs = lane >> 3, kl = lane & 7;
  const int head = item & 3, seg = item >> 2;
  const bool ident = wv >= 4;
  const int R0 = wv * 16 + rs * 2;
  const int v0 = R0 & 63;
  const float* RWW = (const float*)(p.ws + OFF_RWW);
  const float* RWKK = (const float*)(p.ws + OFF_RWKK);
  const u16* RB = (const u16*)(p.ws + OFF_RWB);
  float* PF = (float*)(p.ws + OFF_PROJ);
  float* ZP = (float*)(p.ws + OFF_ZP);
  const int tbase = seg * SL;
  const int half = tid >> 8, ls = (tid & 255) >> 4, lc4 = (tid & 15) * 4;
  f32x2 S0[4], S1[4];
#pragma unroll
  for (int e = 0; e < 4; ++e) { S0[e] = (f32x2){0.f, 0.f}; S1[e] = (f32x2){0.f, 0.f}; }
  if (ident) {
#pragma unroll
    for (int e = 0; e < 4; ++e) {
      const int k0 = kl * 8 + 2 * e;
      S0[e] = (f32x2){(v0 == k0) ? 1.f : 0.f, (v0 == k0 + 1) ? 1.f : 0.f};
      S1[e] = (f32x2){(v0 + 1 == k0) ? 1.f : 0.f, (v0 + 1 == k0 + 1) ? 1.f : 0.f};
    }
  }
  float4 g0 = make_float4(0.f, 0.f, 0.f, 0.f);
  uint2 h0 = make_uint2(0u, 0u), h1 = h0, h2 = h0;
  const float* gp0 = (half == 0 ? RWW : RWKK) + (size_t)(tbase + ls) * 256 + head * 64 + lc4;
  const u16* hp = RB + (size_t)(tbase + ls) * 256 + head * 64 + lc4;
#define SCAN_GLOAD(ch) do { const size_t _o = (size_t)(ch) * 16 * 256; g0 = *(const float4*)(gp0 + _o); \
    if (half == 0) { h0 = *(const uint2*)(hp + _o); } \
    else { h0 = *(const uint2*)(hp + (size_t)T_ * 256 + _o); h1 = *(const uint2*)(hp + (size_t)3 * T_ * 256 + _o); h2 = *(const uint2*)(hp + (size_t)2 * T_ * 256 + _o); } } while (0)
#define SCAN_LSTORE(buf) do { float* _b = st + (buf) * 6144 + ls * 64 + lc4; \
    if (half == 0) { *(float4*)(_b) = g0; *(float4*)(_b + 2048) = make_float4(bflo(h0.x), bfhi(h0.x), bflo(h0.y), bfhi(h0.y)); } \
    else { *(float4*)(_b + 1024) = g0; *(float4*)(_b + 3072) = make_float4(bflo(h0.x), bfhi(h0.x), bflo(h0.y), bfhi(h0.y)); \
           *(float4*)(_b + 4096) = make_float4(bflo(h1.x), bfhi(h1.x), bflo(h1.y), bfhi(h1.y)); *(float4*)(_b + 5120) = make_float4(bflo(h2.x), bfhi(h2.x), bflo(h2.y), bfhi(h2.y)); } } while (0)
  if (tid < 16) st[2 * 6144 + tid] = 0.f;
  SCAN_GLOAD(0);
  SCAN_LSTORE(0);
  __syncthreads();
  const int nch = SL / 16;
  float* yout = PF + (size_t)tbase * PROJF + (ident ? 256 : 0) + head * 64 + v0;
  const int voff = ident ? (2 * 6144) : (5120 + v0);
  const int vstep = ident ? 0 : 64, vbuf = ident ? 0 : 6144;
#define V2(a, i) ((f32x2){(i) ? a.z : a.x, (i) ? a.w : a.y})
#define SCAN_STEP(s_) do { \
    const float* bp = b + (s_) * 64 + kl * 8; \
    const float4 wl = *(const float4*)(bp), wh = *(const float4*)(bp + 4); \
    const float4 kkl = *(const float4*)(bp + 1024), kkh = *(const float4*)(bp + 1028); \
    const float4 rl4 = *(const float4*)(bp + 2048), rh4 = *(const float4*)(bp + 2052); \
    const float4 kl4 = *(const float4*)(bp + 3072), kh4 = *(const float4*)(bp + 3076); \
    const float4 bl4 = *(const float4*)(bp + 4096), bh4 = *(const float4*)(bp + 4100); \
    const f32x2 vv = *(const f32x2*)(vsrc + (s_) * vstep); \
    const f32x2 W[4] = {V2(wl, 0), V2(wl, 1), V2(wh, 0), V2(wh, 1)}, KK[4] = {V2(kkl, 0), V2(kkl, 1), V2(kkh, 0), V2(kkh, 1)}; \
    const f32x2 RR[4] = {V2(rl4, 0), V2(rl4, 1), V2(rh4, 0), V2(rh4, 1)}, KV[4] = {V2(kl4, 0), V2(kl4, 1), V2(kh4, 0), V2(kh4, 1)}; \
    const f32x2 BB[4] = {V2(bl4, 0), V2(bl4, 1), V2(bh4, 0), V2(bh4, 1)}; \
    f32x2 t0 = S0[0] * KK[0] + S0[1] * KK[1] + S0[2] * KK[2] + S0[3] * KK[3]; \
    f32x2 t1 = S1[0] * KK[0] + S1[1] * KK[1] + S1[2] * KK[2] + S1[3] * KK[3]; \
    float sa0 = -(t0.x + t0.y), sa1 = -(t1.x + t1.y); \
    sa0 += dpp_f<0xB1>(sa0); sa1 += dpp_f<0xB1>(sa1); sa0 += dpp_f<0x4E>(sa0); sa1 += dpp_f<0x4E>(sa1); sa0 += dpp_f<0x141>(sa0); sa1 += dpp_f<0x141>(sa1); \
    const f32x2 a0 = {sa0, sa0}, a1 = {sa1, sa1}, u0 = {vv.x, vv.x}, u1 = {vv.y, vv.y}; \
    _Pragma("unroll") for (int e = 0; e < 4; ++e) { S0[e] = S0[e] * W[e] + a0 * BB[e] + u0 * KV[e]; S1[e] = S1[e] * W[e] + a1 * BB[e] + u1 * KV[e]; } \
    f32x2 q0 = S0[0] * RR[0] + S0[1] * RR[1] + S0[2] * RR[2] + S0[3] * RR[3]; \
    f32x2 q1 = S1[0] * RR[0] + S1[1] * RR[1] + S1[2] * RR[2] + S1[3] * RR[3]; \
    float y0 = q0.x + q0.y, y1 = q1.x + q1.y; \
    y0 += dpp_f<0xB1>(y0); y1 += dpp_f<0xB1>(y1); y0 += dpp_f<0x4E>(y0); y1 += dpp_f<0x4E>(y1); y0 += dpp_f<0x141>(y0); y1 += dpp_f<0x141>(y1); \
    const bool mine = (kl == ((s_) & 7)); \
    if ((s_) < 8) { ya.x = mine ? y0 : ya.x; ya.y = mine ? y1 : ya.y; } else { yb.x = mine ? y0 : yb.x; yb.y = mine ? y1 : yb.y; } } while (0)
  for (int ch = 0; ch < nch; ++ch) {
    const int cur = ch & 1;
    if (ch + 1 < nch) SCAN_GLOAD(ch + 1);
    const float* b = st + cur * 6144;
    const float* vsrc = st + voff + cur * vbuf;
    f32x2 ya = {0.f, 0.f}, yb = {0.f, 0.f};
#pragma unroll 2
    for (int s = 0; s < 8; ++s) SCAN_STEP(s);
#pragma unroll 2
    for (int s = 8; s < 16; ++s) SCAN_STEP(s);
    *(f32x2*)(yout + (size_t)(ch * 16 + kl) * PROJF) = ya;
    *(f32x2*)(yout + (size_t)(ch * 16 + 8 + kl) * PROJF) = yb;
    if (ch + 1 < nch) SCAN_LSTORE(cur ^ 1);
    __syncthreads();
  }
#pragma unroll
  for (int j = 0; j < 2; ++j) {
    float* zp = ZP + ((size_t)((seg * 4 + head) * 128 + R0 + j)) * 64 + kl * 8;
    if (j == 0) { *(float4*)(zp) = make_float4(S0[0].x, S0[0].y, S0[1].x, S0[1].y); *(float4*)(zp + 4) = make_float4(S0[2].x, S0[2].y, S0[3].x, S0[3].y); }
    else { *(float4*)(zp) = make_float4(S1[0].x, S1[0].y, S1[1].x, S1[1].y); *(float4*)(zp + 4) = make_float4(S1[2].x, S1[2].y, S1[3].x, S1[3].y); }
  }
}

__device__ void rwkv_combine(const Params& p, unsigned char* dsm_) {
  float* ring = (float*)dsm_;
  float* ZP = (float*)(p.ws + OFF_ZP);
  const int tid = opaque_tid512(); const int lane = tid & 63;
  const int rowi = blockIdx.x * 8 + (tid >> 6);
  const int head = rowi >> 6, v = rowi & 63;
  float4 pa0, pa1, pa2, pa3, pb0, pb1, pb2, pb3;
  float z0, z1, z2, z3;
#define COMB_ONE(stg_, q, PA, PB, Z) do { const float* base = ZP + (size_t)((((stg_) * 4 + q) * 4 + head) * 128) * 64; \
      PA = ((const float4*)(base + 4096))[tid]; PB = ((const float4*)(base + 4096))[tid + 512]; Z = base[v * 64 + lane]; } while (0)
#define COMB_ISSUE(stg_) do { COMB_ONE(stg_, 0, pa0, pb0, z0); COMB_ONE(stg_, 1, pa1, pb1, z1); COMB_ONE(stg_, 2, pa2, pb2, z2); COMB_ONE(stg_, 3, pa3, pb3, z3); } while (0)
#define COMB_SEG(q, ZC) do { const int seg = stg * 4 + q; \
      ZP[((size_t)((seg * 4 + head) * 128 + v)) * 64 + lane] = s; \
      float ns0 = ZC, ns1 = 0.f; const float* P = buf + q * 4096 + lane; \
      _Pragma("unroll") for (int i = 0; i < 64; i += 2) { \
        float s0 = __builtin_bit_cast(float, __builtin_amdgcn_readlane(__builtin_bit_cast(int, s), i)); \
        float s1 = __builtin_bit_cast(float, __builtin_amdgcn_readlane(__builtin_bit_cast(int, s), i + 1)); \
        ns0 += s0 * P[i * 64]; ns1 += s1 * P[(i + 1) * 64]; } \
      s = ns0 + ns1; } while (0)
  COMB_ISSUE(0);
  float s = 0.f;
#pragma unroll 1
  for (int stg = 0; stg < NSEG / 4; ++stg) {
    float* buf = ring + (stg & 1) * 16384;
    ((float4*)(buf))[tid] = pa0; ((float4*)(buf))[tid + 512] = pb0;
    ((float4*)(buf + 4096))[tid] = pa1; ((float4*)(buf + 4096))[tid + 512] = pb1;
    ((float4*)(buf + 8192))[tid] = pa2; ((float4*)(buf + 8192))[tid + 512] = pb2;
    ((float4*)(buf + 12288))[tid] = pa3; ((float4*)(buf + 12288))[tid + 512] = pb3;
    const float c0 = z0, c1 = z1, c2 = z2, c3 = z3;
    __syncthreads();
    if (stg + 1 < NSEG / 4) COMB_ISSUE(stg + 1);
    COMB_SEG(0, c0); COMB_SEG(1, c1); COMB_SEG(2, c2); COMB_SEG(3, c3);
  }
  __syncthreads();
}

__device__ __forceinline__ bf16x8 pack8(const float4 a, const float4 b) {
  uint4 u = make_uint4(pack2(a.x, a.y), pack2(a.z, a.w), pack2(b.x, b.y), pack2(b.z, b.w));
  return __builtin_bit_cast(bf16x8, u);
}
__device__ void rwkv_final_item(const Params& p, int l, int item, unsigned char* smem) {
  l = opq(l); item = opq(item);
  const int tid = opaque_tid(), w = tid >> 6, lane = tid & 63, l31 = lane & 31, hf = lane >> 5;
  const int parts = SL / 128;
  const int q = item % parts, head = (item / parts) & 3, seg = item / (parts * 4);
  const int t = seg * SL + q * 128 + w * 32 + l31;
  const float* ZP = (const float*)(p.ws + OFF_ZP);
  const float* PF = (const float*)(p.ws + OFF_PROJ);
  const u16* PROJ = (const u16*)(p.ws + OFF_PROJ);
  const u16* RBv = (const u16*)(p.ws + OFF_RWB) + (size_t)2 * T_ * 256;
  const float* BON = (const float*)(p.ws + OFF_BONUS);
  u16* MIX = (u16*)(p.ws + OFF_MIX);
  f32x16 acc0, acc1;
#pragma unroll
  for (int r = 0; r < 16; ++r) { acc0[r] = 0.f; acc1[r] = 0.f; }
  {
    const float* sp = ZP + ((size_t)((seg * 4 + head) * 128 + l31)) * 64 + 8 * hf;
    const float* rp = PF + (size_t)t * PROJF + 256 + head * 64 + 8 * hf;
#pragma unroll
    for (int ks = 0; ks < 4; ++ks) {
      const bf16x8 bfrag = pack8(*(const float4*)(rp + 16 * ks), *(const float4*)(rp + 16 * ks + 4));
      const bf16x8 a0 = pack8(*(const float4*)(sp + 16 * ks), *(const float4*)(sp + 16 * ks + 4));
      const bf16x8 a1 = pack8(*(const float4*)(sp + 32 * 64 + 16 * ks), *(const float4*)(sp + 32 * 64 + 16 * ks + 4));
      acc0 = __builtin_amdgcn_mfma_f32_32x32x16_bf16(a0, bfrag, acc0, 0, 0, 0);
      acc1 = __builtin_amdgcn_mfma_f32_32x32x16_bf16(a1, bfrag, acc1, 0, 0, 0);
    }
  }
  const float* y0p = PF + (size_t)t * PROJF + head * 64 + 4 * hf;
  float sum = 0.f;
#pragma unroll
  for (int g = 0; g < 4; ++g) {
    const float4 ya = *(const float4*)(y0p + 8 * g), yb = *(const float4*)(y0p + 32 + 8 * g);
    acc0[4 * g + 0] += ya.x; acc0[4 * g + 1] += ya.y; acc0[4 * g + 2] += ya.z; acc0[4 * g + 3] += ya.w;
    acc1[4 * g + 0] += yb.x; acc1[4 * g + 1] += yb.y; acc1[4 * g + 2] += yb.z; acc1[4 * g + 3] += yb.w;
  }
#pragma unroll
  for (int r = 0; r < 16; ++r) sum += acc0[r] + acc1[r];
  sum += __shfl_xor(sum, 32);
  const float mean = sum * (1.f / 64.f);
  float var = 0.f;
#pragma unroll
  for (int r = 0; r < 16; ++r) { const float d0 = acc0[r] - mean, d1 = acc1[r] - mean; var += d0 * d0 + d1 * d1; }
  var += __shfl_xor(var, 32);
  const float rstd = rsqrtf(var * (1.f / 64.f) + 64e-5f);
  const float bon = BON[t * 4 + head];
  const int cb = head * 64 + 4 * hf;
#pragma unroll
  for (int mt = 0; mt < 2; ++mt)
#pragma unroll
    for (int g = 0; g < 4; ++g) {
      const int c = cb + mt * 32 + 8 * g;
      const float4 lw = *(const float4*)(p.ln_w + l * 256 + c), lb = *(const float4*)(p.ln_b + l * 256 + c);
      const uint2 vv = *(const uint2*)(RBv + (size_t)t * 256 + c);
      const uint2 gg = *(const uint2*)(PROJ + (size_t)t * NALL + 2048 + c);
      float o0 = (mt ? acc1[4 * g + 0] : acc0[4 * g + 0]), o1 = (mt ? acc1[4 * g + 1] : acc0[4 * g + 1]);
      float o2 = (mt ? acc1[4 * g + 2] : acc0[4 * g + 2]), o3 = (mt ? acc1[4 * g + 3] : acc0[4 * g + 3]);
      o0 = (o0 - mean) * rstd * lw.x + lb.x + bon * bflo(vv.x);
      o1 = (o1 - mean) * rstd * lw.y + lb.y + bon * bfhi(vv.x);
      o2 = (o2 - mean) * rstd * lw.z + lb.z + bon * bflo(vv.y);
      o3 = (o3 - mean) * rstd * lw.w + lb.w + bon * bfhi(vv.y);
      o0 *= silu(bflo(gg.x)); o1 *= silu(bfhi(gg.x)); o2 *= silu(bflo(gg.y)); o3 *= silu(bfhi(gg.y));
      *(uint2*)(MIX + (size_t)t * 1024 + 512 + c) = make_uint2(pack2(o0, o1), pack2(o2, o3));
    }
}

#define LDS_BYTES (131072 + 16)
#ifndef REP_G1
#define REP_G1 1
#endif
#ifndef REP_G2
#define REP_G2 1
#endif
#ifndef REP_P3
#define REP_P3 1
#endif
#ifndef REP_SCAN
#define REP_SCAN 1
#endif
#ifndef REP_GO
#define REP_GO 1
#endif
#ifndef REP_FIN
#define REP_FIN 1
#endif
#define PAIR_LOOP(N, BODY) for (int _pr = blockIdx.x; _pr < (N) / 2; _pr += gridDim.x) { const int it = 2 * _pr + vb; BODY }
__global__ void __launch_bounds__(512) fwd_megakernel(Params p) {
  cg::grid_group grid = cg::this_grid();
  extern __shared__ __attribute__((aligned(16))) unsigned char dsm[];
  const int vb = __builtin_amdgcn_readfirstlane(threadIdx.x >> 8);
  unsigned char* smem = dsm + vb * 65536;
  if (threadIdx.x == 0) *(uint4*)(dsm + 131072) = make_uint4(0u, 0u, 0u, 0u);
  __syncthreads();
  const XcdBarrier xb = xcd_barrier_post((unsigned*)(p.ws + OFF_BAR), (volatile LAS unsigned*)(dsm + 131072));
#define GSYNC() xcd_barrier(xb)
#ifndef PH
#define PH 0xffff
#endif
  if (PH & 1) PAIR_LOOP(384, phase_mod_item(p, it, smem);)
  if (PH & 2) PAIR_LOOP(4480, phase_wconv_item(p, it, smem);)
  if (PH & 2) PAIR_LOOP(8, phase_w2t_item(p, it);)
  grid.sync();
  if (PH & 4) phase_h0(p);
  GSYNC();
#pragma unroll 1
  for (int hl = 0; hl < 8; ++hl) {
    const int l = hl >> 1;
    const bool second = hl & 1;
    if (PH & 8) {
      pg8::Gemm g; g.M = T_; g.K = 1024;
      pg8::EpiU E; E.O = (void*)(p.ws + OFF_PROJ);
      if (!second) { g.A = (const u16*)(p.ws + OFF_H); g.Bt = (const u16*)(p.ws + OFF_WALL) + (size_t)l * NALL * 1024; g.N = 3584; E.ldc = NALL; E.ncols = NALL; E.f32out = 0; }
      else { g.A = (const u16*)(p.ws + OFF_MIX); g.Bt = (const u16*)(p.ws + OFF_WOUT) + (size_t)l * 1024 * 1024; g.N = 1024; E.ldc = 1024; E.ncols = 1024; E.f32out = 0; }
      pg8::StaticOrder S; S.init(T_, g.N, gridDim.x, blockIdx.x);
      const int nrep = second ? REP_G2 : REP_G1;
#pragma unroll 1
      for (int rep = 0; rep < nrep; ++rep)
      pg8::gemm_phase<pg8::EpiU, pg8::StaticOrder, false>((PG8_LAS unsigned char*)dsm, g, S, E, nullptr);
    }
    GSYNC();
    if (!second) {
#pragma unroll 1
      for (int rep = 0; rep < REP_P3; ++rep)
      PAIR_LOOP(3072,
        if (it < 1024) { if (PH & 16) attn_item(p, l, it, smem); }
        else if (it < 2048) { if (PH & 32) rwkv_prep_item(p, l, it - 1024, smem); }
        else { if (PH & 64) gla_local_item(p, l, it - 2048, smem); }
      )
      GSYNC();
      if (PH & 128) for (int eb = blockIdx.x; eb < 256; eb += gridDim.x) gla_state_block(p, eb, dsm);
#pragma unroll 1
      for (int rep = 0; rep < REP_SCAN; ++rep)
      if (PH & 256) for (int it = blockIdx.x; it < NSEG * 4; it += gridDim.x) rwkv_scan_item(p, it, dsm);
      GSYNC();
      if (blockIdx.x < 32) { if (PH & 512) rwkv_combine(p, dsm); }
#pragma unroll 1
      for (int rep = 0; rep < REP_GO; ++rep)
      if (PH & 1024) { if (blockIdx.x >= 32) for (int _pr = blockIdx.x - 32; _pr < 512; _pr += gridDim.x - 32) { const int it = 2 * _pr + vb; gla_out_item(p, l, it, smem); } }
      GSYNC();
#pragma unroll 1
      for (int rep = 0; rep < REP_FIN; ++rep)
      if (PH & 2048) PAIR_LOOP(NSEG * 4 * (SL / 128), rwkv_final_item(p, l, it, smem);)
      GSYNC();
    } else {
      if (PH & 8192) phase_post(p, l);
      if (hl < 7) GSYNC();
    }
  }
}

extern "C" void kernel_launch(void* const* d_in, const int* in_sizes, int n_in, void* d_out, int out_size, void* d_ws, size_t ws_size,
                              hipStream_t stream) {
  static int grid_blocks = 0;
  if (!grid_blocks) {
    int dev = 0, cus = 0, per_cu = 0;
    (void)hipGetDevice(&dev);
    (void)hipDeviceGetAttribute(&cus, hipDeviceAttributeMultiprocessorCount, dev);
    (void)hipFuncSetAttribute((const void*)fwd_megakernel, hipFuncAttributeMaxDynamicSharedMemorySize, LDS_BYTES);
    (void)hipOccupancyMaxActiveBlocksPerMultiprocessor(&per_cu, fwd_megakernel, 512, LDS_BYTES);
    if (per_cu < 1) per_cu = 1;
    grid_blocks = cus;
    if (grid_blocks < 32) grid_blocks = 32;
  }
  if (n_in != 27 || ws_size < WS_END) {
    fprintf(stderr, "kernel_launch: unexpected n_in %d / ws %zu\n", n_in, ws_size);
    return;
  }
  Params p{};
  const float** pp = (const float**)&p;
  for (int i = 0; i < 27; ++i) pp[i] = (const float*)d_in[i];
  p.out = (float*)d_out;
  p.ws = (unsigned char*)d_ws;
  (void)hipMemsetAsync((unsigned char*)d_ws + OFF_BAR, 0, XCD_BAR_WORDS * 4, stream);
  void* args[] = {&p};
  hipError_t e = hipLaunchCooperativeKernel((void*)fwd_megakernel, dim3(grid_blocks), dim3(512), args, LDS_BYTES, stream);
  if (e != hipSuccess) fprintf(stderr, "cooperative launch failed: %s (grid %d)\n", hipGetErrorString(e), grid_blocks);
}
```

```cpp
#include <hip/hip_runtime.h>
#include <hip/hip_bf16.h>
#include <hip/hip_cooperative_groups.h>
#include <cstdio>
namespace cg = cooperative_groups;

typedef unsigned short u16;
using bf16x8 = __attribute__((ext_vector_type(8))) short;
using f32x4 = __attribute__((ext_vector_type(4))) float;
using f32x16 = __attribute__((ext_vector_type(16))) float;

#define T_ 16384
#define NALL 3456
#define NSEG 64
#define SL (T_ / NSEG)
#define PROJF 1728

#define OFF_WALL 0ull
#define OFF_WOUT 28311552ull
#define OFF_MOD 36700160ull
#define OFF_H 36749312ull
#define OFF_RWW OFF_H
#define OFF_RWKK (OFF_H + 16777216ull)
#define OFF_PROJ 70303744ull
#define OFF_MIX 183549952ull
#define OFF_RWB 217104384ull
#define OFF_GLAS 250658816ull
#define OFF_GLAD 259047424ull
#define OFF_BONUS 259178496ull
#define OFF_ZP 259440640ull
#define OFF_BAR 267829248ull
#define OFF_W2T 267845632ull
#define OFF_A2T 267976704ull
#define WS_END 268107776ull


struct Params {
  const float *x, *c, *ada_w, *ada_b, *norm_pre, *norm_post, *w_in, *w_out, *sinks, *mu_rkv, *mu_w, *mu_a, *w0, *w1, *w2,
      *a0, *a1, *a2, *k_k, *k_a, *r_k, *ln_w, *ln_b, *gk1, *gk2, *gk_b, *gla_nw;
  float* out;
  unsigned char* ws;
};

__device__ __forceinline__ u16 f2bf(float f) {
  unsigned u = __float_as_uint(f);
  u += 0x7fffu + ((u >> 16) & 1u);
  return (u16)(u >> 16);
}
__device__ __forceinline__ float bf2f(u16 h) { return __uint_as_float(((unsigned)h) << 16); }
__device__ __forceinline__ unsigned pack2(float a, float b) { return (unsigned)f2bf(a) | ((unsigned)f2bf(b) << 16); }
__device__ __forceinline__ float bflo(unsigned u) { return __uint_as_float(u << 16); }
__device__ __forceinline__ float bfhi(unsigned u) { return __uint_as_float(u & 0xffff0000u); }

__device__ __forceinline__ float silu(float x) { return x / (1.f + __expf(-x)); }
__device__ __forceinline__ float sigmoidf_(float x) { return 1.f / (1.f + __expf(-x)); }
__device__ __forceinline__ float softplusf_(float z) { return fmaxf(z, 0.f) + log1pf(__expf(-fabsf(z))); }

__device__ __forceinline__ int opq(int x) { asm volatile("" : "+s"(x)); return x; }
__device__ __forceinline__ int opaque_tid() { int t = threadIdx.x & 255; asm volatile("" : "+v"(t)); return t; }
__device__ __forceinline__ int opaque_tid512() { int t = threadIdx.x; asm volatile("" : "+v"(t)); return t; }
template <int CTRL>
__device__ __forceinline__ float dpp_f(float x) {
  return __builtin_bit_cast(float, __builtin_amdgcn_update_dpp(0, __builtin_bit_cast(int, x), CTRL, 0xf, 0xf, true));
}
__device__ __forceinline__ float row16_allsum(float x) {
  x += dpp_f<0x128>(x);
  x += dpp_f<0x124>(x);
  x += dpp_f<0x122>(x);
  x += dpp_f<0x121>(x);
  return x;
}
__device__ __forceinline__ float wave_sum(float v) {
  v = row16_allsum(v);
  const int iv = __builtin_bit_cast(int, v);
  const float a = __builtin_bit_cast(float, __builtin_amdgcn_readlane(iv, 0)), b = __builtin_bit_cast(float, __builtin_amdgcn_readlane(iv, 16));
  const float c = __builtin_bit_cast(float, __builtin_amdgcn_readlane(iv, 32)), d = __builtin_bit_cast(float, __builtin_amdgcn_readlane(iv, 48));
  return (a + b) + (c + d);
}

namespace pg8 {
#define PG8_LAS __attribute__((address_space(3)))
typedef unsigned short bf16_t;
typedef short bf16x8 __attribute__((ext_vector_type(8)));
typedef float f32x4 __attribute__((ext_vector_type(4)));
typedef unsigned u32x4 __attribute__((ext_vector_type(4)));
constexpr int BM = 256, BK = 64, HALF = 128, HTB = HALF * BK * 2  , STAGE_BYTES = 8 * HTB, NXCD = 8, WGM = 8;

__host__ __device__ __forceinline__ int lds_byte(int r, int c) { const int st = (r >> 4) * 2 + (c >> 5), rr = r & 15, cc = c & 31, ob = rr * 64 + cc * 2; return st * 1024 + (ob ^ (((ob >> 9) & 1) << 5)); }
__host__ __device__ __forceinline__ void stage_rc(int b, int& R, int& C) { const int st = b / 1024, sb = b % 1024, swz = sb ^ (((sb >> 9) & 1) << 5); R = (st >> 1) * 16 + swz / 64; C = (st & 1) * 32 + (swz % 64) / 2; }
__host__ __device__ __forceinline__ int perm32(int rho) { const int n = rho >> 4, i = rho & 15; return 8 * (i >> 2) + 4 * n + (i & 3); }

struct Unit { int pm, pn; };
struct Gemm { const bf16_t* A; const bf16_t* Bt; int M, N, K; };

struct StaticOrder {
    int nM, nN, nwg, G, c;
    __host__ __device__ void init(int M, int N, int G_, int c_) { nM = M / BM; nN = N / BM; nwg = nM * nN; G = G_; c = c_; }
    __host__ __device__ bool next(int i, Unit& u) const {
        const long L = (long)i * G + c; if (L >= nwg) return false;
        int wgid = (int)L; { const int q = nwg / NXCD, r = nwg % NXCD, xcd = wgid % NXCD, off = wgid / NXCD; wgid = (xcd < r ? xcd * (q + 1) : r * (q + 1) + (xcd - r) * q) + off; }
        const int nig = WGM * nN, gid = wgid / nig, fm = gid * WGM, gsz = (nM - fm) < WGM ? (nM - fm) : WGM;
        u.pm = fm + ((wgid % nig) % gsz); u.pn = (wgid % nig) / gsz; return true;
    }
    __device__ __forceinline__ void a_ready(const Unit&) const {}
    __device__ __forceinline__ void done(const Unit&) const {}
};
__device__ __forceinline__ unsigned cvt_pk_bf16(float lo, float hi) { unsigned r; asm volatile("v_cvt_pk_bf16_f32 %0, %1, %2" : "=v"(r) : "v"(lo), "v"(hi)); return r; }
template <class Epi, class Sched, bool STAMP = false>
__device__ __forceinline__ void gemm_phase(PG8_LAS unsigned char* lds, const Gemm g, const Sched& S, const Epi& E, unsigned long long* stamps) {
    const int tid = threadIdx.x, wid = __builtin_amdgcn_readfirstlane(tid >> 6), lane = tid & 63, wr = wid >> 2, wc = wid & 3, fr = lane & 15, fq = lane >> 4;
    const int K = g.K, nt = K / BK;
    int ts_lo = 0, ts_hi = 0, nts = 0; const unsigned long long rt_entry = STAMP ? (unsigned long long)wall_clock64() : 0ull;
#define PG8_STAMP() do { if (STAMP && wid == 0 && nts < 64) { const unsigned long long _c = (unsigned long long)clock64(); \
        ts_lo = (lane == nts) ? (int)(unsigned)_c : ts_lo; ts_hi = (lane == nts) ? (int)(unsigned)(_c >> 32) : ts_hi; ++nts; } } while (0)
    PG8_STAMP();
    unsigned voffA[2], voffB[2];
#pragma unroll
    for (int i = 0; i < 2; ++i) { int R, C; stage_rc(tid * 16 + i * 8192, R, C); const int Rb = Epi::PERM ? ((R & ~31) + perm32(R & 31)) : R;
        voffA[i] = (unsigned)(R * K + C) * 2u; voffB[i] = (unsigned)(Rb * K + C) * 2u; }
    const size_t kstep = (size_t)(BK * 2);
    const size_t hstep = (size_t)HALF * K * 2;
    const size_t tstep = 2 * hstep;
    const unsigned ldsw = (unsigned)wid * 1024u;
    const int aoff = lds_byte(wr * 64 + fr, fq * 8), boff = lds_byte(wc * 32 + fr, fq * 8);
#define PG8_SA(b, h) (((b) * 2 + (h)) * HTB)
#define PG8_SB(b, h) ((4 + (b) * 2 + (h)) * HTB)
#define PG8_STAGE(bufoff, gbase, voff) do { _Pragma("unroll") for (int _i = 0; _i < 2; ++_i) \
        __builtin_amdgcn_global_load_lds((const unsigned*)((const char*)(gbase) + (voff)[_i]), (PG8_LAS unsigned*)(lds + (bufoff) + ldsw + _i * 8192), 16, 0, 0); } while (0)
#define PG8_LDA(dst, b, h) do { _Pragma("unroll") for (int m = 0; m < 4; ++m) _Pragma("unroll") for (int k = 0; k < 2; ++k) dst[m][k] = *(const PG8_LAS bf16x8*)(lds + PG8_SA(b, h) + aoff + m * 2048 + k * 1024); } while (0)
#define PG8_LDB(dst, b, h) do { _Pragma("unroll") for (int n = 0; n < 2; ++n) _Pragma("unroll") for (int k = 0; k < 2; ++k) dst[n][k] = *(const PG8_LAS bf16x8*)(lds + PG8_SB(b, h) + boff + n * 2048 + k * 1024); } while (0)
#define PG8_MMA(ai, bj, At, Bt) do { __builtin_amdgcn_s_setprio(1); _Pragma("unroll") for (int m = 0; m < 4; ++m) _Pragma("unroll") for (int n = 0; n < 2; ++n) _Pragma("unroll") for (int k = 0; k < 2; ++k) \
        acc[ai][bj][m][n] = __builtin_amdgcn_mfma_f32_16x16x32_bf16(Bt[n][k], At[m][k], acc[ai][bj][m][n], 0, 0, 0); __builtin_amdgcn_s_setprio(0); } while (0)
#define PG8_WAIT_V(n) asm volatile("s_waitcnt vmcnt(" #n ")" ::: "memory")
#define PG8_WAIT_L(n) asm volatile("s_waitcnt lgkmcnt(" #n ")" ::: "memory")
#define PG8_BAR __builtin_amdgcn_s_barrier()
#define PG8_SCHED __builtin_amdgcn_sched_barrier(0)
    Unit cur, nxt; int ui = 0;
    if (!S.next(0, cur)) return;
    f32x4 acc[2][2][4][2];
#pragma unroll
    for (int a = 0; a < 2; ++a)
#pragma unroll
        for (int b = 0; b < 2; ++b)
#pragma unroll
            for (int m = 0; m < 4; ++m)
#pragma unroll
                for (int n = 0; n < 2; ++n) acc[a][b][m][n] = (f32x4){0.f, 0.f, 0.f, 0.f};
    bf16x8 At[4][2], B0[2][2], B1[2][2];
    const char* cA = (const char*)g.A + (size_t)cur.pm * tstep; const char* cB = (const char*)g.Bt + (size_t)cur.pn * tstep;
    S.a_ready(cur);
    PG8_STAGE(PG8_SB(0, 0), cB, voffB); PG8_STAGE(PG8_SA(0, 0), cA, voffA); PG8_STAGE(PG8_SB(0, 1), cB + hstep, voffB); PG8_STAGE(PG8_SA(0, 1), cA + hstep, voffA);
    if (wr == 1) PG8_BAR;
    PG8_WAIT_V(4); PG8_BAR;
    PG8_STAGE(PG8_SB(1, 0), cB + kstep, voffB); PG8_STAGE(PG8_SA(1, 0), cA + kstep, voffA); PG8_STAGE(PG8_SB(1, 1), cB + hstep + kstep, voffB);
    PG8_WAIT_V(6); PG8_BAR;
    PG8_STAMP();
    for (;;) {
        const bool has_next = S.next(ui + 1, nxt);
        const char* nA = has_next ? (const char*)g.A + (size_t)nxt.pm * tstep : cA; const char* nB = has_next ? (const char*)g.Bt + (size_t)nxt.pn * tstep : cB;
        for (int t = 0; t < nt; t += 2) {
            const bool last = (t == nt - 2);
            const char* a1 = cA + (size_t)(t + 1) * kstep;
            const char* a2 = last ? nA : cA + (size_t)(t + 2) * kstep; const char* b2 = last ? nB : cB + (size_t)(t + 2) * kstep;
            const char* a3 = a2 + kstep; const char* b3 = b2 + kstep;
            if (last && has_next) S.a_ready(nxt);
            PG8_LDB(B0, 0, 0); PG8_SCHED; PG8_LDA(At, 0, 0); PG8_STAGE(PG8_SA(1, 1), a1 + hstep, voffA);
            PG8_WAIT_L(8); PG8_BAR; PG8_WAIT_L(0); PG8_MMA(0, 0, At, B0); PG8_BAR; PG8_SCHED;
            PG8_LDB(B1, 0, 1); PG8_STAGE(PG8_SB(0, 0), b2, voffB);
            PG8_BAR; PG8_WAIT_L(0); PG8_MMA(0, 1, At, B1); PG8_BAR;
            PG8_LDA(At, 0, 1); PG8_STAGE(PG8_SA(0, 0), a2, voffA);
            PG8_BAR; PG8_WAIT_L(0); PG8_MMA(1, 0, At, B0); PG8_BAR; PG8_SCHED;
            PG8_STAGE(PG8_SB(0, 1), b2 + hstep, voffB);
            PG8_WAIT_V(6); PG8_BAR; PG8_MMA(1, 1, At, B1); PG8_BAR;
            PG8_LDB(B0, 1, 0); PG8_SCHED; PG8_LDA(At, 1, 0); PG8_STAGE(PG8_SA(0, 1), a2 + hstep, voffA);
            PG8_WAIT_L(8); PG8_BAR; PG8_WAIT_L(0); PG8_MMA(0, 0, At, B0); PG8_BAR; PG8_SCHED;
            PG8_LDB(B1, 1, 1); PG8_STAGE(PG8_SB(1, 0), b3, voffB);
            PG8_BAR; PG8_WAIT_L(0); PG8_MMA(0, 1, At, B1); PG8_BAR;
            PG8_LDA(At, 1, 1); PG8_STAGE(PG8_SA(1, 0), a3, voffA);
            PG8_BAR; PG8_WAIT_L(0); PG8_MMA(1, 0, At, B0); PG8_BAR; PG8_SCHED;
            PG8_STAGE(PG8_SB(1, 1), b3 + hstep, voffB);
            PG8_WAIT_V(6); PG8_BAR; PG8_MMA(1, 1, At, B1); PG8_BAR;
        }
        PG8_STAMP();
        if constexpr (!Epi::AFTER_DRAIN) { E(acc, cur, wr, wc, fr, fq); S.done(cur); }
        PG8_STAMP();
        if (!has_next) break;
#pragma unroll
        for (int a = 0; a < 2; ++a)
#pragma unroll
            for (int b = 0; b < 2; ++b)
#pragma unroll
                for (int m = 0; m < 4; ++m)
#pragma unroll
                    for (int n = 0; n < 2; ++n) acc[a][b][m][n] = (f32x4){0.f, 0.f, 0.f, 0.f};
        cur = nxt; cA = nA; cB = nB; ++ui;
    }
    PG8_WAIT_V(0);
    if (wr == 0) PG8_BAR;
    PG8_BAR;
    if constexpr (Epi::AFTER_DRAIN) { E.fused(acc, cur, wr, wc, fr, fq, lds, wid, lane); S.done(cur); }
    PG8_STAMP();
    if (STAMP && wid == 0) { stamps[lane] = lane < nts ? (((unsigned long long)(unsigned)ts_hi << 32) | (unsigned)ts_lo) : 0ull;
        if (lane == 62) stamps[62] = rt_entry; if (lane == 63) stamps[63] = (unsigned long long)wall_clock64(); }
#undef PG8_STAMP
#undef PG8_SA
#undef PG8_SB
#undef PG8_STAGE
#undef PG8_LDA
#undef PG8_LDB
#undef PG8_MMA
#undef PG8_WAIT_V
#undef PG8_WAIT_L
#undef PG8_BAR
#undef PG8_SCHED
}
}

namespace pg8 {
struct EpiProj {
    static constexpr bool PERM = true, AFTER_DRAIN = false;
    bf16_t* O; int ldc; int ncols;
    __device__ __forceinline__ void operator()(const f32x4 (&acc)[2][2][4][2], const Unit& u, int wr, int wc, int fr, int fq) const {
        const int row0 = u.pm * BM + wr * 64 + fr; const int col0 = u.pn * BM + wc * 32 + 8 * fq;
#pragma unroll
        for (int ai = 0; ai < 2; ++ai)
#pragma unroll
            for (int m = 0; m < 4; ++m) { bf16_t* rowp = O + (size_t)(row0 + ai * HALF + m * 16) * ldc + col0;
#pragma unroll
                for (int bj = 0; bj < 2; ++bj) { const f32x4 v0 = acc[ai][bj][m][0], v1 = acc[ai][bj][m][1];
                    u32x4 w; w.x = cvt_pk_bf16(v0[0], v0[1]); w.y = cvt_pk_bf16(v0[2], v0[3]); w.z = cvt_pk_bf16(v1[0], v1[1]); w.w = cvt_pk_bf16(v1[2], v1[3]);
                    if (col0 + bj * HALF < ncols) *(u32x4*)(rowp + bj * HALF) = w; } }
    }
};
struct EpiU {
    static constexpr bool PERM = true, AFTER_DRAIN = false;
    void* O; int ldc; int ncols; int f32out;
    __device__ __forceinline__ void operator()(const f32x4 (&acc)[2][2][4][2], const Unit& u, int wr, int wc, int fr, int fq) const {
        const int row0 = u.pm * BM + wr * 64 + fr; const int col0 = u.pn * BM + wc * 32 + 8 * fq;
        if (f32out) {
#pragma unroll
            for (int ai = 0; ai < 2; ++ai)
#pragma unroll
                for (int m = 0; m < 4; ++m) { float* rowp = (float*)O + (size_t)(row0 + ai * HALF + m * 16) * ldc + col0;
#pragma unroll
                    for (int bj = 0; bj < 2; ++bj) { *(f32x4*)(rowp + bj * HALF) = acc[ai][bj][m][0]; *(f32x4*)(rowp + bj * HALF + 4) = acc[ai][bj][m][1]; } }
        } else {
#pragma unroll
            for (int ai = 0; ai < 2; ++ai)
#pragma unroll
                for (int m = 0; m < 4; ++m) { bf16_t* rowp = (bf16_t*)O + (size_t)(row0 + ai * HALF + m * 16) * ldc + col0;
#pragma unroll
                    for (int bj = 0; bj < 2; ++bj) { const f32x4 v0 = acc[ai][bj][m][0], v1 = acc[ai][bj][m][1];
                        u32x4 w; w.x = cvt_pk_bf16(v0[0], v0[1]); w.y = cvt_pk_bf16(v0[2], v0[3]); w.z = cvt_pk_bf16(v1[0], v1[1]); w.w = cvt_pk_bf16(v1[2], v1[3]);
                        if (col0 + bj * HALF < ncols) *(u32x4*)(rowp + bj * HALF) = w; } }
        }
    }
};
}

#define XB_TMO      128
#define XB_XCNT(j)  (256  + 64 * (j))
#define XB_XSUB(j)  (1280 + 64 * (j))
#define XB_XGEN(j)  (2304 + 64 * (j))
#define XB_TOP      3328
#define XB_TOPGEN   3392
#define XCD_BAR_WORDS 3456
#define XB_SPIN_CAP (1u << 18)
#define LAS __attribute__((address_space(3)))

__device__ __forceinline__ unsigned xb_ld(unsigned* p)              { return __hip_atomic_load(p, __ATOMIC_RELAXED, __HIP_MEMORY_SCOPE_AGENT); }
__device__ __forceinline__ unsigned xb_add(unsigned* p, unsigned v) { return __hip_atomic_fetch_add(p, v, __ATOMIC_RELAXED, __HIP_MEMORY_SCOPE_AGENT); }
__device__ __forceinline__ unsigned xb_xcc_id() { return (unsigned)__builtin_amdgcn_s_getreg((3 << 11) | 20) & 0xFu; }
#define XB_SPIN(cond, bar) do { unsigned _sp = 0; while (cond) { __builtin_amdgcn_s_sleep(1); \
    if ((++_sp & 255u) == 0u) { if (xb_ld(&(bar)[XB_TMO])) break; if (_sp > XB_SPIN_CAP) { atomicAdd(&(bar)[XB_TMO], 1u); break; } } } } while (0)

struct XcdBarrier {
    unsigned* bar; unsigned x;
    volatile LAS unsigned* st;
};

__device__ __forceinline__ XcdBarrier xcd_barrier_post(unsigned* bar, volatile LAS unsigned* st) {
    XcdBarrier b; b.bar = bar; b.x = xb_xcc_id(); b.st = st;
    if (threadIdx.x == 0) (void)xb_add(&bar[XB_XCNT(b.x)], 1u);
    return b;
}
__device__ __forceinline__ void xcd_barrier_complete(unsigned* bar, unsigned x, unsigned& nloc, unsigned& nx) {
    const unsigned G = gridDim.x * gridDim.y * gridDim.z;
    unsigned sum, cnt, mine, sp = 0u;
    for (;;) {
        sum = 0u; cnt = 0u; mine = 0u;
#pragma unroll
        for (unsigned j = 0; j < 16; ++j) { const unsigned c = xb_ld(&bar[XB_XCNT(j)]); sum += c; cnt += (c > 0u) ? 1u : 0u; mine = (j == x) ? c : mine; }
        if (sum == G) break;
        __builtin_amdgcn_s_sleep(1);
        if ((++sp & 255u) == 0u) { if (xb_ld(&bar[XB_TMO])) break; if (sp > XB_SPIN_CAP) { atomicAdd(&bar[XB_TMO], 1u); break; } }
    }
    nloc = mine > 0u ? mine : 1u; nx = cnt > 0u ? cnt : 1u;
}

__device__ __forceinline__ void xcd_barrier(const XcdBarrier& b) {
    asm volatile("s_waitcnt vmcnt(0)" ::: "memory");
    __syncthreads();
    if (threadIdx.x == 0) {
        unsigned* bar = b.bar;
        __builtin_amdgcn_s_waitcnt(0);
        unsigned nloc = b.st[0], nx = b.st[1];
        if (nloc == 0u) { xcd_barrier_complete(bar, b.x, nloc, nx); b.st[0] = nloc; b.st[1] = nx; }
        const unsigned old = xb_add(&bar[XB_XSUB(b.x)], 1u);
        const unsigned gen = old / nloc;
        if (old + 1u == (gen + 1u) * nloc) {
            __builtin_amdgcn_fence(__ATOMIC_RELEASE, "agent");
            asm volatile("s_waitcnt vmcnt(0)" ::: "memory");
            const unsigned og = xb_add(&bar[XB_TOP], 1u);
            const unsigned tg = og / nx;
            if (og + 1u == (tg + 1u) * nx) xb_add(&bar[XB_TOPGEN], 1u);
            else XB_SPIN(xb_ld(&bar[XB_TOPGEN]) == tg, bar);
            __builtin_amdgcn_fence(__ATOMIC_ACQUIRE, "agent");
            xb_add(&bar[XB_XGEN(b.x)], 1u);
            asm volatile("s_waitcnt vmcnt(0)" ::: "memory");
        } else {
            XB_SPIN(xb_ld(&bar[XB_XGEN(b.x)]) == gen, bar);
            __builtin_amdgcn_fence(__ATOMIC_ACQUIRE, "agent");
            asm volatile("s_waitcnt vmcnt(0)" ::: "memory");
        }
    }
    __syncthreads();
}

__device__ void phase_mod_item(const Params& p, int it, unsigned char* smem) {
  float* red = (float*)smem;
  const int tid = opaque_tid(), tx = tid & 31, ty = tid >> 5;
  float* mod = (float*)(p.ws + OFF_MOD);
  it = opq(it);
  {
    int l = it / 96;
    int j = (it % 96) * 32 + tx;
    const float* W = p.ada_w + (size_t)l * 1024 * 3072;
    float* cs = red + 256;
#pragma unroll
    for (int i = 0; i < 4; ++i) cs[tid + 256 * i] = silu(p.c[tid + 256 * i]);
    __syncthreads();
    float acc = 0.f;
#pragma unroll 1
    for (int i0 = 0; i0 < 128; i0 += 16) {
      float wv[16];
#pragma unroll
      for (int i = 0; i < 16; ++i) wv[i] = W[(size_t)(ty * 128 + i0 + i) * 3072 + j];
#pragma unroll
      for (int i = 0; i < 16; ++i) acc += cs[ty * 128 + i0 + i] * wv[i];
    }
    red[ty * 32 + tx] = acc;
    __syncthreads();
    if (ty == 0) {
      float s = 0.f;
      for (int g = 0; g < 8; ++g) s += red[g * 32 + tx];
      mod[l * 3072 + j] = s + p.ada_b[l * 3072 + j];
    }
    __syncthreads();
  }
}

__device__ __forceinline__ float wall_src(const Params& p, int l, int k, int n) {
  size_t lk = (size_t)l * 1024 + k;
  if (n < 3072) return p.w_in[lk * 3072 + n];
  if (n < 3136) return (1.f - p.mu_w[lk]) * p.w1[lk * 64 + (n - 3072)];
  if (n < 3200) return p.mu_w[lk] * p.w1[lk * 64 + (n - 3136)];
  if (n < 3264) return (1.f - p.mu_a[lk]) * p.a1[lk * 64 + (n - 3200)];
  if (n < 3328) return p.mu_a[lk] * p.a1[lk * 64 + (n - 3264)];
  if (n < 3344) return p.gk1[lk * 16 + (n - 3328)];
  return 0.f;
}

__device__ void phase_wconv_item(const Params& p, int it, unsigned char* smem) {
  float* tile = (float*)smem;
  const int tid = opaque_tid();
  u16* WALL = (u16*)(p.ws + OFF_WALL);
  u16* WOUT = (u16*)(p.ws + OFF_WOUT);
  it = opq(it);
  {
    bool isout = it >= 3456;
    int l, nt, kt;
    if (!isout) { l = it / 864; int r = it % 864; nt = r >> 4; kt = r & 15; }
    else { int r = it - 3456; l = r >> 8; r &= 255; nt = r >> 4; kt = r & 15; }
    int tx = tid & 63, ty = tid >> 6;
#pragma unroll
    for (int i = 0; i < 16; ++i) {
      int kl = ty + 4 * i;
      int k = kt * 64 + kl, n = nt * 64 + tx;
      float v = isout ? p.w_out[((size_t)l * 1024 + k) * 1024 + n] : wall_src(p, l, k, n);
      tile[kl * 65 + tx] = v;
    }
    __syncthreads();
    int nl = tid >> 2, kq = tid & 3;
    unsigned w[8];
#pragma unroll
    for (int j = 0; j < 8; ++j) w[j] = pack2(tile[(kq * 16 + 2 * j) * 65 + nl], tile[(kq * 16 + 2 * j + 1) * 65 + nl]);
    u16* dst = (isout ? WOUT + ((size_t)l * 1024 + nt * 64 + nl) * 1024 : WALL + ((size_t)l * NALL + nt * 64 + nl) * 1024) + kt * 64 + kq * 16;
    ((uint4*)dst)[0] = make_uint4(w[0], w[1], w[2], w[3]);
    ((uint4*)dst)[1] = make_uint4(w[4], w[5], w[6], w[7]);
    __syncthreads();
  }
}

__device__ void phase_w2t_item(const Params& p, int it) {
  it = opq(it);
  const int c = opaque_tid();
  const int l = it >> 1, which = it & 1;
  const float* src = (which ? p.a2 : p.w2) + (size_t)l * 64 * 256 + c;
  u16* dst = (u16*)(p.ws + (which ? OFF_A2T : OFF_W2T)) + ((size_t)l * 256 + c) * 64;
#pragma unroll
  for (int j8 = 0; j8 < 8; ++j8) {
    float f[8];
#pragma unroll
    for (int q = 0; q < 8; ++q) f[q] = src[(j8 * 8 + q) * 256];
    *(uint4*)(dst + j8 * 8) = make_uint4(pack2(f[0], f[1]), pack2(f[2], f[3]), pack2(f[4], f[5]), pack2(f[6], f[7]));
  }
}

__device__ __forceinline__ void write_h(const Params& p, int l, int row, int lane, const float4* v, float ss) {
  const float* mod = (const float*)(p.ws + OFF_MOD) + l * 3072;
  u16* H = (u16*)(p.ws + OFF_H);
  float rs = rsqrtf(ss * (1.f / 1024.f) + 1e-6f);
#pragma unroll
  for (int i = 0; i < 4; ++i) {
    int col = (lane + 64 * i) * 4;
    float4 g = *(const float4*)(p.norm_pre + l * 1024 + col);
    float4 sh = *(const float4*)(mod + col);
    float4 sc = *(const float4*)(mod + 1024 + col);
    float h0 = v[i].x * rs * g.x * (1.f + sc.x) + sh.x;
    float h1 = v[i].y * rs * g.y * (1.f + sc.y) + sh.y;
    float h2 = v[i].z * rs * g.z * (1.f + sc.z) + sh.z;
    float h3 = v[i].w * rs * g.w * (1.f + sc.w) + sh.w;
    *(uint2*)(H + (size_t)row * 1024 + col) = make_uint2(pack2(h0, h1), pack2(h2, h3));
  }
}

__device__ void phase_h0(const Params& p) {
  const int tid = opaque_tid512(); const int wave = tid >> 6, lane = tid & 63;
  for (int row = blockIdx.x * 8 + wave; row < T_; row += gridDim.x * 8) {
    const float4* xr = (const float4*)(p.x + (size_t)row * 1024);
    float4 v[4];
    float ss = 0.f;
#pragma unroll
    for (int i = 0; i < 4; ++i) {
      v[i] = xr[lane + 64 * i];
      ss += v[i].x * v[i].x + v[i].y * v[i].y + v[i].z * v[i].z + v[i].w * v[i].w;
    }
    ss = wave_sum(ss);
    write_h(p, 0, row, lane, v, ss);
  }
}

__device__ void phase_post(const Params& p, int l) {
  l = opq(l);
  const int tid = opaque_tid512(); const int wave = tid >> 6, lane = tid & 63;
  const u16* Y = (const u16*)(p.ws + OFF_PROJ);
  const float* mod = (const float*)(p.ws + OFF_MOD) + l * 3072;
  const float* xold = (l == 0) ? p.x : p.out;
  for (int row = blockIdx.x * 8 + wave; row < T_; row += gridDim.x * 8) {
    const uint2* yr = (const uint2*)(Y + (size_t)row * 1024);
    const float4* xr = (const float4*)(xold + (size_t)row * 1024);
    float4 y[4], v[4];
    float ss = 0.f;
#pragma unroll
    for (int i = 0; i < 4; ++i) {
      const uint2 u = yr[lane + 64 * i];
      y[i] = make_float4(bflo(u.x), bfhi(u.x), bflo(u.y), bfhi(u.y));
      v[i] = xr[lane + 64 * i];
      ss += y[i].x * y[i].x + y[i].y * y[i].y + y[i].z * y[i].z + y[i].w * y[i].w;
    }
    ss = wave_sum(ss);
    float rs = rsqrtf(ss * (1.f / 1024.f) + 1e-6f);
    float s2 = 0.f;
#pragma unroll
    for (int i = 0; i < 4; ++i) {
      int col = (lane + 64 * i) * 4;
      float4 g = *(const float4*)(p.norm_post + l * 1024 + col);
      float4 gt = *(const float4*)(mod + 2048 + col);
      v[i].x += gt.x * (y[i].x * rs * g.x);
      v[i].y += gt.y * (y[i].y * rs * g.y);
      v[i].z += gt.z * (y[i].z * rs * g.z);
      v[i].w += gt.w * (y[i].w * rs * g.w);
      *(float4*)(p.out + (size_t)row * 1024 + col) = v[i];
      s2 += v[i].x * v[i].x + v[i].y * v[i].y + v[i].z * v[i].z + v[i].w * v[i].w;
    }
    if (l < 3) {
      s2 = wave_sum(s2);
      write_h(p, l + 1, row, lane, v, s2);
    }
  }
}

__device__ void attn_item(const Params& p, int l, int item, unsigned char* smem) {
  l = opq(l); item = opq(item);
  u16* Vt = (u16*)smem;
  const u16* PROJ = (const u16*)(p.ws + OFF_PROJ);
  u16* MIX = (u16*)(p.ws + OFF_MIX);
  const int tid = opaque_tid(), w = tid >> 6, lane = tid & 63, l31 = lane & 31, hf = lane >> 5;
  const int qb = item >> 3, head = item & 7, kvh = head >> 2;
  const int kpos0 = (qb - 1) * 128;
  {
    int kp = kpos0 + tid;
    if (kp < 0) kp = 0;
    const uint4* src = (const uint4*)(PROJ + (size_t)kp * NALL + 640 + kvh * 64);
#pragma unroll
    for (int c8 = 0; c8 < 8; ++c8) {
      uint4 v = src[c8];
      int d = c8 * 8;
      Vt[(d + 0) * 264 + tid] = (u16)(v.x & 0xffff);
      Vt[(d + 1) * 264 + tid] = (u16)(v.x >> 16);
      Vt[(d + 2) * 264 + tid] = (u16)(v.y & 0xffff);
      Vt[(d + 3) * 264 + tid] = (u16)(v.y >> 16);
      Vt[(d + 4) * 264 + tid] = (u16)(v.z & 0xffff);
      Vt[(d + 5) * 264 + tid] = (u16)(v.z >> 16);
      Vt[(d + 6) * 264 + tid] = (u16)(v.w & 0xffff);
      Vt[(d + 7) * 264 + tid] = (u16)(v.w >> 16);
    }
  }
  const int tq = qb * 128 + 32 * w + l31;
  bf16x8 qf[4], kc[4];
  {
    const u16* qp = PROJ + (size_t)tq * NALL + head * 64 + 8 * hf;
#pragma unroll
    for (int s = 0; s < 4; ++s) qf[s] = *(const bf16x8*)(qp + 16 * s);
    int kp = kpos0 + 32 * w + l31;
    if (kp < 0) kp = 0;
    const u16* kptr = PROJ + (size_t)kp * NALL + 512 + kvh * 64 + 8 * hf;
#pragma unroll
    for (int s = 0; s < 4; ++s) kc[s] = *(const bf16x8*)(kptr + 16 * s);
  }
  __syncthreads();
  const float slope = exp2f(-(float)(head + 1));
  const float sink = p.sinks[l * 8 + head];
  const int rq = 32 * w + l31;
  float mrun = -1e30f, lsum = 0.f;
  f32x16 o0, o1;
#pragma unroll
  for (int r = 0; r < 16; ++r) { o0[r] = 0.f; o1[r] = 0.f; }
#pragma unroll 1
  for (int i = 0; i < 5; ++i) {
    bf16x8 kn[4];
    {
      const int in_ = (i < 4) ? i + 1 : 4;
      int kp = kpos0 + 32 * w + 32 * in_ + l31;
      if (kp < 0) kp = 0;
      const u16* kptr = PROJ + (size_t)kp * NALL + 512 + kvh * 64 + 8 * hf;
#pragma unroll
      for (int s = 0; s < 4; ++s) kn[s] = *(const bf16x8*)(kptr + 16 * s);
    }
    f32x16 a;
#pragma unroll
    for (int r = 0; r < 16; ++r) a[r] = 0.f;
#pragma unroll
    for (int s = 0; s < 4; ++s) a = __builtin_amdgcn_mfma_f32_32x32x16_bf16(kc[s], qf[s], a, 0, 0, 0);
#pragma unroll
    for (int s = 0; s < 4; ++s) kc[s] = kn[s];
    float tmax = -1e30f;
#pragma unroll
    for (int r = 0; r < 16; ++r) {
      int kj = 32 * w + 32 * i + (r & 3) + 8 * (r >> 2) + 4 * hf;
      int dist = 128 + rq - kj;
      bool valid = (dist >= 0) && (dist < 128) && (kpos0 + kj >= 0);
      float sv = a[r] * 0.125f - slope * (float)dist;
      sv = valid ? sv : -1e30f;
      a[r] = sv;
      tmax = fmaxf(tmax, sv);
    }
    tmax = fmaxf(tmax, __shfl_xor(tmax, 32));
    const float mnew = fmaxf(mrun, tmax);
    const float alpha = __expf(mrun - mnew);
    float psum = 0.f;
#pragma unroll
    for (int r = 0; r < 16; ++r) {
      float e = (a[r] > -1e29f) ? __expf(a[r] - mnew) : 0.f;
      a[r] = e;
      psum += e;
    }
    lsum = lsum * alpha + psum;
    mrun = mnew;
#pragma unroll
    for (int r = 0; r < 16; ++r) { o0[r] *= alpha; o1[r] *= alpha; }
#pragma unroll
    for (int u = 0; u < 2; ++u) {
      bf16x8 pf;
#pragma unroll
      for (int j = 0; j < 8; ++j) pf[j] = (short)f2bf(a[8 * u + j]);
      const int kb = 32 * w + 32 * i + 16 * u + 4 * hf;
      const u16* v0 = Vt + l31 * 264 + kb;
      const u16* v1 = Vt + (32 + l31) * 264 + kb;
      uint2 a0 = *(const uint2*)(v0), a1 = *(const uint2*)(v0 + 8);
      uint2 b0 = *(const uint2*)(v1), b1 = *(const uint2*)(v1 + 8);
      uint4 A0 = make_uint4(a0.x, a0.y, a1.x, a1.y), A1 = make_uint4(b0.x, b0.y, b1.x, b1.y);
      o0 = __builtin_amdgcn_mfma_f32_32x32x16_bf16(__builtin_bit_cast(bf16x8, A0), pf, o0, 0, 0, 0);
      o1 = __builtin_amdgcn_mfma_f32_32x32x16_bf16(__builtin_bit_cast(bf16x8, A1), pf, o1, 0, 0, 0);
    }
  }
  {
    const float mf = fmaxf(mrun, sink);
    const float scl = __expf(mrun - mf);
    const float ltot = (lsum + __shfl_xor(lsum, 32)) * scl + __expf(sink - mf);
    const float fin = scl / ltot;
#pragma unroll
    for (int r = 0; r < 16; ++r) { o0[r] *= fin; o1[r] *= fin; }
  }
  const u16* gp = PROJ + (size_t)tq * NALL + 768 + head * 64;
  u16* op = MIX + (size_t)tq * 1024 + head * 64;
#pragma unroll
  for (int g = 0; g < 4; ++g) {
    int d0 = 8 * g + 4 * hf;
    uint2 gg = *(const uint2*)(gp + d0);
    float r0 = o0[4 * g + 0] * silu(bflo(gg.x)), r1 = o0[4 * g + 1] * silu(bfhi(gg.x));
    float r2 = o0[4 * g + 2] * silu(bflo(gg.y)), r3 = o0[4 * g + 3] * silu(bfhi(gg.y));
    *(uint2*)(op + d0) = make_uint2(pack2(r0, r1), pack2(r2, r3));
    uint2 g2 = *(const uint2*)(gp + 32 + d0);
    r0 = o1[4 * g + 0] * silu(bflo(g2.x)); r1 = o1[4 * g + 1] * silu(bfhi(g2.x));
    r2 = o1[4 * g + 2] * silu(bflo(g2.y)); r3 = o1[4 * g + 3] * silu(bfhi(g2.y));
    *(uint2*)(op + 32 + d0) = make_uint2(pack2(r0, r1), pack2(r2, r3));
  }
  __syncthreads();
}

__device__ void rwkv_prep_item(const Params& p, int l, int item, unsigned char* smem) {
  l = opq(l); item = opq(item);
  u16* lwb = (u16*)smem;
  u16* lab = lwb + 16 * 72;
  const u16* PROJ = (const u16*)(p.ws + OFF_PROJ);
  const int tid = opaque_tid(), head = tid >> 6, lane = tid & 63, fr = lane & 15, fq = lane >> 4;
  const int t0 = item * 16;
#pragma unroll
  for (int i = 0; i < 8; ++i) {
    int idx = tid + 256 * i;
    int which = idx >> 10, tt = (idx >> 6) & 15, j = idx & 63;
    int t = t0 + tt;
    const u16* pr = PROJ + (size_t)t * NALL;
    float cur = bf2f(pr[(which ? 3200 : 3072) + j]);
    float prev = (t > 0) ? bf2f((pr - NALL)[(which ? 3264 : 3136) + j]) : 0.f;
    float sv = cur + prev;
    if (!which) sv = tanhf(sv);
    (which ? lab : lwb)[tt * 72 + j] = f2bf(sv);
  }
  __syncthreads();
  f32x4 accw[4], acca[4];
#pragma unroll
  for (int nt = 0; nt < 4; ++nt) { accw[nt] = (f32x4){0.f, 0.f, 0.f, 0.f}; acca[nt] = (f32x4){0.f, 0.f, 0.f, 0.f}; }
  {
    const u16* W2T = (const u16*)(p.ws + OFF_W2T) + ((size_t)l * 256 + head * 64 + fr) * 64 + fq * 8;
    const u16* A2T = (const u16*)(p.ws + OFF_A2T) + ((size_t)l * 256 + head * 64 + fr) * 64 + fq * 8;
#pragma unroll
    for (int ks = 0; ks < 2; ++ks) {
      const bf16x8 aw = *(const bf16x8*)(lwb + fr * 72 + ks * 32 + fq * 8);
      const bf16x8 aa = *(const bf16x8*)(lab + fr * 72 + ks * 32 + fq * 8);
#pragma unroll
      for (int nt = 0; nt < 4; ++nt) {
        const bf16x8 bw = *(const bf16x8*)(W2T + nt * 16 * 64 + ks * 32);
        const bf16x8 ba = *(const bf16x8*)(A2T + nt * 16 * 64 + ks * 32);
        accw[nt] = __builtin_amdgcn_mfma_f32_16x16x32_bf16(aw, bw, accw[nt], 0, 0, 0);
        acca[nt] = __builtin_amdgcn_mfma_f32_16x16x32_bf16(aa, ba, acca[nt], 0, 0, 0);
      }
    }
  }
  float mur[4], muk[4], muv[4], w0[4], a0[4], kkw[4], kaw[4], rkw[4];
#pragma unroll
  for (int nt = 0; nt < 4; ++nt) {
    const int c = head * 64 + nt * 16 + fr;
    mur[nt] = p.mu_rkv[l * 768 + c]; muk[nt] = p.mu_rkv[l * 768 + 256 + c]; muv[nt] = p.mu_rkv[l * 768 + 512 + c];
    w0[nt] = p.w0[l * 256 + c]; a0[nt] = p.a0[l * 256 + c]; kkw[nt] = p.k_k[l * 256 + c]; kaw[nt] = p.k_a[l * 256 + c]; rkw[nt] = p.r_k[l * 256 + c];
  }
  float* RWW = (float*)(p.ws + OFF_RWW);
  float* RWKK = (float*)(p.ws + OFF_RWKK);
  u16* RB = (u16*)(p.ws + OFF_RWB);
  float* BON = (float*)(p.ws + OFF_BONUS);
#pragma unroll
  for (int rg = 0; rg < 4; ++rg) {
    const int t = t0 + fq * 4 + rg;
    const u16* pr = PROJ + (size_t)t * NALL;
    float kkc[4], av[4];
    float n2 = 0.f, bonus = 0.f;
#pragma unroll
    for (int nt = 0; nt < 4; ++nt) {
      const int c = head * 64 + nt * 16 + fr;
      float rc = bf2f(pr[1280 + c]), kc = bf2f(pr[1536 + c]), vc = bf2f(pr[1792 + c]);
      float rp = 0.f, kp = 0.f, vp = 0.f;
      if (t > 0) { rp = bf2f((pr - NALL)[1280 + c]); kp = bf2f((pr - NALL)[1536 + c]); vp = bf2f((pr - NALL)[1792 + c]); }
      const float r = rc + (rp - rc) * mur[nt], k = kc + (kp - kc) * muk[nt], v = vc + (vp - vc) * muv[nt];
      const float wpre = w0[nt] + accw[nt][rg];
      const float wl = -softplusf_(-wpre) - 0.5f;
      const float decay = __expf(-__expf(wl));
      const float a = sigmoidf_(a0[nt] + acca[nt][rg]);
      const float kc2 = k * kkw[nt];
      const float kmod = k * (1.f + (a - 1.f) * kaw[nt]);
      kkc[nt] = kc2; av[nt] = a;
      n2 += kc2 * kc2;
      bonus += r * kmod * rkw[nt];
      const size_t o = (size_t)t * 256 + c;
      RWW[o] = decay;
      RB[o] = f2bf(r);
      RB[(size_t)T_ * 256 + o] = f2bf(kmod);
      RB[(size_t)2 * T_ * 256 + o] = f2bf(v);
    }
    n2 = row16_allsum(n2);
    bonus = row16_allsum(bonus);
    const float inv = 1.f / fmaxf(sqrtf(n2), 1e-12f);
#pragma unroll
    for (int nt = 0; nt < 4; ++nt) {
      const int c = head * 64 + nt * 16 + fr;
      const size_t o = (size_t)t * 256 + c;
      const float kk = kkc[nt] * inv;
      RWKK[o] = kk;
      RB[(size_t)3 * T_ * 256 + o] = f2bf(kk * av[nt]);
    }
    if (fr == 0) BON[t * 4 + head] = bonus;
  }
  __syncthreads();
}

__device__ __forceinline__ void gla_b(const Params& p, int l, int chunk, int head, float* tot, float* bl) {
  const u16* PROJ = (const u16*)(p.ws + OFF_PROJ);
  const int tid = opaque_tid(), d = tid & 31, ig = tid >> 5;
  float g2[16];
#pragma unroll
  for (int m = 0; m < 16; ++m) g2[m] = p.gk2[(size_t)l * 16 * 128 + m * 128 + head * 32 + d];
  const float bias = p.gk_b[l * 128 + head * 32 + d];
  float run = 0.f;
#pragma unroll
  for (int ii = 0; ii < 8; ++ii) {
    int t = chunk * 64 + ig * 8 + ii;
    const uint4* lp = (const uint4*)(PROJ + (size_t)t * NALL + 3328);
    uint4 u0 = lp[0], u1 = lp[1];
    float z = bias;
    z += bflo(u0.x) * g2[0] + bfhi(u0.x) * g2[1] + bflo(u0.y) * g2[2] + bfhi(u0.y) * g2[3];
    z += bflo(u0.z) * g2[4] + bfhi(u0.z) * g2[5] + bflo(u0.w) * g2[6] + bfhi(u0.w) * g2[7];
    z += bflo(u1.x) * g2[8] + bfhi(u1.x) * g2[9] + bflo(u1.y) * g2[10] + bfhi(u1.y) * g2[11];
    z += bflo(u1.z) * g2[12] + bfhi(u1.z) * g2[13] + bflo(u1.w) * g2[14] + bfhi(u1.w) * g2[15];
    float g = (fminf(z, 0.f) - log1pf(__expf(-fabsf(z)))) * (1.f / 16.f);
    run += g;
    bl[ii] = run;
  }
  tot[ig * 32 + d] = run;
  __syncthreads();
  float off = 0.f;
#pragma unroll
  for (int g = 0; g < 8; ++g) off += (g < ig) ? tot[g * 32 + d] : 0.f;
#pragma unroll
  for (int ii = 0; ii < 8; ++ii) bl[ii] += off;
}

__device__ void gla_local_item(const Params& p, int l, int item, unsigned char* smem) {
  l = opq(l); item = opq(item);
  float* tot = (float*)smem;
  float* Kp = tot + 256;
  float* Vs = Kp + 2048;
  const u16* PROJ = (const u16*)(p.ws + OFF_PROJ);
  const int tid = opaque_tid(), d = tid & 31, ig = tid >> 5;
  const int chunk = item >> 2, head = item & 3;
  float bl[8];
  gla_b(p, l, chunk, head, tot, bl);
  float blast = 0.f;
#pragma unroll
  for (int g = 0; g < 8; ++g) blast += tot[g * 32 + d];
#pragma unroll
  for (int ii = 0; ii < 8; ++ii) {
    int i = ig * 8 + ii;
    int t = chunk * 64 + i;
    float k = bf2f(PROJ[(size_t)t * NALL + 2432 + head * 32 + d]);
    Kp[i * 32 + d] = k * __expf(blast - bl[ii]);
  }
#pragma unroll
  for (int r = 0; r < 16; ++r) {
    int idx = tid + 256 * r;
    int i = idx >> 6, v = idx & 63;
    Vs[idx] = bf2f(PROJ[(size_t)(chunk * 64 + i) * NALL + 2560 + head * 64 + v]);
  }
  __syncthreads();
  const int v = tid & 63, dg = tid >> 6;
  float acc[8];
#pragma unroll
  for (int q = 0; q < 8; ++q) acc[q] = 0.f;
  for (int i = 0; i < 64; ++i) {
    float vv = Vs[i * 64 + v];
    float4 k0 = *(const float4*)(Kp + i * 32 + dg * 8), k1 = *(const float4*)(Kp + i * 32 + dg * 8 + 4);
    acc[0] += k0.x * vv; acc[1] += k0.y * vv; acc[2] += k0.z * vv; acc[3] += k0.w * vv;
    acc[4] += k1.x * vv; acc[5] += k1.y * vv; acc[6] += k1.z * vv; acc[7] += k1.w * vv;
  }
  float* GS = (float*)(p.ws + OFF_GLAS);
  float* GD = (float*)(p.ws + OFF_GLAD);
#pragma unroll
  for (int q = 0; q < 8; ++q) GS[((size_t)(chunk * 4 + head) * 32 + dg * 8 + q) * 64 + v] = acc[q];
  if (tid < 32) GD[(chunk * 4 + head) * 32 + tid] = __expf(blast);
  __syncthreads();
}

__device__ void gla_state_block(const Params& p, int eb, unsigned char* dsm_) {
  float* comp = (float*)dsm_;
  float* GS = (float*)(p.ws + OFF_GLAS);
  const float* GD = (const float*)(p.ws + OFF_GLAD);
  eb = opq(eb);
  const int tid = opaque_tid512();
  const int ei = tid & 31, g = tid >> 5;
  const int e = eb * 32 + ei;
  const int head = e >> 11, d = (e >> 6) & 31, v = e & 63;
  float ds[16], dc[16];
#pragma unroll
  for (int i = 0; i < 16; ++i) {
    const int c = g * 16 + i;
    ds[i] = GS[((size_t)(c * 4 + head) * 32 + d) * 64 + v];
    dc[i] = GD[(c * 4 + head) * 32 + d];
  }
  float S = 0.f, P = 1.f;
#pragma unroll
  for (int i = 0; i < 16; ++i) { S = dc[i] * S + ds[i]; P *= dc[i]; }
  comp[(g * 32 + ei) * 2] = P;
  comp[(g * 32 + ei) * 2 + 1] = S;
  __syncthreads();
  float G = 0.f;
  for (int gg = 0; gg < g; ++gg) G = comp[(gg * 32 + ei) * 2] * G + comp[(gg * 32 + ei) * 2 + 1];
#pragma unroll
  for (int i = 0; i < 16; ++i) {
    const int c = g * 16 + i;
    GS[((size_t)(c * 4 + head) * 32 + d) * 64 + v] = G;
    G = dc[i] * G + ds[i];
  }
  __syncthreads();
}

__device__ void gla_out_item(const Params& p, int l, int item, unsigned char* smem) {
  l = opq(l); item = opq(item);
  float* tot = (float*)smem;
  float* qt = tot + 256;
  float* kt = qt + 2304;
  float* Vs = kt + 2304;
  float* Am = Vs + 4096;
  float* Ss = Am + 4352;
  const u16* PROJ = (const u16*)(p.ws + OFF_PROJ);
  u16* MIX = (u16*)(p.ws + OFF_MIX);
  const float* GS = (const float*)(p.ws + OFF_GLAS);
  const int tid = opaque_tid();
  const int chunk = item >> 2, head = item & 3;
  {
    const int d = tid & 31, ig = tid >> 5;
    float bl[8];
    gla_b(p, l, chunk, head, tot, bl);
#pragma unroll
    for (int ii = 0; ii < 8; ++ii) {
      int i = ig * 8 + ii;
      int t = chunk * 64 + i;
      float q = bf2f(PROJ[(size_t)t * NALL + 2304 + head * 32 + d]);
      float k = bf2f(PROJ[(size_t)t * NALL + 2432 + head * 32 + d]);
      qt[i * 36 + d] = q * 0.17677669529663687f * __expf(bl[ii]);
      kt[i * 36 + d] = k * __expf(-bl[ii]);
    }
  }
#pragma unroll
  for (int r = 0; r < 16; ++r) {
    int idx = tid + 256 * r;
    int i = idx >> 6, v = idx & 63;
    Vs[idx] = bf2f(PROJ[(size_t)(chunk * 64 + i) * NALL + 2560 + head * 64 + v]);
  }
#pragma unroll
  for (int r = 0; r < 8; ++r) {
    int idx = tid + 256 * r;
    Ss[idx] = GS[(size_t)(chunk * 4 + head) * 2048 + idx];
  }
  __syncthreads();
  const int j = tid & 63, ig = tid >> 6;
  {
    float acc[16];
#pragma unroll
    for (int ii = 0; ii < 16; ++ii) acc[ii] = 0.f;
#pragma unroll 2
    for (int d4 = 0; d4 < 8; ++d4) {
      const float4 kv = *(const float4*)(kt + j * 36 + d4 * 4);
#pragma unroll
      for (int ii = 0; ii < 16; ++ii) {
        const float4 qv = *(const float4*)(qt + (ig * 16 + ii) * 36 + d4 * 4);
        acc[ii] += qv.x * kv.x + qv.y * kv.y + qv.z * kv.z + qv.w * kv.w;
      }
    }
#pragma unroll
    for (int ii = 0; ii < 16; ++ii) {
      int i = ig * 16 + ii;
      Am[i * 68 + j] = (j <= i) ? acc[ii] : 0.f;
    }
  }
  __syncthreads();
  {
    const int v = j;
    float acc[16];
#pragma unroll
    for (int ii = 0; ii < 16; ++ii) acc[ii] = 0.f;
    const int jmax = (ig + 1) * 4;
    for (int j4 = 0; j4 < jmax; ++j4) {
      const float v0 = Vs[(j4 * 4 + 0) * 64 + v], v1 = Vs[(j4 * 4 + 1) * 64 + v], v2 = Vs[(j4 * 4 + 2) * 64 + v], v3 = Vs[(j4 * 4 + 3) * 64 + v];
#pragma unroll
      for (int ii = 0; ii < 16; ++ii) {
        const float4 av = *(const float4*)(Am + (ig * 16 + ii) * 68 + j4 * 4);
        acc[ii] += av.x * v0 + av.y * v1 + av.z * v2 + av.w * v3;
      }
    }
#pragma unroll 2
    for (int d4 = 0; d4 < 8; ++d4) {
      const float s0 = Ss[(d4 * 4 + 0) * 64 + v], s1 = Ss[(d4 * 4 + 1) * 64 + v], s2 = Ss[(d4 * 4 + 2) * 64 + v], s3 = Ss[(d4 * 4 + 3) * 64 + v];
#pragma unroll
      for (int ii = 0; ii < 16; ++ii) {
        const float4 qv = *(const float4*)(qt + (ig * 16 + ii) * 36 + d4 * 4);
        acc[ii] += qv.x * s0 + qv.y * s1 + qv.z * s2 + qv.w * s3;
      }
    }
    const float nw = p.gla_nw[l * 64 + v];
#pragma unroll
    for (int ii = 0; ii < 16; ++ii) {
      int t = chunk * 64 + ig * 16 + ii;
      float o = acc[ii];
      float ms = wave_sum(o * o) * (1.f / 64.f);
      float gg = bf2f(PROJ[(size_t)t * NALL + 2816 + head * 64 + v]);
      float r = o * rsqrtf(ms + 1e-5f) * nw * silu(gg);
      MIX[(size_t)t * 1024 + 768 + head * 64 + v] = f2bf(r);
    }
  }
  __syncthreads();
}

typedef float f32x2 __attribute__((ext_vector_type(2)));
__device__ __forceinline__ float oct_allsum(float x) {
  x += dpp_f<0xB1>(x);
  x += dpp_f<0x4E>(x);
  x += dpp_f<0x141>(x);
  return x;
}
__device__ void rwkv_scan_item(const Params& p, int item, unsigned char* dsm_) {
  item = opq(item);
  float* st = (float*)dsm_;
  const int tid = opaque_tid512(), wv = tid >> 6, lane = tid & 63, rs = lane >> 3, kl = lane & 7;
  const int head = item & 3, seg = item >> 2;
  const bool ident = wv >= 4;
  const int R0 = wv * 16 + rs * 2;
  const int v0 = R0 & 63;
  const float* RWW = (const float*)(p.ws + OFF_RWW);
  const float* RWKK = (const float*)(p.ws + OFF_RWKK);
  const u16* RB = (const u16*)(p.ws + OFF_RWB);
  float* PF = (float*)(p.ws + OFF_PROJ);
  float* ZP = (float*)(p.ws + OFF_ZP);
  const int tbase = seg * SL;
  const int half = tid >> 8, ls = (tid & 255) >> 4, lc4 = (tid & 15) * 4;
  f32x2 S0[4], S1[4];
#pragma unroll
  for (int e = 0; e < 4; ++e) { S0[e] = (f32x2){0.f, 0.f}; S1[e] = (f32x2){0.f, 0.f}; }
  if (ident) {
#pragma unroll
    for (int e = 0; e < 4; ++e) {
      const int k0 = kl * 8 + 2 * e;
      S0[e] = (f32x2){(v0 == k0) ? 1.f : 0.f, (v0 == k0 + 1) ? 1.f : 0.f};
      S1[e] = (f32x2){(v0 + 1 == k0) ? 1.f : 0.f, (v0 + 1 == k0 + 1) ? 1.f : 0.f};
    }
  }
  float4 g0 = make_float4(0.f, 0.f, 0.f, 0.f);
  uint2 h0 = make_uint2(0u, 0u), h1 = h0, h2 = h0;
  const float* gp0 = (half == 0 ? RWW : RWKK) + (size_t)(tbase + ls) * 256 + head * 64 + lc4;
  const u16* hp = RB + (size_t)(tbase + ls) * 256 + head * 64 + lc4;
#define SCAN_GLOAD(ch) do { const size_t _o = (size_t)(ch) * 16 * 256; g0 = *(const float4*)(gp0 + _o); \
    if (half == 0) { h0 = *(const uint2*)(hp + _o); } \
    else { h0 = *(const uint2*)(hp + (size_t)T_ * 256 + _o); h1 = *(const uint2*)(hp + (size_t)3 * T_ * 256 + _o); h2 = *(const uint2*)(hp + (size_t)2 * T_ * 256 + _o); } } while (0)
#define SCAN_LSTORE(buf) do { float* _b = st + (buf) * 6144 + ls * 64 + lc4; \
    if (half == 0) { *(float4*)(_b) = g0; *(float4*)(_b + 2048) = make_float4(bflo(h0.x), bfhi(h0.x), bflo(h0.y), bfhi(h0.y)); } \
    else { *(float4*)(_b + 1024) = g0; *(float4*)(_b + 3072) = make_float4(bflo(h0.x), bfhi(h0.x), bflo(h0.y), bfhi(h0.y)); \
           *(float4*)(_b + 4096) = make_float4(bflo(h1.x), bfhi(h1.x), bflo(h1.y), bfhi(h1.y)); *(float4*)(_b + 5120) = make_float4(bflo(h2.x), bfhi(h2.x), bflo(h2.y), bfhi(h2.y)); } } while (0)
  if (tid < 16) st[2 * 6144 + tid] = 0.f;
  SCAN_GLOAD(0);
  SCAN_LSTORE(0);
  __syncthreads();
  const int nch = SL / 16;
  float* yout = PF + (size_t)tbase * PROJF + (ident ? 256 : 0) + head * 64 + v0;
  const int voff = ident ? (2 * 6144) : (5120 + v0);
  const int vstep = ident ? 0 : 64, vbuf = ident ? 0 : 6144;
#define V2(a, i) ((f32x2){(i) ? a.z : a.x, (i) ? a.w : a.y})
#define SCAN_STEP(s_) do { \
    const float* bp = b + (s_) * 64 + kl * 8; \
    const float4 wl = *(const float4*)(bp), wh = *(const float4*)(bp + 4); \
    const float4 kkl = *(const float4*)(bp + 1024), kkh = *(const float4*)(bp + 1028); \
    const float4 rl4 = *(const float4*)(bp + 2048), rh4 = *(const float4*)(bp + 2052); \
    const float4 kl4 = *(const float4*)(bp + 3072), kh4 = *(const float4*)(bp + 3076); \
    const float4 bl4 = *(const float4*)(bp + 4096), bh4 = *(const float4*)(bp + 4100); \
    const f32x2 vv = *(const f32x2*)(vsrc + (s_) * vstep); \
    const f32x2 W[4] = {V2(wl, 0), V2(wl, 1), V2(wh, 0), V2(wh, 1)}, KK[4] = {V2(kkl, 0), V2(kkl, 1), V2(kkh, 0), V2(kkh, 1)}; \
    const f32x2 RR[4] = {V2(rl4, 0), V2(rl4, 1), V2(rh4, 0), V2(rh4, 1)}, KV[4] = {V2(kl4, 0), V2(kl4, 1), V2(kh4, 0), V2(kh4, 1)}; \
    const f32x2 BB[4] = {V2(bl4, 0), V2(bl4, 1), V2(bh4, 0), V2(bh4, 1)}; \
    f32x2 t0 = S0[0] * KK[0] + S0[1] * KK[1] + S0[2] * KK[2] + S0[3] * KK[3]; \
    f32x2 t1 = S1[0] * KK[0] + S1[1] * KK[1] + S1[2] * KK[2] + S1[3] * KK[3]; \
    float sa0 = -(t0.x + t0.y), sa1 = -(t1.x + t1.y); \
    sa0 += dpp_f<0xB1>(sa0); sa1 += dpp_f<0xB1>(sa1); sa0 += dpp_f<0x4E>(sa0); sa1 += dpp_f<0x4E>(sa1); sa0 += dpp_f<0x141>(sa0); sa1 += dpp_f<0x141>(sa1); \
    const f32x2 a0 = {sa0, sa0}, a1 = {sa1, sa1}, u0 = {vv.x, vv.x}, u1 = {vv.y, vv.y}; \
    _Pragma("unroll") for (int e = 0; e < 4; ++e) { S0[e] = S0[e] * W[e] + a0 * BB[e] + u0 * KV[e]; S1[e] = S1[e] * W[e] + a1 * BB[e] + u1 * KV[e]; } \
    f32x2 q0 = S0[0] * RR[0] + S0[1] * RR[1] + S0[2] * RR[2] + S0[3] * RR[3]; \
    f32x2 q1 = S1[0] * RR[0] + S1[1] * RR[1] + S1[2] * RR[2] + S1[3] * RR[3]; \
    float y0 = q0.x + q0.y, y1 = q1.x + q1.y; \
    y0 += dpp_f<0xB1>(y0); y1 += dpp_f<0xB1>(y1); y0 += dpp_f<0x4E>(y0); y1 += dpp_f<0x4E>(y1); y0 += dpp_f<0x141>(y0); y1 += dpp_f<0x141>(y1); \
    const bool mine = (kl == ((s_) & 7)); \
    if ((s_) < 8) { ya.x = mine ? y0 : ya.x; ya.y = mine ? y1 : ya.y; } else { yb.x = mine ? y0 : yb.x; yb.y = mine ? y1 : yb.y; } } while (0)
  for (int ch = 0; ch < nch; ++ch) {
    const int cur = ch & 1;
    if (ch + 1 < nch) SCAN_GLOAD(ch + 1);
    const float* b = st + cur * 6144;
    const float* vsrc = st + voff + cur * vbuf;
    f32x2 ya = {0.f, 0.f}, yb = {0.f, 0.f};
#pragma unroll 2
    for (int s = 0; s < 8; ++s) SCAN_STEP(s);
#pragma unroll 2
    for (int s = 8; s < 16; ++s) SCAN_STEP(s);
    *(f32x2*)(yout + (size_t)(ch * 16 + kl) * PROJF) = ya;
    *(f32x2*)(yout + (size_t)(ch * 16 + 8 + kl) * PROJF) = yb;
    if (ch + 1 < nch) SCAN_LSTORE(cur ^ 1);
    __syncthreads();
  }
#pragma unroll
  for (int j = 0; j < 2; ++j) {
    float* zp = ZP + ((size_t)((seg * 4 + head) * 128 + R0 + j)) * 64 + kl * 8;
    if (j == 0) { *(float4*)(zp) = make_float4(S0[0].x, S0[0].y, S0[1].x, S0[1].y); *(float4*)(zp + 4) = make_float4(S0[2].x, S0[2].y, S0[3].x, S0[3].y); }
    else { *(float4*)(zp) = make_float4(S1[0].x, S1[0].y, S1[1].x, S1[1].y); *(float4*)(zp + 4) = make_float4(S1[2].x, S1[2].y, S1[3].x, S1[3].y); }
  }
}

__device__ void rwkv_combine(const Params& p, unsigned char* dsm_) {
  float* ring = (float*)dsm_;
  float* ZP = (float*)(p.ws + OFF_ZP);
  const int tid = opaque_tid512(); const int lane = tid & 63;
  const int rowi = blockIdx.x * 8 + (tid >> 6);
  const int head = rowi >> 6, v = rowi & 63;
  float4 pa0, pa1, pa2, pa3, pb0, pb1, pb2, pb3;
  float z0, z1, z2, z3;
#define COMB_ONE(stg_, q, PA, PB, Z) do { const float* base = ZP + (size_t)((((stg_) * 4 + q) * 4 + head) * 128) * 64; \
      PA = ((const float4*)(base + 4096))[tid]; PB = ((const float4*)(base + 4096))[tid + 512]; Z = base[v * 64 + lane]; } while (0)
#define COMB_ISSUE(stg_) do { COMB_ONE(stg_, 0, pa0, pb0, z0); COMB_ONE(stg_, 1, pa1, pb1, z1); COMB_ONE(stg_, 2, pa2, pb2, z2); COMB_ONE(stg_, 3, pa3, pb3, z3); } while (0)
#define COMB_SEG(q, ZC) do { const int seg = stg * 4 + q; \
      ZP[((size_t)((seg * 4 + head) * 128 + v)) * 64 + lane] = s; \
      float ns0 = ZC, ns1 = 0.f; const float* P = buf + q * 4096 + lane; \
      _Pragma("unroll") for (int i = 0; i < 64; i += 2) { \
        float s0 = __builtin_bit_cast(float, __builtin_amdgcn_readlane(__builtin_bit_cast(int, s), i)); \
        float s1 = __builtin_bit_cast(float, __builtin_amdgcn_readlane(__builtin_bit_cast(int, s), i + 1)); \
        ns0 += s0 * P[i * 64]; ns1 += s1 * P[(i + 1) * 64]; } \
      s = ns0 + ns1; } while (0)
  COMB_ISSUE(0);
  float s = 0.f;
#pragma unroll 1
  for (int stg = 0; stg < NSEG / 4; ++stg) {
    float* buf = ring + (stg & 1) * 16384;
    ((float4*)(buf))[tid] = pa0; ((float4*)(buf))[tid + 512] = pb0;
    ((float4*)(buf + 4096))[tid] = pa1; ((float4*)(buf + 4096))[tid + 512] = pb1;
    ((float4*)(buf + 8192))[tid] = pa2; ((float4*)(buf + 8192))[tid + 512] = pb2;
    ((float4*)(buf + 12288))[tid] = pa3; ((float4*)(buf + 12288))[tid + 512] = pb3;
    const float c0 = z0, c1 = z1, c2 = z2, c3 = z3;
    __syncthreads();
    if (stg + 1 < NSEG / 4) COMB_ISSUE(stg + 1);
    COMB_SEG(0, c0); COMB_SEG(1, c1); COMB_SEG(2, c2); COMB_SEG(3, c3);
  }
  __syncthreads();
}

__device__ __forceinline__ bf16x8 pack8(const float4 a, const float4 b) {
  uint4 u = make_uint4(pack2(a.x, a.y), pack2(a.z, a.w), pack2(b.x, b.y), pack2(b.z, b.w));
  return __builtin_bit_cast(bf16x8, u);
}
__device__ void rwkv_final_item(const Params& p, int l, int item, unsigned char* smem) {
  l = opq(l); item = opq(item);
  const int tid = opaque_tid(), w = tid >> 6, lane = tid & 63, l31 = lane & 31, hf = lane >> 5;
  const int parts = SL / 128;
  const int q = item % parts, head = (item / parts) & 3, seg = item / (parts * 4);
  const int t = seg * SL + q * 128 + w * 32 + l31;
  const float* ZP = (const float*)(p.ws + OFF_ZP);
  const float* PF = (const float*)(p.ws + OFF_PROJ);
  const u16* PROJ = (const u16*)(p.ws + OFF_PROJ);
  const u16* RBv = (const u16*)(p.ws + OFF_RWB) + (size_t)2 * T_ * 256;
  const float* BON = (const float*)(p.ws + OFF_BONUS);
  u16* MIX = (u16*)(p.ws + OFF_MIX);
  f32x16 acc0, acc1;
#pragma unroll
  for (int r = 0; r < 16; ++r) { acc0[r] = 0.f; acc1[r] = 0.f; }
  {
    const float* sp = ZP + ((size_t)((seg * 4 + head) * 128 + l31)) * 64 + 8 * hf;
    const float* rp = PF + (size_t)t * PROJF + 256 + head * 64 + 8 * hf;
#pragma unroll
    for (int ks = 0; ks < 4; ++ks) {
      const bf16x8 bfrag = pack8(*(const float4*)(rp + 16 * ks), *(const float4*)(rp + 16 * ks + 4));
      const bf16x8 a0 = pack8(*(const float4*)(sp + 16 * ks), *(const float4*)(sp + 16 * ks + 4));
      const bf16x8 a1 = pack8(*(const float4*)(sp + 32 * 64 + 16 * ks), *(const float4*)(sp + 32 * 64 + 16 * ks + 4));
      acc0 = __builtin_amdgcn_mfma_f32_32x32x16_bf16(a0, bfrag, acc0, 0, 0, 0);
      acc1 = __builtin_amdgcn_mfma_f32_32x32x16_bf16(a1, bfrag, acc1, 0, 0, 0);
    }
  }
  const float* y0p = PF + (size_t)t * PROJF + head * 64 + 4 * hf;
  float sum = 0.f;
#pragma unroll
  for (int g = 0; g < 4; ++g) {
    const float4 ya = *(const float4*)(y0p + 8 * g), yb = *(const float4*)(y0p + 32 + 8 * g);
    acc0[4 * g + 0] += ya.x; acc0[4 * g + 1] += ya.y; acc0[4 * g + 2] += ya.z; acc0[4 * g + 3] += ya.w;
    acc1[4 * g + 0] += yb.x; acc1[4 * g + 1] += yb.y; acc1[4 * g + 2] += yb.z; acc1[4 * g + 3] += yb.w;
  }
#pragma unroll
  for (int r = 0; r < 16; ++r) sum += acc0[r] + acc1[r];
  sum += __shfl_xor(sum, 32);
  const float mean = sum * (1.f / 64.f);
  float var = 0.f;
#pragma unroll
  for (int r = 0; r < 16; ++r) { const float d0 = acc0[r] - mean, d1 = acc1[r] - mean; var += d0 * d0 + d1 * d1; }
  var += __shfl_xor(var, 32);
  const float rstd = rsqrtf(var * (1.f / 64.f) + 64e-5f);
  const float bon = BON[t * 4 + head];
  const int cb = head * 64 + 4 * hf;
#pragma unroll
  for (int mt = 0; mt < 2; ++mt)
#pragma unroll
    for (int g = 0; g < 4; ++g) {
      const int c = cb + mt * 32 + 8 * g;
      const float4 lw = *(const float4*)(p.ln_w + l * 256 + c), lb = *(const float4*)(p.ln_b + l * 256 + c);
      const uint2 vv = *(const uint2*)(RBv + (size_t)t * 256 + c);
      const uint2 gg = *(const uint2*)(PROJ + (size_t)t * NALL + 2048 + c);
      float o0 = (mt ? acc1[4 * g + 0] : acc0[4 * g + 0]), o1 = (mt ? acc1[4 * g + 1] : acc0[4 * g + 1]);
      float o2 = (mt ? acc1[4 * g + 2] : acc0[4 * g + 2]), o3 = (mt ? acc1[4 * g + 3] : acc0[4 * g + 3]);
      o0 = (o0 - mean) * rstd * lw.x + lb.x + bon * bflo(vv.x);
      o1 = (o1 - mean) * rstd * lw.y + lb.y + bon * bfhi(vv.x);
      o2 = (o2 - mean) * rstd * lw.z + lb.z + bon * bflo(vv.y);
      o3 = (o3 - mean) * rstd * lw.w + lb.w + bon * bfhi(vv.y);
      o0 *= silu(bflo(gg.x)); o1 *= silu(bfhi(gg.x)); o2 *= silu(bflo(gg.y)); o3 *= silu(bfhi(gg.y));
      *(uint2*)(MIX + (size_t)t * 1024 + 512 + c) = make_uint2(pack2(o0, o1), pack2(o2, o3));
    }
}

#define LDS_BYTES (131072 + 16)
#ifndef REP_G1
#define REP_G1 1
#endif
#ifndef REP_G2
#define REP_G2 1
#endif
#ifndef REP_P3
#define REP_P3 1
#endif
#ifndef REP_SCAN
#define REP_SCAN 1
#endif
#ifndef REP_GO
#define REP_GO 1
#endif
#ifndef REP_FIN
#define REP_FIN 1
#endif
#define PAIR_LOOP(N, BODY) for (int _pr = blockIdx.x; _pr < (N) / 2; _pr += gridDim.x) { const int it = 2 * _pr + vb; BODY }
__global__ void __launch_bounds__(512) fwd_megakernel(Params p) {
  cg::grid_group grid = cg::this_grid();
  extern __shared__ __attribute__((aligned(16))) unsigned char dsm[];
  const int vb = __builtin_amdgcn_readfirstlane(threadIdx.x >> 8);
  unsigned char* smem = dsm + vb * 65536;
  if (threadIdx.x == 0) *(uint4*)(dsm + 131072) = make_uint4(0u, 0u, 0u, 0u);
  __syncthreads();
  const XcdBarrier xb = xcd_barrier_post((unsigned*)(p.ws + OFF_BAR), (volatile LAS unsigned*)(dsm + 131072));
#define GSYNC() xcd_barrier(xb)
#ifndef PH
#define PH 0xffff
#endif
  if (PH & 1) PAIR_LOOP(384, phase_mod_item(p, it, smem);)
  if (PH & 2) PAIR_LOOP(4480, phase_wconv_item(p, it, smem);)
  if (PH & 2) PAIR_LOOP(8, phase_w2t_item(p, it);)
  grid.sync();
  if (PH & 4) phase_h0(p);
  GSYNC();
#pragma unroll 1
  for (int hl = 0; hl < 8; ++hl) {
    const int l = hl >> 1;
    const bool second = hl & 1;
    if (PH & 8) {
      pg8::Gemm g; g.M = T_; g.K = 1024;
      pg8::EpiU E; E.O = (void*)(p.ws + OFF_PROJ);
      if (!second) { g.A = (const u16*)(p.ws + OFF_H); g.Bt = (const u16*)(p.ws + OFF_WALL) + (size_t)l * NALL * 1024; g.N = 3584; E.ldc = NALL; E.ncols = NALL; E.f32out = 0; }
      else { g.A = (const u16*)(p.ws + OFF_MIX); g.Bt = (const u16*)(p.ws + OFF_WOUT) + (size_t)l * 1024 * 1024; g.N = 1024; E.ldc = 1024; E.ncols = 1024; E.f32out = 0; }
      pg8::StaticOrder S; S.init(T_, g.N, gridDim.x, blockIdx.x);
      const int nrep = second ? REP_G2 : REP_G1;
#pragma unroll 1
      for (int rep = 0; rep < nrep; ++rep)
      pg8::gemm_phase<pg8::EpiU, pg8::StaticOrder, false>((PG8_LAS unsigned char*)dsm, g, S, E, nullptr);
    }
    GSYNC();
    if (!second) {
#pragma unroll 1
      for (int rep = 0; rep < REP_P3; ++rep)
      PAIR_LOOP(3072,
        if (it < 1024) { if (PH & 16) attn_item(p, l, it, smem); }
        else if (it < 2048) { if (PH & 32) rwkv_prep_item(p, l, it - 1024, smem); }
        else { if (PH & 64) gla_local_item(p, l, it - 2048, smem); }
      )
      GSYNC();
      if (PH & 128) for (int eb = blockIdx.x; eb < 256; eb += gridDim.x) gla_state_block(p, eb, dsm);
#pragma unroll 1
      for (int rep = 0; rep < REP_SCAN; ++rep)
      if (PH & 256) for (int it = blockIdx.x; it < NSEG * 4; it += gridDim.x) rwkv_scan_item(p, it, dsm);
      GSYNC();
      if (blockIdx.x < 32) { if (PH & 512) rwkv_combine(p, dsm); }
#pragma unroll 1
      for (int rep = 0; rep < REP_GO; ++rep)
      if (PH & 1024) {
        unsigned* ctr = (unsigned*)(p.ws + OFF_BAR) + 32 + l;
        volatile unsigned* slot = (volatile unsigned*)(dsm + 131072) + 2;
        for (;;) {
          if (threadIdx.x == 0) *slot = atomicAdd(ctr, 1u);
          __syncthreads();
          const unsigned pr = (unsigned)__builtin_amdgcn_readfirstlane((int)*slot);
          __syncthreads();
          if (pr >= 512u) break;
          gla_out_item(p, l, 2 * (int)pr + vb, smem);
        }
      }
      GSYNC();
#pragma unroll 1
      for (int rep = 0; rep < REP_FIN; ++rep)
      if (PH & 2048) PAIR_LOOP(NSEG * 4 * (SL / 128), rwkv_final_item(p, l, it, smem);)
      GSYNC();
    } else {
      if (PH & 8192) phase_post(p, l);
      if (hl < 7) GSYNC();
    }
  }
}

extern "C" void kernel_launch(void* const* d_in, const int* in_sizes, int n_in, void* d_out, int out_size, void* d_ws, size_t ws_size,
                              hipStream_t stream) {
  static int grid_blocks = 0;
  if (!grid_blocks) {
    int dev = 0, cus = 0, per_cu = 0;
    (void)hipGetDevice(&dev);
    (void)hipDeviceGetAttribute(&cus, hipDeviceAttributeMultiprocessorCount, dev);
    (void)hipFuncSetAttribute((const void*)fwd_megakernel, hipFuncAttributeMaxDynamicSharedMemorySize, LDS_BYTES);
    (void)hipOccupancyMaxActiveBlocksPerMultiprocessor(&per_cu, fwd_megakernel, 512, LDS_BYTES);
    if (per_cu < 1) per_cu = 1;
    grid_blocks = cus;
    if (grid_blocks < 32) grid_blocks = 32;
  }
  if (n_in != 27 || ws_size < WS_END) {
    fprintf(stderr, "kernel_launch: unexpected n_in %d / ws %zu\n", n_in, ws_size);
    return;
  }
  Params p{};
  const float** pp = (const float**)&p;
  for (int i = 0; i < 27; ++i) pp[i] = (const float*)d_in[i];
  p.out = (float*)d_out;
  p.ws = (unsigned char*)d_ws;
  (void)hipMemsetAsync((unsigned char*)d_ws + OFF_BAR, 0, XCD_BAR_WORDS * 4, stream);
  void* args[] = {&p};
  hipError_t e = hipLaunchCooperativeKernel((void*)fwd_megakernel, dim3(grid_blocks), dim3(512), args, LDS_BYTES, stream);
  if (e != hipSuccess) fprintf(stderr, "cooperative launch failed: %s (grid %d)\n", hipGetErrorString(e), grid_blocks);
}
```

```cpp
#include <hip/hip_runtime.h>
#include <hip/hip_bf16.h>
#include <hip/hip_cooperative_groups.h>
#include <cstdio>
namespace cg = cooperative_groups;

typedef unsigned short u16;
using bf16x8 = __attribute__((ext_vector_type(8))) short;
using f32x4 = __attribute__((ext_vector_type(4))) float;
using f32x16 = __attribute__((ext_vector_type(16))) float;

#define T_ 16384
#define NALL 3456
#define NSEG 64
#define SL (T_ / NSEG)
#define PROJF 1728

#define OFF_WALL 0ull
#define OFF_WOUT 28311552ull
#define OFF_MOD 36700160ull
#define OFF_H 36749312ull
#define OFF_RWW OFF_H
#define OFF_RWKK (OFF_H + 16777216ull)
#define OFF_PROJ 70303744ull
#define OFF_MIX 183549952ull
#define OFF_RWB 217104384ull
#define OFF_GLAS 250658816ull
#define OFF_GLAD 259047424ull
#define OFF_BONUS 259178496ull
#define OFF_ZP 259440640ull
#define OFF_BAR 267829248ull
#define OFF_W2T 267845632ull
#define OFF_A2T 267976704ull
#define WS_END 268107776ull


struct Params {
  const float *x, *c, *ada_w, *ada_b, *norm_pre, *norm_post, *w_in, *w_out, *sinks, *mu_rkv, *mu_w, *mu_a, *w0, *w1, *w2,
      *a0, *a1, *a2, *k_k, *k_a, *r_k, *ln_w, *ln_b, *gk1, *gk2, *gk_b, *gla_nw;
  float* out;
  unsigned char* ws;
};

__device__ __forceinline__ u16 f2bf(float f) {
  unsigned u = __float_as_uint(f);
  u += 0x7fffu + ((u >> 16) & 1u);
  return (u16)(u >> 16);
}
__device__ __forceinline__ float bf2f(u16 h) { return __uint_as_float(((unsigned)h) << 16); }
__device__ __forceinline__ unsigned pack2(float a, float b) { return (unsigned)f2bf(a) | ((unsigned)f2bf(b) << 16); }
__device__ __forceinline__ float bflo(unsigned u) { return __uint_as_float(u << 16); }
__device__ __forceinline__ float bfhi(unsigned u) { return __uint_as_float(u & 0xffff0000u); }

__device__ __forceinline__ float frcp(float x) { return __builtin_amdgcn_rcpf(x); }
__device__ __forceinline__ float silu(float x) { return x * frcp(1.f + __expf(-x)); }
__device__ __forceinline__ float sigmoidf_(float x) { return frcp(1.f + __expf(-x)); }
__device__ __forceinline__ float softplusf_(float z) { return fmaxf(z, 0.f) + __logf(1.f + __expf(-fabsf(z))); }
__device__ __forceinline__ float tanh_fast(float x) { return 1.f - 2.f * frcp(1.f + __expf(2.f * x)); }

__device__ __forceinline__ int opq(int x) { asm volatile("" : "+s"(x)); return x; }
__device__ __forceinline__ int opaque_tid() { int t = threadIdx.x & 255; asm volatile("" : "+v"(t)); return t; }
__device__ __forceinline__ int opaque_tid512() { int t = threadIdx.x; asm volatile("" : "+v"(t)); return t; }
template <int CTRL>
__device__ __forceinline__ float dpp_f(float x) {
  return __builtin_bit_cast(float, __builtin_amdgcn_update_dpp(0, __builtin_bit_cast(int, x), CTRL, 0xf, 0xf, true));
}
__device__ __forceinline__ float row16_allsum(float x) {
  x += dpp_f<0x128>(x);
  x += dpp_f<0x124>(x);
  x += dpp_f<0x122>(x);
  x += dpp_f<0x121>(x);
  return x;
}
__device__ __forceinline__ float wave_sum(float v) {
  v = row16_allsum(v);
  const int iv = __builtin_bit_cast(int, v);
  const float a = __builtin_bit_cast(float, __builtin_amdgcn_readlane(iv, 0)), b = __builtin_bit_cast(float, __builtin_amdgcn_readlane(iv, 16));
  const float c = __builtin_bit_cast(float, __builtin_amdgcn_readlane(iv, 32)), d = __builtin_bit_cast(float, __builtin_amdgcn_readlane(iv, 48));
  return (a + b) + (c + d);
}

namespace pg8 {
#define PG8_LAS __attribute__((address_space(3)))
typedef unsigned short bf16_t;
typedef short bf16x8 __attribute__((ext_vector_type(8)));
typedef float f32x4 __attribute__((ext_vector_type(4)));
typedef unsigned u32x4 __attribute__((ext_vector_type(4)));
constexpr int BM = 256, BK = 64, HALF = 128, HTB = HALF * BK * 2  , STAGE_BYTES = 8 * HTB, NXCD = 8, WGM = 8;

__host__ __device__ __forceinline__ int lds_byte(int r, int c) { const int st = (r >> 4) * 2 + (c >> 5), rr = r & 15, cc = c & 31, ob = rr * 64 + cc * 2; return st * 1024 + (ob ^ (((ob >> 9) & 1) << 5)); }
__host__ __device__ __forceinline__ void stage_rc(int b, int& R, int& C) { const int st = b / 1024, sb = b % 1024, swz = sb ^ (((sb >> 9) & 1) << 5); R = (st >> 1) * 16 + swz / 64; C = (st & 1) * 32 + (swz % 64) / 2; }
__host__ __device__ __forceinline__ int perm32(int rho) { const int n = rho >> 4, i = rho & 15; return 8 * (i >> 2) + 4 * n + (i & 3); }

struct Unit { int pm, pn; };
struct Gemm { const bf16_t* A; const bf16_t* Bt; int M, N, K; };

struct StaticOrder {
    int nM, nN, nwg, G, c;
    __host__ __device__ void init(int M, int N, int G_, int c_) { nM = M / BM; nN = N / BM; nwg = nM * nN; G = G_; c = c_; }
    __host__ __device__ bool next(int i, Unit& u) const {
        const long L = (long)i * G + c; if (L >= nwg) return false;
        int wgid = (int)L; { const int q = nwg / NXCD, r = nwg % NXCD, xcd = wgid % NXCD, off = wgid / NXCD; wgid = (xcd < r ? xcd * (q + 1) : r * (q + 1) + (xcd - r) * q) + off; }
        const int nig = WGM * nN, gid = wgid / nig, fm = gid * WGM, gsz = (nM - fm) < WGM ? (nM - fm) : WGM;
        u.pm = fm + ((wgid % nig) % gsz); u.pn = (wgid % nig) / gsz; return true;
    }
    __device__ __forceinline__ void a_ready(const Unit&) const {}
    __device__ __forceinline__ void done(const Unit&) const {}
};
__device__ __forceinline__ unsigned cvt_pk_bf16(float lo, float hi) { unsigned r; asm volatile("v_cvt_pk_bf16_f32 %0, %1, %2" : "=v"(r) : "v"(lo), "v"(hi)); return r; }
template <class Epi, class Sched, bool STAMP = false>
__device__ __forceinline__ void gemm_phase(PG8_LAS unsigned char* lds, const Gemm g, const Sched& S, const Epi& E, unsigned long long* stamps) {
    const int tid = threadIdx.x, wid = __builtin_amdgcn_readfirstlane(tid >> 6), lane = tid & 63, wr = wid >> 2, wc = wid & 3, fr = lane & 15, fq = lane >> 4;
    const int K = g.K, nt = K / BK;
    int ts_lo = 0, ts_hi = 0, nts = 0; const unsigned long long rt_entry = STAMP ? (unsigned long long)wall_clock64() : 0ull;
#define PG8_STAMP() do { if (STAMP && wid == 0 && nts < 64) { const unsigned long long _c = (unsigned long long)clock64(); \
        ts_lo = (lane == nts) ? (int)(unsigned)_c : ts_lo; ts_hi = (lane == nts) ? (int)(unsigned)(_c >> 32) : ts_hi; ++nts; } } while (0)
    PG8_STAMP();
    unsigned voffA[2], voffB[2];
#pragma unroll
    for (int i = 0; i < 2; ++i) { int R, C; stage_rc(tid * 16 + i * 8192, R, C); const int Rb = Epi::PERM ? ((R & ~31) + perm32(R & 31)) : R;
        voffA[i] = (unsigned)(R * K + C) * 2u; voffB[i] = (unsigned)(Rb * K + C) * 2u; }
    const size_t kstep = (size_t)(BK * 2);
    const size_t hstep = (size_t)HALF * K * 2;
    const size_t tstep = 2 * hstep;
    const unsigned ldsw = (unsigned)wid * 1024u;
    const int aoff = lds_byte(wr * 64 + fr, fq * 8), boff = lds_byte(wc * 32 + fr, fq * 8);
#define PG8_SA(b, h) (((b) * 2 + (h)) * HTB)
#define PG8_SB(b, h) ((4 + (b) * 2 + (h)) * HTB)
#define PG8_STAGE(bufoff, gbase, voff) do { _Pragma("unroll") for (int _i = 0; _i < 2; ++_i) \
        __builtin_amdgcn_global_load_lds((const unsigned*)((const char*)(gbase) + (voff)[_i]), (PG8_LAS unsigned*)(lds + (bufoff) + ldsw + _i * 8192), 16, 0, 0); } while (0)
#define PG8_LDA(dst, b, h) do { _Pragma("unroll") for (int m = 0; m < 4; ++m) _Pragma("unroll") for (int k = 0; k < 2; ++k) dst[m][k] = *(const PG8_LAS bf16x8*)(lds + PG8_SA(b, h) + aoff + m * 2048 + k * 1024); } while (0)
#define PG8_LDB(dst, b, h) do { _Pragma("unroll") for (int n = 0; n < 2; ++n) _Pragma("unroll") for (int k = 0; k < 2; ++k) dst[n][k] = *(const PG8_LAS bf16x8*)(lds + PG8_SB(b, h) + boff + n * 2048 + k * 1024); } while (0)
#define PG8_MMA(ai, bj, At, Bt) do { __builtin_amdgcn_s_setprio(1); _Pragma("unroll") for (int m = 0; m < 4; ++m) _Pragma("unroll") for (int n = 0; n < 2; ++n) _Pragma("unroll") for (int k = 0; k < 2; ++k) \
        acc[ai][bj][m][n] = __builtin_amdgcn_mfma_f32_16x16x32_bf16(Bt[n][k], At[m][k], acc[ai][bj][m][n], 0, 0, 0); __builtin_amdgcn_s_setprio(0); } while (0)
#define PG8_WAIT_V(n) asm volatile("s_waitcnt vmcnt(" #n ")" ::: "memory")
#define PG8_WAIT_L(n) asm volatile("s_waitcnt lgkmcnt(" #n ")" ::: "memory")
#define PG8_BAR __builtin_amdgcn_s_barrier()
#define PG8_SCHED __builtin_amdgcn_sched_barrier(0)
    Unit cur, nxt; int ui = 0;
    if (!S.next(0, cur)) return;
    f32x4 acc[2][2][4][2];
#pragma unroll
    for (int a = 0; a < 2; ++a)
#pragma unroll
        for (int b = 0; b < 2; ++b)
#pragma unroll
            for (int m = 0; m < 4; ++m)
#pragma unroll
                for (int n = 0; n < 2; ++n) acc[a][b][m][n] = (f32x4){0.f, 0.f, 0.f, 0.f};
    bf16x8 At[4][2], B0[2][2], B1[2][2];
    const char* cA = (const char*)g.A + (size_t)cur.pm * tstep; const char* cB = (const char*)g.Bt + (size_t)cur.pn * tstep;
    S.a_ready(cur);
    PG8_STAGE(PG8_SB(0, 0), cB, voffB); PG8_STAGE(PG8_SA(0, 0), cA, voffA); PG8_STAGE(PG8_SB(0, 1), cB + hstep, voffB); PG8_STAGE(PG8_SA(0, 1), cA + hstep, voffA);
    if (wr == 1) PG8_BAR;
    PG8_WAIT_V(4); PG8_BAR;
    PG8_STAGE(PG8_SB(1, 0), cB + kstep, voffB); PG8_STAGE(PG8_SA(1, 0), cA + kstep, voffA); PG8_STAGE(PG8_SB(1, 1), cB + hstep + kstep, voffB);
    PG8_WAIT_V(6); PG8_BAR;
    PG8_STAMP();
    for (;;) {
        const bool has_next = S.next(ui + 1, nxt);
        const char* nA = has_next ? (const char*)g.A + (size_t)nxt.pm * tstep : cA; const char* nB = has_next ? (const char*)g.Bt + (size_t)nxt.pn * tstep : cB;
        for (int t = 0; t < nt; t += 2) {
            const bool last = (t == nt - 2);
            const char* a1 = cA + (size_t)(t + 1) * kstep;
            const char* a2 = last ? nA : cA + (size_t)(t + 2) * kstep; const char* b2 = last ? nB : cB + (size_t)(t + 2) * kstep;
            const char* a3 = a2 + kstep; const char* b3 = b2 + kstep;
            if (last && has_next) S.a_ready(nxt);
            PG8_LDB(B0, 0, 0); PG8_SCHED; PG8_LDA(At, 0, 0); PG8_STAGE(PG8_SA(1, 1), a1 + hstep, voffA);
            PG8_WAIT_L(8); PG8_BAR; PG8_WAIT_L(0); PG8_MMA(0, 0, At, B0); PG8_BAR; PG8_SCHED;
            PG8_LDB(B1, 0, 1); PG8_STAGE(PG8_SB(0, 0), b2, voffB);
            PG8_BAR; PG8_WAIT_L(0); PG8_MMA(0, 1, At, B1); PG8_BAR;
            PG8_LDA(At, 0, 1); PG8_STAGE(PG8_SA(0, 0), a2, voffA);
            PG8_BAR; PG8_WAIT_L(0); PG8_MMA(1, 0, At, B0); PG8_BAR; PG8_SCHED;
            PG8_STAGE(PG8_SB(0, 1), b2 + hstep, voffB);
            PG8_WAIT_V(6); PG8_BAR; PG8_MMA(1, 1, At, B1); PG8_BAR;
            PG8_LDB(B0, 1, 0); PG8_SCHED; PG8_LDA(At, 1, 0); PG8_STAGE(PG8_SA(0, 1), a2 + hstep, voffA);
            PG8_WAIT_L(8); PG8_BAR; PG8_WAIT_L(0); PG8_MMA(0, 0, At, B0); PG8_BAR; PG8_SCHED;
            PG8_LDB(B1, 1, 1); PG8_STAGE(PG8_SB(1, 0), b3, voffB);
            PG8_BAR; PG8_WAIT_L(0); PG8_MMA(0, 1, At, B1); PG8_BAR;
            PG8_LDA(At, 1, 1); PG8_STAGE(PG8_SA(1, 0), a3, voffA);
            PG8_BAR; PG8_WAIT_L(0); PG8_MMA(1, 0, At, B0); PG8_BAR; PG8_SCHED;
            PG8_STAGE(PG8_SB(1, 1), b3 + hstep, voffB);
            PG8_WAIT_V(6); PG8_BAR; PG8_MMA(1, 1, At, B1); PG8_BAR;
        }
        PG8_STAMP();
        if constexpr (!Epi::AFTER_DRAIN) { E(acc, cur, wr, wc, fr, fq); S.done(cur); }
        PG8_STAMP();
        if (!has_next) break;
#pragma unroll
        for (int a = 0; a < 2; ++a)
#pragma unroll
            for (int b = 0; b < 2; ++b)
#pragma unroll
                for (int m = 0; m < 4; ++m)
#pragma unroll
                    for (int n = 0; n < 2; ++n) acc[a][b][m][n] = (f32x4){0.f, 0.f, 0.f, 0.f};
        cur = nxt; cA = nA; cB = nB; ++ui;
    }
    PG8_WAIT_V(0);
    if (wr == 0) PG8_BAR;
    PG8_BAR;
    if constexpr (Epi::AFTER_DRAIN) { E.fused(acc, cur, wr, wc, fr, fq, lds, wid, lane); S.done(cur); }
    PG8_STAMP();
    if (STAMP && wid == 0) { stamps[lane] = lane < nts ? (((unsigned long long)(unsigned)ts_hi << 32) | (unsigned)ts_lo) : 0ull;
        if (lane == 62) stamps[62] = rt_entry; if (lane == 63) stamps[63] = (unsigned long long)wall_clock64(); }
#undef PG8_STAMP
#undef PG8_SA
#undef PG8_SB
#undef PG8_STAGE
#undef PG8_LDA
#undef PG8_LDB
#undef PG8_MMA
#undef PG8_WAIT_V
#undef PG8_WAIT_L
#undef PG8_BAR
#undef PG8_SCHED
}
}

namespace pg8 {
struct EpiProj {
    static constexpr bool PERM = true, AFTER_DRAIN = false;
    bf16_t* O; int ldc; int ncols;
    __device__ __forceinline__ void operator()(const f32x4 (&acc)[2][2][4][2], const Unit& u, int wr, int wc, int fr, int fq) const {
        const int row0 = u.pm * BM + wr * 64 + fr; const int col0 = u.pn * BM + wc * 32 + 8 * fq;
#pragma unroll
        for (int ai = 0; ai < 2; ++ai)
#pragma unroll
            for (int m = 0; m < 4; ++m) { bf16_t* rowp = O + (size_t)(row0 + ai * HALF + m * 16) * ldc + col0;
#pragma unroll
                for (int bj = 0; bj < 2; ++bj) { const f32x4 v0 = acc[ai][bj][m][0], v1 = acc[ai][bj][m][1];
                    u32x4 w; w.x = cvt_pk_bf16(v0[0], v0[1]); w.y = cvt_pk_bf16(v0[2], v0[3]); w.z = cvt_pk_bf16(v1[0], v1[1]); w.w = cvt_pk_bf16(v1[2], v1[3]);
                    if (col0 + bj * HALF < ncols) *(u32x4*)(rowp + bj * HALF) = w; } }
    }
};
struct EpiU {
    static constexpr bool PERM = true, AFTER_DRAIN = false;
    void* O; int ldc; int ncols; int f32out;
    __device__ __forceinline__ void operator()(const f32x4 (&acc)[2][2][4][2], const Unit& u, int wr, int wc, int fr, int fq) const {
        const int row0 = u.pm * BM + wr * 64 + fr; const int col0 = u.pn * BM + wc * 32 + 8 * fq;
        if (f32out) {
#pragma unroll
            for (int ai = 0; ai < 2; ++ai)
#pragma unroll
                for (int m = 0; m < 4; ++m) { float* rowp = (float*)O + (size_t)(row0 + ai * HALF + m * 16) * ldc + col0;
#pragma unroll
                    for (int bj = 0; bj < 2; ++bj) { *(f32x4*)(rowp + bj * HALF) = acc[ai][bj][m][0]; *(f32x4*)(rowp + bj * HALF + 4) = acc[ai][bj][m][1]; } }
        } else {
#pragma unroll
            for (int ai = 0; ai < 2; ++ai)
#pragma unroll
                for (int m = 0; m < 4; ++m) { bf16_t* rowp = (bf16_t*)O + (size_t)(row0 + ai * HALF + m * 16) * ldc + col0;
#pragma unroll
                    for (int bj = 0; bj < 2; ++bj) { const f32x4 v0 = acc[ai][bj][m][0], v1 = acc[ai][bj][m][1];
                        u32x4 w; w.x = cvt_pk_bf16(v0[0], v0[1]); w.y = cvt_pk_bf16(v0[2], v0[3]); w.z = cvt_pk_bf16(v1[0], v1[1]); w.w = cvt_pk_bf16(v1[2], v1[3]);
                        if (col0 + bj * HALF < ncols) *(u32x4*)(rowp + bj * HALF) = w; } }
        }
    }
};
}

#define XB_TMO      128
#define XB_XCNT(j)  (256  + 64 * (j))
#define XB_XSUB(j)  (1280 + 64 * (j))
#define XB_XGEN(j)  (2304 + 64 * (j))
#define XB_TOP      3328
#define XB_TOPGEN   3392
#define XCD_BAR_WORDS 3456
#define XB_SPIN_CAP (1u << 18)
#define LAS __attribute__((address_space(3)))

__device__ __forceinline__ unsigned xb_ld(unsigned* p)              { return __hip_atomic_load(p, __ATOMIC_RELAXED, __HIP_MEMORY_SCOPE_AGENT); }
__device__ __forceinline__ unsigned xb_add(unsigned* p, unsigned v) { return __hip_atomic_fetch_add(p, v, __ATOMIC_RELAXED, __HIP_MEMORY_SCOPE_AGENT); }
__device__ __forceinline__ unsigned xb_xcc_id() { return (unsigned)__builtin_amdgcn_s_getreg((3 << 11) | 20) & 0xFu; }
#define XB_SPIN(cond, bar) do { unsigned _sp = 0; while (cond) { __builtin_amdgcn_s_sleep(1); \
    if ((++_sp & 255u) == 0u) { if (xb_ld(&(bar)[XB_TMO])) break; if (_sp > XB_SPIN_CAP) { atomicAdd(&(bar)[XB_TMO], 1u); break; } } } } while (0)

struct XcdBarrier {
    unsigned* bar; unsigned x;
    volatile LAS unsigned* st;
};

__device__ __forceinline__ XcdBarrier xcd_barrier_post(unsigned* bar, volatile LAS unsigned* st) {
    XcdBarrier b; b.bar = bar; b.x = xb_xcc_id(); b.st = st;
    if (threadIdx.x == 0) (void)xb_add(&bar[XB_XCNT(b.x)], 1u);
    return b;
}
__device__ __forceinline__ void xcd_barrier_complete(unsigned* bar, unsigned x, unsigned& nloc, unsigned& nx) {
    const unsigned G = gridDim.x * gridDim.y * gridDim.z;
    unsigned sum, cnt, mine, sp = 0u;
    for (;;) {
        sum = 0u; cnt = 0u; mine = 0u;
#pragma unroll
        for (unsigned j = 0; j < 16; ++j) { const unsigned c = xb_ld(&bar[XB_XCNT(j)]); sum += c; cnt += (c > 0u) ? 1u : 0u; mine = (j == x) ? c : mine; }
        if (sum == G) break;
        __builtin_amdgcn_s_sleep(1);
        if ((++sp & 255u) == 0u) { if (xb_ld(&bar[XB_TMO])) break; if (sp > XB_SPIN_CAP) { atomicAdd(&bar[XB_TMO], 1u); break; } }
    }
    nloc = mine > 0u ? mine : 1u; nx = cnt > 0u ? cnt : 1u;
}

__device__ __forceinline__ void xcd_barrier(const XcdBarrier& b) {
    asm volatile("s_waitcnt vmcnt(0)" ::: "memory");
    __syncthreads();
    if (threadIdx.x == 0) {
        unsigned* bar = b.bar;
        __builtin_amdgcn_s_waitcnt(0);
        unsigned nloc = b.st[0], nx = b.st[1];
        if (nloc == 0u) { xcd_barrier_complete(bar, b.x, nloc, nx); b.st[0] = nloc; b.st[1] = nx; }
        const unsigned old = xb_add(&bar[XB_XSUB(b.x)], 1u);
        const unsigned gen = old / nloc;
        if (old + 1u == (gen + 1u) * nloc) {
            __builtin_amdgcn_fence(__ATOMIC_RELEASE, "agent");
            asm volatile("s_waitcnt vmcnt(0)" ::: "memory");
            const unsigned og = xb_add(&bar[XB_TOP], 1u);
            const unsigned tg = og / nx;
            if (og + 1u == (tg + 1u) * nx) xb_add(&bar[XB_TOPGEN], 1u);
            else XB_SPIN(xb_ld(&bar[XB_TOPGEN]) == tg, bar);
            __builtin_amdgcn_fence(__ATOMIC_ACQUIRE, "agent");
            xb_add(&bar[XB_XGEN(b.x)], 1u);
            asm volatile("s_waitcnt vmcnt(0)" ::: "memory");
        } else {
            XB_SPIN(xb_ld(&bar[XB_XGEN(b.x)]) == gen, bar);
            __builtin_amdgcn_fence(__ATOMIC_ACQUIRE, "agent");
            asm volatile("s_waitcnt vmcnt(0)" ::: "memory");
        }
    }
    __syncthreads();
}

__device__ void phase_mod_item(const Params& p, int it, unsigned char* smem) {
  float* red = (float*)smem;
  const int tid = opaque_tid(), tx = tid & 31, ty = tid >> 5;
  float* mod = (float*)(p.ws + OFF_MOD);
  it = opq(it);
  {
    int l = it / 96;
    int j = (it % 96) * 32 + tx;
    const float* W = p.ada_w + (size_t)l * 1024 * 3072;
    float* cs = red + 256;
#pragma unroll
    for (int i = 0; i < 4; ++i) cs[tid + 256 * i] = silu(p.c[tid + 256 * i]);
    __syncthreads();
    float acc = 0.f;
#pragma unroll 1
    for (int i0 = 0; i0 < 128; i0 += 16) {
      float wv[16];
#pragma unroll
      for (int i = 0; i < 16; ++i) wv[i] = W[(size_t)(ty * 128 + i0 + i) * 3072 + j];
#pragma unroll
      for (int i = 0; i < 16; ++i) acc += cs[ty * 128 + i0 + i] * wv[i];
    }
    red[ty * 32 + tx] = acc;
    __syncthreads();
    if (ty == 0) {
      float s = 0.f;
      for (int g = 0; g < 8; ++g) s += red[g * 32 + tx];
      mod[l * 3072 + j] = s + p.ada_b[l * 3072 + j];
    }
    __syncthreads();
  }
}

__device__ __forceinline__ float wall_src(const Params& p, int l, int k, int n) {
  size_t lk = (size_t)l * 1024 + k;
  if (n < 3072) return p.w_in[lk * 3072 + n];
  if (n < 3136) return (1.f - p.mu_w[lk]) * p.w1[lk * 64 + (n - 3072)];
  if (n < 3200) return p.mu_w[lk] * p.w1[lk * 64 + (n - 3136)];
  if (n < 3264) return (1.f - p.mu_a[lk]) * p.a1[lk * 64 + (n - 3200)];
  if (n < 3328) return p.mu_a[lk] * p.a1[lk * 64 + (n - 3264)];
  if (n < 3344) return p.gk1[lk * 16 + (n - 3328)];
  return 0.f;
}

__device__ void phase_wconv_item(const Params& p, int it, unsigned char* smem) {
  float* tile = (float*)smem;
  const int tid = opaque_tid();
  u16* WALL = (u16*)(p.ws + OFF_WALL);
  u16* WOUT = (u16*)(p.ws + OFF_WOUT);
  it = opq(it);
  {
    bool isout = it >= 3456;
    int l, nt, kt;
    if (!isout) { l = it / 864; int r = it % 864; nt = r >> 4; kt = r & 15; }
    else { int r = it - 3456; l = r >> 8; r &= 255; nt = r >> 4; kt = r & 15; }
    int tx = tid & 63, ty = tid >> 6;
#pragma unroll
    for (int i = 0; i < 16; ++i) {
      int kl = ty + 4 * i;
      int k = kt * 64 + kl, n = nt * 64 + tx;
      float v = isout ? p.w_out[((size_t)l * 1024 + k) * 1024 + n] : wall_src(p, l, k, n);
      tile[kl * 65 + tx] = v;
    }
    __syncthreads();
    int nl = tid >> 2, kq = tid & 3;
    unsigned w[8];
#pragma unroll
    for (int j = 0; j < 8; ++j) w[j] = pack2(tile[(kq * 16 + 2 * j) * 65 + nl], tile[(kq * 16 + 2 * j + 1) * 65 + nl]);
    u16* dst = (isout ? WOUT + ((size_t)l * 1024 + nt * 64 + nl) * 1024 : WALL + ((size_t)l * NALL + nt * 64 + nl) * 1024) + kt * 64 + kq * 16;
    ((uint4*)dst)[0] = make_uint4(w[0], w[1], w[2], w[3]);
    ((uint4*)dst)[1] = make_uint4(w[4], w[5], w[6], w[7]);
    __syncthreads();
  }
}

__device__ void phase_w2t_item(const Params& p, int it) {
  it = opq(it);
  const int c = opaque_tid();
  const int l = it >> 1, which = it & 1;
  const float* src = (which ? p.a2 : p.w2) + (size_t)l * 64 * 256 + c;
  u16* dst = (u16*)(p.ws + (which ? OFF_A2T : OFF_W2T)) + ((size_t)l * 256 + c) * 64;
#pragma unroll
  for (int j8 = 0; j8 < 8; ++j8) {
    float f[8];
#pragma unroll
    for (int q = 0; q < 8; ++q) f[q] = src[(j8 * 8 + q) * 256];
    *(uint4*)(dst + j8 * 8) = make_uint4(pack2(f[0], f[1]), pack2(f[2], f[3]), pack2(f[4], f[5]), pack2(f[6], f[7]));
  }
}

__device__ __forceinline__ void write_h(const Params& p, int l, int row, int lane, const float4* v, float ss) {
  const float* mod = (const float*)(p.ws + OFF_MOD) + l * 3072;
  u16* H = (u16*)(p.ws + OFF_H);
  float rs = rsqrtf(ss * (1.f / 1024.f) + 1e-6f);
#pragma unroll
  for (int i = 0; i < 4; ++i) {
    int col = (lane + 64 * i) * 4;
    float4 g = *(const float4*)(p.norm_pre + l * 1024 + col);
    float4 sh = *(const float4*)(mod + col);
    float4 sc = *(const float4*)(mod + 1024 + col);
    float h0 = v[i].x * rs * g.x * (1.f + sc.x) + sh.x;
    float h1 = v[i].y * rs * g.y * (1.f + sc.y) + sh.y;
    float h2 = v[i].z * rs * g.z * (1.f + sc.z) + sh.z;
    float h3 = v[i].w * rs * g.w * (1.f + sc.w) + sh.w;
    *(uint2*)(H + (size_t)row * 1024 + col) = make_uint2(pack2(h0, h1), pack2(h2, h3));
  }
}

__device__ void phase_h0(const Params& p) {
  const int tid = opaque_tid512(); const int wave = tid >> 6, lane = tid & 63;
  for (int row = blockIdx.x * 8 + wave; row < T_; row += gridDim.x * 8) {
    const float4* xr = (const float4*)(p.x + (size_t)row * 1024);
    float4 v[4];
    float ss = 0.f;
#pragma unroll
    for (int i = 0; i < 4; ++i) {
      v[i] = xr[lane + 64 * i];
      ss += v[i].x * v[i].x + v[i].y * v[i].y + v[i].z * v[i].z + v[i].w * v[i].w;
    }
    ss = wave_sum(ss);
    write_h(p, 0, row, lane, v, ss);
  }
}

__device__ void phase_post(const Params& p, int l) {
  l = opq(l);
  const int tid = opaque_tid512(); const int wave = tid >> 6, lane = tid & 63;
  const u16* Y = (const u16*)(p.ws + OFF_PROJ);
  const float* mod = (const float*)(p.ws + OFF_MOD) + l * 3072;
  const float* xold = (l == 0) ? p.x : p.out;
  for (int row = blockIdx.x * 8 + wave; row < T_; row += gridDim.x * 8) {
    const uint2* yr = (const uint2*)(Y + (size_t)row * 1024);
    const float4* xr = (const float4*)(xold + (size_t)row * 1024);
    float4 y[4], v[4];
    float ss = 0.f;
#pragma unroll
    for (int i = 0; i < 4; ++i) {
      const uint2 u = yr[lane + 64 * i];
      y[i] = make_float4(bflo(u.x), bfhi(u.x), bflo(u.y), bfhi(u.y));
      v[i] = xr[lane + 64 * i];
      ss += y[i].x * y[i].x + y[i].y * y[i].y + y[i].z * y[i].z + y[i].w * y[i].w;
    }
    ss = wave_sum(ss);
    float rs = rsqrtf(ss * (1.f / 1024.f) + 1e-6f);
    float s2 = 0.f;
#pragma unroll
    for (int i = 0; i < 4; ++i) {
      int col = (lane + 64 * i) * 4;
      float4 g = *(const float4*)(p.norm_post + l * 1024 + col);
      float4 gt = *(const float4*)(mod + 2048 + col);
      v[i].x += gt.x * (y[i].x * rs * g.x);
      v[i].y += gt.y * (y[i].y * rs * g.y);
      v[i].z += gt.z * (y[i].z * rs * g.z);
      v[i].w += gt.w * (y[i].w * rs * g.w);
      *(float4*)(p.out + (size_t)row * 1024 + col) = v[i];
      s2 += v[i].x * v[i].x + v[i].y * v[i].y + v[i].z * v[i].z + v[i].w * v[i].w;
    }
    if (l < 3) {
      s2 = wave_sum(s2);
      write_h(p, l + 1, row, lane, v, s2);
    }
  }
}

__device__ void attn_item(const Params& p, int l, int item, unsigned char* smem) {
  l = opq(l); item = opq(item);
  u16* Vt = (u16*)smem;
  const u16* PROJ = (const u16*)(p.ws + OFF_PROJ);
  u16* MIX = (u16*)(p.ws + OFF_MIX);
  const int tid = opaque_tid(), w = tid >> 6, lane = tid & 63, l31 = lane & 31, hf = lane >> 5;
  const int qb = item >> 3, head = item & 7, kvh = head >> 2;
  const int kpos0 = (qb - 1) * 128;
  {
    int kp = kpos0 + tid;
    if (kp < 0) kp = 0;
    const uint4* src = (const uint4*)(PROJ + (size_t)kp * NALL + 640 + kvh * 64);
#pragma unroll
    for (int c8 = 0; c8 < 8; ++c8) {
      uint4 v = src[c8];
      int d = c8 * 8;
      Vt[(d + 0) * 264 + tid] = (u16)(v.x & 0xffff);
      Vt[(d + 1) * 264 + tid] = (u16)(v.x >> 16);
      Vt[(d + 2) * 264 + tid] = (u16)(v.y & 0xffff);
      Vt[(d + 3) * 264 + tid] = (u16)(v.y >> 16);
      Vt[(d + 4) * 264 + tid] = (u16)(v.z & 0xffff);
      Vt[(d + 5) * 264 + tid] = (u16)(v.z >> 16);
      Vt[(d + 6) * 264 + tid] = (u16)(v.w & 0xffff);
      Vt[(d + 7) * 264 + tid] = (u16)(v.w >> 16);
    }
  }
  const int tq = qb * 128 + 32 * w + l31;
  bf16x8 qf[4], kc[4];
  {
    const u16* qp = PROJ + (size_t)tq * NALL + head * 64 + 8 * hf;
#pragma unroll
    for (int s = 0; s < 4; ++s) qf[s] = *(const bf16x8*)(qp + 16 * s);
    int kp = kpos0 + 32 * w + l31;
    if (kp < 0) kp = 0;
    const u16* kptr = PROJ + (size_t)kp * NALL + 512 + kvh * 64 + 8 * hf;
#pragma unroll
    for (int s = 0; s < 4; ++s) kc[s] = *(const bf16x8*)(kptr + 16 * s);
  }
  __syncthreads();
  const float slope = exp2f(-(float)(head + 1));
  const float sink = p.sinks[l * 8 + head];
  const int rq = 32 * w + l31;
  float mrun = -1e30f, lsum = 0.f;
  f32x16 o0, o1;
#pragma unroll
  for (int r = 0; r < 16; ++r) { o0[r] = 0.f; o1[r] = 0.f; }
#pragma unroll 1
  for (int i = 0; i < 5; ++i) {
    bf16x8 kn[4];
    {
      const int in_ = (i < 4) ? i + 1 : 4;
      int kp = kpos0 + 32 * w + 32 * in_ + l31;
      if (kp < 0) kp = 0;
      const u16* kptr = PROJ + (size_t)kp * NALL + 512 + kvh * 64 + 8 * hf;
#pragma unroll
      for (int s = 0; s < 4; ++s) kn[s] = *(const bf16x8*)(kptr + 16 * s);
    }
    f32x16 a;
#pragma unroll
    for (int r = 0; r < 16; ++r) a[r] = 0.f;
#pragma unroll
    for (int s = 0; s < 4; ++s) a = __builtin_amdgcn_mfma_f32_32x32x16_bf16(kc[s], qf[s], a, 0, 0, 0);
#pragma unroll
    for (int s = 0; s < 4; ++s) kc[s] = kn[s];
    float tmax = -1e30f;
#pragma unroll
    for (int r = 0; r < 16; ++r) {
      int kj = 32 * w + 32 * i + (r & 3) + 8 * (r >> 2) + 4 * hf;
      int dist = 128 + rq - kj;
      bool valid = (dist >= 0) && (dist < 128) && (kpos0 + kj >= 0);
      float sv = a[r] * 0.125f - slope * (float)dist;
      sv = valid ? sv : -1e30f;
      a[r] = sv;
      tmax = fmaxf(tmax, sv);
    }
    tmax = fmaxf(tmax, __shfl_xor(tmax, 32));
    const float mnew = fmaxf(mrun, tmax);
    const float alpha = __expf(mrun - mnew);
    float psum = 0.f;
#pragma unroll
    for (int r = 0; r < 16; ++r) {
      float e = (a[r] > -1e29f) ? __expf(a[r] - mnew) : 0.f;
      a[r] = e;
      psum += e;
    }
    lsum = lsum * alpha + psum;
    mrun = mnew;
#pragma unroll
    for (int r = 0; r < 16; ++r) { o0[r] *= alpha; o1[r] *= alpha; }
#pragma unroll
    for (int u = 0; u < 2; ++u) {
      bf16x8 pf;
#pragma unroll
      for (int j = 0; j < 8; ++j) pf[j] = (short)f2bf(a[8 * u + j]);
      const int kb = 32 * w + 32 * i + 16 * u + 4 * hf;
      const u16* v0 = Vt + l31 * 264 + kb;
      const u16* v1 = Vt + (32 + l31) * 264 + kb;
      uint2 a0 = *(const uint2*)(v0), a1 = *(const uint2*)(v0 + 8);
      uint2 b0 = *(const uint2*)(v1), b1 = *(const uint2*)(v1 + 8);
      uint4 A0 = make_uint4(a0.x, a0.y, a1.x, a1.y), A1 = make_uint4(b0.x, b0.y, b1.x, b1.y);
      o0 = __builtin_amdgcn_mfma_f32_32x32x16_bf16(__builtin_bit_cast(bf16x8, A0), pf, o0, 0, 0, 0);
      o1 = __builtin_amdgcn_mfma_f32_32x32x16_bf16(__builtin_bit_cast(bf16x8, A1), pf, o1, 0, 0, 0);
    }
  }
  {
    const float mf = fmaxf(mrun, sink);
    const float scl = __expf(mrun - mf);
    const float ltot = (lsum + __shfl_xor(lsum, 32)) * scl + __expf(sink - mf);
    const float fin = scl / ltot;
#pragma unroll
    for (int r = 0; r < 16; ++r) { o0[r] *= fin; o1[r] *= fin; }
  }
  const u16* gp = PROJ + (size_t)tq * NALL + 768 + head * 64;
  u16* op = MIX + (size_t)tq * 1024 + head * 64;
#pragma unroll
  for (int g = 0; g < 4; ++g) {
    int d0 = 8 * g + 4 * hf;
    uint2 gg = *(const uint2*)(gp + d0);
    float r0 = o0[4 * g + 0] * silu(bflo(gg.x)), r1 = o0[4 * g + 1] * silu(bfhi(gg.x));
    float r2 = o0[4 * g + 2] * silu(bflo(gg.y)), r3 = o0[4 * g + 3] * silu(bfhi(gg.y));
    *(uint2*)(op + d0) = make_uint2(pack2(r0, r1), pack2(r2, r3));
    uint2 g2 = *(const uint2*)(gp + 32 + d0);
    r0 = o1[4 * g + 0] * silu(bflo(g2.x)); r1 = o1[4 * g + 1] * silu(bfhi(g2.x));
    r2 = o1[4 * g + 2] * silu(bflo(g2.y)); r3 = o1[4 * g + 3] * silu(bfhi(g2.y));
    *(uint2*)(op + 32 + d0) = make_uint2(pack2(r0, r1), pack2(r2, r3));
  }
  __syncthreads();
}

__device__ void rwkv_prep_item(const Params& p, int l, int item, unsigned char* smem) {
  l = opq(l); item = opq(item);
  u16* lwb = (u16*)smem;
  u16* lab = lwb + 16 * 72;
  const u16* PROJ = (const u16*)(p.ws + OFF_PROJ);
  const int tid = opaque_tid(), head = tid >> 6, lane = tid & 63, fr = lane & 15, fq = lane >> 4;
  const int t0 = item * 16;
  {
    const int which = tid >> 7, tt = (tid >> 3) & 15, j0 = (tid & 7) * 8;
    const int t = t0 + tt;
    const u16* pr = PROJ + (size_t)t * NALL;
    const u16* pq = (t > 0) ? pr - NALL : pr;
    const float pm = (t > 0) ? 1.f : 0.f;
    const uint4 cu = *(const uint4*)(pr + (which ? 3200 : 3072) + j0);
    const uint4 pu = *(const uint4*)(pq + (which ? 3264 : 3136) + j0);
    float sv[8];
    sv[0] = bflo(cu.x) + pm * bflo(pu.x); sv[1] = bfhi(cu.x) + pm * bfhi(pu.x);
    sv[2] = bflo(cu.y) + pm * bflo(pu.y); sv[3] = bfhi(cu.y) + pm * bfhi(pu.y);
    sv[4] = bflo(cu.z) + pm * bflo(pu.z); sv[5] = bfhi(cu.z) + pm * bfhi(pu.z);
    sv[6] = bflo(cu.w) + pm * bflo(pu.w); sv[7] = bfhi(cu.w) + pm * bfhi(pu.w);
    if (!which) {
#pragma unroll
      for (int q = 0; q < 8; ++q) sv[q] = tanh_fast(sv[q]);
    }
    *(uint4*)((which ? lab : lwb) + tt * 72 + j0) = make_uint4(pack2(sv[0], sv[1]), pack2(sv[2], sv[3]), pack2(sv[4], sv[5]), pack2(sv[6], sv[7]));
  }
  __syncthreads();
  f32x4 accw[4], acca[4];
#pragma unroll
  for (int nt = 0; nt < 4; ++nt) { accw[nt] = (f32x4){0.f, 0.f, 0.f, 0.f}; acca[nt] = (f32x4){0.f, 0.f, 0.f, 0.f}; }
  {
    const u16* W2T = (const u16*)(p.ws + OFF_W2T) + ((size_t)l * 256 + head * 64 + fr * 4) * 64 + fq * 8;
    const u16* A2T = (const u16*)(p.ws + OFF_A2T) + ((size_t)l * 256 + head * 64 + fr * 4) * 64 + fq * 8;
#pragma unroll
    for (int ks = 0; ks < 2; ++ks) {
      const bf16x8 aw = *(const bf16x8*)(lwb + fr * 72 + ks * 32 + fq * 8);
      const bf16x8 aa = *(const bf16x8*)(lab + fr * 72 + ks * 32 + fq * 8);
#pragma unroll
      for (int nt = 0; nt < 4; ++nt) {
        const bf16x8 bw = *(const bf16x8*)(W2T + nt * 64 + ks * 32);
        const bf16x8 ba = *(const bf16x8*)(A2T + nt * 64 + ks * 32);
        accw[nt] = __builtin_amdgcn_mfma_f32_16x16x32_bf16(aw, bw, accw[nt], 0, 0, 0);
        acca[nt] = __builtin_amdgcn_mfma_f32_16x16x32_bf16(aa, ba, acca[nt], 0, 0, 0);
      }
    }
  }
  const int c0 = head * 64 + fr * 4;
  const float4 mur = *(const float4*)(p.mu_rkv + l * 768 + c0), muk = *(const float4*)(p.mu_rkv + l * 768 + 256 + c0), muv = *(const float4*)(p.mu_rkv + l * 768 + 512 + c0);
  const float4 w0 = *(const float4*)(p.w0 + l * 256 + c0), a0 = *(const float4*)(p.a0 + l * 256 + c0);
  const float4 kkw = *(const float4*)(p.k_k + l * 256 + c0), kaw = *(const float4*)(p.k_a + l * 256 + c0), rkw = *(const float4*)(p.r_k + l * 256 + c0);
  float* RWW = (float*)(p.ws + OFF_RWW);
  float* RWKK = (float*)(p.ws + OFF_RWKK);
  u16* RB = (u16*)(p.ws + OFF_RWB);
  float* BON = (float*)(p.ws + OFF_BONUS);
#define F4E(v, i) ((i) == 0 ? v.x : (i) == 1 ? v.y : (i) == 2 ? v.z : v.w)
#pragma unroll
  for (int rg = 0; rg < 4; ++rg) {
    const int t = t0 + fq * 4 + rg;
    const u16* pr = PROJ + (size_t)t * NALL;
    const u16* pp = (t > 0) ? pr - NALL : pr;
    const float pm = (t > 0) ? 1.f : 0.f;
    const uint2 rcu = *(const uint2*)(pr + 1280 + c0), kcu = *(const uint2*)(pr + 1536 + c0), vcu = *(const uint2*)(pr + 1792 + c0);
    const uint2 rpu = *(const uint2*)(pp + 1280 + c0), kpu = *(const uint2*)(pp + 1536 + c0), vpu = *(const uint2*)(pp + 1792 + c0);
    const float rc[4] = {bflo(rcu.x), bfhi(rcu.x), bflo(rcu.y), bfhi(rcu.y)}, kc[4] = {bflo(kcu.x), bfhi(kcu.x), bflo(kcu.y), bfhi(kcu.y)};
    const float vc[4] = {bflo(vcu.x), bfhi(vcu.x), bflo(vcu.y), bfhi(vcu.y)};
    const float rp[4] = {bflo(rpu.x), bfhi(rpu.x), bflo(rpu.y), bfhi(rpu.y)}, kp[4] = {bflo(kpu.x), bfhi(kpu.x), bflo(kpu.y), bfhi(kpu.y)};
    const float vp[4] = {bflo(vpu.x), bfhi(vpu.x), bflo(vpu.y), bfhi(vpu.y)};
    float kkc[4], av[4], dec[4], rr[4], km[4], vv[4];
    float n2 = 0.f, bonus = 0.f;
#pragma unroll
    for (int nt = 0; nt < 4; ++nt) {
      const float r = rc[nt] + (pm * rp[nt] - rc[nt]) * F4E(mur, nt), k = kc[nt] + (pm * kp[nt] - kc[nt]) * F4E(muk, nt), v = vc[nt] + (pm * vp[nt] - vc[nt]) * F4E(muv, nt);
      const float wpre = F4E(w0, nt) + accw[nt][rg];
      const float wl = -softplusf_(-wpre) - 0.5f;
      dec[nt] = __expf(-__expf(wl));
      const float a = sigmoidf_(F4E(a0, nt) + acca[nt][rg]);
      const float kc2 = k * F4E(kkw, nt);
      const float kmod = k * (1.f + (a - 1.f) * F4E(kaw, nt));
      kkc[nt] = kc2; av[nt] = a; rr[nt] = r; km[nt] = kmod; vv[nt] = v;
      n2 += kc2 * kc2;
      bonus += r * kmod * F4E(rkw, nt);
    }
    n2 = row16_allsum(n2);
    bonus = row16_allsum(bonus);
    const float inv = __builtin_amdgcn_rsqf(fmaxf(n2, 1e-24f));
    const size_t o = (size_t)t * 256 + c0;
    *(float4*)(RWW + o) = make_float4(dec[0], dec[1], dec[2], dec[3]);
    *(float4*)(RWKK + o) = make_float4(kkc[0] * inv, kkc[1] * inv, kkc[2] * inv, kkc[3] * inv);
    *(uint2*)(RB + o) = make_uint2(pack2(rr[0], rr[1]), pack2(rr[2], rr[3]));
    *(uint2*)(RB + (size_t)T_ * 256 + o) = make_uint2(pack2(km[0], km[1]), pack2(km[2], km[3]));
    *(uint2*)(RB + (size_t)2 * T_ * 256 + o) = make_uint2(pack2(vv[0], vv[1]), pack2(vv[2], vv[3]));
    *(uint2*)(RB + (size_t)3 * T_ * 256 + o) = make_uint2(pack2(kkc[0] * inv * av[0], kkc[1] * inv * av[1]), pack2(kkc[2] * inv * av[2], kkc[3] * inv * av[3]));
    if (fr == 0) BON[t * 4 + head] = bonus;
  }
  __syncthreads();
}

__device__ __forceinline__ void gla_b(const Params& p, int l, int chunk, int head, float* tot, float* bl) {
  const u16* PROJ = (const u16*)(p.ws + OFF_PROJ);
  const int tid = opaque_tid(), d = tid & 31, ig = tid >> 5;
  float g2[16];
#pragma unroll
  for (int m = 0; m < 16; ++m) g2[m] = p.gk2[(size_t)l * 16 * 128 + m * 128 + head * 32 + d];
  const float bias = p.gk_b[l * 128 + head * 32 + d];
  float run = 0.f;
#pragma unroll
  for (int ii = 0; ii < 8; ++ii) {
    int t = chunk * 64 + ig * 8 + ii;
    const uint4* lp = (const uint4*)(PROJ + (size_t)t * NALL + 3328);
    uint4 u0 = lp[0], u1 = lp[1];
    float z = bias;
    z += bflo(u0.x) * g2[0] + bfhi(u0.x) * g2[1] + bflo(u0.y) * g2[2] + bfhi(u0.y) * g2[3];
    z += bflo(u0.z) * g2[4] + bfhi(u0.z) * g2[5] + bflo(u0.w) * g2[6] + bfhi(u0.w) * g2[7];
    z += bflo(u1.x) * g2[8] + bfhi(u1.x) * g2[9] + bflo(u1.y) * g2[10] + bfhi(u1.y) * g2[11];
    z += bflo(u1.z) * g2[12] + bfhi(u1.z) * g2[13] + bflo(u1.w) * g2[14] + bfhi(u1.w) * g2[15];
    float g = (fminf(z, 0.f) - __logf(1.f + __expf(-fabsf(z)))) * (1.f / 16.f);
    run += g;
    bl[ii] = run;
  }
  tot[ig * 32 + d] = run;
  __syncthreads();
  float off = 0.f;
#pragma unroll
  for (int g = 0; g < 8; ++g) off += (g < ig) ? tot[g * 32 + d] : 0.f;
#pragma unroll
  for (int ii = 0; ii < 8; ++ii) bl[ii] += off;
}

__device__ void gla_local_item(const Params& p, int l, int item, unsigned char* smem) {
  l = opq(l); item = opq(item);
  float* tot = (float*)smem;
  float* Kp = tot + 256;
  float* Vs = Kp + 2048;
  const u16* PROJ = (const u16*)(p.ws + OFF_PROJ);
  const int tid = opaque_tid(), d = tid & 31, ig = tid >> 5;
  const int chunk = item >> 2, head = item & 3;
  float bl[8];
  gla_b(p, l, chunk, head, tot, bl);
  float blast = 0.f;
#pragma unroll
  for (int g = 0; g < 8; ++g) blast += tot[g * 32 + d];
#pragma unroll
  for (int ii = 0; ii < 8; ++ii) {
    int i = ig * 8 + ii;
    int t = chunk * 64 + i;
    float k = bf2f(PROJ[(size_t)t * NALL + 2432 + head * 32 + d]);
    Kp[i * 32 + d] = k * __expf(blast - bl[ii]);
  }
#pragma unroll
  for (int r = 0; r < 16; ++r) {
    int idx = tid + 256 * r;
    int i = idx >> 6, v = idx & 63;
    Vs[idx] = bf2f(PROJ[(size_t)(chunk * 64 + i) * NALL + 2560 + head * 64 + v]);
  }
  __syncthreads();
  const int v = tid & 63, dg = tid >> 6;
  float acc[8];
#pragma unroll
  for (int q = 0; q < 8; ++q) acc[q] = 0.f;
  for (int i = 0; i < 64; ++i) {
    float vv = Vs[i * 64 + v];
    float4 k0 = *(const float4*)(Kp + i * 32 + dg * 8), k1 = *(const float4*)(Kp + i * 32 + dg * 8 + 4);
    acc[0] += k0.x * vv; acc[1] += k0.y * vv; acc[2] += k0.z * vv; acc[3] += k0.w * vv;
    acc[4] += k1.x * vv; acc[5] += k1.y * vv; acc[6] += k1.z * vv; acc[7] += k1.w * vv;
  }
  float* GS = (float*)(p.ws + OFF_GLAS);
  float* GD = (float*)(p.ws + OFF_GLAD);
#pragma unroll
  for (int q = 0; q < 8; ++q) GS[((size_t)(chunk * 4 + head) * 32 + dg * 8 + q) * 64 + v] = acc[q];
  if (tid < 32) GD[(chunk * 4 + head) * 32 + tid] = __expf(blast);
  __syncthreads();
}

__device__ void gla_state_block(const Params& p, int eb, unsigned char* dsm_) {
  float* comp = (float*)dsm_;
  float* GS = (float*)(p.ws + OFF_GLAS);
  const float* GD = (const float*)(p.ws + OFF_GLAD);
  eb = opq(eb);
  const int tid = opaque_tid512();
  const int ei = tid & 31, g = tid >> 5;
  const int e = eb * 32 + ei;
  const int head = e >> 11, d = (e >> 6) & 31, v = e & 63;
  float ds[16], dc[16];
#pragma unroll
  for (int i = 0; i < 16; ++i) {
    const int c = g * 16 + i;
    ds[i] = GS[((size_t)(c * 4 + head) * 32 + d) * 64 + v];
    dc[i] = GD[(c * 4 + head) * 32 + d];
  }
  float S = 0.f, P = 1.f;
#pragma unroll
  for (int i = 0; i < 16; ++i) { S = dc[i] * S + ds[i]; P *= dc[i]; }
  comp[(g * 32 + ei) * 2] = P;
  comp[(g * 32 + ei) * 2 + 1] = S;
  __syncthreads();
  float G = 0.f;
  for (int gg = 0; gg < g; ++gg) G = comp[(gg * 32 + ei) * 2] * G + comp[(gg * 32 + ei) * 2 + 1];
#pragma unroll
  for (int i = 0; i < 16; ++i) {
    const int c = g * 16 + i;
    GS[((size_t)(c * 4 + head) * 32 + d) * 64 + v] = G;
    G = dc[i] * G + ds[i];
  }
  __syncthreads();
}

__device__ void gla_out_item(const Params& p, int l, int item, unsigned char* smem) {
  l = opq(l); item = opq(item);
  float* tot = (float*)smem;
  float* qt = tot + 256;
  float* kt = qt + 2304;
  float* Vs = kt + 2304;
  float* Am = Vs + 4096;
  float* Ss = Am + 4352;
  const u16* PROJ = (const u16*)(p.ws + OFF_PROJ);
  u16* MIX = (u16*)(p.ws + OFF_MIX);
  const float* GS = (const float*)(p.ws + OFF_GLAS);
  const int tid = opaque_tid();
  const int chunk = item >> 2, head = item & 3;
  {
    const int d = tid & 31, ig = tid >> 5;
    float bl[8];
    gla_b(p, l, chunk, head, tot, bl);
#pragma unroll
    for (int ii = 0; ii < 8; ++ii) {
      int i = ig * 8 + ii;
      int t = chunk * 64 + i;
      float q = bf2f(PROJ[(size_t)t * NALL + 2304 + head * 32 + d]);
      float k = bf2f(PROJ[(size_t)t * NALL + 2432 + head * 32 + d]);
      qt[i * 36 + d] = q * 0.17677669529663687f * __expf(bl[ii]);
      kt[i * 36 + d] = k * __expf(-bl[ii]);
    }
  }
#pragma unroll
  for (int r = 0; r < 16; ++r) {
    int idx = tid + 256 * r;
    int i = idx >> 6, v = idx & 63;
    Vs[idx] = bf2f(PROJ[(size_t)(chunk * 64 + i) * NALL + 2560 + head * 64 + v]);
  }
#pragma unroll
  for (int r = 0; r < 8; ++r) {
    int idx = tid + 256 * r;
    Ss[idx] = GS[(size_t)(chunk * 4 + head) * 2048 + idx];
  }
  __syncthreads();
  const int j = tid & 63, ig = tid >> 6;
  {
    float acc[16];
#pragma unroll
    for (int ii = 0; ii < 16; ++ii) acc[ii] = 0.f;
#pragma unroll 2
    for (int d4 = 0; d4 < 8; ++d4) {
      const float4 kv = *(const float4*)(kt + j * 36 + d4 * 4);
#pragma unroll
      for (int ii = 0; ii < 16; ++ii) {
        const float4 qv = *(const float4*)(qt + (ig * 16 + ii) * 36 + d4 * 4);
        acc[ii] += qv.x * kv.x + qv.y * kv.y + qv.z * kv.z + qv.w * kv.w;
      }
    }
#pragma unroll
    for (int ii = 0; ii < 16; ++ii) {
      int i = ig * 16 + ii;
      Am[i * 68 + j] = (j <= i) ? acc[ii] : 0.f;
    }
  }
  __syncthreads();
  {
    const int v = j;
    float acc[16];
#pragma unroll
    for (int ii = 0; ii < 16; ++ii) acc[ii] = 0.f;
    const int jmax = (ig + 1) * 4;
    for (int j4 = 0; j4 < jmax; ++j4) {
      const float v0 = Vs[(j4 * 4 + 0) * 64 + v], v1 = Vs[(j4 * 4 + 1) * 64 + v], v2 = Vs[(j4 * 4 + 2) * 64 + v], v3 = Vs[(j4 * 4 + 3) * 64 + v];
#pragma unroll
      for (int ii = 0; ii < 16; ++ii) {
        const float4 av = *(const float4*)(Am + (ig * 16 + ii) * 68 + j4 * 4);
        acc[ii] += av.x * v0 + av.y * v1 + av.z * v2 + av.w * v3;
      }
    }
#pragma unroll 2
    for (int d4 = 0; d4 < 8; ++d4) {
      const float s0 = Ss[(d4 * 4 + 0) * 64 + v], s1 = Ss[(d4 * 4 + 1) * 64 + v], s2 = Ss[(d4 * 4 + 2) * 64 + v], s3 = Ss[(d4 * 4 + 3) * 64 + v];
#pragma unroll
      for (int ii = 0; ii < 16; ++ii) {
        const float4 qv = *(const float4*)(qt + (ig * 16 + ii) * 36 + d4 * 4);
        acc[ii] += qv.x * s0 + qv.y * s1 + qv.z * s2 + qv.w * s3;
      }
    }
    const float nw = p.gla_nw[l * 64 + v];
#pragma unroll
    for (int ii = 0; ii < 16; ++ii) {
      int t = chunk * 64 + ig * 16 + ii;
      float o = acc[ii];
      float ms = wave_sum(o * o) * (1.f / 64.f);
      float gg = bf2f(PROJ[(size_t)t * NALL + 2816 + head * 64 + v]);
      float r = o * rsqrtf(ms + 1e-5f) * nw * silu(gg);
      MIX[(size_t)t * 1024 + 768 + head * 64 + v] = f2bf(r);
    }
  }
  __syncthreads();
}

typedef float f32x2 __attribute__((ext_vector_type(2)));
__device__ __forceinline__ float oct_allsum(float x) {
  x += dpp_f<0xB1>(x);
  x += dpp_f<0x4E>(x);
  x += dpp_f<0x141>(x);
  return x;
}
__device__ void rwkv_scan_item(const Params& p, int item, unsigned char* dsm_) {
  item = opq(item);
  float* st = (float*)dsm_;
  const int tid = opaque_tid512(), wv = tid >> 6, lane = tid & 63, rs = lane >> 3, kl = lane & 7;
  const int head = item & 3, seg = item >> 2;
  const bool ident = wv >= 4;
  const int R0 = wv * 16 + rs * 2;
  const int v0 = R0 & 63;
  const float* RWW = (const float*)(p.ws + OFF_RWW);
  const float* RWKK = (const float*)(p.ws + OFF_RWKK);
  const u16* RB = (const u16*)(p.ws + OFF_RWB);
  float* PF = (float*)(p.ws + OFF_PROJ);
  float* ZP = (float*)(p.ws + OFF_ZP);
  const int tbase = seg * SL;
  const int half = tid >> 8, ls = (tid & 255) >> 4, lc4 = (tid & 15) * 4;
  f32x2 S0[4], S1[4];
#pragma unroll
  for (int e = 0; e < 4; ++e) { S0[e] = (f32x2){0.f, 0.f}; S1[e] = (f32x2){0.f, 0.f}; }
  if (ident) {
#pragma unroll
    for (int e = 0; e < 4; ++e) {
      const int k0 = kl * 8 + 2 * e;
      S0[e] = (f32x2){(v0 == k0) ? 1.f : 0.f, (v0 == k0 + 1) ? 1.f : 0.f};
      S1[e] = (f32x2){(v0 + 1 == k0) ? 1.f : 0.f, (v0 + 1 == k0 + 1) ? 1.f : 0.f};
    }
  }
  float4 g0 = make_float4(0.f, 0.f, 0.f, 0.f);
  uint2 h0 = make_uint2(0u, 0u), h1 = h0, h2 = h0;
  const float* gp0 = (half == 0 ? RWW : RWKK) + (size_t)(tbase + ls) * 256 + head * 64 + lc4;
  const u16* hp = RB + (size_t)(tbase + ls) * 256 + head * 64 + lc4;
#define SCAN_GLOAD(ch) do { const size_t _o = (size_t)(ch) * 16 * 256; g0 = *(const float4*)(gp0 + _o); \
    if (half == 0) { h0 = *(const uint2*)(hp + _o); } \
    else { h0 = *(const uint2*)(hp + (size_t)T_ * 256 + _o); h1 = *(const uint2*)(hp + (size_t)3 * T_ * 256 + _o); h2 = *(const uint2*)(hp + (size_t)2 * T_ * 256 + _o); } } while (0)
#define SCAN_LSTORE(buf) do { float* _b = st + (buf) * 6144 + ls * 64 + lc4; \
    if (half == 0) { *(float4*)(_b) = g0; *(float4*)(_b + 2048) = make_float4(bflo(h0.x), bfhi(h0.x), bflo(h0.y), bfhi(h0.y)); } \
    else { *(float4*)(_b + 1024) = g0; *(float4*)(_b + 3072) = make_float4(bflo(h0.x), bfhi(h0.x), bflo(h0.y), bfhi(h0.y)); \
           *(float4*)(_b + 4096) = make_float4(bflo(h1.x), bfhi(h1.x), bflo(h1.y), bfhi(h1.y)); *(float4*)(_b + 5120) = make_float4(bflo(h2.x), bfhi(h2.x), bflo(h2.y), bfhi(h2.y)); } } while (0)
  if (tid < 16) st[2 * 6144 + tid] = 0.f;
  SCAN_GLOAD(0);
  SCAN_LSTORE(0);
  __syncthreads();
  const int nch = SL / 16;
  float* yout = PF + (size_t)tbase * PROJF + (ident ? 256 : 0) + head * 64 + v0;
  const int voff = ident ? (2 * 6144) : (5120 + v0);
  const int vstep = ident ? 0 : 64, vbuf = ident ? 0 : 6144;
#define V2(a, i) ((f32x2){(i) ? a.z : a.x, (i) ? a.w : a.y})
#define SCAN_STEP(s_) do { \
    const float* bp = b + (s_) * 64 + kl * 8; \
    const float4 wl = *(const float4*)(bp), wh = *(const float4*)(bp + 4); \
    const float4 kkl = *(const float4*)(bp + 1024), kkh = *(const float4*)(bp + 1028); \
    const float4 rl4 = *(const float4*)(bp + 2048), rh4 = *(const float4*)(bp + 2052); \
    const float4 kl4 = *(const float4*)(bp + 3072), kh4 = *(const float4*)(bp + 3076); \
    const float4 bl4 = *(const float4*)(bp + 4096), bh4 = *(const float4*)(bp + 4100); \
    const f32x2 vv = *(const f32x2*)(vsrc + (s_) * vstep); \
    const f32x2 W[4] = {V2(wl, 0), V2(wl, 1), V2(wh, 0), V2(wh, 1)}, KK[4] = {V2(kkl, 0), V2(kkl, 1), V2(kkh, 0), V2(kkh, 1)}; \
    const f32x2 RR[4] = {V2(rl4, 0), V2(rl4, 1), V2(rh4, 0), V2(rh4, 1)}, KV[4] = {V2(kl4, 0), V2(kl4, 1), V2(kh4, 0), V2(kh4, 1)}; \
    const f32x2 BB[4] = {V2(bl4, 0), V2(bl4, 1), V2(bh4, 0), V2(bh4, 1)}; \
    f32x2 t0 = S0[0] * KK[0] + S0[1] * KK[1] + S0[2] * KK[2] + S0[3] * KK[3]; \
    f32x2 t1 = S1[0] * KK[0] + S1[1] * KK[1] + S1[2] * KK[2] + S1[3] * KK[3]; \
    float sa0 = -(t0.x + t0.y), sa1 = -(t1.x + t1.y); \
    sa0 += dpp_f<0xB1>(sa0); sa1 += dpp_f<0xB1>(sa1); sa0 += dpp_f<0x4E>(sa0); sa1 += dpp_f<0x4E>(sa1); sa0 += dpp_f<0x141>(sa0); sa1 += dpp_f<0x141>(sa1); \
    const f32x2 a0 = {sa0, sa0}, a1 = {sa1, sa1}, u0 = {vv.x, vv.x}, u1 = {vv.y, vv.y}; \
    _Pragma("unroll") for (int e = 0; e < 4; ++e) { S0[e] = S0[e] * W[e] + a0 * BB[e] + u0 * KV[e]; S1[e] = S1[e] * W[e] + a1 * BB[e] + u1 * KV[e]; } \
    f32x2 q0 = S0[0] * RR[0] + S0[1] * RR[1] + S0[2] * RR[2] + S0[3] * RR[3]; \
    f32x2 q1 = S1[0] * RR[0] + S1[1] * RR[1] + S1[2] * RR[2] + S1[3] * RR[3]; \
    float y0 = q0.x + q0.y, y1 = q1.x + q1.y; \
    y0 += dpp_f<0xB1>(y0); y1 += dpp_f<0xB1>(y1); y0 += dpp_f<0x4E>(y0); y1 += dpp_f<0x4E>(y1); y0 += dpp_f<0x141>(y0); y1 += dpp_f<0x141>(y1); \
    const bool mine = (kl == ((s_) & 7)); \
    if ((s_) < 8) { ya.x = mine ? y0 : ya.x; ya.y = mine ? y1 : ya.y; } else { yb.x = mine ? y0 : yb.x; yb.y = mine ? y1 : yb.y; } } while (0)
  for (int ch = 0; ch < nch; ++ch) {
    const int cur = ch & 1;
    if (ch + 1 < nch) SCAN_GLOAD(ch + 1);
    const float* b = st + cur * 6144;
    const float* vsrc = st + voff + cur * vbuf;
    f32x2 ya = {0.f, 0.f}, yb = {0.f, 0.f};
#pragma unroll 2
    for (int s = 0; s < 8; ++s) SCAN_STEP(s);
#pragma unroll 2
    for (int s = 8; s < 16; ++s) SCAN_STEP(s);
    *(f32x2*)(yout + (size_t)(ch * 16 + kl) * PROJF) = ya;
    *(f32x2*)(yout + (size_t)(ch * 16 + 8 + kl) * PROJF) = yb;
    if (ch + 1 < nch) SCAN_LSTORE(cur ^ 1);
    __syncthreads();
  }
#pragma unroll
  for (int j = 0; j < 2; ++j) {
    float* zp = ZP + ((size_t)((seg * 4 + head) * 128 + R0 + j)) * 64 + kl * 8;
    if (j == 0) { *(float4*)(zp) = make_float4(S0[0].x, S0[0].y, S0[1].x, S0[1].y); *(float4*)(zp + 4) = make_float4(S0[2].x, S0[2].y, S0[3].x, S0[3].y); }
    else { *(float4*)(zp) = make_float4(S1[0].x, S1[0].y, S1[1].x, S1[1].y); *(float4*)(zp + 4) = make_float4(S1[2].x, S1[2].y, S1[3].x, S1[3].y); }
  }
}

__device__ void rwkv_combine(const Params& p, unsigned char* dsm_) {
  float* ring = (float*)dsm_;
  float* ZP = (float*)(p.ws + OFF_ZP);
  const int tid = opaque_tid512(); const int lane = tid & 63;
  const int rowi = blockIdx.x * 8 + (tid >> 6);
  const int head = rowi >> 6, v = rowi & 63;
  float4 pa0, pa1, pa2, pa3, pb0, pb1, pb2, pb3;
  float z0, z1, z2, z3;
#define COMB_ONE(stg_, q, PA, PB, Z) do { const float* base = ZP + (size_t)((((stg_) * 4 + q) * 4 + head) * 128) * 64; \
      PA = ((const float4*)(base + 4096))[tid]; PB = ((const float4*)(base + 4096))[tid + 512]; Z = base[v * 64 + lane]; } while (0)
#define COMB_ISSUE(stg_) do { COMB_ONE(stg_, 0, pa0, pb0, z0); COMB_ONE(stg_, 1, pa1, pb1, z1); COMB_ONE(stg_, 2, pa2, pb2, z2); COMB_ONE(stg_, 3, pa3, pb3, z3); } while (0)
#define COMB_SEG(q, ZC) do { const int seg = stg * 4 + q; \
      ZP[((size_t)((seg * 4 + head) * 128 + v)) * 64 + lane] = s; \
      float ns0 = ZC, ns1 = 0.f; const float* P = buf + q * 4096 + lane; \
      _Pragma("unroll") for (int i = 0; i < 64; i += 2) { \
        float s0 = __builtin_bit_cast(float, __builtin_amdgcn_readlane(__builtin_bit_cast(int, s), i)); \
        float s1 = __builtin_bit_cast(float, __builtin_amdgcn_readlane(__builtin_bit_cast(int, s), i + 1)); \
        ns0 += s0 * P[i * 64]; ns1 += s1 * P[(i + 1) * 64]; } \
      s = ns0 + ns1; } while (0)
  COMB_ISSUE(0);
  float s = 0.f;
#pragma unroll 1
  for (int stg = 0; stg < NSEG / 4; ++stg) {
    float* buf = ring + (stg & 1) * 16384;
    ((float4*)(buf))[tid] = pa0; ((float4*)(buf))[tid + 512] = pb0;
    ((float4*)(buf + 4096))[tid] = pa1; ((float4*)(buf + 4096))[tid + 512] = pb1;
    ((float4*)(buf + 8192))[tid] = pa2; ((float4*)(buf + 8192))[tid + 512] = pb2;
    ((float4*)(buf + 12288))[tid] = pa3; ((float4*)(buf + 12288))[tid + 512] = pb3;
    const float c0 = z0, c1 = z1, c2 = z2, c3 = z3;
    __syncthreads();
    if (stg + 1 < NSEG / 4) COMB_ISSUE(stg + 1);
    COMB_SEG(0, c0); COMB_SEG(1, c1); COMB_SEG(2, c2); COMB_SEG(3, c3);
  }
  __syncthreads();
}

__device__ __forceinline__ bf16x8 pack8(const float4 a, const float4 b) {
  uint4 u = make_uint4(pack2(a.x, a.y), pack2(a.z, a.w), pack2(b.x, b.y), pack2(b.z, b.w));
  return __builtin_bit_cast(bf16x8, u);
}
__device__ void rwkv_final_item(const Params& p, int l, int item, unsigned char* smem) {
  l = opq(l); item = opq(item);
  const int tid = opaque_tid(), w = tid >> 6, lane = tid & 63, l31 = lane & 31, hf = lane >> 5;
  const int parts = SL / 128;
  const int q = item % parts, head = (item / parts) & 3, seg = item / (parts * 4);
  const int t = seg * SL + q * 128 + w * 32 + l31;
  const float* ZP = (const float*)(p.ws + OFF_ZP);
  const float* PF = (const float*)(p.ws + OFF_PROJ);
  const u16* PROJ = (const u16*)(p.ws + OFF_PROJ);
  const u16* RBv = (const u16*)(p.ws + OFF_RWB) + (size_t)2 * T_ * 256;
  const float* BON = (const float*)(p.ws + OFF_BONUS);
  u16* MIX = (u16*)(p.ws + OFF_MIX);
  f32x16 acc0, acc1;
#pragma unroll
  for (int r = 0; r < 16; ++r) { acc0[r] = 0.f; acc1[r] = 0.f; }
  {
    const float* sp = ZP + ((size_t)((seg * 4 + head) * 128 + l31)) * 64 + 8 * hf;
    const float* rp = PF + (size_t)t * PROJF + 256 + head * 64 + 8 * hf;
#pragma unroll
    for (int ks = 0; ks < 4; ++ks) {
      const bf16x8 bfrag = pack8(*(const float4*)(rp + 16 * ks), *(const float4*)(rp + 16 * ks + 4));
      const bf16x8 a0 = pack8(*(const float4*)(sp + 16 * ks), *(const float4*)(sp + 16 * ks + 4));
      const bf16x8 a1 = pack8(*(const float4*)(sp + 32 * 64 + 16 * ks), *(const float4*)(sp + 32 * 64 + 16 * ks + 4));
      acc0 = __builtin_amdgcn_mfma_f32_32x32x16_bf16(a0, bfrag, acc0, 0, 0, 0);
      acc1 = __builtin_amdgcn_mfma_f32_32x32x16_bf16(a1, bfrag, acc1, 0, 0, 0);
    }
  }
  const float* y0p = PF + (size_t)t * PROJF + head * 64 + 4 * hf;
  float sum = 0.f;
#pragma unroll
  for (int g = 0; g < 4; ++g) {
    const float4 ya = *(const float4*)(y0p + 8 * g), yb = *(const float4*)(y0p + 32 + 8 * g);
    acc0[4 * g + 0] += ya.x; acc0[4 * g + 1] += ya.y; acc0[4 * g + 2] += ya.z; acc0[4 * g + 3] += ya.w;
    acc1[4 * g + 0] += yb.x; acc1[4 * g + 1] += yb.y; acc1[4 * g + 2] += yb.z; acc1[4 * g + 3] += yb.w;
  }
#pragma unroll
  for (int r = 0; r < 16; ++r) sum += acc0[r] + acc1[r];
  sum += __shfl_xor(sum, 32);
  const float mean = sum * (1.f / 64.f);
  float var = 0.f;
#pragma unroll
  for (int r = 0; r < 16; ++r) { const float d0 = acc0[r] - mean, d1 = acc1[r] - mean; var += d0 * d0 + d1 * d1; }
  var += __shfl_xor(var, 32);
  const float rstd = rsqrtf(var * (1.f / 64.f) + 64e-5f);
  const float bon = BON[t * 4 + head];
  const int cb = head * 64 + 4 * hf;
#pragma unroll
  for (int mt = 0; mt < 2; ++mt)
#pragma unroll
    for (int g = 0; g < 4; ++g) {
      const int c = cb + mt * 32 + 8 * g;
      const float4 lw = *(const float4*)(p.ln_w + l * 256 + c), lb = *(const float4*)(p.ln_b + l * 256 + c);
      const uint2 vv = *(const uint2*)(RBv + (size_t)t * 256 + c);
      const uint2 gg = *(const uint2*)(PROJ + (size_t)t * NALL + 2048 + c);
      float o0 = (mt ? acc1[4 * g + 0] : acc0[4 * g + 0]), o1 = (mt ? acc1[4 * g + 1] : acc0[4 * g + 1]);
      float o2 = (mt ? acc1[4 * g + 2] : acc0[4 * g + 2]), o3 = (mt ? acc1[4 * g + 3] : acc0[4 * g + 3]);
      o0 = (o0 - mean) * rstd * lw.x + lb.x + bon * bflo(vv.x);
      o1 = (o1 - mean) * rstd * lw.y + lb.y + bon * bfhi(vv.x);
      o2 = (o2 - mean) * rstd * lw.z + lb.z + bon * bflo(vv.y);
      o3 = (o3 - mean) * rstd * lw.w + lb.w + bon * bfhi(vv.y);
      o0 *= silu(bflo(gg.x)); o1 *= silu(bfhi(gg.x)); o2 *= silu(bflo(gg.y)); o3 *= silu(bfhi(gg.y));
      *(uint2*)(MIX + (size_t)t * 1024 + 512 + c) = make_uint2(pack2(o0, o1), pack2(o2, o3));
    }
}

#define LDS_BYTES (131072 + 16)
#ifndef REP_G1
#define REP_G1 1
#endif
#ifndef REP_G2
#define REP_G2 1
#endif
#ifndef REP_P3
#define REP_P3 1
#endif
#ifndef REP_SCAN
#define REP_SCAN 1
#endif
#ifndef REP_GO
#define REP_GO 1
#endif
#ifndef REP_FIN
#define REP_FIN 1
#endif
#define PAIR_LOOP(N, BODY) for (int _pr = blockIdx.x; _pr < (N) / 2; _pr += gridDim.x) { const int it = 2 * _pr + vb; BODY }
__global__ void __launch_bounds__(512) fwd_megakernel(Params p) {
  cg::grid_group grid = cg::this_grid();
  extern __shared__ __attribute__((aligned(16))) unsigned char dsm[];
  const int vb = __builtin_amdgcn_readfirstlane(threadIdx.x >> 8);
  unsigned char* smem = dsm + vb * 65536;
  if (threadIdx.x == 0) *(uint4*)(dsm + 131072) = make_uint4(0u, 0u, 0u, 0u);
  __syncthreads();
  const XcdBarrier xb = xcd_barrier_post((unsigned*)(p.ws + OFF_BAR), (volatile LAS unsigned*)(dsm + 131072));
#define GSYNC() xcd_barrier(xb)
#ifndef PH
#define PH 0xffff
#endif
  if (PH & 1) PAIR_LOOP(384, phase_mod_item(p, it, smem);)
  if (PH & 2) PAIR_LOOP(4480, phase_wconv_item(p, it, smem);)
  if (PH & 2) PAIR_LOOP(8, phase_w2t_item(p, it);)
  grid.sync();
  if (PH & 4) phase_h0(p);
  GSYNC();
#pragma unroll 1
  for (int hl = 0; hl < 8; ++hl) {
    const int l = hl >> 1;
    const bool second = hl & 1;
    if (PH & 8) {
      pg8::Gemm g; g.M = T_; g.K = 1024;
      pg8::EpiU E; E.O = (void*)(p.ws + OFF_PROJ);
      if (!second) { g.A = (const u16*)(p.ws + OFF_H); g.Bt = (const u16*)(p.ws + OFF_WALL) + (size_t)l * NALL * 1024; g.N = 3584; E.ldc = NALL; E.ncols = NALL; E.f32out = 0; }
      else { g.A = (const u16*)(p.ws + OFF_MIX); g.Bt = (const u16*)(p.ws + OFF_WOUT) + (size_t)l * 1024 * 1024; g.N = 1024; E.ldc = 1024; E.ncols = 1024; E.f32out = 0; }
      pg8::StaticOrder S; S.init(T_, g.N, gridDim.x, blockIdx.x);
      const int nrep = second ? REP_G2 : REP_G1;
#pragma unroll 1
      for (int rep = 0; rep < nrep; ++rep)
      pg8::gemm_phase<pg8::EpiU, pg8::StaticOrder, false>((PG8_LAS unsigned char*)dsm, g, S, E, nullptr);
    }
    GSYNC();
    if (!second) {
#pragma unroll 1
      for (int rep = 0; rep < REP_P3; ++rep)
      PAIR_LOOP(3072,
        if (it < 1024) { if (PH & 16) attn_item(p, l, it, smem); }
        else if (it < 2048) { if (PH & 32) rwkv_prep_item(p, l, it - 1024, smem); }
        else { if (PH & 64) gla_local_item(p, l, it - 2048, smem); }
      )
      GSYNC();
      if (PH & 128) for (int eb = blockIdx.x; eb < 256; eb += gridDim.x) gla_state_block(p, eb, dsm);
#pragma unroll 1
      for (int rep = 0; rep < REP_SCAN; ++rep)
      if (PH & 256) for (int it = blockIdx.x; it < NSEG * 4; it += gridDim.x) rwkv_scan_item(p, it, dsm);
      GSYNC();
      if (blockIdx.x < 32) { if (PH & 512) rwkv_combine(p, dsm); }
#pragma unroll 1
      for (int rep = 0; rep < REP_GO; ++rep)
      if (PH & 1024) {
        unsigned* ctr = (unsigned*)(p.ws + OFF_BAR) + 32 + l;
        volatile unsigned* slot = (volatile unsigned*)(dsm + 131072) + 2;
        for (;;) {
          if (threadIdx.x == 0) *slot = atomicAdd(ctr, 1u);
          __syncthreads();
          const unsigned pr = (unsigned)__builtin_amdgcn_readfirstlane((int)*slot);
          __syncthreads();
          if (pr >= 512u) break;
          gla_out_item(p, l, 2 * (int)pr + vb, smem);
        }
      }
      GSYNC();
#pragma unroll 1
      for (int rep = 0; rep < REP_FIN; ++rep)
      if (PH & 2048) PAIR_LOOP(NSEG * 4 * (SL / 128), rwkv_final_item(p, l, it, smem);)
      GSYNC();
    } else {
      if (PH & 8192) phase_post(p, l);
      if (hl < 7) GSYNC();
    }
  }
}

extern "C" void kernel_launch(void* const* d_in, const int* in_sizes, int n_in, void* d_out, int out_size, void* d_ws, size_t ws_size,
                              hipStream_t stream) {
  static int grid_blocks = 0;
  if (!grid_blocks) {
    int dev = 0, cus = 0, per_cu = 0;
    (void)hipGetDevice(&dev);
    (void)hipDeviceGetAttribute(&cus, hipDeviceAttributeMultiprocessorCount, dev);
    (void)hipFuncSetAttribute((const void*)fwd_megakernel, hipFuncAttributeMaxDynamicSharedMemorySize, LDS_BYTES);
    (void)hipOccupancyMaxActiveBlocksPerMultiprocessor(&per_cu, fwd_megakernel, 512, LDS_BYTES);
    if (per_cu < 1) per_cu = 1;
    grid_blocks = cus;
    if (grid_blocks < 32) grid_blocks = 32;
  }
  if (n_in != 27 || ws_size < WS_END) {
    fprintf(stderr, "kernel_launch: unexpected n_in %d / ws %zu\n", n_in, ws_size);
    return;
  }
  Params p{};
  const float** pp = (const float**)&p;
  for (int i = 0; i < 27; ++i) pp[i] = (const float*)d_in[i];
  p.out = (float*)d_out;
  p.ws = (unsigned char*)d_ws;
  (void)hipMemsetAsync((unsigned char*)d_ws + OFF_BAR, 0, XCD_BAR_WORDS * 4, stream);
  void* args[] = {&p};
  hipError_t e = hipLaunchCooperativeKernel((void*)fwd_megakernel, dim3(grid_blocks), dim3(512), args, LDS_BYTES, stream);
  if (e != hipSuccess) fprintf(stderr, "cooperative launch failed: %s (grid %d)\n", hipGetErrorString(e), grid_blocks);
}
```

```cpp
#include <hip/hip_runtime.h>
#include <hip/hip_bf16.h>
#include <hip/hip_cooperative_groups.h>
#include <cstdio>
namespace cg = cooperative_groups;

typedef unsigned short u16;
using bf16x8 = __attribute__((ext_vector_type(8))) short;
using f32x4 = __attribute__((ext_vector_type(4))) float;
using f32x16 = __attribute__((ext_vector_type(16))) float;

#define T_ 16384
#define NALL 3456
#define NSEG 64
#define SL (T_ / NSEG)
#define PROJF 1728

#define OFF_WALL 0ull
#define OFF_WOUT 28311552ull
#define OFF_MOD 36700160ull
#define OFF_H 36749312ull
#define OFF_RWW OFF_H
#define OFF_RWKK (OFF_H + 16777216ull)
#define OFF_PROJ 70303744ull
#define OFF_MIX 183549952ull
#define OFF_RWB 217104384ull
#define OFF_GLAS 250658816ull
#define OFF_GLAD 259047424ull
#define OFF_BONUS 259178496ull
#define OFF_ZP 259440640ull
#define OFF_BAR 267829248ull
#define OFF_W2T 267845632ull
#define OFF_A2T 267976704ull
#define WS_END 268107776ull


struct Params {
  const float *x, *c, *ada_w, *ada_b, *norm_pre, *norm_post, *w_in, *w_out, *sinks, *mu_rkv, *mu_w, *mu_a, *w0, *w1, *w2,
      *a0, *a1, *a2, *k_k, *k_a, *r_k, *ln_w, *ln_b, *gk1, *gk2, *gk_b, *gla_nw;
  float* out;
  unsigned char* ws;
};

__device__ __forceinline__ u16 f2bf(float f) {
  unsigned u = __float_as_uint(f);
  u += 0x7fffu + ((u >> 16) & 1u);
  return (u16)(u >> 16);
}
__device__ __forceinline__ float bf2f(u16 h) { return __uint_as_float(((unsigned)h) << 16); }
__device__ __forceinline__ unsigned pack2(float a, float b) { return (unsigned)f2bf(a) | ((unsigned)f2bf(b) << 16); }
__device__ __forceinline__ float bflo(unsigned u) { return __uint_as_float(u << 16); }
__device__ __forceinline__ float bfhi(unsigned u) { return __uint_as_float(u & 0xffff0000u); }

__device__ __forceinline__ float frcp(float x) { return __builtin_amdgcn_rcpf(x); }
__device__ __forceinline__ float silu(float x) { return x * frcp(1.f + __expf(-x)); }
__device__ __forceinline__ float sigmoidf_(float x) { return frcp(1.f + __expf(-x)); }
__device__ __forceinline__ float softplusf_(float z) { return fmaxf(z, 0.f) + __logf(1.f + __expf(-fabsf(z))); }
__device__ __forceinline__ float tanh_fast(float x) { return 1.f - 2.f * frcp(1.f + __expf(2.f * x)); }

__device__ __forceinline__ int opq(int x) { asm volatile("" : "+s"(x)); return x; }
__device__ __forceinline__ int opaque_tid() { int t = threadIdx.x & 255; asm volatile("" : "+v"(t)); return t; }
__device__ __forceinline__ int opaque_tid512() { int t = threadIdx.x; asm volatile("" : "+v"(t)); return t; }
template <int CTRL>
__device__ __forceinline__ float dpp_f(float x) {
  return __builtin_bit_cast(float, __builtin_amdgcn_update_dpp(0, __builtin_bit_cast(int, x), CTRL, 0xf, 0xf, true));
}
__device__ __forceinline__ float row16_allsum(float x) {
  x += dpp_f<0x128>(x);
  x += dpp_f<0x124>(x);
  x += dpp_f<0x122>(x);
  x += dpp_f<0x121>(x);
  return x;
}
__device__ __forceinline__ float wave_sum(float v) {
  v = row16_allsum(v);
  const int iv = __builtin_bit_cast(int, v);
  const float a = __builtin_bit_cast(float, __builtin_amdgcn_readlane(iv, 0)), b = __builtin_bit_cast(float, __builtin_amdgcn_readlane(iv, 16));
  const float c = __builtin_bit_cast(float, __builtin_amdgcn_readlane(iv, 32)), d = __builtin_bit_cast(float, __builtin_amdgcn_readlane(iv, 48));
  return (a + b) + (c + d);
}

namespace pg8 {
#define PG8_LAS __attribute__((address_space(3)))
typedef unsigned short bf16_t;
typedef short bf16x8 __attribute__((ext_vector_type(8)));
typedef float f32x4 __attribute__((ext_vector_type(4)));
typedef unsigned u32x4 __attribute__((ext_vector_type(4)));
constexpr int BM = 256, BK = 64, HALF = 128, HTB = HALF * BK * 2  , STAGE_BYTES = 8 * HTB, NXCD = 8, WGM = 8;

__host__ __device__ __forceinline__ int lds_byte(int r, int c) { const int st = (r >> 4) * 2 + (c >> 5), rr = r & 15, cc = c & 31, ob = rr * 64 + cc * 2; return st * 1024 + (ob ^ (((ob >> 9) & 1) << 5)); }
__host__ __device__ __forceinline__ void stage_rc(int b, int& R, int& C) { const int st = b / 1024, sb = b % 1024, swz = sb ^ (((sb >> 9) & 1) << 5); R = (st >> 1) * 16 + swz / 64; C = (st & 1) * 32 + (swz % 64) / 2; }
__host__ __device__ __forceinline__ int perm32(int rho) { const int n = rho >> 4, i = rho & 15; return 8 * (i >> 2) + 4 * n + (i & 3); }

struct Unit { int pm, pn; };
struct Gemm { const bf16_t* A; const bf16_t* Bt; int M, N, K; };

struct StaticOrder {
    int nM, nN, nwg, G, c;
    __host__ __device__ void init(int M, int N, int G_, int c_) { nM = M / BM; nN = N / BM; nwg = nM * nN; G = G_; c = c_; }
    __host__ __device__ bool next(int i, Unit& u) const {
        const long L = (long)i * G + c; if (L >= nwg) return false;
        int wgid = (int)L; { const int q = nwg / NXCD, r = nwg % NXCD, xcd = wgid % NXCD, off = wgid / NXCD; wgid = (xcd < r ? xcd * (q + 1) : r * (q + 1) + (xcd - r) * q) + off; }
        const int nig = WGM * nN, gid = wgid / nig, fm = gid * WGM, gsz = (nM - fm) < WGM ? (nM - fm) : WGM;
        u.pm = fm + ((wgid % nig) % gsz); u.pn = (wgid % nig) / gsz; return true;
    }
    __device__ __forceinline__ void a_ready(const Unit&) const {}
    __device__ __forceinline__ void done(const Unit&) const {}
};
__device__ __forceinline__ unsigned cvt_pk_bf16(float lo, float hi) { unsigned r; asm volatile("v_cvt_pk_bf16_f32 %0, %1, %2" : "=v"(r) : "v"(lo), "v"(hi)); return r; }
template <class Epi, class Sched, bool STAMP = false>
__device__ __forceinline__ void gemm_phase(PG8_LAS unsigned char* lds, const Gemm g, const Sched& S, const Epi& E, unsigned long long* stamps) {
    const int tid = threadIdx.x, wid = __builtin_amdgcn_readfirstlane(tid >> 6), lane = tid & 63, wr = wid >> 2, wc = wid & 3, fr = lane & 15, fq = lane >> 4;
    const int K = g.K, nt = K / BK;
    int ts_lo = 0, ts_hi = 0, nts = 0; const unsigned long long rt_entry = STAMP ? (unsigned long long)wall_clock64() : 0ull;
#define PG8_STAMP() do { if (STAMP && wid == 0 && nts < 64) { const unsigned long long _c = (unsigned long long)clock64(); \
        ts_lo = (lane == nts) ? (int)(unsigned)_c : ts_lo; ts_hi = (lane == nts) ? (int)(unsigned)(_c >> 32) : ts_hi; ++nts; } } while (0)
    PG8_STAMP();
    unsigned voffA[2], voffB[2];
#pragma unroll
    for (int i = 0; i < 2; ++i) { int R, C; stage_rc(tid * 16 + i * 8192, R, C); const int Rb = Epi::PERM ? ((R & ~31) + perm32(R & 31)) : R;
        voffA[i] = (unsigned)(R * K + C) * 2u; voffB[i] = (unsigned)(Rb * K + C) * 2u; }
    const size_t kstep = (size_t)(BK * 2);
    const size_t hstep = (size_t)HALF * K * 2;
    const size_t tstep = 2 * hstep;
    const unsigned ldsw = (unsigned)wid * 1024u;
    const int aoff = lds_byte(wr * 64 + fr, fq * 8), boff = lds_byte(wc * 32 + fr, fq * 8);
#define PG8_SA(b, h) (((b) * 2 + (h)) * HTB)
#define PG8_SB(b, h) ((4 + (b) * 2 + (h)) * HTB)
#define PG8_STAGE(bufoff, gbase, voff) do { _Pragma("unroll") for (int _i = 0; _i < 2; ++_i) \
        __builtin_amdgcn_global_load_lds((const unsigned*)((const char*)(gbase) + (voff)[_i]), (PG8_LAS unsigned*)(lds + (bufoff) + ldsw + _i * 8192), 16, 0, 0); } while (0)
#define PG8_LDA(dst, b, h) do { _Pragma("unroll") for (int m = 0; m < 4; ++m) _Pragma("unroll") for (int k = 0; k < 2; ++k) dst[m][k] = *(const PG8_LAS bf16x8*)(lds + PG8_SA(b, h) + aoff + m * 2048 + k * 1024); } while (0)
#define PG8_LDB(dst, b, h) do { _Pragma("unroll") for (int n = 0; n < 2; ++n) _Pragma("unroll") for (int k = 0; k < 2; ++k) dst[n][k] = *(const PG8_LAS bf16x8*)(lds + PG8_SB(b, h) + boff + n * 2048 + k * 1024); } while (0)
#define PG8_MMA(ai, bj, At, Bt) do { __builtin_amdgcn_s_setprio(1); _Pragma("unroll") for (int m = 0; m < 4; ++m) _Pragma("unroll") for (int n = 0; n < 2; ++n) _Pragma("unroll") for (int k = 0; k < 2; ++k) \
        acc[ai][bj][m][n] = __builtin_amdgcn_mfma_f32_16x16x32_bf16(Bt[n][k], At[m][k], acc[ai][bj][m][n], 0, 0, 0); __builtin_amdgcn_s_setprio(0); } while (0)
#define PG8_WAIT_V(n) asm volatile("s_waitcnt vmcnt(" #n ")" ::: "memory")
#define PG8_WAIT_L(n) asm volatile("s_waitcnt lgkmcnt(" #n ")" ::: "memory")
#define PG8_BAR __builtin_amdgcn_s_barrier()
#define PG8_SCHED __builtin_amdgcn_sched_barrier(0)
    Unit cur, nxt; int ui = 0;
    if (!S.next(0, cur)) return;
    f32x4 acc[2][2][4][2];
#pragma unroll
    for (int a = 0; a < 2; ++a)
#pragma unroll
        for (int b = 0; b < 2; ++b)
#pragma unroll
            for (int m = 0; m < 4; ++m)
#pragma unroll
                for (int n = 0; n < 2; ++n) acc[a][b][m][n] = (f32x4){0.f, 0.f, 0.f, 0.f};
    bf16x8 At[4][2], B0[2][2], B1[2][2];
    const char* cA = (const char*)g.A + (size_t)cur.pm * tstep; const char* cB = (const char*)g.Bt + (size_t)cur.pn * tstep;
    S.a_ready(cur);
    PG8_STAGE(PG8_SB(0, 0), cB, voffB); PG8_STAGE(PG8_SA(0, 0), cA, voffA); PG8_STAGE(PG8_SB(0, 1), cB + hstep, voffB); PG8_STAGE(PG8_SA(0, 1), cA + hstep, voffA);
    if (wr == 1) PG8_BAR;
    PG8_WAIT_V(4); PG8_BAR;
    PG8_STAGE(PG8_SB(1, 0), cB + kstep, voffB); PG8_STAGE(PG8_SA(1, 0), cA + kstep, voffA); PG8_STAGE(PG8_SB(1, 1), cB + hstep + kstep, voffB);
    PG8_WAIT_V(6); PG8_BAR;
    PG8_STAMP();
    for (;;) {
        const bool has_next = S.next(ui + 1, nxt);
        const char* nA = has_next ? (const char*)g.A + (size_t)nxt.pm * tstep : cA; const char* nB = has_next ? (const char*)g.Bt + (size_t)nxt.pn * tstep : cB;
        for (int t = 0; t < nt; t += 2) {
            const bool last = (t == nt - 2);
            const char* a1 = cA + (size_t)(t + 1) * kstep;
            const char* a2 = last ? nA : cA + (size_t)(t + 2) * kstep; const char* b2 = last ? nB : cB + (size_t)(t + 2) * kstep;
            const char* a3 = a2 + kstep; const char* b3 = b2 + kstep;
            if (last && has_next) S.a_ready(nxt);
            PG8_LDB(B0, 0, 0); PG8_SCHED; PG8_LDA(At, 0, 0); PG8_STAGE(PG8_SA(1, 1), a1 + hstep, voffA);
            PG8_WAIT_L(8); PG8_BAR; PG8_WAIT_L(0); PG8_MMA(0, 0, At, B0); PG8_BAR; PG8_SCHED;
            PG8_LDB(B1, 0, 1); PG8_STAGE(PG8_SB(0, 0), b2, voffB);
            PG8_BAR; PG8_WAIT_L(0); PG8_MMA(0, 1, At, B1); PG8_BAR;
            PG8_LDA(At, 0, 1); PG8_STAGE(PG8_SA(0, 0), a2, voffA);
            PG8_BAR; PG8_WAIT_L(0); PG8_MMA(1, 0, At, B0); PG8_BAR; PG8_SCHED;
            PG8_STAGE(PG8_SB(0, 1), b2 + hstep, voffB);
            PG8_WAIT_V(6); PG8_BAR; PG8_MMA(1, 1, At, B1); PG8_BAR;
            PG8_LDB(B0, 1, 0); PG8_SCHED; PG8_LDA(At, 1, 0); PG8_STAGE(PG8_SA(0, 1), a2 + hstep, voffA);
            PG8_WAIT_L(8); PG8_BAR; PG8_WAIT_L(0); PG8_MMA(0, 0, At, B0); PG8_BAR; PG8_SCHED;
            PG8_LDB(B1, 1, 1); PG8_STAGE(PG8_SB(1, 0), b3, voffB);
            PG8_BAR; PG8_WAIT_L(0); PG8_MMA(0, 1, At, B1); PG8_BAR;
            PG8_LDA(At, 1, 1); PG8_STAGE(PG8_SA(1, 0), a3, voffA);
            PG8_BAR; PG8_WAIT_L(0); PG8_MMA(1, 0, At, B0); PG8_BAR; PG8_SCHED;
            PG8_STAGE(PG8_SB(1, 1), b3 + hstep, voffB);
            PG8_WAIT_V(6); PG8_BAR; PG8_MMA(1, 1, At, B1); PG8_BAR;
        }
        PG8_STAMP();
        if constexpr (!Epi::AFTER_DRAIN) { E(acc, cur, wr, wc, fr, fq); S.done(cur); }
        PG8_STAMP();
        if (!has_next) break;
#pragma unroll
        for (int a = 0; a < 2; ++a)
#pragma unroll
            for (int b = 0; b < 2; ++b)
#pragma unroll
                for (int m = 0; m < 4; ++m)
#pragma unroll
                    for (int n = 0; n < 2; ++n) acc[a][b][m][n] = (f32x4){0.f, 0.f, 0.f, 0.f};
        cur = nxt; cA = nA; cB = nB; ++ui;
    }
    PG8_WAIT_V(0);
    if (wr == 0) PG8_BAR;
    PG8_BAR;
    if constexpr (Epi::AFTER_DRAIN) { E.fused(acc, cur, wr, wc, fr, fq, lds, wid, lane); S.done(cur); }
    PG8_STAMP();
    if (STAMP && wid == 0) { stamps[lane] = lane < nts ? (((unsigned long long)(unsigned)ts_hi << 32) | (unsigned)ts_lo) : 0ull;
        if (lane == 62) stamps[62] = rt_entry; if (lane == 63) stamps[63] = (unsigned long long)wall_clock64(); }
#undef PG8_STAMP
#undef PG8_SA
#undef PG8_SB
#undef PG8_STAGE
#undef PG8_LDA
#undef PG8_LDB
#undef PG8_MMA
#undef PG8_WAIT_V
#undef PG8_WAIT_L
#undef PG8_BAR
#undef PG8_SCHED
}
}

namespace pg8 {
struct EpiProj {
    static constexpr bool PERM = true, AFTER_DRAIN = false;
    bf16_t* O; int ldc; int ncols;
    __device__ __forceinline__ void operator()(const f32x4 (&acc)[2][2][4][2], const Unit& u, int wr, int wc, int fr, int fq) const {
        const int row0 = u.pm * BM + wr * 64 + fr; const int col0 = u.pn * BM + wc * 32 + 8 * fq;
#pragma unroll
        for (int ai = 0; ai < 2; ++ai)
#pragma unroll
            for (int m = 0; m < 4; ++m) { bf16_t* rowp = O + (size_t)(row0 + ai * HALF + m * 16) * ldc + col0;
#pragma unroll
                for (int bj = 0; bj < 2; ++bj) { const f32x4 v0 = acc[ai][bj][m][0], v1 = acc[ai][bj][m][1];
                    u32x4 w; w.x = cvt_pk_bf16(v0[0], v0[1]); w.y = cvt_pk_bf16(v0[2], v0[3]); w.z = cvt_pk_bf16(v1[0], v1[1]); w.w = cvt_pk_bf16(v1[2], v1[3]);
                    if (col0 + bj * HALF < ncols) *(u32x4*)(rowp + bj * HALF) = w; } }
    }
};
struct EpiU {
    static constexpr bool PERM = true, AFTER_DRAIN = false;
    void* O; int ldc; int ncols; int f32out;
    __device__ __forceinline__ void operator()(const f32x4 (&acc)[2][2][4][2], const Unit& u, int wr, int wc, int fr, int fq) const {
        const int row0 = u.pm * BM + wr * 64 + fr; const int col0 = u.pn * BM + wc * 32 + 8 * fq;
        if (f32out) {
#pragma unroll
            for (int ai = 0; ai < 2; ++ai)
#pragma unroll
                for (int m = 0; m < 4; ++m) { float* rowp = (float*)O + (size_t)(row0 + ai * HALF + m * 16) * ldc + col0;
#pragma unroll
                    for (int bj = 0; bj < 2; ++bj) { *(f32x4*)(rowp + bj * HALF) = acc[ai][bj][m][0]; *(f32x4*)(rowp + bj * HALF + 4) = acc[ai][bj][m][1]; } }
        } else {
#pragma unroll
            for (int ai = 0; ai < 2; ++ai)
#pragma unroll
                for (int m = 0; m < 4; ++m) { bf16_t* rowp = (bf16_t*)O + (size_t)(row0 + ai * HALF + m * 16) * ldc + col0;
#pragma unroll
                    for (int bj = 0; bj < 2; ++bj) { const f32x4 v0 = acc[ai][bj][m][0], v1 = acc[ai][bj][m][1];
                        u32x4 w; w.x = cvt_pk_bf16(v0[0], v0[1]); w.y = cvt_pk_bf16(v0[2], v0[3]); w.z = cvt_pk_bf16(v1[0], v1[1]); w.w = cvt_pk_bf16(v1[2], v1[3]);
                        if (col0 + bj * HALF < ncols) *(u32x4*)(rowp + bj * HALF) = w; } }
        }
    }
};
}

#define XB_TMO      128
#define XB_XCNT(j)  (256  + 64 * (j))
#define XB_XSUB(j)  (1280 + 64 * (j))
#define XB_XGEN(j)  (2304 + 64 * (j))
#define XB_TOP      3328
#define XB_TOPGEN   3392
#define XCD_BAR_WORDS 3456
#define XB_SPIN_CAP (1u << 18)
#define LAS __attribute__((address_space(3)))

__device__ __forceinline__ unsigned xb_ld(unsigned* p)              { return __hip_atomic_load(p, __ATOMIC_RELAXED, __HIP_MEMORY_SCOPE_AGENT); }
__device__ __forceinline__ unsigned xb_add(unsigned* p, unsigned v) { return __hip_atomic_fetch_add(p, v, __ATOMIC_RELAXED, __HIP_MEMORY_SCOPE_AGENT); }
__device__ __forceinline__ unsigned xb_xcc_id() { return (unsigned)__builtin_amdgcn_s_getreg((3 << 11) | 20) & 0xFu; }
#define XB_SPIN(cond, bar) do { unsigned _sp = 0; while (cond) { __builtin_amdgcn_s_sleep(1); \
    if ((++_sp & 255u) == 0u) { if (xb_ld(&(bar)[XB_TMO])) break; if (_sp > XB_SPIN_CAP) { atomicAdd(&(bar)[XB_TMO], 1u); break; } } } } while (0)

struct XcdBarrier {
    unsigned* bar; unsigned x;
    volatile LAS unsigned* st;
};

__device__ __forceinline__ XcdBarrier xcd_barrier_post(unsigned* bar, volatile LAS unsigned* st) {
    XcdBarrier b; b.bar = bar; b.x = xb_xcc_id(); b.st = st;
    if (threadIdx.x == 0) (void)xb_add(&bar[XB_XCNT(b.x)], 1u);
    return b;
}
__device__ __forceinline__ void xcd_barrier_complete(unsigned* bar, unsigned x, unsigned& nloc, unsigned& nx) {
    const unsigned G = gridDim.x * gridDim.y * gridDim.z;
    unsigned sum, cnt, mine, sp = 0u;
    for (;;) {
        sum = 0u; cnt = 0u; mine = 0u;
#pragma unroll
        for (unsigned j = 0; j < 16; ++j) { const unsigned c = xb_ld(&bar[XB_XCNT(j)]); sum += c; cnt += (c > 0u) ? 1u : 0u; mine = (j == x) ? c : mine; }
        if (sum == G) break;
        __builtin_amdgcn_s_sleep(1);
        if ((++sp & 255u) == 0u) { if (xb_ld(&bar[XB_TMO])) break; if (sp > XB_SPIN_CAP) { atomicAdd(&bar[XB_TMO], 1u); break; } }
    }
    nloc = mine > 0u ? mine : 1u; nx = cnt > 0u ? cnt : 1u;
}

__device__ __forceinline__ void xcd_barrier(const XcdBarrier& b) {
    asm volatile("s_waitcnt vmcnt(0)" ::: "memory");
    __syncthreads();
    if (threadIdx.x == 0) {
        unsigned* bar = b.bar;
        __builtin_amdgcn_s_waitcnt(0);
        unsigned nloc = b.st[0], nx = b.st[1];
        if (nloc == 0u) { xcd_barrier_complete(bar, b.x, nloc, nx); b.st[0] = nloc; b.st[1] = nx; }
        const unsigned old = xb_add(&bar[XB_XSUB(b.x)], 1u);
        const unsigned gen = old / nloc;
        if (old + 1u == (gen + 1u) * nloc) {
            __builtin_amdgcn_fence(__ATOMIC_RELEASE, "agent");
            asm volatile("s_waitcnt vmcnt(0)" ::: "memory");
            const unsigned og = xb_add(&bar[XB_TOP], 1u);
            const unsigned tg = og / nx;
            if (og + 1u == (tg + 1u) * nx) xb_add(&bar[XB_TOPGEN], 1u);
            else XB_SPIN(xb_ld(&bar[XB_TOPGEN]) == tg, bar);
            __builtin_amdgcn_fence(__ATOMIC_ACQUIRE, "agent");
            xb_add(&bar[XB_XGEN(b.x)], 1u);
            asm volatile("s_waitcnt vmcnt(0)" ::: "memory");
        } else {
            XB_SPIN(xb_ld(&bar[XB_XGEN(b.x)]) == gen, bar);
            __builtin_amdgcn_fence(__ATOMIC_ACQUIRE, "agent");
            asm volatile("s_waitcnt vmcnt(0)" ::: "memory");
        }
    }
    __syncthreads();
}

__device__ void phase_mod_item(const Params& p, int it, unsigned char* smem) {
  float* red = (float*)smem;
  const int tid = opaque_tid(), tx = tid & 31, ty = tid >> 5;
  float* mod = (float*)(p.ws + OFF_MOD);
  it = opq(it);
  {
    int l = it / 96;
    int j = (it % 96) * 32 + tx;
    const float* W = p.ada_w + (size_t)l * 1024 * 3072;
    float* cs = red + 256;
#pragma unroll
    for (int i = 0; i < 4; ++i) cs[tid + 256 * i] = silu(p.c[tid + 256 * i]);
    __syncthreads();
    float acc = 0.f;
#pragma unroll 1
    for (int i0 = 0; i0 < 128; i0 += 16) {
      float wv[16];
#pragma unroll
      for (int i = 0; i < 16; ++i) wv[i] = W[(size_t)(ty * 128 + i0 + i) * 3072 + j];
#pragma unroll
      for (int i = 0; i < 16; ++i) acc += cs[ty * 128 + i0 + i] * wv[i];
    }
    red[ty * 32 + tx] = acc;
    __syncthreads();
    if (ty == 0) {
      float s = 0.f;
      for (int g = 0; g < 8; ++g) s += red[g * 32 + tx];
      mod[l * 3072 + j] = s + p.ada_b[l * 3072 + j];
    }
    __syncthreads();
  }
}

__device__ __forceinline__ float wall_src(const Params& p, int l, int k, int n) {
  size_t lk = (size_t)l * 1024 + k;
  if (n < 3072) return p.w_in[lk * 3072 + n];
  if (n < 3136) return (1.f - p.mu_w[lk]) * p.w1[lk * 64 + (n - 3072)];
  if (n < 3200) return p.mu_w[lk] * p.w1[lk * 64 + (n - 3136)];
  if (n < 3264) return (1.f - p.mu_a[lk]) * p.a1[lk * 64 + (n - 3200)];
  if (n < 3328) return p.mu_a[lk] * p.a1[lk * 64 + (n - 3264)];
  if (n < 3344) return p.gk1[lk * 16 + (n - 3328)];
  return 0.f;
}

__device__ void phase_wconv_item(const Params& p, int it, unsigned char* smem) {
  float* tile = (float*)smem;
  const int tid = opaque_tid();
  u16* WALL = (u16*)(p.ws + OFF_WALL);
  u16* WOUT = (u16*)(p.ws + OFF_WOUT);
  it = opq(it);
  {
    bool isout = it >= 3456;
    int l, nt, kt;
    if (!isout) { l = it / 864; int r = it % 864; nt = r >> 4; kt = r & 15; }
    else { int r = it - 3456; l = r >> 8; r &= 255; nt = r >> 4; kt = r & 15; }
    int tx = tid & 63, ty = tid >> 6;
#pragma unroll
    for (int i = 0; i < 16; ++i) {
      int kl = ty + 4 * i;
      int k = kt * 64 + kl, n = nt * 64 + tx;
      float v = isout ? p.w_out[((size_t)l * 1024 + k) * 1024 + n] : wall_src(p, l, k, n);
      tile[kl * 65 + tx] = v;
    }
    __syncthreads();
    int nl = tid >> 2, kq = tid & 3;
    unsigned w[8];
#pragma unroll
    for (int j = 0; j < 8; ++j) w[j] = pack2(tile[(kq * 16 + 2 * j) * 65 + nl], tile[(kq * 16 + 2 * j + 1) * 65 + nl]);
    u16* dst = (isout ? WOUT + ((size_t)l * 1024 + nt * 64 + nl) * 1024 : WALL + ((size_t)l * NALL + nt * 64 + nl) * 1024) + kt * 64 + kq * 16;
    ((uint4*)dst)[0] = make_uint4(w[0], w[1], w[2], w[3]);
    ((uint4*)dst)[1] = make_uint4(w[4], w[5], w[6], w[7]);
    __syncthreads();
  }
}

__device__ void phase_w2t_item(const Params& p, int it) {
  it = opq(it);
  const int c = opaque_tid();
  const int l = it >> 1, which = it & 1;
  const float* src = (which ? p.a2 : p.w2) + (size_t)l * 64 * 256 + c;
  u16* dst = (u16*)(p.ws + (which ? OFF_A2T : OFF_W2T)) + ((size_t)l * 256 + c) * 64;
#pragma unroll
  for (int j8 = 0; j8 < 8; ++j8) {
    float f[8];
#pragma unroll
    for (int q = 0; q < 8; ++q) f[q] = src[(j8 * 8 + q) * 256];
    *(uint4*)(dst + j8 * 8) = make_uint4(pack2(f[0], f[1]), pack2(f[2], f[3]), pack2(f[4], f[5]), pack2(f[6], f[7]));
  }
}

__device__ __forceinline__ void write_h(const Params& p, int l, int row, int lane, const float4* v, float ss) {
  const float* mod = (const float*)(p.ws + OFF_MOD) + l * 3072;
  u16* H = (u16*)(p.ws + OFF_H);
  float rs = rsqrtf(ss * (1.f / 1024.f) + 1e-6f);
#pragma unroll
  for (int i = 0; i < 4; ++i) {
    int col = (lane + 64 * i) * 4;
    float4 g = *(const float4*)(p.norm_pre + l * 1024 + col);
    float4 sh = *(const float4*)(mod + col);
    float4 sc = *(const float4*)(mod + 1024 + col);
    float h0 = v[i].x * rs * g.x * (1.f + sc.x) + sh.x;
    float h1 = v[i].y * rs * g.y * (1.f + sc.y) + sh.y;
    float h2 = v[i].z * rs * g.z * (1.f + sc.z) + sh.z;
    float h3 = v[i].w * rs * g.w * (1.f + sc.w) + sh.w;
    *(uint2*)(H + (size_t)row * 1024 + col) = make_uint2(pack2(h0, h1), pack2(h2, h3));
  }
}

__device__ void phase_h0(const Params& p) {
  const int tid = opaque_tid512(); const int wave = tid >> 6, lane = tid & 63;
  for (int row = blockIdx.x * 8 + wave; row < T_; row += gridDim.x * 8) {
    const float4* xr = (const float4*)(p.x + (size_t)row * 1024);
    float4 v[4];
    float ss = 0.f;
#pragma unroll
    for (int i = 0; i < 4; ++i) {
      v[i] = xr[lane + 64 * i];
      ss += v[i].x * v[i].x + v[i].y * v[i].y + v[i].z * v[i].z + v[i].w * v[i].w;
    }
    ss = wave_sum(ss);
    write_h(p, 0, row, lane, v, ss);
  }
}

__device__ void phase_post(const Params& p, int l) {
  l = opq(l);
  const int tid = opaque_tid512(); const int wave = tid >> 6, lane = tid & 63;
  const u16* Y = (const u16*)(p.ws + OFF_PROJ);
  const float* mod = (const float*)(p.ws + OFF_MOD) + l * 3072;
  const float* xold = (l == 0) ? p.x : p.out;
  for (int row = blockIdx.x * 8 + wave; row < T_; row += gridDim.x * 8) {
    const uint2* yr = (const uint2*)(Y + (size_t)row * 1024);
    const float4* xr = (const float4*)(xold + (size_t)row * 1024);
    float4 y[4], v[4];
    float ss = 0.f;
#pragma unroll
    for (int i = 0; i < 4; ++i) {
      const uint2 u = yr[lane + 64 * i];
      y[i] = make_float4(bflo(u.x), bfhi(u.x), bflo(u.y), bfhi(u.y));
      v[i] = xr[lane + 64 * i];
      ss += y[i].x * y[i].x + y[i].y * y[i].y + y[i].z * y[i].z + y[i].w * y[i].w;
    }
    ss = wave_sum(ss);
    float rs = rsqrtf(ss * (1.f / 1024.f) + 1e-6f);
    float s2 = 0.f;
#pragma unroll
    for (int i = 0; i < 4; ++i) {
      int col = (lane + 64 * i) * 4;
      float4 g = *(const float4*)(p.norm_post + l * 1024 + col);
      float4 gt = *(const float4*)(mod + 2048 + col);
      v[i].x += gt.x * (y[i].x * rs * g.x);
      v[i].y += gt.y * (y[i].y * rs * g.y);
      v[i].z += gt.z * (y[i].z * rs * g.z);
      v[i].w += gt.w * (y[i].w * rs * g.w);
      *(float4*)(p.out + (size_t)row * 1024 + col) = v[i];
      s2 += v[i].x * v[i].x + v[i].y * v[i].y + v[i].z * v[i].z + v[i].w * v[i].w;
    }
    if (l < 3) {
      s2 = wave_sum(s2);
      write_h(p, l + 1, row, lane, v, s2);
    }
  }
}

__device__ void attn_item(const Params& p, int l, int item, unsigned char* smem) {
  l = opq(l); item = opq(item);
  u16* Vt = (u16*)smem;
  const u16* PROJ = (const u16*)(p.ws + OFF_PROJ);
  u16* MIX = (u16*)(p.ws + OFF_MIX);
  const int tid = opaque_tid(), w = tid >> 6, lane = tid & 63, l31 = lane & 31, hf = lane >> 5;
  const int qb = item >> 3, head = item & 7, kvh = head >> 2;
  const int kpos0 = (qb - 1) * 128;
  {
    int kp = kpos0 + tid;
    if (kp < 0) kp = 0;
    const uint4* src = (const uint4*)(PROJ + (size_t)kp * NALL + 640 + kvh * 64);
#pragma unroll
    for (int c8 = 0; c8 < 8; ++c8) {
      uint4 v = src[c8];
      int d = c8 * 8;
      Vt[(d + 0) * 264 + tid] = (u16)(v.x & 0xffff);
      Vt[(d + 1) * 264 + tid] = (u16)(v.x >> 16);
      Vt[(d + 2) * 264 + tid] = (u16)(v.y & 0xffff);
      Vt[(d + 3) * 264 + tid] = (u16)(v.y >> 16);
      Vt[(d + 4) * 264 + tid] = (u16)(v.z & 0xffff);
      Vt[(d + 5) * 264 + tid] = (u16)(v.z >> 16);
      Vt[(d + 6) * 264 + tid] = (u16)(v.w & 0xffff);
      Vt[(d + 7) * 264 + tid] = (u16)(v.w >> 16);
    }
  }
  const int tq = qb * 128 + 32 * w + l31;
  bf16x8 qf[4], kc[4];
  {
    const u16* qp = PROJ + (size_t)tq * NALL + head * 64 + 8 * hf;
#pragma unroll
    for (int s = 0; s < 4; ++s) qf[s] = *(const bf16x8*)(qp + 16 * s);
    int kp = kpos0 + 32 * w + l31;
    if (kp < 0) kp = 0;
    const u16* kptr = PROJ + (size_t)kp * NALL + 512 + kvh * 64 + 8 * hf;
#pragma unroll
    for (int s = 0; s < 4; ++s) kc[s] = *(const bf16x8*)(kptr + 16 * s);
  }
  __syncthreads();
  const float slope = exp2f(-(float)(head + 1));
  const float sink = p.sinks[l * 8 + head];
  const int rq = 32 * w + l31;
  float mrun = -1e30f, lsum = 0.f;
  f32x16 o0, o1;
#pragma unroll
  for (int r = 0; r < 16; ++r) { o0[r] = 0.f; o1[r] = 0.f; }
#pragma unroll 1
  for (int i = 0; i < 5; ++i) {
    bf16x8 kn[4];
    {
      const int in_ = (i < 4) ? i + 1 : 4;
      int kp = kpos0 + 32 * w + 32 * in_ + l31;
      if (kp < 0) kp = 0;
      const u16* kptr = PROJ + (size_t)kp * NALL + 512 + kvh * 64 + 8 * hf;
#pragma unroll
      for (int s = 0; s < 4; ++s) kn[s] = *(const bf16x8*)(kptr + 16 * s);
    }
    f32x16 a;
#pragma unroll
    for (int r = 0; r < 16; ++r) a[r] = 0.f;
#pragma unroll
    for (int s = 0; s < 4; ++s) a = __builtin_amdgcn_mfma_f32_32x32x16_bf16(kc[s], qf[s], a, 0, 0, 0);
#pragma unroll
    for (int s = 0; s < 4; ++s) kc[s] = kn[s];
    float tmax = -1e30f;
#pragma unroll
    for (int r = 0; r < 16; ++r) {
      int kj = 32 * w + 32 * i + (r & 3) + 8 * (r >> 2) + 4 * hf;
      int dist = 128 + rq - kj;
      bool valid = (dist >= 0) && (dist < 128) && (kpos0 + kj >= 0);
      float sv = a[r] * 0.125f - slope * (float)dist;
      sv = valid ? sv : -1e30f;
      a[r] = sv;
      tmax = fmaxf(tmax, sv);
    }
    tmax = fmaxf(tmax, __shfl_xor(tmax, 32));
    const float mnew = fmaxf(mrun, tmax);
    const float alpha = __expf(mrun - mnew);
    float psum = 0.f;
#pragma unroll
    for (int r = 0; r < 16; ++r) {
      float e = (a[r] > -1e29f) ? __expf(a[r] - mnew) : 0.f;
      a[r] = e;
      psum += e;
    }
    lsum = lsum * alpha + psum;
    mrun = mnew;
#pragma unroll
    for (int r = 0; r < 16; ++r) { o0[r] *= alpha; o1[r] *= alpha; }
#pragma unroll
    for (int u = 0; u < 2; ++u) {
      bf16x8 pf;
#pragma unroll
      for (int j = 0; j < 8; ++j) pf[j] = (short)f2bf(a[8 * u + j]);
      const int kb = 32 * w + 32 * i + 16 * u + 4 * hf;
      const u16* v0 = Vt + l31 * 264 + kb;
      const u16* v1 = Vt + (32 + l31) * 264 + kb;
      uint2 a0 = *(const uint2*)(v0), a1 = *(const uint2*)(v0 + 8);
      uint2 b0 = *(const uint2*)(v1), b1 = *(const uint2*)(v1 + 8);
      uint4 A0 = make_uint4(a0.x, a0.y, a1.x, a1.y), A1 = make_uint4(b0.x, b0.y, b1.x, b1.y);
      o0 = __builtin_amdgcn_mfma_f32_32x32x16_bf16(__builtin_bit_cast(bf16x8, A0), pf, o0, 0, 0, 0);
      o1 = __builtin_amdgcn_mfma_f32_32x32x16_bf16(__builtin_bit_cast(bf16x8, A1), pf, o1, 0, 0, 0);
    }
  }
  {
    const float mf = fmaxf(mrun, sink);
    const float scl = __expf(mrun - mf);
    const float ltot = (lsum + __shfl_xor(lsum, 32)) * scl + __expf(sink - mf);
    const float fin = scl / ltot;
#pragma unroll
    for (int r = 0; r < 16; ++r) { o0[r] *= fin; o1[r] *= fin; }
  }
  const u16* gp = PROJ + (size_t)tq * NALL + 768 + head * 64;
  u16* op = MIX + (size_t)tq * 1024 + head * 64;
#pragma unroll
  for (int g = 0; g < 4; ++g) {
    int d0 = 8 * g + 4 * hf;
    uint2 gg = *(const uint2*)(gp + d0);
    float r0 = o0[4 * g + 0] * silu(bflo(gg.x)), r1 = o0[4 * g + 1] * silu(bfhi(gg.x));
    float r2 = o0[4 * g + 2] * silu(bflo(gg.y)), r3 = o0[4 * g + 3] * silu(bfhi(gg.y));
    *(uint2*)(op + d0) = make_uint2(pack2(r0, r1), pack2(r2, r3));
    uint2 g2 = *(const uint2*)(gp + 32 + d0);
    r0 = o1[4 * g + 0] * silu(bflo(g2.x)); r1 = o1[4 * g + 1] * silu(bfhi(g2.x));
    r2 = o1[4 * g + 2] * silu(bflo(g2.y)); r3 = o1[4 * g + 3] * silu(bfhi(g2.y));
    *(uint2*)(op + 32 + d0) = make_uint2(pack2(r0, r1), pack2(r2, r3));
  }
  __syncthreads();
}

__device__ void rwkv_prep_item(const Params& p, int l, int item, unsigned char* smem) {
  l = opq(l); item = opq(item);
  u16* lwb = (u16*)smem;
  u16* lab = lwb + 16 * 72;
  const u16* PROJ = (const u16*)(p.ws + OFF_PROJ);
  const int tid = opaque_tid(), head = tid >> 6, lane = tid & 63, fr = lane & 15, fq = lane >> 4;
  const int t0 = item * 16;
  {
    const int which = tid >> 7, tt = (tid >> 3) & 15, j0 = (tid & 7) * 8;
    const int t = t0 + tt;
    const u16* pr = PROJ + (size_t)t * NALL;
    const u16* pq = (t > 0) ? pr - NALL : pr;
    const float pm = (t > 0) ? 1.f : 0.f;
    const uint4 cu = *(const uint4*)(pr + (which ? 3200 : 3072) + j0);
    const uint4 pu = *(const uint4*)(pq + (which ? 3264 : 3136) + j0);
    float sv[8];
    sv[0] = bflo(cu.x) + pm * bflo(pu.x); sv[1] = bfhi(cu.x) + pm * bfhi(pu.x);
    sv[2] = bflo(cu.y) + pm * bflo(pu.y); sv[3] = bfhi(cu.y) + pm * bfhi(pu.y);
    sv[4] = bflo(cu.z) + pm * bflo(pu.z); sv[5] = bfhi(cu.z) + pm * bfhi(pu.z);
    sv[6] = bflo(cu.w) + pm * bflo(pu.w); sv[7] = bfhi(cu.w) + pm * bfhi(pu.w);
    if (!which) {
#pragma unroll
      for (int q = 0; q < 8; ++q) sv[q] = tanh_fast(sv[q]);
    }
    *(uint4*)((which ? lab : lwb) + tt * 72 + j0) = make_uint4(pack2(sv[0], sv[1]), pack2(sv[2], sv[3]), pack2(sv[4], sv[5]), pack2(sv[6], sv[7]));
  }
  __syncthreads();
  f32x4 accw[4], acca[4];
#pragma unroll
  for (int nt = 0; nt < 4; ++nt) { accw[nt] = (f32x4){0.f, 0.f, 0.f, 0.f}; acca[nt] = (f32x4){0.f, 0.f, 0.f, 0.f}; }
  {
    const u16* W2T = (const u16*)(p.ws + OFF_W2T) + ((size_t)l * 256 + head * 64 + fr * 4) * 64 + fq * 8;
    const u16* A2T = (const u16*)(p.ws + OFF_A2T) + ((size_t)l * 256 + head * 64 + fr * 4) * 64 + fq * 8;
#pragma unroll
    for (int ks = 0; ks < 2; ++ks) {
      const bf16x8 aw = *(const bf16x8*)(lwb + fr * 72 + ks * 32 + fq * 8);
      const bf16x8 aa = *(const bf16x8*)(lab + fr * 72 + ks * 32 + fq * 8);
#pragma unroll
      for (int nt = 0; nt < 4; ++nt) {
        const bf16x8 bw = *(const bf16x8*)(W2T + nt * 64 + ks * 32);
        const bf16x8 ba = *(const bf16x8*)(A2T + nt * 64 + ks * 32);
        accw[nt] = __builtin_amdgcn_mfma_f32_16x16x32_bf16(aw, bw, accw[nt], 0, 0, 0);
        acca[nt] = __builtin_amdgcn_mfma_f32_16x16x32_bf16(aa, ba, acca[nt], 0, 0, 0);
      }
    }
  }
  const int c0 = head * 64 + fr * 4;
  const float4 mur = *(const float4*)(p.mu_rkv + l * 768 + c0), muk = *(const float4*)(p.mu_rkv + l * 768 + 256 + c0), muv = *(const float4*)(p.mu_rkv + l * 768 + 512 + c0);
  const float4 w0 = *(const float4*)(p.w0 + l * 256 + c0), a0 = *(const float4*)(p.a0 + l * 256 + c0);
  const float4 kkw = *(const float4*)(p.k_k + l * 256 + c0), kaw = *(const float4*)(p.k_a + l * 256 + c0), rkw = *(const float4*)(p.r_k + l * 256 + c0);
  float* RWW = (float*)(p.ws + OFF_RWW);
  float* RWKK = (float*)(p.ws + OFF_RWKK);
  u16* RB = (u16*)(p.ws + OFF_RWB);
  float* BON = (float*)(p.ws + OFF_BONUS);
#define F4E(v, i) ((i) == 0 ? v.x : (i) == 1 ? v.y : (i) == 2 ? v.z : v.w)
#pragma unroll
  for (int rg = 0; rg < 4; ++rg) {
    const int t = t0 + fq * 4 + rg;
    const u16* pr = PROJ + (size_t)t * NALL;
    const u16* pp = (t > 0) ? pr - NALL : pr;
    const float pm = (t > 0) ? 1.f : 0.f;
    const uint2 rcu = *(const uint2*)(pr + 1280 + c0), kcu = *(const uint2*)(pr + 1536 + c0), vcu = *(const uint2*)(pr + 1792 + c0);
    const uint2 rpu = *(const uint2*)(pp + 1280 + c0), kpu = *(const uint2*)(pp + 1536 + c0), vpu = *(const uint2*)(pp + 1792 + c0);
    const float rc[4] = {bflo(rcu.x), bfhi(rcu.x), bflo(rcu.y), bfhi(rcu.y)}, kc[4] = {bflo(kcu.x), bfhi(kcu.x), bflo(kcu.y), bfhi(kcu.y)};
    const float vc[4] = {bflo(vcu.x), bfhi(vcu.x), bflo(vcu.y), bfhi(vcu.y)};
    const float rp[4] = {bflo(rpu.x), bfhi(rpu.x), bflo(rpu.y), bfhi(rpu.y)}, kp[4] = {bflo(kpu.x), bfhi(kpu.x), bflo(kpu.y), bfhi(kpu.y)};
    const float vp[4] = {bflo(vpu.x), bfhi(vpu.x), bflo(vpu.y), bfhi(vpu.y)};
    float kkc[4], av[4], dec[4], rr[4], km[4], vv[4];
    float n2 = 0.f, bonus = 0.f;
#pragma unroll
    for (int nt = 0; nt < 4; ++nt) {
      const float r = rc[nt] + (pm * rp[nt] - rc[nt]) * F4E(mur, nt), k = kc[nt] + (pm * kp[nt] - kc[nt]) * F4E(muk, nt), v = vc[nt] + (pm * vp[nt] - vc[nt]) * F4E(muv, nt);
      const float wpre = F4E(w0, nt) + accw[nt][rg];
      const float wl = -softplusf_(-wpre) - 0.5f;
      dec[nt] = __expf(-__expf(wl));
      const float a = sigmoidf_(F4E(a0, nt) + acca[nt][rg]);
      const float kc2 = k * F4E(kkw, nt);
      const float kmod = k * (1.f + (a - 1.f) * F4E(kaw, nt));
      kkc[nt] = kc2; av[nt] = a; rr[nt] = r; km[nt] = kmod; vv[nt] = v;
      n2 += kc2 * kc2;
      bonus += r * kmod * F4E(rkw, nt);
    }
    n2 = row16_allsum(n2);
    bonus = row16_allsum(bonus);
    const float inv = __builtin_amdgcn_rsqf(fmaxf(n2, 1e-24f));
    const size_t o = (size_t)t * 256 + c0;
    *(float4*)(RWW + o) = make_float4(dec[0], dec[1], dec[2], dec[3]);
    *(float4*)(RWKK + o) = make_float4(kkc[0] * inv, kkc[1] * inv, kkc[2] * inv, kkc[3] * inv);
    *(uint2*)(RB + o) = make_uint2(pack2(rr[0], rr[1]), pack2(rr[2], rr[3]));
    *(uint2*)(RB + (size_t)T_ * 256 + o) = make_uint2(pack2(km[0], km[1]), pack2(km[2], km[3]));
    *(uint2*)(RB + (size_t)2 * T_ * 256 + o) = make_uint2(pack2(vv[0], vv[1]), pack2(vv[2], vv[3]));
    *(uint2*)(RB + (size_t)3 * T_ * 256 + o) = make_uint2(pack2(kkc[0] * inv * av[0], kkc[1] * inv * av[1]), pack2(kkc[2] * inv * av[2], kkc[3] * inv * av[3]));
    if (fr == 0) BON[t * 4 + head] = bonus;
  }
  __syncthreads();
}

__device__ __forceinline__ void gla_b(const Params& p, int l, int head, const u16* lgs, float* tot, float* bl) {
  const int tid = opaque_tid(), d = tid & 31, ig = tid >> 5;
  float g2[16];
#pragma unroll
  for (int m = 0; m < 16; ++m) g2[m] = p.gk2[(size_t)l * 16 * 128 + m * 128 + head * 32 + d];
  const float bias = p.gk_b[l * 128 + head * 32 + d];
  float run = 0.f;
#pragma unroll
  for (int ii = 0; ii < 8; ++ii) {
    const uint4* lp = (const uint4*)(lgs + (ig * 8 + ii) * 16);
    uint4 u0 = lp[0], u1 = lp[1];
    float z = bias;
    z += bflo(u0.x) * g2[0] + bfhi(u0.x) * g2[1] + bflo(u0.y) * g2[2] + bfhi(u0.y) * g2[3];
    z += bflo(u0.z) * g2[4] + bfhi(u0.z) * g2[5] + bflo(u0.w) * g2[6] + bfhi(u0.w) * g2[7];
    z += bflo(u1.x) * g2[8] + bfhi(u1.x) * g2[9] + bflo(u1.y) * g2[10] + bfhi(u1.y) * g2[11];
    z += bflo(u1.z) * g2[12] + bfhi(u1.z) * g2[13] + bflo(u1.w) * g2[14] + bfhi(u1.w) * g2[15];
    float g = (fminf(z, 0.f) - __logf(1.f + __expf(-fabsf(z)))) * (1.f / 16.f);
    run += g;
    bl[ii] = run;
  }
  tot[ig * 32 + d] = run;
  __syncthreads();
  float off = 0.f;
#pragma unroll
  for (int g = 0; g < 8; ++g) off += (g < ig) ? tot[g * 32 + d] : 0.f;
#pragma unroll
  for (int ii = 0; ii < 8; ++ii) bl[ii] += off;
}
__device__ __forceinline__ void st8f(float* dst, const uint4 u) {
  *(float4*)(dst) = make_float4(bflo(u.x), bfhi(u.x), bflo(u.y), bfhi(u.y));
  *(float4*)(dst + 4) = make_float4(bflo(u.z), bfhi(u.z), bflo(u.w), bfhi(u.w));
}

__device__ void gla_local_item(const Params& p, int l, int item, unsigned char* smem) {
  l = opq(l); item = opq(item);
  float* tot = (float*)smem;
  float* Kp = tot + 256;
  float* Vs = Kp + 2048;
  u16* lgs = (u16*)(Vs + 4096);
  const u16* PROJ = (const u16*)(p.ws + OFF_PROJ);
  const int tid = opaque_tid(), d = tid & 31, ig = tid >> 5;
  const int chunk = item >> 2, head = item & 3;
  {
    const u16* base = PROJ + (size_t)(chunk * 64) * NALL;
    const int ki = tid >> 2, kd0 = (tid & 3) * 8;
    const uint4 ku = *(const uint4*)(base + (size_t)ki * NALL + 2432 + head * 32 + kd0);
    const int g0 = tid, g1 = tid + 256;
    const uint4 vu0 = *(const uint4*)(base + (size_t)(g0 >> 3) * NALL + 2560 + head * 64 + (g0 & 7) * 8);
    const uint4 vu1 = *(const uint4*)(base + (size_t)(g1 >> 3) * NALL + 2560 + head * 64 + (g1 & 7) * 8);
    uint4 lu = make_uint4(0u, 0u, 0u, 0u);
    if (tid < 128) lu = *(const uint4*)(base + (size_t)(tid >> 1) * NALL + 3328 + (tid & 1) * 8);
    st8f(Kp + ki * 32 + kd0, ku);
    st8f(Vs + (g0 >> 3) * 64 + (g0 & 7) * 8, vu0);
    st8f(Vs + (g1 >> 3) * 64 + (g1 & 7) * 8, vu1);
    if (tid < 128) *(uint4*)(lgs + (tid >> 1) * 16 + (tid & 1) * 8) = lu;
  }
  __syncthreads();
  float bl[8];
  gla_b(p, l, head, lgs, tot, bl);
  float blast = 0.f;
#pragma unroll
  for (int g = 0; g < 8; ++g) blast += tot[g * 32 + d];
#pragma unroll
  for (int ii = 0; ii < 8; ++ii) {
    const int i = ig * 8 + ii;
    Kp[i * 32 + d] *= __expf(blast - bl[ii]);
  }
  __syncthreads();
  const int v = tid & 63, dg = tid >> 6;
  float acc[8];
#pragma unroll
  for (int q = 0; q < 8; ++q) acc[q] = 0.f;
  for (int i = 0; i < 64; ++i) {
    float vv = Vs[i * 64 + v];
    float4 k0 = *(const float4*)(Kp + i * 32 + dg * 8), k1 = *(const float4*)(Kp + i * 32 + dg * 8 + 4);
    acc[0] += k0.x * vv; acc[1] += k0.y * vv; acc[2] += k0.z * vv; acc[3] += k0.w * vv;
    acc[4] += k1.x * vv; acc[5] += k1.y * vv; acc[6] += k1.z * vv; acc[7] += k1.w * vv;
  }
  float* GS = (float*)(p.ws + OFF_GLAS);
  float* GD = (float*)(p.ws + OFF_GLAD);
#pragma unroll
  for (int q = 0; q < 8; ++q) GS[((size_t)(chunk * 4 + head) * 32 + dg * 8 + q) * 64 + v] = acc[q];
  if (tid < 32) GD[(chunk * 4 + head) * 32 + tid] = __expf(blast);
  __syncthreads();
}

__device__ void gla_state_block(const Params& p, int eb, unsigned char* dsm_) {
  float* comp = (float*)dsm_;
  float* GS = (float*)(p.ws + OFF_GLAS);
  const float* GD = (const float*)(p.ws + OFF_GLAD);
  eb = opq(eb);
  const int tid = opaque_tid512();
  const int ei = tid & 31, g = tid >> 5;
  const int e = eb * 32 + ei;
  const int head = e >> 11, d = (e >> 6) & 31, v = e & 63;
  float ds[16], dc[16];
#pragma unroll
  for (int i = 0; i < 16; ++i) {
    const int c = g * 16 + i;
    ds[i] = GS[((size_t)(c * 4 + head) * 32 + d) * 64 + v];
    dc[i] = GD[(c * 4 + head) * 32 + d];
  }
  float S = 0.f, P = 1.f;
#pragma unroll
  for (int i = 0; i < 16; ++i) { S = dc[i] * S + ds[i]; P *= dc[i]; }
  comp[(g * 32 + ei) * 2] = P;
  comp[(g * 32 + ei) * 2 + 1] = S;
  __syncthreads();
  float G = 0.f;
  for (int gg = 0; gg < g; ++gg) G = comp[(gg * 32 + ei) * 2] * G + comp[(gg * 32 + ei) * 2 + 1];
#pragma unroll
  for (int i = 0; i < 16; ++i) {
    const int c = g * 16 + i;
    GS[((size_t)(c * 4 + head) * 32 + d) * 64 + v] = G;
    G = dc[i] * G + ds[i];
  }
  __syncthreads();
}

__device__ void gla_out_item(const Params& p, int l, int item, unsigned char* smem) {
  l = opq(l); item = opq(item);
  float* tot = (float*)smem;
  float* qt = tot + 256;
  float* kt = qt + 2304;
  float* Vs = kt + 2304;
  float* Am = Vs + 4096;
  float* Ss = Am + 4352;
  u16* lgs = (u16*)(Ss + 2048);
  const u16* PROJ = (const u16*)(p.ws + OFF_PROJ);
  u16* MIX = (u16*)(p.ws + OFF_MIX);
  const float* GS = (const float*)(p.ws + OFF_GLAS);
  const int tid = opaque_tid();
  const int chunk = item >> 2, head = item & 3;
  {
    const u16* base = PROJ + (size_t)(chunk * 64) * NALL;
    const int ki = tid >> 2, kd0 = (tid & 3) * 8;
    const uint4 qu = *(const uint4*)(base + (size_t)ki * NALL + 2304 + head * 32 + kd0);
    const uint4 ku = *(const uint4*)(base + (size_t)ki * NALL + 2432 + head * 32 + kd0);
    const int g0 = tid, g1 = tid + 256;
    const uint4 vu0 = *(const uint4*)(base + (size_t)(g0 >> 3) * NALL + 2560 + head * 64 + (g0 & 7) * 8);
    const uint4 vu1 = *(const uint4*)(base + (size_t)(g1 >> 3) * NALL + 2560 + head * 64 + (g1 & 7) * 8);
    const float4 s0 = ((const float4*)(GS + (size_t)(chunk * 4 + head) * 2048))[tid];
    const float4 s1 = ((const float4*)(GS + (size_t)(chunk * 4 + head) * 2048))[tid + 256];
    uint4 lu = make_uint4(0u, 0u, 0u, 0u);
    if (tid < 128) lu = *(const uint4*)(base + (size_t)(tid >> 1) * NALL + 3328 + (tid & 1) * 8);
    st8f(qt + ki * 36 + kd0, qu);
    st8f(kt + ki * 36 + kd0, ku);
    st8f(Vs + (g0 >> 3) * 64 + (g0 & 7) * 8, vu0);
    st8f(Vs + (g1 >> 3) * 64 + (g1 & 7) * 8, vu1);
    ((float4*)Ss)[tid] = s0;
    ((float4*)Ss)[tid + 256] = s1;
    if (tid < 128) *(uint4*)(lgs + (tid >> 1) * 16 + (tid & 1) * 8) = lu;
  }
  __syncthreads();
  {
    const int d = tid & 31, ig = tid >> 5;
    float bl[8];
    gla_b(p, l, head, lgs, tot, bl);
#pragma unroll
    for (int ii = 0; ii < 8; ++ii) {
      const int i = ig * 8 + ii;
      qt[i * 36 + d] *= 0.17677669529663687f * __expf(bl[ii]);
      kt[i * 36 + d] *= __expf(-bl[ii]);
    }
  }
  __syncthreads();
  const int j = tid & 63, ig = tid >> 6;
  {
    float acc[16];
#pragma unroll
    for (int ii = 0; ii < 16; ++ii) acc[ii] = 0.f;
#pragma unroll 2
    for (int d4 = 0; d4 < 8; ++d4) {
      const float4 kv = *(const float4*)(kt + j * 36 + d4 * 4);
#pragma unroll
      for (int ii = 0; ii < 16; ++ii) {
        const float4 qv = *(const float4*)(qt + (ig * 16 + ii) * 36 + d4 * 4);
        acc[ii] += qv.x * kv.x + qv.y * kv.y + qv.z * kv.z + qv.w * kv.w;
      }
    }
#pragma unroll
    for (int ii = 0; ii < 16; ++ii) {
      int i = ig * 16 + ii;
      Am[i * 68 + j] = (j <= i) ? acc[ii] : 0.f;
    }
  }
  __syncthreads();
  {
    const int v = j;
    float acc[16];
#pragma unroll
    for (int ii = 0; ii < 16; ++ii) acc[ii] = 0.f;
    const int jmax = (ig + 1) * 4;
    for (int j4 = 0; j4 < jmax; ++j4) {
      const float v0 = Vs[(j4 * 4 + 0) * 64 + v], v1 = Vs[(j4 * 4 + 1) * 64 + v], v2 = Vs[(j4 * 4 + 2) * 64 + v], v3 = Vs[(j4 * 4 + 3) * 64 + v];
#pragma unroll
      for (int ii = 0; ii < 16; ++ii) {
        const float4 av = *(const float4*)(Am + (ig * 16 + ii) * 68 + j4 * 4);
        acc[ii] += av.x * v0 + av.y * v1 + av.z * v2 + av.w * v3;
      }
    }
#pragma unroll 2
    for (int d4 = 0; d4 < 8; ++d4) {
      const float s0 = Ss[(d4 * 4 + 0) * 64 + v], s1 = Ss[(d4 * 4 + 1) * 64 + v], s2 = Ss[(d4 * 4 + 2) * 64 + v], s3 = Ss[(d4 * 4 + 3) * 64 + v];
#pragma unroll
      for (int ii = 0; ii < 16; ++ii) {
        const float4 qv = *(const float4*)(qt + (ig * 16 + ii) * 36 + d4 * 4);
        acc[ii] += qv.x * s0 + qv.y * s1 + qv.z * s2 + qv.w * s3;
      }
    }
    const float nw = p.gla_nw[l * 64 + v];
#pragma unroll
    for (int ii = 0; ii < 16; ++ii) {
      int t = chunk * 64 + ig * 16 + ii;
      float o = acc[ii];
      float ms = wave_sum(o * o) * (1.f / 64.f);
      float gg = bf2f(PROJ[(size_t)t * NALL + 2816 + head * 64 + v]);
      float r = o * rsqrtf(ms + 1e-5f) * nw * silu(gg);
      MIX[(size_t)t * 1024 + 768 + head * 64 + v] = f2bf(r);
    }
  }
  __syncthreads();
}

typedef float f32x2 __attribute__((ext_vector_type(2)));
__device__ __forceinline__ float oct_allsum(float x) {
  x += dpp_f<0xB1>(x);
  x += dpp_f<0x4E>(x);
  x += dpp_f<0x141>(x);
  return x;
}
__device__ void rwkv_scan_item(const Params& p, int item, unsigned char* dsm_) {
  item = opq(item);
  float* st = (float*)dsm_;
  const int tid = opaque_tid512(), wv = tid >> 6, lane = tid & 63, rs = lane >> 3, kl = lane & 7;
  const int head = item & 3, seg = item >> 2;
  const bool ident = wv >= 4;
  const int R0 = wv * 16 + rs * 2;
  const int v0 = R0 & 63;
  const float* RWW = (const float*)(p.ws + OFF_RWW);
  const float* RWKK = (const float*)(p.ws + OFF_RWKK);
  const u16* RB = (const u16*)(p.ws + OFF_RWB);
  float* PF = (float*)(p.ws + OFF_PROJ);
  float* ZP = (float*)(p.ws + OFF_ZP);
  const int tbase = seg * SL;
  const int half = tid >> 8, ls = (tid & 255) >> 4, lc4 = (tid & 15) * 4;
  f32x2 S0[4], S1[4];
#pragma unroll
  for (int e = 0; e < 4; ++e) { S0[e] = (f32x2){0.f, 0.f}; S1[e] = (f32x2){0.f, 0.f}; }
  if (ident) {
#pragma unroll
    for (int e = 0; e < 4; ++e) {
      const int k0 = kl * 8 + 2 * e;
      S0[e] = (f32x2){(v0 == k0) ? 1.f : 0.f, (v0 == k0 + 1) ? 1.f : 0.f};
      S1[e] = (f32x2){(v0 + 1 == k0) ? 1.f : 0.f, (v0 + 1 == k0 + 1) ? 1.f : 0.f};
    }
  }
  float4 g0 = make_float4(0.f, 0.f, 0.f, 0.f);
  uint2 h0 = make_uint2(0u, 0u), h1 = h0, h2 = h0;
  const float* gp0 = (half == 0 ? RWW : RWKK) + (size_t)(tbase + ls) * 256 + head * 64 + lc4;
  const u16* hp = RB + (size_t)(tbase + ls) * 256 + head * 64 + lc4;
#define SCAN_GLOAD(ch) do { const size_t _o = (size_t)(ch) * 16 * 256; g0 = *(const float4*)(gp0 + _o); \
    if (half == 0) { h0 = *(const uint2*)(hp + _o); } \
    else { h0 = *(const uint2*)(hp + (size_t)T_ * 256 + _o); h1 = *(const uint2*)(hp + (size_t)3 * T_ * 256 + _o); h2 = *(const uint2*)(hp + (size_t)2 * T_ * 256 + _o); } } while (0)
#define SCAN_LSTORE(buf) do { float* _b = st + (buf) * 6144 + ls * 64 + lc4; \
    if (half == 0) { *(float4*)(_b) = g0; *(float4*)(_b + 2048) = make_float4(bflo(h0.x), bfhi(h0.x), bflo(h0.y), bfhi(h0.y)); } \
    else { *(float4*)(_b + 1024) = g0; *(float4*)(_b + 3072) = make_float4(bflo(h0.x), bfhi(h0.x), bflo(h0.y), bfhi(h0.y)); \
           *(float4*)(_b + 4096) = make_float4(bflo(h1.x), bfhi(h1.x), bflo(h1.y), bfhi(h1.y)); *(float4*)(_b + 5120) = make_float4(bflo(h2.x), bfhi(h2.x), bflo(h2.y), bfhi(h2.y)); } } while (0)
  if (tid < 16) st[2 * 6144 + tid] = 0.f;
  SCAN_GLOAD(0);
  SCAN_LSTORE(0);
  __syncthreads();
  const int nch = SL / 16;
  float* yout = PF + (size_t)tbase * PROJF + (ident ? 256 : 0) + head * 64 + v0;
  const int voff = ident ? (2 * 6144) : (5120 + v0);
  const int vstep = ident ? 0 : 64, vbuf = ident ? 0 : 6144;
#define V2(a, i) ((f32x2){(i) ? a.z : a.x, (i) ? a.w : a.y})
#define SCAN_STEP(s_) do { \
    const float* bp = b + (s_) * 64 + kl * 8; \
    const float4 wl = *(const float4*)(bp), wh = *(const float4*)(bp + 4); \
    const float4 kkl = *(const float4*)(bp + 1024), kkh = *(const float4*)(bp + 1028); \
    const float4 rl4 = *(const float4*)(bp + 2048), rh4 = *(const float4*)(bp + 2052); \
    const float4 kl4 = *(const float4*)(bp + 3072), kh4 = *(const float4*)(bp + 3076); \
    const float4 bl4 = *(const float4*)(bp + 4096), bh4 = *(const float4*)(bp + 4100); \
    const f32x2 vv = *(const f32x2*)(vsrc + (s_) * vstep); \
    const f32x2 W[4] = {V2(wl, 0), V2(wl, 1), V2(wh, 0), V2(wh, 1)}, KK[4] = {V2(kkl, 0), V2(kkl, 1), V2(kkh, 0), V2(kkh, 1)}; \
    const f32x2 RR[4] = {V2(rl4, 0), V2(rl4, 1), V2(rh4, 0), V2(rh4, 1)}, KV[4] = {V2(kl4, 0), V2(kl4, 1), V2(kh4, 0), V2(kh4, 1)}; \
    const f32x2 BB[4] = {V2(bl4, 0), V2(bl4, 1), V2(bh4, 0), V2(bh4, 1)}; \
    f32x2 t0 = S0[0] * KK[0] + S0[1] * KK[1] + S0[2] * KK[2] + S0[3] * KK[3]; \
    f32x2 t1 = S1[0] * KK[0] + S1[1] * KK[1] + S1[2] * KK[2] + S1[3] * KK[3]; \
    float sa0 = -(t0.x + t0.y), sa1 = -(t1.x + t1.y); \
    sa0 += dpp_f<0xB1>(sa0); sa1 += dpp_f<0xB1>(sa1); sa0 += dpp_f<0x4E>(sa0); sa1 += dpp_f<0x4E>(sa1); sa0 += dpp_f<0x141>(sa0); sa1 += dpp_f<0x141>(sa1); \
    const f32x2 a0 = {sa0, sa0}, a1 = {sa1, sa1}, u0 = {vv.x, vv.x}, u1 = {vv.y, vv.y}; \
    _Pragma("unroll") for (int e = 0; e < 4; ++e) { S0[e] = S0[e] * W[e] + a0 * BB[e] + u0 * KV[e]; S1[e] = S1[e] * W[e] + a1 * BB[e] + u1 * KV[e]; } \
    f32x2 q0 = S0[0] * RR[0] + S0[1] * RR[1] + S0[2] * RR[2] + S0[3] * RR[3]; \
    f32x2 q1 = S1[0] * RR[0] + S1[1] * RR[1] + S1[2] * RR[2] + S1[3] * RR[3]; \
    float y0 = q0.x + q0.y, y1 = q1.x + q1.y; \
    y0 += dpp_f<0xB1>(y0); y1 += dpp_f<0xB1>(y1); y0 += dpp_f<0x4E>(y0); y1 += dpp_f<0x4E>(y1); y0 += dpp_f<0x141>(y0); y1 += dpp_f<0x141>(y1); \
    const bool mine = (kl == ((s_) & 7)); \
    if ((s_) < 8) { ya.x = mine ? y0 : ya.x; ya.y = mine ? y1 : ya.y; } else { yb.x = mine ? y0 : yb.x; yb.y = mine ? y1 : yb.y; } } while (0)
  for (int ch = 0; ch < nch; ++ch) {
    const int cur = ch & 1;
    if (ch + 1 < nch) SCAN_GLOAD(ch + 1);
    const float* b = st + cur * 6144;
    const float* vsrc = st + voff + cur * vbuf;
    f32x2 ya = {0.f, 0.f}, yb = {0.f, 0.f};
#pragma unroll 2
    for (int s = 0; s < 8; ++s) SCAN_STEP(s);
#pragma unroll 2
    for (int s = 8; s < 16; ++s) SCAN_STEP(s);
    *(f32x2*)(yout + (size_t)(ch * 16 + kl) * PROJF) = ya;
    *(f32x2*)(yout + (size_t)(ch * 16 + 8 + kl) * PROJF) = yb;
    if (ch + 1 < nch) SCAN_LSTORE(cur ^ 1);
    __syncthreads();
  }
#pragma unroll
  for (int j = 0; j < 2; ++j) {
    float* zp = ZP + ((size_t)((seg * 4 + head) * 128 + R0 + j)) * 64 + kl * 8;
    if (j == 0) { *(float4*)(zp) = make_float4(S0[0].x, S0[0].y, S0[1].x, S0[1].y); *(float4*)(zp + 4) = make_float4(S0[2].x, S0[2].y, S0[3].x, S0[3].y); }
    else { *(float4*)(zp) = make_float4(S1[0].x, S1[0].y, S1[1].x, S1[1].y); *(float4*)(zp + 4) = make_float4(S1[2].x, S1[2].y, S1[3].x, S1[3].y); }
  }
}

__device__ void rwkv_combine(const Params& p, unsigned char* dsm_) {
  float* ring = (float*)dsm_;
  float* ZP = (float*)(p.ws + OFF_ZP);
  const int tid = opaque_tid512(); const int lane = tid & 63;
  const int rowi = blockIdx.x * 8 + (tid >> 6);
  const int head = rowi >> 6, v = rowi & 63;
  float4 pa0, pa1, pa2, pa3, pb0, pb1, pb2, pb3;
  float z0, z1, z2, z3;
#define COMB_ONE(stg_, q, PA, PB, Z) do { const float* base = ZP + (size_t)((((stg_) * 4 + q) * 4 + head) * 128) * 64; \
      PA = ((const float4*)(base + 4096))[tid]; PB = ((const float4*)(base + 4096))[tid + 512]; Z = base[v * 64 + lane]; } while (0)
#define COMB_ISSUE(stg_) do { COMB_ONE(stg_, 0, pa0, pb0, z0); COMB_ONE(stg_, 1, pa1, pb1, z1); COMB_ONE(stg_, 2, pa2, pb2, z2); COMB_ONE(stg_, 3, pa3, pb3, z3); } while (0)
#define COMB_SEG(q, ZC) do { const int seg = stg * 4 + q; \
      ZP[((size_t)((seg * 4 + head) * 128 + v)) * 64 + lane] = s; \
      float ns0 = ZC, ns1 = 0.f; const float* P = buf + q * 4096 + lane; \
      _Pragma("unroll") for (int i = 0; i < 64; i += 2) { \
        float s0 = __builtin_bit_cast(float, __builtin_amdgcn_readlane(__builtin_bit_cast(int, s), i)); \
        float s1 = __builtin_bit_cast(float, __builtin_amdgcn_readlane(__builtin_bit_cast(int, s), i + 1)); \
        ns0 += s0 * P[i * 64]; ns1 += s1 * P[(i + 1) * 64]; } \
      s = ns0 + ns1; } while (0)
  COMB_ISSUE(0);
  float s = 0.f;
#pragma unroll 1
  for (int stg = 0; stg < NSEG / 4; ++stg) {
    float* buf = ring + (stg & 1) * 16384;
    ((float4*)(buf))[tid] = pa0; ((float4*)(buf))[tid + 512] = pb0;
    ((float4*)(buf + 4096))[tid] = pa1; ((float4*)(buf + 4096))[tid + 512] = pb1;
    ((float4*)(buf + 8192))[tid] = pa2; ((float4*)(buf + 8192))[tid + 512] = pb2;
    ((float4*)(buf + 12288))[tid] = pa3; ((float4*)(buf + 12288))[tid + 512] = pb3;
    const float c0 = z0, c1 = z1, c2 = z2, c3 = z3;
    __syncthreads();
    if (stg + 1 < NSEG / 4) COMB_ISSUE(stg + 1);
    COMB_SEG(0, c0); COMB_SEG(1, c1); COMB_SEG(2, c2); COMB_SEG(3, c3);
  }
  __syncthreads();
}

__device__ __forceinline__ bf16x8 pack8(const float4 a, const float4 b) {
  uint4 u = make_uint4(pack2(a.x, a.y), pack2(a.z, a.w), pack2(b.x, b.y), pack2(b.z, b.w));
  return __builtin_bit_cast(bf16x8, u);
}
__device__ void rwkv_final_item(const Params& p, int l, int item, unsigned char* smem) {
  l = opq(l); item = opq(item);
  const int tid = opaque_tid(), w = tid >> 6, lane = tid & 63, l31 = lane & 31, hf = lane >> 5;
  const int parts = SL / 128;
  const int q = item % parts, head = (item / parts) & 3, seg = item / (parts * 4);
  const int t = seg * SL + q * 128 + w * 32 + l31;
  const float* ZP = (const float*)(p.ws + OFF_ZP);
  const float* PF = (const float*)(p.ws + OFF_PROJ);
  const u16* PROJ = (const u16*)(p.ws + OFF_PROJ);
  const u16* RBv = (const u16*)(p.ws + OFF_RWB) + (size_t)2 * T_ * 256;
  const float* BON = (const float*)(p.ws + OFF_BONUS);
  u16* MIX = (u16*)(p.ws + OFF_MIX);
  f32x16 acc0, acc1;
#pragma unroll
  for (int r = 0; r < 16; ++r) { acc0[r] = 0.f; acc1[r] = 0.f; }
  {
    const float* sp = ZP + ((size_t)((seg * 4 + head) * 128 + l31)) * 64 + 8 * hf;
    const float* rp = PF + (size_t)t * PROJF + 256 + head * 64 + 8 * hf;
#pragma unroll
    for (int ks = 0; ks < 4; ++ks) {
      const bf16x8 bfrag = pack8(*(const float4*)(rp + 16 * ks), *(const float4*)(rp + 16 * ks + 4));
      const bf16x8 a0 = pack8(*(const float4*)(sp + 16 * ks), *(const float4*)(sp + 16 * ks + 4));
      const bf16x8 a1 = pack8(*(const float4*)(sp + 32 * 64 + 16 * ks), *(const float4*)(sp + 32 * 64 + 16 * ks + 4));
      acc0 = __builtin_amdgcn_mfma_f32_32x32x16_bf16(a0, bfrag, acc0, 0, 0, 0);
      acc1 = __builtin_amdgcn_mfma_f32_32x32x16_bf16(a1, bfrag, acc1, 0, 0, 0);
    }
  }
  const float* y0p = PF + (size_t)t * PROJF + head * 64 + 4 * hf;
  float sum = 0.f;
#pragma unroll
  for (int g = 0; g < 4; ++g) {
    const float4 ya = *(const float4*)(y0p + 8 * g), yb = *(const float4*)(y0p + 32 + 8 * g);
    acc0[4 * g + 0] += ya.x; acc0[4 * g + 1] += ya.y; acc0[4 * g + 2] += ya.z; acc0[4 * g + 3] += ya.w;
    acc1[4 * g + 0] += yb.x; acc1[4 * g + 1] += yb.y; acc1[4 * g + 2] += yb.z; acc1[4 * g + 3] += yb.w;
  }
#pragma unroll
  for (int r = 0; r < 16; ++r) sum += acc0[r] + acc1[r];
  sum += __shfl_xor(sum, 32);
  const float mean = sum * (1.f / 64.f);
  float var = 0.f;
#pragma unroll
  for (int r = 0; r < 16; ++r) { const float d0 = acc0[r] - mean, d1 = acc1[r] - mean; var += d0 * d0 + d1 * d1; }
  var += __shfl_xor(var, 32);
  const float rstd = rsqrtf(var * (1.f / 64.f) + 64e-5f);
  const float bon = BON[t * 4 + head];
  const int cb = head * 64 + 4 * hf;
#pragma unroll
  for (int mt = 0; mt < 2; ++mt)
#pragma unroll
    for (int g = 0; g < 4; ++g) {
      const int c = cb + mt * 32 + 8 * g;
      const float4 lw = *(const float4*)(p.ln_w + l * 256 + c), lb = *(const float4*)(p.ln_b + l * 256 + c);
      const uint2 vv = *(const uint2*)(RBv + (size_t)t * 256 + c);
      const uint2 gg = *(const uint2*)(PROJ + (size_t)t * NALL + 2048 + c);
      float o0 = (mt ? acc1[4 * g + 0] : acc0[4 * g + 0]), o1 = (mt ? acc1[4 * g + 1] : acc0[4 * g + 1]);
      float o2 = (mt ? acc1[4 * g + 2] : acc0[4 * g + 2]), o3 = (mt ? acc1[4 * g + 3] : acc0[4 * g + 3]);
      o0 = (o0 - mean) * rstd * lw.x + lb.x + bon * bflo(vv.x);
      o1 = (o1 - mean) * rstd * lw.y + lb.y + bon * bfhi(vv.x);
      o2 = (o2 - mean) * rstd * lw.z + lb.z + bon * bflo(vv.y);
      o3 = (o3 - mean) * rstd * lw.w + lb.w + bon * bfhi(vv.y);
      o0 *= silu(bflo(gg.x)); o1 *= silu(bfhi(gg.x)); o2 *= silu(bflo(gg.y)); o3 *= silu(bfhi(gg.y));
      *(uint2*)(MIX + (size_t)t * 1024 + 512 + c) = make_uint2(pack2(o0, o1), pack2(o2, o3));
    }
}

#define LDS_BYTES (131072 + 16)
#ifndef REP_G1
#define REP_G1 1
#endif
#ifndef REP_G2
#define REP_G2 1
#endif
#ifndef REP_P3
#define REP_P3 1
#endif
#ifndef REP_SCAN
#define REP_SCAN 1
#endif
#ifndef REP_GO
#define REP_GO 1
#endif
#ifndef REP_FIN
#define REP_FIN 1
#endif
#define PAIR_LOOP(N, BODY) for (int _pr = blockIdx.x; _pr < (N) / 2; _pr += gridDim.x) { const int it = 2 * _pr + vb; BODY }
__global__ void __launch_bounds__(512) fwd_megakernel(Params p) {
  cg::grid_group grid = cg::this_grid();
  extern __shared__ __attribute__((aligned(16))) unsigned char dsm[];
  const int vb = __builtin_amdgcn_readfirstlane(threadIdx.x >> 8);
  unsigned char* smem = dsm + vb * 65536;
  if (threadIdx.x == 0) *(uint4*)(dsm + 131072) = make_uint4(0u, 0u, 0u, 0u);
  __syncthreads();
  const XcdBarrier xb = xcd_barrier_post((unsigned*)(p.ws + OFF_BAR), (volatile LAS unsigned*)(dsm + 131072));
#define GSYNC() xcd_barrier(xb)
#ifndef PH
#define PH 0xffff
#endif
  if (PH & 1) PAIR_LOOP(384, phase_mod_item(p, it, smem);)
  if (PH & 2) PAIR_LOOP(4480, phase_wconv_item(p, it, smem);)
  if (PH & 2) PAIR_LOOP(8, phase_w2t_item(p, it);)
  grid.sync();
  if (PH & 4) phase_h0(p);
  GSYNC();
#pragma unroll 1
  for (int hl = 0; hl < 8; ++hl) {
    const int l = hl >> 1;
    const bool second = hl & 1;
    if (PH & 8) {
      pg8::Gemm g; g.M = T_; g.K = 1024;
      pg8::EpiU E; E.O = (void*)(p.ws + OFF_PROJ);
      if (!second) { g.A = (const u16*)(p.ws + OFF_H); g.Bt = (const u16*)(p.ws + OFF_WALL) + (size_t)l * NALL * 1024; g.N = 3584; E.ldc = NALL; E.ncols = NALL; E.f32out = 0; }
      else { g.A = (const u16*)(p.ws + OFF_MIX); g.Bt = (const u16*)(p.ws + OFF_WOUT) + (size_t)l * 1024 * 1024; g.N = 1024; E.ldc = 1024; E.ncols = 1024; E.f32out = 0; }
      pg8::StaticOrder S; S.init(T_, g.N, gridDim.x, blockIdx.x);
      const int nrep = second ? REP_G2 : REP_G1;
#pragma unroll 1
      for (int rep = 0; rep < nrep; ++rep)
      pg8::gemm_phase<pg8::EpiU, pg8::StaticOrder, false>((PG8_LAS unsigned char*)dsm, g, S, E, nullptr);
    }
    GSYNC();
    if (!second) {
#pragma unroll 1
      for (int rep = 0; rep < REP_P3; ++rep)
      PAIR_LOOP(3072,
        if (it < 1024) { if (PH & 16) attn_item(p, l, it, smem); }
        else if (it < 2048) { if (PH & 32) rwkv_prep_item(p, l, it - 1024, smem); }
        else { if (PH & 64) gla_local_item(p, l, it - 2048, smem); }
      )
      GSYNC();
      if (PH & 128) for (int eb = blockIdx.x; eb < 256; eb += gridDim.x) gla_state_block(p, eb, dsm);
#pragma unroll 1
      for (int rep = 0; rep < REP_SCAN; ++rep)
      if (PH & 256) for (int it = blockIdx.x; it < NSEG * 4; it += gridDim.x) rwkv_scan_item(p, it, dsm);
      GSYNC();
      if (blockIdx.x < 32) { if (PH & 512) rwkv_combine(p, dsm); }
#pragma unroll 1
      for (int rep = 0; rep < REP_GO; ++rep)
      if (PH & 1024) {
        unsigned* ctr = (unsigned*)(p.ws + OFF_BAR) + 32 + l;
        volatile unsigned* slot = (volatile unsigned*)(dsm + 131072) + 2;
        for (;;) {
          if (threadIdx.x == 0) *slot = atomicAdd(ctr, 1u);
          __syncthreads();
          const unsigned pr = (unsigned)__builtin_amdgcn_readfirstlane((int)*slot);
          __syncthreads();
          if (pr >= 512u) break;
          gla_out_item(p, l, 2 * (int)pr + vb, smem);
        }
      }
      GSYNC();
#pragma unroll 1
      for (int rep = 0; rep < REP_FIN; ++rep)
      if (PH & 2048) PAIR_LOOP(NSEG * 4 * (SL / 128), rwkv_final_item(p, l, it, smem);)
      GSYNC();
    } else {
      if (PH & 8192) phase_post(p, l);
      if (hl < 7) GSYNC();
    }
  }
}

extern "C" void kernel_launch(void* const* d_in, const int* in_sizes, int n_in, void* d_out, int out_size, void* d_ws, size_t ws_size,
                              hipStream_t stream) {
  static int grid_blocks = 0;
  if (!grid_blocks) {
    int dev = 0, cus = 0, per_cu = 0;
    (void)hipGetDevice(&dev);
    (void)hipDeviceGetAttribute(&cus, hipDeviceAttributeMultiprocessorCount, dev);
    (void)hipFuncSetAttribute((const void*)fwd_megakernel, hipFuncAttributeMaxDynamicSharedMemorySize, LDS_BYTES);
    (void)hipOccupancyMaxActiveBlocksPerMultiprocessor(&per_cu, fwd_megakernel, 512, LDS_BYTES);
    if (per_cu < 1) per_cu = 1;
    grid_blocks = cus;
    if (grid_blocks < 32) grid_blocks = 32;
  }
  if (n_in != 27 || ws_size < WS_END) {
    fprintf(stderr, "kernel_launch: unexpected n_in %d / ws %zu\n", n_in, ws_size);
    return;
  }
  Params p{};
  const float** pp = (const float**)&p;
  for (int i = 0; i < 27; ++i) pp[i] = (const float*)d_in[i];
  p.out = (float*)d_out;
  p.ws = (unsigned char*)d_ws;
  (void)hipMemsetAsync((unsigned char*)d_ws + OFF_BAR, 0, XCD_BAR_WORDS * 4, stream);
  void* args[] = {&p};
  hipError_t e = hipLaunchCooperativeKernel((void*)fwd_megakernel, dim3(grid_blocks), dim3(512), args, LDS_BYTES, stream);
  if (e != hipSuccess) fprintf(stderr, "cooperative launch failed: %s (grid %d)\n", hipGetErrorString(e), grid_blocks);
}
```

```cpp
#include <hip/hip_runtime.h>
#include <hip/hip_bf16.h>
#include <hip/hip_cooperative_groups.h>
#include <cstdio>
namespace cg = cooperative_groups;

typedef unsigned short u16;
using bf16x8 = __attribute__((ext_vector_type(8))) short;
using f32x4 = __attribute__((ext_vector_type(4))) float;
using f32x16 = __attribute__((ext_vector_type(16))) float;

#define T_ 16384
#define NALL 3456
#define NSEG 64
#define SL (T_ / NSEG)
#define PROJF 1728

#define OFF_WALL 0ull
#define OFF_WOUT 28311552ull
#define OFF_MOD 36700160ull
#define OFF_H 36749312ull
#define OFF_RWW OFF_H
#define OFF_RWKK (OFF_H + 16777216ull)
#define OFF_PROJ 70303744ull
#define OFF_MIX 183549952ull
#define OFF_RWB 217104384ull
#define OFF_GLAS 250658816ull
#define OFF_GLAD 259047424ull
#define OFF_BONUS 259178496ull
#define OFF_ZP 259440640ull
#define OFF_BAR 267829248ull
#define OFF_W2T 267845632ull
#define OFF_A2T 267976704ull
#define WS_END 268107776ull


struct Params {
  const float *x, *c, *ada_w, *ada_b, *norm_pre, *norm_post, *w_in, *w_out, *sinks, *mu_rkv, *mu_w, *mu_a, *w0, *w1, *w2,
      *a0, *a1, *a2, *k_k, *k_a, *r_k, *ln_w, *ln_b, *gk1, *gk2, *gk_b, *gla_nw;
  float* out;
  unsigned char* ws;
};

__device__ __forceinline__ u16 f2bf(float f) {
  unsigned u = __float_as_uint(f);
  u += 0x7fffu + ((u >> 16) & 1u);
  return (u16)(u >> 16);
}
__device__ __forceinline__ float bf2f(u16 h) { return __uint_as_float(((unsigned)h) << 16); }
__device__ __forceinline__ unsigned pack2(float a, float b) { return (unsigned)f2bf(a) | ((unsigned)f2bf(b) << 16); }
__device__ __forceinline__ float bflo(unsigned u) { return __uint_as_float(u << 16); }
__device__ __forceinline__ float bfhi(unsigned u) { return __uint_as_float(u & 0xffff0000u); }

__device__ __forceinline__ float frcp(float x) { return __builtin_amdgcn_rcpf(x); }
__device__ __forceinline__ float silu(float x) { return x * frcp(1.f + __expf(-x)); }
__device__ __forceinline__ float sigmoidf_(float x) { return frcp(1.f + __expf(-x)); }
__device__ __forceinline__ float softplusf_(float z) { return fmaxf(z, 0.f) + __logf(1.f + __expf(-fabsf(z))); }
__device__ __forceinline__ float tanh_fast(float x) { return 1.f - 2.f * frcp(1.f + __expf(2.f * x)); }

__device__ __forceinline__ int opq(int x) { asm volatile("" : "+s"(x)); return x; }
__device__ __forceinline__ int opaque_tid() { int t = threadIdx.x & 255; asm volatile("" : "+v"(t)); return t; }
__device__ __forceinline__ int opaque_tid512() { int t = threadIdx.x; asm volatile("" : "+v"(t)); return t; }
template <int CTRL>
__device__ __forceinline__ float dpp_f(float x) {
  return __builtin_bit_cast(float, __builtin_amdgcn_update_dpp(0, __builtin_bit_cast(int, x), CTRL, 0xf, 0xf, true));
}
__device__ __forceinline__ float row16_allsum(float x) {
  x += dpp_f<0x128>(x);
  x += dpp_f<0x124>(x);
  x += dpp_f<0x122>(x);
  x += dpp_f<0x121>(x);
  return x;
}
__device__ __forceinline__ float wave_sum(float v) {
  v = row16_allsum(v);
  const int iv = __builtin_bit_cast(int, v);
  const float a = __builtin_bit_cast(float, __builtin_amdgcn_readlane(iv, 0)), b = __builtin_bit_cast(float, __builtin_amdgcn_readlane(iv, 16));
  const float c = __builtin_bit_cast(float, __builtin_amdgcn_readlane(iv, 32)), d = __builtin_bit_cast(float, __builtin_amdgcn_readlane(iv, 48));
  return (a + b) + (c + d);
}

namespace pg8 {
#define PG8_LAS __attribute__((address_space(3)))
typedef unsigned short bf16_t;
typedef short bf16x8 __attribute__((ext_vector_type(8)));
typedef float f32x4 __attribute__((ext_vector_type(4)));
typedef unsigned u32x4 __attribute__((ext_vector_type(4)));
constexpr int BM = 256, BK = 64, HALF = 128, HTB = HALF * BK * 2  , STAGE_BYTES = 8 * HTB, NXCD = 8, WGM = 8;

__host__ __device__ __forceinline__ int lds_byte(int r, int c) { const int st = (r >> 4) * 2 + (c >> 5), rr = r & 15, cc = c & 31, ob = rr * 64 + cc * 2; return st * 1024 + (ob ^ (((ob >> 9) & 1) << 5)); }
__host__ __device__ __forceinline__ void stage_rc(int b, int& R, int& C) { const int st = b / 1024, sb = b % 1024, swz = sb ^ (((sb >> 9) & 1) << 5); R = (st >> 1) * 16 + swz / 64; C = (st & 1) * 32 + (swz % 64) / 2; }
__host__ __device__ __forceinline__ int perm32(int rho) { const int n = rho >> 4, i = rho & 15; return 8 * (i >> 2) + 4 * n + (i & 3); }

struct Unit { int pm, pn; };
struct Gemm { const bf16_t* A; const bf16_t* Bt; int M, N, K; };

struct StaticOrder {
    int nM, nN, nwg, G, c;
    __host__ __device__ void init(int M, int N, int G_, int c_) { nM = M / BM; nN = N / BM; nwg = nM * nN; G = G_; c = c_; }
    __host__ __device__ bool next(int i, Unit& u) const {
        const long L = (long)i * G + c; if (L >= nwg) return false;
        int wgid = (int)L; { const int q = nwg / NXCD, r = nwg % NXCD, xcd = wgid % NXCD, off = wgid / NXCD; wgid = (xcd < r ? xcd * (q + 1) : r * (q + 1) + (xcd - r) * q) + off; }
        const int nig = WGM * nN, gid = wgid / nig, fm = gid * WGM, gsz = (nM - fm) < WGM ? (nM - fm) : WGM;
        u.pm = fm + ((wgid % nig) % gsz); u.pn = (wgid % nig) / gsz; return true;
    }
    __device__ __forceinline__ void a_ready(const Unit&) const {}
    __device__ __forceinline__ void done(const Unit&) const {}
};
__device__ __forceinline__ unsigned cvt_pk_bf16(float lo, float hi) { unsigned r; asm volatile("v_cvt_pk_bf16_f32 %0, %1, %2" : "=v"(r) : "v"(lo), "v"(hi)); return r; }
template <class Epi, class Sched, bool STAMP = false>
__device__ __forceinline__ void gemm_phase(PG8_LAS unsigned char* lds, const Gemm g, const Sched& S, const Epi& E, unsigned long long* stamps) {
    const int tid = threadIdx.x, wid = __builtin_amdgcn_readfirstlane(tid >> 6), lane = tid & 63, wr = wid >> 2, wc = wid & 3, fr = lane & 15, fq = lane >> 4;
    const int K = g.K, nt = K / BK;
    int ts_lo = 0, ts_hi = 0, nts = 0; const unsigned long long rt_entry = STAMP ? (unsigned long long)wall_clock64() : 0ull;
#define PG8_STAMP() do { if (STAMP && wid == 0 && nts < 64) { const unsigned long long _c = (unsigned long long)clock64(); \
        ts_lo = (lane == nts) ? (int)(unsigned)_c : ts_lo; ts_hi = (lane == nts) ? (int)(unsigned)(_c >> 32) : ts_hi; ++nts; } } while (0)
    PG8_STAMP();
    unsigned voffA[2], voffB[2];
#pragma unroll
    for (int i = 0; i < 2; ++i) { int R, C; stage_rc(tid * 16 + i * 8192, R, C); const int Rb = Epi::PERM ? ((R & ~31) + perm32(R & 31)) : R;
        voffA[i] = (unsigned)(R * K + C) * 2u; voffB[i] = (unsigned)(Rb * K + C) * 2u; }
    const size_t kstep = (size_t)(BK * 2);
    const size_t hstep = (size_t)HALF * K * 2;
    const size_t tstep = 2 * hstep;
    const unsigned ldsw = (unsigned)wid * 1024u;
    const int aoff = lds_byte(wr * 64 + fr, fq * 8), boff = lds_byte(wc * 32 + fr, fq * 8);
#define PG8_SA(b, h) (((b) * 2 + (h)) * HTB)
#define PG8_SB(b, h) ((4 + (b) * 2 + (h)) * HTB)
#define PG8_STAGE(bufoff, gbase, voff) do { _Pragma("unroll") for (int _i = 0; _i < 2; ++_i) \
        __builtin_amdgcn_global_load_lds((const unsigned*)((const char*)(gbase) + (voff)[_i]), (PG8_LAS unsigned*)(lds + (bufoff) + ldsw + _i * 8192), 16, 0, 0); } while (0)
#define PG8_LDA(dst, b, h) do { _Pragma("unroll") for (int m = 0; m < 4; ++m) _Pragma("unroll") for (int k = 0; k < 2; ++k) dst[m][k] = *(const PG8_LAS bf16x8*)(lds + PG8_SA(b, h) + aoff + m * 2048 + k * 1024); } while (0)
#define PG8_LDB(dst, b, h) do { _Pragma("unroll") for (int n = 0; n < 2; ++n) _Pragma("unroll") for (int k = 0; k < 2; ++k) dst[n][k] = *(const PG8_LAS bf16x8*)(lds + PG8_SB(b, h) + boff + n * 2048 + k * 1024); } while (0)
#define PG8_MMA(ai, bj, At, Bt) do { __builtin_amdgcn_s_setprio(1); _Pragma("unroll") for (int m = 0; m < 4; ++m) _Pragma("unroll") for (int n = 0; n < 2; ++n) _Pragma("unroll") for (int k = 0; k < 2; ++k) \
        acc[ai][bj][m][n] = __builtin_amdgcn_mfma_f32_16x16x32_bf16(Bt[n][k], At[m][k], acc[ai][bj][m][n], 0, 0, 0); __builtin_amdgcn_s_setprio(0); } while (0)
#define PG8_WAIT_V(n) asm volatile("s_waitcnt vmcnt(" #n ")" ::: "memory")
#define PG8_WAIT_L(n) asm volatile("s_waitcnt lgkmcnt(" #n ")" ::: "memory")
#define PG8_BAR __builtin_amdgcn_s_barrier()
#define PG8_SCHED __builtin_amdgcn_sched_barrier(0)
    Unit cur, nxt; int ui = 0;
    if (!S.next(0, cur)) return;
    f32x4 acc[2][2][4][2];
#pragma unroll
    for (int a = 0; a < 2; ++a)
#pragma unroll
        for (int b = 0; b < 2; ++b)
#pragma unroll
            for (int m = 0; m < 4; ++m)
#pragma unroll
                for (int n = 0; n < 2; ++n) acc[a][b][m][n] = (f32x4){0.f, 0.f, 0.f, 0.f};
    bf16x8 At[4][2], B0[2][2], B1[2][2];
    const char* cA = (const char*)g.A + (size_t)cur.pm * tstep; const char* cB = (const char*)g.Bt + (size_t)cur.pn * tstep;
    S.a_ready(cur);
    PG8_STAGE(PG8_SB(0, 0), cB, voffB); PG8_STAGE(PG8_SA(0, 0), cA, voffA); PG8_STAGE(PG8_SB(0, 1), cB + hstep, voffB); PG8_STAGE(PG8_SA(0, 1), cA + hstep, voffA);
    if (wr == 1) PG8_BAR;
    PG8_WAIT_V(4); PG8_BAR;
    PG8_STAGE(PG8_SB(1, 0), cB + kstep, voffB); PG8_STAGE(PG8_SA(1, 0), cA + kstep, voffA); PG8_STAGE(PG8_SB(1, 1), cB + hstep + kstep, voffB);
    PG8_WAIT_V(6); PG8_BAR;
    PG8_STAMP();
    for (;;) {
        const bool has_next = S.next(ui + 1, nxt);
        const char* nA = has_next ? (const char*)g.A + (size_t)nxt.pm * tstep : cA; const char* nB = has_next ? (const char*)g.Bt + (size_t)nxt.pn * tstep : cB;
        for (int t = 0; t < nt; t += 2) {
            const bool last = (t == nt - 2);
            const char* a1 = cA + (size_t)(t + 1) * kstep;
            const char* a2 = last ? nA : cA + (size_t)(t + 2) * kstep; const char* b2 = last ? nB : cB + (size_t)(t + 2) * kstep;
            const char* a3 = a2 + kstep; const char* b3 = b2 + kstep;
            if (last && has_next) S.a_ready(nxt);
            PG8_LDB(B0, 0, 0); PG8_SCHED; PG8_LDA(At, 0, 0); PG8_STAGE(PG8_SA(1, 1), a1 + hstep, voffA);
            PG8_WAIT_L(8); PG8_BAR; PG8_WAIT_L(0); PG8_MMA(0, 0, At, B0); PG8_BAR; PG8_SCHED;
            PG8_LDB(B1, 0, 1); PG8_STAGE(PG8_SB(0, 0), b2, voffB);
            PG8_BAR; PG8_WAIT_L(0); PG8_MMA(0, 1, At, B1); PG8_BAR;
            PG8_LDA(At, 0, 1); PG8_STAGE(PG8_SA(0, 0), a2, voffA);
            PG8_BAR; PG8_WAIT_L(0); PG8_MMA(1, 0, At, B0); PG8_BAR; PG8_SCHED;
            PG8_STAGE(PG8_SB(0, 1), b2 + hstep, voffB);
            PG8_WAIT_V(6); PG8_BAR; PG8_MMA(1, 1, At, B1); PG8_BAR;
            PG8_LDB(B0, 1, 0); PG8_SCHED; PG8_LDA(At, 1, 0); PG8_STAGE(PG8_SA(0, 1), a2 + hstep, voffA);
            PG8_WAIT_L(8); PG8_BAR; PG8_WAIT_L(0); PG8_MMA(0, 0, At, B0); PG8_BAR; PG8_SCHED;
            PG8_LDB(B1, 1, 1); PG8_STAGE(PG8_SB(1, 0), b3, voffB);
            PG8_BAR; PG8_WAIT_L(0); PG8_MMA(0, 1, At, B1); PG8_BAR;
            PG8_LDA(At, 1, 1); PG8_STAGE(PG8_SA(1, 0), a3, voffA);
            PG8_BAR; PG8_WAIT_L(0); PG8_MMA(1, 0, At, B0); PG8_BAR; PG8_SCHED;
            PG8_STAGE(PG8_SB(1, 1), b3 + hstep, voffB);
            PG8_WAIT_V(6); PG8_BAR; PG8_MMA(1, 1, At, B1); PG8_BAR;
        }
        PG8_STAMP();
        if constexpr (!Epi::AFTER_DRAIN) { E(acc, cur, wr, wc, fr, fq); S.done(cur); }
        PG8_STAMP();
        if (!has_next) break;
#pragma unroll
        for (int a = 0; a < 2; ++a)
#pragma unroll
            for (int b = 0; b < 2; ++b)
#pragma unroll
                for (int m = 0; m < 4; ++m)
#pragma unroll
                    for (int n = 0; n < 2; ++n) acc[a][b][m][n] = (f32x4){0.f, 0.f, 0.f, 0.f};
        cur = nxt; cA = nA; cB = nB; ++ui;
    }
    PG8_WAIT_V(0);
    if (wr == 0) PG8_BAR;
    PG8_BAR;
    if constexpr (Epi::AFTER_DRAIN) { E.fused(acc, cur, wr, wc, fr, fq, lds, wid, lane); S.done(cur); }
    PG8_STAMP();
    if (STAMP && wid == 0) { stamps[lane] = lane < nts ? (((unsigned long long)(unsigned)ts_hi << 32) | (unsigned)ts_lo) : 0ull;
        if (lane == 62) stamps[62] = rt_entry; if (lane == 63) stamps[63] = (unsigned long long)wall_clock64(); }
#undef PG8_STAMP
#undef PG8_SA
#undef PG8_SB
#undef PG8_STAGE
#undef PG8_LDA
#undef PG8_LDB
#undef PG8_MMA
#undef PG8_WAIT_V
#undef PG8_WAIT_L
#undef PG8_BAR
#undef PG8_SCHED
}
}

namespace pg8 {
struct EpiProj {
    static constexpr bool PERM = true, AFTER_DRAIN = false;
    bf16_t* O; int ldc; int ncols;
    __device__ __forceinline__ void operator()(const f32x4 (&acc)[2][2][4][2], const Unit& u, int wr, int wc, int fr, int fq) const {
        const int row0 = u.pm * BM + wr * 64 + fr; const int col0 = u.pn * BM + wc * 32 + 8 * fq;
#pragma unroll
        for (int ai = 0; ai < 2; ++ai)
#pragma unroll
            for (int m = 0; m < 4; ++m) { bf16_t* rowp = O + (size_t)(row0 + ai * HALF + m * 16) * ldc + col0;
#pragma unroll
                for (int bj = 0; bj < 2; ++bj) { const f32x4 v0 = acc[ai][bj][m][0], v1 = acc[ai][bj][m][1];
                    u32x4 w; w.x = cvt_pk_bf16(v0[0], v0[1]); w.y = cvt_pk_bf16(v0[2], v0[3]); w.z = cvt_pk_bf16(v1[0], v1[1]); w.w = cvt_pk_bf16(v1[2], v1[3]);
                    if (col0 + bj * HALF < ncols) *(u32x4*)(rowp + bj * HALF) = w; } }
    }
};
struct EpiU {
    static constexpr bool PERM = true, AFTER_DRAIN = false;
    void* O; int ldc; int ncols; int f32out;
    __device__ __forceinline__ void operator()(const f32x4 (&acc)[2][2][4][2], const Unit& u, int wr, int wc, int fr, int fq) const {
        const int row0 = u.pm * BM + wr * 64 + fr; const int col0 = u.pn * BM + wc * 32 + 8 * fq;
        if (f32out) {
#pragma unroll
            for (int ai = 0; ai < 2; ++ai)
#pragma unroll
                for (int m = 0; m < 4; ++m) { float* rowp = (float*)O + (size_t)(row0 + ai * HALF + m * 16) * ldc + col0;
#pragma unroll
                    for (int bj = 0; bj < 2; ++bj) { *(f32x4*)(rowp + bj * HALF) = acc[ai][bj][m][0]; *(f32x4*)(rowp + bj * HALF + 4) = acc[ai][bj][m][1]; } }
        } else {
#pragma unroll
            for (int ai = 0; ai < 2; ++ai)
#pragma unroll
                for (int m = 0; m < 4; ++m) { bf16_t* rowp = (bf16_t*)O + (size_t)(row0 + ai * HALF + m * 16) * ldc + col0;
#pragma unroll
                    for (int bj = 0; bj < 2; ++bj) { const f32x4 v0 = acc[ai][bj][m][0], v1 = acc[ai][bj][m][1];
                        u32x4 w; w.x = cvt_pk_bf16(v0[0], v0[1]); w.y = cvt_pk_bf16(v0[2], v0[3]); w.z = cvt_pk_bf16(v1[0], v1[1]); w.w = cvt_pk_bf16(v1[2], v1[3]);
                        if (col0 + bj * HALF < ncols) *(u32x4*)(rowp + bj * HALF) = w; } }
        }
    }
};
}

#define XB_TMO      128
#define XB_XCNT(j)  (256  + 64 * (j))
#define XB_XSUB(j)  (1280 + 64 * (j))
#define XB_XGEN(j)  (2304 + 64 * (j))
#define XB_TOP      3328
#define XB_TOPGEN   3392
#define XCD_BAR_WORDS 3456
#define XB_SPIN_CAP (1u << 18)
#define LAS __attribute__((address_space(3)))

__device__ __forceinline__ unsigned xb_ld(unsigned* p)              { return __hip_atomic_load(p, __ATOMIC_RELAXED, __HIP_MEMORY_SCOPE_AGENT); }
__device__ __forceinline__ unsigned xb_add(unsigned* p, unsigned v) { return __hip_atomic_fetch_add(p, v, __ATOMIC_RELAXED, __HIP_MEMORY_SCOPE_AGENT); }
__device__ __forceinline__ unsigned xb_xcc_id() { return (unsigned)__builtin_amdgcn_s_getreg((3 << 11) | 20) & 0xFu; }
#define XB_SPIN(cond, bar) do { unsigned _sp = 0; while (cond) { __builtin_amdgcn_s_sleep(1); \
    if ((++_sp & 255u) == 0u) { if (xb_ld(&(bar)[XB_TMO])) break; if (_sp > XB_SPIN_CAP) { atomicAdd(&(bar)[XB_TMO], 1u); break; } } } } while (0)

struct XcdBarrier {
    unsigned* bar; unsigned x;
    volatile LAS unsigned* st;
};

__device__ __forceinline__ XcdBarrier xcd_barrier_post(unsigned* bar, volatile LAS unsigned* st) {
    XcdBarrier b; b.bar = bar; b.x = xb_xcc_id(); b.st = st;
    if (threadIdx.x == 0) (void)xb_add(&bar[XB_XCNT(b.x)], 1u);
    return b;
}
__device__ __forceinline__ void xcd_barrier_complete(unsigned* bar, unsigned x, unsigned& nloc, unsigned& nx) {
    const unsigned G = gridDim.x * gridDim.y * gridDim.z;
    unsigned sum, cnt, mine, sp = 0u;
    for (;;) {
        sum = 0u; cnt = 0u; mine = 0u;
#pragma unroll
        for (unsigned j = 0; j < 16; ++j) { const unsigned c = xb_ld(&bar[XB_XCNT(j)]); sum += c; cnt += (c > 0u) ? 1u : 0u; mine = (j == x) ? c : mine; }
        if (sum == G) break;
        __builtin_amdgcn_s_sleep(1);
        if ((++sp & 255u) == 0u) { if (xb_ld(&bar[XB_TMO])) break; if (sp > XB_SPIN_CAP) { atomicAdd(&bar[XB_TMO], 1u); break; } }
    }
    nloc = mine > 0u ? mine : 1u; nx = cnt > 0u ? cnt : 1u;
}

__device__ __forceinline__ void xcd_barrier(const XcdBarrier& b) {
    asm volatile("s_waitcnt vmcnt(0)" ::: "memory");
    __syncthreads();
    if (threadIdx.x == 0) {
        unsigned* bar = b.bar;
        __builtin_amdgcn_s_waitcnt(0);
        unsigned nloc = b.st[0], nx = b.st[1];
        if (nloc == 0u) { xcd_barrier_complete(bar, b.x, nloc, nx); b.st[0] = nloc; b.st[1] = nx; }
        const unsigned old = xb_add(&bar[XB_XSUB(b.x)], 1u);
        const unsigned gen = old / nloc;
        if (old + 1u == (gen + 1u) * nloc) {
            __builtin_amdgcn_fence(__ATOMIC_RELEASE, "agent");
            asm volatile("s_waitcnt vmcnt(0)" ::: "memory");
            const unsigned og = xb_add(&bar[XB_TOP], 1u);
            const unsigned tg = og / nx;
            if (og + 1u == (tg + 1u) * nx) xb_add(&bar[XB_TOPGEN], 1u);
            else XB_SPIN(xb_ld(&bar[XB_TOPGEN]) == tg, bar);
            __builtin_amdgcn_fence(__ATOMIC_ACQUIRE, "agent");
            xb_add(&bar[XB_XGEN(b.x)], 1u);
            asm volatile("s_waitcnt vmcnt(0)" ::: "memory");
        } else {
            XB_SPIN(xb_ld(&bar[XB_XGEN(b.x)]) == gen, bar);
            __builtin_amdgcn_fence(__ATOMIC_ACQUIRE, "agent");
            asm volatile("s_waitcnt vmcnt(0)" ::: "memory");
        }
    }
    __syncthreads();
}

__device__ void phase_mod_item(const Params& p, int it, unsigned char* smem) {
  float* red = (float*)smem;
  const int tid = opaque_tid(), tx = tid & 31, ty = tid >> 5;
  float* mod = (float*)(p.ws + OFF_MOD);
  it = opq(it);
  {
    int l = it / 96;
    int j = (it % 96) * 32 + tx;
    const float* W = p.ada_w + (size_t)l * 1024 * 3072;
    float* cs = red + 256;
#pragma unroll
    for (int i = 0; i < 4; ++i) cs[tid + 256 * i] = silu(p.c[tid + 256 * i]);
    __syncthreads();
    float acc = 0.f;
#pragma unroll 1
    for (int i0 = 0; i0 < 128; i0 += 16) {
      float wv[16];
#pragma unroll
      for (int i = 0; i < 16; ++i) wv[i] = W[(size_t)(ty * 128 + i0 + i) * 3072 + j];
#pragma unroll
      for (int i = 0; i < 16; ++i) acc += cs[ty * 128 + i0 + i] * wv[i];
    }
    red[ty * 32 + tx] = acc;
    __syncthreads();
    if (ty == 0) {
      float s = 0.f;
      for (int g = 0; g < 8; ++g) s += red[g * 32 + tx];
      mod[l * 3072 + j] = s + p.ada_b[l * 3072 + j];
    }
    __syncthreads();
  }
}

__device__ __forceinline__ float wall_src(const Params& p, int l, int k, int n) {
  size_t lk = (size_t)l * 1024 + k;
  if (n < 3072) return p.w_in[lk * 3072 + n];
  if (n < 3136) return (1.f - p.mu_w[lk]) * p.w1[lk * 64 + (n - 3072)];
  if (n < 3200) return p.mu_w[lk] * p.w1[lk * 64 + (n - 3136)];
  if (n < 3264) return (1.f - p.mu_a[lk]) * p.a1[lk * 64 + (n - 3200)];
  if (n < 3328) return p.mu_a[lk] * p.a1[lk * 64 + (n - 3264)];
  if (n < 3344) return p.gk1[lk * 16 + (n - 3328)];
  return 0.f;
}

__device__ void phase_wconv_item(const Params& p, int it, unsigned char* smem) {
  float* tile = (float*)smem;
  const int tid = opaque_tid();
  u16* WALL = (u16*)(p.ws + OFF_WALL);
  u16* WOUT = (u16*)(p.ws + OFF_WOUT);
  it = opq(it);
  {
    bool isout = it >= 3456;
    int l, nt, kt;
    if (!isout) { l = it / 864; int r = it % 864; nt = r >> 4; kt = r & 15; }
    else { int r = it - 3456; l = r >> 8; r &= 255; nt = r >> 4; kt = r & 15; }
    int tx = tid & 63, ty = tid >> 6;
#pragma unroll
    for (int i = 0; i < 16; ++i) {
      int kl = ty + 4 * i;
      int k = kt * 64 + kl, n = nt * 64 + tx;
      float v = isout ? p.w_out[((size_t)l * 1024 + k) * 1024 + n] : wall_src(p, l, k, n);
      tile[kl * 65 + tx] = v;
    }
    __syncthreads();
    int nl = tid >> 2, kq = tid & 3;
    unsigned w[8];
#pragma unroll
    for (int j = 0; j < 8; ++j) w[j] = pack2(tile[(kq * 16 + 2 * j) * 65 + nl], tile[(kq * 16 + 2 * j + 1) * 65 + nl]);
    u16* dst = (isout ? WOUT + ((size_t)l * 1024 + nt * 64 + nl) * 1024 : WALL + ((size_t)l * NALL + nt * 64 + nl) * 1024) + kt * 64 + kq * 16;
    ((uint4*)dst)[0] = make_uint4(w[0], w[1], w[2], w[3]);
    ((uint4*)dst)[1] = make_uint4(w[4], w[5], w[6], w[7]);
    __syncthreads();
  }
}

__device__ void phase_w2t_item(const Params& p, int it) {
  it = opq(it);
  const int c = opaque_tid();
  const int l = it >> 1, which = it & 1;
  const float* src = (which ? p.a2 : p.w2) + (size_t)l * 64 * 256 + c;
  u16* dst = (u16*)(p.ws + (which ? OFF_A2T : OFF_W2T)) + ((size_t)l * 256 + c) * 64;
#pragma unroll
  for (int j8 = 0; j8 < 8; ++j8) {
    float f[8];
#pragma unroll
    for (int q = 0; q < 8; ++q) f[q] = src[(j8 * 8 + q) * 256];
    *(uint4*)(dst + j8 * 8) = make_uint4(pack2(f[0], f[1]), pack2(f[2], f[3]), pack2(f[4], f[5]), pack2(f[6], f[7]));
  }
}

__device__ __forceinline__ void write_h(const Params& p, int l, int row, int lane, const float4* v, float ss) {
  const float* mod = (const float*)(p.ws + OFF_MOD) + l * 3072;
  u16* H = (u16*)(p.ws + OFF_H);
  float rs = rsqrtf(ss * (1.f / 1024.f) + 1e-6f);
#pragma unroll
  for (int i = 0; i < 4; ++i) {
    int col = (lane + 64 * i) * 4;
    float4 g = *(const float4*)(p.norm_pre + l * 1024 + col);
    float4 sh = *(const float4*)(mod + col);
    float4 sc = *(const float4*)(mod + 1024 + col);
    float h0 = v[i].x * rs * g.x * (1.f + sc.x) + sh.x;
    float h1 = v[i].y * rs * g.y * (1.f + sc.y) + sh.y;
    float h2 = v[i].z * rs * g.z * (1.f + sc.z) + sh.z;
    float h3 = v[i].w * rs * g.w * (1.f + sc.w) + sh.w;
    *(uint2*)(H + (size_t)row * 1024 + col) = make_uint2(pack2(h0, h1), pack2(h2, h3));
  }
}

__device__ void phase_h0(const Params& p) {
  const int tid = opaque_tid512(); const int wave = tid >> 6, lane = tid & 63;
  for (int row = blockIdx.x * 8 + wave; row < T_; row += gridDim.x * 8) {
    const float4* xr = (const float4*)(p.x + (size_t)row * 1024);
    float4 v[4];
    float ss = 0.f;
#pragma unroll
    for (int i = 0; i < 4; ++i) {
      v[i] = xr[lane + 64 * i];
      ss += v[i].x * v[i].x + v[i].y * v[i].y + v[i].z * v[i].z + v[i].w * v[i].w;
    }
    ss = wave_sum(ss);
    write_h(p, 0, row, lane, v, ss);
  }
}

__device__ void phase_post(const Params& p, int l) {
  l = opq(l);
  const int tid = opaque_tid512(); const int wave = tid >> 6, lane = tid & 63;
  const u16* Y = (const u16*)(p.ws + OFF_PROJ);
  const float* mod = (const float*)(p.ws + OFF_MOD) + l * 3072;
  const float* xold = (l == 0) ? p.x : p.out;
  for (int row = blockIdx.x * 8 + wave; row < T_; row += gridDim.x * 8) {
    const uint2* yr = (const uint2*)(Y + (size_t)row * 1024);
    const float4* xr = (const float4*)(xold + (size_t)row * 1024);
    float4 y[4], v[4];
    float ss = 0.f;
#pragma unroll
    for (int i = 0; i < 4; ++i) {
      const uint2 u = yr[lane + 64 * i];
      y[i] = make_float4(bflo(u.x), bfhi(u.x), bflo(u.y), bfhi(u.y));
      v[i] = xr[lane + 64 * i];
      ss += y[i].x * y[i].x + y[i].y * y[i].y + y[i].z * y[i].z + y[i].w * y[i].w;
    }
    ss = wave_sum(ss);
    float rs = rsqrtf(ss * (1.f / 1024.f) + 1e-6f);
    float s2 = 0.f;
#pragma unroll
    for (int i = 0; i < 4; ++i) {
      int col = (lane + 64 * i) * 4;
      float4 g = *(const float4*)(p.norm_post + l * 1024 + col);
      float4 gt = *(const float4*)(mod + 2048 + col);
      v[i].x += gt.x * (y[i].x * rs * g.x);
      v[i].y += gt.y * (y[i].y * rs * g.y);
      v[i].z += gt.z * (y[i].z * rs * g.z);
      v[i].w += gt.w * (y[i].w * rs * g.w);
      *(float4*)(p.out + (size_t)row * 1024 + col) = v[i];
      s2 += v[i].x * v[i].x + v[i].y * v[i].y + v[i].z * v[i].z + v[i].w * v[i].w;
    }
    if (l < 3) {
      s2 = wave_sum(s2);
      write_h(p, l + 1, row, lane, v, s2);
    }
  }
}

__device__ void attn_item(const Params& p, int l, int item, unsigned char* smem) {
  l = opq(l); item = opq(item);
  u16* Vt = (u16*)smem;
  const u16* PROJ = (const u16*)(p.ws + OFF_PROJ);
  u16* MIX = (u16*)(p.ws + OFF_MIX);
  const int tid = opaque_tid(), w = tid >> 6, lane = tid & 63, l31 = lane & 31, hf = lane >> 5;
  const int qb = item >> 3, head = item & 7, kvh = head >> 2;
  const int kpos0 = (qb - 1) * 128;
  {
    int kp = kpos0 + tid;
    if (kp < 0) kp = 0;
    const uint4* src = (const uint4*)(PROJ + (size_t)kp * NALL + 640 + kvh * 64);
#pragma unroll
    for (int c8 = 0; c8 < 8; ++c8) {
      uint4 v = src[c8];
      int d = c8 * 8;
      Vt[(d + 0) * 264 + tid] = (u16)(v.x & 0xffff);
      Vt[(d + 1) * 264 + tid] = (u16)(v.x >> 16);
      Vt[(d + 2) * 264 + tid] = (u16)(v.y & 0xffff);
      Vt[(d + 3) * 264 + tid] = (u16)(v.y >> 16);
      Vt[(d + 4) * 264 + tid] = (u16)(v.z & 0xffff);
      Vt[(d + 5) * 264 + tid] = (u16)(v.z >> 16);
      Vt[(d + 6) * 264 + tid] = (u16)(v.w & 0xffff);
      Vt[(d + 7) * 264 + tid] = (u16)(v.w >> 16);
    }
  }
  const int tq = qb * 128 + 32 * w + l31;
  bf16x8 qf[4], kc[4];
  {
    const u16* qp = PROJ + (size_t)tq * NALL + head * 64 + 8 * hf;
#pragma unroll
    for (int s = 0; s < 4; ++s) qf[s] = *(const bf16x8*)(qp + 16 * s);
    int kp = kpos0 + 32 * w + l31;
    if (kp < 0) kp = 0;
    const u16* kptr = PROJ + (size_t)kp * NALL + 512 + kvh * 64 + 8 * hf;
#pragma unroll
    for (int s = 0; s < 4; ++s) kc[s] = *(const bf16x8*)(kptr + 16 * s);
  }
  __syncthreads();
  const float slope = exp2f(-(float)(head + 1));
  const float sink = p.sinks[l * 8 + head];
  const int rq = 32 * w + l31;
  const u16* gp = PROJ + (size_t)tq * NALL + 768 + head * 64;
  uint2 gA[4], gB[4];
#pragma unroll
  for (int g = 0; g < 4; ++g) { gA[g] = *(const uint2*)(gp + 8 * g + 4 * hf); gB[g] = *(const uint2*)(gp + 32 + 8 * g + 4 * hf); }
  float mrun = -1e30f, lsum = 0.f;
  f32x16 o0, o1;
#pragma unroll
  for (int r = 0; r < 16; ++r) { o0[r] = 0.f; o1[r] = 0.f; }
#pragma unroll 1
  for (int i = 0; i < 5; ++i) {
    bf16x8 kn[4];
    {
      const int in_ = (i < 4) ? i + 1 : 4;
      int kp = kpos0 + 32 * w + 32 * in_ + l31;
      if (kp < 0) kp = 0;
      const u16* kptr = PROJ + (size_t)kp * NALL + 512 + kvh * 64 + 8 * hf;
#pragma unroll
      for (int s = 0; s < 4; ++s) kn[s] = *(const bf16x8*)(kptr + 16 * s);
    }
    f32x16 a;
#pragma unroll
    for (int r = 0; r < 16; ++r) a[r] = 0.f;
#pragma unroll
    for (int s = 0; s < 4; ++s) a = __builtin_amdgcn_mfma_f32_32x32x16_bf16(kc[s], qf[s], a, 0, 0, 0);
#pragma unroll
    for (int s = 0; s < 4; ++s) kc[s] = kn[s];
    float tmax = -1e30f;
#pragma unroll
    for (int r = 0; r < 16; ++r) {
      int kj = 32 * w + 32 * i + (r & 3) + 8 * (r >> 2) + 4 * hf;
      int dist = 128 + rq - kj;
      bool valid = (dist >= 0) && (dist < 128) && (kpos0 + kj >= 0);
      float sv = a[r] * 0.125f - slope * (float)dist;
      sv = valid ? sv : -1e30f;
      a[r] = sv;
      tmax = fmaxf(tmax, sv);
    }
    tmax = fmaxf(tmax, __shfl_xor(tmax, 32));
    const float mnew = fmaxf(mrun, tmax);
    const float alpha = __expf(mrun - mnew);
    float psum = 0.f;
#pragma unroll
    for (int r = 0; r < 16; ++r) {
      float e = (a[r] > -1e29f) ? __expf(a[r] - mnew) : 0.f;
      a[r] = e;
      psum += e;
    }
    lsum = lsum * alpha + psum;
    mrun = mnew;
#pragma unroll
    for (int r = 0; r < 16; ++r) { o0[r] *= alpha; o1[r] *= alpha; }
#pragma unroll
    for (int u = 0; u < 2; ++u) {
      bf16x8 pf;
#pragma unroll
      for (int j = 0; j < 8; ++j) pf[j] = (short)f2bf(a[8 * u + j]);
      const int kb = 32 * w + 32 * i + 16 * u + 4 * hf;
      const u16* v0 = Vt + l31 * 264 + kb;
      const u16* v1 = Vt + (32 + l31) * 264 + kb;
      uint2 a0 = *(const uint2*)(v0), a1 = *(const uint2*)(v0 + 8);
      uint2 b0 = *(const uint2*)(v1), b1 = *(const uint2*)(v1 + 8);
      uint4 A0 = make_uint4(a0.x, a0.y, a1.x, a1.y), A1 = make_uint4(b0.x, b0.y, b1.x, b1.y);
      o0 = __builtin_amdgcn_mfma_f32_32x32x16_bf16(__builtin_bit_cast(bf16x8, A0), pf, o0, 0, 0, 0);
      o1 = __builtin_amdgcn_mfma_f32_32x32x16_bf16(__builtin_bit_cast(bf16x8, A1), pf, o1, 0, 0, 0);
    }
  }
  {
    const float mf = fmaxf(mrun, sink);
    const float scl = __expf(mrun - mf);
    const float ltot = (lsum + __shfl_xor(lsum, 32)) * scl + __expf(sink - mf);
    const float fin = scl / ltot;
#pragma unroll
    for (int r = 0; r < 16; ++r) { o0[r] *= fin; o1[r] *= fin; }
  }
  u16* op = MIX + (size_t)tq * 1024 + head * 64;
#pragma unroll
  for (int g = 0; g < 4; ++g) {
    int d0 = 8 * g + 4 * hf;
    uint2 gg = gA[g];
    float r0 = o0[4 * g + 0] * silu(bflo(gg.x)), r1 = o0[4 * g + 1] * silu(bfhi(gg.x));
    float r2 = o0[4 * g + 2] * silu(bflo(gg.y)), r3 = o0[4 * g + 3] * silu(bfhi(gg.y));
    *(uint2*)(op + d0) = make_uint2(pack2(r0, r1), pack2(r2, r3));
    uint2 g2 = gB[g];
    r0 = o1[4 * g + 0] * silu(bflo(g2.x)); r1 = o1[4 * g + 1] * silu(bfhi(g2.x));
    r2 = o1[4 * g + 2] * silu(bflo(g2.y)); r3 = o1[4 * g + 3] * silu(bfhi(g2.y));
    *(uint2*)(op + 32 + d0) = make_uint2(pack2(r0, r1), pack2(r2, r3));
  }
  __syncthreads();
}

__device__ void rwkv_prep_item(const Params& p, int l, int item, unsigned char* smem) {
  l = opq(l); item = opq(item);
  u16* lwb = (u16*)smem;
  u16* lab = lwb + 16 * 72;
  const u16* PROJ = (const u16*)(p.ws + OFF_PROJ);
  const int tid = opaque_tid(), head = tid >> 6, lane = tid & 63, fr = lane & 15, fq = lane >> 4;
  const int t0 = item * 16;
  {
    const int which = tid >> 7, tt = (tid >> 3) & 15, j0 = (tid & 7) * 8;
    const int t = t0 + tt;
    const u16* pr = PROJ + (size_t)t * NALL;
    const u16* pq = (t > 0) ? pr - NALL : pr;
    const float pm = (t > 0) ? 1.f : 0.f;
    const uint4 cu = *(const uint4*)(pr + (which ? 3200 : 3072) + j0);
    const uint4 pu = *(const uint4*)(pq + (which ? 3264 : 3136) + j0);
    float sv[8];
    sv[0] = bflo(cu.x) + pm * bflo(pu.x); sv[1] = bfhi(cu.x) + pm * bfhi(pu.x);
    sv[2] = bflo(cu.y) + pm * bflo(pu.y); sv[3] = bfhi(cu.y) + pm * bfhi(pu.y);
    sv[4] = bflo(cu.z) + pm * bflo(pu.z); sv[5] = bfhi(cu.z) + pm * bfhi(pu.z);
    sv[6] = bflo(cu.w) + pm * bflo(pu.w); sv[7] = bfhi(cu.w) + pm * bfhi(pu.w);
    if (!which) {
#pragma unroll
      for (int q = 0; q < 8; ++q) sv[q] = tanh_fast(sv[q]);
    }
    *(uint4*)((which ? lab : lwb) + tt * 72 + j0) = make_uint4(pack2(sv[0], sv[1]), pack2(sv[2], sv[3]), pack2(sv[4], sv[5]), pack2(sv[6], sv[7]));
  }
  __syncthreads();
  f32x4 accw[4], acca[4];
#pragma unroll
  for (int nt = 0; nt < 4; ++nt) { accw[nt] = (f32x4){0.f, 0.f, 0.f, 0.f}; acca[nt] = (f32x4){0.f, 0.f, 0.f, 0.f}; }
  {
    const u16* W2T = (const u16*)(p.ws + OFF_W2T) + ((size_t)l * 256 + head * 64 + fr * 4) * 64 + fq * 8;
    const u16* A2T = (const u16*)(p.ws + OFF_A2T) + ((size_t)l * 256 + head * 64 + fr * 4) * 64 + fq * 8;
#pragma unroll
    for (int ks = 0; ks < 2; ++ks) {
      const bf16x8 aw = *(const bf16x8*)(lwb + fr * 72 + ks * 32 + fq * 8);
      const bf16x8 aa = *(const bf16x8*)(lab + fr * 72 + ks * 32 + fq * 8);
#pragma unroll
      for (int nt = 0; nt < 4; ++nt) {
        const bf16x8 bw = *(const bf16x8*)(W2T + nt * 64 + ks * 32);
        const bf16x8 ba = *(const bf16x8*)(A2T + nt * 64 + ks * 32);
        accw[nt] = __builtin_amdgcn_mfma_f32_16x16x32_bf16(aw, bw, accw[nt], 0, 0, 0);
        acca[nt] = __builtin_amdgcn_mfma_f32_16x16x32_bf16(aa, ba, acca[nt], 0, 0, 0);
      }
    }
  }
  const int c0 = head * 64 + fr * 4;
  const float4 mur = *(const float4*)(p.mu_rkv + l * 768 + c0), muk = *(const float4*)(p.mu_rkv + l * 768 + 256 + c0), muv = *(const float4*)(p.mu_rkv + l * 768 + 512 + c0);
  const float4 w0 = *(const float4*)(p.w0 + l * 256 + c0), a0 = *(const float4*)(p.a0 + l * 256 + c0);
  const float4 kkw = *(const float4*)(p.k_k + l * 256 + c0), kaw = *(const float4*)(p.k_a + l * 256 + c0), rkw = *(const float4*)(p.r_k + l * 256 + c0);
  float* RWW = (float*)(p.ws + OFF_RWW);
  float* RWKK = (float*)(p.ws + OFF_RWKK);
  u16* RB = (u16*)(p.ws + OFF_RWB);
  float* BON = (float*)(p.ws + OFF_BONUS);
#define F4E(v, i) ((i) == 0 ? v.x : (i) == 1 ? v.y : (i) == 2 ? v.z : v.w)
#pragma unroll
  for (int rg = 0; rg < 4; ++rg) {
    const int t = t0 + fq * 4 + rg;
    const u16* pr = PROJ + (size_t)t * NALL;
    const u16* pp = (t > 0) ? pr - NALL : pr;
    const float pm = (t > 0) ? 1.f : 0.f;
    const uint2 rcu = *(const uint2*)(pr + 1280 + c0), kcu = *(const uint2*)(pr + 1536 + c0), vcu = *(const uint2*)(pr + 1792 + c0);
    const uint2 rpu = *(const uint2*)(pp + 1280 + c0), kpu = *(const uint2*)(pp + 1536 + c0), vpu = *(const uint2*)(pp + 1792 + c0);
    const float rc[4] = {bflo(rcu.x), bfhi(rcu.x), bflo(rcu.y), bfhi(rcu.y)}, kc[4] = {bflo(kcu.x), bfhi(kcu.x), bflo(kcu.y), bfhi(kcu.y)};
    const float vc[4] = {bflo(vcu.x), bfhi(vcu.x), bflo(vcu.y), bfhi(vcu.y)};
    const float rp[4] = {bflo(rpu.x), bfhi(rpu.x), bflo(rpu.y), bfhi(rpu.y)}, kp[4] = {bflo(kpu.x), bfhi(kpu.x), bflo(kpu.y), bfhi(kpu.y)};
    const float vp[4] = {bflo(vpu.x), bfhi(vpu.x), bflo(vpu.y), bfhi(vpu.y)};
    float kkc[4], av[4], dec[4], rr[4], km[4], vv[4];
    float n2 = 0.f, bonus = 0.f;
#pragma unroll
    for (int nt = 0; nt < 4; ++nt) {
      const float r = rc[nt] + (pm * rp[nt] - rc[nt]) * F4E(mur, nt), k = kc[nt] + (pm * kp[nt] - kc[nt]) * F4E(muk, nt), v = vc[nt] + (pm * vp[nt] - vc[nt]) * F4E(muv, nt);
      const float wpre = F4E(w0, nt) + accw[nt][rg];
      const float wl = -softplusf_(-wpre) - 0.5f;
      dec[nt] = __expf(-__expf(wl));
      const float a = sigmoidf_(F4E(a0, nt) + acca[nt][rg]);
      const float kc2 = k * F4E(kkw, nt);
      const float kmod = k * (1.f + (a - 1.f) * F4E(kaw, nt));
      kkc[nt] = kc2; av[nt] = a; rr[nt] = r; km[nt] = kmod; vv[nt] = v;
      n2 += kc2 * kc2;
      bonus += r * kmod * F4E(rkw, nt);
    }
    n2 = row16_allsum(n2);
    bonus = row16_allsum(bonus);
    const float inv = __builtin_amdgcn_rsqf(fmaxf(n2, 1e-24f));
    const size_t o = (size_t)t * 256 + c0;
    *(float4*)(RWW + o) = make_float4(dec[0], dec[1], dec[2], dec[3]);
    *(float4*)(RWKK + o) = make_float4(kkc[0] * inv, kkc[1] * inv, kkc[2] * inv, kkc[3] * inv);
    *(uint2*)(RB + o) = make_uint2(pack2(rr[0], rr[1]), pack2(rr[2], rr[3]));
    *(uint2*)(RB + (size_t)T_ * 256 + o) = make_uint2(pack2(km[0], km[1]), pack2(km[2], km[3]));
    *(uint2*)(RB + (size_t)2 * T_ * 256 + o) = make_uint2(pack2(vv[0], vv[1]), pack2(vv[2], vv[3]));
    *(uint2*)(RB + (size_t)3 * T_ * 256 + o) = make_uint2(pack2(kkc[0] * inv * av[0], kkc[1] * inv * av[1]), pack2(kkc[2] * inv * av[2], kkc[3] * inv * av[3]));
    if (fr == 0) BON[t * 4 + head] = bonus;
  }
  __syncthreads();
}

__device__ __forceinline__ void gla_b(const Params& p, int l, int head, const u16* lgs, float* tot, float* bl) {
  const int tid = opaque_tid(), d = tid & 31, ig = tid >> 5;
  float g2[16];
#pragma unroll
  for (int m = 0; m < 16; ++m) g2[m] = p.gk2[(size_t)l * 16 * 128 + m * 128 + head * 32 + d];
  const float bias = p.gk_b[l * 128 + head * 32 + d];
  float run = 0.f;
#pragma unroll
  for (int ii = 0; ii < 8; ++ii) {
    const uint4* lp = (const uint4*)(lgs + (ig * 8 + ii) * 16);
    uint4 u0 = lp[0], u1 = lp[1];
    float z = bias;
    z += bflo(u0.x) * g2[0] + bfhi(u0.x) * g2[1] + bflo(u0.y) * g2[2] + bfhi(u0.y) * g2[3];
    z += bflo(u0.z) * g2[4] + bfhi(u0.z) * g2[5] + bflo(u0.w) * g2[6] + bfhi(u0.w) * g2[7];
    z += bflo(u1.x) * g2[8] + bfhi(u1.x) * g2[9] + bflo(u1.y) * g2[10] + bfhi(u1.y) * g2[11];
    z += bflo(u1.z) * g2[12] + bfhi(u1.z) * g2[13] + bflo(u1.w) * g2[14] + bfhi(u1.w) * g2[15];
    float g = (fminf(z, 0.f) - __logf(1.f + __expf(-fabsf(z)))) * (1.f / 16.f);
    run += g;
    bl[ii] = run;
  }
  tot[ig * 32 + d] = run;
  __syncthreads();
  float off = 0.f;
#pragma unroll
  for (int g = 0; g < 8; ++g) off += (g < ig) ? tot[g * 32 + d] : 0.f;
#pragma unroll
  for (int ii = 0; ii < 8; ++ii) bl[ii] += off;
}
__device__ __forceinline__ void st8f(float* dst, const uint4 u) {
  *(float4*)(dst) = make_float4(bflo(u.x), bfhi(u.x), bflo(u.y), bfhi(u.y));
  *(float4*)(dst + 4) = make_float4(bflo(u.z), bfhi(u.z), bflo(u.w), bfhi(u.w));
}

__device__ void gla_local_item(const Params& p, int l, int item, unsigned char* smem) {
  l = opq(l); item = opq(item);
  float* tot = (float*)smem;
  float* Kp = tot + 256;
  float* Vs = Kp + 2048;
  u16* lgs = (u16*)(Vs + 4096);
  const u16* PROJ = (const u16*)(p.ws + OFF_PROJ);
  const int tid = opaque_tid(), d = tid & 31, ig = tid >> 5;
  const int chunk = item >> 2, head = item & 3;
  {
    const u16* base = PROJ + (size_t)(chunk * 64) * NALL;
    const int ki = tid >> 2, kd0 = (tid & 3) * 8;
    const uint4 ku = *(const uint4*)(base + (size_t)ki * NALL + 2432 + head * 32 + kd0);
    const int g0 = tid, g1 = tid + 256;
    const uint4 vu0 = *(const uint4*)(base + (size_t)(g0 >> 3) * NALL + 2560 + head * 64 + (g0 & 7) * 8);
    const uint4 vu1 = *(const uint4*)(base + (size_t)(g1 >> 3) * NALL + 2560 + head * 64 + (g1 & 7) * 8);
    uint4 lu = make_uint4(0u, 0u, 0u, 0u);
    if (tid < 128) lu = *(const uint4*)(base + (size_t)(tid >> 1) * NALL + 3328 + (tid & 1) * 8);
    st8f(Kp + ki * 32 + kd0, ku);
    st8f(Vs + (g0 >> 3) * 64 + (g0 & 7) * 8, vu0);
    st8f(Vs + (g1 >> 3) * 64 + (g1 & 7) * 8, vu1);
    if (tid < 128) *(uint4*)(lgs + (tid >> 1) * 16 + (tid & 1) * 8) = lu;
  }
  __syncthreads();
  float bl[8];
  gla_b(p, l, head, lgs, tot, bl);
  float blast = 0.f;
#pragma unroll
  for (int g = 0; g < 8; ++g) blast += tot[g * 32 + d];
#pragma unroll
  for (int ii = 0; ii < 8; ++ii) {
    const int i = ig * 8 + ii;
    Kp[i * 32 + d] *= __expf(blast - bl[ii]);
  }
  __syncthreads();
  const int v = tid & 63, dg = tid >> 6;
  float acc[8];
#pragma unroll
  for (int q = 0; q < 8; ++q) acc[q] = 0.f;
  for (int i = 0; i < 64; ++i) {
    float vv = Vs[i * 64 + v];
    float4 k0 = *(const float4*)(Kp + i * 32 + dg * 8), k1 = *(const float4*)(Kp + i * 32 + dg * 8 + 4);
    acc[0] += k0.x * vv; acc[1] += k0.y * vv; acc[2] += k0.z * vv; acc[3] += k0.w * vv;
    acc[4] += k1.x * vv; acc[5] += k1.y * vv; acc[6] += k1.z * vv; acc[7] += k1.w * vv;
  }
  float* GS = (float*)(p.ws + OFF_GLAS);
  float* GD = (float*)(p.ws + OFF_GLAD);
#pragma unroll
  for (int q = 0; q < 8; ++q) GS[((size_t)(chunk * 4 + head) * 32 + dg * 8 + q) * 64 + v] = acc[q];
  if (tid < 32) GD[(chunk * 4 + head) * 32 + tid] = __expf(blast);
  __syncthreads();
}

__device__ void gla_state_block(const Params& p, int eb, unsigned char* dsm_) {
  float* comp = (float*)dsm_;
  float* GS = (float*)(p.ws + OFF_GLAS);
  const float* GD = (const float*)(p.ws + OFF_GLAD);
  eb = opq(eb);
  const int tid = opaque_tid512();
  const int ei = tid & 31, g = tid >> 5;
  const int e = eb * 32 + ei;
  const int head = e >> 11, d = (e >> 6) & 31, v = e & 63;
  float ds[16], dc[16];
#pragma unroll
  for (int i = 0; i < 16; ++i) {
    const int c = g * 16 + i;
    ds[i] = GS[((size_t)(c * 4 + head) * 32 + d) * 64 + v];
    dc[i] = GD[(c * 4 + head) * 32 + d];
  }
  float S = 0.f, P = 1.f;
#pragma unroll
  for (int i = 0; i < 16; ++i) { S = dc[i] * S + ds[i]; P *= dc[i]; }
  comp[(g * 32 + ei) * 2] = P;
  comp[(g * 32 + ei) * 2 + 1] = S;
  __syncthreads();
  float G = 0.f;
  for (int gg = 0; gg < g; ++gg) G = comp[(gg * 32 + ei) * 2] * G + comp[(gg * 32 + ei) * 2 + 1];
#pragma unroll
  for (int i = 0; i < 16; ++i) {
    const int c = g * 16 + i;
    GS[((size_t)(c * 4 + head) * 32 + d) * 64 + v] = G;
    G = dc[i] * G + ds[i];
  }
  __syncthreads();
}

__device__ void gla_out_item(const Params& p, int l, int item, unsigned char* smem) {
  l = opq(l); item = opq(item);
  float* tot = (float*)smem;
  float* qt = tot + 256;
  float* kt = qt + 2304;
  float* Vs = kt + 2304;
  float* Am = Vs + 4096;
  float* Ss = Am + 4352;
  u16* lgs = (u16*)(Ss + 2048);
  const u16* PROJ = (const u16*)(p.ws + OFF_PROJ);
  u16* MIX = (u16*)(p.ws + OFF_MIX);
  const float* GS = (const float*)(p.ws + OFF_GLAS);
  const int tid = opaque_tid();
  const int chunk = item >> 2, head = item & 3;
  {
    const u16* base = PROJ + (size_t)(chunk * 64) * NALL;
    const int ki = tid >> 2, kd0 = (tid & 3) * 8;
    const uint4 qu = *(const uint4*)(base + (size_t)ki * NALL + 2304 + head * 32 + kd0);
    const uint4 ku = *(const uint4*)(base + (size_t)ki * NALL + 2432 + head * 32 + kd0);
    const int g0 = tid, g1 = tid + 256;
    const uint4 vu0 = *(const uint4*)(base + (size_t)(g0 >> 3) * NALL + 2560 + head * 64 + (g0 & 7) * 8);
    const uint4 vu1 = *(const uint4*)(base + (size_t)(g1 >> 3) * NALL + 2560 + head * 64 + (g1 & 7) * 8);
    const float4 s0 = ((const float4*)(GS + (size_t)(chunk * 4 + head) * 2048))[tid];
    const float4 s1 = ((const float4*)(GS + (size_t)(chunk * 4 + head) * 2048))[tid + 256];
    uint4 lu = make_uint4(0u, 0u, 0u, 0u);
    if (tid < 128) lu = *(const uint4*)(base + (size_t)(tid >> 1) * NALL + 3328 + (tid & 1) * 8);
    st8f(qt + ki * 36 + kd0, qu);
    st8f(kt + ki * 36 + kd0, ku);
    st8f(Vs + (g0 >> 3) * 64 + (g0 & 7) * 8, vu0);
    st8f(Vs + (g1 >> 3) * 64 + (g1 & 7) * 8, vu1);
    ((float4*)Ss)[tid] = s0;
    ((float4*)Ss)[tid + 256] = s1;
    if (tid < 128) *(uint4*)(lgs + (tid >> 1) * 16 + (tid & 1) * 8) = lu;
  }
  __syncthreads();
  {
    const int d = tid & 31, ig = tid >> 5;
    float bl[8];
    gla_b(p, l, head, lgs, tot, bl);
#pragma unroll
    for (int ii = 0; ii < 8; ++ii) {
      const int i = ig * 8 + ii;
      qt[i * 36 + d] *= 0.17677669529663687f * __expf(bl[ii]);
      kt[i * 36 + d] *= __expf(-bl[ii]);
    }
  }
  __syncthreads();
  const int j = tid & 63, ig = tid >> 6;
  {
    float acc[16];
#pragma unroll
    for (int ii = 0; ii < 16; ++ii) acc[ii] = 0.f;
#pragma unroll 2
    for (int d4 = 0; d4 < 8; ++d4) {
      const float4 kv = *(const float4*)(kt + j * 36 + d4 * 4);
#pragma unroll
      for (int ii = 0; ii < 16; ++ii) {
        const float4 qv = *(const float4*)(qt + (ig * 16 + ii) * 36 + d4 * 4);
        acc[ii] += qv.x * kv.x + qv.y * kv.y + qv.z * kv.z + qv.w * kv.w;
      }
    }
#pragma unroll
    for (int ii = 0; ii < 16; ++ii) {
      int i = ig * 16 + ii;
      Am[i * 68 + j] = (j <= i) ? acc[ii] : 0.f;
    }
  }
  __syncthreads();
  {
    const int v = j;
    float acc[16];
#pragma unroll
    for (int ii = 0; ii < 16; ++ii) acc[ii] = 0.f;
    const int jmax = (ig + 1) * 4;
    for (int j4 = 0; j4 < jmax; ++j4) {
      const float v0 = Vs[(j4 * 4 + 0) * 64 + v], v1 = Vs[(j4 * 4 + 1) * 64 + v], v2 = Vs[(j4 * 4 + 2) * 64 + v], v3 = Vs[(j4 * 4 + 3) * 64 + v];
#pragma unroll
      for (int ii = 0; ii < 16; ++ii) {
        const float4 av = *(const float4*)(Am + (ig * 16 + ii) * 68 + j4 * 4);
        acc[ii] += av.x * v0 + av.y * v1 + av.z * v2 + av.w * v3;
      }
    }
#pragma unroll 2
    for (int d4 = 0; d4 < 8; ++d4) {
      const float s0 = Ss[(d4 * 4 + 0) * 64 + v], s1 = Ss[(d4 * 4 + 1) * 64 + v], s2 = Ss[(d4 * 4 + 2) * 64 + v], s3 = Ss[(d4 * 4 + 3) * 64 + v];
#pragma unroll
      for (int ii = 0; ii < 16; ++ii) {
        const float4 qv = *(const float4*)(qt + (ig * 16 + ii) * 36 + d4 * 4);
        acc[ii] += qv.x * s0 + qv.y * s1 + qv.z * s2 + qv.w * s3;
      }
    }
    __syncthreads();
#pragma unroll
    for (int ii = 0; ii < 16; ++ii) Am[(ig * 16 + ii) * 68 + v] = acc[ii];
  }
  __syncthreads();
  {
    const int fr = tid & 15, tg = tid >> 4;
    const float4 nw = *(const float4*)(p.gla_nw + l * 64 + fr * 4);
#pragma unroll
    for (int ps = 0; ps < 4; ++ps) {
      const int i = ps * 16 + tg;
      const int t = chunk * 64 + i;
      const float4 o = *(const float4*)(Am + i * 68 + fr * 4);
      const uint2 gg = *(const uint2*)(PROJ + (size_t)t * NALL + 2816 + head * 64 + fr * 4);
      const float ms = row16_allsum(o.x * o.x + o.y * o.y + o.z * o.z + o.w * o.w) * (1.f / 64.f);
      const float rs = rsqrtf(ms + 1e-5f);
      const float r0 = o.x * rs * nw.x * silu(bflo(gg.x)), r1 = o.y * rs * nw.y * silu(bfhi(gg.x));
      const float r2 = o.z * rs * nw.z * silu(bflo(gg.y)), r3 = o.w * rs * nw.w * silu(bfhi(gg.y));
      *(uint2*)(MIX + (size_t)t * 1024 + 768 + head * 64 + fr * 4) = make_uint2(pack2(r0, r1), pack2(r2, r3));
    }
  }
  __syncthreads();
}

typedef float f32x2 __attribute__((ext_vector_type(2)));
__device__ __forceinline__ float oct_allsum(float x) {
  x += dpp_f<0xB1>(x);
  x += dpp_f<0x4E>(x);
  x += dpp_f<0x141>(x);
  return x;
}
__device__ void rwkv_scan_item(const Params& p, int item, unsigned char* dsm_) {
  item = opq(item);
  float* st = (float*)dsm_;
  const int tid = opaque_tid512(), wv = tid >> 6, lane = tid & 63, rs = lane >> 3, kl = lane & 7;
  const int head = item & 3, seg = item >> 2;
  const bool ident = wv >= 4;
  const int R0 = wv * 16 + rs * 2;
  const int v0 = R0 & 63;
  const float* RWW = (const float*)(p.ws + OFF_RWW);
  const float* RWKK = (const float*)(p.ws + OFF_RWKK);
  const u16* RB = (const u16*)(p.ws + OFF_RWB);
  float* PF = (float*)(p.ws + OFF_PROJ);
  float* ZP = (float*)(p.ws + OFF_ZP);
  const int tbase = seg * SL;
  const int half = tid >> 8, ls = (tid & 255) >> 4, lc4 = (tid & 15) * 4;
  f32x2 S0[4], S1[4];
#pragma unroll
  for (int e = 0; e < 4; ++e) { S0[e] = (f32x2){0.f, 0.f}; S1[e] = (f32x2){0.f, 0.f}; }
  if (ident) {
#pragma unroll
    for (int e = 0; e < 4; ++e) {
      const int k0 = kl * 8 + 2 * e;
      S0[e] = (f32x2){(v0 == k0) ? 1.f : 0.f, (v0 == k0 + 1) ? 1.f : 0.f};
      S1[e] = (f32x2){(v0 + 1 == k0) ? 1.f : 0.f, (v0 + 1 == k0 + 1) ? 1.f : 0.f};
    }
  }
  float4 g0 = make_float4(0.f, 0.f, 0.f, 0.f);
  uint2 h0 = make_uint2(0u, 0u), h1 = h0, h2 = h0;
  const float* gp0 = (half == 0 ? RWW : RWKK) + (size_t)(tbase + ls) * 256 + head * 64 + lc4;
  const u16* hp = RB + (size_t)(tbase + ls) * 256 + head * 64 + lc4;
#define SCAN_GLOAD(ch) do { const size_t _o = (size_t)(ch) * 16 * 256; g0 = *(const float4*)(gp0 + _o); \
    if (half == 0) { h0 = *(const uint2*)(hp + _o); } \
    else { h0 = *(const uint2*)(hp + (size_t)T_ * 256 + _o); h1 = *(const uint2*)(hp + (size_t)3 * T_ * 256 + _o); h2 = *(const uint2*)(hp + (size_t)2 * T_ * 256 + _o); } } while (0)
#define SCAN_LSTORE(buf) do { float* _b = st + (buf) * 6144 + ls * 64 + lc4; \
    if (half == 0) { *(float4*)(_b) = g0; *(float4*)(_b + 2048) = make_float4(bflo(h0.x), bfhi(h0.x), bflo(h0.y), bfhi(h0.y)); } \
    else { *(float4*)(_b + 1024) = g0; *(float4*)(_b + 3072) = make_float4(bflo(h0.x), bfhi(h0.x), bflo(h0.y), bfhi(h0.y)); \
           *(float4*)(_b + 4096) = make_float4(bflo(h1.x), bfhi(h1.x), bflo(h1.y), bfhi(h1.y)); *(float4*)(_b + 5120) = make_float4(bflo(h2.x), bfhi(h2.x), bflo(h2.y), bfhi(h2.y)); } } while (0)
  if (tid < 16) st[2 * 6144 + tid] = 0.f;
  SCAN_GLOAD(0);
  SCAN_LSTORE(0);
  __syncthreads();
  const int nch = SL / 16;
  float* yout = PF + (size_t)tbase * PROJF + (ident ? 256 : 0) + head * 64 + v0;
  const int voff = ident ? (2 * 6144) : (5120 + v0);
  const int vstep = ident ? 0 : 64, vbuf = ident ? 0 : 6144;
#define V2(a, i) ((f32x2){(i) ? a.z : a.x, (i) ? a.w : a.y})
#define SCAN_STEP(s_) do { \
    const float* bp = b + (s_) * 64 + kl * 8; \
    const float4 wl = *(const float4*)(bp), wh = *(const float4*)(bp + 4); \
    const float4 kkl = *(const float4*)(bp + 1024), kkh = *(const float4*)(bp + 1028); \
    const float4 rl4 = *(const float4*)(bp + 2048), rh4 = *(const float4*)(bp + 2052); \
    const float4 kl4 = *(const float4*)(bp + 3072), kh4 = *(const float4*)(bp + 3076); \
    const float4 bl4 = *(const float4*)(bp + 4096), bh4 = *(const float4*)(bp + 4100); \
    const f32x2 vv = *(const f32x2*)(vsrc + (s_) * vstep); \
    const f32x2 W[4] = {V2(wl, 0), V2(wl, 1), V2(wh, 0), V2(wh, 1)}, KK[4] = {V2(kkl, 0), V2(kkl, 1), V2(kkh, 0), V2(kkh, 1)}; \
    const f32x2 RR[4] = {V2(rl4, 0), V2(rl4, 1), V2(rh4, 0), V2(rh4, 1)}, KV[4] = {V2(kl4, 0), V2(kl4, 1), V2(kh4, 0), V2(kh4, 1)}; \
    const f32x2 BB[4] = {V2(bl4, 0), V2(bl4, 1), V2(bh4, 0), V2(bh4, 1)}; \
    f32x2 t0 = S0[0] * KK[0] + S0[1] * KK[1] + S0[2] * KK[2] + S0[3] * KK[3]; \
    f32x2 t1 = S1[0] * KK[0] + S1[1] * KK[1] + S1[2] * KK[2] + S1[3] * KK[3]; \
    float sa0 = -(t0.x + t0.y), sa1 = -(t1.x + t1.y); \
    sa0 += dpp_f<0xB1>(sa0); sa1 += dpp_f<0xB1>(sa1); sa0 += dpp_f<0x4E>(sa0); sa1 += dpp_f<0x4E>(sa1); sa0 += dpp_f<0x141>(sa0); sa1 += dpp_f<0x141>(sa1); \
    const f32x2 a0 = {sa0, sa0}, a1 = {sa1, sa1}, u0 = {vv.x, vv.x}, u1 = {vv.y, vv.y}; \
    _Pragma("unroll") for (int e = 0; e < 4; ++e) { S0[e] = S0[e] * W[e] + a0 * BB[e] + u0 * KV[e]; S1[e] = S1[e] * W[e] + a1 * BB[e] + u1 * KV[e]; } \
    f32x2 q0 = S0[0] * RR[0] + S0[1] * RR[1] + S0[2] * RR[2] + S0[3] * RR[3]; \
    f32x2 q1 = S1[0] * RR[0] + S1[1] * RR[1] + S1[2] * RR[2] + S1[3] * RR[3]; \
    float y0 = q0.x + q0.y, y1 = q1.x + q1.y; \
    y0 += dpp_f<0xB1>(y0); y1 += dpp_f<0xB1>(y1); y0 += dpp_f<0x4E>(y0); y1 += dpp_f<0x4E>(y1); y0 += dpp_f<0x141>(y0); y1 += dpp_f<0x141>(y1); \
    const bool mine = (kl == ((s_) & 7)); \
    if ((s_) < 8) { ya.x = mine ? y0 : ya.x; ya.y = mine ? y1 : ya.y; } else { yb.x = mine ? y0 : yb.x; yb.y = mine ? y1 : yb.y; } } while (0)
  for (int ch = 0; ch < nch; ++ch) {
    const int cur = ch & 1;
    if (ch + 1 < nch) SCAN_GLOAD(ch + 1);
    const float* b = st + cur * 6144;
    const float* vsrc = st + voff + cur * vbuf;
    f32x2 ya = {0.f, 0.f}, yb = {0.f, 0.f};
#pragma unroll 2
    for (int s = 0; s < 8; ++s) SCAN_STEP(s);
#pragma unroll 2
    for (int s = 8; s < 16; ++s) SCAN_STEP(s);
    *(f32x2*)(yout + (size_t)(ch * 16 + kl) * PROJF) = ya;
    *(f32x2*)(yout + (size_t)(ch * 16 + 8 + kl) * PROJF) = yb;
    if (ch + 1 < nch) SCAN_LSTORE(cur ^ 1);
    __syncthreads();
  }
#pragma unroll
  for (int j = 0; j < 2; ++j) {
    float* zp = ZP + ((size_t)((seg * 4 + head) * 128 + R0 + j)) * 64 + kl * 8;
    if (j == 0) { *(float4*)(zp) = make_float4(S0[0].x, S0[0].y, S0[1].x, S0[1].y); *(float4*)(zp + 4) = make_float4(S0[2].x, S0[2].y, S0[3].x, S0[3].y); }
    else { *(float4*)(zp) = make_float4(S1[0].x, S1[0].y, S1[1].x, S1[1].y); *(float4*)(zp + 4) = make_float4(S1[2].x, S1[2].y, S1[3].x, S1[3].y); }
  }
}

__device__ void rwkv_combine(const Params& p, unsigned char* dsm_) {
  float* ring = (float*)dsm_;
  float* ZP = (float*)(p.ws + OFF_ZP);
  const int tid = opaque_tid512(); const int lane = tid & 63;
  const int rowi = blockIdx.x * 8 + (tid >> 6);
  const int head = rowi >> 6, v = rowi & 63;
  float4 a0A, b0A, a1A, b1A, a0B, b0B, a1B, b1B, a0C, b0C, a1C, b1C, a0D, b0D, a1D, b1D;
  float z0A, z1A, z0B, z1B, z0C, z1C, z0D, z1D;
#define COMB_LOAD(X, stg_) do { \
      const float* base0 = ZP + (size_t)((((stg_) * 2 + 0) * 4 + head) * 128) * 64; \
      const float* base1 = ZP + (size_t)((((stg_) * 2 + 1) * 4 + head) * 128) * 64; \
      a0##X = ((const float4*)(base0 + 4096))[tid]; b0##X = ((const float4*)(base0 + 4096))[tid + 512]; z0##X = base0[v * 64 + lane]; \
      a1##X = ((const float4*)(base1 + 4096))[tid]; b1##X = ((const float4*)(base1 + 4096))[tid + 512]; z1##X = base1[v * 64 + lane]; } while (0)
#define COMB_SEG(q, ZC) do { const int seg = stg * 2 + q; \
      ZP[((size_t)((seg * 4 + head) * 128 + v)) * 64 + lane] = s; \
      float ns0 = ZC, ns1 = 0.f; const float* P = buf + q * 4096 + lane; \
      _Pragma("unroll") for (int i = 0; i < 64; i += 2) { \
        float s0 = __builtin_bit_cast(float, __builtin_amdgcn_readlane(__builtin_bit_cast(int, s), i)); \
        float s1 = __builtin_bit_cast(float, __builtin_amdgcn_readlane(__builtin_bit_cast(int, s), i + 1)); \
        ns0 += s0 * P[i * 64]; ns1 += s1 * P[(i + 1) * 64]; } \
      s = ns0 + ns1; } while (0)
#define COMB_STAGE(X, bi) do { \
      float* buf = ring + (bi) * 8192; \
      ((float4*)(buf))[tid] = a0##X; ((float4*)(buf))[tid + 512] = b0##X; \
      ((float4*)(buf + 4096))[tid] = a1##X; ((float4*)(buf + 4096))[tid + 512] = b1##X; \
      const float c0 = z0##X, c1 = z1##X; \
      { const int nstg = (stg + 4 < NSEG / 2) ? stg + 4 : stg; COMB_LOAD(X, nstg); } \
      __syncthreads(); \
      COMB_SEG(0, c0); COMB_SEG(1, c1); ++stg; } while (0)
  COMB_LOAD(A, 0); COMB_LOAD(B, 1); COMB_LOAD(C, 2); COMB_LOAD(D, 3);
  float s = 0.f;
  int stg = 0;
#pragma unroll 1
  for (int it4 = 0; it4 < NSEG / 8; ++it4) {
    COMB_STAGE(A, 0); COMB_STAGE(B, 1); COMB_STAGE(C, 2); COMB_STAGE(D, 3);
  }
  __syncthreads();
#undef COMB_LOAD
#undef COMB_SEG
#undef COMB_STAGE
}

__device__ __forceinline__ bf16x8 pack8(const float4 a, const float4 b) {
  uint4 u = make_uint4(pack2(a.x, a.y), pack2(a.z, a.w), pack2(b.x, b.y), pack2(b.z, b.w));
  return __builtin_bit_cast(bf16x8, u);
}
__device__ void rwkv_final_item(const Params& p, int l, int item, unsigned char* smem) {
  l = opq(l); item = opq(item);
  const int tid = opaque_tid(), w = tid >> 6, lane = tid & 63, l31 = lane & 31, hf = lane >> 5;
  const int parts = SL / 128;
  const int q = item % parts, head = (item / parts) & 3, seg = item / (parts * 4);
  const int t = seg * SL + q * 128 + w * 32 + l31;
  const float* ZP = (const float*)(p.ws + OFF_ZP);
  const float* PF = (const float*)(p.ws + OFF_PROJ);
  const u16* PROJ = (const u16*)(p.ws + OFF_PROJ);
  const u16* RBv = (const u16*)(p.ws + OFF_RWB) + (size_t)2 * T_ * 256;
  const float* BON = (const float*)(p.ws + OFF_BONUS);
  u16* MIX = (u16*)(p.ws + OFF_MIX);
  f32x16 acc0, acc1;
#pragma unroll
  for (int r = 0; r < 16; ++r) { acc0[r] = 0.f; acc1[r] = 0.f; }
  const float* y0p = PF + (size_t)t * PROJF + head * 64 + 4 * hf;
  const int cb = head * 64 + 4 * hf;
  float4 yA[4], yB[4];
  uint2 vvl[8], ggl[8];
#pragma unroll
  for (int g = 0; g < 4; ++g) { yA[g] = *(const float4*)(y0p + 8 * g); yB[g] = *(const float4*)(y0p + 32 + 8 * g); }
#pragma unroll
  for (int q8 = 0; q8 < 8; ++q8) {
    const int c = cb + (q8 >> 2) * 32 + 8 * (q8 & 3);
    vvl[q8] = *(const uint2*)(RBv + (size_t)t * 256 + c);
    ggl[q8] = *(const uint2*)(PROJ + (size_t)t * NALL + 2048 + c);
  }
  const float bon = BON[t * 4 + head];
  {
    const float* sp = ZP + ((size_t)((seg * 4 + head) * 128 + l31)) * 64 + 8 * hf;
    const float* rp = PF + (size_t)t * PROJF + 256 + head * 64 + 8 * hf;
#pragma unroll
    for (int ks = 0; ks < 4; ++ks) {
      const bf16x8 bfrag = pack8(*(const float4*)(rp + 16 * ks), *(const float4*)(rp + 16 * ks + 4));
      const bf16x8 a0 = pack8(*(const float4*)(sp + 16 * ks), *(const float4*)(sp + 16 * ks + 4));
      const bf16x8 a1 = pack8(*(const float4*)(sp + 32 * 64 + 16 * ks), *(const float4*)(sp + 32 * 64 + 16 * ks + 4));
      acc0 = __builtin_amdgcn_mfma_f32_32x32x16_bf16(a0, bfrag, acc0, 0, 0, 0);
      acc1 = __builtin_amdgcn_mfma_f32_32x32x16_bf16(a1, bfrag, acc1, 0, 0, 0);
    }
  }
  float sum = 0.f;
#pragma unroll
  for (int g = 0; g < 4; ++g) {
    const float4 ya = yA[g], yb = yB[g];
    acc0[4 * g + 0] += ya.x; acc0[4 * g + 1] += ya.y; acc0[4 * g + 2] += ya.z; acc0[4 * g + 3] += ya.w;
    acc1[4 * g + 0] += yb.x; acc1[4 * g + 1] += yb.y; acc1[4 * g + 2] += yb.z; acc1[4 * g + 3] += yb.w;
  }
#pragma unroll
  for (int r = 0; r < 16; ++r) sum += acc0[r] + acc1[r];
  sum += __shfl_xor(sum, 32);
  const float mean = sum * (1.f / 64.f);
  float var = 0.f;
#pragma unroll
  for (int r = 0; r < 16; ++r) { const float d0 = acc0[r] - mean, d1 = acc1[r] - mean; var += d0 * d0 + d1 * d1; }
  var += __shfl_xor(var, 32);
  const float rstd = rsqrtf(var * (1.f / 64.f) + 64e-5f);
#pragma unroll
  for (int mt = 0; mt < 2; ++mt)
#pragma unroll
    for (int g = 0; g < 4; ++g) {
      const int c = cb + mt * 32 + 8 * g;
      const float4 lw = *(const float4*)(p.ln_w + l * 256 + c), lb = *(const float4*)(p.ln_b + l * 256 + c);
      const uint2 vv = vvl[mt * 4 + g];
      const uint2 gg = ggl[mt * 4 + g];
      float o0 = (mt ? acc1[4 * g + 0] : acc0[4 * g + 0]), o1 = (mt ? acc1[4 * g + 1] : acc0[4 * g + 1]);
      float o2 = (mt ? acc1[4 * g + 2] : acc0[4 * g + 2]), o3 = (mt ? acc1[4 * g + 3] : acc0[4 * g + 3]);
      o0 = (o0 - mean) * rstd * lw.x + lb.x + bon * bflo(vv.x);
      o1 = (o1 - mean) * rstd * lw.y + lb.y + bon * bfhi(vv.x);
      o2 = (o2 - mean) * rstd * lw.z + lb.z + bon * bflo(vv.y);
      o3 = (o3 - mean) * rstd * lw.w + lb.w + bon * bfhi(vv.y);
      o0 *= silu(bflo(gg.x)); o1 *= silu(bfhi(gg.x)); o2 *= silu(bflo(gg.y)); o3 *= silu(bfhi(gg.y));
      *(uint2*)(MIX + (size_t)t * 1024 + 512 + c) = make_uint2(pack2(o0, o1), pack2(o2, o3));
    }
}

#define LDS_BYTES (131072 + 16)
#ifndef REP_G1
#define REP_G1 1
#endif
#ifndef REP_G2
#define REP_G2 1
#endif
#ifndef REP_P3
#define REP_P3 1
#endif
#ifndef REP_SCAN
#define REP_SCAN 1
#endif
#ifndef REP_GO
#define REP_GO 1
#endif
#ifndef REP_FIN
#define REP_FIN 1
#endif
#define PAIR_LOOP(N, BODY) for (int _pr = blockIdx.x; _pr < (N) / 2; _pr += gridDim.x) { const int it = 2 * _pr + vb; BODY }
__global__ void __launch_bounds__(512) fwd_megakernel(Params p) {
  cg::grid_group grid = cg::this_grid();
  extern __shared__ __attribute__((aligned(16))) unsigned char dsm[];
  const int vb = __builtin_amdgcn_readfirstlane(threadIdx.x >> 8);
  unsigned char* smem = dsm + vb * 65536;
  if (threadIdx.x == 0) *(uint4*)(dsm + 131072) = make_uint4(0u, 0u, 0u, 0u);
  __syncthreads();
  const XcdBarrier xb = xcd_barrier_post((unsigned*)(p.ws + OFF_BAR), (volatile LAS unsigned*)(dsm + 131072));
#define GSYNC() xcd_barrier(xb)
#ifndef PH
#define PH 0xffff
#endif
  if (PH & 1) PAIR_LOOP(384, phase_mod_item(p, it, smem);)
  if (PH & 2) PAIR_LOOP(4480, phase_wconv_item(p, it, smem);)
  if (PH & 2) PAIR_LOOP(8, phase_w2t_item(p, it);)
  grid.sync();
  if (PH & 4) phase_h0(p);
  GSYNC();
#pragma unroll 1
  for (int hl = 0; hl < 8; ++hl) {
    const int l = hl >> 1;
    const bool second = hl & 1;
    if (PH & 8) {
      pg8::Gemm g; g.M = T_; g.K = 1024;
      pg8::EpiU E; E.O = (void*)(p.ws + OFF_PROJ);
      if (!second) { g.A = (const u16*)(p.ws + OFF_H); g.Bt = (const u16*)(p.ws + OFF_WALL) + (size_t)l * NALL * 1024; g.N = 3584; E.ldc = NALL; E.ncols = NALL; E.f32out = 0; }
      else { g.A = (const u16*)(p.ws + OFF_MIX); g.Bt = (const u16*)(p.ws + OFF_WOUT) + (size_t)l * 1024 * 1024; g.N = 1024; E.ldc = 1024; E.ncols = 1024; E.f32out = 0; }
      pg8::StaticOrder S; S.init(T_, g.N, gridDim.x, blockIdx.x);
      const int nrep = second ? REP_G2 : REP_G1;
#pragma unroll 1
      for (int rep = 0; rep < nrep; ++rep)
      pg8::gemm_phase<pg8::EpiU, pg8::StaticOrder, false>((PG8_LAS unsigned char*)dsm, g, S, E, nullptr);
    }
    GSYNC();
    if (!second) {
#pragma unroll 1
      for (int rep = 0; rep < REP_P3; ++rep)
      PAIR_LOOP(3072,
        if (it < 1024) { if (PH & 16) attn_item(p, l, it, smem); }
        else if (it < 2048) { if (PH & 32) rwkv_prep_item(p, l, it - 1024, smem); }
        else { if (PH & 64) gla_local_item(p, l, it - 2048, smem); }
      )
      GSYNC();
      if (PH & 128) for (int eb = blockIdx.x; eb < 256; eb += gridDim.x) gla_state_block(p, eb, dsm);
#pragma unroll 1
      for (int rep = 0; rep < REP_SCAN; ++rep)
      if (PH & 256) for (int it = blockIdx.x; it < NSEG * 4; it += gridDim.x) rwkv_scan_item(p, it, dsm);
      GSYNC();
      if (blockIdx.x < 32) { if (PH & 512) rwkv_combine(p, dsm); }
#pragma unroll 1
      for (int rep = 0; rep < REP_GO; ++rep)
      if (PH & 1024) {
        unsigned* ctr = (unsigned*)(p.ws + OFF_BAR) + 32 + l;
        volatile unsigned* slot = (volatile unsigned*)(dsm + 131072) + 2;
        for (;;) {
          if (threadIdx.x == 0) *slot = atomicAdd(ctr, 1u);
          __syncthreads();
          const unsigned pr = (unsigned)__builtin_amdgcn_readfirstlane((int)*slot);
          __syncthreads();
          if (pr >= 512u) break;
          gla_out_item(p, l, 2 * (int)pr + vb, smem);
        }
      }
      GSYNC();
#pragma unroll 1
      for (int rep = 0; rep < REP_FIN; ++rep)
      if (PH & 2048) PAIR_LOOP(NSEG * 4 * (SL / 128), rwkv_final_item(p, l, it, smem);)
      GSYNC();
    } else {
      if (PH & 8192) phase_post(p, l);
      if (hl < 7) GSYNC();
    }
  }
}

extern "C" void kernel_launch(void* const* d_in, const int* in_sizes, int n_in, void* d_out, int out_size, void* d_ws, size_t ws_size,
                              hipStream_t stream) {
  static int grid_blocks = 0;
  if (!grid_blocks) {
    int dev = 0, cus = 0, per_cu = 0;
    (void)hipGetDevice(&dev);
    (void)hipDeviceGetAttribute(&cus, hipDeviceAttributeMultiprocessorCount, dev);
    (void)hipFuncSetAttribute((const void*)fwd_megakernel, hipFuncAttributeMaxDynamicSharedMemorySize, LDS_BYTES);
    (void)hipOccupancyMaxActiveBlocksPerMultiprocessor(&per_cu, fwd_megakernel, 512, LDS_BYTES);
    if (per_cu < 1) per_cu = 1;
    grid_blocks = cus;
    if (grid_blocks < 32) grid_blocks = 32;
  }
  if (n_in != 27 || ws_size < WS_END) {
    fprintf(stderr, "kernel_launch: unexpected n_in %d / ws %zu\n", n_in, ws_size);
    return;
  }
  Params p{};
  const float** pp = (const float**)&p;
  for (int i = 0; i < 27; ++i) pp[i] = (const float*)d_in[i];
  p.out = (float*)d_out;
  p.ws = (unsigned char*)d_ws;
  (void)hipMemsetAsync((unsigned char*)d_ws + OFF_BAR, 0, XCD_BAR_WORDS * 4, stream);
  void* args[] = {&p};
  hipError_t e = hipLaunchCooperativeKernel((void*)fwd_megakernel, dim3(grid_blocks), dim3(512), args, LDS_BYTES, stream);
  if (e != hipSuccess) fprintf(stderr, "cooperative launch failed: %s (grid %d)\n", hipGetErrorString(e), grid_blocks);
}
```

```cpp
#include <hip/hip_runtime.h>
#include <hip/hip_bf16.h>
#include <hip/hip_cooperative_groups.h>
#include <cstdio>
namespace cg = cooperative_groups;

typedef unsigned short u16;
using bf16x8 = __attribute__((ext_vector_type(8))) short;
using f32x4 = __attribute__((ext_vector_type(4))) float;
using f32x16 = __attribute__((ext_vector_type(16))) float;

#define T_ 16384
#define NALL 3456
#define NSEG 64
#define SL (T_ / NSEG)
#define PROJF 1728

#define OFF_WALL 0ull
#define OFF_WOUT 28311552ull
#define OFF_MOD 36700160ull
#define OFF_H 36749312ull
#define OFF_RWW OFF_H
#define OFF_RWKK (OFF_H + 16777216ull)
#define OFF_PROJ 70303744ull
#define OFF_MIX 183549952ull
#define OFF_RWB 217104384ull
#define OFF_GLAS 250658816ull
#define OFF_GLAD 259047424ull
#define OFF_BONUS 259178496ull
#define OFF_ZP 259440640ull
#define OFF_BAR 267829248ull
#define OFF_W2T 267845632ull
#define OFF_A2T 267976704ull
#define WS_END 268107776ull


struct Params {
  const float *x, *c, *ada_w, *ada_b, *norm_pre, *norm_post, *w_in, *w_out, *sinks, *mu_rkv, *mu_w, *mu_a, *w0, *w1, *w2,
      *a0, *a1, *a2, *k_k, *k_a, *r_k, *ln_w, *ln_b, *gk1, *gk2, *gk_b, *gla_nw;
  float* out;
  unsigned char* ws;
};

__device__ __forceinline__ u16 f2bf(float f) {
  unsigned u = __float_as_uint(f);
  u += 0x7fffu + ((u >> 16) & 1u);
  return (u16)(u >> 16);
}
__device__ __forceinline__ float bf2f(u16 h) { return __uint_as_float(((unsigned)h) << 16); }
__device__ __forceinline__ unsigned pack2(float a, float b) { return (unsigned)f2bf(a) | ((unsigned)f2bf(b) << 16); }
__device__ __forceinline__ float bflo(unsigned u) { return __uint_as_float(u << 16); }
__device__ __forceinline__ float bfhi(unsigned u) { return __uint_as_float(u & 0xffff0000u); }

__device__ __forceinline__ float frcp(float x) { return __builtin_amdgcn_rcpf(x); }
__device__ __forceinline__ float silu(float x) { return x * frcp(1.f + __expf(-x)); }
__device__ __forceinline__ float sigmoidf_(float x) { return frcp(1.f + __expf(-x)); }
__device__ __forceinline__ float softplusf_(float z) { return fmaxf(z, 0.f) + __logf(1.f + __expf(-fabsf(z))); }
__device__ __forceinline__ float tanh_fast(float x) { return 1.f - 2.f * frcp(1.f + __expf(2.f * x)); }

__device__ __forceinline__ int opq(int x) { asm volatile("" : "+s"(x)); return x; }
__device__ __forceinline__ int opaque_tid() { int t = threadIdx.x & 255; asm volatile("" : "+v"(t)); return t; }
__device__ __forceinline__ int opaque_tid512() { int t = threadIdx.x; asm volatile("" : "+v"(t)); return t; }
template <int CTRL>
__device__ __forceinline__ float dpp_f(float x) {
  return __builtin_bit_cast(float, __builtin_amdgcn_update_dpp(0, __builtin_bit_cast(int, x), CTRL, 0xf, 0xf, true));
}
__device__ __forceinline__ float row16_allsum(float x) {
  x += dpp_f<0x128>(x);
  x += dpp_f<0x124>(x);
  x += dpp_f<0x122>(x);
  x += dpp_f<0x121>(x);
  return x;
}
__device__ __forceinline__ float wave_sum(float v) {
  v = row16_allsum(v);
  const int iv = __builtin_bit_cast(int, v);
  const float a = __builtin_bit_cast(float, __builtin_amdgcn_readlane(iv, 0)), b = __builtin_bit_cast(float, __builtin_amdgcn_readlane(iv, 16));
  const float c = __builtin_bit_cast(float, __builtin_amdgcn_readlane(iv, 32)), d = __builtin_bit_cast(float, __builtin_amdgcn_readlane(iv, 48));
  return (a + b) + (c + d);
}

namespace pg8 {
#define PG8_LAS __attribute__((address_space(3)))
typedef unsigned short bf16_t;
typedef short bf16x8 __attribute__((ext_vector_type(8)));
typedef float f32x4 __attribute__((ext_vector_type(4)));
typedef unsigned u32x4 __attribute__((ext_vector_type(4)));
constexpr int BM = 256, BK = 64, HALF = 128, HTB = HALF * BK * 2  , STAGE_BYTES = 8 * HTB, NXCD = 8, WGM = 8;

__host__ __device__ __forceinline__ int lds_byte(int r, int c) { const int st = (r >> 4) * 2 + (c >> 5), rr = r & 15, cc = c & 31, ob = rr * 64 + cc * 2; return st * 1024 + (ob ^ (((ob >> 9) & 1) << 5)); }
__host__ __device__ __forceinline__ void stage_rc(int b, int& R, int& C) { const int st = b / 1024, sb = b % 1024, swz = sb ^ (((sb >> 9) & 1) << 5); R = (st >> 1) * 16 + swz / 64; C = (st & 1) * 32 + (swz % 64) / 2; }
__host__ __device__ __forceinline__ int perm32(int rho) { const int n = rho >> 4, i = rho & 15; return 8 * (i >> 2) + 4 * n + (i & 3); }

struct Unit { int pm, pn; };
struct Gemm { const bf16_t* A; const bf16_t* Bt; int M, N, K; };

struct StaticOrder {
    int nM, nN, nwg, G, c;
    __host__ __device__ void init(int M, int N, int G_, int c_) { nM = M / BM; nN = N / BM; nwg = nM * nN; G = G_; c = c_; }
    __host__ __device__ bool next(int i, Unit& u) const {
        const long L = (long)i * G + c; if (L >= nwg) return false;
        int wgid = (int)L; { const int q = nwg / NXCD, r = nwg % NXCD, xcd = wgid % NXCD, off = wgid / NXCD; wgid = (xcd < r ? xcd * (q + 1) : r * (q + 1) + (xcd - r) * q) + off; }
        const int nig = WGM * nN, gid = wgid / nig, fm = gid * WGM, gsz = (nM - fm) < WGM ? (nM - fm) : WGM;
        u.pm = fm + ((wgid % nig) % gsz); u.pn = (wgid % nig) / gsz; return true;
    }
    __device__ __forceinline__ void a_ready(const Unit&) const {}
    __device__ __forceinline__ void done(const Unit&) const {}
};
__device__ __forceinline__ unsigned cvt_pk_bf16(float lo, float hi) { unsigned r; asm volatile("v_cvt_pk_bf16_f32 %0, %1, %2" : "=v"(r) : "v"(lo), "v"(hi)); return r; }
template <class Epi, class Sched, bool STAMP = false>
__device__ __forceinline__ void gemm_phase(PG8_LAS unsigned char* lds, const Gemm g, const Sched& S, const Epi& E, unsigned long long* stamps) {
    const int tid = threadIdx.x, wid = __builtin_amdgcn_readfirstlane(tid >> 6), lane = tid & 63, wr = wid >> 2, wc = wid & 3, fr = lane & 15, fq = lane >> 4;
    const int K = g.K, nt = K / BK;
    int ts_lo = 0, ts_hi = 0, nts = 0; const unsigned long long rt_entry = STAMP ? (unsigned long long)wall_clock64() : 0ull;
#define PG8_STAMP() do { if (STAMP && wid == 0 && nts < 64) { const unsigned long long _c = (unsigned long long)clock64(); \
        ts_lo = (lane == nts) ? (int)(unsigned)_c : ts_lo; ts_hi = (lane == nts) ? (int)(unsigned)(_c >> 32) : ts_hi; ++nts; } } while (0)
    PG8_STAMP();
    unsigned voffA[2], voffB[2];
#pragma unroll
    for (int i = 0; i < 2; ++i) { int R, C; stage_rc(tid * 16 + i * 8192, R, C); const int Rb = Epi::PERM ? ((R & ~31) + perm32(R & 31)) : R;
        voffA[i] = (unsigned)(R * K + C) * 2u; voffB[i] = (unsigned)(Rb * K + C) * 2u; }
    const size_t kstep = (size_t)(BK * 2);
    const size_t hstep = (size_t)HALF * K * 2;
    const size_t tstep = 2 * hstep;
    const unsigned ldsw = (unsigned)wid * 1024u;
    const int aoff = lds_byte(wr * 64 + fr, fq * 8), boff = lds_byte(wc * 32 + fr, fq * 8);
#define PG8_SA(b, h) (((b) * 2 + (h)) * HTB)
#define PG8_SB(b, h) ((4 + (b) * 2 + (h)) * HTB)
#define PG8_STAGE(bufoff, gbase, voff) do { _Pragma("unroll") for (int _i = 0; _i < 2; ++_i) \
        __builtin_amdgcn_global_load_lds((const unsigned*)((const char*)(gbase) + (voff)[_i]), (PG8_LAS unsigned*)(lds + (bufoff) + ldsw + _i * 8192), 16, 0, 0); } while (0)
#define PG8_LDA(dst, b, h) do { _Pragma("unroll") for (int m = 0; m < 4; ++m) _Pragma("unroll") for (int k = 0; k < 2; ++k) dst[m][k] = *(const PG8_LAS bf16x8*)(lds + PG8_SA(b, h) + aoff + m * 2048 + k * 1024); } while (0)
#define PG8_LDB(dst, b, h) do { _Pragma("unroll") for (int n = 0; n < 2; ++n) _Pragma("unroll") for (int k = 0; k < 2; ++k) dst[n][k] = *(const PG8_LAS bf16x8*)(lds + PG8_SB(b, h) + boff + n * 2048 + k * 1024); } while (0)
#define PG8_MMA(ai, bj, At, Bt) do { __builtin_amdgcn_s_setprio(1); _Pragma("unroll") for (int m = 0; m < 4; ++m) _Pragma("unroll") for (int n = 0; n < 2; ++n) _Pragma("unroll") for (int k = 0; k < 2; ++k) \
        acc[ai][bj][m][n] = __builtin_amdgcn_mfma_f32_16x16x32_bf16(Bt[n][k], At[m][k], acc[ai][bj][m][n], 0, 0, 0); __builtin_amdgcn_s_setprio(0); } while (0)
#define PG8_WAIT_V(n) asm volatile("s_waitcnt vmcnt(" #n ")" ::: "memory")
#define PG8_WAIT_L(n) asm volatile("s_waitcnt lgkmcnt(" #n ")" ::: "memory")
#define PG8_BAR __builtin_amdgcn_s_barrier()
#define PG8_SCHED __builtin_amdgcn_sched_barrier(0)
    Unit cur, nxt; int ui = 0;
    if (!S.next(0, cur)) return;
    f32x4 acc[2][2][4][2];
#pragma unroll
    for (int a = 0; a < 2; ++a)
#pragma unroll
        for (int b = 0; b < 2; ++b)
#pragma unroll
            for (int m = 0; m < 4; ++m)
#pragma unroll
                for (int n = 0; n < 2; ++n) acc[a][b][m][n] = (f32x4){0.f, 0.f, 0.f, 0.f};
    bf16x8 At[4][2], B0[2][2], B1[2][2];
    const char* cA = (const char*)g.A + (size_t)cur.pm * tstep; const char* cB = (const char*)g.Bt + (size_t)cur.pn * tstep;
    S.a_ready(cur);
    PG8_STAGE(PG8_SB(0, 0), cB, voffB); PG8_STAGE(PG8_SA(0, 0), cA, voffA); PG8_STAGE(PG8_SB(0, 1), cB + hstep, voffB); PG8_STAGE(PG8_SA(0, 1), cA + hstep, voffA);
    if (wr == 1) PG8_BAR;
    PG8_WAIT_V(4); PG8_BAR;
    PG8_STAGE(PG8_SB(1, 0), cB + kstep, voffB); PG8_STAGE(PG8_SA(1, 0), cA + kstep, voffA); PG8_STAGE(PG8_SB(1, 1), cB + hstep + kstep, voffB);
    PG8_WAIT_V(6); PG8_BAR;
    PG8_STAMP();
    for (;;) {
        const bool has_next = S.next(ui + 1, nxt);
        const char* nA = has_next ? (const char*)g.A + (size_t)nxt.pm * tstep : cA; const char* nB = has_next ? (const char*)g.Bt + (size_t)nxt.pn * tstep : cB;
        for (int t = 0; t < nt; t += 2) {
            const bool last = (t == nt - 2);
            const char* a1 = cA + (size_t)(t + 1) * kstep;
            const char* a2 = last ? nA : cA + (size_t)(t + 2) * kstep; const char* b2 = last ? nB : cB + (size_t)(t + 2) * kstep;
            const char* a3 = a2 + kstep; const char* b3 = b2 + kstep;
            if (last && has_next) S.a_ready(nxt);
            PG8_LDB(B0, 0, 0); PG8_SCHED; PG8_LDA(At, 0, 0); PG8_STAGE(PG8_SA(1, 1), a1 + hstep, voffA);
            PG8_WAIT_L(8); PG8_BAR; PG8_WAIT_L(0); PG8_MMA(0, 0, At, B0); PG8_BAR; PG8_SCHED;
            PG8_LDB(B1, 0, 1); PG8_STAGE(PG8_SB(0, 0), b2, voffB);
            PG8_BAR; PG8_WAIT_L(0); PG8_MMA(0, 1, At, B1); PG8_BAR;
            PG8_LDA(At, 0, 1); PG8_STAGE(PG8_SA(0, 0), a2, voffA);
            PG8_BAR; PG8_WAIT_L(0); PG8_MMA(1, 0, At, B0); PG8_BAR; PG8_SCHED;
            PG8_STAGE(PG8_SB(0, 1), b2 + hstep, voffB);
            PG8_WAIT_V(6); PG8_BAR; PG8_MMA(1, 1, At, B1); PG8_BAR;
            PG8_LDB(B0, 1, 0); PG8_SCHED; PG8_LDA(At, 1, 0); PG8_STAGE(PG8_SA(0, 1), a2 + hstep, voffA);
            PG8_WAIT_L(8); PG8_BAR; PG8_WAIT_L(0); PG8_MMA(0, 0, At, B0); PG8_BAR; PG8_SCHED;
            PG8_LDB(B1, 1, 1); PG8_STAGE(PG8_SB(1, 0), b3, voffB);
            PG8_BAR; PG8_WAIT_L(0); PG8_MMA(0, 1, At, B1); PG8_BAR;
            PG8_LDA(At, 1, 1); PG8_STAGE(PG8_SA(1, 0), a3, voffA);
            PG8_BAR; PG8_WAIT_L(0); PG8_MMA(1, 0, At, B0); PG8_BAR; PG8_SCHED;
            PG8_STAGE(PG8_SB(1, 1), b3 + hstep, voffB);
            PG8_WAIT_V(6); PG8_BAR; PG8_MMA(1, 1, At, B1); PG8_BAR;
        }
        PG8_STAMP();
        if constexpr (!Epi::AFTER_DRAIN) { E(acc, cur, wr, wc, fr, fq); S.done(cur); }
        PG8_STAMP();
        if (!has_next) break;
#pragma unroll
        for (int a = 0; a < 2; ++a)
#pragma unroll
            for (int b = 0; b < 2; ++b)
#pragma unroll
                for (int m = 0; m < 4; ++m)
#pragma unroll
                    for (int n = 0; n < 2; ++n) acc[a][b][m][n] = (f32x4){0.f, 0.f, 0.f, 0.f};
        cur = nxt; cA = nA; cB = nB; ++ui;
    }
    PG8_WAIT_V(0);
    if (wr == 0) PG8_BAR;
    PG8_BAR;
    if constexpr (Epi::AFTER_DRAIN) { E.fused(acc, cur, wr, wc, fr, fq, lds, wid, lane); S.done(cur); }
    PG8_STAMP();
    if (STAMP && wid == 0) { stamps[lane] = lane < nts ? (((unsigned long long)(unsigned)ts_hi << 32) | (unsigned)ts_lo) : 0ull;
        if (lane == 62) stamps[62] = rt_entry; if (lane == 63) stamps[63] = (unsigned long long)wall_clock64(); }
#undef PG8_STAMP
#undef PG8_SA
#undef PG8_SB
#undef PG8_STAGE
#undef PG8_LDA
#undef PG8_LDB
#undef PG8_MMA
#undef PG8_WAIT_V
#undef PG8_WAIT_L
#undef PG8_BAR
#undef PG8_SCHED
}
}

namespace pg8 {
struct EpiProj {
    static constexpr bool PERM = true, AFTER_DRAIN = false;
    bf16_t* O; int ldc; int ncols;
    __device__ __forceinline__ void operator()(const f32x4 (&acc)[2][2][4][2], const Unit& u, int wr, int wc, int fr, int fq) const {
        const int row0 = u.pm * BM + wr * 64 + fr; const int col0 = u.pn * BM + wc * 32 + 8 * fq;
#pragma unroll
        for (int ai = 0; ai < 2; ++ai)
#pragma unroll
            for (int m = 0; m < 4; ++m) { bf16_t* rowp = O + (size_t)(row0 + ai * HALF + m * 16) * ldc + col0;
#pragma unroll
                for (int bj = 0; bj < 2; ++bj) { const f32x4 v0 = acc[ai][bj][m][0], v1 = acc[ai][bj][m][1];
                    u32x4 w; w.x = cvt_pk_bf16(v0[0], v0[1]); w.y = cvt_pk_bf16(v0[2], v0[3]); w.z = cvt_pk_bf16(v1[0], v1[1]); w.w = cvt_pk_bf16(v1[2], v1[3]);
                    if (col0 + bj * HALF < ncols) *(u32x4*)(rowp + bj * HALF) = w; } }
    }
};
struct EpiU {
    static constexpr bool PERM = true, AFTER_DRAIN = false;
    void* O; int ldc; int ncols; int f32out;
    __device__ __forceinline__ void operator()(const f32x4 (&acc)[2][2][4][2], const Unit& u, int wr, int wc, int fr, int fq) const {
        const int row0 = u.pm * BM + wr * 64 + fr; const int col0 = u.pn * BM + wc * 32 + 8 * fq;
        if (f32out) {
#pragma unroll
            for (int ai = 0; ai < 2; ++ai)
#pragma unroll
                for (int m = 0; m < 4; ++m) { float* rowp = (float*)O + (size_t)(row0 + ai * HALF + m * 16) * ldc + col0;
#pragma unroll
                    for (int bj = 0; bj < 2; ++bj) { *(f32x4*)(rowp + bj * HALF) = acc[ai][bj][m][0]; *(f32x4*)(rowp + bj * HALF + 4) = acc[ai][bj][m][1]; } }
        } else {
#pragma unroll
            for (int ai = 0; ai < 2; ++ai)
#pragma unroll
                for (int m = 0; m < 4; ++m) { bf16_t* rowp = (bf16_t*)O + (size_t)(row0 + ai * HALF + m * 16) * ldc + col0;
#pragma unroll
                    for (int bj = 0; bj < 2; ++bj) { const f32x4 v0 = acc[ai][bj][m][0], v1 = acc[ai][bj][m][1];
                        u32x4 w; w.x = cvt_pk_bf16(v0[0], v0[1]); w.y = cvt_pk_bf16(v0[2], v0[3]); w.z = cvt_pk_bf16(v1[0], v1[1]); w.w = cvt_pk_bf16(v1[2], v1[3]);
                        if (col0 + bj * HALF < ncols) *(u32x4*)(rowp + bj * HALF) = w; } }
        }
    }
};
}

#define XB_TMO      128
#define XB_XCNT(j)  (256  + 64 * (j))
#define XB_XSUB(j)  (1280 + 64 * (j))
#define XB_XGEN(j)  (2304 + 64 * (j))
#define XB_TOP      3328
#define XB_TOPGEN   3392
#define XCD_BAR_WORDS 3456
#define XB_SPIN_CAP (1u << 18)
#define LAS __attribute__((address_space(3)))

__device__ __forceinline__ unsigned xb_ld(unsigned* p)              { return __hip_atomic_load(p, __ATOMIC_RELAXED, __HIP_MEMORY_SCOPE_AGENT); }
__device__ __forceinline__ unsigned xb_add(unsigned* p, unsigned v) { return __hip_atomic_fetch_add(p, v, __ATOMIC_RELAXED, __HIP_MEMORY_SCOPE_AGENT); }
__device__ __forceinline__ unsigned xb_xcc_id() { return (unsigned)__builtin_amdgcn_s_getreg((3 << 11) | 20) & 0xFu; }
#define XB_SPIN(cond, bar) do { unsigned _sp = 0; while (cond) { __builtin_amdgcn_s_sleep(1); \
    if ((++_sp & 255u) == 0u) { if (xb_ld(&(bar)[XB_TMO])) break; if (_sp > XB_SPIN_CAP) { atomicAdd(&(bar)[XB_TMO], 1u); break; } } } } while (0)

struct XcdBarrier {
    unsigned* bar; unsigned x;
    volatile LAS unsigned* st;
};

__device__ __forceinline__ XcdBarrier xcd_barrier_post(unsigned* bar, volatile LAS unsigned* st) {
    XcdBarrier b; b.bar = bar; b.x = xb_xcc_id(); b.st = st;
    if (threadIdx.x == 0) (void)xb_add(&bar[XB_XCNT(b.x)], 1u);
    return b;
}
__device__ __forceinline__ void xcd_barrier_complete(unsigned* bar, unsigned x, unsigned& nloc, unsigned& nx) {
    const unsigned G = gridDim.x * gridDim.y * gridDim.z;
    unsigned sum, cnt, mine, sp = 0u;
    for (;;) {
        sum = 0u; cnt = 0u; mine = 0u;
#pragma unroll
        for (unsigned j = 0; j < 16; ++j) { const unsigned c = xb_ld(&bar[XB_XCNT(j)]); sum += c; cnt += (c > 0u) ? 1u : 0u; mine = (j == x) ? c : mine; }
        if (sum == G) break;
        __builtin_amdgcn_s_sleep(1);
        if ((++sp & 255u) == 0u) { if (xb_ld(&bar[XB_TMO])) break; if (sp > XB_SPIN_CAP) { atomicAdd(&bar[XB_TMO], 1u); break; } }
    }
    nloc = mine > 0u ? mine : 1u; nx = cnt > 0u ? cnt : 1u;
}

__device__ __forceinline__ void xcd_barrier(const XcdBarrier& b) {
    asm volatile("s_waitcnt vmcnt(0)" ::: "memory");
    __syncthreads();
    if (threadIdx.x == 0) {
        unsigned* bar = b.bar;
        __builtin_amdgcn_s_waitcnt(0);
        unsigned nloc = b.st[0], nx = b.st[1];
        if (nloc == 0u) { xcd_barrier_complete(bar, b.x, nloc, nx); b.st[0] = nloc; b.st[1] = nx; }
        const unsigned old = xb_add(&bar[XB_XSUB(b.x)], 1u);
        const unsigned gen = old / nloc;
        if (old + 1u == (gen + 1u) * nloc) {
            __builtin_amdgcn_fence(__ATOMIC_RELEASE, "agent");
            asm volatile("s_waitcnt vmcnt(0)" ::: "memory");
            const unsigned og = xb_add(&bar[XB_TOP], 1u);
            const unsigned tg = og / nx;
            if (og + 1u == (tg + 1u) * nx) xb_add(&bar[XB_TOPGEN], 1u);
            else XB_SPIN(xb_ld(&bar[XB_TOPGEN]) == tg, bar);
            __builtin_amdgcn_fence(__ATOMIC_ACQUIRE, "agent");
            xb_add(&bar[XB_XGEN(b.x)], 1u);
            asm volatile("s_waitcnt vmcnt(0)" ::: "memory");
        } else {
            XB_SPIN(xb_ld(&bar[XB_XGEN(b.x)]) == gen, bar);
            __builtin_amdgcn_fence(__ATOMIC_ACQUIRE, "agent");
            asm volatile("s_waitcnt vmcnt(0)" ::: "memory");
        }
    }
    __syncthreads();
}

__device__ void phase_mod_item(const Params& p, int it, unsigned char* smem) {
  float* red = (float*)smem;
  const int tid = opaque_tid(), tx = tid & 31, ty = tid >> 5;
  float* mod = (float*)(p.ws + OFF_MOD);
  it = opq(it);
  {
    int l = it / 96;
    int j = (it % 96) * 32 + tx;
    const float* W = p.ada_w + (size_t)l * 1024 * 3072;
    float* cs = red + 256;
#pragma unroll
    for (int i = 0; i < 4; ++i) cs[tid + 256 * i] = silu(p.c[tid + 256 * i]);
    __syncthreads();
    float acc = 0.f;
#pragma unroll 1
    for (int i0 = 0; i0 < 128; i0 += 16) {
      float wv[16];
#pragma unroll
      for (int i = 0; i < 16; ++i) wv[i] = W[(size_t)(ty * 128 + i0 + i) * 3072 + j];
#pragma unroll
      for (int i = 0; i < 16; ++i) acc += cs[ty * 128 + i0 + i] * wv[i];
    }
    red[ty * 32 + tx] = acc;
    __syncthreads();
    if (ty == 0) {
      float s = 0.f;
      for (int g = 0; g < 8; ++g) s += red[g * 32 + tx];
      mod[l * 3072 + j] = s + p.ada_b[l * 3072 + j];
    }
    __syncthreads();
  }
}

__device__ __forceinline__ float wall_src(const Params& p, int l, int k, int n) {
  size_t lk = (size_t)l * 1024 + k;
  if (n < 3072) return p.w_in[lk * 3072 + n];
  if (n < 3136) return (1.f - p.mu_w[lk]) * p.w1[lk * 64 + (n - 3072)];
  if (n < 3200) return p.mu_w[lk] * p.w1[lk * 64 + (n - 3136)];
  if (n < 3264) return (1.f - p.mu_a[lk]) * p.a1[lk * 64 + (n - 3200)];
  if (n < 3328) return p.mu_a[lk] * p.a1[lk * 64 + (n - 3264)];
  if (n < 3344) return p.gk1[lk * 16 + (n - 3328)];
  return 0.f;
}

__device__ void phase_wconv_item(const Params& p, int it, unsigned char* smem) {
  float* tile = (float*)smem;
  const int tid = opaque_tid();
  u16* WALL = (u16*)(p.ws + OFF_WALL);
  u16* WOUT = (u16*)(p.ws + OFF_WOUT);
  it = opq(it);
  {
    bool isout = it >= 3456;
    int l, nt, kt;
    if (!isout) { l = it / 864; int r = it % 864; nt = r >> 4; kt = r & 15; }
    else { int r = it - 3456; l = r >> 8; r &= 255; nt = r >> 4; kt = r & 15; }
    if (isout || nt < 48) {
      const float* src = isout ? p.w_out + (size_t)l * 1024 * 1024 : p.w_in + (size_t)l * 1024 * 3072;
      const int ld = isout ? 1024 : 3072;
      const int n4 = (tid & 15) * 4, k0 = tid >> 4;
      float4 v4[4];
#pragma unroll
      for (int i = 0; i < 4; ++i) v4[i] = *(const float4*)(src + (size_t)(kt * 64 + k0 + 16 * i) * ld + nt * 64 + n4);
#pragma unroll
      for (int i = 0; i < 4; ++i) {
        float* tp = tile + (k0 + 16 * i) * 65 + n4;
        tp[0] = v4[i].x; tp[1] = v4[i].y; tp[2] = v4[i].z; tp[3] = v4[i].w;
      }
    } else {
      int tx = tid & 63, ty = tid >> 6;
#pragma unroll
      for (int i = 0; i < 16; ++i) {
        int kl = ty + 4 * i;
        int k = kt * 64 + kl, n = nt * 64 + tx;
        tile[kl * 65 + tx] = wall_src(p, l, k, n);
      }
    }
    __syncthreads();
    int nl = tid >> 2, kq = tid & 3;
    unsigned w[8];
#pragma unroll
    for (int j = 0; j < 8; ++j) w[j] = pack2(tile[(kq * 16 + 2 * j) * 65 + nl], tile[(kq * 16 + 2 * j + 1) * 65 + nl]);
    u16* dst = (isout ? WOUT + ((size_t)l * 1024 + nt * 64 + nl) * 1024 : WALL + ((size_t)l * NALL + nt * 64 + nl) * 1024) + kt * 64 + kq * 16;
    ((uint4*)dst)[0] = make_uint4(w[0], w[1], w[2], w[3]);
    ((uint4*)dst)[1] = make_uint4(w[4], w[5], w[6], w[7]);
    __syncthreads();
  }
}

__device__ void phase_w2t_item(const Params& p, int it) {
  it = opq(it);
  const int c = opaque_tid();
  const int l = it >> 1, which = it & 1;
  const float* src = (which ? p.a2 : p.w2) + (size_t)l * 64 * 256 + c;
  u16* dst = (u16*)(p.ws + (which ? OFF_A2T : OFF_W2T)) + ((size_t)l * 256 + c) * 64;
#pragma unroll
  for (int j8 = 0; j8 < 8; ++j8) {
    float f[8];
#pragma unroll
    for (int q = 0; q < 8; ++q) f[q] = src[(j8 * 8 + q) * 256];
    *(uint4*)(dst + j8 * 8) = make_uint4(pack2(f[0], f[1]), pack2(f[2], f[3]), pack2(f[4], f[5]), pack2(f[6], f[7]));
  }
}

__device__ __forceinline__ void write_h(const Params& p, int l, int row, int lane, const float4* v, float ss) {
  const float* mod = (const float*)(p.ws + OFF_MOD) + l * 3072;
  u16* H = (u16*)(p.ws + OFF_H);
  float rs = rsqrtf(ss * (1.f / 1024.f) + 1e-6f);
#pragma unroll
  for (int i = 0; i < 4; ++i) {
    int col = (lane + 64 * i) * 4;
    float4 g = *(const float4*)(p.norm_pre + l * 1024 + col);
    float4 sh = *(const float4*)(mod + col);
    float4 sc = *(const float4*)(mod + 1024 + col);
    float h0 = v[i].x * rs * g.x * (1.f + sc.x) + sh.x;
    float h1 = v[i].y * rs * g.y * (1.f + sc.y) + sh.y;
    float h2 = v[i].z * rs * g.z * (1.f + sc.z) + sh.z;
    float h3 = v[i].w * rs * g.w * (1.f + sc.w) + sh.w;
    *(uint2*)(H + (size_t)row * 1024 + col) = make_uint2(pack2(h0, h1), pack2(h2, h3));
  }
}

__device__ void phase_h0(const Params& p) {
  const int tid = opaque_tid512(); const int wave = tid >> 6, lane = tid & 63;
  for (int row = blockIdx.x * 8 + wave; row < T_; row += gridDim.x * 8) {
    const float4* xr = (const float4*)(p.x + (size_t)row * 1024);
    float4 v[4];
    float ss = 0.f;
#pragma unroll
    for (int i = 0; i < 4; ++i) {
      v[i] = xr[lane + 64 * i];
      ss += v[i].x * v[i].x + v[i].y * v[i].y + v[i].z * v[i].z + v[i].w * v[i].w;
    }
    ss = wave_sum(ss);
    write_h(p, 0, row, lane, v, ss);
  }
}

__device__ void phase_post(const Params& p, int l) {
  l = opq(l);
  const int tid = opaque_tid512(); const int wave = tid >> 6, lane = tid & 63;
  const u16* Y = (const u16*)(p.ws + OFF_PROJ);
  const float* mod = (const float*)(p.ws + OFF_MOD) + l * 3072;
  const float* xold = (l == 0) ? p.x : p.out;
  for (int row = blockIdx.x * 8 + wave; row < T_; row += gridDim.x * 8) {
    const uint2* yr = (const uint2*)(Y + (size_t)row * 1024);
    const float4* xr = (const float4*)(xold + (size_t)row * 1024);
    float4 y[4], v[4];
    float ss = 0.f;
#pragma unroll
    for (int i = 0; i < 4; ++i) {
      const uint2 u = yr[lane + 64 * i];
      y[i] = make_float4(bflo(u.x), bfhi(u.x), bflo(u.y), bfhi(u.y));
      v[i] = xr[lane + 64 * i];
      ss += y[i].x * y[i].x + y[i].y * y[i].y + y[i].z * y[i].z + y[i].w * y[i].w;
    }
    ss = wave_sum(ss);
    float rs = rsqrtf(ss * (1.f / 1024.f) + 1e-6f);
    float s2 = 0.f;
#pragma unroll
    for (int i = 0; i < 4; ++i) {
      int col = (lane + 64 * i) * 4;
      float4 g = *(const float4*)(p.norm_post + l * 1024 + col);
      float4 gt = *(const float4*)(mod + 2048 + col);
      v[i].x += gt.x * (y[i].x * rs * g.x);
      v[i].y += gt.y * (y[i].y * rs * g.y);
      v[i].z += gt.z * (y[i].z * rs * g.z);
      v[i].w += gt.w * (y[i].w * rs * g.w);
      *(float4*)(p.out + (size_t)row * 1024 + col) = v[i];
      s2 += v[i].x * v[i].x + v[i].y * v[i].y + v[i].z * v[i].z + v[i].w * v[i].w;
    }
    if (l < 3) {
      s2 = wave_sum(s2);
      write_h(p, l + 1, row, lane, v, s2);
    }
  }
}

__device__ void attn_item(const Params& p, int l, int item, unsigned char* smem) {
  l = opq(l); item = opq(item);
  u16* Vt = (u16*)smem;
  const u16* PROJ = (const u16*)(p.ws + OFF_PROJ);
  u16* MIX = (u16*)(p.ws + OFF_MIX);
  const int tid = opaque_tid(), w = tid >> 6, lane = tid & 63, l31 = lane & 31, hf = lane >> 5;
  const int qb = item >> 3, head = item & 7, kvh = head >> 2;
  const int kpos0 = (qb - 1) * 128;
  {
    int kp = kpos0 + tid;
    if (kp < 0) kp = 0;
    const uint4* src = (const uint4*)(PROJ + (size_t)kp * NALL + 640 + kvh * 64);
#pragma unroll
    for (int c8 = 0; c8 < 8; ++c8) {
      uint4 v = src[c8];
      int d = c8 * 8;
      Vt[(d + 0) * 264 + tid] = (u16)(v.x & 0xffff);
      Vt[(d + 1) * 264 + tid] = (u16)(v.x >> 16);
      Vt[(d + 2) * 264 + tid] = (u16)(v.y & 0xffff);
      Vt[(d + 3) * 264 + tid] = (u16)(v.y >> 16);
      Vt[(d + 4) * 264 + tid] = (u16)(v.z & 0xffff);
      Vt[(d + 5) * 264 + tid] = (u16)(v.z >> 16);
      Vt[(d + 6) * 264 + tid] = (u16)(v.w & 0xffff);
      Vt[(d + 7) * 264 + tid] = (u16)(v.w >> 16);
    }
  }
  const int tq = qb * 128 + 32 * w + l31;
  bf16x8 qf[4], kc[4];
  {
    const u16* qp = PROJ + (size_t)tq * NALL + head * 64 + 8 * hf;
#pragma unroll
    for (int s = 0; s < 4; ++s) qf[s] = *(const bf16x8*)(qp + 16 * s);
    int kp = kpos0 + 32 * w + l31;
    if (kp < 0) kp = 0;
    const u16* kptr = PROJ + (size_t)kp * NALL + 512 + kvh * 64 + 8 * hf;
#pragma unroll
    for (int s = 0; s < 4; ++s) kc[s] = *(const bf16x8*)(kptr + 16 * s);
  }
  __syncthreads();
  const float slope = exp2f(-(float)(head + 1));
  const float sink = p.sinks[l * 8 + head];
  const int rq = 32 * w + l31;
  const u16* gp = PROJ + (size_t)tq * NALL + 768 + head * 64;
  uint2 gA[4], gB[4];
#pragma unroll
  for (int g = 0; g < 4; ++g) { gA[g] = *(const uint2*)(gp + 8 * g + 4 * hf); gB[g] = *(const uint2*)(gp + 32 + 8 * g + 4 * hf); }
  float mrun = -1e30f, lsum = 0.f;
  f32x16 o0, o1;
#pragma unroll
  for (int r = 0; r < 16; ++r) { o0[r] = 0.f; o1[r] = 0.f; }
#pragma unroll 1
  for (int i = 0; i < 5; ++i) {
    bf16x8 kn[4];
    {
      const int in_ = (i < 4) ? i + 1 : 4;
      int kp = kpos0 + 32 * w + 32 * in_ + l31;
      if (kp < 0) kp = 0;
      const u16* kptr = PROJ + (size_t)kp * NALL + 512 + kvh * 64 + 8 * hf;
#pragma unroll
      for (int s = 0; s < 4; ++s) kn[s] = *(const bf16x8*)(kptr + 16 * s);
    }
    f32x16 a;
#pragma unroll
    for (int r = 0; r < 16; ++r) a[r] = 0.f;
#pragma unroll
    for (int s = 0; s < 4; ++s) a = __builtin_amdgcn_mfma_f32_32x32x16_bf16(kc[s], qf[s], a, 0, 0, 0);
#pragma unroll
    for (int s = 0; s < 4; ++s) kc[s] = kn[s];
    float tmax = -1e30f;
#pragma unroll
    for (int r = 0; r < 16; ++r) {
      int kj = 32 * w + 32 * i + (r & 3) + 8 * (r >> 2) + 4 * hf;
      int dist = 128 + rq - kj;
      bool valid = (dist >= 0) && (dist < 128) && (kpos0 + kj >= 0);
      float sv = a[r] * 0.125f - slope * (float)dist;
      sv = valid ? sv : -1e30f;
      a[r] = sv;
      tmax = fmaxf(tmax, sv);
    }
    tmax = fmaxf(tmax, __shfl_xor(tmax, 32));
    const float mnew = fmaxf(mrun, tmax);
    const float alpha = __expf(mrun - mnew);
    float psum = 0.f;
#pragma unroll
    for (int r = 0; r < 16; ++r) {
      float e = (a[r] > -1e29f) ? __expf(a[r] - mnew) : 0.f;
      a[r] = e;
      psum += e;
    }
    lsum = lsum * alpha + psum;
    mrun = mnew;
#pragma unroll
    for (int r = 0; r < 16; ++r) { o0[r] *= alpha; o1[r] *= alpha; }
#pragma unroll
    for (int u = 0; u < 2; ++u) {
      bf16x8 pf;
#pragma unroll
      for (int j = 0; j < 8; ++j) pf[j] = (short)f2bf(a[8 * u + j]);
      const int kb = 32 * w + 32 * i + 16 * u + 4 * hf;
      const u16* v0 = Vt + l31 * 264 + kb;
      const u16* v1 = Vt + (32 + l31) * 264 + kb;
      uint2 a0 = *(const uint2*)(v0), a1 = *(const uint2*)(v0 + 8);
      uint2 b0 = *(const uint2*)(v1), b1 = *(const uint2*)(v1 + 8);
      uint4 A0 = make_uint4(a0.x, a0.y, a1.x, a1.y), A1 = make_uint4(b0.x, b0.y, b1.x, b1.y);
      o0 = __builtin_amdgcn_mfma_f32_32x32x16_bf16(__builtin_bit_cast(bf16x8, A0), pf, o0, 0, 0, 0);
      o1 = __builtin_amdgcn_mfma_f32_32x32x16_bf16(__builtin_bit_cast(bf16x8, A1), pf, o1, 0, 0, 0);
    }
  }
  {
    const float mf = fmaxf(mrun, sink);
    const float scl = __expf(mrun - mf);
    const float ltot = (lsum + __shfl_xor(lsum, 32)) * scl + __expf(sink - mf);
    const float fin = scl / ltot;
#pragma unroll
    for (int r = 0; r < 16; ++r) { o0[r] *= fin; o1[r] *= fin; }
  }
  u16* op = MIX + (size_t)tq * 1024 + head * 64;
#pragma unroll
  for (int g = 0; g < 4; ++g) {
    int d0 = 8 * g + 4 * hf;
    uint2 gg = gA[g];
    float r0 = o0[4 * g + 0] * silu(bflo(gg.x)), r1 = o0[4 * g + 1] * silu(bfhi(gg.x));
    float r2 = o0[4 * g + 2] * silu(bflo(gg.y)), r3 = o0[4 * g + 3] * silu(bfhi(gg.y));
    *(uint2*)(op + d0) = make_uint2(pack2(r0, r1), pack2(r2, r3));
    uint2 g2 = gB[g];
    r0 = o1[4 * g + 0] * silu(bflo(g2.x)); r1 = o1[4 * g + 1] * silu(bfhi(g2.x));
    r2 = o1[4 * g + 2] * silu(bflo(g2.y)); r3 = o1[4 * g + 3] * silu(bfhi(g2.y));
    *(uint2*)(op + 32 + d0) = make_uint2(pack2(r0, r1), pack2(r2, r3));
  }
  __syncthreads();
}

__device__ void rwkv_prep_item(const Params& p, int l, int item, unsigned char* smem) {
  l = opq(l); item = opq(item);
  u16* lwb = (u16*)smem;
  u16* lab = lwb + 16 * 72;
  const u16* PROJ = (const u16*)(p.ws + OFF_PROJ);
  const int tid = opaque_tid(), head = tid >> 6, lane = tid & 63, fr = lane & 15, fq = lane >> 4;
  const int t0 = item * 16;
  {
    const int which = tid >> 7, tt = (tid >> 3) & 15, j0 = (tid & 7) * 8;
    const int t = t0 + tt;
    const u16* pr = PROJ + (size_t)t * NALL;
    const u16* pq = (t > 0) ? pr - NALL : pr;
    const float pm = (t > 0) ? 1.f : 0.f;
    const uint4 cu = *(const uint4*)(pr + (which ? 3200 : 3072) + j0);
    const uint4 pu = *(const uint4*)(pq + (which ? 3264 : 3136) + j0);
    float sv[8];
    sv[0] = bflo(cu.x) + pm * bflo(pu.x); sv[1] = bfhi(cu.x) + pm * bfhi(pu.x);
    sv[2] = bflo(cu.y) + pm * bflo(pu.y); sv[3] = bfhi(cu.y) + pm * bfhi(pu.y);
    sv[4] = bflo(cu.z) + pm * bflo(pu.z); sv[5] = bfhi(cu.z) + pm * bfhi(pu.z);
    sv[6] = bflo(cu.w) + pm * bflo(pu.w); sv[7] = bfhi(cu.w) + pm * bfhi(pu.w);
    if (!which) {
#pragma unroll
      for (int q = 0; q < 8; ++q) sv[q] = tanh_fast(sv[q]);
    }
    *(uint4*)((which ? lab : lwb) + tt * 72 + j0) = make_uint4(pack2(sv[0], sv[1]), pack2(sv[2], sv[3]), pack2(sv[4], sv[5]), pack2(sv[6], sv[7]));
  }
  __syncthreads();
  f32x4 accw[4], acca[4];
#pragma unroll
  for (int nt = 0; nt < 4; ++nt) { accw[nt] = (f32x4){0.f, 0.f, 0.f, 0.f}; acca[nt] = (f32x4){0.f, 0.f, 0.f, 0.f}; }
  {
    const u16* W2T = (const u16*)(p.ws + OFF_W2T) + ((size_t)l * 256 + head * 64 + fr * 4) * 64 + fq * 8;
    const u16* A2T = (const u16*)(p.ws + OFF_A2T) + ((size_t)l * 256 + head * 64 + fr * 4) * 64 + fq * 8;
#pragma unroll
    for (int ks = 0; ks < 2; ++ks) {
      const bf16x8 aw = *(const bf16x8*)(lwb + fr * 72 + ks * 32 + fq * 8);
      const bf16x8 aa = *(const bf16x8*)(lab + fr * 72 + ks * 32 + fq * 8);
#pragma unroll
      for (int nt = 0; nt < 4; ++nt) {
        const bf16x8 bw = *(const bf16x8*)(W2T + nt * 64 + ks * 32);
        const bf16x8 ba = *(const bf16x8*)(A2T + nt * 64 + ks * 32);
        accw[nt] = __builtin_amdgcn_mfma_f32_16x16x32_bf16(aw, bw, accw[nt], 0, 0, 0);
        acca[nt] = __builtin_amdgcn_mfma_f32_16x16x32_bf16(aa, ba, acca[nt], 0, 0, 0);
      }
    }
  }
  const int c0 = head * 64 + fr * 4;
  const float4 mur = *(const float4*)(p.mu_rkv + l * 768 + c0), muk = *(const float4*)(p.mu_rkv + l * 768 + 256 + c0), muv = *(const float4*)(p.mu_rkv + l * 768 + 512 + c0);
  const float4 w0 = *(const float4*)(p.w0 + l * 256 + c0), a0 = *(const float4*)(p.a0 + l * 256 + c0);
  const float4 kkw = *(const float4*)(p.k_k + l * 256 + c0), kaw = *(const float4*)(p.k_a + l * 256 + c0), rkw = *(const float4*)(p.r_k + l * 256 + c0);
  float* RWW = (float*)(p.ws + OFF_RWW);
  float* RWKK = (float*)(p.ws + OFF_RWKK);
  u16* RB = (u16*)(p.ws + OFF_RWB);
  float* BON = (float*)(p.ws + OFF_BONUS);
#define F4E(v, i) ((i) == 0 ? v.x : (i) == 1 ? v.y : (i) == 2 ? v.z : v.w)
#pragma unroll
  for (int rg = 0; rg < 4; ++rg) {
    const int t = t0 + fq * 4 + rg;
    const u16* pr = PROJ + (size_t)t * NALL;
    const u16* pp = (t > 0) ? pr - NALL : pr;
    const float pm = (t > 0) ? 1.f : 0.f;
    const uint2 rcu = *(const uint2*)(pr + 1280 + c0), kcu = *(const uint2*)(pr + 1536 + c0), vcu = *(const uint2*)(pr + 1792 + c0);
    const uint2 rpu = *(const uint2*)(pp + 1280 + c0), kpu = *(const uint2*)(pp + 1536 + c0), vpu = *(const uint2*)(pp + 1792 + c0);
    const float rc[4] = {bflo(rcu.x), bfhi(rcu.x), bflo(rcu.y), bfhi(rcu.y)}, kc[4] = {bflo(kcu.x), bfhi(kcu.x), bflo(kcu.y), bfhi(kcu.y)};
    const float vc[4] = {bflo(vcu.x), bfhi(vcu.x), bflo(vcu.y), bfhi(vcu.y)};
    const float rp[4] = {bflo(rpu.x), bfhi(rpu.x), bflo(rpu.y), bfhi(rpu.y)}, kp[4] = {bflo(kpu.x), bfhi(kpu.x), bflo(kpu.y), bfhi(kpu.y)};
    const float vp[4] = {bflo(vpu.x), bfhi(vpu.x), bflo(vpu.y), bfhi(vpu.y)};
    float kkc[4], av[4], dec[4], rr[4], km[4], vv[4];
    float n2 = 0.f, bonus = 0.f;
#pragma unroll
    for (int nt = 0; nt < 4; ++nt) {
      const float r = rc[nt] + (pm * rp[nt] - rc[nt]) * F4E(mur, nt), k = kc[nt] + (pm * kp[nt] - kc[nt]) * F4E(muk, nt), v = vc[nt] + (pm * vp[nt] - vc[nt]) * F4E(muv, nt);
      const float wpre = F4E(w0, nt) + accw[nt][rg];
      const float wl = -softplusf_(-wpre) - 0.5f;
      dec[nt] = __expf(-__expf(wl));
      const float a = sigmoidf_(F4E(a0, nt) + acca[nt][rg]);
      const float kc2 = k * F4E(kkw, nt);
      const float kmod = k * (1.f + (a - 1.f) * F4E(kaw, nt));
      kkc[nt] = kc2; av[nt] = a; rr[nt] = r; km[nt] = kmod; vv[nt] = v;
      n2 += kc2 * kc2;
      bonus += r * kmod * F4E(rkw, nt);
    }
    n2 = row16_allsum(n2);
    bonus = row16_allsum(bonus);
    const float inv = __builtin_amdgcn_rsqf(fmaxf(n2, 1e-24f));
    const size_t o = (size_t)t * 256 + c0;
    *(float4*)(RWW + o) = make_float4(dec[0], dec[1], dec[2], dec[3]);
    *(float4*)(RWKK + o) = make_float4(kkc[0] * inv, kkc[1] * inv, kkc[2] * inv, kkc[3] * inv);
    *(uint2*)(RB + o) = make_uint2(pack2(rr[0], rr[1]), pack2(rr[2], rr[3]));
    *(uint2*)(RB + (size_t)T_ * 256 + o) = make_uint2(pack2(km[0], km[1]), pack2(km[2], km[3]));
    *(uint2*)(RB + (size_t)2 * T_ * 256 + o) = make_uint2(pack2(vv[0], vv[1]), pack2(vv[2], vv[3]));
    *(uint2*)(RB + (size_t)3 * T_ * 256 + o) = make_uint2(pack2(kkc[0] * inv * av[0], kkc[1] * inv * av[1]), pack2(kkc[2] * inv * av[2], kkc[3] * inv * av[3]));
    if (fr == 0) BON[t * 4 + head] = bonus;
  }
  __syncthreads();
}

__device__ __forceinline__ void gla_b(const Params& p, int l, int head, const u16* lgs, float* tot, float* bl) {
  const int tid = opaque_tid(), d = tid & 31, ig = tid >> 5;
  float g2[16];
#pragma unroll
  for (int m = 0; m < 16; ++m) g2[m] = p.gk2[(size_t)l * 16 * 128 + m * 128 + head * 32 + d];
  const float bias = p.gk_b[l * 128 + head * 32 + d];
  float run = 0.f;
#pragma unroll
  for (int ii = 0; ii < 8; ++ii) {
    const uint4* lp = (const uint4*)(lgs + (ig * 8 + ii) * 16);
    uint4 u0 = lp[0], u1 = lp[1];
    float z = bias;
    z += bflo(u0.x) * g2[0] + bfhi(u0.x) * g2[1] + bflo(u0.y) * g2[2] + bfhi(u0.y) * g2[3];
    z += bflo(u0.z) * g2[4] + bfhi(u0.z) * g2[5] + bflo(u0.w) * g2[6] + bfhi(u0.w) * g2[7];
    z += bflo(u1.x) * g2[8] + bfhi(u1.x) * g2[9] + bflo(u1.y) * g2[10] + bfhi(u1.y) * g2[11];
    z += bflo(u1.z) * g2[12] + bfhi(u1.z) * g2[13] + bflo(u1.w) * g2[14] + bfhi(u1.w) * g2[15];
    float g = (fminf(z, 0.f) - __logf(1.f + __expf(-fabsf(z)))) * (1.f / 16.f);
    run += g;
    bl[ii] = run;
  }
  tot[ig * 32 + d] = run;
  __syncthreads();
  float off = 0.f;
#pragma unroll
  for (int g = 0; g < 8; ++g) off += (g < ig) ? tot[g * 32 + d] : 0.f;
#pragma unroll
  for (int ii = 0; ii < 8; ++ii) bl[ii] += off;
}
__device__ __forceinline__ void st8f(float* dst, const uint4 u) {
  *(float4*)(dst) = make_float4(bflo(u.x), bfhi(u.x), bflo(u.y), bfhi(u.y));
  *(float4*)(dst + 4) = make_float4(bflo(u.z), bfhi(u.z), bflo(u.w), bfhi(u.w));
}

__device__ void gla_local_item(const Params& p, int l, int item, unsigned char* smem) {
  l = opq(l); item = opq(item);
  float* tot = (float*)smem;
  float* Kp = tot + 256;
  float* Vs = Kp + 2048;
  u16* lgs = (u16*)(Vs + 4096);
  const u16* PROJ = (const u16*)(p.ws + OFF_PROJ);
  const int tid = opaque_tid(), d = tid & 31, ig = tid >> 5;
  const int chunk = item >> 2, head = item & 3;
  {
    const u16* base = PROJ + (size_t)(chunk * 64) * NALL;
    const int ki = tid >> 2, kd0 = (tid & 3) * 8;
    const uint4 ku = *(const uint4*)(base + (size_t)ki * NALL + 2432 + head * 32 + kd0);
    const int g0 = tid, g1 = tid + 256;
    const uint4 vu0 = *(const uint4*)(base + (size_t)(g0 >> 3) * NALL + 2560 + head * 64 + (g0 & 7) * 8);
    const uint4 vu1 = *(const uint4*)(base + (size_t)(g1 >> 3) * NALL + 2560 + head * 64 + (g1 & 7) * 8);
    uint4 lu = make_uint4(0u, 0u, 0u, 0u);
    if (tid < 128) lu = *(const uint4*)(base + (size_t)(tid >> 1) * NALL + 3328 + (tid & 1) * 8);
    st8f(Kp + ki * 32 + kd0, ku);
    st8f(Vs + (g0 >> 3) * 64 + (g0 & 7) * 8, vu0);
    st8f(Vs + (g1 >> 3) * 64 + (g1 & 7) * 8, vu1);
    if (tid < 128) *(uint4*)(lgs + (tid >> 1) * 16 + (tid & 1) * 8) = lu;
  }
  __syncthreads();
  float bl[8];
  gla_b(p, l, head, lgs, tot, bl);
  float blast = 0.f;
#pragma unroll
  for (int g = 0; g < 8; ++g) blast += tot[g * 32 + d];
#pragma unroll
  for (int ii = 0; ii < 8; ++ii) {
    const int i = ig * 8 + ii;
    Kp[i * 32 + d] *= __expf(blast - bl[ii]);
  }
  __syncthreads();
  const int v = tid & 63, dg = tid >> 6;
  float acc[8];
#pragma unroll
  for (int q = 0; q < 8; ++q) acc[q] = 0.f;
  for (int i = 0; i < 64; ++i) {
    float vv = Vs[i * 64 + v];
    float4 k0 = *(const float4*)(Kp + i * 32 + dg * 8), k1 = *(const float4*)(Kp + i * 32 + dg * 8 + 4);
    acc[0] += k0.x * vv; acc[1] += k0.y * vv; acc[2] += k0.z * vv; acc[3] += k0.w * vv;
    acc[4] += k1.x * vv; acc[5] += k1.y * vv; acc[6] += k1.z * vv; acc[7] += k1.w * vv;
  }
  float* GS = (float*)(p.ws + OFF_GLAS);
  float* GD = (float*)(p.ws + OFF_GLAD);
#pragma unroll
  for (int q = 0; q < 8; ++q) GS[((size_t)(chunk * 4 + head) * 32 + dg * 8 + q) * 64 + v] = acc[q];
  if (tid < 32) GD[(chunk * 4 + head) * 32 + tid] = __expf(blast);
  __syncthreads();
}

#define GLA_STATE_LOAD(eb_) \
  const int gs_tid = opaque_tid512(); const int gs_ei = gs_tid & 31, gs_g = gs_tid >> 5; \
  const int gs_e = (eb_) * 32 + gs_ei; const int gs_head = gs_e >> 11, gs_d = (gs_e >> 6) & 31, gs_v = gs_e & 63; \
  float gs_ds[16], gs_dc[16]; \
  { float* GSl = (float*)(p.ws + OFF_GLAS); const float* GDl = (const float*)(p.ws + OFF_GLAD); \
    _Pragma("unroll") for (int i = 0; i < 16; ++i) { const int c = gs_g * 16 + i; \
      gs_ds[i] = GSl[((size_t)(c * 4 + gs_head) * 32 + gs_d) * 64 + gs_v]; gs_dc[i] = GDl[(c * 4 + gs_head) * 32 + gs_d]; } }
#define GLA_STATE_FINISH(dsm_) { \
    float* comp = (float*)(dsm_); float* GSl = (float*)(p.ws + OFF_GLAS); \
    float S = 0.f, P = 1.f; \
    _Pragma("unroll") for (int i = 0; i < 16; ++i) { S = gs_dc[i] * S + gs_ds[i]; P *= gs_dc[i]; } \
    comp[(gs_g * 32 + gs_ei) * 2] = P; comp[(gs_g * 32 + gs_ei) * 2 + 1] = S; \
    __syncthreads(); \
    float G = 0.f; \
    for (int gg = 0; gg < gs_g; ++gg) G = comp[(gg * 32 + gs_ei) * 2] * G + comp[(gg * 32 + gs_ei) * 2 + 1]; \
    _Pragma("unroll") for (int i = 0; i < 16; ++i) { const int c = gs_g * 16 + i; \
      GSl[((size_t)(c * 4 + gs_head) * 32 + gs_d) * 64 + gs_v] = G; G = gs_dc[i] * G + gs_ds[i]; } \
    __syncthreads(); }

__device__ void gla_out_item(const Params& p, int l, int item, unsigned char* smem) {
  l = opq(l); item = opq(item);
  float* tot = (float*)smem;
  float* qt = tot + 256;
  float* kt = qt + 2304;
  float* Vs = kt + 2304;
  float* Am = Vs + 4096;
  float* Ss = Am + 4352;
  u16* lgs = (u16*)(Ss + 2048);
  const u16* PROJ = (const u16*)(p.ws + OFF_PROJ);
  u16* MIX = (u16*)(p.ws + OFF_MIX);
  const float* GS = (const float*)(p.ws + OFF_GLAS);
  const int tid = opaque_tid();
  const int chunk = item >> 2, head = item & 3;
  {
    const u16* base = PROJ + (size_t)(chunk * 64) * NALL;
    const int ki = tid >> 2, kd0 = (tid & 3) * 8;
    const uint4 qu = *(const uint4*)(base + (size_t)ki * NALL + 2304 + head * 32 + kd0);
    const uint4 ku = *(const uint4*)(base + (size_t)ki * NALL + 2432 + head * 32 + kd0);
    const int g0 = tid, g1 = tid + 256;
    const uint4 vu0 = *(const uint4*)(base + (size_t)(g0 >> 3) * NALL + 2560 + head * 64 + (g0 & 7) * 8);
    const uint4 vu1 = *(const uint4*)(base + (size_t)(g1 >> 3) * NALL + 2560 + head * 64 + (g1 & 7) * 8);
    const float4 s0 = ((const float4*)(GS + (size_t)(chunk * 4 + head) * 2048))[tid];
    const float4 s1 = ((const float4*)(GS + (size_t)(chunk * 4 + head) * 2048))[tid + 256];
    uint4 lu = make_uint4(0u, 0u, 0u, 0u);
    if (tid < 128) lu = *(const uint4*)(base + (size_t)(tid >> 1) * NALL + 3328 + (tid & 1) * 8);
    st8f(qt + ki * 36 + kd0, qu);
    st8f(kt + ki * 36 + kd0, ku);
    st8f(Vs + (g0 >> 3) * 64 + (g0 & 7) * 8, vu0);
    st8f(Vs + (g1 >> 3) * 64 + (g1 & 7) * 8, vu1);
    ((float4*)Ss)[tid] = s0;
    ((float4*)Ss)[tid + 256] = s1;
    if (tid < 128) *(uint4*)(lgs + (tid >> 1) * 16 + (tid & 1) * 8) = lu;
  }
  __syncthreads();
  {
    const int d = tid & 31, ig = tid >> 5;
    float bl[8];
    gla_b(p, l, head, lgs, tot, bl);
#pragma unroll
    for (int ii = 0; ii < 8; ++ii) {
      const int i = ig * 8 + ii;
      qt[i * 36 + d] *= 0.17677669529663687f * __expf(bl[ii]);
      kt[i * 36 + d] *= __expf(-bl[ii]);
    }
  }
  __syncthreads();
  const int j = tid & 63, ig = tid >> 6;
  {
    float acc[16];
#pragma unroll
    for (int ii = 0; ii < 16; ++ii) acc[ii] = 0.f;
#pragma unroll 2
    for (int d4 = 0; d4 < 8; ++d4) {
      const float4 kv = *(const float4*)(kt + j * 36 + d4 * 4);
#pragma unroll
      for (int ii = 0; ii < 16; ++ii) {
        const float4 qv = *(const float4*)(qt + (ig * 16 + ii) * 36 + d4 * 4);
        acc[ii] += qv.x * kv.x + qv.y * kv.y + qv.z * kv.z + qv.w * kv.w;
      }
    }
#pragma unroll
    for (int ii = 0; ii < 16; ++ii) {
      int i = ig * 16 + ii;
      Am[i * 68 + j] = (j <= i) ? acc[ii] : 0.f;
    }
  }
  __syncthreads();
  {
    const int v = j;
    float acc[16];
#pragma unroll
    for (int ii = 0; ii < 16; ++ii) acc[ii] = 0.f;
    const int jmax = (ig + 1) * 4;
    for (int j4 = 0; j4 < jmax; ++j4) {
      const float v0 = Vs[(j4 * 4 + 0) * 64 + v], v1 = Vs[(j4 * 4 + 1) * 64 + v], v2 = Vs[(j4 * 4 + 2) * 64 + v], v3 = Vs[(j4 * 4 + 3) * 64 + v];
#pragma unroll
      for (int ii = 0; ii < 16; ++ii) {
        const float4 av = *(const float4*)(Am + (ig * 16 + ii) * 68 + j4 * 4);
        acc[ii] += av.x * v0 + av.y * v1 + av.z * v2 + av.w * v3;
      }
    }
#pragma unroll 2
    for (int d4 = 0; d4 < 8; ++d4) {
      const float s0 = Ss[(d4 * 4 + 0) * 64 + v], s1 = Ss[(d4 * 4 + 1) * 64 + v], s2 = Ss[(d4 * 4 + 2) * 64 + v], s3 = Ss[(d4 * 4 + 3) * 64 + v];
#pragma unroll
      for (int ii = 0; ii < 16; ++ii) {
        const float4 qv = *(const float4*)(qt + (ig * 16 + ii) * 36 + d4 * 4);
        acc[ii] += qv.x * s0 + qv.y * s1 + qv.z * s2 + qv.w * s3;
      }
    }
    __syncthreads();
#pragma unroll
    for (int ii = 0; ii < 16; ++ii) Am[(ig * 16 + ii) * 68 + v] = acc[ii];
  }
  __syncthreads();
  {
    const int fr = tid & 15, tg = tid >> 4;
    const float4 nw = *(const float4*)(p.gla_nw + l * 64 + fr * 4);
#pragma unroll
    for (int ps = 0; ps < 4; ++ps) {
      const int i = ps * 16 + tg;
      const int t = chunk * 64 + i;
      const float4 o = *(const float4*)(Am + i * 68 + fr * 4);
      const uint2 gg = *(const uint2*)(PROJ + (size_t)t * NALL + 2816 + head * 64 + fr * 4);
      const float ms = row16_allsum(o.x * o.x + o.y * o.y + o.z * o.z + o.w * o.w) * (1.f / 64.f);
      const float rs = rsqrtf(ms + 1e-5f);
      const float r0 = o.x * rs * nw.x * silu(bflo(gg.x)), r1 = o.y * rs * nw.y * silu(bfhi(gg.x));
      const float r2 = o.z * rs * nw.z * silu(bflo(gg.y)), r3 = o.w * rs * nw.w * silu(bfhi(gg.y));
      *(uint2*)(MIX + (size_t)t * 1024 + 768 + head * 64 + fr * 4) = make_uint2(pack2(r0, r1), pack2(r2, r3));
    }
  }
  __syncthreads();
}

typedef float f32x2 __attribute__((ext_vector_type(2)));
__device__ __forceinline__ float oct_allsum(float x) {
  x += dpp_f<0xB1>(x);
  x += dpp_f<0x4E>(x);
  x += dpp_f<0x141>(x);
  return x;
}
__device__ void rwkv_scan_item(const Params& p, int item, unsigned char* dsm_) {
  item = opq(item);
  float* st = (float*)dsm_;
  const int tid = opaque_tid512(), wv = tid >> 6, lane = tid & 63, rs = lane >> 3, kl = lane & 7;
  const int head = item & 3, seg = item >> 2;
  const bool ident = wv >= 4;
  const int R0 = wv * 16 + rs * 2;
  const int v0 = R0 & 63;
  const float* RWW = (const float*)(p.ws + OFF_RWW);
  const float* RWKK = (const float*)(p.ws + OFF_RWKK);
  const u16* RB = (const u16*)(p.ws + OFF_RWB);
  float* PF = (float*)(p.ws + OFF_PROJ);
  float* ZP = (float*)(p.ws + OFF_ZP);
  const int tbase = seg * SL;
  const int half = tid >> 8, ls = (tid & 255) >> 4, lc4 = (tid & 15) * 4;
  f32x2 S0[4], S1[4];
#pragma unroll
  for (int e = 0; e < 4; ++e) { S0[e] = (f32x2){0.f, 0.f}; S1[e] = (f32x2){0.f, 0.f}; }
  if (ident) {
#pragma unroll
    for (int e = 0; e < 4; ++e) {
      const int k0 = kl * 8 + 2 * e;
      S0[e] = (f32x2){(v0 == k0) ? 1.f : 0.f, (v0 == k0 + 1) ? 1.f : 0.f};
      S1[e] = (f32x2){(v0 + 1 == k0) ? 1.f : 0.f, (v0 + 1 == k0 + 1) ? 1.f : 0.f};
    }
  }
  float4 g0 = make_float4(0.f, 0.f, 0.f, 0.f);
  uint2 h0 = make_uint2(0u, 0u), h1 = h0, h2 = h0;
  const float* gp0 = (half == 0 ? RWW : RWKK) + (size_t)(tbase + ls) * 256 + head * 64 + lc4;
  const u16* hp = RB + (size_t)(tbase + ls) * 256 + head * 64 + lc4;
#define SCAN_GLOAD(ch) do { const size_t _o = (size_t)(ch) * 16 * 256; g0 = *(const float4*)(gp0 + _o); \
    if (half == 0) { h0 = *(const uint2*)(hp + _o); } \
    else { h0 = *(const uint2*)(hp + (size_t)T_ * 256 + _o); h1 = *(const uint2*)(hp + (size_t)3 * T_ * 256 + _o); h2 = *(const uint2*)(hp + (size_t)2 * T_ * 256 + _o); } } while (0)
#define SCAN_LSTORE(buf) do { float* _b = st + (buf) * 6144 + ls * 64 + lc4; \
    if (half == 0) { *(float4*)(_b) = g0; *(float4*)(_b + 2048) = make_float4(bflo(h0.x), bfhi(h0.x), bflo(h0.y), bfhi(h0.y)); } \
    else { *(float4*)(_b + 1024) = g0; *(float4*)(_b + 3072) = make_float4(bflo(h0.x), bfhi(h0.x), bflo(h0.y), bfhi(h0.y)); \
           *(float4*)(_b + 4096) = make_float4(bflo(h1.x), bfhi(h1.x), bflo(h1.y), bfhi(h1.y)); *(float4*)(_b + 5120) = make_float4(bflo(h2.x), bfhi(h2.x), bflo(h2.y), bfhi(h2.y)); } } while (0)
  if (tid < 16) st[2 * 6144 + tid] = 0.f;
  SCAN_GLOAD(0);
  SCAN_LSTORE(0);
  __syncthreads();
  const int nch = SL / 16;
  float* yout = PF + (size_t)tbase * PROJF + (ident ? 256 : 0) + head * 64 + v0;
  const int voff = ident ? (2 * 6144) : (5120 + v0);
  const int vstep = ident ? 0 : 64, vbuf = ident ? 0 : 6144;
#define V2(a, i) ((f32x2){(i) ? a.z : a.x, (i) ? a.w : a.y})
#define SCAN_STEP(s_) do { \
    const float* bp = b + (s_) * 64 + kl * 8; \
    const float4 wl = *(const float4*)(bp), wh = *(const float4*)(bp + 4); \
    const float4 kkl = *(const float4*)(bp + 1024), kkh = *(const float4*)(bp + 1028); \
    const float4 rl4 = *(const float4*)(bp + 2048), rh4 = *(const float4*)(bp + 2052); \
    const float4 kl4 = *(const float4*)(bp + 3072), kh4 = *(const float4*)(bp + 3076); \
    const float4 bl4 = *(const float4*)(bp + 4096), bh4 = *(const float4*)(bp + 4100); \
    const f32x2 vv = *(const f32x2*)(vsrc + (s_) * vstep); \
    const f32x2 W[4] = {V2(wl, 0), V2(wl, 1), V2(wh, 0), V2(wh, 1)}, KK[4] = {V2(kkl, 0), V2(kkl, 1), V2(kkh, 0), V2(kkh, 1)}; \
    const f32x2 RR[4] = {V2(rl4, 0), V2(rl4, 1), V2(rh4, 0), V2(rh4, 1)}, KV[4] = {V2(kl4, 0), V2(kl4, 1), V2(kh4, 0), V2(kh4, 1)}; \
    const f32x2 BB[4] = {V2(bl4, 0), V2(bl4, 1), V2(bh4, 0), V2(bh4, 1)}; \
    f32x2 t0 = S0[0] * KK[0] + S0[1] * KK[1] + S0[2] * KK[2] + S0[3] * KK[3]; \
    f32x2 t1 = S1[0] * KK[0] + S1[1] * KK[1] + S1[2] * KK[2] + S1[3] * KK[3]; \
    float sa0 = -(t0.x + t0.y), sa1 = -(t1.x + t1.y); \
    sa0 += dpp_f<0xB1>(sa0); sa1 += dpp_f<0xB1>(sa1); sa0 += dpp_f<0x4E>(sa0); sa1 += dpp_f<0x4E>(sa1); sa0 += dpp_f<0x141>(sa0); sa1 += dpp_f<0x141>(sa1); \
    const f32x2 a0 = {sa0, sa0}, a1 = {sa1, sa1}, u0 = {vv.x, vv.x}, u1 = {vv.y, vv.y}; \
    _Pragma("unroll") for (int e = 0; e < 4; ++e) { S0[e] = S0[e] * W[e] + a0 * BB[e] + u0 * KV[e]; S1[e] = S1[e] * W[e] + a1 * BB[e] + u1 * KV[e]; } \
    f32x2 q0 = S0[0] * RR[0] + S0[1] * RR[1] + S0[2] * RR[2] + S0[3] * RR[3]; \
    f32x2 q1 = S1[0] * RR[0] + S1[1] * RR[1] + S1[2] * RR[2] + S1[3] * RR[3]; \
    float y0 = q0.x + q0.y, y1 = q1.x + q1.y; \
    y0 += dpp_f<0xB1>(y0); y1 += dpp_f<0xB1>(y1); y0 += dpp_f<0x4E>(y0); y1 += dpp_f<0x4E>(y1); y0 += dpp_f<0x141>(y0); y1 += dpp_f<0x141>(y1); \
    const bool mine = (kl == ((s_) & 7)); \
    if ((s_) < 8) { ya.x = mine ? y0 : ya.x; ya.y = mine ? y1 : ya.y; } else { yb.x = mine ? y0 : yb.x; yb.y = mine ? y1 : yb.y; } } while (0)
  for (int ch = 0; ch < nch; ++ch) {
    const int cur = ch & 1;
    if (ch + 1 < nch) SCAN_GLOAD(ch + 1);
    const float* b = st + cur * 6144;
    const float* vsrc = st + voff + cur * vbuf;
    f32x2 ya = {0.f, 0.f}, yb = {0.f, 0.f};
#pragma unroll 2
    for (int s = 0; s < 8; ++s) SCAN_STEP(s);
#pragma unroll 2
    for (int s = 8; s < 16; ++s) SCAN_STEP(s);
    *(f32x2*)(yout + (size_t)(ch * 16 + kl) * PROJF) = ya;
    *(f32x2*)(yout + (size_t)(ch * 16 + 8 + kl) * PROJF) = yb;
    if (ch + 1 < nch) SCAN_LSTORE(cur ^ 1);
    __syncthreads();
  }
#pragma unroll
  for (int j = 0; j < 2; ++j) {
    float* zp = ZP + ((size_t)((seg * 4 + head) * 128 + R0 + j)) * 64 + kl * 8;
    if (j == 0) { *(float4*)(zp) = make_float4(S0[0].x, S0[0].y, S0[1].x, S0[1].y); *(float4*)(zp + 4) = make_float4(S0[2].x, S0[2].y, S0[3].x, S0[3].y); }
    else { *(float4*)(zp) = make_float4(S1[0].x, S1[0].y, S1[1].x, S1[1].y); *(float4*)(zp + 4) = make_float4(S1[2].x, S1[2].y, S1[3].x, S1[3].y); }
  }
}

__device__ void rwkv_combine(const Params& p, unsigned char* dsm_) {
  float* ring = (float*)dsm_;
  float* ZP = (float*)(p.ws + OFF_ZP);
  const int tid = opaque_tid512(); const int lane = tid & 63;
  const int rowi = blockIdx.x * 8 + (tid >> 6);
  const int head = rowi >> 6, v = rowi & 63;
  float4 a0A, b0A, a1A, b1A, a0B, b0B, a1B, b1B, a0C, b0C, a1C, b1C, a0D, b0D, a1D, b1D;
  float z0A, z1A, z0B, z1B, z0C, z1C, z0D, z1D;
#define COMB_LOAD(X, stg_) do { \
      const float* base0 = ZP + (size_t)((((stg_) * 2 + 0) * 4 + head) * 128) * 64; \
      const float* base1 = ZP + (size_t)((((stg_) * 2 + 1) * 4 + head) * 128) * 64; \
      a0##X = ((const float4*)(base0 + 4096))[tid]; b0##X = ((const float4*)(base0 + 4096))[tid + 512]; z0##X = base0[v * 64 + lane]; \
      a1##X = ((const float4*)(base1 + 4096))[tid]; b1##X = ((const float4*)(base1 + 4096))[tid + 512]; z1##X = base1[v * 64 + lane]; } while (0)
#define COMB_SEG(q, ZC) do { const int seg = stg * 2 + q; \
      ZP[((size_t)((seg * 4 + head) * 128 + v)) * 64 + lane] = s; \
      float ns0 = ZC, ns1 = 0.f; const float* P = buf + q * 4096 + lane; \
      _Pragma("unroll") for (int i = 0; i < 64; i += 2) { \
        float s0 = __builtin_bit_cast(float, __builtin_amdgcn_readlane(__builtin_bit_cast(int, s), i)); \
        float s1 = __builtin_bit_cast(float, __builtin_amdgcn_readlane(__builtin_bit_cast(int, s), i + 1)); \
        ns0 += s0 * P[i * 64]; ns1 += s1 * P[(i + 1) * 64]; } \
      s = ns0 + ns1; } while (0)
#define COMB_STAGE(X, bi) do { \
      float* buf = ring + (bi) * 8192; \
      ((float4*)(buf))[tid] = a0##X; ((float4*)(buf))[tid + 512] = b0##X; \
      ((float4*)(buf + 4096))[tid] = a1##X; ((float4*)(buf + 4096))[tid + 512] = b1##X; \
      const float c0 = z0##X, c1 = z1##X; \
      { const int nstg = (stg + 4 < NSEG / 2) ? stg + 4 : stg; COMB_LOAD(X, nstg); } \
      __syncthreads(); \
      COMB_SEG(0, c0); COMB_SEG(1, c1); ++stg; } while (0)
  COMB_LOAD(A, 0); COMB_LOAD(B, 1); COMB_LOAD(C, 2); COMB_LOAD(D, 3);
  float s = 0.f;
  int stg = 0;
#pragma unroll 1
  for (int it4 = 0; it4 < NSEG / 8; ++it4) {
    COMB_STAGE(A, 0); COMB_STAGE(B, 1); COMB_STAGE(C, 2); COMB_STAGE(D, 3);
  }
  __syncthreads();
#undef COMB_LOAD
#undef COMB_SEG
#undef COMB_STAGE
}

__device__ __forceinline__ bf16x8 pack8(const float4 a, const float4 b) {
  uint4 u = make_uint4(pack2(a.x, a.y), pack2(a.z, a.w), pack2(b.x, b.y), pack2(b.z, b.w));
  return __builtin_bit_cast(bf16x8, u);
}
__device__ void rwkv_final_item(const Params& p, int l, int item, unsigned char* smem) {
  l = opq(l); item = opq(item);
  const int tid = opaque_tid(), w = tid >> 6, lane = tid & 63, l31 = lane & 31, hf = lane >> 5;
  const int parts = SL / 128;
  const int q = item % parts, head = (item / parts) & 3, seg = item / (parts * 4);
  const int t = seg * SL + q * 128 + w * 32 + l31;
  const float* ZP = (const float*)(p.ws + OFF_ZP);
  const float* PF = (const float*)(p.ws + OFF_PROJ);
  const u16* PROJ = (const u16*)(p.ws + OFF_PROJ);
  const u16* RBv = (const u16*)(p.ws + OFF_RWB) + (size_t)2 * T_ * 256;
  const float* BON = (const float*)(p.ws + OFF_BONUS);
  u16* MIX = (u16*)(p.ws + OFF_MIX);
  f32x16 acc0, acc1;
#pragma unroll
  for (int r = 0; r < 16; ++r) { acc0[r] = 0.f; acc1[r] = 0.f; }
  const float* y0p = PF + (size_t)t * PROJF + head * 64 + 4 * hf;
  const int cb = head * 64 + 4 * hf;
  float4 yA[4], yB[4];
  uint2 vvl[8], ggl[8];
#pragma unroll
  for (int g = 0; g < 4; ++g) { yA[g] = *(const float4*)(y0p + 8 * g); yB[g] = *(const float4*)(y0p + 32 + 8 * g); }
#pragma unroll
  for (int q8 = 0; q8 < 8; ++q8) {
    const int c = cb + (q8 >> 2) * 32 + 8 * (q8 & 3);
    vvl[q8] = *(const uint2*)(RBv + (size_t)t * 256 + c);
    ggl[q8] = *(const uint2*)(PROJ + (size_t)t * NALL + 2048 + c);
  }
  const float bon = BON[t * 4 + head];
  {
    const float* sp = ZP + ((size_t)((seg * 4 + head) * 128 + l31)) * 64 + 8 * hf;
    const float* rp = PF + (size_t)t * PROJF + 256 + head * 64 + 8 * hf;
#pragma unroll
    for (int ks = 0; ks < 4; ++ks) {
      const bf16x8 bfrag = pack8(*(const float4*)(rp + 16 * ks), *(const float4*)(rp + 16 * ks + 4));
      const bf16x8 a0 = pack8(*(const float4*)(sp + 16 * ks), *(const float4*)(sp + 16 * ks + 4));
      const bf16x8 a1 = pack8(*(const float4*)(sp + 32 * 64 + 16 * ks), *(const float4*)(sp + 32 * 64 + 16 * ks + 4));
      acc0 = __builtin_amdgcn_mfma_f32_32x32x16_bf16(a0, bfrag, acc0, 0, 0, 0);
      acc1 = __builtin_amdgcn_mfma_f32_32x32x16_bf16(a1, bfrag, acc1, 0, 0, 0);
    }
  }
  float sum = 0.f;
#pragma unroll
  for (int g = 0; g < 4; ++g) {
    const float4 ya = yA[g], yb = yB[g];
    acc0[4 * g + 0] += ya.x; acc0[4 * g + 1] += ya.y; acc0[4 * g + 2] += ya.z; acc0[4 * g + 3] += ya.w;
    acc1[4 * g + 0] += yb.x; acc1[4 * g + 1] += yb.y; acc1[4 * g + 2] += yb.z; acc1[4 * g + 3] += yb.w;
  }
#pragma unroll
  for (int r = 0; r < 16; ++r) sum += acc0[r] + acc1[r];
  sum += __shfl_xor(sum, 32);
  const float mean = sum * (1.f / 64.f);
  float var = 0.f;
#pragma unroll
  for (int r = 0; r < 16; ++r) { const float d0 = acc0[r] - mean, d1 = acc1[r] - mean; var += d0 * d0 + d1 * d1; }
  var += __shfl_xor(var, 32);
  const float rstd = rsqrtf(var * (1.f / 64.f) + 64e-5f);
#pragma unroll
  for (int mt = 0; mt < 2; ++mt)
#pragma unroll
    for (int g = 0; g < 4; ++g) {
      const int c = cb + mt * 32 + 8 * g;
      const float4 lw = *(const float4*)(p.ln_w + l * 256 + c), lb = *(const float4*)(p.ln_b + l * 256 + c);
      const uint2 vv = vvl[mt * 4 + g];
      const uint2 gg = ggl[mt * 4 + g];
      float o0 = (mt ? acc1[4 * g + 0] : acc0[4 * g + 0]), o1 = (mt ? acc1[4 * g + 1] : acc0[4 * g + 1]);
      float o2 = (mt ? acc1[4 * g + 2] : acc0[4 * g + 2]), o3 = (mt ? acc1[4 * g + 3] : acc0[4 * g + 3]);
      o0 = (o0 - mean) * rstd * lw.x + lb.x + bon * bflo(vv.x);
      o1 = (o1 - mean) * rstd * lw.y + lb.y + bon * bfhi(vv.x);
      o2 = (o2 - mean) * rstd * lw.z + lb.z + bon * bflo(vv.y);
      o3 = (o3 - mean) * rstd * lw.w + lb.w + bon * bfhi(vv.y);
      o0 *= silu(bflo(gg.x)); o1 *= silu(bfhi(gg.x)); o2 *= silu(bflo(gg.y)); o3 *= silu(bfhi(gg.y));
      *(uint2*)(MIX + (size_t)t * 1024 + 512 + c) = make_uint2(pack2(o0, o1), pack2(o2, o3));
    }
}

#define LDS_BYTES (131072 + 16)
#ifndef REP_G1
#define REP_G1 1
#endif
#ifndef REP_G2
#define REP_G2 1
#endif
#ifndef REP_P3
#define REP_P3 1
#endif
#ifndef REP_SCAN
#define REP_SCAN 1
#endif
#ifndef REP_GO
#define REP_GO 1
#endif
#ifndef REP_FIN
#define REP_FIN 1
#endif
#define PAIR_LOOP(N, BODY) for (int _pr = blockIdx.x; _pr < (N) / 2; _pr += gridDim.x) { const int it = 2 * _pr + vb; BODY }
__global__ void __launch_bounds__(512) fwd_megakernel(Params p) {
  cg::grid_group grid = cg::this_grid();
  extern __shared__ __attribute__((aligned(16))) unsigned char dsm[];
  const int vb = __builtin_amdgcn_readfirstlane(threadIdx.x >> 8);
  unsigned char* smem = dsm + vb * 65536;
  if (threadIdx.x == 0) *(uint4*)(dsm + 131072) = make_uint4(0u, 0u, 0u, 0u);
  __syncthreads();
  const XcdBarrier xb = xcd_barrier_post((unsigned*)(p.ws + OFF_BAR), (volatile LAS unsigned*)(dsm + 131072));
#define GSYNC() xcd_barrier(xb)
#ifndef PH
#define PH 0xffff
#endif
  if (PH & 1) PAIR_LOOP(384, phase_mod_item(p, it, smem);)
  if (PH & 2) PAIR_LOOP(4480, phase_wconv_item(p, it, smem);)
  if (PH & 2) PAIR_LOOP(8, phase_w2t_item(p, it);)
  grid.sync();
  if (PH & 4) phase_h0(p);
  GSYNC();
#pragma unroll 1
  for (int hl = 0; hl < 8; ++hl) {
    const int l = hl >> 1;
    const bool second = hl & 1;
    if (PH & 8) {
      pg8::Gemm g; g.M = T_; g.K = 1024;
      pg8::EpiU E; E.O = (void*)(p.ws + OFF_PROJ);
      if (!second) { g.A = (const u16*)(p.ws + OFF_H); g.Bt = (const u16*)(p.ws + OFF_WALL) + (size_t)l * NALL * 1024; g.N = 3584; E.ldc = NALL; E.ncols = NALL; E.f32out = 0; }
      else { g.A = (const u16*)(p.ws + OFF_MIX); g.Bt = (const u16*)(p.ws + OFF_WOUT) + (size_t)l * 1024 * 1024; g.N = 1024; E.ldc = 1024; E.ncols = 1024; E.f32out = 0; }
      pg8::StaticOrder S; S.init(T_, g.N, gridDim.x, blockIdx.x);
      const int nrep = second ? REP_G2 : REP_G1;
#pragma unroll 1
      for (int rep = 0; rep < nrep; ++rep)
      pg8::gemm_phase<pg8::EpiU, pg8::StaticOrder, false>((PG8_LAS unsigned char*)dsm, g, S, E, nullptr);
    }
    GSYNC();
    if (!second) {
#pragma unroll 1
      for (int rep = 0; rep < REP_P3; ++rep)
      PAIR_LOOP(3072,
        if (it < 1024) { if (PH & 16) attn_item(p, l, it, smem); }
        else if (it < 2048) { if (PH & 32) rwkv_prep_item(p, l, it - 1024, smem); }
        else { if (PH & 64) gla_local_item(p, l, it - 2048, smem); }
      )
      GSYNC();
      {
        GLA_STATE_LOAD(blockIdx.x)
#pragma unroll 1
        for (int rep = 0; rep < REP_SCAN; ++rep)
        if (PH & 256) rwkv_scan_item(p, blockIdx.x, dsm);
        __syncthreads();
        if (PH & 128) GLA_STATE_FINISH(dsm)
      }
      GSYNC();
      if (blockIdx.x < 32) { if (PH & 512) rwkv_combine(p, dsm); }
#pragma unroll 1
      for (int rep = 0; rep < REP_GO; ++rep)
      if (PH & 1024) {
        unsigned* ctr = (unsigned*)(p.ws + OFF_BAR) + 32 + l;
        volatile unsigned* slot = (volatile unsigned*)(dsm + 131072) + 2;
        for (;;) {
          if (threadIdx.x == 0) *slot = atomicAdd(ctr, 1u);
          __syncthreads();
          const unsigned pr = (unsigned)__builtin_amdgcn_readfirstlane((int)*slot);
          __syncthreads();
          if (pr >= 512u) break;
          gla_out_item(p, l, 2 * (int)pr + vb, smem);
        }
      }
      GSYNC();
#pragma unroll 1
      for (int rep = 0; rep < REP_FIN; ++rep)
      if (PH & 2048) PAIR_LOOP(NSEG * 4 * (SL / 128), rwkv_final_item(p, l, it, smem);)
      GSYNC();
    } else {
      if (PH & 8192) phase_post(p, l);
      if (hl < 7) GSYNC();
    }
  }
}

extern "C" void kernel_launch(void* const* d_in, const int* in_sizes, int n_in, void* d_out, int out_size, void* d_ws, size_t ws_size,
                              hipStream_t stream) {
  static int grid_blocks = 0;
  if (!grid_blocks) {
    int dev = 0, cus = 0, per_cu = 0;
    (void)hipGetDevice(&dev);
    (void)hipDeviceGetAttribute(&cus, hipDeviceAttributeMultiprocessorCount, dev);
    (void)hipFuncSetAttribute((const void*)fwd_megakernel, hipFuncAttributeMaxDynamicSharedMemorySize, LDS_BYTES);
    (void)hipOccupancyMaxActiveBlocksPerMultiprocessor(&per_cu, fwd_megakernel, 512, LDS_BYTES);
    if (per_cu < 1) per_cu = 1;
    grid_blocks = cus;
    if (grid_blocks != 256) { fprintf(stderr, "kernel_launch: built for a 256-CU device (got %d)\n", cus); grid_blocks = -1; }
  }
  if (grid_blocks < 0) return;
  if (n_in != 27 || ws_size < WS_END) {
    fprintf(stderr, "kernel_launch: unexpected n_in %d / ws %zu\n", n_in, ws_size);
    return;
  }
  Params p{};
  const float** pp = (const float**)&p;
  for (int i = 0; i < 27; ++i) pp[i] = (const float*)d_in[i];
  p.out = (float*)d_out;
  p.ws = (unsigned char*)d_ws;
  (void)hipMemsetAsync((unsigned char*)d_ws + OFF_BAR, 0, XCD_BAR_WORDS * 4, stream);
  void* args[] = {&p};
  hipError_t e = hipLaunchCooperativeKernel((void*)fwd_megakernel, dim3(grid_blocks), dim3(512), args, LDS_BYTES, stream);
  if (e != hipSuccess) fprintf(stderr, "cooperative launch failed: %s (grid %d)\n", hipGetErrorString(e), grid_blocks);
}
```

```cpp
#include <hip/hip_runtime.h>
#include <hip/hip_bf16.h>
#include <hip/hip_cooperative_groups.h>
#include <cstdio>
namespace cg = cooperative_groups;

typedef unsigned short u16;
using bf16x8 = __attribute__((ext_vector_type(8))) short;
using f32x4 = __attribute__((ext_vector_type(4))) float;
using f32x16 = __attribute__((ext_vector_type(16))) float;

#define T_ 16384
#define NALL 3456
#define NSEG 64
#define SL (T_ / NSEG)
#define PROJF 1728

#define OFF_WALL 0ull
#define OFF_WOUT 28311552ull
#define OFF_MOD 36700160ull
#define OFF_H 36749312ull
#define OFF_RWW OFF_H
#define OFF_RWKK (OFF_H + 16777216ull)
#define OFF_PROJ 70303744ull
#define OFF_MIX 183549952ull
#define OFF_RWB 217104384ull
#define OFF_GLAS 250658816ull
#define OFF_GLAD 259047424ull
#define OFF_BONUS 259178496ull
#define OFF_ZP 259440640ull
#define OFF_BAR 267829248ull
#define OFF_W2T 267845632ull
#define OFF_A2T 267976704ull
#define WS_END 268107776ull


struct Params {
  const float *x, *c, *ada_w, *ada_b, *norm_pre, *norm_post, *w_in, *w_out, *sinks, *mu_rkv, *mu_w, *mu_a, *w0, *w1, *w2,
      *a0, *a1, *a2, *k_k, *k_a, *r_k, *ln_w, *ln_b, *gk1, *gk2, *gk_b, *gla_nw;
  float* out;
  unsigned char* ws;
};

__device__ __forceinline__ u16 f2bf(float f) {
  unsigned u = __float_as_uint(f);
  u += 0x7fffu + ((u >> 16) & 1u);
  return (u16)(u >> 16);
}
__device__ __forceinline__ float bf2f(u16 h) { return __uint_as_float(((unsigned)h) << 16); }
__device__ __forceinline__ unsigned pack2(float a, float b) { return (unsigned)f2bf(a) | ((unsigned)f2bf(b) << 16); }
__device__ __forceinline__ float bflo(unsigned u) { return __uint_as_float(u << 16); }
__device__ __forceinline__ float bfhi(unsigned u) { return __uint_as_float(u & 0xffff0000u); }

__device__ __forceinline__ float frcp(float x) { return __builtin_amdgcn_rcpf(x); }
__device__ __forceinline__ float silu(float x) { return x * frcp(1.f + __expf(-x)); }
__device__ __forceinline__ float sigmoidf_(float x) { return frcp(1.f + __expf(-x)); }
__device__ __forceinline__ float softplusf_(float z) { return fmaxf(z, 0.f) + __logf(1.f + __expf(-fabsf(z))); }
__device__ __forceinline__ float tanh_fast(float x) { return 1.f - 2.f * frcp(1.f + __expf(2.f * x)); }

__device__ __forceinline__ int opq(int x) { asm volatile("" : "+s"(x)); return x; }
__device__ __forceinline__ int opaque_tid() { int t = threadIdx.x & 255; asm volatile("" : "+v"(t)); return t; }
__device__ __forceinline__ int opaque_tid512() { int t = threadIdx.x; asm volatile("" : "+v"(t)); return t; }
template <int CTRL>
__device__ __forceinline__ float dpp_f(float x) {
  return __builtin_bit_cast(float, __builtin_amdgcn_update_dpp(0, __builtin_bit_cast(int, x), CTRL, 0xf, 0xf, true));
}
__device__ __forceinline__ float row16_allsum(float x) {
  x += dpp_f<0x128>(x);
  x += dpp_f<0x124>(x);
  x += dpp_f<0x122>(x);
  x += dpp_f<0x121>(x);
  return x;
}
__device__ __forceinline__ float wave_sum(float v) {
  v = row16_allsum(v);
  const int iv = __builtin_bit_cast(int, v);
  const float a = __builtin_bit_cast(float, __builtin_amdgcn_readlane(iv, 0)), b = __builtin_bit_cast(float, __builtin_amdgcn_readlane(iv, 16));
  const float c = __builtin_bit_cast(float, __builtin_amdgcn_readlane(iv, 32)), d = __builtin_bit_cast(float, __builtin_amdgcn_readlane(iv, 48));
  return (a + b) + (c + d);
}

namespace pg8 {
#define PG8_LAS __attribute__((address_space(3)))
typedef unsigned short bf16_t;
typedef short bf16x8 __attribute__((ext_vector_type(8)));
typedef float f32x4 __attribute__((ext_vector_type(4)));
typedef unsigned u32x4 __attribute__((ext_vector_type(4)));
constexpr int BM = 256, BK = 64, HALF = 128, HTB = HALF * BK * 2  , STAGE_BYTES = 8 * HTB, NXCD = 8, WGM = 8;

__host__ __device__ __forceinline__ int lds_byte(int r, int c) { const int st = (r >> 4) * 2 + (c >> 5), rr = r & 15, cc = c & 31, ob = rr * 64 + cc * 2; return st * 1024 + (ob ^ (((ob >> 9) & 1) << 5)); }
__host__ __device__ __forceinline__ void stage_rc(int b, int& R, int& C) { const int st = b / 1024, sb = b % 1024, swz = sb ^ (((sb >> 9) & 1) << 5); R = (st >> 1) * 16 + swz / 64; C = (st & 1) * 32 + (swz % 64) / 2; }
__host__ __device__ __forceinline__ int perm32(int rho) { const int n = rho >> 4, i = rho & 15; return 8 * (i >> 2) + 4 * n + (i & 3); }

struct Unit { int pm, pn; };
struct Gemm { const bf16_t* A; const bf16_t* Bt; int M, N, K; };

struct StaticOrder {
    int nM, nN, nwg, G, c;
    __host__ __device__ void init(int M, int N, int G_, int c_) { nM = M / BM; nN = N / BM; nwg = nM * nN; G = G_; c = c_; }
    __host__ __device__ bool next(int i, Unit& u) const {
        const long L = (long)i * G + c; if (L >= nwg) return false;
        int wgid = (int)L; { const int q = nwg / NXCD, r = nwg % NXCD, xcd = wgid % NXCD, off = wgid / NXCD; wgid = (xcd < r ? xcd * (q + 1) : r * (q + 1) + (xcd - r) * q) + off; }
        const int nig = WGM * nN, gid = wgid / nig, fm = gid * WGM, gsz = (nM - fm) < WGM ? (nM - fm) : WGM;
        u.pm = fm + ((wgid % nig) % gsz); u.pn = (wgid % nig) / gsz; return true;
    }
    __device__ __forceinline__ void a_ready(const Unit&) const {}
    __device__ __forceinline__ void done(const Unit&) const {}
};
__device__ __forceinline__ unsigned cvt_pk_bf16(float lo, float hi) { unsigned r; asm volatile("v_cvt_pk_bf16_f32 %0, %1, %2" : "=v"(r) : "v"(lo), "v"(hi)); return r; }
template <class Epi, class Sched, bool STAMP = false>
__device__ __forceinline__ void gemm_phase(PG8_LAS unsigned char* lds, const Gemm g, const Sched& S, const Epi& E, unsigned long long* stamps) {
    const int tid = threadIdx.x, wid = __builtin_amdgcn_readfirstlane(tid >> 6), lane = tid & 63, wr = wid >> 2, wc = wid & 3, fr = lane & 15, fq = lane >> 4;
    const int K = g.K, nt = K / BK;
    int ts_lo = 0, ts_hi = 0, nts = 0; const unsigned long long rt_entry = STAMP ? (unsigned long long)wall_clock64() : 0ull;
#define PG8_STAMP() do { if (STAMP && wid == 0 && nts < 64) { const unsigned long long _c = (unsigned long long)clock64(); \
        ts_lo = (lane == nts) ? (int)(unsigned)_c : ts_lo; ts_hi = (lane == nts) ? (int)(unsigned)(_c >> 32) : ts_hi; ++nts; } } while (0)
    PG8_STAMP();
    unsigned voffA[2], voffB[2];
#pragma unroll
    for (int i = 0; i < 2; ++i) { int R, C; stage_rc(tid * 16 + i * 8192, R, C); const int Rb = Epi::PERM ? ((R & ~31) + perm32(R & 31)) : R;
        voffA[i] = (unsigned)(R * K + C) * 2u; voffB[i] = (unsigned)(Rb * K + C) * 2u; }
    const size_t kstep = (size_t)(BK * 2);
    const size_t hstep = (size_t)HALF * K * 2;
    const size_t tstep = 2 * hstep;
    const unsigned ldsw = (unsigned)wid * 1024u;
    const int aoff = lds_byte(wr * 64 + fr, fq * 8), boff = lds_byte(wc * 32 + fr, fq * 8);
#define PG8_SA(b, h) (((b) * 2 + (h)) * HTB)
#define PG8_SB(b, h) ((4 + (b) * 2 + (h)) * HTB)
#define PG8_STAGE(bufoff, gbase, voff) do { _Pragma("unroll") for (int _i = 0; _i < 2; ++_i) \
        __builtin_amdgcn_global_load_lds((const unsigned*)((const char*)(gbase) + (voff)[_i]), (PG8_LAS unsigned*)(lds + (bufoff) + ldsw + _i * 8192), 16, 0, 0); } while (0)
#define PG8_LDA(dst, b, h) do { _Pragma("unroll") for (int m = 0; m < 4; ++m) _Pragma("unroll") for (int k = 0; k < 2; ++k) dst[m][k] = *(const PG8_LAS bf16x8*)(lds + PG8_SA(b, h) + aoff + m * 2048 + k * 1024); } while (0)
#define PG8_LDB(dst, b, h) do { _Pragma("unroll") for (int n = 0; n < 2; ++n) _Pragma("unroll") for (int k = 0; k < 2; ++k) dst[n][k] = *(const PG8_LAS bf16x8*)(lds + PG8_SB(b, h) + boff + n * 2048 + k * 1024); } while (0)
#define PG8_MMA(ai, bj, At, Bt) do { __builtin_amdgcn_s_setprio(1); _Pragma("unroll") for (int m = 0; m < 4; ++m) _Pragma("unroll") for (int n = 0; n < 2; ++n) _Pragma("unroll") for (int k = 0; k < 2; ++k) \
        acc[ai][bj][m][n] = __builtin_amdgcn_mfma_f32_16x16x32_bf16(Bt[n][k], At[m][k], acc[ai][bj][m][n], 0, 0, 0); __builtin_amdgcn_s_setprio(0); } while (0)
#define PG8_WAIT_V(n) asm volatile("s_waitcnt vmcnt(" #n ")" ::: "memory")
#define PG8_WAIT_L(n) asm volatile("s_waitcnt lgkmcnt(" #n ")" ::: "memory")
#define PG8_BAR __builtin_amdgcn_s_barrier()
#define PG8_SCHED __builtin_amdgcn_sched_barrier(0)
    Unit cur, nxt; int ui = 0;
    if (!S.next(0, cur)) return;
    f32x4 acc[2][2][4][2];
#pragma unroll
    for (int a = 0; a < 2; ++a)
#pragma unroll
        for (int b = 0; b < 2; ++b)
#pragma unroll
            for (int m = 0; m < 4; ++m)
#pragma unroll
                for (int n = 0; n < 2; ++n) acc[a][b][m][n] = (f32x4){0.f, 0.f, 0.f, 0.f};
    bf16x8 At[4][2], B0[2][2], B1[2][2];
    const char* cA = (const char*)g.A + (size_t)cur.pm * tstep; const char* cB = (const char*)g.Bt + (size_t)cur.pn * tstep;
    S.a_ready(cur);
    PG8_STAGE(PG8_SB(0, 0), cB, voffB); PG8_STAGE(PG8_SA(0, 0), cA, voffA); PG8_STAGE(PG8_SB(0, 1), cB + hstep, voffB); PG8_STAGE(PG8_SA(0, 1), cA + hstep, voffA);
    if (wr == 1) PG8_BAR;
    PG8_WAIT_V(4); PG8_BAR;
    PG8_STAGE(PG8_SB(1, 0), cB + kstep, voffB); PG8_STAGE(PG8_SA(1, 0), cA + kstep, voffA); PG8_STAGE(PG8_SB(1, 1), cB + hstep + kstep, voffB);
    PG8_WAIT_V(6); PG8_BAR;
    PG8_STAMP();
    for (;;) {
        const bool has_next = S.next(ui + 1, nxt);
        const char* nA = has_next ? (const char*)g.A + (size_t)nxt.pm * tstep : cA; const char* nB = has_next ? (const char*)g.Bt + (size_t)nxt.pn * tstep : cB;
        for (int t = 0; t < nt; t += 2) {
            const bool last = (t == nt - 2);
            const char* a1 = cA + (size_t)(t + 1) * kstep;
            const char* a2 = last ? nA : cA + (size_t)(t + 2) * kstep; const char* b2 = last ? nB : cB + (size_t)(t + 2) * kstep;
            const char* a3 = a2 + kstep; const char* b3 = b2 + kstep;
            if (last && has_next) S.a_ready(nxt);
            PG8_LDB(B0, 0, 0); PG8_SCHED; PG8_LDA(At, 0, 0); PG8_STAGE(PG8_SA(1, 1), a1 + hstep, voffA);
            PG8_WAIT_L(8); PG8_BAR; PG8_WAIT_L(0); PG8_MMA(0, 0, At, B0); PG8_BAR; PG8_SCHED;
            PG8_LDB(B1, 0, 1); PG8_STAGE(PG8_SB(0, 0), b2, voffB);
            PG8_BAR; PG8_WAIT_L(0); PG8_MMA(0, 1, At, B1); PG8_BAR;
            PG8_LDA(At, 0, 1); PG8_STAGE(PG8_SA(0, 0), a2, voffA);
            PG8_BAR; PG8_WAIT_L(0); PG8_MMA(1, 0, At, B0); PG8_BAR; PG8_SCHED;
            PG8_STAGE(PG8_SB(0, 1), b2 + hstep, voffB);
            PG8_WAIT_V(6); PG8_BAR; PG8_MMA(1, 1, At, B1); PG8_BAR;
            PG8_LDB(B0, 1, 0); PG8_SCHED; PG8_LDA(At, 1, 0); PG8_STAGE(PG8_SA(0, 1), a2 + hstep, voffA);
            PG8_WAIT_L(8); PG8_BAR; PG8_WAIT_L(0); PG8_MMA(0, 0, At, B0); PG8_BAR; PG8_SCHED;
            PG8_LDB(B1, 1, 1); PG8_STAGE(PG8_SB(1, 0), b3, voffB);
            PG8_BAR; PG8_WAIT_L(0); PG8_MMA(0, 1, At, B1); PG8_BAR;
            PG8_LDA(At, 1, 1); PG8_STAGE(PG8_SA(1, 0), a3, voffA);
            PG8_BAR; PG8_WAIT_L(0); PG8_MMA(1, 0, At, B0); PG8_BAR; PG8_SCHED;
            PG8_STAGE(PG8_SB(1, 1), b3 + hstep, voffB);
            PG8_WAIT_V(6); PG8_BAR; PG8_MMA(1, 1, At, B1); PG8_BAR;
        }
        PG8_STAMP();
        if constexpr (!Epi::AFTER_DRAIN) { E(acc, cur, wr, wc, fr, fq); S.done(cur); }
        PG8_STAMP();
        if (!has_next) break;
#pragma unroll
        for (int a = 0; a < 2; ++a)
#pragma unroll
            for (int b = 0; b < 2; ++b)
#pragma unroll
                for (int m = 0; m < 4; ++m)
#pragma unroll
                    for (int n = 0; n < 2; ++n) acc[a][b][m][n] = (f32x4){0.f, 0.f, 0.f, 0.f};
        cur = nxt; cA = nA; cB = nB; ++ui;
    }
    PG8_WAIT_V(0);
    if (wr == 0) PG8_BAR;
    PG8_BAR;
    if constexpr (Epi::AFTER_DRAIN) { E.fused(acc, cur, wr, wc, fr, fq, lds, wid, lane); S.done(cur); }
    PG8_STAMP();
    if (STAMP && wid == 0) { stamps[lane] = lane < nts ? (((unsigned long long)(unsigned)ts_hi << 32) | (unsigned)ts_lo) : 0ull;
        if (lane == 62) stamps[62] = rt_entry; if (lane == 63) stamps[63] = (unsigned long long)wall_clock64(); }
#undef PG8_STAMP
#undef PG8_SA
#undef PG8_SB
#undef PG8_STAGE
#undef PG8_LDA
#undef PG8_LDB
#undef PG8_MMA
#undef PG8_WAIT_V
#undef PG8_WAIT_L
#undef PG8_BAR
#undef PG8_SCHED
}
}

namespace pg8 {
struct EpiProj {
    static constexpr bool PERM = true, AFTER_DRAIN = false;
    bf16_t* O; int ldc; int ncols;
    __device__ __forceinline__ void operator()(const f32x4 (&acc)[2][2][4][2], const Unit& u, int wr, int wc, int fr, int fq) const {
        const int row0 = u.pm * BM + wr * 64 + fr; const int col0 = u.pn * BM + wc * 32 + 8 * fq;
#pragma unroll
        for (int ai = 0; ai < 2; ++ai)
#pragma unroll
            for (int m = 0; m < 4; ++m) { bf16_t* rowp = O + (size_t)(row0 + ai * HALF + m * 16) * ldc + col0;
#pragma unroll
                for (int bj = 0; bj < 2; ++bj) { const f32x4 v0 = acc[ai][bj][m][0], v1 = acc[ai][bj][m][1];
                    u32x4 w; w.x = cvt_pk_bf16(v0[0], v0[1]); w.y = cvt_pk_bf16(v0[2], v0[3]); w.z = cvt_pk_bf16(v1[0], v1[1]); w.w = cvt_pk_bf16(v1[2], v1[3]);
                    if (col0 + bj * HALF < ncols) *(u32x4*)(rowp + bj * HALF) = w; } }
    }
};
struct EpiU {
    static constexpr bool PERM = true, AFTER_DRAIN = false;
    void* O; int ldc; int ncols; int f32out;
    __device__ __forceinline__ void operator()(const f32x4 (&acc)[2][2][4][2], const Unit& u, int wr, int wc, int fr, int fq) const {
        const int row0 = u.pm * BM + wr * 64 + fr; const int col0 = u.pn * BM + wc * 32 + 8 * fq;
        if (f32out) {
#pragma unroll
            for (int ai = 0; ai < 2; ++ai)
#pragma unroll
                for (int m = 0; m < 4; ++m) { float* rowp = (float*)O + (size_t)(row0 + ai * HALF + m * 16) * ldc + col0;
#pragma unroll
                    for (int bj = 0; bj < 2; ++bj) { *(f32x4*)(rowp + bj * HALF) = acc[ai][bj][m][0]; *(f32x4*)(rowp + bj * HALF + 4) = acc[ai][bj][m][1]; } }
        } else {
#pragma unroll
            for (int ai = 0; ai < 2; ++ai)
#pragma unroll
                for (int m = 0; m < 4; ++m) { bf16_t* rowp = (bf16_t*)O + (size_t)(row0 + ai * HALF + m * 16) * ldc + col0;
#pragma unroll
                    for (int bj = 0; bj < 2; ++bj) { const f32x4 v0 = acc[ai][bj][m][0], v1 = acc[ai][bj][m][1];
                        u32x4 w; w.x = cvt_pk_bf16(v0[0], v0[1]); w.y = cvt_pk_bf16(v0[2], v0[3]); w.z = cvt_pk_bf16(v1[0], v1[1]); w.w = cvt_pk_bf16(v1[2], v1[3]);
                        if (col0 + bj * HALF < ncols) *(u32x4*)(rowp + bj * HALF) = w; } }
        }
    }
};
}

#define XB_TMO      128
#define XB_XCNT(j)  (256  + 64 * (j))
#define XB_XSUB(j)  (1280 + 64 * (j))
#define XB_XGEN(j)  (2304 + 64 * (j))
#define XB_TOP      3328
#define XB_TOPGEN   3392
#define XCD_BAR_WORDS 3456
#define XB_SPIN_CAP (1u << 18)
#define LAS __attribute__((address_space(3)))

__device__ __forceinline__ unsigned xb_ld(unsigned* p)              { return __hip_atomic_load(p, __ATOMIC_RELAXED, __HIP_MEMORY_SCOPE_AGENT); }
__device__ __forceinline__ unsigned xb_add(unsigned* p, unsigned v) { return __hip_atomic_fetch_add(p, v, __ATOMIC_RELAXED, __HIP_MEMORY_SCOPE_AGENT); }
__device__ __forceinline__ unsigned xb_xcc_id() { return (unsigned)__builtin_amdgcn_s_getreg((3 << 11) | 20) & 0xFu; }
#define XB_SPIN(cond, bar) do { unsigned _sp = 0; while (cond) { __builtin_amdgcn_s_sleep(1); \
    if ((++_sp & 255u) == 0u) { if (xb_ld(&(bar)[XB_TMO])) break; if (_sp > XB_SPIN_CAP) { atomicAdd(&(bar)[XB_TMO], 1u); break; } } } } while (0)

struct XcdBarrier {
    unsigned* bar; unsigned x;
    volatile LAS unsigned* st;
};

__device__ __forceinline__ XcdBarrier xcd_barrier_post(unsigned* bar, volatile LAS unsigned* st) {
    XcdBarrier b; b.bar = bar; b.x = xb_xcc_id(); b.st = st;
    if (threadIdx.x == 0) (void)xb_add(&bar[XB_XCNT(b.x)], 1u);
    return b;
}
__device__ __forceinline__ void xcd_barrier_complete(unsigned* bar, unsigned x, unsigned& nloc, unsigned& nx) {
    const unsigned G = gridDim.x * gridDim.y * gridDim.z;
    unsigned sum, cnt, mine, sp = 0u;
    for (;;) {
        sum = 0u; cnt = 0u; mine = 0u;
#pragma unroll
        for (unsigned j = 0; j < 16; ++j) { const unsigned c = xb_ld(&bar[XB_XCNT(j)]); sum += c; cnt += (c > 0u) ? 1u : 0u; mine = (j == x) ? c : mine; }
        if (sum == G) break;
        __builtin_amdgcn_s_sleep(1);
        if ((++sp & 255u) == 0u) { if (xb_ld(&bar[XB_TMO])) break; if (sp > XB_SPIN_CAP) { atomicAdd(&bar[XB_TMO], 1u); break; } }
    }
    nloc = mine > 0u ? mine : 1u; nx = cnt > 0u ? cnt : 1u;
}

__device__ __forceinline__ void xcd_barrier(const XcdBarrier& b) {
    asm volatile("s_waitcnt vmcnt(0)" ::: "memory");
    __syncthreads();
    if (threadIdx.x == 0) {
        unsigned* bar = b.bar;
        __builtin_amdgcn_s_waitcnt(0);
        unsigned nloc = b.st[0], nx = b.st[1];
        if (nloc == 0u) { xcd_barrier_complete(bar, b.x, nloc, nx); b.st[0] = nloc; b.st[1] = nx; }
        const unsigned old = xb_add(&bar[XB_XSUB(b.x)], 1u);
        const unsigned gen = old / nloc;
        if (old + 1u == (gen + 1u) * nloc) {
            __builtin_amdgcn_fence(__ATOMIC_RELEASE, "agent");
            asm volatile("s_waitcnt vmcnt(0)" ::: "memory");
            const unsigned og = xb_add(&bar[XB_TOP], 1u);
            const unsigned tg = og / nx;
            if (og + 1u == (tg + 1u) * nx) xb_add(&bar[XB_TOPGEN], 1u);
            else XB_SPIN(xb_ld(&bar[XB_TOPGEN]) == tg, bar);
            __builtin_amdgcn_fence(__ATOMIC_ACQUIRE, "agent");
            xb_add(&bar[XB_XGEN(b.x)], 1u);
            asm volatile("s_waitcnt vmcnt(0)" ::: "memory");
        } else {
            XB_SPIN(xb_ld(&bar[XB_XGEN(b.x)]) == gen, bar);
            __builtin_amdgcn_fence(__ATOMIC_ACQUIRE, "agent");
            asm volatile("s_waitcnt vmcnt(0)" ::: "memory");
        }
    }
    __syncthreads();
}

__device__ void phase_mod_item(const Params& p, int it, unsigned char* smem) {
  float* red = (float*)smem;
  const int tid = opaque_tid(), tx = tid & 31, ty = tid >> 5;
  float* mod = (float*)(p.ws + OFF_MOD);
  it = opq(it);
  {
    int l = it / 96;
    int j = (it % 96) * 32 + tx;
    const float* W = p.ada_w + (size_t)l * 1024 * 3072;
    float* cs = red + 256;
#pragma unroll
    for (int i = 0; i < 4; ++i) cs[tid + 256 * i] = silu(p.c[tid + 256 * i]);
    __syncthreads();
    float acc = 0.f;
#pragma unroll 1
    for (int i0 = 0; i0 < 128; i0 += 16) {
      float wv[16];
#pragma unroll
      for (int i = 0; i < 16; ++i) wv[i] = W[(size_t)(ty * 128 + i0 + i) * 3072 + j];
#pragma unroll
      for (int i = 0; i < 16; ++i) acc += cs[ty * 128 + i0 + i] * wv[i];
    }
    red[ty * 32 + tx] = acc;
    __syncthreads();
    if (ty == 0) {
      float s = 0.f;
      for (int g = 0; g < 8; ++g) s += red[g * 32 + tx];
      mod[l * 3072 + j] = s + p.ada_b[l * 3072 + j];
    }
    __syncthreads();
  }
}

__device__ __forceinline__ float wall_src(const Params& p, int l, int k, int n) {
  size_t lk = (size_t)l * 1024 + k;
  if (n < 3072) return p.w_in[lk * 3072 + n];
  if (n < 3136) return (1.f - p.mu_w[lk]) * p.w1[lk * 64 + (n - 3072)];
  if (n < 3200) return p.mu_w[lk] * p.w1[lk * 64 + (n - 3136)];
  if (n < 3264) return (1.f - p.mu_a[lk]) * p.a1[lk * 64 + (n - 3200)];
  if (n < 3328) return p.mu_a[lk] * p.a1[lk * 64 + (n - 3264)];
  if (n < 3344) return p.gk1[lk * 16 + (n - 3328)];
  return 0.f;
}

__device__ void phase_wconv_item(const Params& p, int it, unsigned char* smem) {
  float* tile = (float*)smem;
  const int tid = opaque_tid();
  u16* WALL = (u16*)(p.ws + OFF_WALL);
  u16* WOUT = (u16*)(p.ws + OFF_WOUT);
  it = opq(it);
  {
    bool isout = it >= 3456;
    int l, nt, kt;
    if (!isout) { l = it / 864; int r = it % 864; nt = r >> 4; kt = r & 15; }
    else { int r = it - 3456; l = r >> 8; r &= 255; nt = r >> 4; kt = r & 15; }
    if (isout || nt < 48) {
      const float* src = isout ? p.w_out + (size_t)l * 1024 * 1024 : p.w_in + (size_t)l * 1024 * 3072;
      const int ld = isout ? 1024 : 3072;
      const int n4 = (tid & 15) * 4, k0 = tid >> 4;
      float4 v4[4];
#pragma unroll
      for (int i = 0; i < 4; ++i) v4[i] = *(const float4*)(src + (size_t)(kt * 64 + k0 + 16 * i) * ld + nt * 64 + n4);
#pragma unroll
      for (int i = 0; i < 4; ++i) {
        float* tp = tile + (k0 + 16 * i) * 65 + n4;
        tp[0] = v4[i].x; tp[1] = v4[i].y; tp[2] = v4[i].z; tp[3] = v4[i].w;
      }
    } else {
      int tx = tid & 63, ty = tid >> 6;
#pragma unroll
      for (int i = 0; i < 16; ++i) {
        int kl = ty + 4 * i;
        int k = kt * 64 + kl, n = nt * 64 + tx;
        tile[kl * 65 + tx] = wall_src(p, l, k, n);
      }
    }
    __syncthreads();
    int nl = tid >> 2, kq = tid & 3;
    unsigned w[8];
#pragma unroll
    for (int j = 0; j < 8; ++j) w[j] = pack2(tile[(kq * 16 + 2 * j) * 65 + nl], tile[(kq * 16 + 2 * j + 1) * 65 + nl]);
    u16* dst = (isout ? WOUT + ((size_t)l * 1024 + nt * 64 + nl) * 1024 : WALL + ((size_t)l * NALL + nt * 64 + nl) * 1024) + kt * 64 + kq * 16;
    ((uint4*)dst)[0] = make_uint4(w[0], w[1], w[2], w[3]);
    ((uint4*)dst)[1] = make_uint4(w[4], w[5], w[6], w[7]);
    __syncthreads();
  }
}

__device__ void phase_w2t_item(const Params& p, int it) {
  it = opq(it);
  const int c = opaque_tid();
  const int l = it >> 1, which = it & 1;
  const float* src = (which ? p.a2 : p.w2) + (size_t)l * 64 * 256 + c;
  u16* dst = (u16*)(p.ws + (which ? OFF_A2T : OFF_W2T)) + ((size_t)l * 256 + c) * 64;
#pragma unroll
  for (int j8 = 0; j8 < 8; ++j8) {
    float f[8];
#pragma unroll
    for (int q = 0; q < 8; ++q) f[q] = src[(j8 * 8 + q) * 256];
    *(uint4*)(dst + j8 * 8) = make_uint4(pack2(f[0], f[1]), pack2(f[2], f[3]), pack2(f[4], f[5]), pack2(f[6], f[7]));
  }
}

__device__ __forceinline__ void write_h(const Params& p, int l, int row, int lane, const float4* v, float ss) {
  const float* mod = (const float*)(p.ws + OFF_MOD) + l * 3072;
  u16* H = (u16*)(p.ws + OFF_H);
  float rs = rsqrtf(ss * (1.f / 1024.f) + 1e-6f);
#pragma unroll
  for (int i = 0; i < 4; ++i) {
    int col = (lane + 64 * i) * 4;
    float4 g = *(const float4*)(p.norm_pre + l * 1024 + col);
    float4 sh = *(const float4*)(mod + col);
    float4 sc = *(const float4*)(mod + 1024 + col);
    float h0 = v[i].x * rs * g.x * (1.f + sc.x) + sh.x;
    float h1 = v[i].y * rs * g.y * (1.f + sc.y) + sh.y;
    float h2 = v[i].z * rs * g.z * (1.f + sc.z) + sh.z;
    float h3 = v[i].w * rs * g.w * (1.f + sc.w) + sh.w;
    *(uint2*)(H + (size_t)row * 1024 + col) = make_uint2(pack2(h0, h1), pack2(h2, h3));
  }
}

__device__ void phase_h0(const Params& p) {
  const int tid = opaque_tid512(); const int wave = tid >> 6, lane = tid & 63;
  for (int row = blockIdx.x * 8 + wave; row < T_; row += gridDim.x * 8) {
    const float4* xr = (const float4*)(p.x + (size_t)row * 1024);
    float4 v[4];
    float ss = 0.f;
#pragma unroll
    for (int i = 0; i < 4; ++i) {
      v[i] = xr[lane + 64 * i];
      ss += v[i].x * v[i].x + v[i].y * v[i].y + v[i].z * v[i].z + v[i].w * v[i].w;
    }
    ss = wave_sum(ss);
    write_h(p, 0, row, lane, v, ss);
  }
}

__device__ void phase_post(const Params& p, int l) {
  l = opq(l);
  const int tid = opaque_tid512(); const int wave = tid >> 6, lane = tid & 63;
  const u16* Y = (const u16*)(p.ws + OFF_PROJ);
  const float* mod = (const float*)(p.ws + OFF_MOD) + l * 3072;
  const float* modn = (const float*)(p.ws + OFF_MOD) + (l < 3 ? l + 1 : l) * 3072;
  const float* xold = (l == 0) ? p.x : p.out;
  u16* H = (u16*)(p.ws + OFF_H);
  float4 gg[4], hs[4], hh[4];
#pragma unroll
  for (int i = 0; i < 4; ++i) {
    const int col = (lane + 64 * i) * 4;
    const float4 g = *(const float4*)(p.norm_post + l * 1024 + col), gt = *(const float4*)(mod + 2048 + col);
    gg[i] = make_float4(g.x * gt.x, g.y * gt.y, g.z * gt.z, g.w * gt.w);
    const float4 gp = *(const float4*)(p.norm_pre + (l < 3 ? l + 1 : l) * 1024 + col), sc = *(const float4*)(modn + 1024 + col);
    hs[i] = make_float4(gp.x * (1.f + sc.x), gp.y * (1.f + sc.y), gp.z * (1.f + sc.z), gp.w * (1.f + sc.w));
    hh[i] = *(const float4*)(modn + col);
  }
  const int stride = gridDim.x * 8;
  int row = blockIdx.x * 8 + wave;
  uint2 yu[4]; float4 v[4];
#pragma unroll
  for (int i = 0; i < 4; ++i) { yu[i] = ((const uint2*)(Y + (size_t)row * 1024))[lane + 64 * i]; v[i] = ((const float4*)(xold + (size_t)row * 1024))[lane + 64 * i]; }
  for (; row < T_; row += stride) {
    const int nrow = (row + stride < T_) ? row + stride : row;
    uint2 yn[4]; float4 vn[4];
#pragma unroll
    for (int i = 0; i < 4; ++i) { yn[i] = ((const uint2*)(Y + (size_t)nrow * 1024))[lane + 64 * i]; vn[i] = ((const float4*)(xold + (size_t)nrow * 1024))[lane + 64 * i]; }
    float4 y[4];
    float ss = 0.f;
#pragma unroll
    for (int i = 0; i < 4; ++i) {
      y[i] = make_float4(bflo(yu[i].x), bfhi(yu[i].x), bflo(yu[i].y), bfhi(yu[i].y));
      ss += y[i].x * y[i].x + y[i].y * y[i].y + y[i].z * y[i].z + y[i].w * y[i].w;
    }
    ss = wave_sum(ss);
    const float rs = rsqrtf(ss * (1.f / 1024.f) + 1e-6f);
    float s2 = 0.f;
#pragma unroll
    for (int i = 0; i < 4; ++i) {
      const int col = (lane + 64 * i) * 4;
      v[i].x += gg[i].x * (y[i].x * rs);
      v[i].y += gg[i].y * (y[i].y * rs);
      v[i].z += gg[i].z * (y[i].z * rs);
      v[i].w += gg[i].w * (y[i].w * rs);
      *(float4*)(p.out + (size_t)row * 1024 + col) = v[i];
      s2 += v[i].x * v[i].x + v[i].y * v[i].y + v[i].z * v[i].z + v[i].w * v[i].w;
    }
    if (l < 3) {
      s2 = wave_sum(s2);
      const float r2 = rsqrtf(s2 * (1.f / 1024.f) + 1e-6f);
#pragma unroll
      for (int i = 0; i < 4; ++i) {
        const int col = (lane + 64 * i) * 4;
        const float h0 = v[i].x * r2 * hs[i].x + hh[i].x, h1 = v[i].y * r2 * hs[i].y + hh[i].y;
        const float h2 = v[i].z * r2 * hs[i].z + hh[i].z, h3 = v[i].w * r2 * hs[i].w + hh[i].w;
        *(uint2*)(H + (size_t)row * 1024 + col) = make_uint2(pack2(h0, h1), pack2(h2, h3));
      }
    }
#pragma unroll
    for (int i = 0; i < 4; ++i) { yu[i] = yn[i]; v[i] = vn[i]; }
  }
}

__device__ void attn_item(const Params& p, int l, int item, unsigned char* smem) {
  l = opq(l); item = opq(item);
  u16* Vt = (u16*)smem;
  const u16* PROJ = (const u16*)(p.ws + OFF_PROJ);
  u16* MIX = (u16*)(p.ws + OFF_MIX);
  const int tid = opaque_tid(), w = tid >> 6, lane = tid & 63, l31 = lane & 31, hf = lane >> 5;
  const int qb = item >> 3, head = item & 7, kvh = head >> 2;
  const int kpos0 = (qb - 1) * 128;
  {
    int kp = kpos0 + tid;
    if (kp < 0) kp = 0;
    const uint4* src = (const uint4*)(PROJ + (size_t)kp * NALL + 640 + kvh * 64);
#pragma unroll
    for (int c8 = 0; c8 < 8; ++c8) {
      uint4 v = src[c8];
      int d = c8 * 8;
      Vt[(d + 0) * 264 + tid] = (u16)(v.x & 0xffff);
      Vt[(d + 1) * 264 + tid] = (u16)(v.x >> 16);
      Vt[(d + 2) * 264 + tid] = (u16)(v.y & 0xffff);
      Vt[(d + 3) * 264 + tid] = (u16)(v.y >> 16);
      Vt[(d + 4) * 264 + tid] = (u16)(v.z & 0xffff);
      Vt[(d + 5) * 264 + tid] = (u16)(v.z >> 16);
      Vt[(d + 6) * 264 + tid] = (u16)(v.w & 0xffff);
      Vt[(d + 7) * 264 + tid] = (u16)(v.w >> 16);
    }
  }
  const int tq = qb * 128 + 32 * w + l31;
  bf16x8 qf[4], kc[4];
  {
    const u16* qp = PROJ + (size_t)tq * NALL + head * 64 + 8 * hf;
#pragma unroll
    for (int s = 0; s < 4; ++s) qf[s] = *(const bf16x8*)(qp + 16 * s);
    int kp = kpos0 + 32 * w + l31;
    if (kp < 0) kp = 0;
    const u16* kptr = PROJ + (size_t)kp * NALL + 512 + kvh * 64 + 8 * hf;
#pragma unroll
    for (int s = 0; s < 4; ++s) kc[s] = *(const bf16x8*)(kptr + 16 * s);
  }
  __syncthreads();
  const float slope = exp2f(-(float)(head + 1));
  const float sink = p.sinks[l * 8 + head];
  const int rq = 32 * w + l31;
  const u16* gp = PROJ + (size_t)tq * NALL + 768 + head * 64;
  uint2 gA[4], gB[4];
#pragma unroll
  for (int g = 0; g < 4; ++g) { gA[g] = *(const uint2*)(gp + 8 * g + 4 * hf); gB[g] = *(const uint2*)(gp + 32 + 8 * g + 4 * hf); }
  float mrun = -1e30f, lsum = 0.f;
  f32x16 o0, o1;
#pragma unroll
  for (int r = 0; r < 16; ++r) { o0[r] = 0.f; o1[r] = 0.f; }
#pragma unroll 1
  for (int i = 0; i < 5; ++i) {
    bf16x8 kn[4];
    {
      const int in_ = (i < 4) ? i + 1 : 4;
      int kp = kpos0 + 32 * w + 32 * in_ + l31;
      if (kp < 0) kp = 0;
      const u16* kptr = PROJ + (size_t)kp * NALL + 512 + kvh * 64 + 8 * hf;
#pragma unroll
      for (int s = 0; s < 4; ++s) kn[s] = *(const bf16x8*)(kptr + 16 * s);
    }
    f32x16 a;
#pragma unroll
    for (int r = 0; r < 16; ++r) a[r] = 0.f;
#pragma unroll
    for (int s = 0; s < 4; ++s) a = __builtin_amdgcn_mfma_f32_32x32x16_bf16(kc[s], qf[s], a, 0, 0, 0);
#pragma unroll
    for (int s = 0; s < 4; ++s) kc[s] = kn[s];
    float tmax = -1e30f;
#pragma unroll
    for (int r = 0; r < 16; ++r) {
      int kj = 32 * w + 32 * i + (r & 3) + 8 * (r >> 2) + 4 * hf;
      int dist = 128 + rq - kj;
      bool valid = (dist >= 0) && (dist < 128) && (kpos0 + kj >= 0);
      float sv = a[r] * 0.125f - slope * (float)dist;
      sv = valid ? sv : -1e30f;
      a[r] = sv;
      tmax = fmaxf(tmax, sv);
    }
    tmax = fmaxf(tmax, __shfl_xor(tmax, 32));
    const float mnew = fmaxf(mrun, tmax);
    const float alpha = __expf(mrun - mnew);
    float psum = 0.f;
#pragma unroll
    for (int r = 0; r < 16; ++r) {
      float e = (a[r] > -1e29f) ? __expf(a[r] - mnew) : 0.f;
      a[r] = e;
      psum += e;
    }
    lsum = lsum * alpha + psum;
    mrun = mnew;
#pragma unroll
    for (int r = 0; r < 16; ++r) { o0[r] *= alpha; o1[r] *= alpha; }
#pragma unroll
    for (int u = 0; u < 2; ++u) {
      bf16x8 pf;
#pragma unroll
      for (int j = 0; j < 8; ++j) pf[j] = (short)f2bf(a[8 * u + j]);
      const int kb = 32 * w + 32 * i + 16 * u + 4 * hf;
      const u16* v0 = Vt + l31 * 264 + kb;
      const u16* v1 = Vt + (32 + l31) * 264 + kb;
      uint2 a0 = *(const uint2*)(v0), a1 = *(const uint2*)(v0 + 8);
      uint2 b0 = *(const uint2*)(v1), b1 = *(const uint2*)(v1 + 8);
      uint4 A0 = make_uint4(a0.x, a0.y, a1.x, a1.y), A1 = make_uint4(b0.x, b0.y, b1.x, b1.y);
      o0 = __builtin_amdgcn_mfma_f32_32x32x16_bf16(__builtin_bit_cast(bf16x8, A0), pf, o0, 0, 0, 0);
      o1 = __builtin_amdgcn_mfma_f32_32x32x16_bf16(__builtin_bit_cast(bf16x8, A1), pf, o1, 0, 0, 0);
    }
  }
  {
    const float mf = fmaxf(mrun, sink);
    const float scl = __expf(mrun - mf);
    const float ltot = (lsum + __shfl_xor(lsum, 32)) * scl + __expf(sink - mf);
    const float fin = scl / ltot;
#pragma unroll
    for (int r = 0; r < 16; ++r) { o0[r] *= fin; o1[r] *= fin; }
  }
  u16* op = MIX + (size_t)tq * 1024 + head * 64;
#pragma unroll
  for (int g = 0; g < 4; ++g) {
    int d0 = 8 * g + 4 * hf;
    uint2 gg = gA[g];
    float r0 = o0[4 * g + 0] * silu(bflo(gg.x)), r1 = o0[4 * g + 1] * silu(bfhi(gg.x));
    float r2 = o0[4 * g + 2] * silu(bflo(gg.y)), r3 = o0[4 * g + 3] * silu(bfhi(gg.y));
    *(uint2*)(op + d0) = make_uint2(pack2(r0, r1), pack2(r2, r3));
    uint2 g2 = gB[g];
    r0 = o1[4 * g + 0] * silu(bflo(g2.x)); r1 = o1[4 * g + 1] * silu(bfhi(g2.x));
    r2 = o1[4 * g + 2] * silu(bflo(g2.y)); r3 = o1[4 * g + 3] * silu(bfhi(g2.y));
    *(uint2*)(op + 32 + d0) = make_uint2(pack2(r0, r1), pack2(r2, r3));
  }
  __syncthreads();
}

__device__ void rwkv_prep_item(const Params& p, int l, int item, unsigned char* smem) {
  l = opq(l); item = opq(item);
  u16* lwb = (u16*)smem;
  u16* lab = lwb + 16 * 72;
  const u16* PROJ = (const u16*)(p.ws + OFF_PROJ);
  const int tid = opaque_tid(), head = tid >> 6, lane = tid & 63, fr = lane & 15, fq = lane >> 4;
  const int t0 = item * 16;
  {
    const int which = tid >> 7, tt = (tid >> 3) & 15, j0 = (tid & 7) * 8;
    const int t = t0 + tt;
    const u16* pr = PROJ + (size_t)t * NALL;
    const u16* pq = (t > 0) ? pr - NALL : pr;
    const float pm = (t > 0) ? 1.f : 0.f;
    const uint4 cu = *(const uint4*)(pr + (which ? 3200 : 3072) + j0);
    const uint4 pu = *(const uint4*)(pq + (which ? 3264 : 3136) + j0);
    float sv[8];
    sv[0] = bflo(cu.x) + pm * bflo(pu.x); sv[1] = bfhi(cu.x) + pm * bfhi(pu.x);
    sv[2] = bflo(cu.y) + pm * bflo(pu.y); sv[3] = bfhi(cu.y) + pm * bfhi(pu.y);
    sv[4] = bflo(cu.z) + pm * bflo(pu.z); sv[5] = bfhi(cu.z) + pm * bfhi(pu.z);
    sv[6] = bflo(cu.w) + pm * bflo(pu.w); sv[7] = bfhi(cu.w) + pm * bfhi(pu.w);
    if (!which) {
#pragma unroll
      for (int q = 0; q < 8; ++q) sv[q] = tanh_fast(sv[q]);
    }
    *(uint4*)((which ? lab : lwb) + tt * 72 + j0) = make_uint4(pack2(sv[0], sv[1]), pack2(sv[2], sv[3]), pack2(sv[4], sv[5]), pack2(sv[6], sv[7]));
  }
  __syncthreads();
  f32x4 accw[4], acca[4];
#pragma unroll
  for (int nt = 0; nt < 4; ++nt) { accw[nt] = (f32x4){0.f, 0.f, 0.f, 0.f}; acca[nt] = (f32x4){0.f, 0.f, 0.f, 0.f}; }
  {
    const u16* W2T = (const u16*)(p.ws + OFF_W2T) + ((size_t)l * 256 + head * 64 + fr * 4) * 64 + fq * 8;
    const u16* A2T = (const u16*)(p.ws + OFF_A2T) + ((size_t)l * 256 + head * 64 + fr * 4) * 64 + fq * 8;
#pragma unroll
    for (int ks = 0; ks < 2; ++ks) {
      const bf16x8 aw = *(const bf16x8*)(lwb + fr * 72 + ks * 32 + fq * 8);
      const bf16x8 aa = *(const bf16x8*)(lab + fr * 72 + ks * 32 + fq * 8);
#pragma unroll
      for (int nt = 0; nt < 4; ++nt) {
        const bf16x8 bw = *(const bf16x8*)(W2T + nt * 64 + ks * 32);
        const bf16x8 ba = *(const bf16x8*)(A2T + nt * 64 + ks * 32);
        accw[nt] = __builtin_amdgcn_mfma_f32_16x16x32_bf16(aw, bw, accw[nt], 0, 0, 0);
        acca[nt] = __builtin_amdgcn_mfma_f32_16x16x32_bf16(aa, ba, acca[nt], 0, 0, 0);
      }
    }
  }
  const int c0 = head * 64 + fr * 4;
  const float4 mur = *(const float4*)(p.mu_rkv + l * 768 + c0), muk = *(const float4*)(p.mu_rkv + l * 768 + 256 + c0), muv = *(const float4*)(p.mu_rkv + l * 768 + 512 + c0);
  const float4 w0 = *(const float4*)(p.w0 + l * 256 + c0), a0 = *(const float4*)(p.a0 + l * 256 + c0);
  const float4 kkw = *(const float4*)(p.k_k + l * 256 + c0), kaw = *(const float4*)(p.k_a + l * 256 + c0), rkw = *(const float4*)(p.r_k + l * 256 + c0);
  float* RWW = (float*)(p.ws + OFF_RWW);
  float* RWKK = (float*)(p.ws + OFF_RWKK);
  u16* RB = (u16*)(p.ws + OFF_RWB);
  float* BON = (float*)(p.ws + OFF_BONUS);
#define F4E(v, i) ((i) == 0 ? v.x : (i) == 1 ? v.y : (i) == 2 ? v.z : v.w)
#pragma unroll
  for (int rg = 0; rg < 4; ++rg) {
    const int t = t0 + fq * 4 + rg;
    const u16* pr = PROJ + (size_t)t * NALL;
    const u16* pp = (t > 0) ? pr - NALL : pr;
    const float pm = (t > 0) ? 1.f : 0.f;
    const uint2 rcu = *(const uint2*)(pr + 1280 + c0), kcu = *(const uint2*)(pr + 1536 + c0), vcu = *(const uint2*)(pr + 1792 + c0);
    const uint2 rpu = *(const uint2*)(pp + 1280 + c0), kpu = *(const uint2*)(pp + 1536 + c0), vpu = *(const uint2*)(pp + 1792 + c0);
    const float rc[4] = {bflo(rcu.x), bfhi(rcu.x), bflo(rcu.y), bfhi(rcu.y)}, kc[4] = {bflo(kcu.x), bfhi(kcu.x), bflo(kcu.y), bfhi(kcu.y)};
    const float vc[4] = {bflo(vcu.x), bfhi(vcu.x), bflo(vcu.y), bfhi(vcu.y)};
    const float rp[4] = {bflo(rpu.x), bfhi(rpu.x), bflo(rpu.y), bfhi(rpu.y)}, kp[4] = {bflo(kpu.x), bfhi(kpu.x), bflo(kpu.y), bfhi(kpu.y)};
    const float vp[4] = {bflo(vpu.x), bfhi(vpu.x), bflo(vpu.y), bfhi(vpu.y)};
    float kkc[4], av[4], dec[4], rr[4], km[4], vv[4];
    float n2 = 0.f, bonus = 0.f;
#pragma unroll
    for (int nt = 0; nt < 4; ++nt) {
      const float r = rc[nt] + (pm * rp[nt] - rc[nt]) * F4E(mur, nt), k = kc[nt] + (pm * kp[nt] - kc[nt]) * F4E(muk, nt), v = vc[nt] + (pm * vp[nt] - vc[nt]) * F4E(muv, nt);
      const float wpre = F4E(w0, nt) + accw[nt][rg];
      const float wl = -softplusf_(-wpre) - 0.5f;
      dec[nt] = __expf(-__expf(wl));
      const float a = sigmoidf_(F4E(a0, nt) + acca[nt][rg]);
      const float kc2 = k * F4E(kkw, nt);
      const float kmod = k * (1.f + (a - 1.f) * F4E(kaw, nt));
      kkc[nt] = kc2; av[nt] = a; rr[nt] = r; km[nt] = kmod; vv[nt] = v;
      n2 += kc2 * kc2;
      bonus += r * kmod * F4E(rkw, nt);
    }
    n2 = row16_allsum(n2);
    bonus = row16_allsum(bonus);
    const float inv = __builtin_amdgcn_rsqf(fmaxf(n2, 1e-24f));
    const size_t o = (size_t)t * 256 + c0;
    *(float4*)(RWW + o) = make_float4(dec[0], dec[1], dec[2], dec[3]);
    *(float4*)(RWKK + o) = make_float4(kkc[0] * inv, kkc[1] * inv, kkc[2] * inv, kkc[3] * inv);
    *(uint2*)(RB + o) = make_uint2(pack2(rr[0], rr[1]), pack2(rr[2], rr[3]));
    *(uint2*)(RB + (size_t)T_ * 256 + o) = make_uint2(pack2(km[0], km[1]), pack2(km[2], km[3]));
    *(uint2*)(RB + (size_t)2 * T_ * 256 + o) = make_uint2(pack2(vv[0], vv[1]), pack2(vv[2], vv[3]));
    *(uint2*)(RB + (size_t)3 * T_ * 256 + o) = make_uint2(pack2(kkc[0] * inv * av[0], kkc[1] * inv * av[1]), pack2(kkc[2] * inv * av[2], kkc[3] * inv * av[3]));
    if (fr == 0) BON[t * 4 + head] = bonus;
  }
  __syncthreads();
}

__device__ __forceinline__ void gla_b(const Params& p, int l, int head, const u16* lgs, float* tot, float* bl) {
  const int tid = opaque_tid(), d = tid & 31, ig = tid >> 5;
  float g2[16];
#pragma unroll
  for (int m = 0; m < 16; ++m) g2[m] = p.gk2[(size_t)l * 16 * 128 + m * 128 + head * 32 + d];
  const float bias = p.gk_b[l * 128 + head * 32 + d];
  float run = 0.f;
#pragma unroll
  for (int ii = 0; ii < 8; ++ii) {
    const uint4* lp = (const uint4*)(lgs + (ig * 8 + ii) * 16);
    uint4 u0 = lp[0], u1 = lp[1];
    float z = bias;
    z += bflo(u0.x) * g2[0] + bfhi(u0.x) * g2[1] + bflo(u0.y) * g2[2] + bfhi(u0.y) * g2[3];
    z += bflo(u0.z) * g2[4] + bfhi(u0.z) * g2[5] + bflo(u0.w) * g2[6] + bfhi(u0.w) * g2[7];
    z += bflo(u1.x) * g2[8] + bfhi(u1.x) * g2[9] + bflo(u1.y) * g2[10] + bfhi(u1.y) * g2[11];
    z += bflo(u1.z) * g2[12] + bfhi(u1.z) * g2[13] + bflo(u1.w) * g2[14] + bfhi(u1.w) * g2[15];
    float g = (fminf(z, 0.f) - __logf(1.f + __expf(-fabsf(z)))) * (1.f / 16.f);
    run += g;
    bl[ii] = run;
  }
  tot[ig * 32 + d] = run;
  __syncthreads();
  float off = 0.f;
#pragma unroll
  for (int g = 0; g < 8; ++g) off += (g < ig) ? tot[g * 32 + d] : 0.f;
#pragma unroll
  for (int ii = 0; ii < 8; ++ii) bl[ii] += off;
}
__device__ __forceinline__ void st8f(float* dst, const uint4 u) {
  *(float4*)(dst) = make_float4(bflo(u.x), bfhi(u.x), bflo(u.y), bfhi(u.y));
  *(float4*)(dst + 4) = make_float4(bflo(u.z), bfhi(u.z), bflo(u.w), bfhi(u.w));
}

__device__ void gla_local_item(const Params& p, int l, int item, unsigned char* smem) {
  l = opq(l); item = opq(item);
  float* tot = (float*)smem;
  float* Kp = tot + 256;
  float* Vs = Kp + 2048;
  u16* lgs = (u16*)(Vs + 4096);
  const u16* PROJ = (const u16*)(p.ws + OFF_PROJ);
  const int tid = opaque_tid(), d = tid & 31, ig = tid >> 5;
  const int chunk = item >> 2, head = item & 3;
  {
    const u16* base = PROJ + (size_t)(chunk * 64) * NALL;
    const int ki = tid >> 2, kd0 = (tid & 3) * 8;
    const uint4 ku = *(const uint4*)(base + (size_t)ki * NALL + 2432 + head * 32 + kd0);
    const int g0 = tid, g1 = tid + 256;
    const uint4 vu0 = *(const uint4*)(base + (size_t)(g0 >> 3) * NALL + 2560 + head * 64 + (g0 & 7) * 8);
    const uint4 vu1 = *(const uint4*)(base + (size_t)(g1 >> 3) * NALL + 2560 + head * 64 + (g1 & 7) * 8);
    uint4 lu = make_uint4(0u, 0u, 0u, 0u);
    if (tid < 128) lu = *(const uint4*)(base + (size_t)(tid >> 1) * NALL + 3328 + (tid & 1) * 8);
    st8f(Kp + ki * 32 + kd0, ku);
    st8f(Vs + (g0 >> 3) * 64 + (g0 & 7) * 8, vu0);
    st8f(Vs + (g1 >> 3) * 64 + (g1 & 7) * 8, vu1);
    if (tid < 128) *(uint4*)(lgs + (tid >> 1) * 16 + (tid & 1) * 8) = lu;
  }
  __syncthreads();
  float bl[8];
  gla_b(p, l, head, lgs, tot, bl);
  float blast = 0.f;
#pragma unroll
  for (int g = 0; g < 8; ++g) blast += tot[g * 32 + d];
#pragma unroll
  for (int ii = 0; ii < 8; ++ii) {
    const int i = ig * 8 + ii;
    Kp[i * 32 + d] *= __expf(blast - bl[ii]);
  }
  __syncthreads();
  const int v = tid & 63, dg = tid >> 6;
  float acc[8];
#pragma unroll
  for (int q = 0; q < 8; ++q) acc[q] = 0.f;
  for (int i = 0; i < 64; ++i) {
    float vv = Vs[i * 64 + v];
    float4 k0 = *(const float4*)(Kp + i * 32 + dg * 8), k1 = *(const float4*)(Kp + i * 32 + dg * 8 + 4);
    acc[0] += k0.x * vv; acc[1] += k0.y * vv; acc[2] += k0.z * vv; acc[3] += k0.w * vv;
    acc[4] += k1.x * vv; acc[5] += k1.y * vv; acc[6] += k1.z * vv; acc[7] += k1.w * vv;
  }
  float* GS = (float*)(p.ws + OFF_GLAS);
  float* GD = (float*)(p.ws + OFF_GLAD);
#pragma unroll
  for (int q = 0; q < 8; ++q) GS[((size_t)(chunk * 4 + head) * 32 + dg * 8 + q) * 64 + v] = acc[q];
  if (tid < 32) GD[(chunk * 4 + head) * 32 + tid] = __expf(blast);
  __syncthreads();
}

#define GLA_STATE_LOAD(eb_) \
  const int gs_tid = opaque_tid512(); const int gs_ei = gs_tid & 31, gs_g = gs_tid >> 5; \
  const int gs_e = (eb_) * 32 + gs_ei; const int gs_head = gs_e >> 11, gs_d = (gs_e >> 6) & 31, gs_v = gs_e & 63; \
  float gs_ds[16], gs_dc[16]; \
  { float* GSl = (float*)(p.ws + OFF_GLAS); const float* GDl = (const float*)(p.ws + OFF_GLAD); \
    _Pragma("unroll") for (int i = 0; i < 16; ++i) { const int c = gs_g * 16 + i; \
      gs_ds[i] = GSl[((size_t)(c * 4 + gs_head) * 32 + gs_d) * 64 + gs_v]; gs_dc[i] = GDl[(c * 4 + gs_head) * 32 + gs_d]; } }
#define GLA_STATE_FINISH(dsm_) { \
    float* comp = (float*)(dsm_); float* GSl = (float*)(p.ws + OFF_GLAS); \
    float S = 0.f, P = 1.f; \
    _Pragma("unroll") for (int i = 0; i < 16; ++i) { S = gs_dc[i] * S + gs_ds[i]; P *= gs_dc[i]; } \
    comp[(gs_g * 32 + gs_ei) * 2] = P; comp[(gs_g * 32 + gs_ei) * 2 + 1] = S; \
    __syncthreads(); \
    float G = 0.f; \
    for (int gg = 0; gg < gs_g; ++gg) G = comp[(gg * 32 + gs_ei) * 2] * G + comp[(gg * 32 + gs_ei) * 2 + 1]; \
    _Pragma("unroll") for (int i = 0; i < 16; ++i) { const int c = gs_g * 16 + i; \
      GSl[((size_t)(c * 4 + gs_head) * 32 + gs_d) * 64 + gs_v] = G; G = gs_dc[i] * G + gs_ds[i]; } \
    __syncthreads(); }

__device__ void gla_out_item(const Params& p, int l, int item, unsigned char* smem) {
  l = opq(l); item = opq(item);
  float* tot = (float*)smem;
  float* qt = tot + 256;
  float* kt = qt + 2304;
  float* Vs = kt + 2304;
  float* Am = Vs + 4096;
  float* Ss = Am + 4352;
  u16* lgs = (u16*)(Ss + 2048);
  const u16* PROJ = (const u16*)(p.ws + OFF_PROJ);
  u16* MIX = (u16*)(p.ws + OFF_MIX);
  const float* GS = (const float*)(p.ws + OFF_GLAS);
  const int tid = opaque_tid();
  const int chunk = item >> 2, head = item & 3;
  {
    const u16* base = PROJ + (size_t)(chunk * 64) * NALL;
    const int ki = tid >> 2, kd0 = (tid & 3) * 8;
    const uint4 qu = *(const uint4*)(base + (size_t)ki * NALL + 2304 + head * 32 + kd0);
    const uint4 ku = *(const uint4*)(base + (size_t)ki * NALL + 2432 + head * 32 + kd0);
    const int g0 = tid, g1 = tid + 256;
    const uint4 vu0 = *(const uint4*)(base + (size_t)(g0 >> 3) * NALL + 2560 + head * 64 + (g0 & 7) * 8);
    const uint4 vu1 = *(const uint4*)(base + (size_t)(g1 >> 3) * NALL + 2560 + head * 64 + (g1 & 7) * 8);
    const float4 s0 = ((const float4*)(GS + (size_t)(chunk * 4 + head) * 2048))[tid];
    const float4 s1 = ((const float4*)(GS + (size_t)(chunk * 4 + head) * 2048))[tid + 256];
    uint4 lu = make_uint4(0u, 0u, 0u, 0u);
    if (tid < 128) lu = *(const uint4*)(base + (size_t)(tid >> 1) * NALL + 3328 + (tid & 1) * 8);
    st8f(qt + ki * 36 + kd0, qu);
    st8f(kt + ki * 36 + kd0, ku);
    st8f(Vs + (g0 >> 3) * 64 + (g0 & 7) * 8, vu0);
    st8f(Vs + (g1 >> 3) * 64 + (g1 & 7) * 8, vu1);
    ((float4*)Ss)[tid] = s0;
    ((float4*)Ss)[tid + 256] = s1;
    if (tid < 128) *(uint4*)(lgs + (tid >> 1) * 16 + (tid & 1) * 8) = lu;
  }
  __syncthreads();
  {
    const int d = tid & 31, ig = tid >> 5;
    float bl[8];
    gla_b(p, l, head, lgs, tot, bl);
#pragma unroll
    for (int ii = 0; ii < 8; ++ii) {
      const int i = ig * 8 + ii;
      qt[i * 36 + d] *= 0.17677669529663687f * __expf(bl[ii]);
      kt[i * 36 + d] *= __expf(-bl[ii]);
    }
  }
  __syncthreads();
  const int j = tid & 63, ig = tid >> 6;
  {
    float acc[16];
#pragma unroll
    for (int ii = 0; ii < 16; ++ii) acc[ii] = 0.f;
#pragma unroll 2
    for (int d4 = 0; d4 < 8; ++d4) {
      const float4 kv = *(const float4*)(kt + j * 36 + d4 * 4);
#pragma unroll
      for (int ii = 0; ii < 16; ++ii) {
        const float4 qv = *(const float4*)(qt + (ig * 16 + ii) * 36 + d4 * 4);
        acc[ii] += qv.x * kv.x + qv.y * kv.y + qv.z * kv.z + qv.w * kv.w;
      }
    }
#pragma unroll
    for (int ii = 0; ii < 16; ++ii) {
      int i = ig * 16 + ii;
      Am[i * 68 + j] = (j <= i) ? acc[ii] : 0.f;
    }
  }
  __syncthreads();
  {
    const int v = j;
    float acc[16];
#pragma unroll
    for (int ii = 0; ii < 16; ++ii) acc[ii] = 0.f;
    const int jmax = (ig + 1) * 4;
    for (int j4 = 0; j4 < jmax; ++j4) {
      const float v0 = Vs[(j4 * 4 + 0) * 64 + v], v1 = Vs[(j4 * 4 + 1) * 64 + v], v2 = Vs[(j4 * 4 + 2) * 64 + v], v3 = Vs[(j4 * 4 + 3) * 64 + v];
#pragma unroll
      for (int ii = 0; ii < 16; ++ii) {
        const float4 av = *(const float4*)(Am + (ig * 16 + ii) * 68 + j4 * 4);
        acc[ii] += av.x * v0 + av.y * v1 + av.z * v2 + av.w * v3;
      }
    }
#pragma unroll 2
    for (int d4 = 0; d4 < 8; ++d4) {
      const float s0 = Ss[(d4 * 4 + 0) * 64 + v], s1 = Ss[(d4 * 4 + 1) * 64 + v], s2 = Ss[(d4 * 4 + 2) * 64 + v], s3 = Ss[(d4 * 4 + 3) * 64 + v];
#pragma unroll
      for (int ii = 0; ii < 16; ++ii) {
        const float4 qv = *(const float4*)(qt + (ig * 16 + ii) * 36 + d4 * 4);
        acc[ii] += qv.x * s0 + qv.y * s1 + qv.z * s2 + qv.w * s3;
      }
    }
    __syncthreads();
#pragma unroll
    for (int ii = 0; ii < 16; ++ii) Am[(ig * 16 + ii) * 68 + v] = acc[ii];
  }
  __syncthreads();
  {
    const int fr = tid & 15, tg = tid >> 4;
    const float4 nw = *(const float4*)(p.gla_nw + l * 64 + fr * 4);
#pragma unroll
    for (int ps = 0; ps < 4; ++ps) {
      const int i = ps * 16 + tg;
      const int t = chunk * 64 + i;
      const float4 o = *(const float4*)(Am + i * 68 + fr * 4);
      const uint2 gg = *(const uint2*)(PROJ + (size_t)t * NALL + 2816 + head * 64 + fr * 4);
      const float ms = row16_allsum(o.x * o.x + o.y * o.y + o.z * o.z + o.w * o.w) * (1.f / 64.f);
      const float rs = rsqrtf(ms + 1e-5f);
      const float r0 = o.x * rs * nw.x * silu(bflo(gg.x)), r1 = o.y * rs * nw.y * silu(bfhi(gg.x));
      const float r2 = o.z * rs * nw.z * silu(bflo(gg.y)), r3 = o.w * rs * nw.w * silu(bfhi(gg.y));
      *(uint2*)(MIX + (size_t)t * 1024 + 768 + head * 64 + fr * 4) = make_uint2(pack2(r0, r1), pack2(r2, r3));
    }
  }
  __syncthreads();
}

typedef float f32x2 __attribute__((ext_vector_type(2)));
__device__ __forceinline__ float oct_allsum(float x) {
  x += dpp_f<0xB1>(x);
  x += dpp_f<0x4E>(x);
  x += dpp_f<0x141>(x);
  return x;
}
__device__ void rwkv_scan_item(const Params& p, int item, unsigned char* dsm_) {
  item = opq(item);
  float* st = (float*)dsm_;
  const int tid = opaque_tid512(), wv = tid >> 6, lane = tid & 63, rs = lane >> 3, kl = lane & 7;
  const int head = item & 3, seg = item >> 2;
  const bool ident = wv >= 4;
  const int R0 = wv * 16 + rs * 2;
  const int v0 = R0 & 63;
  const float* RWW = (const float*)(p.ws + OFF_RWW);
  const float* RWKK = (const float*)(p.ws + OFF_RWKK);
  const u16* RB = (const u16*)(p.ws + OFF_RWB);
  float* PF = (float*)(p.ws + OFF_PROJ);
  float* ZP = (float*)(p.ws + OFF_ZP);
  const int tbase = seg * SL;
  const int half = tid >> 8, ls = (tid & 255) >> 4, lc4 = (tid & 15) * 4;
  f32x2 S0[4], S1[4];
#pragma unroll
  for (int e = 0; e < 4; ++e) { S0[e] = (f32x2){0.f, 0.f}; S1[e] = (f32x2){0.f, 0.f}; }
  if (ident) {
#pragma unroll
    for (int e = 0; e < 4; ++e) {
      const int k0 = kl * 8 + 2 * e;
      S0[e] = (f32x2){(v0 == k0) ? 1.f : 0.f, (v0 == k0 + 1) ? 1.f : 0.f};
      S1[e] = (f32x2){(v0 + 1 == k0) ? 1.f : 0.f, (v0 + 1 == k0 + 1) ? 1.f : 0.f};
    }
  }
  float4 g0 = make_float4(0.f, 0.f, 0.f, 0.f);
  uint2 h0 = make_uint2(0u, 0u), h1 = h0, h2 = h0;
  const float* gp0 = (half == 0 ? RWW : RWKK) + (size_t)(tbase + ls) * 256 + head * 64 + lc4;
  const u16* hp = RB + (size_t)(tbase + ls) * 256 + head * 64 + lc4;
#define SCAN_GLOAD(ch) do { const size_t _o = (size_t)(ch) * 16 * 256; g0 = *(const float4*)(gp0 + _o); \
    if (half == 0) { h0 = *(const uint2*)(hp + _o); } \
    else { h0 = *(const uint2*)(hp + (size_t)T_ * 256 + _o); h1 = *(const uint2*)(hp + (size_t)3 * T_ * 256 + _o); h2 = *(const uint2*)(hp + (size_t)2 * T_ * 256 + _o); } } while (0)
#define SCAN_LSTORE(buf) do { float* _b = st + (buf) * 6144 + ls * 64 + lc4; \
    if (half == 0) { *(float4*)(_b) = g0; *(float4*)(_b + 2048) = make_float4(bflo(h0.x), bfhi(h0.x), bflo(h0.y), bfhi(h0.y)); } \
    else { *(float4*)(_b + 1024) = g0; *(float4*)(_b + 3072) = make_float4(bflo(h0.x), bfhi(h0.x), bflo(h0.y), bfhi(h0.y)); \
           *(float4*)(_b + 4096) = make_float4(bflo(h1.x), bfhi(h1.x), bflo(h1.y), bfhi(h1.y)); *(float4*)(_b + 5120) = make_float4(bflo(h2.x), bfhi(h2.x), bflo(h2.y), bfhi(h2.y)); } } while (0)
  if (tid < 16) st[2 * 6144 + tid] = 0.f;
  SCAN_GLOAD(0);
  SCAN_LSTORE(0);
  __syncthreads();
  const int nch = SL / 16;
  float* yout = PF + (size_t)tbase * PROJF + (ident ? 256 : 0) + head * 64 + v0;
  const int voff = ident ? (2 * 6144) : (5120 + v0);
  const int vstep = ident ? 0 : 64, vbuf = ident ? 0 : 6144;
#define V2(a, i) ((f32x2){(i) ? a.z : a.x, (i) ? a.w : a.y})
#define SCAN_STEP(s_) do { \
    const float* bp = b + (s_) * 64 + kl * 8; \
    const float4 wl = *(const float4*)(bp), wh = *(const float4*)(bp + 4); \
    const float4 kkl = *(const float4*)(bp + 1024), kkh = *(const float4*)(bp + 1028); \
    const float4 rl4 = *(const float4*)(bp + 2048), rh4 = *(const float4*)(bp + 2052); \
    const float4 kl4 = *(const float4*)(bp + 3072), kh4 = *(const float4*)(bp + 3076); \
    const float4 bl4 = *(const float4*)(bp + 4096), bh4 = *(const float4*)(bp + 4100); \
    const f32x2 vv = *(const f32x2*)(vsrc + (s_) * vstep); \
    const f32x2 W[4] = {V2(wl, 0), V2(wl, 1), V2(wh, 0), V2(wh, 1)}, KK[4] = {V2(kkl, 0), V2(kkl, 1), V2(kkh, 0), V2(kkh, 1)}; \
    const f32x2 RR[4] = {V2(rl4, 0), V2(rl4, 1), V2(rh4, 0), V2(rh4, 1)}, KV[4] = {V2(kl4, 0), V2(kl4, 1), V2(kh4, 0), V2(kh4, 1)}; \
    const f32x2 BB[4] = {V2(bl4, 0), V2(bl4, 1), V2(bh4, 0), V2(bh4, 1)}; \
    f32x2 t0 = S0[0] * KK[0] + S0[1] * KK[1] + S0[2] * KK[2] + S0[3] * KK[3]; \
    f32x2 t1 = S1[0] * KK[0] + S1[1] * KK[1] + S1[2] * KK[2] + S1[3] * KK[3]; \
    float sa0 = -(t0.x + t0.y), sa1 = -(t1.x + t1.y); \
    sa0 += dpp_f<0xB1>(sa0); sa1 += dpp_f<0xB1>(sa1); sa0 += dpp_f<0x4E>(sa0); sa1 += dpp_f<0x4E>(sa1); sa0 += dpp_f<0x141>(sa0); sa1 += dpp_f<0x141>(sa1); \
    const f32x2 a0 = {sa0, sa0}, a1 = {sa1, sa1}, u0 = {vv.x, vv.x}, u1 = {vv.y, vv.y}; \
    _Pragma("unroll") for (int e = 0; e < 4; ++e) { S0[e] = S0[e] * W[e] + a0 * BB[e] + u0 * KV[e]; S1[e] = S1[e] * W[e] + a1 * BB[e] + u1 * KV[e]; } \
    f32x2 q0 = S0[0] * RR[0] + S0[1] * RR[1] + S0[2] * RR[2] + S0[3] * RR[3]; \
    f32x2 q1 = S1[0] * RR[0] + S1[1] * RR[1] + S1[2] * RR[2] + S1[3] * RR[3]; \
    float y0 = q0.x + q0.y, y1 = q1.x + q1.y; \
    y0 += dpp_f<0xB1>(y0); y1 += dpp_f<0xB1>(y1); y0 += dpp_f<0x4E>(y0); y1 += dpp_f<0x4E>(y1); y0 += dpp_f<0x141>(y0); y1 += dpp_f<0x141>(y1); \
    const bool mine = (kl == ((s_) & 7)); \
    if ((s_) < 8) { ya.x = mine ? y0 : ya.x; ya.y = mine ? y1 : ya.y; } else { yb.x = mine ? y0 : yb.x; yb.y = mine ? y1 : yb.y; } } while (0)
  for (int ch = 0; ch < nch; ++ch) {
    const int cur = ch & 1;
    if (ch + 1 < nch) SCAN_GLOAD(ch + 1);
    const float* b = st + cur * 6144;
    const float* vsrc = st + voff + cur * vbuf;
    f32x2 ya = {0.f, 0.f}, yb = {0.f, 0.f};
#pragma unroll 2
    for (int s = 0; s < 8; ++s) SCAN_STEP(s);
#pragma unroll 2
    for (int s = 8; s < 16; ++s) SCAN_STEP(s);
    *(f32x2*)(yout + (size_t)(ch * 16 + kl) * PROJF) = ya;
    *(f32x2*)(yout + (size_t)(ch * 16 + 8 + kl) * PROJF) = yb;
    if (ch + 1 < nch) SCAN_LSTORE(cur ^ 1);
    __syncthreads();
  }
#pragma unroll
  for (int j = 0; j < 2; ++j) {
    float* zp = ZP + ((size_t)((seg * 4 + head) * 128 + R0 + j)) * 64 + kl * 8;
    if (j == 0) { *(float4*)(zp) = make_float4(S0[0].x, S0[0].y, S0[1].x, S0[1].y); *(float4*)(zp + 4) = make_float4(S0[2].x, S0[2].y, S0[3].x, S0[3].y); }
    else { *(float4*)(zp) = make_float4(S1[0].x, S1[0].y, S1[1].x, S1[1].y); *(float4*)(zp + 4) = make_float4(S1[2].x, S1[2].y, S1[3].x, S1[3].y); }
  }
}

__device__ void rwkv_combine(const Params& p, unsigned char* dsm_) {
  float* ring = (float*)dsm_;
  float* ZP = (float*)(p.ws + OFF_ZP);
  const int tid = opaque_tid512(); const int lane = tid & 63;
  const int rowi = blockIdx.x * 8 + (tid >> 6);
  const int head = rowi >> 6, v = rowi & 63;
  float4 a0A, b0A, a1A, b1A, a0B, b0B, a1B, b1B, a0C, b0C, a1C, b1C, a0D, b0D, a1D, b1D;
  float z0A, z1A, z0B, z1B, z0C, z1C, z0D, z1D;
#define COMB_LOAD(X, stg_) do { \
      const float* base0 = ZP + (size_t)((((stg_) * 2 + 0) * 4 + head) * 128) * 64; \
      const float* base1 = ZP + (size_t)((((stg_) * 2 + 1) * 4 + head) * 128) * 64; \
      a0##X = ((const float4*)(base0 + 4096))[tid]; b0##X = ((const float4*)(base0 + 4096))[tid + 512]; z0##X = base0[v * 64 + lane]; \
      a1##X = ((const float4*)(base1 + 4096))[tid]; b1##X = ((const float4*)(base1 + 4096))[tid + 512]; z1##X = base1[v * 64 + lane]; } while (0)
#define COMB_SEG(q, ZC) do { const int seg = stg * 2 + q; \
      ZP[((size_t)((seg * 4 + head) * 128 + v)) * 64 + lane] = s; \
      float ns0 = ZC, ns1 = 0.f; const float* P = buf + q * 4096 + lane; \
      _Pragma("unroll") for (int i = 0; i < 64; i += 2) { \
        float s0 = __builtin_bit_cast(float, __builtin_amdgcn_readlane(__builtin_bit_cast(int, s), i)); \
        float s1 = __builtin_bit_cast(float, __builtin_amdgcn_readlane(__builtin_bit_cast(int, s), i + 1)); \
        ns0 += s0 * P[i * 64]; ns1 += s1 * P[(i + 1) * 64]; } \
      s = ns0 + ns1; } while (0)
#define COMB_STAGE(X, bi) do { \
      float* buf = ring + (bi) * 8192; \
      ((float4*)(buf))[tid] = a0##X; ((float4*)(buf))[tid + 512] = b0##X; \
      ((float4*)(buf + 4096))[tid] = a1##X; ((float4*)(buf + 4096))[tid + 512] = b1##X; \
      const float c0 = z0##X, c1 = z1##X; \
      { const int nstg = (stg + 4 < NSEG / 2) ? stg + 4 : stg; COMB_LOAD(X, nstg); } \
      __syncthreads(); \
      COMB_SEG(0, c0); COMB_SEG(1, c1); ++stg; } while (0)
  COMB_LOAD(A, 0); COMB_LOAD(B, 1); COMB_LOAD(C, 2); COMB_LOAD(D, 3);
  float s = 0.f;
  int stg = 0;
#pragma unroll 1
  for (int it4 = 0; it4 < NSEG / 8; ++it4) {
    COMB_STAGE(A, 0); COMB_STAGE(B, 1); COMB_STAGE(C, 2); COMB_STAGE(D, 3);
  }
  __syncthreads();
#undef COMB_LOAD
#undef COMB_SEG
#undef COMB_STAGE
}

__device__ __forceinline__ bf16x8 pack8(const float4 a, const float4 b) {
  uint4 u = make_uint4(pack2(a.x, a.y), pack2(a.z, a.w), pack2(b.x, b.y), pack2(b.z, b.w));
  return __builtin_bit_cast(bf16x8, u);
}
__device__ void rwkv_final_item(const Params& p, int l, int item, unsigned char* smem) {
  l = opq(l); item = opq(item);
  const int tid = opaque_tid(), w = tid >> 6, lane = tid & 63, l31 = lane & 31, hf = lane >> 5;
  const int parts = SL / 128;
  const int q = item % parts, head = (item / parts) & 3, seg = item / (parts * 4);
  const int t = seg * SL + q * 128 + w * 32 + l31;
  const float* ZP = (const float*)(p.ws + OFF_ZP);
  const float* PF = (const float*)(p.ws + OFF_PROJ);
  const u16* PROJ = (const u16*)(p.ws + OFF_PROJ);
  const u16* RBv = (const u16*)(p.ws + OFF_RWB) + (size_t)2 * T_ * 256;
  const float* BON = (const float*)(p.ws + OFF_BONUS);
  u16* MIX = (u16*)(p.ws + OFF_MIX);
  f32x16 acc0, acc1;
#pragma unroll
  for (int r = 0; r < 16; ++r) { acc0[r] = 0.f; acc1[r] = 0.f; }
  const float* y0p = PF + (size_t)t * PROJF + head * 64 + 4 * hf;
  const int cb = head * 64 + 4 * hf;
  float4 yA[4], yB[4];
  uint2 vvl[8], ggl[8];
#pragma unroll
  for (int g = 0; g < 4; ++g) { yA[g] = *(const float4*)(y0p + 8 * g); yB[g] = *(const float4*)(y0p + 32 + 8 * g); }
#pragma unroll
  for (int q8 = 0; q8 < 8; ++q8) {
    const int c = cb + (q8 >> 2) * 32 + 8 * (q8 & 3);
    vvl[q8] = *(const uint2*)(RBv + (size_t)t * 256 + c);
    ggl[q8] = *(const uint2*)(PROJ + (size_t)t * NALL + 2048 + c);
  }
  const float bon = BON[t * 4 + head];
  {
    const float* sp = ZP + ((size_t)((seg * 4 + head) * 128 + l31)) * 64 + 8 * hf;
    const float* rp = PF + (size_t)t * PROJF + 256 + head * 64 + 8 * hf;
#pragma unroll
    for (int ks = 0; ks < 4; ++ks) {
      const bf16x8 bfrag = pack8(*(const float4*)(rp + 16 * ks), *(const float4*)(rp + 16 * ks + 4));
      const bf16x8 a0 = pack8(*(const float4*)(sp + 16 * ks), *(const float4*)(sp + 16 * ks + 4));
      const bf16x8 a1 = pack8(*(const float4*)(sp + 32 * 64 + 16 * ks), *(const float4*)(sp + 32 * 64 + 16 * ks + 4));
      acc0 = __builtin_amdgcn_mfma_f32_32x32x16_bf16(a0, bfrag, acc0, 0, 0, 0);
      acc1 = __builtin_amdgcn_mfma_f32_32x32x16_bf16(a1, bfrag, acc1, 0, 0, 0);
    }
  }
  float sum = 0.f;
#pragma unroll
  for (int g = 0; g < 4; ++g) {
    const float4 ya = yA[g], yb = yB[g];
    acc0[4 * g + 0] += ya.x; acc0[4 * g + 1] += ya.y; acc0[4 * g + 2] += ya.z; acc0[4 * g + 3] += ya.w;
    acc1[4 * g + 0] += yb.x; acc1[4 * g + 1] += yb.y; acc1[4 * g + 2] += yb.z; acc1[4 * g + 3] += yb.w;
  }
#pragma unroll
  for (int r = 0; r < 16; ++r) sum += acc0[r] + acc1[r];
  sum += __shfl_xor(sum, 32);
  const float mean = sum * (1.f / 64.f);
  float var = 0.f;
#pragma unroll
  for (int r = 0; r < 16; ++r) { const float d0 = acc0[r] - mean, d1 = acc1[r] - mean; var += d0 * d0 + d1 * d1; }
  var += __shfl_xor(var, 32);
  const float rstd = rsqrtf(var * (1.f / 64.f) + 64e-5f);
#pragma unroll
  for (int mt = 0; mt < 2; ++mt)
#pragma unroll
    for (int g = 0; g < 4; ++g) {
      const int c = cb + mt * 32 + 8 * g;
      const float4 lw = *(const float4*)(p.ln_w + l * 256 + c), lb = *(const float4*)(p.ln_b + l * 256 + c);
      const uint2 vv = vvl[mt * 4 + g];
      const uint2 gg = ggl[mt * 4 + g];
      float o0 = (mt ? acc1[4 * g + 0] : acc0[4 * g + 0]), o1 = (mt ? acc1[4 * g + 1] : acc0[4 * g + 1]);
      float o2 = (mt ? acc1[4 * g + 2] : acc0[4 * g + 2]), o3 = (mt ? acc1[4 * g + 3] : acc0[4 * g + 3]);
      o0 = (o0 - mean) * rstd * lw.x + lb.x + bon * bflo(vv.x);
      o1 = (o1 - mean) * rstd * lw.y + lb.y + bon * bfhi(vv.x);
      o2 = (o2 - mean) * rstd * lw.z + lb.z + bon * bflo(vv.y);
      o3 = (o3 - mean) * rstd * lw.w + lb.w + bon * bfhi(vv.y);
      o0 *= silu(bflo(gg.x)); o1 *= silu(bfhi(gg.x)); o2 *= silu(bflo(gg.y)); o3 *= silu(bfhi(gg.y));
      *(uint2*)(MIX + (size_t)t * 1024 + 512 + c) = make_uint2(pack2(o0, o1), pack2(o2, o3));
    }
}

#define LDS_BYTES (131072 + 16)
#ifndef REP_G1
#define REP_G1 1
#endif
#ifndef REP_G2
#define REP_G2 1
#endif
#ifndef REP_P3
#define REP_P3 1
#endif
#ifndef REP_SCAN
#define REP_SCAN 1
#endif
#ifndef REP_GO
#define REP_GO 1
#endif
#ifndef REP_FIN
#define REP_FIN 1
#endif
#define PAIR_LOOP(N, BODY) for (int _pr = blockIdx.x; _pr < (N) / 2; _pr += gridDim.x) { const int it = 2 * _pr + vb; BODY }
__global__ void __launch_bounds__(512) fwd_megakernel(Params p) {
  cg::grid_group grid = cg::this_grid();
  extern __shared__ __attribute__((aligned(16))) unsigned char dsm[];
  const int vb = __builtin_amdgcn_readfirstlane(threadIdx.x >> 8);
  unsigned char* smem = dsm + vb * 65536;
  if (threadIdx.x == 0) *(uint4*)(dsm + 131072) = make_uint4(0u, 0u, 0u, 0u);
  __syncthreads();
  const XcdBarrier xb = xcd_barrier_post((unsigned*)(p.ws + OFF_BAR), (volatile LAS unsigned*)(dsm + 131072));
#define GSYNC() xcd_barrier(xb)
#ifndef PH
#define PH 0xffff
#endif
  if (PH & 1) PAIR_LOOP(384, phase_mod_item(p, it, smem);)
  if (PH & 2) PAIR_LOOP(4480, phase_wconv_item(p, it, smem);)
  if (PH & 2) PAIR_LOOP(8, phase_w2t_item(p, it);)
  grid.sync();
  if (PH & 4) phase_h0(p);
  GSYNC();
#pragma unroll 1
  for (int hl = 0; hl < 8; ++hl) {
    const int l = hl >> 1;
    const bool second = hl & 1;
    if (PH & 8) {
      pg8::Gemm g; g.M = T_; g.K = 1024;
      pg8::EpiU E; E.O = (void*)(p.ws + OFF_PROJ);
      if (!second) { g.A = (const u16*)(p.ws + OFF_H); g.Bt = (const u16*)(p.ws + OFF_WALL) + (size_t)l * NALL * 1024; g.N = 3584; E.ldc = NALL; E.ncols = NALL; E.f32out = 0; }
      else { g.A = (const u16*)(p.ws + OFF_MIX); g.Bt = (const u16*)(p.ws + OFF_WOUT) + (size_t)l * 1024 * 1024; g.N = 1024; E.ldc = 1024; E.ncols = 1024; E.f32out = 0; }
      pg8::StaticOrder S; S.init(T_, g.N, gridDim.x, blockIdx.x);
      const int nrep = second ? REP_G2 : REP_G1;
#pragma unroll 1
      for (int rep = 0; rep < nrep; ++rep)
      pg8::gemm_phase<pg8::EpiU, pg8::StaticOrder, false>((PG8_LAS unsigned char*)dsm, g, S, E, nullptr);
    }
    GSYNC();
    if (!second) {
#pragma unroll 1
      for (int rep = 0; rep < REP_P3; ++rep)
      PAIR_LOOP(3072,
        if (it < 1024) { if (PH & 16) attn_item(p, l, it, smem); }
        else if (it < 2048) { if (PH & 32) rwkv_prep_item(p, l, it - 1024, smem); }
        else { if (PH & 64) gla_local_item(p, l, it - 2048, smem); }
      )
      GSYNC();
      {
        GLA_STATE_LOAD(blockIdx.x)
#pragma unroll 1
        for (int rep = 0; rep < REP_SCAN; ++rep)
        if (PH & 256) rwkv_scan_item(p, blockIdx.x, dsm);
        __syncthreads();
        if (PH & 128) GLA_STATE_FINISH(dsm)
      }
      GSYNC();
      if (blockIdx.x < 32) { if (PH & 512) rwkv_combine(p, dsm); }
#pragma unroll 1
      for (int rep = 0; rep < REP_GO; ++rep)
      if (PH & 1024) {
        unsigned* ctr = (unsigned*)(p.ws + OFF_BAR) + 32 + l;
        volatile unsigned* slot = (volatile unsigned*)(dsm + 131072) + 2;
        for (;;) {
          if (threadIdx.x == 0) *slot = atomicAdd(ctr, 1u);
          __syncthreads();
          const unsigned pr = (unsigned)__builtin_amdgcn_readfirstlane((int)*slot);
          __syncthreads();
          if (pr >= 512u) break;
          gla_out_item(p, l, 2 * (int)pr + vb, smem);
        }
      }
      GSYNC();
#pragma unroll 1
      for (int rep = 0; rep < REP_FIN; ++rep)
      if (PH & 2048) PAIR_LOOP(NSEG * 4 * (SL / 128), rwkv_final_item(p, l, it, smem);)
      GSYNC();
    } else {
      if (PH & 8192) phase_post(p, l);
      if (hl < 7) GSYNC();
    }
  }
}

extern "C" void kernel_launch(void* const* d_in, const int* in_sizes, int n_in, void* d_out, int out_size, void* d_ws, size_t ws_size,
                              hipStream_t stream) {
  static int grid_blocks = 0;
  if (!grid_blocks) {
    int dev = 0, cus = 0, per_cu = 0;
    (void)hipGetDevice(&dev);
    (void)hipDeviceGetAttribute(&cus, hipDeviceAttributeMultiprocessorCount, dev);
    (void)hipFuncSetAttribute((const void*)fwd_megakernel, hipFuncAttributeMaxDynamicSharedMemorySize, LDS_BYTES);
    (void)hipOccupancyMaxActiveBlocksPerMultiprocessor(&per_cu, fwd_megakernel, 512, LDS_BYTES);
    if (per_cu < 1) per_cu = 1;
    grid_blocks = cus;
    if (grid_blocks != 256) { fprintf(stderr, "kernel_launch: built for a 256-CU device (got %d)\n", cus); grid_blocks = -1; }
  }
  if (grid_blocks < 0) return;
  if (n_in != 27 || ws_size < WS_END) {
    fprintf(stderr, "kernel_launch: unexpected n_in %d / ws %zu\n", n_in, ws_size);
    return;
  }
  Params p{};
  const float** pp = (const float**)&p;
  for (int i = 0; i < 27; ++i) pp[i] = (const float*)d_in[i];
  p.out = (float*)d_out;
  p.ws = (unsigned char*)d_ws;
  (void)hipMemsetAsync((unsigned char*)d_ws + OFF_BAR, 0, XCD_BAR_WORDS * 4, stream);
  void* args[] = {&p};
  hipError_t e = hipLaunchCooperativeKernel((void*)fwd_megakernel, dim3(grid_blocks), dim3(512), args, LDS_BYTES, stream);
  if (e != hipSuccess) fprintf(stderr, "cooperative launch failed: %s (grid %d)\n", hipGetErrorString(e), grid_blocks);
}
```

```cpp
#include <hip/hip_runtime.h>
#include <hip/hip_bf16.h>
#include <hip/hip_cooperative_groups.h>
#include <cstdio>
namespace cg = cooperative_groups;

typedef unsigned short u16;
using bf16x8 = __attribute__((ext_vector_type(8))) short;
using f32x4 = __attribute__((ext_vector_type(4))) float;
using f32x16 = __attribute__((ext_vector_type(16))) float;

#define T_ 16384
#define NALL 3456
#define NSEG 64
#define SL (T_ / NSEG)
#define PROJF 1728

#define OFF_WALL 0ull
#define OFF_WOUT 28311552ull
#define OFF_MOD 36700160ull
#define OFF_H 36749312ull
#define OFF_RWW OFF_H
#define OFF_RWKK (OFF_H + 16777216ull)
#define OFF_PROJ 70303744ull
#define OFF_MIX 183549952ull
#define OFF_RWB 217104384ull
#define OFF_GLAS 250658816ull
#define OFF_GLAD 259047424ull
#define OFF_BONUS 259178496ull
#define OFF_ZP 259440640ull
#define OFF_BAR 267829248ull
#define OFF_W2T 267845632ull
#define OFF_A2T 267976704ull
#define WS_END 268107776ull


struct Params {
  const float *x, *c, *ada_w, *ada_b, *norm_pre, *norm_post, *w_in, *w_out, *sinks, *mu_rkv, *mu_w, *mu_a, *w0, *w1, *w2,
      *a0, *a1, *a2, *k_k, *k_a, *r_k, *ln_w, *ln_b, *gk1, *gk2, *gk_b, *gla_nw;
  float* out;
  unsigned char* ws;
};

__device__ __forceinline__ u16 f2bf(float f) {
  unsigned u = __float_as_uint(f);
  u += 0x7fffu + ((u >> 16) & 1u);
  return (u16)(u >> 16);
}
__device__ __forceinline__ float bf2f(u16 h) { return __uint_as_float(((unsigned)h) << 16); }
__device__ __forceinline__ unsigned pack2(float a, float b) { return (unsigned)f2bf(a) | ((unsigned)f2bf(b) << 16); }
__device__ __forceinline__ float bflo(unsigned u) { return __uint_as_float(u << 16); }
__device__ __forceinline__ float bfhi(unsigned u) { return __uint_as_float(u & 0xffff0000u); }

__device__ __forceinline__ float frcp(float x) { return __builtin_amdgcn_rcpf(x); }
__device__ __forceinline__ float silu(float x) { return x * frcp(1.f + __expf(-x)); }
__device__ __forceinline__ float sigmoidf_(float x) { return frcp(1.f + __expf(-x)); }
__device__ __forceinline__ float softplusf_(float z) { return fmaxf(z, 0.f) + __logf(1.f + __expf(-fabsf(z))); }
__device__ __forceinline__ float tanh_fast(float x) { return 1.f - 2.f * frcp(1.f + __expf(2.f * x)); }

__device__ __forceinline__ int opq(int x) { asm volatile("" : "+s"(x)); return x; }
__device__ __forceinline__ int opaque_tid() { int t = threadIdx.x & 255; asm volatile("" : "+v"(t)); return t; }
__device__ __forceinline__ int opaque_tid512() { int t = threadIdx.x; asm volatile("" : "+v"(t)); return t; }
template <int CTRL>
__device__ __forceinline__ float dpp_f(float x) {
  return __builtin_bit_cast(float, __builtin_amdgcn_update_dpp(0, __builtin_bit_cast(int, x), CTRL, 0xf, 0xf, true));
}
__device__ __forceinline__ float row16_allsum(float x) {
  x += dpp_f<0x128>(x);
  x += dpp_f<0x124>(x);
  x += dpp_f<0x122>(x);
  x += dpp_f<0x121>(x);
  return x;
}
__device__ __forceinline__ float wave_sum(float v) {
  v = row16_allsum(v);
  const int iv = __builtin_bit_cast(int, v);
  const float a = __builtin_bit_cast(float, __builtin_amdgcn_readlane(iv, 0)), b = __builtin_bit_cast(float, __builtin_amdgcn_readlane(iv, 16));
  const float c = __builtin_bit_cast(float, __builtin_amdgcn_readlane(iv, 32)), d = __builtin_bit_cast(float, __builtin_amdgcn_readlane(iv, 48));
  return (a + b) + (c + d);
}

namespace pg8 {
#define PG8_LAS __attribute__((address_space(3)))
typedef unsigned short bf16_t;
typedef short bf16x8 __attribute__((ext_vector_type(8)));
typedef float f32x4 __attribute__((ext_vector_type(4)));
typedef unsigned u32x4 __attribute__((ext_vector_type(4)));
constexpr int BM = 256, BK = 64, HALF = 128, HTB = HALF * BK * 2  , STAGE_BYTES = 8 * HTB, NXCD = 8, WGM = 8;

__host__ __device__ __forceinline__ int lds_byte(int r, int c) { const int st = (r >> 4) * 2 + (c >> 5), rr = r & 15, cc = c & 31, ob = rr * 64 + cc * 2; return st * 1024 + (ob ^ (((ob >> 9) & 1) << 5)); }
__host__ __device__ __forceinline__ void stage_rc(int b, int& R, int& C) { const int st = b / 1024, sb = b % 1024, swz = sb ^ (((sb >> 9) & 1) << 5); R = (st >> 1) * 16 + swz / 64; C = (st & 1) * 32 + (swz % 64) / 2; }
__host__ __device__ __forceinline__ int perm32(int rho) { const int n = rho >> 4, i = rho & 15; return 8 * (i >> 2) + 4 * n + (i & 3); }

struct Unit { int pm, pn; };
struct Gemm { const bf16_t* A; const bf16_t* Bt; int M, N, K; };

struct StaticOrder {
    int nM, nN, nwg, G, c;
    __host__ __device__ void init(int M, int N, int G_, int c_) { nM = M / BM; nN = N / BM; nwg = nM * nN; G = G_; c = c_; }
    __host__ __device__ bool next(int i, Unit& u) const {
        const long L = (long)i * G + c; if (L >= nwg) return false;
        int wgid = (int)L; { const int q = nwg / NXCD, r = nwg % NXCD, xcd = wgid % NXCD, off = wgid / NXCD; wgid = (xcd < r ? xcd * (q + 1) : r * (q + 1) + (xcd - r) * q) + off; }
        const int nig = WGM * nN, gid = wgid / nig, fm = gid * WGM, gsz = (nM - fm) < WGM ? (nM - fm) : WGM;
        u.pm = fm + ((wgid % nig) % gsz); u.pn = (wgid % nig) / gsz; return true;
    }
    __device__ __forceinline__ void a_ready(const Unit&) const {}
    __device__ __forceinline__ void done(const Unit&) const {}
};
__device__ __forceinline__ unsigned cvt_pk_bf16(float lo, float hi) { unsigned r; asm volatile("v_cvt_pk_bf16_f32 %0, %1, %2" : "=v"(r) : "v"(lo), "v"(hi)); return r; }
template <class Epi, class Sched, bool STAMP = false>
__device__ __forceinline__ void gemm_phase(PG8_LAS unsigned char* lds, const Gemm g, const Sched& S, const Epi& E, unsigned long long* stamps) {
    const int tid = threadIdx.x, wid = __builtin_amdgcn_readfirstlane(tid >> 6), lane = tid & 63, wr = wid >> 2, wc = wid & 3, fr = lane & 15, fq = lane >> 4;
    const int K = g.K, nt = K / BK;
    int ts_lo = 0, ts_hi = 0, nts = 0; const unsigned long long rt_entry = STAMP ? (unsigned long long)wall_clock64() : 0ull;
#define PG8_STAMP() do { if (STAMP && wid == 0 && nts < 64) { const unsigned long long _c = (unsigned long long)clock64(); \
        ts_lo = (lane == nts) ? (int)(unsigned)_c : ts_lo; ts_hi = (lane == nts) ? (int)(unsigned)(_c >> 32) : ts_hi; ++nts; } } while (0)
    PG8_STAMP();
    unsigned voffA[2], voffB[2];
#pragma unroll
    for (int i = 0; i < 2; ++i) { int R, C; stage_rc(tid * 16 + i * 8192, R, C); const int Rb = Epi::PERM ? ((R & ~31) + perm32(R & 31)) : R;
        voffA[i] = (unsigned)(R * K + C) * 2u; voffB[i] = (unsigned)(Rb * K + C) * 2u; }
    const size_t kstep = (size_t)(BK * 2);
    const size_t hstep = (size_t)HALF * K * 2;
    const size_t tstep = 2 * hstep;
    const unsigned ldsw = (unsigned)wid * 1024u;
    const int aoff = lds_byte(wr * 64 + fr, fq * 8), boff = lds_byte(wc * 32 + fr, fq * 8);
#define PG8_SA(b, h) (((b) * 2 + (h)) * HTB)
#define PG8_SB(b, h) ((4 + (b) * 2 + (h)) * HTB)
#define PG8_STAGE(bufoff, gbase, voff) do { _Pragma("unroll") for (int _i = 0; _i < 2; ++_i) \
        __builtin_amdgcn_global_load_lds((const unsigned*)((const char*)(gbase) + (voff)[_i]), (PG8_LAS unsigned*)(lds + (bufoff) + ldsw + _i * 8192), 16, 0, 0); } while (0)
#define PG8_LDA(dst, b, h) do { _Pragma("unroll") for (int m = 0; m < 4; ++m) _Pragma("unroll") for (int k = 0; k < 2; ++k) dst[m][k] = *(const PG8_LAS bf16x8*)(lds + PG8_SA(b, h) + aoff + m * 2048 + k * 1024); } while (0)
#define PG8_LDB(dst, b, h) do { _Pragma("unroll") for (int n = 0; n < 2; ++n) _Pragma("unroll") for (int k = 0; k < 2; ++k) dst[n][k] = *(const PG8_LAS bf16x8*)(lds + PG8_SB(b, h) + boff + n * 2048 + k * 1024); } while (0)
#define PG8_MMA(ai, bj, At, Bt) do { __builtin_amdgcn_s_setprio(1); _Pragma("unroll") for (int m = 0; m < 4; ++m) _Pragma("unroll") for (int n = 0; n < 2; ++n) _Pragma("unroll") for (int k = 0; k < 2; ++k) \
        acc[ai][bj][m][n] = __builtin_amdgcn_mfma_f32_16x16x32_bf16(Bt[n][k], At[m][k], acc[ai][bj][m][n], 0, 0, 0); __builtin_amdgcn_s_setprio(0); } while (0)
#define PG8_WAIT_V(n) asm volatile("s_waitcnt vmcnt(" #n ")" ::: "memory")
#define PG8_WAIT_L(n) asm volatile("s_waitcnt lgkmcnt(" #n ")" ::: "memory")
#define PG8_BAR __builtin_amdgcn_s_barrier()
#define PG8_SCHED __builtin_amdgcn_sched_barrier(0)
    Unit cur, nxt; int ui = 0;
    if (!S.next(0, cur)) return;
    f32x4 acc[2][2][4][2];
#pragma unroll
    for (int a = 0; a < 2; ++a)
#pragma unroll
        for (int b = 0; b < 2; ++b)
#pragma unroll
            for (int m = 0; m < 4; ++m)
#pragma unroll
                for (int n = 0; n < 2; ++n) acc[a][b][m][n] = (f32x4){0.f, 0.f, 0.f, 0.f};
    bf16x8 At[4][2], B0[2][2], B1[2][2];
    const char* cA = (const char*)g.A + (size_t)cur.pm * tstep; const char* cB = (const char*)g.Bt + (size_t)cur.pn * tstep;
    S.a_ready(cur);
    PG8_STAGE(PG8_SB(0, 0), cB, voffB); PG8_STAGE(PG8_SA(0, 0), cA, voffA); PG8_STAGE(PG8_SB(0, 1), cB + hstep, voffB); PG8_STAGE(PG8_SA(0, 1), cA + hstep, voffA);
    if (wr == 1) PG8_BAR;
    PG8_WAIT_V(4); PG8_BAR;
    PG8_STAGE(PG8_SB(1, 0), cB + kstep, voffB); PG8_STAGE(PG8_SA(1, 0), cA + kstep, voffA); PG8_STAGE(PG8_SB(1, 1), cB + hstep + kstep, voffB);
    PG8_WAIT_V(6); PG8_BAR;
    PG8_STAMP();
    for (;;) {
        const bool has_next = S.next(ui + 1, nxt);
        const char* nA = has_next ? (const char*)g.A + (size_t)nxt.pm * tstep : cA; const char* nB = has_next ? (const char*)g.Bt + (size_t)nxt.pn * tstep : cB;
        for (int t = 0; t < nt; t += 2) {
            const bool last = (t == nt - 2);
            const char* a1 = cA + (size_t)(t + 1) * kstep;
            const char* a2 = last ? nA : cA + (size_t)(t + 2) * kstep; const char* b2 = last ? nB : cB + (size_t)(t + 2) * kstep;
            const char* a3 = a2 + kstep; const char* b3 = b2 + kstep;
            if (last && has_next) S.a_ready(nxt);
            PG8_LDB(B0, 0, 0); PG8_SCHED; PG8_LDA(At, 0, 0); PG8_STAGE(PG8_SA(1, 1), a1 + hstep, voffA);
            PG8_WAIT_L(8); PG8_BAR; PG8_WAIT_L(0); PG8_MMA(0, 0, At, B0); PG8_BAR; PG8_SCHED;
            PG8_LDB(B1, 0, 1); PG8_STAGE(PG8_SB(0, 0), b2, voffB);
            PG8_BAR; PG8_WAIT_L(0); PG8_MMA(0, 1, At, B1); PG8_BAR;
            PG8_LDA(At, 0, 1); PG8_STAGE(PG8_SA(0, 0), a2, voffA);
            PG8_BAR; PG8_WAIT_L(0); PG8_MMA(1, 0, At, B0); PG8_BAR; PG8_SCHED;
            PG8_STAGE(PG8_SB(0, 1), b2 + hstep, voffB);
            PG8_WAIT_V(6); PG8_BAR; PG8_MMA(1, 1, At, B1); PG8_BAR;
            PG8_LDB(B0, 1, 0); PG8_SCHED; PG8_LDA(At, 1, 0); PG8_STAGE(PG8_SA(0, 1), a2 + hstep, voffA);
            PG8_WAIT_L(8); PG8_BAR; PG8_WAIT_L(0); PG8_MMA(0, 0, At, B0); PG8_BAR; PG8_SCHED;
            PG8_LDB(B1, 1, 1); PG8_STAGE(PG8_SB(1, 0), b3, voffB);
            PG8_BAR; PG8_WAIT_L(0); PG8_MMA(0, 1, At, B1); PG8_BAR;
            PG8_LDA(At, 1, 1); PG8_STAGE(PG8_SA(1, 0), a3, voffA);
            PG8_BAR; PG8_WAIT_L(0); PG8_MMA(1, 0, At, B0); PG8_BAR; PG8_SCHED;
            PG8_STAGE(PG8_SB(1, 1), b3 + hstep, voffB);
            PG8_WAIT_V(6); PG8_BAR; PG8_MMA(1, 1, At, B1); PG8_BAR;
        }
        PG8_STAMP();
        if constexpr (!Epi::AFTER_DRAIN) { E(acc, cur, wr, wc, fr, fq); S.done(cur); }
        PG8_STAMP();
        if (!has_next) break;
#pragma unroll
        for (int a = 0; a < 2; ++a)
#pragma unroll
            for (int b = 0; b < 2; ++b)
#pragma unroll
                for (int m = 0; m < 4; ++m)
#pragma unroll
                    for (int n = 0; n < 2; ++n) acc[a][b][m][n] = (f32x4){0.f, 0.f, 0.f, 0.f};
        cur = nxt; cA = nA; cB = nB; ++ui;
    }
    PG8_WAIT_V(0);
    if (wr == 0) PG8_BAR;
    PG8_BAR;
    if constexpr (Epi::AFTER_DRAIN) { E.fused(acc, cur, wr, wc, fr, fq, lds, wid, lane); S.done(cur); }
    PG8_STAMP();
    if (STAMP && wid == 0) { stamps[lane] = lane < nts ? (((unsigned long long)(unsigned)ts_hi << 32) | (unsigned)ts_lo) : 0ull;
        if (lane == 62) stamps[62] = rt_entry; if (lane == 63) stamps[63] = (unsigned long long)wall_clock64(); }
#undef PG8_STAMP
#undef PG8_SA
#undef PG8_SB
#undef PG8_STAGE
#undef PG8_LDA
#undef PG8_LDB
#undef PG8_MMA
#undef PG8_WAIT_V
#undef PG8_WAIT_L
#undef PG8_BAR
#undef PG8_SCHED
}
}

namespace pg8 {
struct EpiProj {
    static constexpr bool PERM = true, AFTER_DRAIN = false;
    bf16_t* O; int ldc; int ncols;
    __device__ __forceinline__ void operator()(const f32x4 (&acc)[2][2][4][2], const Unit& u, int wr, int wc, int fr, int fq) const {
        const int row0 = u.pm * BM + wr * 64 + fr; const int col0 = u.pn * BM + wc * 32 + 8 * fq;
#pragma unroll
        for (int ai = 0; ai < 2; ++ai)
#pragma unroll
            for (int m = 0; m < 4; ++m) { bf16_t* rowp = O + (size_t)(row0 + ai * HALF + m * 16) * ldc + col0;
#pragma unroll
                for (int bj = 0; bj < 2; ++bj) { const f32x4 v0 = acc[ai][bj][m][0], v1 = acc[ai][bj][m][1];
                    u32x4 w; w.x = cvt_pk_bf16(v0[0], v0[1]); w.y = cvt_pk_bf16(v0[2], v0[3]); w.z = cvt_pk_bf16(v1[0], v1[1]); w.w = cvt_pk_bf16(v1[2], v1[3]);
                    if (col0 + bj * HALF < ncols) *(u32x4*)(rowp + bj * HALF) = w; } }
    }
};
struct EpiU {
    static constexpr bool PERM = true, AFTER_DRAIN = false;
    void* O; int ldc; int ncols; int f32out;
    __device__ __forceinline__ void operator()(const f32x4 (&acc)[2][2][4][2], const Unit& u, int wr, int wc, int fr, int fq) const {
        const int row0 = u.pm * BM + wr * 64 + fr; const int col0 = u.pn * BM + wc * 32 + 8 * fq;
        if (f32out) {
#pragma unroll
            for (int ai = 0; ai < 2; ++ai)
#pragma unroll
                for (int m = 0; m < 4; ++m) { float* rowp = (float*)O + (size_t)(row0 + ai * HALF + m * 16) * ldc + col0;
#pragma unroll
                    for (int bj = 0; bj < 2; ++bj) { *(f32x4*)(rowp + bj * HALF) = acc[ai][bj][m][0]; *(f32x4*)(rowp + bj * HALF + 4) = acc[ai][bj][m][1]; } }
        } else {
#pragma unroll
            for (int ai = 0; ai < 2; ++ai)
#pragma unroll
                for (int m = 0; m < 4; ++m) { bf16_t* rowp = (bf16_t*)O + (size_t)(row0 + ai * HALF + m * 16) * ldc + col0;
#pragma unroll
                    for (int bj = 0; bj < 2; ++bj) { const f32x4 v0 = acc[ai][bj][m][0], v1 = acc[ai][bj][m][1];
                        u32x4 w; w.x = cvt_pk_bf16(v0[0], v0[1]); w.y = cvt_pk_bf16(v0[2], v0[3]); w.z = cvt_pk_bf16(v1[0], v1[1]); w.w = cvt_pk_bf16(v1[2], v1[3]);
                        if (col0 + bj * HALF < ncols) *(u32x4*)(rowp + bj * HALF) = w; } }
        }
    }
};
}

#define XB_TMO      128
#define XB_XCNT(j)  (256  + 64 * (j))
#define XB_XSUB(j)  (1280 + 64 * (j))
#define XB_XGEN(j)  (2304 + 64 * (j))
#define XB_TOP      3328
#define XB_TOPGEN   3392
#define XCD_BAR_WORDS 3456
#define XB_SPIN_CAP (1u << 18)
#define LAS __attribute__((address_space(3)))

__device__ __forceinline__ unsigned xb_ld(unsigned* p)              { return __hip_atomic_load(p, __ATOMIC_RELAXED, __HIP_MEMORY_SCOPE_AGENT); }
__device__ __forceinline__ unsigned xb_add(unsigned* p, unsigned v) { return __hip_atomic_fetch_add(p, v, __ATOMIC_RELAXED, __HIP_MEMORY_SCOPE_AGENT); }
__device__ __forceinline__ unsigned xb_xcc_id() { return (unsigned)__builtin_amdgcn_s_getreg((3 << 11) | 20) & 0xFu; }
#define XB_SPIN(cond, bar) do { unsigned _sp = 0; while (cond) { __builtin_amdgcn_s_sleep(1); \
    if ((++_sp & 255u) == 0u) { if (xb_ld(&(bar)[XB_TMO])) break; if (_sp > XB_SPIN_CAP) { atomicAdd(&(bar)[XB_TMO], 1u); break; } } } } while (0)

struct XcdBarrier {
    unsigned* bar; unsigned x;
    volatile LAS unsigned* st;
};

__device__ __forceinline__ XcdBarrier xcd_barrier_post(unsigned* bar, volatile LAS unsigned* st) {
    XcdBarrier b; b.bar = bar; b.x = xb_xcc_id(); b.st = st;
    if (threadIdx.x == 0) (void)xb_add(&bar[XB_XCNT(b.x)], 1u);
    return b;
}
__device__ __forceinline__ void xcd_barrier_complete(unsigned* bar, unsigned x, unsigned& nloc, unsigned& nx) {
    const unsigned G = gridDim.x * gridDim.y * gridDim.z;
    unsigned sum, cnt, mine, sp = 0u;
    for (;;) {
        sum = 0u; cnt = 0u; mine = 0u;
#pragma unroll
        for (unsigned j = 0; j < 16; ++j) { const unsigned c = xb_ld(&bar[XB_XCNT(j)]); sum += c; cnt += (c > 0u) ? 1u : 0u; mine = (j == x) ? c : mine; }
        if (sum == G) break;
        __builtin_amdgcn_s_sleep(1);
        if ((++sp & 255u) == 0u) { if (xb_ld(&bar[XB_TMO])) break; if (sp > XB_SPIN_CAP) { atomicAdd(&bar[XB_TMO], 1u); break; } }
    }
    nloc = mine > 0u ? mine : 1u; nx = cnt > 0u ? cnt : 1u;
}

__device__ __forceinline__ void xcd_barrier(const XcdBarrier& b) {
    asm volatile("s_waitcnt vmcnt(0)" ::: "memory");
    __syncthreads();
    if (threadIdx.x == 0) {
        unsigned* bar = b.bar;
        __builtin_amdgcn_s_waitcnt(0);
        unsigned nloc = b.st[0], nx = b.st[1];
        if (nloc == 0u) { xcd_barrier_complete(bar, b.x, nloc, nx); b.st[0] = nloc; b.st[1] = nx; }
        const unsigned old = xb_add(&bar[XB_XSUB(b.x)], 1u);
        const unsigned gen = old / nloc;
        if (old + 1u == (gen + 1u) * nloc) {
            __builtin_amdgcn_fence(__ATOMIC_RELEASE, "agent");
            asm volatile("s_waitcnt vmcnt(0)" ::: "memory");
            const unsigned og = xb_add(&bar[XB_TOP], 1u);
            const unsigned tg = og / nx;
            if (og + 1u == (tg + 1u) * nx) xb_add(&bar[XB_TOPGEN], 1u);
            else XB_SPIN(xb_ld(&bar[XB_TOPGEN]) == tg, bar);
            __builtin_amdgcn_fence(__ATOMIC_ACQUIRE, "agent");
            xb_add(&bar[XB_XGEN(b.x)], 1u);
            asm volatile("s_waitcnt vmcnt(0)" ::: "memory");
        } else {
            XB_SPIN(xb_ld(&bar[XB_XGEN(b.x)]) == gen, bar);
            __builtin_amdgcn_fence(__ATOMIC_ACQUIRE, "agent");
            asm volatile("s_waitcnt vmcnt(0)" ::: "memory");
        }
    }
    __syncthreads();
}

__device__ void phase_mod_item(const Params& p, int it, unsigned char* smem) {
  float* red = (float*)smem;
  const int tid = opaque_tid(), tx = tid & 31, ty = tid >> 5;
  float* mod = (float*)(p.ws + OFF_MOD);
  it = opq(it);
  {
    int l = it / 96;
    int j = (it % 96) * 32 + tx;
    const float* W = p.ada_w + (size_t)l * 1024 * 3072;
    float* cs = red + 256;
#pragma unroll
    for (int i = 0; i < 4; ++i) cs[tid + 256 * i] = silu(p.c[tid + 256 * i]);
    __syncthreads();
    float acc = 0.f;
#pragma unroll 1
    for (int i0 = 0; i0 < 128; i0 += 16) {
      float wv[16];
#pragma unroll
      for (int i = 0; i < 16; ++i) wv[i] = W[(size_t)(ty * 128 + i0 + i) * 3072 + j];
#pragma unroll
      for (int i = 0; i < 16; ++i) acc += cs[ty * 128 + i0 + i] * wv[i];
    }
    red[ty * 32 + tx] = acc;
    __syncthreads();
    if (ty == 0) {
      float s = 0.f;
      for (int g = 0; g < 8; ++g) s += red[g * 32 + tx];
      mod[l * 3072 + j] = s + p.ada_b[l * 3072 + j];
    }
    __syncthreads();
  }
}

__device__ __forceinline__ float wall_src(const Params& p, int l, int k, int n) {
  size_t lk = (size_t)l * 1024 + k;
  if (n < 3072) return p.w_in[lk * 3072 + n];
  if (n < 3136) return (1.f - p.mu_w[lk]) * p.w1[lk * 64 + (n - 3072)];
  if (n < 3200) return p.mu_w[lk] * p.w1[lk * 64 + (n - 3136)];
  if (n < 3264) return (1.f - p.mu_a[lk]) * p.a1[lk * 64 + (n - 3200)];
  if (n < 3328) return p.mu_a[lk] * p.a1[lk * 64 + (n - 3264)];
  if (n < 3344) return p.gk1[lk * 16 + (n - 3328)];
  return 0.f;
}

__device__ void phase_wconv_item(const Params& p, int it, unsigned char* smem) {
  float* tile = (float*)smem;
  const int tid = opaque_tid();
  u16* WALL = (u16*)(p.ws + OFF_WALL);
  u16* WOUT = (u16*)(p.ws + OFF_WOUT);
  it = opq(it);
  {
    bool isout = it >= 3456;
    int l, nt, kt;
    if (!isout) { l = it / 864; int r = it % 864; nt = r >> 4; kt = r & 15; }
    else { int r = it - 3456; l = r >> 8; r &= 255; nt = r >> 4; kt = r & 15; }
    if (isout || nt < 48) {
      const float* src = isout ? p.w_out + (size_t)l * 1024 * 1024 : p.w_in + (size_t)l * 1024 * 3072;
      const int ld = isout ? 1024 : 3072;
      const int n4 = (tid & 15) * 4, k0 = tid >> 4;
      float4 v4[4];
#pragma unroll
      for (int i = 0; i < 4; ++i) v4[i] = *(const float4*)(src + (size_t)(kt * 64 + k0 + 16 * i) * ld + nt * 64 + n4);
#pragma unroll
      for (int i = 0; i < 4; ++i) {
        float* tp = tile + (k0 + 16 * i) * 65 + n4;
        tp[0] = v4[i].x; tp[1] = v4[i].y; tp[2] = v4[i].z; tp[3] = v4[i].w;
      }
    } else {
      int tx = tid & 63, ty = tid >> 6;
#pragma unroll
      for (int i = 0; i < 16; ++i) {
        int kl = ty + 4 * i;
        int k = kt * 64 + kl, n = nt * 64 + tx;
        tile[kl * 65 + tx] = wall_src(p, l, k, n);
      }
    }
    __syncthreads();
    int nl = tid >> 2, kq = tid & 3;
    unsigned w[8];
#pragma unroll
    for (int j = 0; j < 8; ++j) w[j] = pack2(tile[(kq * 16 + 2 * j) * 65 + nl], tile[(kq * 16 + 2 * j + 1) * 65 + nl]);
    u16* dst = (isout ? WOUT + ((size_t)l * 1024 + nt * 64 + nl) * 1024 : WALL + ((size_t)l * NALL + nt * 64 + nl) * 1024) + kt * 64 + kq * 16;
    ((uint4*)dst)[0] = make_uint4(w[0], w[1], w[2], w[3]);
    ((uint4*)dst)[1] = make_uint4(w[4], w[5], w[6], w[7]);
    __syncthreads();
  }
}

__device__ void phase_w2t_item(const Params& p, int it) {
  it = opq(it);
  const int c = opaque_tid();
  const int l = it >> 1, which = it & 1;
  const float* src = (which ? p.a2 : p.w2) + (size_t)l * 64 * 256 + c;
  u16* dst = (u16*)(p.ws + (which ? OFF_A2T : OFF_W2T)) + ((size_t)l * 256 + c) * 64;
#pragma unroll
  for (int j8 = 0; j8 < 8; ++j8) {
    float f[8];
#pragma unroll
    for (int q = 0; q < 8; ++q) f[q] = src[(j8 * 8 + q) * 256];
    *(uint4*)(dst + j8 * 8) = make_uint4(pack2(f[0], f[1]), pack2(f[2], f[3]), pack2(f[4], f[5]), pack2(f[6], f[7]));
  }
}

__device__ void phase_h0(const Params& p) {
  const int tid = opaque_tid512(); const int wave = tid >> 6, lane = tid & 63;
  const float* mod = (const float*)(p.ws + OFF_MOD);
  u16* H = (u16*)(p.ws + OFF_H);
  float4 hs[4], hh[4];
#pragma unroll
  for (int i = 0; i < 4; ++i) {
    const int col = (lane + 64 * i) * 4;
    const float4 gp = *(const float4*)(p.norm_pre + col), sc = *(const float4*)(mod + 1024 + col);
    hs[i] = make_float4(gp.x * (1.f + sc.x), gp.y * (1.f + sc.y), gp.z * (1.f + sc.z), gp.w * (1.f + sc.w));
    hh[i] = *(const float4*)(mod + col);
  }
  const int stride = gridDim.x * 8;
  int row = blockIdx.x * 8 + wave;
  float4 v[4];
#pragma unroll
  for (int i = 0; i < 4; ++i) v[i] = ((const float4*)(p.x + (size_t)row * 1024))[lane + 64 * i];
  for (; row < T_; row += stride) {
    const int nrow = (row + stride < T_) ? row + stride : row;
    float4 vn[4];
#pragma unroll
    for (int i = 0; i < 4; ++i) vn[i] = ((const float4*)(p.x + (size_t)nrow * 1024))[lane + 64 * i];
    float ss = 0.f;
#pragma unroll
    for (int i = 0; i < 4; ++i) ss += v[i].x * v[i].x + v[i].y * v[i].y + v[i].z * v[i].z + v[i].w * v[i].w;
    ss = wave_sum(ss);
    const float r2 = rsqrtf(ss * (1.f / 1024.f) + 1e-6f);
#pragma unroll
    for (int i = 0; i < 4; ++i) {
      const int col = (lane + 64 * i) * 4;
      const float h0 = v[i].x * r2 * hs[i].x + hh[i].x, h1 = v[i].y * r2 * hs[i].y + hh[i].y;
      const float h2 = v[i].z * r2 * hs[i].z + hh[i].z, h3 = v[i].w * r2 * hs[i].w + hh[i].w;
      *(uint2*)(H + (size_t)row * 1024 + col) = make_uint2(pack2(h0, h1), pack2(h2, h3));
    }
#pragma unroll
    for (int i = 0; i < 4; ++i) v[i] = vn[i];
  }
}

__device__ void phase_post(const Params& p, int l) {
  l = opq(l);
  const int tid = opaque_tid512(); const int wave = tid >> 6, lane = tid & 63;
  const u16* Y = (const u16*)(p.ws + OFF_PROJ);
  const float* mod = (const float*)(p.ws + OFF_MOD) + l * 3072;
  const float* modn = (const float*)(p.ws + OFF_MOD) + (l < 3 ? l + 1 : l) * 3072;
  const float* xold = (l == 0) ? p.x : p.out;
  u16* H = (u16*)(p.ws + OFF_H);
  float4 gg[4], hs[4], hh[4];
#pragma unroll
  for (int i = 0; i < 4; ++i) {
    const int col = (lane + 64 * i) * 4;
    const float4 g = *(const float4*)(p.norm_post + l * 1024 + col), gt = *(const float4*)(mod + 2048 + col);
    gg[i] = make_float4(g.x * gt.x, g.y * gt.y, g.z * gt.z, g.w * gt.w);
    const float4 gp = *(const float4*)(p.norm_pre + (l < 3 ? l + 1 : l) * 1024 + col), sc = *(const float4*)(modn + 1024 + col);
    hs[i] = make_float4(gp.x * (1.f + sc.x), gp.y * (1.f + sc.y), gp.z * (1.f + sc.z), gp.w * (1.f + sc.w));
    hh[i] = *(const float4*)(modn + col);
  }
  const int stride = gridDim.x * 8;
  int row = blockIdx.x * 8 + wave;
  uint2 yu[4]; float4 v[4];
#pragma unroll
  for (int i = 0; i < 4; ++i) { yu[i] = ((const uint2*)(Y + (size_t)row * 1024))[lane + 64 * i]; v[i] = ((const float4*)(xold + (size_t)row * 1024))[lane + 64 * i]; }
  for (; row < T_; row += stride) {
    const int nrow = (row + stride < T_) ? row + stride : row;
    uint2 yn[4]; float4 vn[4];
#pragma unroll
    for (int i = 0; i < 4; ++i) { yn[i] = ((const uint2*)(Y + (size_t)nrow * 1024))[lane + 64 * i]; vn[i] = ((const float4*)(xold + (size_t)nrow * 1024))[lane + 64 * i]; }
    float4 y[4];
    float ss = 0.f;
#pragma unroll
    for (int i = 0; i < 4; ++i) {
      y[i] = make_float4(bflo(yu[i].x), bfhi(yu[i].x), bflo(yu[i].y), bfhi(yu[i].y));
      ss += y[i].x * y[i].x + y[i].y * y[i].y + y[i].z * y[i].z + y[i].w * y[i].w;
    }
    ss = wave_sum(ss);
    const float rs = rsqrtf(ss * (1.f / 1024.f) + 1e-6f);
    float s2 = 0.f;
#pragma unroll
    for (int i = 0; i < 4; ++i) {
      const int col = (lane + 64 * i) * 4;
      v[i].x += gg[i].x * (y[i].x * rs);
      v[i].y += gg[i].y * (y[i].y * rs);
      v[i].z += gg[i].z * (y[i].z * rs);
      v[i].w += gg[i].w * (y[i].w * rs);
      *(float4*)(p.out + (size_t)row * 1024 + col) = v[i];
      s2 += v[i].x * v[i].x + v[i].y * v[i].y + v[i].z * v[i].z + v[i].w * v[i].w;
    }
    if (l < 3) {
      s2 = wave_sum(s2);
      const float r2 = rsqrtf(s2 * (1.f / 1024.f) + 1e-6f);
#pragma unroll
      for (int i = 0; i < 4; ++i) {
        const int col = (lane + 64 * i) * 4;
        const float h0 = v[i].x * r2 * hs[i].x + hh[i].x, h1 = v[i].y * r2 * hs[i].y + hh[i].y;
        const float h2 = v[i].z * r2 * hs[i].z + hh[i].z, h3 = v[i].w * r2 * hs[i].w + hh[i].w;
        *(uint2*)(H + (size_t)row * 1024 + col) = make_uint2(pack2(h0, h1), pack2(h2, h3));
      }
    }
#pragma unroll
    for (int i = 0; i < 4; ++i) { yu[i] = yn[i]; v[i] = vn[i]; }
  }
}

__device__ void attn_item(const Params& p, int l, int item, unsigned char* smem) {
  l = opq(l); item = opq(item);
  u16* Vt = (u16*)smem;
  const u16* PROJ = (const u16*)(p.ws + OFF_PROJ);
  u16* MIX = (u16*)(p.ws + OFF_MIX);
  const int tid = opaque_tid(), w = tid >> 6, lane = tid & 63, l31 = lane & 31, hf = lane >> 5;
  const int qb = item >> 3, head = item & 7, kvh = head >> 2;
  const int kpos0 = (qb - 1) * 128;
  {
    int kp = kpos0 + tid;
    if (kp < 0) kp = 0;
    const uint4* src = (const uint4*)(PROJ + (size_t)kp * NALL + 640 + kvh * 64);
#pragma unroll
    for (int c8 = 0; c8 < 8; ++c8) {
      uint4 v = src[c8];
      int d = c8 * 8;
      Vt[(d + 0) * 264 + tid] = (u16)(v.x & 0xffff);
      Vt[(d + 1) * 264 + tid] = (u16)(v.x >> 16);
      Vt[(d + 2) * 264 + tid] = (u16)(v.y & 0xffff);
      Vt[(d + 3) * 264 + tid] = (u16)(v.y >> 16);
      Vt[(d + 4) * 264 + tid] = (u16)(v.z & 0xffff);
      Vt[(d + 5) * 264 + tid] = (u16)(v.z >> 16);
      Vt[(d + 6) * 264 + tid] = (u16)(v.w & 0xffff);
      Vt[(d + 7) * 264 + tid] = (u16)(v.w >> 16);
    }
  }
  const int tq = qb * 128 + 32 * w + l31;
  bf16x8 qf[4], kc[4];
  {
    const u16* qp = PROJ + (size_t)tq * NALL + head * 64 + 8 * hf;
#pragma unroll
    for (int s = 0; s < 4; ++s) qf[s] = *(const bf16x8*)(qp + 16 * s);
    int kp = kpos0 + 32 * w + l31;
    if (kp < 0) kp = 0;
    const u16* kptr = PROJ + (size_t)kp * NALL + 512 + kvh * 64 + 8 * hf;
#pragma unroll
    for (int s = 0; s < 4; ++s) kc[s] = *(const bf16x8*)(kptr + 16 * s);
  }
  __syncthreads();
  const float slope = exp2f(-(float)(head + 1));
  const float sink = p.sinks[l * 8 + head];
  const int rq = 32 * w + l31;
  const u16* gp = PROJ + (size_t)tq * NALL + 768 + head * 64;
  uint2 gA[4], gB[4];
#pragma unroll
  for (int g = 0; g < 4; ++g) { gA[g] = *(const uint2*)(gp + 8 * g + 4 * hf); gB[g] = *(const uint2*)(gp + 32 + 8 * g + 4 * hf); }
  float mrun = -1e30f, lsum = 0.f;
  f32x16 o0, o1;
#pragma unroll
  for (int r = 0; r < 16; ++r) { o0[r] = 0.f; o1[r] = 0.f; }
#pragma unroll 1
  for (int i = 0; i < 5; ++i) {
    bf16x8 kn[4];
    {
      const int in_ = (i < 4) ? i + 1 : 4;
      int kp = kpos0 + 32 * w + 32 * in_ + l31;
      if (kp < 0) kp = 0;
      const u16* kptr = PROJ + (size_t)kp * NALL + 512 + kvh * 64 + 8 * hf;
#pragma unroll
      for (int s = 0; s < 4; ++s) kn[s] = *(const bf16x8*)(kptr + 16 * s);
    }
    f32x16 a;
#pragma unroll
    for (int r = 0; r < 16; ++r) a[r] = 0.f;
#pragma unroll
    for (int s = 0; s < 4; ++s) a = __builtin_amdgcn_mfma_f32_32x32x16_bf16(kc[s], qf[s], a, 0, 0, 0);
#pragma unroll
    for (int s = 0; s < 4; ++s) kc[s] = kn[s];
    float tmax = -1e30f;
#pragma unroll
    for (int r = 0; r < 16; ++r) {
      int kj = 32 * w + 32 * i + (r & 3) + 8 * (r >> 2) + 4 * hf;
      int dist = 128 + rq - kj;
      bool valid = (dist >= 0) && (dist < 128) && (kpos0 + kj >= 0);
      float sv = a[r] * 0.125f - slope * (float)dist;
      sv = valid ? sv : -1e30f;
      a[r] = sv;
      tmax = fmaxf(tmax, sv);
    }
    tmax = fmaxf(tmax, __shfl_xor(tmax, 32));
    const float mnew = fmaxf(mrun, tmax);
    const float alpha = __expf(mrun - mnew);
    float psum = 0.f;
#pragma unroll
    for (int r = 0; r < 16; ++r) {
      float e = (a[r] > -1e29f) ? __expf(a[r] - mnew) : 0.f;
      a[r] = e;
      psum += e;
    }
    lsum = lsum * alpha + psum;
    mrun = mnew;
#pragma unroll
    for (int r = 0; r < 16; ++r) { o0[r] *= alpha; o1[r] *= alpha; }
#pragma unroll
    for (int u = 0; u < 2; ++u) {
      bf16x8 pf;
#pragma unroll
      for (int j = 0; j < 8; ++j) pf[j] = (short)f2bf(a[8 * u + j]);
      const int kb = 32 * w + 32 * i + 16 * u + 4 * hf;
      const u16* v0 = Vt + l31 * 264 + kb;
      const u16* v1 = Vt + (32 + l31) * 264 + kb;
      uint2 a0 = *(const uint2*)(v0), a1 = *(const uint2*)(v0 + 8);
      uint2 b0 = *(const uint2*)(v1), b1 = *(const uint2*)(v1 + 8);
      uint4 A0 = make_uint4(a0.x, a0.y, a1.x, a1.y), A1 = make_uint4(b0.x, b0.y, b1.x, b1.y);
      o0 = __builtin_amdgcn_mfma_f32_32x32x16_bf16(__builtin_bit_cast(bf16x8, A0), pf, o0, 0, 0, 0);
      o1 = __builtin_amdgcn_mfma_f32_32x32x16_bf16(__builtin_bit_cast(bf16x8, A1), pf, o1, 0, 0, 0);
    }
  }
  {
    const float mf = fmaxf(mrun, sink);
    const float scl = __expf(mrun - mf);
    const float ltot = (lsum + __shfl_xor(lsum, 32)) * scl + __expf(sink - mf);
    const float fin = scl / ltot;
#pragma unroll
    for (int r = 0; r < 16; ++r) { o0[r] *= fin; o1[r] *= fin; }
  }
  u16* op = MIX + (size_t)tq * 1024 + head * 64;
#pragma unroll
  for (int g = 0; g < 4; ++g) {
    int d0 = 8 * g + 4 * hf;
    uint2 gg = gA[g];
    float r0 = o0[4 * g + 0] * silu(bflo(gg.x)), r1 = o0[4 * g + 1] * silu(bfhi(gg.x));
    float r2 = o0[4 * g + 2] * silu(bflo(gg.y)), r3 = o0[4 * g + 3] * silu(bfhi(gg.y));
    *(uint2*)(op + d0) = make_uint2(pack2(r0, r1), pack2(r2, r3));
    uint2 g2 = gB[g];
    r0 = o1[4 * g + 0] * silu(bflo(g2.x)); r1 = o1[4 * g + 1] * silu(bfhi(g2.x));
    r2 = o1[4 * g + 2] * silu(bflo(g2.y)); r3 = o1[4 * g + 3] * silu(bfhi(g2.y));
    *(uint2*)(op + 32 + d0) = make_uint2(pack2(r0, r1), pack2(r2, r3));
  }
  __syncthreads();
}

__device__ void rwkv_prep_item(const Params& p, int l, int item, unsigned char* smem) {
  l = opq(l); item = opq(item);
  u16* lwb = (u16*)smem;
  u16* lab = lwb + 16 * 72;
  const u16* PROJ = (const u16*)(p.ws + OFF_PROJ);
  const int tid = opaque_tid(), head = tid >> 6, lane = tid & 63, fr = lane & 15, fq = lane >> 4;
  const int t0 = item * 16;
  {
    const int which = tid >> 7, tt = (tid >> 3) & 15, j0 = (tid & 7) * 8;
    const int t = t0 + tt;
    const u16* pr = PROJ + (size_t)t * NALL;
    const u16* pq = (t > 0) ? pr - NALL : pr;
    const float pm = (t > 0) ? 1.f : 0.f;
    const uint4 cu = *(const uint4*)(pr + (which ? 3200 : 3072) + j0);
    const uint4 pu = *(const uint4*)(pq + (which ? 3264 : 3136) + j0);
    float sv[8];
    sv[0] = bflo(cu.x) + pm * bflo(pu.x); sv[1] = bfhi(cu.x) + pm * bfhi(pu.x);
    sv[2] = bflo(cu.y) + pm * bflo(pu.y); sv[3] = bfhi(cu.y) + pm * bfhi(pu.y);
    sv[4] = bflo(cu.z) + pm * bflo(pu.z); sv[5] = bfhi(cu.z) + pm * bfhi(pu.z);
    sv[6] = bflo(cu.w) + pm * bflo(pu.w); sv[7] = bfhi(cu.w) + pm * bfhi(pu.w);
    if (!which) {
#pragma unroll
      for (int q = 0; q < 8; ++q) sv[q] = tanh_fast(sv[q]);
    }
    *(uint4*)((which ? lab : lwb) + tt * 72 + j0) = make_uint4(pack2(sv[0], sv[1]), pack2(sv[2], sv[3]), pack2(sv[4], sv[5]), pack2(sv[6], sv[7]));
  }
  __syncthreads();
  f32x4 accw[4], acca[4];
#pragma unroll
  for (int nt = 0; nt < 4; ++nt) { accw[nt] = (f32x4){0.f, 0.f, 0.f, 0.f}; acca[nt] = (f32x4){0.f, 0.f, 0.f, 0.f}; }
  {
    const u16* W2T = (const u16*)(p.ws + OFF_W2T) + ((size_t)l * 256 + head * 64 + fr * 4) * 64 + fq * 8;
    const u16* A2T = (const u16*)(p.ws + OFF_A2T) + ((size_t)l * 256 + head * 64 + fr * 4) * 64 + fq * 8;
#pragma unroll
    for (int ks = 0; ks < 2; ++ks) {
      const bf16x8 aw = *(const bf16x8*)(lwb + fr * 72 + ks * 32 + fq * 8);
      const bf16x8 aa = *(const bf16x8*)(lab + fr * 72 + ks * 32 + fq * 8);
#pragma unroll
      for (int nt = 0; nt < 4; ++nt) {
        const bf16x8 bw = *(const bf16x8*)(W2T + nt * 64 + ks * 32);
        const bf16x8 ba = *(const bf16x8*)(A2T + nt * 64 + ks * 32);
        accw[nt] = __builtin_amdgcn_mfma_f32_16x16x32_bf16(aw, bw, accw[nt], 0, 0, 0);
        acca[nt] = __builtin_amdgcn_mfma_f32_16x16x32_bf16(aa, ba, acca[nt], 0, 0, 0);
      }
    }
  }
  const int c0 = head * 64 + fr * 4;
  const float4 mur = *(const float4*)(p.mu_rkv + l * 768 + c0), muk = *(const float4*)(p.mu_rkv + l * 768 + 256 + c0), muv = *(const float4*)(p.mu_rkv + l * 768 + 512 + c0);
  const float4 w0 = *(const float4*)(p.w0 + l * 256 + c0), a0 = *(const float4*)(p.a0 + l * 256 + c0);
  const float4 kkw = *(const float4*)(p.k_k + l * 256 + c0), kaw = *(const float4*)(p.k_a + l * 256 + c0), rkw = *(const float4*)(p.r_k + l * 256 + c0);
  float* RWW = (float*)(p.ws + OFF_RWW);
  float* RWKK = (float*)(p.ws + OFF_RWKK);
  u16* RB = (u16*)(p.ws + OFF_RWB);
  float* BON = (float*)(p.ws + OFF_BONUS);
#define F4E(v, i) ((i) == 0 ? v.x : (i) == 1 ? v.y : (i) == 2 ? v.z : v.w)
#pragma unroll
  for (int rg = 0; rg < 4; ++rg) {
    const int t = t0 + fq * 4 + rg;
    const u16* pr = PROJ + (size_t)t * NALL;
    const u16* pp = (t > 0) ? pr - NALL : pr;
    const float pm = (t > 0) ? 1.f : 0.f;
    const uint2 rcu = *(const uint2*)(pr + 1280 + c0), kcu = *(const uint2*)(pr + 1536 + c0), vcu = *(const uint2*)(pr + 1792 + c0);
    const uint2 rpu = *(const uint2*)(pp + 1280 + c0), kpu = *(const uint2*)(pp + 1536 + c0), vpu = *(const uint2*)(pp + 1792 + c0);
    const float rc[4] = {bflo(rcu.x), bfhi(rcu.x), bflo(rcu.y), bfhi(rcu.y)}, kc[4] = {bflo(kcu.x), bfhi(kcu.x), bflo(kcu.y), bfhi(kcu.y)};
    const float vc[4] = {bflo(vcu.x), bfhi(vcu.x), bflo(vcu.y), bfhi(vcu.y)};
    const float rp[4] = {bflo(rpu.x), bfhi(rpu.x), bflo(rpu.y), bfhi(rpu.y)}, kp[4] = {bflo(kpu.x), bfhi(kpu.x), bflo(kpu.y), bfhi(kpu.y)};
    const float vp[4] = {bflo(vpu.x), bfhi(vpu.x), bflo(vpu.y), bfhi(vpu.y)};
    float kkc[4], av[4], dec[4], rr[4], km[4], vv[4];
    float n2 = 0.f, bonus = 0.f;
#pragma unroll
    for (int nt = 0; nt < 4; ++nt) {
      const float r = rc[nt] + (pm * rp[nt] - rc[nt]) * F4E(mur, nt), k = kc[nt] + (pm * kp[nt] - kc[nt]) * F4E(muk, nt), v = vc[nt] + (pm * vp[nt] - vc[nt]) * F4E(muv, nt);
      const float wpre = F4E(w0, nt) + accw[nt][rg];
      const float wl = -softplusf_(-wpre) - 0.5f;
      dec[nt] = __expf(-__expf(wl));
      const float a = sigmoidf_(F4E(a0, nt) + acca[nt][rg]);
      const float kc2 = k * F4E(kkw, nt);
      const float kmod = k * (1.f + (a - 1.f) * F4E(kaw, nt));
      kkc[nt] = kc2; av[nt] = a; rr[nt] = r; km[nt] = kmod; vv[nt] = v;
      n2 += kc2 * kc2;
      bonus += r * kmod * F4E(rkw, nt);
    }
    n2 = row16_allsum(n2);
    bonus = row16_allsum(bonus);
    const float inv = __builtin_amdgcn_rsqf(fmaxf(n2, 1e-24f));
    const size_t o = (size_t)t * 256 + c0;
    *(float4*)(RWW + o) = make_float4(dec[0], dec[1], dec[2], dec[3]);
    *(float4*)(RWKK + o) = make_float4(kkc[0] * inv, kkc[1] * inv, kkc[2] * inv, kkc[3] * inv);
    *(uint2*)(RB + o) = make_uint2(pack2(rr[0], rr[1]), pack2(rr[2], rr[3]));
    *(uint2*)(RB + (size_t)T_ * 256 + o) = make_uint2(pack2(km[0], km[1]), pack2(km[2], km[3]));
    *(uint2*)(RB + (size_t)2 * T_ * 256 + o) = make_uint2(pack2(vv[0], vv[1]), pack2(vv[2], vv[3]));
    *(uint2*)(RB + (size_t)3 * T_ * 256 + o) = make_uint2(pack2(kkc[0] * inv * av[0], kkc[1] * inv * av[1]), pack2(kkc[2] * inv * av[2], kkc[3] * inv * av[3]));
    if (fr == 0) BON[t * 4 + head] = bonus;
  }
  __syncthreads();
}

__device__ __forceinline__ void gla_b(const Params& p, int l, int head, const u16* lgs, float* tot, float* bl) {
  const int tid = opaque_tid(), d = tid & 31, ig = tid >> 5;
  float g2[16];
#pragma unroll
  for (int m = 0; m < 16; ++m) g2[m] = p.gk2[(size_t)l * 16 * 128 + m * 128 + head * 32 + d];
  const float bias = p.gk_b[l * 128 + head * 32 + d];
  float run = 0.f;
#pragma unroll
  for (int ii = 0; ii < 8; ++ii) {
    const uint4* lp = (const uint4*)(lgs + (ig * 8 + ii) * 16);
    uint4 u0 = lp[0], u1 = lp[1];
    float z = bias;
    z += bflo(u0.x) * g2[0] + bfhi(u0.x) * g2[1] + bflo(u0.y) * g2[2] + bfhi(u0.y) * g2[3];
    z += bflo(u0.z) * g2[4] + bfhi(u0.z) * g2[5] + bflo(u0.w) * g2[6] + bfhi(u0.w) * g2[7];
    z += bflo(u1.x) * g2[8] + bfhi(u1.x) * g2[9] + bflo(u1.y) * g2[10] + bfhi(u1.y) * g2[11];
    z += bflo(u1.z) * g2[12] + bfhi(u1.z) * g2[13] + bflo(u1.w) * g2[14] + bfhi(u1.w) * g2[15];
    float g = (fminf(z, 0.f) - __logf(1.f + __expf(-fabsf(z)))) * (1.f / 16.f);
    run += g;
    bl[ii] = run;
  }
  tot[ig * 32 + d] = run;
  __syncthreads();
  float off = 0.f;
#pragma unroll
  for (int g = 0; g < 8; ++g) off += (g < ig) ? tot[g * 32 + d] : 0.f;
#pragma unroll
  for (int ii = 0; ii < 8; ++ii) bl[ii] += off;
}
__device__ __forceinline__ void st8f(float* dst, const uint4 u) {
  *(float4*)(dst) = make_float4(bflo(u.x), bfhi(u.x), bflo(u.y), bfhi(u.y));
  *(float4*)(dst + 4) = make_float4(bflo(u.z), bfhi(u.z), bflo(u.w), bfhi(u.w));
}

__device__ void gla_local_item(const Params& p, int l, int item, unsigned char* smem) {
  l = opq(l); item = opq(item);
  float* tot = (float*)smem;
  float* Kp = tot + 256;
  float* Vs = Kp + 2048;
  u16* lgs = (u16*)(Vs + 4096);
  const u16* PROJ = (const u16*)(p.ws + OFF_PROJ);
  const int tid = opaque_tid(), d = tid & 31, ig = tid >> 5;
  const int chunk = item >> 2, head = item & 3;
  {
    const u16* base = PROJ + (size_t)(chunk * 64) * NALL;
    const int ki = tid >> 2, kd0 = (tid & 3) * 8;
    const uint4 ku = *(const uint4*)(base + (size_t)ki * NALL + 2432 + head * 32 + kd0);
    const int g0 = tid, g1 = tid + 256;
    const uint4 vu0 = *(const uint4*)(base + (size_t)(g0 >> 3) * NALL + 2560 + head * 64 + (g0 & 7) * 8);
    const uint4 vu1 = *(const uint4*)(base + (size_t)(g1 >> 3) * NALL + 2560 + head * 64 + (g1 & 7) * 8);
    uint4 lu = make_uint4(0u, 0u, 0u, 0u);
    if (tid < 128) lu = *(const uint4*)(base + (size_t)(tid >> 1) * NALL + 3328 + (tid & 1) * 8);
    st8f(Kp + ki * 32 + kd0, ku);
    st8f(Vs + (g0 >> 3) * 64 + (g0 & 7) * 8, vu0);
    st8f(Vs + (g1 >> 3) * 64 + (g1 & 7) * 8, vu1);
    if (tid < 128) *(uint4*)(lgs + (tid >> 1) * 16 + (tid & 1) * 8) = lu;
  }
  __syncthreads();
  float bl[8];
  gla_b(p, l, head, lgs, tot, bl);
  float blast = 0.f;
#pragma unroll
  for (int g = 0; g < 8; ++g) blast += tot[g * 32 + d];
#pragma unroll
  for (int ii = 0; ii < 8; ++ii) {
    const int i = ig * 8 + ii;
    Kp[i * 32 + d] *= __expf(blast - bl[ii]);
  }
  __syncthreads();
  const int v = tid & 63, dg = tid >> 6;
  float acc[8];
#pragma unroll
  for (int q = 0; q < 8; ++q) acc[q] = 0.f;
  for (int i = 0; i < 64; ++i) {
    float vv = Vs[i * 64 + v];
    float4 k0 = *(const float4*)(Kp + i * 32 + dg * 8), k1 = *(const float4*)(Kp + i * 32 + dg * 8 + 4);
    acc[0] += k0.x * vv; acc[1] += k0.y * vv; acc[2] += k0.z * vv; acc[3] += k0.w * vv;
    acc[4] += k1.x * vv; acc[5] += k1.y * vv; acc[6] += k1.z * vv; acc[7] += k1.w * vv;
  }
  float* GS = (float*)(p.ws + OFF_GLAS);
  float* GD = (float*)(p.ws + OFF_GLAD);
#pragma unroll
  for (int q = 0; q < 8; ++q) GS[((size_t)(chunk * 4 + head) * 32 + dg * 8 + q) * 64 + v] = acc[q];
  if (tid < 32) GD[(chunk * 4 + head) * 32 + tid] = __expf(blast);
  __syncthreads();
}

#define GLA_STATE_LOAD(eb_) \
  const int gs_tid = opaque_tid512(); const int gs_ei = gs_tid & 31, gs_g = gs_tid >> 5; \
  const int gs_e = (eb_) * 32 + gs_ei; const int gs_head = gs_e >> 11, gs_d = (gs_e >> 6) & 31, gs_v = gs_e & 63; \
  float gs_ds[16], gs_dc[16]; \
  { float* GSl = (float*)(p.ws + OFF_GLAS); const float* GDl = (const float*)(p.ws + OFF_GLAD); \
    _Pragma("unroll") for (int i = 0; i < 16; ++i) { const int c = gs_g * 16 + i; \
      gs_ds[i] = GSl[((size_t)(c * 4 + gs_head) * 32 + gs_d) * 64 + gs_v]; gs_dc[i] = GDl[(c * 4 + gs_head) * 32 + gs_d]; } }
#define GLA_STATE_FINISH(dsm_) { \
    float* comp = (float*)(dsm_); float* GSl = (float*)(p.ws + OFF_GLAS); \
    float S = 0.f, P = 1.f; \
    _Pragma("unroll") for (int i = 0; i < 16; ++i) { S = gs_dc[i] * S + gs_ds[i]; P *= gs_dc[i]; } \
    comp[(gs_g * 32 + gs_ei) * 2] = P; comp[(gs_g * 32 + gs_ei) * 2 + 1] = S; \
    __syncthreads(); \
    float G = 0.f; \
    for (int gg = 0; gg < gs_g; ++gg) G = comp[(gg * 32 + gs_ei) * 2] * G + comp[(gg * 32 + gs_ei) * 2 + 1]; \
    _Pragma("unroll") for (int i = 0; i < 16; ++i) { const int c = gs_g * 16 + i; \
      GSl[((size_t)(c * 4 + gs_head) * 32 + gs_d) * 64 + gs_v] = G; G = gs_dc[i] * G + gs_ds[i]; } \
    __syncthreads(); }

__device__ void gla_out_item(const Params& p, int l, int item, unsigned char* smem) {
  l = opq(l); item = opq(item);
  float* tot = (float*)smem;
  float* qt = tot + 256;
  float* kt = qt + 2304;
  float* Vs = kt + 2304;
  float* Am = Vs + 4096;
  float* Ss = Am + 4352;
  u16* lgs = (u16*)(Ss + 2048);
  const u16* PROJ = (const u16*)(p.ws + OFF_PROJ);
  u16* MIX = (u16*)(p.ws + OFF_MIX);
  const float* GS = (const float*)(p.ws + OFF_GLAS);
  const int tid = opaque_tid();
  const int chunk = item >> 2, head = item & 3;
  {
    const u16* base = PROJ + (size_t)(chunk * 64) * NALL;
    const int ki = tid >> 2, kd0 = (tid & 3) * 8;
    const uint4 qu = *(const uint4*)(base + (size_t)ki * NALL + 2304 + head * 32 + kd0);
    const uint4 ku = *(const uint4*)(base + (size_t)ki * NALL + 2432 + head * 32 + kd0);
    const int g0 = tid, g1 = tid + 256;
    const uint4 vu0 = *(const uint4*)(base + (size_t)(g0 >> 3) * NALL + 2560 + head * 64 + (g0 & 7) * 8);
    const uint4 vu1 = *(const uint4*)(base + (size_t)(g1 >> 3) * NALL + 2560 + head * 64 + (g1 & 7) * 8);
    const float4 s0 = ((const float4*)(GS + (size_t)(chunk * 4 + head) * 2048))[tid];
    const float4 s1 = ((const float4*)(GS + (size_t)(chunk * 4 + head) * 2048))[tid + 256];
    uint4 lu = make_uint4(0u, 0u, 0u, 0u);
    if (tid < 128) lu = *(const uint4*)(base + (size_t)(tid >> 1) * NALL + 3328 + (tid & 1) * 8);
    st8f(qt + ki * 36 + kd0, qu);
    st8f(kt + ki * 36 + kd0, ku);
    st8f(Vs + (g0 >> 3) * 64 + (g0 & 7) * 8, vu0);
    st8f(Vs + (g1 >> 3) * 64 + (g1 & 7) * 8, vu1);
    ((float4*)Ss)[tid] = s0;
    ((float4*)Ss)[tid + 256] = s1;
    if (tid < 128) *(uint4*)(lgs + (tid >> 1) * 16 + (tid & 1) * 8) = lu;
  }
  __syncthreads();
  {
    const int d = tid & 31, ig = tid >> 5;
    float bl[8];
    gla_b(p, l, head, lgs, tot, bl);
#pragma unroll
    for (int ii = 0; ii < 8; ++ii) {
      const int i = ig * 8 + ii;
      qt[i * 36 + d] *= 0.17677669529663687f * __expf(bl[ii]);
      kt[i * 36 + d] *= __expf(-bl[ii]);
    }
  }
  __syncthreads();
  const int j = tid & 63, ig = tid >> 6;
  {
    float acc[16];
#pragma unroll
    for (int ii = 0; ii < 16; ++ii) acc[ii] = 0.f;
#pragma unroll 2
    for (int d4 = 0; d4 < 8; ++d4) {
      const float4 kv = *(const float4*)(kt + j * 36 + d4 * 4);
#pragma unroll
      for (int ii = 0; ii < 16; ++ii) {
        const float4 qv = *(const float4*)(qt + (ig * 16 + ii) * 36 + d4 * 4);
        acc[ii] += qv.x * kv.x + qv.y * kv.y + qv.z * kv.z + qv.w * kv.w;
      }
    }
#pragma unroll
    for (int ii = 0; ii < 16; ++ii) {
      int i = ig * 16 + ii;
      Am[i * 68 + j] = (j <= i) ? acc[ii] : 0.f;
    }
  }
  __syncthreads();
  {
    const int v = j;
    float acc[16];
#pragma unroll
    for (int ii = 0; ii < 16; ++ii) acc[ii] = 0.f;
    const int jmax = (ig + 1) * 4;
    for (int j4 = 0; j4 < jmax; ++j4) {
      const float v0 = Vs[(j4 * 4 + 0) * 64 + v], v1 = Vs[(j4 * 4 + 1) * 64 + v], v2 = Vs[(j4 * 4 + 2) * 64 + v], v3 = Vs[(j4 * 4 + 3) * 64 + v];
#pragma unroll
      for (int ii = 0; ii < 16; ++ii) {
        const float4 av = *(const float4*)(Am + (ig * 16 + ii) * 68 + j4 * 4);
        acc[ii] += av.x * v0 + av.y * v1 + av.z * v2 + av.w * v3;
      }
    }
#pragma unroll 2
    for (int d4 = 0; d4 < 8; ++d4) {
      const float s0 = Ss[(d4 * 4 + 0) * 64 + v], s1 = Ss[(d4 * 4 + 1) * 64 + v], s2 = Ss[(d4 * 4 + 2) * 64 + v], s3 = Ss[(d4 * 4 + 3) * 64 + v];
#pragma unroll
      for (int ii = 0; ii < 16; ++ii) {
        const float4 qv = *(const float4*)(qt + (ig * 16 + ii) * 36 + d4 * 4);
        acc[ii] += qv.x * s0 + qv.y * s1 + qv.z * s2 + qv.w * s3;
      }
    }
    __syncthreads();
#pragma unroll
    for (int ii = 0; ii < 16; ++ii) Am[(ig * 16 + ii) * 68 + v] = acc[ii];
  }
  __syncthreads();
  {
    const int fr = tid & 15, tg = tid >> 4;
    const float4 nw = *(const float4*)(p.gla_nw + l * 64 + fr * 4);
#pragma unroll
    for (int ps = 0; ps < 4; ++ps) {
      const int i = ps * 16 + tg;
      const int t = chunk * 64 + i;
      const float4 o = *(const float4*)(Am + i * 68 + fr * 4);
      const uint2 gg = *(const uint2*)(PROJ + (size_t)t * NALL + 2816 + head * 64 + fr * 4);
      const float ms = row16_allsum(o.x * o.x + o.y * o.y + o.z * o.z + o.w * o.w) * (1.f / 64.f);
      const float rs = rsqrtf(ms + 1e-5f);
      const float r0 = o.x * rs * nw.x * silu(bflo(gg.x)), r1 = o.y * rs * nw.y * silu(bfhi(gg.x));
      const float r2 = o.z * rs * nw.z * silu(bflo(gg.y)), r3 = o.w * rs * nw.w * silu(bfhi(gg.y));
      *(uint2*)(MIX + (size_t)t * 1024 + 768 + head * 64 + fr * 4) = make_uint2(pack2(r0, r1), pack2(r2, r3));
    }
  }
  __syncthreads();
}

typedef float f32x2 __attribute__((ext_vector_type(2)));
__device__ __forceinline__ float oct_allsum(float x) {
  x += dpp_f<0xB1>(x);
  x += dpp_f<0x4E>(x);
  x += dpp_f<0x141>(x);
  return x;
}
__device__ void rwkv_scan_item(const Params& p, int item, unsigned char* dsm_) {
  item = opq(item);
  float* st = (float*)dsm_;
  const int tid = opaque_tid512(), wv = tid >> 6, lane = tid & 63, rs = lane >> 3, kl = lane & 7;
  const int head = item & 3, seg = item >> 2;
  const bool ident = wv >= 4;
  const int R0 = wv * 16 + rs * 2;
  const int v0 = R0 & 63;
  const float* RWW = (const float*)(p.ws + OFF_RWW);
  const float* RWKK = (const float*)(p.ws + OFF_RWKK);
  const u16* RB = (const u16*)(p.ws + OFF_RWB);
  float* PF = (float*)(p.ws + OFF_PROJ);
  float* ZP = (float*)(p.ws + OFF_ZP);
  const int tbase = seg * SL;
  const int half = tid >> 8, ls = (tid & 255) >> 4, lc4 = (tid & 15) * 4;
  f32x2 S0[4], S1[4];
#pragma unroll
  for (int e = 0; e < 4; ++e) { S0[e] = (f32x2){0.f, 0.f}; S1[e] = (f32x2){0.f, 0.f}; }
  if (ident) {
#pragma unroll
    for (int e = 0; e < 4; ++e) {
      const int k0 = kl * 8 + 2 * e;
      S0[e] = (f32x2){(v0 == k0) ? 1.f : 0.f, (v0 == k0 + 1) ? 1.f : 0.f};
      S1[e] = (f32x2){(v0 + 1 == k0) ? 1.f : 0.f, (v0 + 1 == k0 + 1) ? 1.f : 0.f};
    }
  }
  float4 g0 = make_float4(0.f, 0.f, 0.f, 0.f);
  uint2 h0 = make_uint2(0u, 0u), h1 = h0, h2 = h0;
  const float* gp0 = (half == 0 ? RWW : RWKK) + (size_t)(tbase + ls) * 256 + head * 64 + lc4;
  const u16* hp = RB + (size_t)(tbase + ls) * 256 + head * 64 + lc4;
#define SCAN_GLOAD(ch) do { const size_t _o = (size_t)(ch) * 16 * 256; g0 = *(const float4*)(gp0 + _o); \
    if (half == 0) { h0 = *(const uint2*)(hp + _o); } \
    else { h0 = *(const uint2*)(hp + (size_t)T_ * 256 + _o); h1 = *(const uint2*)(hp + (size_t)3 * T_ * 256 + _o); h2 = *(const uint2*)(hp + (size_t)2 * T_ * 256 + _o); } } while (0)
#define SCAN_LSTORE(buf) do { float* _b = st + (buf) * 6144 + ls * 64 + lc4; \
    if (half == 0) { *(float4*)(_b) = g0; *(float4*)(_b + 2048) = make_float4(bflo(h0.x), bfhi(h0.x), bflo(h0.y), bfhi(h0.y)); } \
    else { *(float4*)(_b + 1024) = g0; *(float4*)(_b + 3072) = make_float4(bflo(h0.x), bfhi(h0.x), bflo(h0.y), bfhi(h0.y)); \
           *(float4*)(_b + 4096) = make_float4(bflo(h1.x), bfhi(h1.x), bflo(h1.y), bfhi(h1.y)); *(float4*)(_b + 5120) = make_float4(bflo(h2.x), bfhi(h2.x), bflo(h2.y), bfhi(h2.y)); } } while (0)
  if (tid < 16) st[2 * 6144 + tid] = 0.f;
  SCAN_GLOAD(0);
  SCAN_LSTORE(0);
  __syncthreads();
  const int nch = SL / 16;
  float* yout = PF + (size_t)tbase * PROJF + (ident ? 256 : 0) + head * 64 + v0;
  const int voff = ident ? (2 * 6144) : (5120 + v0);
  const int vstep = ident ? 0 : 64, vbuf = ident ? 0 : 6144;
#define V2(a, i) ((f32x2){(i) ? a.z : a.x, (i) ? a.w : a.y})
#define SCAN_STEP(s_, IDENT) do { \
    const float* bp = b + (s_) * 64 + kl * 8; \
    const float4 wl = *(const float4*)(bp), wh = *(const float4*)(bp + 4); \
    const float4 kkl = *(const float4*)(bp + 1024), kkh = *(const float4*)(bp + 1028); \
    const float4 rl4 = *(const float4*)(bp + 2048), rh4 = *(const float4*)(bp + 2052); \
    float4 kl4 = make_float4(0.f, 0.f, 0.f, 0.f), kh4 = kl4; f32x2 vv = {0.f, 0.f}; \
    if (!(IDENT)) { kl4 = *(const float4*)(bp + 3072); kh4 = *(const float4*)(bp + 3076); vv = *(const f32x2*)(vsrc + (s_) * vstep); } \
    const float4 bl4 = *(const float4*)(bp + 4096), bh4 = *(const float4*)(bp + 4100); \
    const f32x2 W[4] = {V2(wl, 0), V2(wl, 1), V2(wh, 0), V2(wh, 1)}, KK[4] = {V2(kkl, 0), V2(kkl, 1), V2(kkh, 0), V2(kkh, 1)}; \
    const f32x2 RR[4] = {V2(rl4, 0), V2(rl4, 1), V2(rh4, 0), V2(rh4, 1)}, KV[4] = {V2(kl4, 0), V2(kl4, 1), V2(kh4, 0), V2(kh4, 1)}; \
    const f32x2 BB[4] = {V2(bl4, 0), V2(bl4, 1), V2(bh4, 0), V2(bh4, 1)}; \
    f32x2 t0 = S0[0] * KK[0] + S0[1] * KK[1] + S0[2] * KK[2] + S0[3] * KK[3]; \
    f32x2 t1 = S1[0] * KK[0] + S1[1] * KK[1] + S1[2] * KK[2] + S1[3] * KK[3]; \
    float sa0 = -(t0.x + t0.y), sa1 = -(t1.x + t1.y); \
    sa0 += dpp_f<0xB1>(sa0); sa1 += dpp_f<0xB1>(sa1); sa0 += dpp_f<0x4E>(sa0); sa1 += dpp_f<0x4E>(sa1); sa0 += dpp_f<0x141>(sa0); sa1 += dpp_f<0x141>(sa1); \
    const f32x2 a0 = {sa0, sa0}, a1 = {sa1, sa1}, u0 = {vv.x, vv.x}, u1 = {vv.y, vv.y}; \
    if (IDENT) { _Pragma("unroll") for (int e = 0; e < 4; ++e) { S0[e] = S0[e] * W[e] + a0 * BB[e]; S1[e] = S1[e] * W[e] + a1 * BB[e]; } } \
    else { _Pragma("unroll") for (int e = 0; e < 4; ++e) { S0[e] = S0[e] * W[e] + a0 * BB[e] + u0 * KV[e]; S1[e] = S1[e] * W[e] + a1 * BB[e] + u1 * KV[e]; } } \
    f32x2 q0 = S0[0] * RR[0] + S0[1] * RR[1] + S0[2] * RR[2] + S0[3] * RR[3]; \
    f32x2 q1 = S1[0] * RR[0] + S1[1] * RR[1] + S1[2] * RR[2] + S1[3] * RR[3]; \
    float y0 = q0.x + q0.y, y1 = q1.x + q1.y; \
    y0 += dpp_f<0xB1>(y0); y1 += dpp_f<0xB1>(y1); y0 += dpp_f<0x4E>(y0); y1 += dpp_f<0x4E>(y1); y0 += dpp_f<0x141>(y0); y1 += dpp_f<0x141>(y1); \
    const bool mine = (kl == ((s_) & 7)); \
    if ((s_) < 8) { ya.x = mine ? y0 : ya.x; ya.y = mine ? y1 : ya.y; } else { yb.x = mine ? y0 : yb.x; yb.y = mine ? y1 : yb.y; } } while (0)
  for (int ch = 0; ch < nch; ++ch) {
    const int cur = ch & 1;
    if (ch + 1 < nch) SCAN_GLOAD(ch + 1);
    const float* b = st + cur * 6144;
    const float* vsrc = st + voff + cur * vbuf;
    f32x2 ya = {0.f, 0.f}, yb = {0.f, 0.f};
    if (ident) {
#pragma unroll 2
      for (int s = 0; s < 8; ++s) SCAN_STEP(s, true);
#pragma unroll 2
      for (int s = 8; s < 16; ++s) SCAN_STEP(s, true);
    } else {
#pragma unroll 2
      for (int s = 0; s < 8; ++s) SCAN_STEP(s, false);
#pragma unroll 2
      for (int s = 8; s < 16; ++s) SCAN_STEP(s, false);
    }
    *(f32x2*)(yout + (size_t)(ch * 16 + kl) * PROJF) = ya;
    *(f32x2*)(yout + (size_t)(ch * 16 + 8 + kl) * PROJF) = yb;
    if (ch + 1 < nch) SCAN_LSTORE(cur ^ 1);
    __syncthreads();
  }
#pragma unroll
  for (int j = 0; j < 2; ++j) {
    float* zp = ZP + ((size_t)((seg * 4 + head) * 128 + R0 + j)) * 64 + kl * 8;
    if (j == 0) { *(float4*)(zp) = make_float4(S0[0].x, S0[0].y, S0[1].x, S0[1].y); *(float4*)(zp + 4) = make_float4(S0[2].x, S0[2].y, S0[3].x, S0[3].y); }
    else { *(float4*)(zp) = make_float4(S1[0].x, S1[0].y, S1[1].x, S1[1].y); *(float4*)(zp + 4) = make_float4(S1[2].x, S1[2].y, S1[3].x, S1[3].y); }
  }
}

__device__ void rwkv_combine(const Params& p, unsigned char* dsm_) {
  float* ring = (float*)dsm_;
  float* ZP = (float*)(p.ws + OFF_ZP);
  const int tid = opaque_tid512(); const int lane = tid & 63;
  const int rowi = blockIdx.x * 8 + (tid >> 6);
  const int head = rowi >> 6, v = rowi & 63;
  float4 a0A, b0A, a1A, b1A, a0B, b0B, a1B, b1B, a0C, b0C, a1C, b1C, a0D, b0D, a1D, b1D;
  float z0A, z1A, z0B, z1B, z0C, z1C, z0D, z1D;
#define COMB_LOAD(X, stg_) do { \
      const float* base0 = ZP + (size_t)((((stg_) * 2 + 0) * 4 + head) * 128) * 64; \
      const float* base1 = ZP + (size_t)((((stg_) * 2 + 1) * 4 + head) * 128) * 64; \
      a0##X = ((const float4*)(base0 + 4096))[tid]; b0##X = ((const float4*)(base0 + 4096))[tid + 512]; z0##X = base0[v * 64 + lane]; \
      a1##X = ((const float4*)(base1 + 4096))[tid]; b1##X = ((const float4*)(base1 + 4096))[tid + 512]; z1##X = base1[v * 64 + lane]; } while (0)
#define COMB_SEG(q, ZC) do { const int seg = stg * 2 + q; \
      ZP[((size_t)((seg * 4 + head) * 128 + v)) * 64 + lane] = s; \
      float ns0 = ZC, ns1 = 0.f; const float* P = buf + q * 4096 + lane; \
      _Pragma("unroll") for (int i = 0; i < 64; i += 2) { \
        float s0 = __builtin_bit_cast(float, __builtin_amdgcn_readlane(__builtin_bit_cast(int, s), i)); \
        float s1 = __builtin_bit_cast(float, __builtin_amdgcn_readlane(__builtin_bit_cast(int, s), i + 1)); \
        ns0 += s0 * P[i * 64]; ns1 += s1 * P[(i + 1) * 64]; } \
      s = ns0 + ns1; } while (0)
#define COMB_STAGE(X, bi) do { \
      float* buf = ring + (bi) * 8192; \
      ((float4*)(buf))[tid] = a0##X; ((float4*)(buf))[tid + 512] = b0##X; \
      ((float4*)(buf + 4096))[tid] = a1##X; ((float4*)(buf + 4096))[tid + 512] = b1##X; \
      const float c0 = z0##X, c1 = z1##X; \
      { const int nstg = (stg + 4 < NSEG / 2) ? stg + 4 : stg; COMB_LOAD(X, nstg); } \
      __syncthreads(); \
      COMB_SEG(0, c0); COMB_SEG(1, c1); ++stg; } while (0)
  COMB_LOAD(A, 0); COMB_LOAD(B, 1); COMB_LOAD(C, 2); COMB_LOAD(D, 3);
  float s = 0.f;
  int stg = 0;
#pragma unroll 1
  for (int it4 = 0; it4 < NSEG / 8; ++it4) {
    COMB_STAGE(A, 0); COMB_STAGE(B, 1); COMB_STAGE(C, 2); COMB_STAGE(D, 3);
  }
  __syncthreads();
#undef COMB_LOAD
#undef COMB_SEG
#undef COMB_STAGE
}

__device__ __forceinline__ bf16x8 pack8(const float4 a, const float4 b) {
  uint4 u = make_uint4(pack2(a.x, a.y), pack2(a.z, a.w), pack2(b.x, b.y), pack2(b.z, b.w));
  return __builtin_bit_cast(bf16x8, u);
}
__device__ void rwkv_final_item(const Params& p, int l, int item, unsigned char* smem) {
  l = opq(l); item = opq(item);
  const int tid = opaque_tid(), w = tid >> 6, lane = tid & 63, l31 = lane & 31, hf = lane >> 5;
  const int parts = SL / 128;
  const int q = item % parts, head = (item / parts) & 3, seg = item / (parts * 4);
  const int t = seg * SL + q * 128 + w * 32 + l31;
  const float* ZP = (const float*)(p.ws + OFF_ZP);
  const float* PF = (const float*)(p.ws + OFF_PROJ);
  const u16* PROJ = (const u16*)(p.ws + OFF_PROJ);
  const u16* RBv = (const u16*)(p.ws + OFF_RWB) + (size_t)2 * T_ * 256;
  const float* BON = (const float*)(p.ws + OFF_BONUS);
  u16* MIX = (u16*)(p.ws + OFF_MIX);
  f32x16 acc0, acc1;
#pragma unroll
  for (int r = 0; r < 16; ++r) { acc0[r] = 0.f; acc1[r] = 0.f; }
  const float* y0p = PF + (size_t)t * PROJF + head * 64 + 4 * hf;
  const int cb = head * 64 + 4 * hf;
  float4 yA[4], yB[4];
  uint2 vvl[8], ggl[8];
#pragma unroll
  for (int g = 0; g < 4; ++g) { yA[g] = *(const float4*)(y0p + 8 * g); yB[g] = *(const float4*)(y0p + 32 + 8 * g); }
#pragma unroll
  for (int q8 = 0; q8 < 8; ++q8) {
    const int c = cb + (q8 >> 2) * 32 + 8 * (q8 & 3);
    vvl[q8] = *(const uint2*)(RBv + (size_t)t * 256 + c);
    ggl[q8] = *(const uint2*)(PROJ + (size_t)t * NALL + 2048 + c);
  }
  const float bon = BON[t * 4 + head];
  {
    const float* sp = ZP + ((size_t)((seg * 4 + head) * 128 + l31)) * 64 + 8 * hf;
    const float* rp = PF + (size_t)t * PROJF + 256 + head * 64 + 8 * hf;
#pragma unroll
    for (int ks = 0; ks < 4; ++ks) {
      const bf16x8 bfrag = pack8(*(const float4*)(rp + 16 * ks), *(const float4*)(rp + 16 * ks + 4));
      const bf16x8 a0 = pack8(*(const float4*)(sp + 16 * ks), *(const float4*)(sp + 16 * ks + 4));
      const bf16x8 a1 = pack8(*(const float4*)(sp + 32 * 64 + 16 * ks), *(const float4*)(sp + 32 * 64 + 16 * ks + 4));
      acc0 = __builtin_amdgcn_mfma_f32_32x32x16_bf16(a0, bfrag, acc0, 0, 0, 0);
      acc1 = __builtin_amdgcn_mfma_f32_32x32x16_bf16(a1, bfrag, acc1, 0, 0, 0);
    }
  }
  float sum = 0.f;
#pragma unroll
  for (int g = 0; g < 4; ++g) {
    const float4 ya = yA[g], yb = yB[g];
    acc0[4 * g + 0] += ya.x; acc0[4 * g + 1] += ya.y; acc0[4 * g + 2] += ya.z; acc0[4 * g + 3] += ya.w;
    acc1[4 * g + 0] += yb.x; acc1[4 * g + 1] += yb.y; acc1[4 * g + 2] += yb.z; acc1[4 * g + 3] += yb.w;
  }
#pragma unroll
  for (int r = 0; r < 16; ++r) sum += acc0[r] + acc1[r];
  sum += __shfl_xor(sum, 32);
  const float mean = sum * (1.f / 64.f);
  float var = 0.f;
#pragma unroll
  for (int r = 0; r < 16; ++r) { const float d0 = acc0[r] - mean, d1 = acc1[r] - mean; var += d0 * d0 + d1 * d1; }
  var += __shfl_xor(var, 32);
  const float rstd = rsqrtf(var * (1.f / 64.f) + 64e-5f);
#pragma unroll
  for (int mt = 0; mt < 2; ++mt)
#pragma unroll
    for (int g = 0; g < 4; ++g) {
      const int c = cb + mt * 32 + 8 * g;
      const float4 lw = *(const float4*)(p.ln_w + l * 256 + c), lb = *(const float4*)(p.ln_b + l * 256 + c);
      const uint2 vv = vvl[mt * 4 + g];
      const uint2 gg = ggl[mt * 4 + g];
      float o0 = (mt ? acc1[4 * g + 0] : acc0[4 * g + 0]), o1 = (mt ? acc1[4 * g + 1] : acc0[4 * g + 1]);
      float o2 = (mt ? acc1[4 * g + 2] : acc0[4 * g + 2]), o3 = (mt ? acc1[4 * g + 3] : acc0[4 * g + 3]);
      o0 = (o0 - mean) * rstd * lw.x + lb.x + bon * bflo(vv.x);
      o1 = (o1 - mean) * rstd * lw.y + lb.y + bon * bfhi(vv.x);
      o2 = (o2 - mean) * rstd * lw.z + lb.z + bon * bflo(vv.y);
      o3 = (o3 - mean) * rstd * lw.w + lb.w + bon * bfhi(vv.y);
      o0 *= silu(bflo(gg.x)); o1 *= silu(bfhi(gg.x)); o2 *= silu(bflo(gg.y)); o3 *= silu(bfhi(gg.y));
      *(uint2*)(MIX + (size_t)t * 1024 + 512 + c) = make_uint2(pack2(o0, o1), pack2(o2, o3));
    }
}

#define LDS_BYTES (131072 + 16)
#ifndef REP_G1
#define REP_G1 1
#endif
#ifndef REP_G2
#define REP_G2 1
#endif
#ifndef REP_P3
#define REP_P3 1
#endif
#ifndef REP_SCAN
#define REP_SCAN 1
#endif
#ifndef REP_GO
#define REP_GO 1
#endif
#ifndef REP_FIN
#define REP_FIN 1
#endif
#define PAIR_LOOP(N, BODY) for (int _pr = blockIdx.x; _pr < (N) / 2; _pr += gridDim.x) { const int it = 2 * _pr + vb; BODY }
__global__ void __launch_bounds__(512) fwd_megakernel(Params p) {
  cg::grid_group grid = cg::this_grid();
  extern __shared__ __attribute__((aligned(16))) unsigned char dsm[];
  const int vb = __builtin_amdgcn_readfirstlane(threadIdx.x >> 8);
  unsigned char* smem = dsm + vb * 65536;
  if (threadIdx.x == 0) *(uint4*)(dsm + 131072) = make_uint4(0u, 0u, 0u, 0u);
  __syncthreads();
  const XcdBarrier xb = xcd_barrier_post((unsigned*)(p.ws + OFF_BAR), (volatile LAS unsigned*)(dsm + 131072));
#define GSYNC() xcd_barrier(xb)
#ifndef PH
#define PH 0xffff
#endif
  if (PH & 1) PAIR_LOOP(384, phase_mod_item(p, it, smem);)
  if (PH & 2) PAIR_LOOP(4480, phase_wconv_item(p, it, smem);)
  if (PH & 2) PAIR_LOOP(8, phase_w2t_item(p, it);)
  grid.sync();
  if (PH & 4) phase_h0(p);
  GSYNC();
#pragma unroll 1
  for (int hl = 0; hl < 8; ++hl) {
    const int l = hl >> 1;
    const bool second = hl & 1;
    if (PH & 8) {
      pg8::Gemm g; g.M = T_; g.K = 1024;
      pg8::EpiU E; E.O = (void*)(p.ws + OFF_PROJ);
      if (!second) { g.A = (const u16*)(p.ws + OFF_H); g.Bt = (const u16*)(p.ws + OFF_WALL) + (size_t)l * NALL * 1024; g.N = 3584; E.ldc = NALL; E.ncols = NALL; E.f32out = 0; }
      else { g.A = (const u16*)(p.ws + OFF_MIX); g.Bt = (const u16*)(p.ws + OFF_WOUT) + (size_t)l * 1024 * 1024; g.N = 1024; E.ldc = 1024; E.ncols = 1024; E.f32out = 0; }
      pg8::StaticOrder S; S.init(T_, g.N, gridDim.x, blockIdx.x);
      const int nrep = second ? REP_G2 : REP_G1;
#pragma unroll 1
      for (int rep = 0; rep < nrep; ++rep)
      pg8::gemm_phase<pg8::EpiU, pg8::StaticOrder, false>((PG8_LAS unsigned char*)dsm, g, S, E, nullptr);
    }
    GSYNC();
    if (!second) {
#pragma unroll 1
      for (int rep = 0; rep < REP_P3; ++rep)
      PAIR_LOOP(3072,
        if (it < 1024) { if (PH & 16) attn_item(p, l, it, smem); }
        else if (it < 2048) { if (PH & 32) rwkv_prep_item(p, l, it - 1024, smem); }
        else { if (PH & 64) gla_local_item(p, l, it - 2048, smem); }
      )
      GSYNC();
      {
        GLA_STATE_LOAD(blockIdx.x)
#pragma unroll 1
        for (int rep = 0; rep < REP_SCAN; ++rep)
        if (PH & 256) rwkv_scan_item(p, blockIdx.x, dsm);
        __syncthreads();
        if (PH & 128) GLA_STATE_FINISH(dsm)
      }
      GSYNC();
      if (blockIdx.x < 32) { if (PH & 512) rwkv_combine(p, dsm); }
#pragma unroll 1
      for (int rep = 0; rep < REP_GO; ++rep)
      if (PH & 1024) {
        unsigned* ctr = (unsigned*)(p.ws + OFF_BAR) + 32 + l;
        volatile unsigned* slot = (volatile unsigned*)(dsm + 131072) + 2;
        for (;;) {
          if (threadIdx.x == 0) *slot = atomicAdd(ctr, 1u);
          __syncthreads();
          const unsigned pr = (unsigned)__builtin_amdgcn_readfirstlane((int)*slot);
          __syncthreads();
          if (pr >= 512u) break;
          gla_out_item(p, l, 2 * (int)pr + vb, smem);
        }
      }
      GSYNC();
#pragma unroll 1
      for (int rep = 0; rep < REP_FIN; ++rep)
      if (PH & 2048) PAIR_LOOP(NSEG * 4 * (SL / 128), rwkv_final_item(p, l, it, smem);)
      GSYNC();
    } else {
      if (PH & 8192) phase_post(p, l);
      if (hl < 7) GSYNC();
    }
  }
}

extern "C" void kernel_launch(void* const* d_in, const int* in_sizes, int n_in, void* d_out, int out_size, void* d_ws, size_t ws_size,
                              hipStream_t stream) {
  static int grid_blocks = 0;
  if (!grid_blocks) {
    int dev = 0, cus = 0, per_cu = 0;
    (void)hipGetDevice(&dev);
    (void)hipDeviceGetAttribute(&cus, hipDeviceAttributeMultiprocessorCount, dev);
    (void)hipFuncSetAttribute((const void*)fwd_megakernel, hipFuncAttributeMaxDynamicSharedMemorySize, LDS_BYTES);
    (void)hipOccupancyMaxActiveBlocksPerMultiprocessor(&per_cu, fwd_megakernel, 512, LDS_BYTES);
    if (per_cu < 1) per_cu = 1;
    grid_blocks = cus;
    if (grid_blocks != 256) { fprintf(stderr, "kernel_launch: built for a 256-CU device (got %d)\n", cus); grid_blocks = -1; }
  }
  if (grid_blocks < 0) return;
  if (n_in != 27 || ws_size < WS_END) {
    fprintf(stderr, "kernel_launch: unexpected n_in %d / ws %zu\n", n_in, ws_size);
    return;
  }
  Params p{};
  const float** pp = (const float**)&p;
  for (int i = 0; i < 27; ++i) pp[i] = (const float*)d_in[i];
  p.out = (float*)d_out;
  p.ws = (unsigned char*)d_ws;
  (void)hipMemsetAsync((unsigned char*)d_ws + OFF_BAR, 0, XCD_BAR_WORDS * 4, stream);
  void* args[] = {&p};
  hipError_t e = hipLaunchCooperativeKernel((void*)fwd_megakernel, dim3(grid_blocks), dim3(512), args, LDS_BYTES, stream);
  if (e != hipSuccess) fprintf(stderr, "cooperative launch failed: %s (grid %d)\n", hipGetErrorString(e), grid_blocks);
}
```

```cpp
#include <hip/hip_runtime.h>
#include <hip/hip_bf16.h>
#include <hip/hip_cooperative_groups.h>
#include <cstdio>
namespace cg = cooperative_groups;

typedef unsigned short u16;
using bf16x8 = __attribute__((ext_vector_type(8))) short;
using f32x4 = __attribute__((ext_vector_type(4))) float;
using f32x16 = __attribute__((ext_vector_type(16))) float;

#define T_ 16384
#define NALL 3456
#define NSEG 64
#define SL (T_ / NSEG)
#define PROJF 1728

#define OFF_WALL 0ull
#define OFF_WOUT 28311552ull
#define OFF_MOD 36700160ull
#define OFF_H 36749312ull
#define OFF_RWW OFF_H
#define OFF_RWKK (OFF_H + 16777216ull)
#define OFF_PROJ 70303744ull
#define OFF_MIX 183549952ull
#define OFF_RWB 217104384ull
#define OFF_GLAS 250658816ull
#define OFF_GLAD 259047424ull
#define OFF_BONUS 259178496ull
#define OFF_ZP 259440640ull
#define OFF_BAR 267829248ull
#define OFF_W2T 267845632ull
#define OFF_A2T 267976704ull
#define WS_END 268107776ull


struct Params {
  const float *x, *c, *ada_w, *ada_b, *norm_pre, *norm_post, *w_in, *w_out, *sinks, *mu_rkv, *mu_w, *mu_a, *w0, *w1, *w2,
      *a0, *a1, *a2, *k_k, *k_a, *r_k, *ln_w, *ln_b, *gk1, *gk2, *gk_b, *gla_nw;
  float* out;
  unsigned char* ws;
};

__device__ __forceinline__ u16 f2bf(float f) {
  unsigned u = __float_as_uint(f);
  u += 0x7fffu + ((u >> 16) & 1u);
  return (u16)(u >> 16);
}
__device__ __forceinline__ float bf2f(u16 h) { return __uint_as_float(((unsigned)h) << 16); }
__device__ __forceinline__ unsigned pack2(float a, float b) { return (unsigned)f2bf(a) | ((unsigned)f2bf(b) << 16); }
__device__ __forceinline__ float bflo(unsigned u) { return __uint_as_float(u << 16); }
__device__ __forceinline__ float bfhi(unsigned u) { return __uint_as_float(u & 0xffff0000u); }

__device__ __forceinline__ float frcp(float x) { return __builtin_amdgcn_rcpf(x); }
__device__ __forceinline__ float silu(float x) { return x * frcp(1.f + __expf(-x)); }
__device__ __forceinline__ float sigmoidf_(float x) { return frcp(1.f + __expf(-x)); }
__device__ __forceinline__ float softplusf_(float z) { return fmaxf(z, 0.f) + __logf(1.f + __expf(-fabsf(z))); }
__device__ __forceinline__ float tanh_fast(float x) { return 1.f - 2.f * frcp(1.f + __expf(2.f * x)); }

__device__ __forceinline__ int opq(int x) { asm volatile("" : "+s"(x)); return x; }
__device__ __forceinline__ int opaque_tid() { int t = threadIdx.x & 255; asm volatile("" : "+v"(t)); return t; }
__device__ __forceinline__ int opaque_tid512() { int t = threadIdx.x; asm volatile("" : "+v"(t)); return t; }
template <int CTRL>
__device__ __forceinline__ float dpp_f(float x) {
  return __builtin_bit_cast(float, __builtin_amdgcn_update_dpp(0, __builtin_bit_cast(int, x), CTRL, 0xf, 0xf, true));
}
__device__ __forceinline__ float row16_allsum(float x) {
  x += dpp_f<0x128>(x);
  x += dpp_f<0x124>(x);
  x += dpp_f<0x122>(x);
  x += dpp_f<0x121>(x);
  return x;
}
__device__ __forceinline__ float wave_sum(float v) {
  v = row16_allsum(v);
  const int iv = __builtin_bit_cast(int, v);
  const float a = __builtin_bit_cast(float, __builtin_amdgcn_readlane(iv, 0)), b = __builtin_bit_cast(float, __builtin_amdgcn_readlane(iv, 16));
  const float c = __builtin_bit_cast(float, __builtin_amdgcn_readlane(iv, 32)), d = __builtin_bit_cast(float, __builtin_amdgcn_readlane(iv, 48));
  return (a + b) + (c + d);
}

namespace pg8 {
#define PG8_LAS __attribute__((address_space(3)))
typedef unsigned short bf16_t;
typedef short bf16x8 __attribute__((ext_vector_type(8)));
typedef float f32x4 __attribute__((ext_vector_type(4)));
typedef unsigned u32x4 __attribute__((ext_vector_type(4)));
constexpr int BM = 256, BK = 64, HALF = 128, HTB = HALF * BK * 2  , STAGE_BYTES = 8 * HTB, NXCD = 8, WGM = 8;

__host__ __device__ __forceinline__ int lds_byte(int r, int c) { const int st = (r >> 4) * 2 + (c >> 5), rr = r & 15, cc = c & 31, ob = rr * 64 + cc * 2; return st * 1024 + (ob ^ (((ob >> 9) & 1) << 5)); }
__host__ __device__ __forceinline__ void stage_rc(int b, int& R, int& C) { const int st = b / 1024, sb = b % 1024, swz = sb ^ (((sb >> 9) & 1) << 5); R = (st >> 1) * 16 + swz / 64; C = (st & 1) * 32 + (swz % 64) / 2; }
__host__ __device__ __forceinline__ int perm32(int rho) { const int n = rho >> 4, i = rho & 15; return 8 * (i >> 2) + 4 * n + (i & 3); }

struct Unit { int pm, pn; };
struct Gemm { const bf16_t* A; const bf16_t* Bt; int M, N, K; };

struct StaticOrder {
    int nM, nN, nwg, G, c;
    __host__ __device__ void init(int M, int N, int G_, int c_) { nM = M / BM; nN = N / BM; nwg = nM * nN; G = G_; c = c_; }
    __host__ __device__ bool next(int i, Unit& u) const {
        const long L = (long)i * G + c; if (L >= nwg) return false;
        int wgid = (int)L; { const int q = nwg / NXCD, r = nwg % NXCD, xcd = wgid % NXCD, off = wgid / NXCD; wgid = (xcd < r ? xcd * (q + 1) : r * (q + 1) + (xcd - r) * q) + off; }
        const int nig = WGM * nN, gid = wgid / nig, fm = gid * WGM, gsz = (nM - fm) < WGM ? (nM - fm) : WGM;
        u.pm = fm + ((wgid % nig) % gsz); u.pn = (wgid % nig) / gsz; return true;
    }
    __device__ __forceinline__ void a_ready(const Unit&) const {}
    __device__ __forceinline__ void done(const Unit&) const {}
};
__device__ __forceinline__ unsigned cvt_pk_bf16(float lo, float hi) { unsigned r; asm volatile("v_cvt_pk_bf16_f32 %0, %1, %2" : "=v"(r) : "v"(lo), "v"(hi)); return r; }
template <class Epi, class Sched, bool STAMP = false>
__device__ __forceinline__ void gemm_phase(PG8_LAS unsigned char* lds, const Gemm g, const Sched& S, const Epi& E, unsigned long long* stamps) {
    const int tid = threadIdx.x, wid = __builtin_amdgcn_readfirstlane(tid >> 6), lane = tid & 63, wr = wid >> 2, wc = wid & 3, fr = lane & 15, fq = lane >> 4;
    const int K = g.K, nt = K / BK;
    int ts_lo = 0, ts_hi = 0, nts = 0; const unsigned long long rt_entry = STAMP ? (unsigned long long)wall_clock64() : 0ull;
#define PG8_STAMP() do { if (STAMP && wid == 0 && nts < 64) { const unsigned long long _c = (unsigned long long)clock64(); \
        ts_lo = (lane == nts) ? (int)(unsigned)_c : ts_lo; ts_hi = (lane == nts) ? (int)(unsigned)(_c >> 32) : ts_hi; ++nts; } } while (0)
    PG8_STAMP();
    unsigned voffA[2], voffB[2];
#pragma unroll
    for (int i = 0; i < 2; ++i) { int R, C; stage_rc(tid * 16 + i * 8192, R, C); const int Rb = Epi::PERM ? ((R & ~31) + perm32(R & 31)) : R;
        voffA[i] = (unsigned)(R * K + C) * 2u; voffB[i] = (unsigned)(Rb * K + C) * 2u; }
    const size_t kstep = (size_t)(BK * 2);
    const size_t hstep = (size_t)HALF * K * 2;
    const size_t tstep = 2 * hstep;
    const unsigned ldsw = (unsigned)wid * 1024u;
    const int aoff = lds_byte(wr * 64 + fr, fq * 8), boff = lds_byte(wc * 32 + fr, fq * 8);
#define PG8_SA(b, h) (((b) * 2 + (h)) * HTB)
#define PG8_SB(b, h) ((4 + (b) * 2 + (h)) * HTB)
#define PG8_STAGE(bufoff, gbase, voff) do { _Pragma("unroll") for (int _i = 0; _i < 2; ++_i) \
        __builtin_amdgcn_global_load_lds((const unsigned*)((const char*)(gbase) + (voff)[_i]), (PG8_LAS unsigned*)(lds + (bufoff) + ldsw + _i * 8192), 16, 0, 0); } while (0)
#define PG8_LDA(dst, b, h) do { _Pragma("unroll") for (int m = 0; m < 4; ++m) _Pragma("unroll") for (int k = 0; k < 2; ++k) dst[m][k] = *(const PG8_LAS bf16x8*)(lds + PG8_SA(b, h) + aoff + m * 2048 + k * 1024); } while (0)
#define PG8_LDB(dst, b, h) do { _Pragma("unroll") for (int n = 0; n < 2; ++n) _Pragma("unroll") for (int k = 0; k < 2; ++k) dst[n][k] = *(const PG8_LAS bf16x8*)(lds + PG8_SB(b, h) + boff + n * 2048 + k * 1024); } while (0)
#define PG8_MMA(ai, bj, At, Bt) do { __builtin_amdgcn_s_setprio(1); _Pragma("unroll") for (int m = 0; m < 4; ++m) _Pragma("unroll") for (int n = 0; n < 2; ++n) _Pragma("unroll") for (int k = 0; k < 2; ++k) \
        acc[ai][bj][m][n] = __builtin_amdgcn_mfma_f32_16x16x32_bf16(Bt[n][k], At[m][k], acc[ai][bj][m][n], 0, 0, 0); __builtin_amdgcn_s_setprio(0); } while (0)
#define PG8_WAIT_V(n) asm volatile("s_waitcnt vmcnt(" #n ")" ::: "memory")
#define PG8_WAIT_L(n) asm volatile("s_waitcnt lgkmcnt(" #n ")" ::: "memory")
#define PG8_BAR __builtin_amdgcn_s_barrier()
#define PG8_SCHED __builtin_amdgcn_sched_barrier(0)
    Unit cur, nxt; int ui = 0;
    if (!S.next(0, cur)) return;
    f32x4 acc[2][2][4][2];
#pragma unroll
    for (int a = 0; a < 2; ++a)
#pragma unroll
        for (int b = 0; b < 2; ++b)
#pragma unroll
            for (int m = 0; m < 4; ++m)
#pragma unroll
                for (int n = 0; n < 2; ++n) acc[a][b][m][n] = (f32x4){0.f, 0.f, 0.f, 0.f};
    bf16x8 At[4][2], B0[2][2], B1[2][2];
    const char* cA = (const char*)g.A + (size_t)cur.pm * tstep; const char* cB = (const char*)g.Bt + (size_t)cur.pn * tstep;
    S.a_ready(cur);
    PG8_STAGE(PG8_SB(0, 0), cB, voffB); PG8_STAGE(PG8_SA(0, 0), cA, voffA); PG8_STAGE(PG8_SB(0, 1), cB + hstep, voffB); PG8_STAGE(PG8_SA(0, 1), cA + hstep, voffA);
    if (wr == 1) PG8_BAR;
    PG8_WAIT_V(4); PG8_BAR;
    PG8_STAGE(PG8_SB(1, 0), cB + kstep, voffB); PG8_STAGE(PG8_SA(1, 0), cA + kstep, voffA); PG8_STAGE(PG8_SB(1, 1), cB + hstep + kstep, voffB);
    PG8_WAIT_V(6); PG8_BAR;
    PG8_STAMP();
    for (;;) {
        const bool has_next = S.next(ui + 1, nxt);
        const char* nA = has_next ? (const char*)g.A + (size_t)nxt.pm * tstep : cA; const char* nB = has_next ? (const char*)g.Bt + (size_t)nxt.pn * tstep : cB;
        for (int t = 0; t < nt; t += 2) {
            const bool last = (t == nt - 2);
            const char* a1 = cA + (size_t)(t + 1) * kstep;
            const char* a2 = last ? nA : cA + (size_t)(t + 2) * kstep; const char* b2 = last ? nB : cB + (size_t)(t + 2) * kstep;
            const char* a3 = a2 + kstep; const char* b3 = b2 + kstep;
            if (last && has_next) S.a_ready(nxt);
            PG8_LDB(B0, 0, 0); PG8_SCHED; PG8_LDA(At, 0, 0); PG8_STAGE(PG8_SA(1, 1), a1 + hstep, voffA);
            PG8_WAIT_L(8); PG8_BAR; PG8_WAIT_L(0); PG8_MMA(0, 0, At, B0); PG8_BAR; PG8_SCHED;
            PG8_LDB(B1, 0, 1); PG8_STAGE(PG8_SB(0, 0), b2, voffB);
            PG8_BAR; PG8_WAIT_L(0); PG8_MMA(0, 1, At, B1); PG8_BAR;
            PG8_LDA(At, 0, 1); PG8_STAGE(PG8_SA(0, 0), a2, voffA);
            PG8_BAR; PG8_WAIT_L(0); PG8_MMA(1, 0, At, B0); PG8_BAR; PG8_SCHED;
            PG8_STAGE(PG8_SB(0, 1), b2 + hstep, voffB);
            PG8_WAIT_V(6); PG8_BAR; PG8_MMA(1, 1, At, B1); PG8_BAR;
            PG8_LDB(B0, 1, 0); PG8_SCHED; PG8_LDA(At, 1, 0); PG8_STAGE(PG8_SA(0, 1), a2 + hstep, voffA);
            PG8_WAIT_L(8); PG8_BAR; PG8_WAIT_L(0); PG8_MMA(0, 0, At, B0); PG8_BAR; PG8_SCHED;
            PG8_LDB(B1, 1, 1); PG8_STAGE(PG8_SB(1, 0), b3, voffB);
            PG8_BAR; PG8_WAIT_L(0); PG8_MMA(0, 1, At, B1); PG8_BAR;
            PG8_LDA(At, 1, 1); PG8_STAGE(PG8_SA(1, 0), a3, voffA);
            PG8_BAR; PG8_WAIT_L(0); PG8_MMA(1, 0, At, B0); PG8_BAR; PG8_SCHED;
            PG8_STAGE(PG8_SB(1, 1), b3 + hstep, voffB);
            PG8_WAIT_V(6); PG8_BAR; PG8_MMA(1, 1, At, B1); PG8_BAR;
        }
        PG8_STAMP();
        if constexpr (!Epi::AFTER_DRAIN) { E(acc, cur, wr, wc, fr, fq); S.done(cur); }
        PG8_STAMP();
        if (!has_next) break;
#pragma unroll
        for (int a = 0; a < 2; ++a)
#pragma unroll
            for (int b = 0; b < 2; ++b)
#pragma unroll
                for (int m = 0; m < 4; ++m)
#pragma unroll
                    for (int n = 0; n < 2; ++n) acc[a][b][m][n] = (f32x4){0.f, 0.f, 0.f, 0.f};
        cur = nxt; cA = nA; cB = nB; ++ui;
    }
    PG8_WAIT_V(0);
    if (wr == 0) PG8_BAR;
    PG8_BAR;
    if constexpr (Epi::AFTER_DRAIN) { E.fused(acc, cur, wr, wc, fr, fq, lds, wid, lane); S.done(cur); }
    PG8_STAMP();
    if (STAMP && wid == 0) { stamps[lane] = lane < nts ? (((unsigned long long)(unsigned)ts_hi << 32) | (unsigned)ts_lo) : 0ull;
        if (lane == 62) stamps[62] = rt_entry; if (lane == 63) stamps[63] = (unsigned long long)wall_clock64(); }
#undef PG8_STAMP
#undef PG8_SA
#undef PG8_SB
#undef PG8_STAGE
#undef PG8_LDA
#undef PG8_LDB
#undef PG8_MMA
#undef PG8_WAIT_V
#undef PG8_WAIT_L
#undef PG8_BAR
#undef PG8_SCHED
}
}

namespace pg8 {
struct EpiProj {
    static constexpr bool PERM = true, AFTER_DRAIN = false;
    bf16_t* O; int ldc; int ncols;
    __device__ __forceinline__ void operator()(const f32x4 (&acc)[2][2][4][2], const Unit& u, int wr, int wc, int fr, int fq) const {
        const int row0 = u.pm * BM + wr * 64 + fr; const int col0 = u.pn * BM + wc * 32 + 8 * fq;
#pragma unroll
        for (int ai = 0; ai < 2; ++ai)
#pragma unroll
            for (int m = 0; m < 4; ++m) { bf16_t* rowp = O + (size_t)(row0 + ai * HALF + m * 16) * ldc + col0;
#pragma unroll
                for (int bj = 0; bj < 2; ++bj) { const f32x4 v0 = acc[ai][bj][m][0], v1 = acc[ai][bj][m][1];
                    u32x4 w; w.x = cvt_pk_bf16(v0[0], v0[1]); w.y = cvt_pk_bf16(v0[2], v0[3]); w.z = cvt_pk_bf16(v1[0], v1[1]); w.w = cvt_pk_bf16(v1[2], v1[3]);
                    if (col0 + bj * HALF < ncols) *(u32x4*)(rowp + bj * HALF) = w; } }
    }
};
struct EpiU {
    static constexpr bool PERM = true, AFTER_DRAIN = false;
    void* O; int ldc; int ncols; int f32out;
    __device__ __forceinline__ void operator()(const f32x4 (&acc)[2][2][4][2], const Unit& u, int wr, int wc, int fr, int fq) const {
        const int row0 = u.pm * BM + wr * 64 + fr; const int col0 = u.pn * BM + wc * 32 + 8 * fq;
        if (f32out) {
#pragma unroll
            for (int ai = 0; ai < 2; ++ai)
#pragma unroll
                for (int m = 0; m < 4; ++m) { float* rowp = (float*)O + (size_t)(row0 + ai * HALF + m * 16) * ldc + col0;
#pragma unroll
                    for (int bj = 0; bj < 2; ++bj) { *(f32x4*)(rowp + bj * HALF) = acc[ai][bj][m][0]; *(f32x4*)(rowp + bj * HALF + 4) = acc[ai][bj][m][1]; } }
        } else {
#pragma unroll
            for (int ai = 0; ai < 2; ++ai)
#pragma unroll
                for (int m = 0; m < 4; ++m) { bf16_t* rowp = (bf16_t*)O + (size_t)(row0 + ai * HALF + m * 16) * ldc + col0;
#pragma unroll
                    for (int bj = 0; bj < 2; ++bj) { const f32x4 v0 = acc[ai][bj][m][0], v1 = acc[ai][bj][m][1];
                        u32x4 w; w.x = cvt_pk_bf16(v0[0], v0[1]); w.y = cvt_pk_bf16(v0[2], v0[3]); w.z = cvt_pk_bf16(v1[0], v1[1]); w.w = cvt_pk_bf16(v1[2], v1[3]);
                        if (col0 + bj * HALF < ncols) *(u32x4*)(rowp + bj * HALF) = w; } }
        }
    }
};
}

#define XB_TMO      128
#define XB_XCNT(j)  (256  + 64 * (j))
#define XB_XSUB(j)  (1280 + 64 * (j))
#define XB_XGEN(j)  (2304 + 64 * (j))
#define XB_TOP      3328
#define XB_TOPGEN   3392
#define XCD_BAR_WORDS 3456
#define XB_SPIN_CAP (1u << 18)
#define LAS __attribute__((address_space(3)))

__device__ __forceinline__ unsigned xb_ld(unsigned* p)              { return __hip_atomic_load(p, __ATOMIC_RELAXED, __HIP_MEMORY_SCOPE_AGENT); }
__device__ __forceinline__ unsigned xb_add(unsigned* p, unsigned v) { return __hip_atomic_fetch_add(p, v, __ATOMIC_RELAXED, __HIP_MEMORY_SCOPE_AGENT); }
__device__ __forceinline__ unsigned xb_xcc_id() { return (unsigned)__builtin_amdgcn_s_getreg((3 << 11) | 20) & 0xFu; }
#define XB_SPIN(cond, bar) do { unsigned _sp = 0; while (cond) { __builtin_amdgcn_s_sleep(1); \
    if ((++_sp & 255u) == 0u) { if (xb_ld(&(bar)[XB_TMO])) break; if (_sp > XB_SPIN_CAP) { atomicAdd(&(bar)[XB_TMO], 1u); break; } } } } while (0)

struct XcdBarrier {
    unsigned* bar; unsigned x;
    volatile LAS unsigned* st;
};

__device__ __forceinline__ XcdBarrier xcd_barrier_post(unsigned* bar, volatile LAS unsigned* st) {
    XcdBarrier b; b.bar = bar; b.x = xb_xcc_id(); b.st = st;
    if (threadIdx.x == 0) (void)xb_add(&bar[XB_XCNT(b.x)], 1u);
    return b;
}
__device__ __forceinline__ void xcd_barrier_complete(unsigned* bar, unsigned x, unsigned& nloc, unsigned& nx) {
    const unsigned G = gridDim.x * gridDim.y * gridDim.z;
    unsigned sum, cnt, mine, sp = 0u;
    for (;;) {
        sum = 0u; cnt = 0u; mine = 0u;
#pragma unroll
        for (unsigned j = 0; j < 16; ++j) { const unsigned c = xb_ld(&bar[XB_XCNT(j)]); sum += c; cnt += (c > 0u) ? 1u : 0u; mine = (j == x) ? c : mine; }
        if (sum == G) break;
        __builtin_amdgcn_s_sleep(1);
        if ((++sp & 255u) == 0u) { if (xb_ld(&bar[XB_TMO])) break; if (sp > XB_SPIN_CAP) { atomicAdd(&bar[XB_TMO], 1u); break; } }
    }
    nloc = mine > 0u ? mine : 1u; nx = cnt > 0u ? cnt : 1u;
}

__device__ __forceinline__ void xcd_barrier(const XcdBarrier& b) {
    asm volatile("s_waitcnt vmcnt(0)" ::: "memory");
    __syncthreads();
    if (threadIdx.x == 0) {
        unsigned* bar = b.bar;
        __builtin_amdgcn_s_waitcnt(0);
        unsigned nloc = b.st[0], nx = b.st[1];
        if (nloc == 0u) { xcd_barrier_complete(bar, b.x, nloc, nx); b.st[0] = nloc; b.st[1] = nx; }
        const unsigned old = xb_add(&bar[XB_XSUB(b.x)], 1u);
        const unsigned gen = old / nloc;
        if (old + 1u == (gen + 1u) * nloc) {
            __builtin_amdgcn_fence(__ATOMIC_RELEASE, "agent");
            asm volatile("s_waitcnt vmcnt(0)" ::: "memory");
            const unsigned og = xb_add(&bar[XB_TOP], 1u);
            const unsigned tg = og / nx;
            if (og + 1u == (tg + 1u) * nx) xb_add(&bar[XB_TOPGEN], 1u);
            else XB_SPIN(xb_ld(&bar[XB_TOPGEN]) == tg, bar);
            __builtin_amdgcn_fence(__ATOMIC_ACQUIRE, "agent");
            xb_add(&bar[XB_XGEN(b.x)], 1u);
            asm volatile("s_waitcnt vmcnt(0)" ::: "memory");
        } else {
            XB_SPIN(xb_ld(&bar[XB_XGEN(b.x)]) == gen, bar);
            __builtin_amdgcn_fence(__ATOMIC_ACQUIRE, "agent");
            asm volatile("s_waitcnt vmcnt(0)" ::: "memory");
        }
    }
    __syncthreads();
}

__device__ void phase_mod_item(const Params& p, int it, unsigned char* smem) {
  float* red = (float*)smem;
  const int tid = opaque_tid(), tx = tid & 31, ty = tid >> 5;
  float* mod = (float*)(p.ws + OFF_MOD);
  it = opq(it);
  {
    int l = it / 96;
    int j = (it % 96) * 32 + tx;
    const float* W = p.ada_w + (size_t)l * 1024 * 3072;
    float* cs = red + 256;
#pragma unroll
    for (int i = 0; i < 4; ++i) cs[tid + 256 * i] = silu(p.c[tid + 256 * i]);
    __syncthreads();
    float acc = 0.f;
#pragma unroll 1
    for (int i0 = 0; i0 < 128; i0 += 16) {
      float wv[16];
#pragma unroll
      for (int i = 0; i < 16; ++i) wv[i] = W[(size_t)(ty * 128 + i0 + i) * 3072 + j];
#pragma unroll
      for (int i = 0; i < 16; ++i) acc += cs[ty * 128 + i0 + i] * wv[i];
    }
    red[ty * 32 + tx] = acc;
    __syncthreads();
    if (ty == 0) {
      float s = 0.f;
      for (int g = 0; g < 8; ++g) s += red[g * 32 + tx];
      mod[l * 3072 + j] = s + p.ada_b[l * 3072 + j];
    }
    __syncthreads();
  }
}

__device__ __forceinline__ float wall_src(const Params& p, int l, int k, int n) {
  size_t lk = (size_t)l * 1024 + k;
  if (n < 3072) return p.w_in[lk * 3072 + n];
  if (n < 3136) return (1.f - p.mu_w[lk]) * p.w1[lk * 64 + (n - 3072)];
  if (n < 3200) return p.mu_w[lk] * p.w1[lk * 64 + (n - 3136)];
  if (n < 3264) return (1.f - p.mu_a[lk]) * p.a1[lk * 64 + (n - 3200)];
  if (n < 3328) return p.mu_a[lk] * p.a1[lk * 64 + (n - 3264)];
  if (n < 3344) return p.gk1[lk * 16 + (n - 3328)];
  return 0.f;
}

__device__ void phase_wconv_item(const Params& p, int it, unsigned char* smem) {
  float* tile = (float*)smem;
  const int tid = opaque_tid();
  u16* WALL = (u16*)(p.ws + OFF_WALL);
  u16* WOUT = (u16*)(p.ws + OFF_WOUT);
  it = opq(it);
  {
    bool isout = it >= 3456;
    int l, nt, kt;
    if (!isout) { l = it / 864; int r = it % 864; nt = r >> 4; kt = r & 15; }
    else { int r = it - 3456; l = r >> 8; r &= 255; nt = r >> 4; kt = r & 15; }
    if (isout || nt < 48) {
      const float* src = isout ? p.w_out + (size_t)l * 1024 * 1024 : p.w_in + (size_t)l * 1024 * 3072;
      const int ld = isout ? 1024 : 3072;
      const int n4 = (tid & 15) * 4, k0 = tid >> 4;
      float4 v4[4];
#pragma unroll
      for (int i = 0; i < 4; ++i) v4[i] = *(const float4*)(src + (size_t)(kt * 64 + k0 + 16 * i) * ld + nt * 64 + n4);
#pragma unroll
      for (int i = 0; i < 4; ++i) {
        float* tp = tile + (k0 + 16 * i) * 65 + n4;
        tp[0] = v4[i].x; tp[1] = v4[i].y; tp[2] = v4[i].z; tp[3] = v4[i].w;
      }
    } else {
      int tx = tid & 63, ty = tid >> 6;
#pragma unroll
      for (int i = 0; i < 16; ++i) {
        int kl = ty + 4 * i;
        int k = kt * 64 + kl, n = nt * 64 + tx;
        tile[kl * 65 + tx] = wall_src(p, l, k, n);
      }
    }
    __syncthreads();
    int nl = tid >> 2, kq = tid & 3;
    unsigned w[8];
#pragma unroll
    for (int j = 0; j < 8; ++j) w[j] = pack2(tile[(kq * 16 + 2 * j) * 65 + nl], tile[(kq * 16 + 2 * j + 1) * 65 + nl]);
    u16* dst = (isout ? WOUT + ((size_t)l * 1024 + nt * 64 + nl) * 1024 : WALL + ((size_t)l * NALL + nt * 64 + nl) * 1024) + kt * 64 + kq * 16;
    ((uint4*)dst)[0] = make_uint4(w[0], w[1], w[2], w[3]);
    ((uint4*)dst)[1] = make_uint4(w[4], w[5], w[6], w[7]);
    __syncthreads();
  }
}

__device__ void phase_w2t_item(const Params& p, int it) {
  it = opq(it);
  const int c = opaque_tid();
  const int l = it >> 1, which = it & 1;
  const float* src = (which ? p.a2 : p.w2) + (size_t)l * 64 * 256 + c;
  u16* dst = (u16*)(p.ws + (which ? OFF_A2T : OFF_W2T)) + ((size_t)l * 256 + c) * 64;
#pragma unroll
  for (int j8 = 0; j8 < 8; ++j8) {
    float f[8];
#pragma unroll
    for (int q = 0; q < 8; ++q) f[q] = src[(j8 * 8 + q) * 256];
    *(uint4*)(dst + j8 * 8) = make_uint4(pack2(f[0], f[1]), pack2(f[2], f[3]), pack2(f[4], f[5]), pack2(f[6], f[7]));
  }
}

__device__ void phase_h0(const Params& p) {
  const int tid = opaque_tid512(); const int wave = tid >> 6, lane = tid & 63;
  const float* mod = (const float*)(p.ws + OFF_MOD);
  u16* H = (u16*)(p.ws + OFF_H);
  float4 hs[4], hh[4];
#pragma unroll
  for (int i = 0; i < 4; ++i) {
    const int col = (lane + 64 * i) * 4;
    const float4 gp = *(const float4*)(p.norm_pre + col), sc = *(const float4*)(mod + 1024 + col);
    hs[i] = make_float4(gp.x * (1.f + sc.x), gp.y * (1.f + sc.y), gp.z * (1.f + sc.z), gp.w * (1.f + sc.w));
    hh[i] = *(const float4*)(mod + col);
  }
  const int stride = gridDim.x * 8;
  int row = blockIdx.x * 8 + wave;
  float4 v[4];
#pragma unroll
  for (int i = 0; i < 4; ++i) v[i] = ((const float4*)(p.x + (size_t)row * 1024))[lane + 64 * i];
  for (; row < T_; row += stride) {
    const int nrow = (row + stride < T_) ? row + stride : row;
    float4 vn[4];
#pragma unroll
    for (int i = 0; i < 4; ++i) vn[i] = ((const float4*)(p.x + (size_t)nrow * 1024))[lane + 64 * i];
    float ss = 0.f;
#pragma unroll
    for (int i = 0; i < 4; ++i) ss += v[i].x * v[i].x + v[i].y * v[i].y + v[i].z * v[i].z + v[i].w * v[i].w;
    ss = wave_sum(ss);
    const float r2 = rsqrtf(ss * (1.f / 1024.f) + 1e-6f);
#pragma unroll
    for (int i = 0; i < 4; ++i) {
      const int col = (lane + 64 * i) * 4;
      const float h0 = v[i].x * r2 * hs[i].x + hh[i].x, h1 = v[i].y * r2 * hs[i].y + hh[i].y;
      const float h2 = v[i].z * r2 * hs[i].z + hh[i].z, h3 = v[i].w * r2 * hs[i].w + hh[i].w;
      *(uint2*)(H + (size_t)row * 1024 + col) = make_uint2(pack2(h0, h1), pack2(h2, h3));
    }
#pragma unroll
    for (int i = 0; i < 4; ++i) v[i] = vn[i];
  }
}

__device__ void phase_post(const Params& p, int l) {
  l = opq(l);
  const int tid = opaque_tid512(); const int wave = tid >> 6, lane = tid & 63;
  const u16* Y = (const u16*)(p.ws + OFF_PROJ);
  const float* mod = (const float*)(p.ws + OFF_MOD) + l * 3072;
  const float* modn = (const float*)(p.ws + OFF_MOD) + (l < 3 ? l + 1 : l) * 3072;
  const float* xold = (l == 0) ? p.x : p.out;
  u16* H = (u16*)(p.ws + OFF_H);
  float4 gg[4], hs[4], hh[4];
#pragma unroll
  for (int i = 0; i < 4; ++i) {
    const int col = (lane + 64 * i) * 4;
    const float4 g = *(const float4*)(p.norm_post + l * 1024 + col), gt = *(const float4*)(mod + 2048 + col);
    gg[i] = make_float4(g.x * gt.x, g.y * gt.y, g.z * gt.z, g.w * gt.w);
    const float4 gp = *(const float4*)(p.norm_pre + (l < 3 ? l + 1 : l) * 1024 + col), sc = *(const float4*)(modn + 1024 + col);
    hs[i] = make_float4(gp.x * (1.f + sc.x), gp.y * (1.f + sc.y), gp.z * (1.f + sc.z), gp.w * (1.f + sc.w));
    hh[i] = *(const float4*)(modn + col);
  }
  const int stride = gridDim.x * 8;
  int row = blockIdx.x * 8 + wave;
  uint2 yu[4]; float4 v[4];
#pragma unroll
  for (int i = 0; i < 4; ++i) { yu[i] = ((const uint2*)(Y + (size_t)row * 1024))[lane + 64 * i]; v[i] = ((const float4*)(xold + (size_t)row * 1024))[lane + 64 * i]; }
  for (; row < T_; row += stride) {
    const int nrow = (row + stride < T_) ? row + stride : row;
    uint2 yn[4]; float4 vn[4];
#pragma unroll
    for (int i = 0; i < 4; ++i) { yn[i] = ((const uint2*)(Y + (size_t)nrow * 1024))[lane + 64 * i]; vn[i] = ((const float4*)(xold + (size_t)nrow * 1024))[lane + 64 * i]; }
    float4 y[4];
    float ss = 0.f;
#pragma unroll
    for (int i = 0; i < 4; ++i) {
      y[i] = make_float4(bflo(yu[i].x), bfhi(yu[i].x), bflo(yu[i].y), bfhi(yu[i].y));
      ss += y[i].x * y[i].x + y[i].y * y[i].y + y[i].z * y[i].z + y[i].w * y[i].w;
    }
    ss = wave_sum(ss);
    const float rs = rsqrtf(ss * (1.f / 1024.f) + 1e-6f);
    float s2 = 0.f;
#pragma unroll
    for (int i = 0; i < 4; ++i) {
      const int col = (lane + 64 * i) * 4;
      v[i].x += gg[i].x * (y[i].x * rs);
      v[i].y += gg[i].y * (y[i].y * rs);
      v[i].z += gg[i].z * (y[i].z * rs);
      v[i].w += gg[i].w * (y[i].w * rs);
      *(float4*)(p.out + (size_t)row * 1024 + col) = v[i];
      s2 += v[i].x * v[i].x + v[i].y * v[i].y + v[i].z * v[i].z + v[i].w * v[i].w;
    }
    if (l < 3) {
      s2 = wave_sum(s2);
      const float r2 = rsqrtf(s2 * (1.f / 1024.f) + 1e-6f);
#pragma unroll
      for (int i = 0; i < 4; ++i) {
        const int col = (lane + 64 * i) * 4;
        const float h0 = v[i].x * r2 * hs[i].x + hh[i].x, h1 = v[i].y * r2 * hs[i].y + hh[i].y;
        const float h2 = v[i].z * r2 * hs[i].z + hh[i].z, h3 = v[i].w * r2 * hs[i].w + hh[i].w;
        *(uint2*)(H + (size_t)row * 1024 + col) = make_uint2(pack2(h0, h1), pack2(h2, h3));
      }
    }
#pragma unroll
    for (int i = 0; i < 4; ++i) { yu[i] = yn[i]; v[i] = vn[i]; }
  }
}

__device__ void attn_item(const Params& p, int l, int item, unsigned char* smem) {
  l = opq(l); item = opq(item);
  u16* Vt = (u16*)smem;
  const u16* PROJ = (const u16*)(p.ws + OFF_PROJ);
  u16* MIX = (u16*)(p.ws + OFF_MIX);
  const int tid = opaque_tid(), w = tid >> 6, lane = tid & 63, l31 = lane & 31, hf = lane >> 5;
  const int qb = item >> 3, head = item & 7, kvh = head >> 2;
  const int kpos0 = (qb - 1) * 128;
  {
    int kp = kpos0 + tid;
    if (kp < 0) kp = 0;
    const uint4* src = (const uint4*)(PROJ + (size_t)kp * NALL + 640 + kvh * 64);
#pragma unroll
    for (int c8 = 0; c8 < 8; ++c8) {
      uint4 v = src[c8];
      int d = c8 * 8;
      Vt[(d + 0) * 264 + tid] = (u16)(v.x & 0xffff);
      Vt[(d + 1) * 264 + tid] = (u16)(v.x >> 16);
      Vt[(d + 2) * 264 + tid] = (u16)(v.y & 0xffff);
      Vt[(d + 3) * 264 + tid] = (u16)(v.y >> 16);
      Vt[(d + 4) * 264 + tid] = (u16)(v.z & 0xffff);
      Vt[(d + 5) * 264 + tid] = (u16)(v.z >> 16);
      Vt[(d + 6) * 264 + tid] = (u16)(v.w & 0xffff);
      Vt[(d + 7) * 264 + tid] = (u16)(v.w >> 16);
    }
  }
  const int tq = qb * 128 + 32 * w + l31;
  bf16x8 qf[4], kc[4];
  {
    const u16* qp = PROJ + (size_t)tq * NALL + head * 64 + 8 * hf;
#pragma unroll
    for (int s = 0; s < 4; ++s) qf[s] = *(const bf16x8*)(qp + 16 * s);
    int kp = kpos0 + 32 * w + l31;
    if (kp < 0) kp = 0;
    const u16* kptr = PROJ + (size_t)kp * NALL + 512 + kvh * 64 + 8 * hf;
#pragma unroll
    for (int s = 0; s < 4; ++s) kc[s] = *(const bf16x8*)(kptr + 16 * s);
  }
  __syncthreads();
  const float slope = exp2f(-(float)(head + 1));
  const float sink = p.sinks[l * 8 + head];
  const int rq = 32 * w + l31;
  const u16* gp = PROJ + (size_t)tq * NALL + 768 + head * 64;
  uint2 gA[4], gB[4];
#pragma unroll
  for (int g = 0; g < 4; ++g) { gA[g] = *(const uint2*)(gp + 8 * g + 4 * hf); gB[g] = *(const uint2*)(gp + 32 + 8 * g + 4 * hf); }
  float mrun = -1e30f, lsum = 0.f;
  f32x16 o0, o1;
#pragma unroll
  for (int r = 0; r < 16; ++r) { o0[r] = 0.f; o1[r] = 0.f; }
#pragma unroll 1
  for (int i = 0; i < 5; ++i) {
    bf16x8 kn[4];
    {
      const int in_ = (i < 4) ? i + 1 : 4;
      int kp = kpos0 + 32 * w + 32 * in_ + l31;
      if (kp < 0) kp = 0;
      const u16* kptr = PROJ + (size_t)kp * NALL + 512 + kvh * 64 + 8 * hf;
#pragma unroll
      for (int s = 0; s < 4; ++s) kn[s] = *(const bf16x8*)(kptr + 16 * s);
    }
    f32x16 a;
#pragma unroll
    for (int r = 0; r < 16; ++r) a[r] = 0.f;
#pragma unroll
    for (int s = 0; s < 4; ++s) a = __builtin_amdgcn_mfma_f32_32x32x16_bf16(kc[s], qf[s], a, 0, 0, 0);
#pragma unroll
    for (int s = 0; s < 4; ++s) kc[s] = kn[s];
    float tmax = -1e30f;
    if (i >= 1 && i <= 3 && qb > 0) {
      const float c0 = -slope * (float)(128 + rq - 32 * w - 32 * i - 4 * hf);
#pragma unroll
      for (int r = 0; r < 16; ++r) {
        const float sv = a[r] * 0.125f + (c0 + slope * (float)((r & 3) + 8 * (r >> 2)));
        a[r] = sv;
        tmax = fmaxf(tmax, sv);
      }
    } else {
#pragma unroll
      for (int r = 0; r < 16; ++r) {
        int kj = 32 * w + 32 * i + (r & 3) + 8 * (r >> 2) + 4 * hf;
        int dist = 128 + rq - kj;
        bool valid = (dist >= 0) && (dist < 128) && (kpos0 + kj >= 0);
        float sv = a[r] * 0.125f - slope * (float)dist;
        sv = valid ? sv : -1e30f;
        a[r] = sv;
        tmax = fmaxf(tmax, sv);
      }
    }
    tmax = fmaxf(tmax, __shfl_xor(tmax, 32));
    const float mnew = fmaxf(mrun, tmax);
    const float alpha = __expf(mrun - mnew);
    float psum = 0.f;
#pragma unroll
    for (int r = 0; r < 16; ++r) {
      float e = (a[r] > -1e29f) ? __expf(a[r] - mnew) : 0.f;
      a[r] = e;
      psum += e;
    }
    lsum = lsum * alpha + psum;
    mrun = mnew;
#pragma unroll
    for (int r = 0; r < 16; ++r) { o0[r] *= alpha; o1[r] *= alpha; }
#pragma unroll
    for (int u = 0; u < 2; ++u) {
      bf16x8 pf;
#pragma unroll
      for (int j = 0; j < 8; ++j) pf[j] = (short)f2bf(a[8 * u + j]);
      const int kb = 32 * w + 32 * i + 16 * u + 4 * hf;
      const u16* v0 = Vt + l31 * 264 + kb;
      const u16* v1 = Vt + (32 + l31) * 264 + kb;
      uint2 a0 = *(const uint2*)(v0), a1 = *(const uint2*)(v0 + 8);
      uint2 b0 = *(const uint2*)(v1), b1 = *(const uint2*)(v1 + 8);
      uint4 A0 = make_uint4(a0.x, a0.y, a1.x, a1.y), A1 = make_uint4(b0.x, b0.y, b1.x, b1.y);
      o0 = __builtin_amdgcn_mfma_f32_32x32x16_bf16(__builtin_bit_cast(bf16x8, A0), pf, o0, 0, 0, 0);
      o1 = __builtin_amdgcn_mfma_f32_32x32x16_bf16(__builtin_bit_cast(bf16x8, A1), pf, o1, 0, 0, 0);
    }
  }
  {
    const float mf = fmaxf(mrun, sink);
    const float scl = __expf(mrun - mf);
    const float ltot = (lsum + __shfl_xor(lsum, 32)) * scl + __expf(sink - mf);
    const float fin = scl / ltot;
#pragma unroll
    for (int r = 0; r < 16; ++r) { o0[r] *= fin; o1[r] *= fin; }
  }
  u16* op = MIX + (size_t)tq * 1024 + head * 64;
#pragma unroll
  for (int g = 0; g < 4; ++g) {
    int d0 = 8 * g + 4 * hf;
    uint2 gg = gA[g];
    float r0 = o0[4 * g + 0] * silu(bflo(gg.x)), r1 = o0[4 * g + 1] * silu(bfhi(gg.x));
    float r2 = o0[4 * g + 2] * silu(bflo(gg.y)), r3 = o0[4 * g + 3] * silu(bfhi(gg.y));
    *(uint2*)(op + d0) = make_uint2(pack2(r0, r1), pack2(r2, r3));
    uint2 g2 = gB[g];
    r0 = o1[4 * g + 0] * silu(bflo(g2.x)); r1 = o1[4 * g + 1] * silu(bfhi(g2.x));
    r2 = o1[4 * g + 2] * silu(bflo(g2.y)); r3 = o1[4 * g + 3] * silu(bfhi(g2.y));
    *(uint2*)(op + 32 + d0) = make_uint2(pack2(r0, r1), pack2(r2, r3));
  }
  __syncthreads();
}

__device__ void rwkv_prep_item(const Params& p, int l, int item, unsigned char* smem) {
  l = opq(l); item = opq(item);
  u16* lwb = (u16*)smem;
  u16* lab = lwb + 16 * 72;
  const u16* PROJ = (const u16*)(p.ws + OFF_PROJ);
  const int tid = opaque_tid(), head = tid >> 6, lane = tid & 63, fr = lane & 15, fq = lane >> 4;
  const int t0 = item * 16;
  {
    const int which = tid >> 7, tt = (tid >> 3) & 15, j0 = (tid & 7) * 8;
    const int t = t0 + tt;
    const u16* pr = PROJ + (size_t)t * NALL;
    const u16* pq = (t > 0) ? pr - NALL : pr;
    const float pm = (t > 0) ? 1.f : 0.f;
    const uint4 cu = *(const uint4*)(pr + (which ? 3200 : 3072) + j0);
    const uint4 pu = *(const uint4*)(pq + (which ? 3264 : 3136) + j0);
    float sv[8];
    sv[0] = bflo(cu.x) + pm * bflo(pu.x); sv[1] = bfhi(cu.x) + pm * bfhi(pu.x);
    sv[2] = bflo(cu.y) + pm * bflo(pu.y); sv[3] = bfhi(cu.y) + pm * bfhi(pu.y);
    sv[4] = bflo(cu.z) + pm * bflo(pu.z); sv[5] = bfhi(cu.z) + pm * bfhi(pu.z);
    sv[6] = bflo(cu.w) + pm * bflo(pu.w); sv[7] = bfhi(cu.w) + pm * bfhi(pu.w);
    if (!which) {
#pragma unroll
      for (int q = 0; q < 8; ++q) sv[q] = tanh_fast(sv[q]);
    }
    *(uint4*)((which ? lab : lwb) + tt * 72 + j0) = make_uint4(pack2(sv[0], sv[1]), pack2(sv[2], sv[3]), pack2(sv[4], sv[5]), pack2(sv[6], sv[7]));
  }
  __syncthreads();
  f32x4 accw[4], acca[4];
#pragma unroll
  for (int nt = 0; nt < 4; ++nt) { accw[nt] = (f32x4){0.f, 0.f, 0.f, 0.f}; acca[nt] = (f32x4){0.f, 0.f, 0.f, 0.f}; }
  {
    const u16* W2T = (const u16*)(p.ws + OFF_W2T) + ((size_t)l * 256 + head * 64 + fr * 4) * 64 + fq * 8;
    const u16* A2T = (const u16*)(p.ws + OFF_A2T) + ((size_t)l * 256 + head * 64 + fr * 4) * 64 + fq * 8;
#pragma unroll
    for (int ks = 0; ks < 2; ++ks) {
      const bf16x8 aw = *(const bf16x8*)(lwb + fr * 72 + ks * 32 + fq * 8);
      const bf16x8 aa = *(const bf16x8*)(lab + fr * 72 + ks * 32 + fq * 8);
#pragma unroll
      for (int nt = 0; nt < 4; ++nt) {
        const bf16x8 bw = *(const bf16x8*)(W2T + nt * 64 + ks * 32);
        const bf16x8 ba = *(const bf16x8*)(A2T + nt * 64 + ks * 32);
        accw[nt] = __builtin_amdgcn_mfma_f32_16x16x32_bf16(aw, bw, accw[nt], 0, 0, 0);
        acca[nt] = __builtin_amdgcn_mfma_f32_16x16x32_bf16(aa, ba, acca[nt], 0, 0, 0);
      }
    }
  }
  const int c0 = head * 64 + fr * 4;
  const float4 mur = *(const float4*)(p.mu_rkv + l * 768 + c0), muk = *(const float4*)(p.mu_rkv + l * 768 + 256 + c0), muv = *(const float4*)(p.mu_rkv + l * 768 + 512 + c0);
  const float4 w0 = *(const float4*)(p.w0 + l * 256 + c0), a0 = *(const float4*)(p.a0 + l * 256 + c0);
  const float4 kkw = *(const float4*)(p.k_k + l * 256 + c0), kaw = *(const float4*)(p.k_a + l * 256 + c0), rkw = *(const float4*)(p.r_k + l * 256 + c0);
  float* RWW = (float*)(p.ws + OFF_RWW);
  u16* RWKK = (u16*)(p.ws + OFF_RWKK);
  u16* RB = (u16*)(p.ws + OFF_RWB);
  float* BON = (float*)(p.ws + OFF_BONUS);
#define F4E(v, i) ((i) == 0 ? v.x : (i) == 1 ? v.y : (i) == 2 ? v.z : v.w)
#pragma unroll
  for (int rg = 0; rg < 4; ++rg) {
    const int t = t0 + fq * 4 + rg;
    const u16* pr = PROJ + (size_t)t * NALL;
    const u16* pp = (t > 0) ? pr - NALL : pr;
    const float pm = (t > 0) ? 1.f : 0.f;
    const uint2 rcu = *(const uint2*)(pr + 1280 + c0), kcu = *(const uint2*)(pr + 1536 + c0), vcu = *(const uint2*)(pr + 1792 + c0);
    const uint2 rpu = *(const uint2*)(pp + 1280 + c0), kpu = *(const uint2*)(pp + 1536 + c0), vpu = *(const uint2*)(pp + 1792 + c0);
    const float rc[4] = {bflo(rcu.x), bfhi(rcu.x), bflo(rcu.y), bfhi(rcu.y)}, kc[4] = {bflo(kcu.x), bfhi(kcu.x), bflo(kcu.y), bfhi(kcu.y)};
    const float vc[4] = {bflo(vcu.x), bfhi(vcu.x), bflo(vcu.y), bfhi(vcu.y)};
    const float rp[4] = {bflo(rpu.x), bfhi(rpu.x), bflo(rpu.y), bfhi(rpu.y)}, kp[4] = {bflo(kpu.x), bfhi(kpu.x), bflo(kpu.y), bfhi(kpu.y)};
    const float vp[4] = {bflo(vpu.x), bfhi(vpu.x), bflo(vpu.y), bfhi(vpu.y)};
    float kkc[4], av[4], dec[4], rr[4], km[4], vv[4];
    float n2 = 0.f, bonus = 0.f;
#pragma unroll
    for (int nt = 0; nt < 4; ++nt) {
      const float r = rc[nt] + (pm * rp[nt] - rc[nt]) * F4E(mur, nt), k = kc[nt] + (pm * kp[nt] - kc[nt]) * F4E(muk, nt), v = vc[nt] + (pm * vp[nt] - vc[nt]) * F4E(muv, nt);
      const float wpre = F4E(w0, nt) + accw[nt][rg];
      const float wl = -softplusf_(-wpre) - 0.5f;
      dec[nt] = __expf(-__expf(wl));
      const float a = sigmoidf_(F4E(a0, nt) + acca[nt][rg]);
      const float kc2 = k * F4E(kkw, nt);
      const float kmod = k * (1.f + (a - 1.f) * F4E(kaw, nt));
      kkc[nt] = kc2; av[nt] = a; rr[nt] = r; km[nt] = kmod; vv[nt] = v;
      n2 += kc2 * kc2;
      bonus += r * kmod * F4E(rkw, nt);
    }
    n2 = row16_allsum(n2);
    bonus = row16_allsum(bonus);
    const float inv = __builtin_amdgcn_rsqf(fmaxf(n2, 1e-24f));
    const size_t o = (size_t)t * 256 + c0;
    *(float4*)(RWW + o) = make_float4(dec[0], dec[1], dec[2], dec[3]);
    *(uint2*)(RWKK + o) = make_uint2(pack2(-kkc[0] * inv, -kkc[1] * inv), pack2(-kkc[2] * inv, -kkc[3] * inv));
    *(uint2*)(RB + o) = make_uint2(pack2(rr[0], rr[1]), pack2(rr[2], rr[3]));
    *(uint2*)(RB + (size_t)T_ * 256 + o) = make_uint2(pack2(km[0], km[1]), pack2(km[2], km[3]));
    *(uint2*)(RB + (size_t)2 * T_ * 256 + o) = make_uint2(pack2(vv[0], vv[1]), pack2(vv[2], vv[3]));
    *(uint2*)(RB + (size_t)3 * T_ * 256 + o) = make_uint2(pack2(kkc[0] * inv * av[0], kkc[1] * inv * av[1]), pack2(kkc[2] * inv * av[2], kkc[3] * inv * av[3]));
    if (fr == 0) BON[t * 4 + head] = bonus;
  }
  __syncthreads();
}

__device__ __forceinline__ void gla_b(const Params& p, int l, int head, const u16* lgs, float* tot, float* bl) {
  const int tid = opaque_tid(), d = tid & 31, ig = tid >> 5;
  float g2[16];
#pragma unroll
  for (int m = 0; m < 16; ++m) g2[m] = p.gk2[(size_t)l * 16 * 128 + m * 128 + head * 32 + d];
  const float bias = p.gk_b[l * 128 + head * 32 + d];
  float run = 0.f;
#pragma unroll
  for (int ii = 0; ii < 8; ++ii) {
    const uint4* lp = (const uint4*)(lgs + (ig * 8 + ii) * 16);
    uint4 u0 = lp[0], u1 = lp[1];
    float z = bias;
    z += bflo(u0.x) * g2[0] + bfhi(u0.x) * g2[1] + bflo(u0.y) * g2[2] + bfhi(u0.y) * g2[3];
    z += bflo(u0.z) * g2[4] + bfhi(u0.z) * g2[5] + bflo(u0.w) * g2[6] + bfhi(u0.w) * g2[7];
    z += bflo(u1.x) * g2[8] + bfhi(u1.x) * g2[9] + bflo(u1.y) * g2[10] + bfhi(u1.y) * g2[11];
    z += bflo(u1.z) * g2[12] + bfhi(u1.z) * g2[13] + bflo(u1.w) * g2[14] + bfhi(u1.w) * g2[15];
    float g = (fminf(z, 0.f) - __logf(1.f + __expf(-fabsf(z)))) * (1.f / 16.f);
    run += g;
    bl[ii] = run;
  }
  tot[ig * 32 + d] = run;
  __syncthreads();
  float off = 0.f;
#pragma unroll
  for (int g = 0; g < 8; ++g) off += (g < ig) ? tot[g * 32 + d] : 0.f;
#pragma unroll
  for (int ii = 0; ii < 8; ++ii) bl[ii] += off;
}
__device__ __forceinline__ void st8f(float* dst, const uint4 u) {
  *(float4*)(dst) = make_float4(bflo(u.x), bfhi(u.x), bflo(u.y), bfhi(u.y));
  *(float4*)(dst + 4) = make_float4(bflo(u.z), bfhi(u.z), bflo(u.w), bfhi(u.w));
}

__device__ void gla_local_item(const Params& p, int l, int item, unsigned char* smem) {
  l = opq(l); item = opq(item);
  float* tot = (float*)smem;
  float* kf = tot + 256;
  u16* KpT = (u16*)(kf + 2304);
  u16* Vt = KpT + 2304;
  u16* lgs = Vt + 4608;
  const u16* PROJ = (const u16*)(p.ws + OFF_PROJ);
  const int tid = opaque_tid(), d = tid & 31, ig = tid >> 5;
  const int chunk = item >> 2, head = item & 3;
  {
    const u16* base = PROJ + (size_t)(chunk * 64) * NALL;
    const int ki = tid >> 2, kd0 = (tid & 3) * 8;
    const uint4 ku = *(const uint4*)(base + (size_t)ki * NALL + 2432 + head * 32 + kd0);
    const int g0 = tid, g1 = tid + 256;
    const uint4 vu0 = *(const uint4*)(base + (size_t)(g0 >> 3) * NALL + 2560 + head * 64 + (g0 & 7) * 8);
    const uint4 vu1 = *(const uint4*)(base + (size_t)(g1 >> 3) * NALL + 2560 + head * 64 + (g1 & 7) * 8);
    uint4 lu = make_uint4(0u, 0u, 0u, 0u);
    if (tid < 128) lu = *(const uint4*)(base + (size_t)(tid >> 1) * NALL + 3328 + (tid & 1) * 8);
    st8f(kf + ki * 36 + kd0, ku);
    {
      const int j0 = g0 >> 3, c0 = (g0 & 7) * 8, j1 = g1 >> 3, c1 = (g1 & 7) * 8;
      const unsigned w0[4] = {vu0.x, vu0.y, vu0.z, vu0.w}, w1[4] = {vu1.x, vu1.y, vu1.z, vu1.w};
#pragma unroll
      for (int q = 0; q < 4; ++q) {
        Vt[(c0 + 2 * q) * 72 + j0] = (u16)(w0[q] & 0xffff); Vt[(c0 + 2 * q + 1) * 72 + j0] = (u16)(w0[q] >> 16);
        Vt[(c1 + 2 * q) * 72 + j1] = (u16)(w1[q] & 0xffff); Vt[(c1 + 2 * q + 1) * 72 + j1] = (u16)(w1[q] >> 16);
      }
    }
    if (tid < 128) *(uint4*)(lgs + (tid >> 1) * 16 + (tid & 1) * 8) = lu;
  }
  __syncthreads();
  float bl[8];
  gla_b(p, l, head, lgs, tot, bl);
  float blast = 0.f;
#pragma unroll
  for (int g = 0; g < 8; ++g) blast += tot[g * 32 + d];
  {
    float kp[8];
#pragma unroll
    for (int ii = 0; ii < 8; ++ii) kp[ii] = kf[(ig * 8 + ii) * 36 + d] * __expf(blast - bl[ii]);
    *(uint4*)(KpT + d * 72 + ig * 8) = make_uint4(pack2(kp[0], kp[1]), pack2(kp[2], kp[3]), pack2(kp[4], kp[5]), pack2(kp[6], kp[7]));
  }
  __syncthreads();
  const int w = tid >> 6, lane = tid & 63, l31 = lane & 31, hf = lane >> 5;
  if (w < 2) {
    f32x16 c;
#pragma unroll
    for (int r = 0; r < 16; ++r) c[r] = 0.f;
#pragma unroll
    for (int ks = 0; ks < 4; ++ks) {
      const bf16x8 af = *(const bf16x8*)(KpT + l31 * 72 + 16 * ks + 8 * hf);
      const bf16x8 bfr = *(const bf16x8*)(Vt + (32 * w + l31) * 72 + 16 * ks + 8 * hf);
      c = __builtin_amdgcn_mfma_f32_32x32x16_bf16(af, bfr, c, 0, 0, 0);
    }
    float* GS = (float*)(p.ws + OFF_GLAS) + (size_t)(chunk * 4 + head) * 2048 + 32 * w + l31;
#pragma unroll
    for (int r = 0; r < 16; ++r) GS[((r & 3) + 8 * (r >> 2) + 4 * hf) * 64] = c[r];
  }
  float* GD = (float*)(p.ws + OFF_GLAD);
  if (tid < 32) GD[(chunk * 4 + head) * 32 + tid] = __expf(blast);
  __syncthreads();
}

#define GLA_STATE_LOAD(eb_) \
  const int gs_tid = opaque_tid512(); const int gs_ei = gs_tid & 31, gs_g = gs_tid >> 5; \
  const int gs_e = (eb_) * 32 + gs_ei; const int gs_head = gs_e >> 11, gs_d = (gs_e >> 6) & 31, gs_v = gs_e & 63; \
  float gs_ds[16], gs_dc[16]; \
  { float* GSl = (float*)(p.ws + OFF_GLAS); const float* GDl = (const float*)(p.ws + OFF_GLAD); \
    _Pragma("unroll") for (int i = 0; i < 16; ++i) { const int c = gs_g * 16 + i; \
      gs_ds[i] = GSl[((size_t)(c * 4 + gs_head) * 32 + gs_d) * 64 + gs_v]; gs_dc[i] = GDl[(c * 4 + gs_head) * 32 + gs_d]; } }
#define GLA_STATE_FINISH(dsm_) { \
    float* comp = (float*)(dsm_); float* GSl = (float*)(p.ws + OFF_GLAS); \
    float S = 0.f, P = 1.f; \
    _Pragma("unroll") for (int i = 0; i < 16; ++i) { S = gs_dc[i] * S + gs_ds[i]; P *= gs_dc[i]; } \
    comp[(gs_g * 32 + gs_ei) * 2] = P; comp[(gs_g * 32 + gs_ei) * 2 + 1] = S; \
    __syncthreads(); \
    float G = 0.f; \
    for (int gg = 0; gg < gs_g; ++gg) G = comp[(gg * 32 + gs_ei) * 2] * G + comp[(gg * 32 + gs_ei) * 2 + 1]; \
    _Pragma("unroll") for (int i = 0; i < 16; ++i) { const int c = gs_g * 16 + i; \
      GSl[((size_t)(c * 4 + gs_head) * 32 + gs_d) * 64 + gs_v] = G; G = gs_dc[i] * G + gs_ds[i]; } \
    __syncthreads(); }

__device__ void gla_out_item(const Params& p, int l, int item, unsigned char* smem) {
  l = opq(l); item = opq(item);
  float* tot = (float*)smem;
  float* red = tot + 256;
  float* qf = red + 128;
  float* kf = qf + 2304;
  u16* qt = (u16*)(kf + 2304);
  u16* kt = qt + 2560;
  u16* Vt = kt + 2560;
  u16* StT = Vt + 4608;
  u16* lgs = StT + 2560;
  const u16* PROJ = (const u16*)(p.ws + OFF_PROJ);
  u16* MIX = (u16*)(p.ws + OFF_MIX);
  const float* GS = (const float*)(p.ws + OFF_GLAS);
  const int tid = opaque_tid();
  const int chunk = item >> 2, head = item & 3;
  {
    const u16* base = PROJ + (size_t)(chunk * 64) * NALL;
    const int ki = tid >> 2, kd0 = (tid & 3) * 8;
    const uint4 qu = *(const uint4*)(base + (size_t)ki * NALL + 2304 + head * 32 + kd0);
    const uint4 ku = *(const uint4*)(base + (size_t)ki * NALL + 2432 + head * 32 + kd0);
    const int g0 = tid, g1 = tid + 256;
    const uint4 vu0 = *(const uint4*)(base + (size_t)(g0 >> 3) * NALL + 2560 + head * 64 + (g0 & 7) * 8);
    const uint4 vu1 = *(const uint4*)(base + (size_t)(g1 >> 3) * NALL + 2560 + head * 64 + (g1 & 7) * 8);
    const float4 s0 = ((const float4*)(GS + (size_t)(chunk * 4 + head) * 2048))[tid];
    const float4 s1 = ((const float4*)(GS + (size_t)(chunk * 4 + head) * 2048))[tid + 256];
    uint4 lu = make_uint4(0u, 0u, 0u, 0u);
    if (tid < 128) lu = *(const uint4*)(base + (size_t)(tid >> 1) * NALL + 3328 + (tid & 1) * 8);
    st8f(qf + ki * 36 + kd0, qu);
    st8f(kf + ki * 36 + kd0, ku);
    {
      const int j0 = g0 >> 3, c0 = (g0 & 7) * 8, j1 = g1 >> 3, c1 = (g1 & 7) * 8;
      const unsigned w0[4] = {vu0.x, vu0.y, vu0.z, vu0.w}, w1[4] = {vu1.x, vu1.y, vu1.z, vu1.w};
#pragma unroll
      for (int q = 0; q < 4; ++q) {
        Vt[(c0 + 2 * q) * 72 + j0] = (u16)(w0[q] & 0xffff); Vt[(c0 + 2 * q + 1) * 72 + j0] = (u16)(w0[q] >> 16);
        Vt[(c1 + 2 * q) * 72 + j1] = (u16)(w1[q] & 0xffff); Vt[(c1 + 2 * q + 1) * 72 + j1] = (u16)(w1[q] >> 16);
      }
    }
    {
      const int d0 = tid >> 4, v0 = (tid & 15) * 4, d1 = (tid + 256) >> 4;
      StT[(v0 + 0) * 40 + d0] = f2bf(s0.x); StT[(v0 + 1) * 40 + d0] = f2bf(s0.y); StT[(v0 + 2) * 40 + d0] = f2bf(s0.z); StT[(v0 + 3) * 40 + d0] = f2bf(s0.w);
      StT[(v0 + 0) * 40 + d1] = f2bf(s1.x); StT[(v0 + 1) * 40 + d1] = f2bf(s1.y); StT[(v0 + 2) * 40 + d1] = f2bf(s1.z); StT[(v0 + 3) * 40 + d1] = f2bf(s1.w);
    }
    if (tid < 128) *(uint4*)(lgs + (tid >> 1) * 16 + (tid & 1) * 8) = lu;
  }
  __syncthreads();
  {
    const int d = tid & 31, ig = tid >> 5;
    float bl[8];
    gla_b(p, l, head, lgs, tot, bl);
#pragma unroll
    for (int ii = 0; ii < 8; ++ii) {
      const int i = ig * 8 + ii;
      qt[i * 40 + d] = f2bf(qf[i * 36 + d] * 0.17677669529663687f * __expf(bl[ii]));
      kt[i * 40 + d] = f2bf(kf[i * 36 + d] * __expf(-bl[ii]));
    }
  }
  __syncthreads();
  const int w = tid >> 6, lane = tid & 63, l31 = lane & 31, hf = lane >> 5;
  const int it = w & 1, vt = w >> 1;
  const int t = chunk * 64 + 32 * it + l31;
  const u16* gp = PROJ + (size_t)t * NALL + 2816 + head * 64 + 32 * vt + 4 * hf;
  uint2 ggl[4];
#pragma unroll
  for (int g = 0; g < 4; ++g) ggl[g] = *(const uint2*)(gp + 8 * g);
  bf16x8 qfr[2];
#pragma unroll
  for (int ks = 0; ks < 2; ++ks) qfr[ks] = *(const bf16x8*)(qt + (32 * it + l31) * 40 + 16 * ks + 8 * hf);
  f32x16 o;
#pragma unroll
  for (int r = 0; r < 16; ++r) o[r] = 0.f;
#pragma unroll
  for (int jt = 0; jt < 2; ++jt) {
    if (jt <= it) {
      f32x16 c1;
#pragma unroll
      for (int r = 0; r < 16; ++r) c1[r] = 0.f;
#pragma unroll
      for (int ks = 0; ks < 2; ++ks) {
        const bf16x8 kfr = *(const bf16x8*)(kt + (32 * jt + l31) * 40 + 16 * ks + 8 * hf);
        c1 = __builtin_amdgcn_mfma_f32_32x32x16_bf16(kfr, qfr[ks], c1, 0, 0, 0);
      }
      if (jt == it) {
#pragma unroll
        for (int r = 0; r < 16; ++r) { const int jl = (r & 3) + 8 * (r >> 2) + 4 * hf; c1[r] = (jl <= l31) ? c1[r] : 0.f; }
      }
#pragma unroll
      for (int u = 0; u < 2; ++u) {
        bf16x8 pf;
#pragma unroll
        for (int j = 0; j < 8; ++j) pf[j] = (short)f2bf(c1[8 * u + j]);
        const u16* vp = Vt + (32 * vt + l31) * 72 + 32 * jt + 16 * u + 4 * hf;
        const uint2 a0 = *(const uint2*)(vp), a1 = *(const uint2*)(vp + 8);
        const uint4 A0 = make_uint4(a0.x, a0.y, a1.x, a1.y);
        o = __builtin_amdgcn_mfma_f32_32x32x16_bf16(__builtin_bit_cast(bf16x8, A0), pf, o, 0, 0, 0);
      }
    }
  }
#pragma unroll
  for (int ks = 0; ks < 2; ++ks) {
    const bf16x8 sfr = *(const bf16x8*)(StT + (32 * vt + l31) * 40 + 16 * ks + 8 * hf);
    o = __builtin_amdgcn_mfma_f32_32x32x16_bf16(sfr, qfr[ks], o, 0, 0, 0);
  }
  float part = 0.f;
#pragma unroll
  for (int r = 0; r < 16; ++r) part += o[r] * o[r];
  part += __shfl_xor(part, 32);
  if (hf == 0) red[vt * 64 + 32 * it + l31] = part;
  __syncthreads();
  const float ms = (red[32 * it + l31] + red[64 + 32 * it + l31]) * (1.f / 64.f);
  const float rs = rsqrtf(ms + 1e-5f);
  u16* op = MIX + (size_t)t * 1024 + 768 + head * 64 + 32 * vt + 4 * hf;
#pragma unroll
  for (int g = 0; g < 4; ++g) {
    const float4 nw = *(const float4*)(p.gla_nw + l * 64 + 32 * vt + 8 * g + 4 * hf);
    const uint2 gg = ggl[g];
    const float r0 = o[4 * g + 0] * rs * nw.x * silu(bflo(gg.x)), r1 = o[4 * g + 1] * rs * nw.y * silu(bfhi(gg.x));
    const float r2 = o[4 * g + 2] * rs * nw.z * silu(bflo(gg.y)), r3 = o[4 * g + 3] * rs * nw.w * silu(bfhi(gg.y));
    *(uint2*)(op + 8 * g) = make_uint2(pack2(r0, r1), pack2(r2, r3));
  }
  __syncthreads();
}

typedef float f32x2 __attribute__((ext_vector_type(2)));
__device__ __forceinline__ float oct_allsum(float x) {
  x += dpp_f<0xB1>(x);
  x += dpp_f<0x4E>(x);
  x += dpp_f<0x141>(x);
  return x;
}
__device__ void rwkv_scan_item(const Params& p, int item, unsigned char* dsm_) {
  item = opq(item);
  float* st = (float*)dsm_;
  const int tid = opaque_tid512(), wv = tid >> 6, lane = tid & 63, rs = lane >> 3, kl = lane & 7;
  const int head = item & 3, seg = item >> 2;
  const bool ident = wv >= 4;
  const int R0 = wv * 16 + rs * 2;
  const int v0 = R0 & 63;
  const float* RWW = (const float*)(p.ws + OFF_RWW);
  const u16* RWKK = (const u16*)(p.ws + OFF_RWKK);
  const u16* RB = (const u16*)(p.ws + OFF_RWB);
  float* PF = (float*)(p.ws + OFF_PROJ);
  float* ZP = (float*)(p.ws + OFF_ZP);
  const int tbase = seg * SL;
  const int half = tid >> 8, ls = (tid & 255) >> 4, lc4 = (tid & 15) * 4;
  f32x2 S0[4], S1[4];
#pragma unroll
  for (int e = 0; e < 4; ++e) { S0[e] = (f32x2){0.f, 0.f}; S1[e] = (f32x2){0.f, 0.f}; }
  if (ident) {
#pragma unroll
    for (int e = 0; e < 4; ++e) {
      const int k0 = kl * 8 + 2 * e;
      S0[e] = (f32x2){(v0 == k0) ? 1.f : 0.f, (v0 == k0 + 1) ? 1.f : 0.f};
      S1[e] = (f32x2){(v0 + 1 == k0) ? 1.f : 0.f, (v0 + 1 == k0 + 1) ? 1.f : 0.f};
    }
  }
  float4 g0 = make_float4(0.f, 0.f, 0.f, 0.f);
  uint2 h0 = make_uint2(0u, 0u), h1 = h0, h2 = h0;
  const float* gp0 = RWW + (size_t)(tbase + ls) * 256 + head * 64 + lc4;
  const u16* gq0 = RWKK + (size_t)(tbase + ls) * 256 + head * 64 + lc4;
  const u16* hp = RB + (size_t)(tbase + ls) * 256 + head * 64 + lc4;
#define SCAN_GLOAD(ch) do { const size_t _o = (size_t)(ch) * 16 * 256; \
    if (half == 0) { g0 = *(const float4*)(gp0 + _o); h0 = *(const uint2*)(hp + _o); } \
    else { const uint2 _k = *(const uint2*)(gq0 + _o); g0 = make_float4(bflo(_k.x), bfhi(_k.x), bflo(_k.y), bfhi(_k.y)); \
           h0 = *(const uint2*)(hp + (size_t)T_ * 256 + _o); h1 = *(const uint2*)(hp + (size_t)3 * T_ * 256 + _o); h2 = *(const uint2*)(hp + (size_t)2 * T_ * 256 + _o); } } while (0)
#define SCAN_LSTORE(buf) do { float* _b = st + (buf) * 6144 + ls * 64 + lc4; \
    if (half == 0) { *(float4*)(_b) = g0; *(float4*)(_b + 2048) = make_float4(bflo(h0.x), bfhi(h0.x), bflo(h0.y), bfhi(h0.y)); } \
    else { *(float4*)(_b + 1024) = g0; *(float4*)(_b + 3072) = make_float4(bflo(h0.x), bfhi(h0.x), bflo(h0.y), bfhi(h0.y)); \
           *(float4*)(_b + 4096) = make_float4(bflo(h1.x), bfhi(h1.x), bflo(h1.y), bfhi(h1.y)); *(float4*)(_b + 5120) = make_float4(bflo(h2.x), bfhi(h2.x), bflo(h2.y), bfhi(h2.y)); } } while (0)
  if (tid < 16) st[2 * 6144 + tid] = 0.f;
  SCAN_GLOAD(0);
  SCAN_LSTORE(0);
  __syncthreads();
  const int nch = SL / 16;
  u16* yout = (u16*)(p.ws + OFF_PROJ) + (size_t)tbase * NALL + 1280 + (ident ? 256 : 0) + head * 64 + v0;
  const int voff = ident ? (2 * 6144) : (5120 + v0);
  const int vstep = ident ? 0 : 64, vbuf = ident ? 0 : 6144;
#define V2(a, i) ((f32x2){(i) ? a.z : a.x, (i) ? a.w : a.y})
#define SCAN_STEP(s_, IDENT) do { \
    const float* bp = b + (s_) * 64 + kl * 8; \
    const float4 wl = *(const float4*)(bp), wh = *(const float4*)(bp + 4); \
    const float4 kkl = *(const float4*)(bp + 1024), kkh = *(const float4*)(bp + 1028); \
    const float4 rl4 = *(const float4*)(bp + 2048), rh4 = *(const float4*)(bp + 2052); \
    float4 kl4 = make_float4(0.f, 0.f, 0.f, 0.f), kh4 = kl4; f32x2 vv = {0.f, 0.f}; \
    if (!(IDENT)) { kl4 = *(const float4*)(bp + 3072); kh4 = *(const float4*)(bp + 3076); vv = *(const f32x2*)(vsrc + (s_) * vstep); } \
    const float4 bl4 = *(const float4*)(bp + 4096), bh4 = *(const float4*)(bp + 4100); \
    const f32x2 W[4] = {V2(wl, 0), V2(wl, 1), V2(wh, 0), V2(wh, 1)}, KK[4] = {V2(kkl, 0), V2(kkl, 1), V2(kkh, 0), V2(kkh, 1)}; \
    const f32x2 RR[4] = {V2(rl4, 0), V2(rl4, 1), V2(rh4, 0), V2(rh4, 1)}, KV[4] = {V2(kl4, 0), V2(kl4, 1), V2(kh4, 0), V2(kh4, 1)}; \
    const f32x2 BB[4] = {V2(bl4, 0), V2(bl4, 1), V2(bh4, 0), V2(bh4, 1)}; \
    f32x2 t0 = S0[0] * KK[0] + S0[1] * KK[1] + S0[2] * KK[2] + S0[3] * KK[3]; \
    f32x2 t1 = S1[0] * KK[0] + S1[1] * KK[1] + S1[2] * KK[2] + S1[3] * KK[3]; \
    float sa0 = t0.x + t0.y, sa1 = t1.x + t1.y;     \
    sa0 += dpp_f<0xB1>(sa0); sa1 += dpp_f<0xB1>(sa1); sa0 += dpp_f<0x4E>(sa0); sa1 += dpp_f<0x4E>(sa1); sa0 += dpp_f<0x141>(sa0); sa1 += dpp_f<0x141>(sa1); \
    const f32x2 a0 = {sa0, sa0}, a1 = {sa1, sa1}, u0 = {vv.x, vv.x}, u1 = {vv.y, vv.y}; \
    if (IDENT) { _Pragma("unroll") for (int e = 0; e < 4; ++e) { S0[e] = S0[e] * W[e] + a0 * BB[e]; S1[e] = S1[e] * W[e] + a1 * BB[e]; } } \
    else { _Pragma("unroll") for (int e = 0; e < 4; ++e) { S0[e] = S0[e] * W[e] + a0 * BB[e] + u0 * KV[e]; S1[e] = S1[e] * W[e] + a1 * BB[e] + u1 * KV[e]; } } \
    f32x2 q0 = S0[0] * RR[0] + S0[1] * RR[1] + S0[2] * RR[2] + S0[3] * RR[3]; \
    f32x2 q1 = S1[0] * RR[0] + S1[1] * RR[1] + S1[2] * RR[2] + S1[3] * RR[3]; \
    float y0 = q0.x + q0.y, y1 = q1.x + q1.y; \
    y0 += dpp_f<0xB1>(y0); y1 += dpp_f<0xB1>(y1); y0 += dpp_f<0x4E>(y0); y1 += dpp_f<0x4E>(y1); y0 += dpp_f<0x141>(y0); y1 += dpp_f<0x141>(y1); \
    const bool mine = (kl == ((s_) & 7)); \
    if ((s_) < 8) { ya.x = mine ? y0 : ya.x; ya.y = mine ? y1 : ya.y; } else { yb.x = mine ? y0 : yb.x; yb.y = mine ? y1 : yb.y; } } while (0)
  for (int ch = 0; ch < nch; ++ch) {
    const int cur = ch & 1;
    if (ch + 1 < nch) SCAN_GLOAD(ch + 1);
    const float* b = st + cur * 6144;
    const float* vsrc = st + voff + cur * vbuf;
    f32x2 ya = {0.f, 0.f}, yb = {0.f, 0.f};
    if (ident) {
#pragma unroll 2
      for (int s = 0; s < 8; ++s) SCAN_STEP(s, true);
#pragma unroll 2
      for (int s = 8; s < 16; ++s) SCAN_STEP(s, true);
    } else {
#pragma unroll 2
      for (int s = 0; s < 8; ++s) SCAN_STEP(s, false);
#pragma unroll 2
      for (int s = 8; s < 16; ++s) SCAN_STEP(s, false);
    }
    *(unsigned*)(yout + (size_t)(ch * 16 + kl) * NALL) = pack2(ya.x, ya.y);
    *(unsigned*)(yout + (size_t)(ch * 16 + 8 + kl) * NALL) = pack2(yb.x, yb.y);
    if (ch + 1 < nch) SCAN_LSTORE(cur ^ 1);
    __syncthreads();
  }
#pragma unroll
  for (int j = 0; j < 2; ++j) {
    float* zp = ZP + ((size_t)((seg * 4 + head) * 128 + R0 + j)) * 64 + kl * 8;
    if (j == 0) { *(float4*)(zp) = make_float4(S0[0].x, S0[0].y, S0[1].x, S0[1].y); *(float4*)(zp + 4) = make_float4(S0[2].x, S0[2].y, S0[3].x, S0[3].y); }
    else { *(float4*)(zp) = make_float4(S1[0].x, S1[0].y, S1[1].x, S1[1].y); *(float4*)(zp + 4) = make_float4(S1[2].x, S1[2].y, S1[3].x, S1[3].y); }
  }
}

__device__ void rwkv_combine(const Params& p, unsigned char* dsm_) {
  float* ring = (float*)dsm_;
  float* sbuf = ring + 3 * 8704;
  float* ZP = (float*)(p.ws + OFF_ZP);
  const int tid = opaque_tid512(); const int lane = tid & 63, wv = tid >> 6;
  const int rowi = blockIdx.x * 8 + wv;
  const int head = rowi >> 6, v = rowi & 63;
  const int li = (tid & 15) + 16 * (wv & 3), m0 = ((tid >> 4) & 3) + 4 * (wv >> 2);
  float4 a0A, b0A, a1A, b1A, a0B, b0B, a1B, b1B, a0C, b0C, a1C, b1C;
  float z0A, z1A, z0B, z1B, z0C, z1C;
#define COMB_LOAD(X, stg_) do { \
      const float* base0 = ZP + (size_t)((((stg_) * 2 + 0) * 4 + head) * 128) * 64; \
      const float* base1 = ZP + (size_t)((((stg_) * 2 + 1) * 4 + head) * 128) * 64; \
      a0##X = *(const float4*)(base0 + 4096 + li * 64 + 4 * m0); b0##X = *(const float4*)(base0 + 4096 + li * 64 + 32 + 4 * m0); z0##X = base0[v * 64 + lane]; \
      a1##X = *(const float4*)(base1 + 4096 + li * 64 + 4 * m0); b1##X = *(const float4*)(base1 + 4096 + li * 64 + 32 + 4 * m0); z1##X = base1[v * 64 + lane]; } while (0)
#define COMB_PUT(dst, A4, B4) do { float* d_ = (dst) + li; \
      d_[(4 * m0 + 0) * 68] = A4.x; d_[(4 * m0 + 1) * 68] = A4.y; d_[(4 * m0 + 2) * 68] = A4.z; d_[(4 * m0 + 3) * 68] = A4.w; \
      d_[(32 + 4 * m0 + 0) * 68] = B4.x; d_[(32 + 4 * m0 + 1) * 68] = B4.y; d_[(32 + 4 * m0 + 2) * 68] = B4.z; d_[(32 + 4 * m0 + 3) * 68] = B4.w; } while (0)
#define COMB_SEG(q, ZC) do { const int seg = stg * 2 + q; \
      ZP[((size_t)((seg * 4 + head) * 128 + v)) * 64 + lane] = s; \
      sbuf[wv * 64 + lane] = s; \
      const float* PT = buf + q * 4352 + lane * 68; const float* sb = sbuf + wv * 64; \
        \
      float4 pv[16], sv[16]; \
      _Pragma("unroll") for (int i4 = 0; i4 < 16; ++i4) pv[i4] = *(const float4*)(PT + 4 * i4); \
      _Pragma("unroll") for (int i4 = 0; i4 < 16; ++i4) sv[i4] = *(const float4*)(sb + 4 * i4); \
      __builtin_amdgcn_sched_barrier(0); \
      f32x2 acc0 = {ZC, 0.f}, acc1 = {0.f, 0.f}, acc2 = {0.f, 0.f}, acc3 = {0.f, 0.f}; \
      _Pragma("unroll") for (int i4 = 0; i4 < 16; i4 += 2) { \
        acc0 += (f32x2){sv[i4].x, sv[i4].y} * (f32x2){pv[i4].x, pv[i4].y}; acc1 += (f32x2){sv[i4].z, sv[i4].w} * (f32x2){pv[i4].z, pv[i4].w}; \
        acc2 += (f32x2){sv[i4 + 1].x, sv[i4 + 1].y} * (f32x2){pv[i4 + 1].x, pv[i4 + 1].y}; acc3 += (f32x2){sv[i4 + 1].z, sv[i4 + 1].w} * (f32x2){pv[i4 + 1].z, pv[i4 + 1].w}; } \
      s = ((acc0.x + acc0.y) + (acc1.x + acc1.y)) + ((acc2.x + acc2.y) + (acc3.x + acc3.y)); } while (0)
#define COMB_STAGE(X, bi) do { \
      float* buf = ring + (bi) * 8704; \
      COMB_PUT(buf, a0##X, b0##X); COMB_PUT(buf + 4352, a1##X, b1##X); \
      const float c0 = z0##X, c1 = z1##X; \
      { const int nstg = (stg + 3 < NSEG / 2) ? stg + 3 : stg; COMB_LOAD(X, nstg); } \
      __syncthreads(); \
      COMB_SEG(0, c0); COMB_SEG(1, c1); ++stg; } while (0)
  COMB_LOAD(A, 0); COMB_LOAD(B, 1); COMB_LOAD(C, 2);
  float s = 0.f;
  int stg = 0;
#pragma unroll 1
  for (int it3 = 0; it3 < (NSEG / 2) / 3; ++it3) {
    COMB_STAGE(A, 0); COMB_STAGE(B, 1); COMB_STAGE(C, 2);
  }
  COMB_STAGE(A, 0); COMB_STAGE(B, 1);
  __syncthreads();
#undef COMB_LOAD
#undef COMB_PUT
#undef COMB_SEG
#undef COMB_STAGE
}

__device__ __forceinline__ bf16x8 pack8(const float4 a, const float4 b) {
  uint4 u = make_uint4(pack2(a.x, a.y), pack2(a.z, a.w), pack2(b.x, b.y), pack2(b.z, b.w));
  return __builtin_bit_cast(bf16x8, u);
}
__device__ void rwkv_final_item(const Params& p, int l, int item, unsigned char* smem) {
  l = opq(l); item = opq(item);
  const int tid = opaque_tid(), w = tid >> 6, lane = tid & 63, l31 = lane & 31, hf = lane >> 5;
  const int parts = SL / 128;
  const int q = item % parts, head = (item / parts) & 3, seg = item / (parts * 4);
  const int t = seg * SL + q * 128 + w * 32 + l31;
  const float* ZP = (const float*)(p.ws + OFF_ZP);
  const float* PF = (const float*)(p.ws + OFF_PROJ);
  const u16* PROJ = (const u16*)(p.ws + OFF_PROJ);
  const u16* RBv = (const u16*)(p.ws + OFF_RWB) + (size_t)2 * T_ * 256;
  const float* BON = (const float*)(p.ws + OFF_BONUS);
  u16* MIX = (u16*)(p.ws + OFF_MIX);
  f32x16 acc0, acc1;
#pragma unroll
  for (int r = 0; r < 16; ++r) { acc0[r] = 0.f; acc1[r] = 0.f; }
  const u16* y0p = PROJ + (size_t)t * NALL + 1280 + head * 64 + 4 * hf;
  const int cb = head * 64 + 4 * hf;
  float4 yA[4], yB[4];
  uint2 vvl[8], ggl[8];
#pragma unroll
  for (int g = 0; g < 4; ++g) {
    const uint2 ua = *(const uint2*)(y0p + 8 * g), ub = *(const uint2*)(y0p + 32 + 8 * g);
    yA[g] = make_float4(bflo(ua.x), bfhi(ua.x), bflo(ua.y), bfhi(ua.y)); yB[g] = make_float4(bflo(ub.x), bfhi(ub.x), bflo(ub.y), bfhi(ub.y));
  }
#pragma unroll
  for (int q8 = 0; q8 < 8; ++q8) {
    const int c = cb + (q8 >> 2) * 32 + 8 * (q8 & 3);
    vvl[q8] = *(const uint2*)(RBv + (size_t)t * 256 + c);
    ggl[q8] = *(const uint2*)(PROJ + (size_t)t * NALL + 2048 + c);
  }
  const float bon = BON[t * 4 + head];
  {
    const float* sp = ZP + ((size_t)((seg * 4 + head) * 128 + l31)) * 64 + 8 * hf;
    const u16* rp = PROJ + (size_t)t * NALL + 1280 + 256 + head * 64 + 8 * hf;
#pragma unroll
    for (int ks = 0; ks < 4; ++ks) {
      const bf16x8 bfrag = *(const bf16x8*)(rp + 16 * ks);
      const bf16x8 a0 = pack8(*(const float4*)(sp + 16 * ks), *(const float4*)(sp + 16 * ks + 4));
      const bf16x8 a1 = pack8(*(const float4*)(sp + 32 * 64 + 16 * ks), *(const float4*)(sp + 32 * 64 + 16 * ks + 4));
      acc0 = __builtin_amdgcn_mfma_f32_32x32x16_bf16(a0, bfrag, acc0, 0, 0, 0);
      acc1 = __builtin_amdgcn_mfma_f32_32x32x16_bf16(a1, bfrag, acc1, 0, 0, 0);
    }
  }
  float sum = 0.f;
#pragma unroll
  for (int g = 0; g < 4; ++g) {
    const float4 ya = yA[g], yb = yB[g];
    acc0[4 * g + 0] += ya.x; acc0[4 * g + 1] += ya.y; acc0[4 * g + 2] += ya.z; acc0[4 * g + 3] += ya.w;
    acc1[4 * g + 0] += yb.x; acc1[4 * g + 1] += yb.y; acc1[4 * g + 2] += yb.z; acc1[4 * g + 3] += yb.w;
  }
#pragma unroll
  for (int r = 0; r < 16; ++r) sum += acc0[r] + acc1[r];
  sum += __shfl_xor(sum, 32);
  const float mean = sum * (1.f / 64.f);
  float var = 0.f;
#pragma unroll
  for (int r = 0; r < 16; ++r) { const float d0 = acc0[r] - mean, d1 = acc1[r] - mean; var += d0 * d0 + d1 * d1; }
  var += __shfl_xor(var, 32);
  const float rstd = rsqrtf(var * (1.f / 64.f) + 64e-5f);
#pragma unroll
  for (int mt = 0; mt < 2; ++mt)
#pragma unroll
    for (int g = 0; g < 4; ++g) {
      const int c = cb + mt * 32 + 8 * g;
      const float4 lw = *(const float4*)(p.ln_w + l * 256 + c), lb = *(const float4*)(p.ln_b + l * 256 + c);
      const uint2 vv = vvl[mt * 4 + g];
      const uint2 gg = ggl[mt * 4 + g];
      float o0 = (mt ? acc1[4 * g + 0] : acc0[4 * g + 0]), o1 = (mt ? acc1[4 * g + 1] : acc0[4 * g + 1]);
      float o2 = (mt ? acc1[4 * g + 2] : acc0[4 * g + 2]), o3 = (mt ? acc1[4 * g + 3] : acc0[4 * g + 3]);
      o0 = (o0 - mean) * rstd * lw.x + lb.x + bon * bflo(vv.x);
      o1 = (o1 - mean) * rstd * lw.y + lb.y + bon * bfhi(vv.x);
      o2 = (o2 - mean) * rstd * lw.z + lb.z + bon * bflo(vv.y);
      o3 = (o3 - mean) * rstd * lw.w + lb.w + bon * bfhi(vv.y);
      o0 *= silu(bflo(gg.x)); o1 *= silu(bfhi(gg.x)); o2 *= silu(bflo(gg.y)); o3 *= silu(bfhi(gg.y));
      *(uint2*)(MIX + (size_t)t * 1024 + 512 + c) = make_uint2(pack2(o0, o1), pack2(o2, o3));
    }
}

#define LDS_BYTES (131072 + 16)
#ifndef REP_G1
#define REP_G1 1
#endif
#ifndef REP_G2
#define REP_G2 1
#endif
#ifndef REP_P3
#define REP_P3 1
#endif
#ifndef REP_SCAN
#define REP_SCAN 1
#endif
#ifndef REP_GO
#define REP_GO 1
#endif
#ifndef REP_FIN
#define REP_FIN 1
#endif
#define PAIR_LOOP(N, BODY) for (int _pr = blockIdx.x; _pr < (N) / 2; _pr += gridDim.x) { const int it = 2 * _pr + vb; BODY }
__global__ void __launch_bounds__(512) fwd_megakernel(Params p) {
  cg::grid_group grid = cg::this_grid();
  extern __shared__ __attribute__((aligned(16))) unsigned char dsm[];
  const int vb = __builtin_amdgcn_readfirstlane(threadIdx.x >> 8);
  unsigned char* smem = dsm + vb * 65536;
  if (threadIdx.x == 0) *(uint4*)(dsm + 131072) = make_uint4(0u, 0u, 0u, 0u);
  __syncthreads();
  const XcdBarrier xb = xcd_barrier_post((unsigned*)(p.ws + OFF_BAR), (volatile LAS unsigned*)(dsm + 131072));
#define GSYNC() xcd_barrier(xb)
#ifndef PH
#define PH 0xffff
#endif
  if (PH & 1) PAIR_LOOP(384, phase_mod_item(p, it, smem);)
  if (PH & 2) PAIR_LOOP(1120, { const int it2 = (it < 864) ? it : 3456 + (it - 864); phase_wconv_item(p, it2, smem); })
  if (PH & 2) PAIR_LOOP(8, phase_w2t_item(p, it);)
  if (p.ws == nullptr) grid.sync();
  GSYNC();
  if (PH & 4) phase_h0(p);
  GSYNC();
#pragma unroll 1
  for (int hl = 0; hl < 8; ++hl) {
    const int l = hl >> 1;
    const bool second = hl & 1;
    if (PH & 8) {
      pg8::Gemm g; g.M = T_; g.K = 1024;
      pg8::EpiU E; E.O = (void*)(p.ws + OFF_PROJ);
      if (!second) { g.A = (const u16*)(p.ws + OFF_H); g.Bt = (const u16*)(p.ws + OFF_WALL) + (size_t)l * NALL * 1024; g.N = 3584; E.ldc = NALL; E.ncols = 3344; E.f32out = 0; }
      else { g.A = (const u16*)(p.ws + OFF_MIX); g.Bt = (const u16*)(p.ws + OFF_WOUT) + (size_t)l * 1024 * 1024; g.N = 1024; E.ldc = 1024; E.ncols = 1024; E.f32out = 0; }
      pg8::StaticOrder S; S.init(T_, g.N, gridDim.x, blockIdx.x);
      const int nrep = second ? REP_G2 : REP_G1;
#pragma unroll 1
      for (int rep = 0; rep < nrep; ++rep)
      pg8::gemm_phase<pg8::EpiU, pg8::StaticOrder, false>((PG8_LAS unsigned char*)dsm, g, S, E, nullptr);
      if (!second && l < 3 && (PH & 2)) {
        const int G = gridDim.x, rem = 896 % G;
        if (rem != 0 && (int)blockIdx.x >= rem) {
          const int nidle = G - rem, me = blockIdx.x - rem;
          for (int _pr = me; _pr < 560; _pr += nidle) {
            const int it = 2 * _pr + vb;
            const int it2 = (it < 864) ? (l + 1) * 864 + it : 3456 + (l + 1) * 256 + (it - 864);
            phase_wconv_item(p, it2, smem);
          }
        } else if (rem == 0) {
          PAIR_LOOP(1120, { const int it2 = (it < 864) ? (l + 1) * 864 + it : 3456 + (l + 1) * 256 + (it - 864); phase_wconv_item(p, it2, smem); })
        }
      }
    }
    GSYNC();
    if (!second) {
#pragma unroll 1
      for (int rep = 0; rep < REP_P3; ++rep)
      PAIR_LOOP(2048,
        if (it < 1024) { if (PH & 32) rwkv_prep_item(p, l, it, smem); }
        else { if (PH & 64) gla_local_item(p, l, it - 1024, smem); }
      )
      GSYNC();
#pragma unroll 1
      for (int wi = blockIdx.x; wi < 256; wi += gridDim.x) {
        GLA_STATE_LOAD(wi)
#pragma unroll 1
        for (int rep = 0; rep < REP_SCAN; ++rep)
        if (PH & 256) rwkv_scan_item(p, wi, dsm);
        __syncthreads();
        if (PH & 128) GLA_STATE_FINISH(dsm)
      }
      GSYNC();
      if (blockIdx.x < 32) { if (PH & 512) rwkv_combine(p, dsm); }
#pragma unroll 1
      for (int rep = 0; rep < REP_GO; ++rep)
      if (PH & 1024) {
        unsigned* ctr = (unsigned*)(p.ws + OFF_BAR) + 32 + l;
        volatile unsigned* slot = (volatile unsigned*)(dsm + 131072) + 2;
        for (;;) {
          if (threadIdx.x == 0) *slot = atomicAdd(ctr, 1u);
          __syncthreads();
          const unsigned pr = (unsigned)__builtin_amdgcn_readfirstlane((int)*slot);
          __syncthreads();
          if (pr >= 1024u) break;
          if (pr < 512u) attn_item(p, l, 2 * (int)pr + vb, smem);
          else gla_out_item(p, l, 2 * (int)(pr - 512u) + vb, smem);
        }
      }
      GSYNC();
#pragma unroll 1
      for (int rep = 0; rep < REP_FIN; ++rep)
      if (PH & 2048) PAIR_LOOP(NSEG * 4 * (SL / 128), rwkv_final_item(p, l, it, smem);)
      GSYNC();
    } else {
      if (PH & 8192) phase_post(p, l);
      if (hl < 7) GSYNC();
    }
  }
}

extern "C" void kernel_launch(void* const* d_in, const int* in_sizes, int n_in, void* d_out, int out_size, void* d_ws, size_t ws_size,
                              hipStream_t stream) {
  static int grid_blocks = 0;
  if (!grid_blocks) {
    int dev = 0, cus = 0, per_cu = 0;
    (void)hipGetDevice(&dev);
    (void)hipDeviceGetAttribute(&cus, hipDeviceAttributeMultiprocessorCount, dev);
    (void)hipFuncSetAttribute((const void*)fwd_megakernel, hipFuncAttributeMaxDynamicSharedMemorySize, LDS_BYTES);
    (void)hipOccupancyMaxActiveBlocksPerMultiprocessor(&per_cu, fwd_megakernel, 512, LDS_BYTES);
    if (per_cu < 1) per_cu = 1;
    grid_blocks = cus;
    if (grid_blocks < 64) { fprintf(stderr, "kernel_launch: needs at least 64 CUs (got %d)\n", cus); grid_blocks = -1; }
  }
  if (grid_blocks < 0) return;
  if (n_in != 27 || ws_size < WS_END) {
    fprintf(stderr, "kernel_launch: unexpected n_in %d / ws %zu\n", n_in, ws_size);
    return;
  }
  Params p{};
  const float** pp = (const float**)&p;
  for (int i = 0; i < 27; ++i) pp[i] = (const float*)d_in[i];
  p.out = (float*)d_out;
  p.ws = (unsigned char*)d_ws;
  (void)hipMemsetAsync((unsigned char*)d_ws + OFF_BAR, 0, XCD_BAR_WORDS * 4, stream);
  void* args[] = {&p};
  hipError_t e = hipLaunchCooperativeKernel((void*)fwd_megakernel, dim3(grid_blocks), dim3(512), args, LDS_BYTES, stream);
  if (e != hipSuccess) fprintf(stderr, "cooperative launch failed: %s (grid %d)\n", hipGetErrorString(e), grid_blocks);
}
```

```cpp
#include <hip/hip_runtime.h>
#include <hip/hip_bf16.h>
#include <hip/hip_cooperative_groups.h>
#include <cstdio>
namespace cg = cooperative_groups;

typedef unsigned short u16;
using bf16x8 = __attribute__((ext_vector_type(8))) short;
using f32x4 = __attribute__((ext_vector_type(4))) float;
using f32x16 = __attribute__((ext_vector_type(16))) float;

#define T_ 16384
#define NALL 3456
#define NSEG 64
#define SL (T_ / NSEG)
#define PROJF 1728

#define OFF_WALL 0ull
#define OFF_WOUT 28311552ull
#define OFF_MOD 36700160ull
#define OFF_H 36749312ull
#define OFF_RWW OFF_H
#define OFF_RWKK (OFF_H + 16777216ull)
#define OFF_PROJ 70303744ull
#define OFF_MIX 183549952ull
#define OFF_RWB 217104384ull
#define OFF_GLAS 250658816ull
#define OFF_GLAD 259047424ull
#define OFF_BONUS 259178496ull
#define OFF_ZP 259440640ull
#define OFF_BAR 267829248ull
#define OFF_W2T 267845632ull
#define OFF_A2T 267976704ull
#define WS_END 268107776ull


struct Params {
  const float *x, *c, *ada_w, *ada_b, *norm_pre, *norm_post, *w_in, *w_out, *sinks, *mu_rkv, *mu_w, *mu_a, *w0, *w1, *w2,
      *a0, *a1, *a2, *k_k, *k_a, *r_k, *ln_w, *ln_b, *gk1, *gk2, *gk_b, *gla_nw;
  float* out;
  unsigned char* ws;
};

__device__ __forceinline__ unsigned cvt2(float lo, float hi) { unsigned r; asm("v_cvt_pk_bf16_f32 %0, %1, %2" : "=v"(r) : "v"(lo), "v"(hi)); return r; }
__device__ __forceinline__ u16 f2bf(float f) { return (u16)(cvt2(f, f) & 0xffffu); }
__device__ __forceinline__ float bf2f(u16 h) { return __uint_as_float(((unsigned)h) << 16); }
__device__ __forceinline__ unsigned pack2(float a, float b) { return cvt2(a, b); }
__device__ __forceinline__ float bflo(unsigned u) { return __uint_as_float(u << 16); }
__device__ __forceinline__ float bfhi(unsigned u) { return __uint_as_float(u & 0xffff0000u); }

__device__ __forceinline__ float frcp(float x) { return __builtin_amdgcn_rcpf(x); }
__device__ __forceinline__ float silu(float x) { return x * frcp(1.f + __expf(-x)); }
__device__ __forceinline__ float sigmoidf_(float x) { return frcp(1.f + __expf(-x)); }
__device__ __forceinline__ float softplusf_(float z) { return fmaxf(z, 0.f) + __logf(1.f + __expf(-fabsf(z))); }
__device__ __forceinline__ float tanh_fast(float x) { return 1.f - 2.f * frcp(1.f + __expf(2.f * x)); }

__device__ __forceinline__ int opq(int x) { asm volatile("" : "+s"(x)); return x; }
__device__ __forceinline__ int opaque_tid() { int t = threadIdx.x & 255; asm volatile("" : "+v"(t)); return t; }
__device__ __forceinline__ int opaque_tid512() { int t = threadIdx.x; asm volatile("" : "+v"(t)); return t; }
template <int CTRL>
__device__ __forceinline__ float dpp_f(float x) {
  return __builtin_bit_cast(float, __builtin_amdgcn_update_dpp(0, __builtin_bit_cast(int, x), CTRL, 0xf, 0xf, true));
}
__device__ __forceinline__ float row16_allsum(float x) {
  x += dpp_f<0x128>(x);
  x += dpp_f<0x124>(x);
  x += dpp_f<0x122>(x);
  x += dpp_f<0x121>(x);
  return x;
}
__device__ __forceinline__ float wave_sum(float v) {
  v = row16_allsum(v);
  const int iv = __builtin_bit_cast(int, v);
  const float a = __builtin_bit_cast(float, __builtin_amdgcn_readlane(iv, 0)), b = __builtin_bit_cast(float, __builtin_amdgcn_readlane(iv, 16));
  const float c = __builtin_bit_cast(float, __builtin_amdgcn_readlane(iv, 32)), d = __builtin_bit_cast(float, __builtin_amdgcn_readlane(iv, 48));
  return (a + b) + (c + d);
}

namespace pg8 {
#define PG8_LAS __attribute__((address_space(3)))
typedef unsigned short bf16_t;
typedef short bf16x8 __attribute__((ext_vector_type(8)));
typedef float f32x4 __attribute__((ext_vector_type(4)));
typedef unsigned u32x4 __attribute__((ext_vector_type(4)));
constexpr int BM = 256, BK = 64, HALF = 128, HTB = HALF * BK * 2  , STAGE_BYTES = 8 * HTB, NXCD = 8, WGM = 8;

__host__ __device__ __forceinline__ int lds_byte(int r, int c) { const int st = (r >> 4) * 2 + (c >> 5), rr = r & 15, cc = c & 31, ob = rr * 64 + cc * 2; return st * 1024 + (ob ^ (((ob >> 9) & 1) << 5)); }
__host__ __device__ __forceinline__ void stage_rc(int b, int& R, int& C) { const int st = b / 1024, sb = b % 1024, swz = sb ^ (((sb >> 9) & 1) << 5); R = (st >> 1) * 16 + swz / 64; C = (st & 1) * 32 + (swz % 64) / 2; }
__host__ __device__ __forceinline__ int perm32(int rho) { const int n = rho >> 4, i = rho & 15; return 8 * (i >> 2) + 4 * n + (i & 3); }

struct Unit { int pm, pn; };
struct Gemm { const bf16_t* A; const bf16_t* Bt; int M, N, K; };

struct StaticOrder {
    int nM, nN, nwg, G, c;
    __host__ __device__ void init(int M, int N, int G_, int c_) { nM = M / BM; nN = N / BM; nwg = nM * nN; G = G_; c = c_; }
    __host__ __device__ bool next(int i, Unit& u) const {
        const long L = (long)i * G + c; if (L >= nwg) return false;
        int wgid = (int)L; { const int q = nwg / NXCD, r = nwg % NXCD, xcd = wgid % NXCD, off = wgid / NXCD; wgid = (xcd < r ? xcd * (q + 1) : r * (q + 1) + (xcd - r) * q) + off; }
        const int nig = WGM * nN, gid = wgid / nig, fm = gid * WGM, gsz = (nM - fm) < WGM ? (nM - fm) : WGM;
        u.pm = fm + ((wgid % nig) % gsz); u.pn = (wgid % nig) / gsz; return true;
    }
    __device__ __forceinline__ void a_ready(const Unit&) const {}
    __device__ __forceinline__ void done(const Unit&) const {}
};
__device__ __forceinline__ unsigned cvt_pk_bf16(float lo, float hi) { unsigned r; asm volatile("v_cvt_pk_bf16_f32 %0, %1, %2" : "=v"(r) : "v"(lo), "v"(hi)); return r; }
template <class Epi, class Sched, bool STAMP = false>
__device__ __forceinline__ void gemm_phase(PG8_LAS unsigned char* lds, const Gemm g, const Sched& S, const Epi& E, unsigned long long* stamps) {
    const int tid = threadIdx.x, wid = __builtin_amdgcn_readfirstlane(tid >> 6), lane = tid & 63, wr = wid >> 2, wc = wid & 3, fr = lane & 15, fq = lane >> 4;
    const int K = g.K, nt = K / BK;
    int ts_lo = 0, ts_hi = 0, nts = 0; const unsigned long long rt_entry = STAMP ? (unsigned long long)wall_clock64() : 0ull;
#define PG8_STAMP() do { if (STAMP && wid == 0 && nts < 64) { const unsigned long long _c = (unsigned long long)clock64(); \
        ts_lo = (lane == nts) ? (int)(unsigned)_c : ts_lo; ts_hi = (lane == nts) ? (int)(unsigned)(_c >> 32) : ts_hi; ++nts; } } while (0)
    PG8_STAMP();
    unsigned voffA[2], voffB[2];
#pragma unroll
    for (int i = 0; i < 2; ++i) { int R, C; stage_rc(tid * 16 + i * 8192, R, C); const int Rb = Epi::PERM ? ((R & ~31) + perm32(R & 31)) : R;
        voffA[i] = (unsigned)(R * K + C) * 2u; voffB[i] = (unsigned)(Rb * K + C) * 2u; }
    const size_t kstep = (size_t)(BK * 2);
    const size_t hstep = (size_t)HALF * K * 2;
    const size_t tstep = 2 * hstep;
    const unsigned ldsw = (unsigned)wid * 1024u;
    const int aoff = lds_byte(wr * 64 + fr, fq * 8), boff = lds_byte(wc * 32 + fr, fq * 8);
#define PG8_SA(b, h) (((b) * 2 + (h)) * HTB)
#define PG8_SB(b, h) ((4 + (b) * 2 + (h)) * HTB)
#define PG8_STAGE(bufoff, gbase, voff) do { _Pragma("unroll") for (int _i = 0; _i < 2; ++_i) \
        __builtin_amdgcn_global_load_lds((const unsigned*)((const char*)(gbase) + (voff)[_i]), (PG8_LAS unsigned*)(lds + (bufoff) + ldsw + _i * 8192), 16, 0, 0); } while (0)
#define PG8_LDA(dst, b, h) do { _Pragma("unroll") for (int m = 0; m < 4; ++m) _Pragma("unroll") for (int k = 0; k < 2; ++k) dst[m][k] = *(const PG8_LAS bf16x8*)(lds + PG8_SA(b, h) + aoff + m * 2048 + k * 1024); } while (0)
#define PG8_LDB(dst, b, h) do { _Pragma("unroll") for (int n = 0; n < 2; ++n) _Pragma("unroll") for (int k = 0; k < 2; ++k) dst[n][k] = *(const PG8_LAS bf16x8*)(lds + PG8_SB(b, h) + boff + n * 2048 + k * 1024); } while (0)
#define PG8_MMA(ai, bj, At, Bt) do { __builtin_amdgcn_s_setprio(1); _Pragma("unroll") for (int m = 0; m < 4; ++m) _Pragma("unroll") for (int n = 0; n < 2; ++n) _Pragma("unroll") for (int k = 0; k < 2; ++k) \
        acc[ai][bj][m][n] = __builtin_amdgcn_mfma_f32_16x16x32_bf16(Bt[n][k], At[m][k], acc[ai][bj][m][n], 0, 0, 0); __builtin_amdgcn_s_setprio(0); } while (0)
#define PG8_WAIT_V(n) asm volatile("s_waitcnt vmcnt(" #n ")" ::: "memory")
#define PG8_WAIT_L(n) asm volatile("s_waitcnt lgkmcnt(" #n ")" ::: "memory")
#define PG8_BAR __builtin_amdgcn_s_barrier()
#define PG8_SCHED __builtin_amdgcn_sched_barrier(0)
    Unit cur, nxt; int ui = 0;
    if (!S.next(0, cur)) return;
    f32x4 acc[2][2][4][2];
#pragma unroll
    for (int a = 0; a < 2; ++a)
#pragma unroll
        for (int b = 0; b < 2; ++b)
#pragma unroll
            for (int m = 0; m < 4; ++m)
#pragma unroll
                for (int n = 0; n < 2; ++n) acc[a][b][m][n] = (f32x4){0.f, 0.f, 0.f, 0.f};
    bf16x8 At[4][2], B0[2][2], B1[2][2];
    const char* cA = (const char*)g.A + (size_t)cur.pm * tstep; const char* cB = (const char*)g.Bt + (size_t)cur.pn * tstep;
    S.a_ready(cur);
    PG8_STAGE(PG8_SB(0, 0), cB, voffB); PG8_STAGE(PG8_SA(0, 0), cA, voffA); PG8_STAGE(PG8_SB(0, 1), cB + hstep, voffB); PG8_STAGE(PG8_SA(0, 1), cA + hstep, voffA);
    if (wr == 1) PG8_BAR;
    PG8_WAIT_V(4); PG8_BAR;
    PG8_STAGE(PG8_SB(1, 0), cB + kstep, voffB); PG8_STAGE(PG8_SA(1, 0), cA + kstep, voffA); PG8_STAGE(PG8_SB(1, 1), cB + hstep + kstep, voffB);
    PG8_WAIT_V(6); PG8_BAR;
    PG8_STAMP();
    for (;;) {
        const bool has_next = S.next(ui + 1, nxt);
        const char* nA = has_next ? (const char*)g.A + (size_t)nxt.pm * tstep : cA; const char* nB = has_next ? (const char*)g.Bt + (size_t)nxt.pn * tstep : cB;
        for (int t = 0; t < nt; t += 2) {
            const bool last = (t == nt - 2);
            const char* a1 = cA + (size_t)(t + 1) * kstep;
            const char* a2 = last ? nA : cA + (size_t)(t + 2) * kstep; const char* b2 = last ? nB : cB + (size_t)(t + 2) * kstep;
            const char* a3 = a2 + kstep; const char* b3 = b2 + kstep;
            if (last && has_next) S.a_ready(nxt);
            PG8_LDB(B0, 0, 0); PG8_SCHED; PG8_LDA(At, 0, 0); PG8_STAGE(PG8_SA(1, 1), a1 + hstep, voffA);
            PG8_WAIT_L(8); PG8_BAR; PG8_WAIT_L(0); PG8_MMA(0, 0, At, B0); PG8_BAR; PG8_SCHED;
            PG8_LDB(B1, 0, 1); PG8_STAGE(PG8_SB(0, 0), b2, voffB);
            PG8_BAR; PG8_WAIT_L(0); PG8_MMA(0, 1, At, B1); PG8_BAR;
            PG8_LDA(At, 0, 1); PG8_STAGE(PG8_SA(0, 0), a2, voffA);
            PG8_BAR; PG8_WAIT_L(0); PG8_MMA(1, 0, At, B0); PG8_BAR; PG8_SCHED;
            PG8_STAGE(PG8_SB(0, 1), b2 + hstep, voffB);
            PG8_WAIT_V(6); PG8_BAR; PG8_MMA(1, 1, At, B1); PG8_BAR;
            PG8_LDB(B0, 1, 0); PG8_SCHED; PG8_LDA(At, 1, 0); PG8_STAGE(PG8_SA(0, 1), a2 + hstep, voffA);
            PG8_WAIT_L(8); PG8_BAR; PG8_WAIT_L(0); PG8_MMA(0, 0, At, B0); PG8_BAR; PG8_SCHED;
            PG8_LDB(B1, 1, 1); PG8_STAGE(PG8_SB(1, 0), b3, voffB);
            PG8_BAR; PG8_WAIT_L(0); PG8_MMA(0, 1, At, B1); PG8_BAR;
            PG8_LDA(At, 1, 1); PG8_STAGE(PG8_SA(1, 0), a3, voffA);
            PG8_BAR; PG8_WAIT_L(0); PG8_MMA(1, 0, At, B0); PG8_BAR; PG8_SCHED;
            PG8_STAGE(PG8_SB(1, 1), b3 + hstep, voffB);
            PG8_WAIT_V(6); PG8_BAR; PG8_MMA(1, 1, At, B1); PG8_BAR;
        }
        PG8_STAMP();
        if constexpr (!Epi::AFTER_DRAIN) { E(acc, cur, wr, wc, fr, fq); S.done(cur); }
        PG8_STAMP();
        if (!has_next) break;
#pragma unroll
        for (int a = 0; a < 2; ++a)
#pragma unroll
            for (int b = 0; b < 2; ++b)
#pragma unroll
                for (int m = 0; m < 4; ++m)
#pragma unroll
                    for (int n = 0; n < 2; ++n) acc[a][b][m][n] = (f32x4){0.f, 0.f, 0.f, 0.f};
        cur = nxt; cA = nA; cB = nB; ++ui;
    }
    PG8_WAIT_V(0);
    if (wr == 0) PG8_BAR;
    PG8_BAR;
    if constexpr (Epi::AFTER_DRAIN) { E.fused(acc, cur, wr, wc, fr, fq, lds, wid, lane); S.done(cur); }
    PG8_STAMP();
    if (STAMP && wid == 0) { stamps[lane] = lane < nts ? (((unsigned long long)(unsigned)ts_hi << 32) | (unsigned)ts_lo) : 0ull;
        if (lane == 62) stamps[62] = rt_entry; if (lane == 63) stamps[63] = (unsigned long long)wall_clock64(); }
#undef PG8_STAMP
#undef PG8_SA
#undef PG8_SB
#undef PG8_STAGE
#undef PG8_LDA
#undef PG8_LDB
#undef PG8_MMA
#undef PG8_WAIT_V
#undef PG8_WAIT_L
#undef PG8_BAR
#undef PG8_SCHED
}
}

namespace pg8 {
struct EpiProj {
    static constexpr bool PERM = true, AFTER_DRAIN = false;
    bf16_t* O; int ldc; int ncols;
    __device__ __forceinline__ void operator()(const f32x4 (&acc)[2][2][4][2], const Unit& u, int wr, int wc, int fr, int fq) const {
        const int row0 = u.pm * BM + wr * 64 + fr; const int col0 = u.pn * BM + wc * 32 + 8 * fq;
#pragma unroll
        for (int ai = 0; ai < 2; ++ai)
#pragma unroll
            for (int m = 0; m < 4; ++m) { bf16_t* rowp = O + (size_t)(row0 + ai * HALF + m * 16) * ldc + col0;
#pragma unroll
                for (int bj = 0; bj < 2; ++bj) { const f32x4 v0 = acc[ai][bj][m][0], v1 = acc[ai][bj][m][1];
                    u32x4 w; w.x = cvt_pk_bf16(v0[0], v0[1]); w.y = cvt_pk_bf16(v0[2], v0[3]); w.z = cvt_pk_bf16(v1[0], v1[1]); w.w = cvt_pk_bf16(v1[2], v1[3]);
                    if (col0 + bj * HALF < ncols) *(u32x4*)(rowp + bj * HALF) = w; } }
    }
};
struct EpiU {
    static constexpr bool PERM = true, AFTER_DRAIN = false;
    void* O; int ldc; int ncols; int f32out;
    __device__ __forceinline__ void operator()(const f32x4 (&acc)[2][2][4][2], const Unit& u, int wr, int wc, int fr, int fq) const {
        const int row0 = u.pm * BM + wr * 64 + fr; const int col0 = u.pn * BM + wc * 32 + 8 * fq;
        if (f32out) {
#pragma unroll
            for (int ai = 0; ai < 2; ++ai)
#pragma unroll
                for (int m = 0; m < 4; ++m) { float* rowp = (float*)O + (size_t)(row0 + ai * HALF + m * 16) * ldc + col0;
#pragma unroll
                    for (int bj = 0; bj < 2; ++bj) { *(f32x4*)(rowp + bj * HALF) = acc[ai][bj][m][0]; *(f32x4*)(rowp + bj * HALF + 4) = acc[ai][bj][m][1]; } }
        } else {
#pragma unroll
            for (int ai = 0; ai < 2; ++ai)
#pragma unroll
                for (int m = 0; m < 4; ++m) { bf16_t* rowp = (bf16_t*)O + (size_t)(row0 + ai * HALF + m * 16) * ldc + col0;
#pragma unroll
                    for (int bj = 0; bj < 2; ++bj) { const f32x4 v0 = acc[ai][bj][m][0], v1 = acc[ai][bj][m][1];
                        u32x4 w; w.x = cvt_pk_bf16(v0[0], v0[1]); w.y = cvt_pk_bf16(v0[2], v0[3]); w.z = cvt_pk_bf16(v1[0], v1[1]); w.w = cvt_pk_bf16(v1[2], v1[3]);
                        if (col0 + bj * HALF < ncols) *(u32x4*)(rowp + bj * HALF) = w; } }
        }
    }
};
}

#define XB_TMO      128
#define XB_XCNT(j)  (256  + 64 * (j))
#define XB_XSUB(j)  (1280 + 64 * (j))
#define XB_XGEN(j)  (2304 + 64 * (j))
#define XB_TOP      3328
#define XB_TOPGEN   3392
#define XCD_BAR_WORDS 3456
#define XB_SPIN_CAP (1u << 18)
#define LAS __attribute__((address_space(3)))

__device__ __forceinline__ unsigned xb_ld(unsigned* p)              { return __hip_atomic_load(p, __ATOMIC_RELAXED, __HIP_MEMORY_SCOPE_AGENT); }
__device__ __forceinline__ unsigned xb_add(unsigned* p, unsigned v) { return __hip_atomic_fetch_add(p, v, __ATOMIC_RELAXED, __HIP_MEMORY_SCOPE_AGENT); }
__device__ __forceinline__ unsigned xb_xcc_id() { return (unsigned)__builtin_amdgcn_s_getreg((3 << 11) | 20) & 0xFu; }
#define XB_SPIN(cond, bar) do { unsigned _sp = 0; while (cond) { __builtin_amdgcn_s_sleep(1); \
    if ((++_sp & 255u) == 0u) { if (xb_ld(&(bar)[XB_TMO])) break; if (_sp > XB_SPIN_CAP) { atomicAdd(&(bar)[XB_TMO], 1u); break; } } } } while (0)

struct XcdBarrier {
    unsigned* bar; unsigned x;
    volatile LAS unsigned* st;
};

__device__ __forceinline__ XcdBarrier xcd_barrier_post(unsigned* bar, volatile LAS unsigned* st) {
    XcdBarrier b; b.bar = bar; b.x = xb_xcc_id(); b.st = st;
    if (threadIdx.x == 0) (void)xb_add(&bar[XB_XCNT(b.x)], 1u);
    return b;
}
__device__ __forceinline__ void xcd_barrier_complete(unsigned* bar, unsigned x, unsigned& nloc, unsigned& nx) {
    const unsigned G = gridDim.x * gridDim.y * gridDim.z;
    unsigned sum, cnt, mine, sp = 0u;
    for (;;) {
        sum = 0u; cnt = 0u; mine = 0u;
#pragma unroll
        for (unsigned j = 0; j < 16; ++j) { const unsigned c = xb_ld(&bar[XB_XCNT(j)]); sum += c; cnt += (c > 0u) ? 1u : 0u; mine = (j == x) ? c : mine; }
        if (sum == G) break;
        __builtin_amdgcn_s_sleep(1);
        if ((++sp & 255u) == 0u) { if (xb_ld(&bar[XB_TMO])) break; if (sp > XB_SPIN_CAP) { atomicAdd(&bar[XB_TMO], 1u); break; } }
    }
    nloc = mine > 0u ? mine : 1u; nx = cnt > 0u ? cnt : 1u;
}

__device__ __forceinline__ void xcd_barrier(const XcdBarrier& b) {
    asm volatile("s_waitcnt vmcnt(0)" ::: "memory");
    __syncthreads();
    if (threadIdx.x == 0) {
        unsigned* bar = b.bar;
        __builtin_amdgcn_s_waitcnt(0);
        unsigned nloc = b.st[0], nx = b.st[1];
        if (nloc == 0u) { xcd_barrier_complete(bar, b.x, nloc, nx); b.st[0] = nloc; b.st[1] = nx; }
        const unsigned old = xb_add(&bar[XB_XSUB(b.x)], 1u);
        const unsigned gen = old / nloc;
        if (old + 1u == (gen + 1u) * nloc) {
            __builtin_amdgcn_fence(__ATOMIC_RELEASE, "agent");
            asm volatile("s_waitcnt vmcnt(0)" ::: "memory");
            const unsigned og = xb_add(&bar[XB_TOP], 1u);
            const unsigned tg = og / nx;
            if (og + 1u == (tg + 1u) * nx) xb_add(&bar[XB_TOPGEN], 1u);
            else XB_SPIN(xb_ld(&bar[XB_TOPGEN]) == tg, bar);
            __builtin_amdgcn_fence(__ATOMIC_ACQUIRE, "agent");
            xb_add(&bar[XB_XGEN(b.x)], 1u);
            asm volatile("s_waitcnt vmcnt(0)" ::: "memory");
        } else {
            XB_SPIN(xb_ld(&bar[XB_XGEN(b.x)]) == gen, bar);
            __builtin_amdgcn_fence(__ATOMIC_ACQUIRE, "agent");
            asm volatile("s_waitcnt vmcnt(0)" ::: "memory");
        }
    }
    __syncthreads();
}

__device__ void phase_mod_item(const Params& p, int it, unsigned char* smem) {
  float* red = (float*)smem;
  const int tid = opaque_tid(), tx = tid & 31, ty = tid >> 5;
  float* mod = (float*)(p.ws + OFF_MOD);
  it = opq(it);
  {
    int l = it / 96;
    int j = (it % 96) * 32 + tx;
    const float* W = p.ada_w + (size_t)l * 1024 * 3072;
    float* cs = red + 256;
#pragma unroll
    for (int i = 0; i < 4; ++i) cs[tid + 256 * i] = silu(p.c[tid + 256 * i]);
    __syncthreads();
    float acc = 0.f;
#pragma unroll 1
    for (int i0 = 0; i0 < 128; i0 += 16) {
      float wv[16];
#pragma unroll
      for (int i = 0; i < 16; ++i) wv[i] = W[(size_t)(ty * 128 + i0 + i) * 3072 + j];
#pragma unroll
      for (int i = 0; i < 16; ++i) acc += cs[ty * 128 + i0 + i] * wv[i];
    }
    red[ty * 32 + tx] = acc;
    __syncthreads();
    if (ty == 0) {
      float s = 0.f;
      for (int g = 0; g < 8; ++g) s += red[g * 32 + tx];
      mod[l * 3072 + j] = s + p.ada_b[l * 3072 + j];
    }
    __syncthreads();
  }
}

__device__ __forceinline__ float wall_src(const Params& p, int l, int k, int n) {
  size_t lk = (size_t)l * 1024 + k;
  if (n < 3072) return p.w_in[lk * 3072 + n];
  if (n < 3136) return (1.f - p.mu_w[lk]) * p.w1[lk * 64 + (n - 3072)];
  if (n < 3200) return p.mu_w[lk] * p.w1[lk * 64 + (n - 3136)];
  if (n < 3264) return (1.f - p.mu_a[lk]) * p.a1[lk * 64 + (n - 3200)];
  if (n < 3328) return p.mu_a[lk] * p.a1[lk * 64 + (n - 3264)];
  if (n < 3344) return p.gk1[lk * 16 + (n - 3328)];
  return 0.f;
}

__device__ void phase_wconv_item(const Params& p, int it, unsigned char* smem) {
  float* tile = (float*)smem;
  const int tid = opaque_tid();
  u16* WALL = (u16*)(p.ws + OFF_WALL);
  u16* WOUT = (u16*)(p.ws + OFF_WOUT);
  it = opq(it);
  {
    bool isout = it >= 3456;
    int l, nt, kt;
    if (!isout) { l = it / 864; int r = it % 864; nt = r >> 4; kt = r & 15; }
    else { int r = it - 3456; l = r >> 8; r &= 255; nt = r >> 4; kt = r & 15; }
    if (isout || nt < 48) {
      const float* src = isout ? p.w_out + (size_t)l * 1024 * 1024 : p.w_in + (size_t)l * 1024 * 3072;
      const int ld = isout ? 1024 : 3072;
      const int n4 = (tid & 15) * 4, k0 = tid >> 4;
      float4 v4[4];
#pragma unroll
      for (int i = 0; i < 4; ++i) v4[i] = *(const float4*)(src + (size_t)(kt * 64 + k0 + 16 * i) * ld + nt * 64 + n4);
#pragma unroll
      for (int i = 0; i < 4; ++i) {
        float* tp = tile + (k0 + 16 * i) * 65 + n4;
        tp[0] = v4[i].x; tp[1] = v4[i].y; tp[2] = v4[i].z; tp[3] = v4[i].w;
      }
    } else {
      int tx = tid & 63, ty = tid >> 6;
#pragma unroll
      for (int i = 0; i < 16; ++i) {
        int kl = ty + 4 * i;
        int k = kt * 64 + kl, n = nt * 64 + tx;
        tile[kl * 65 + tx] = wall_src(p, l, k, n);
      }
    }
    __syncthreads();
    int nl = tid >> 2, kq = tid & 3;
    unsigned w[8];
#pragma unroll
    for (int j = 0; j < 8; ++j) w[j] = pack2(tile[(kq * 16 + 2 * j) * 65 + nl], tile[(kq * 16 + 2 * j + 1) * 65 + nl]);
    u16* dst = (isout ? WOUT + ((size_t)l * 1024 + nt * 64 + nl) * 1024 : WALL + ((size_t)l * NALL + nt * 64 + nl) * 1024) + kt * 64 + kq * 16;
    ((uint4*)dst)[0] = make_uint4(w[0], w[1], w[2], w[3]);
    ((uint4*)dst)[1] = make_uint4(w[4], w[5], w[6], w[7]);
    __syncthreads();
  }
}

__device__ void phase_w2t_item(const Params& p, int it) {
  it = opq(it);
  const int c = opaque_tid();
  const int l = it >> 1, which = it & 1;
  const float* src = (which ? p.a2 : p.w2) + (size_t)l * 64 * 256 + c;
  u16* dst = (u16*)(p.ws + (which ? OFF_A2T : OFF_W2T)) + ((size_t)l * 256 + c) * 64;
#pragma unroll
  for (int j8 = 0; j8 < 8; ++j8) {
    float f[8];
#pragma unroll
    for (int q = 0; q < 8; ++q) f[q] = src[(j8 * 8 + q) * 256];
    *(uint4*)(dst + j8 * 8) = make_uint4(pack2(f[0], f[1]), pack2(f[2], f[3]), pack2(f[4], f[5]), pack2(f[6], f[7]));
  }
}

__device__ void phase_h0(const Params& p) {
  const int tid = opaque_tid512(); const int wave = tid >> 6, lane = tid & 63;
  const float* mod = (const float*)(p.ws + OFF_MOD);
  u16* H = (u16*)(p.ws + OFF_H);
  float4 hs[4], hh[4];
#pragma unroll
  for (int i = 0; i < 4; ++i) {
    const int col = (lane + 64 * i) * 4;
    const float4 gp = *(const float4*)(p.norm_pre + col), sc = *(const float4*)(mod + 1024 + col);
    hs[i] = make_float4(gp.x * (1.f + sc.x), gp.y * (1.f + sc.y), gp.z * (1.f + sc.z), gp.w * (1.f + sc.w));
    hh[i] = *(const float4*)(mod + col);
  }
  const int stride = gridDim.x * 8;
  int row = blockIdx.x * 8 + wave;
  float4 v[4];
#pragma unroll
  for (int i = 0; i < 4; ++i) v[i] = ((const float4*)(p.x + (size_t)row * 1024))[lane + 64 * i];
  for (; row < T_; row += stride) {
    const int nrow = (row + stride < T_) ? row + stride : row;
    float4 vn[4];
#pragma unroll
    for (int i = 0; i < 4; ++i) vn[i] = ((const float4*)(p.x + (size_t)nrow * 1024))[lane + 64 * i];
    float ss = 0.f;
#pragma unroll
    for (int i = 0; i < 4; ++i) ss += v[i].x * v[i].x + v[i].y * v[i].y + v[i].z * v[i].z + v[i].w * v[i].w;
    ss = wave_sum(ss);
    const float r2 = rsqrtf(ss * (1.f / 1024.f) + 1e-6f);
#pragma unroll
    for (int i = 0; i < 4; ++i) {
      const int col = (lane + 64 * i) * 4;
      const float h0 = v[i].x * r2 * hs[i].x + hh[i].x, h1 = v[i].y * r2 * hs[i].y + hh[i].y;
      const float h2 = v[i].z * r2 * hs[i].z + hh[i].z, h3 = v[i].w * r2 * hs[i].w + hh[i].w;
      *(uint2*)(H + (size_t)row * 1024 + col) = make_uint2(pack2(h0, h1), pack2(h2, h3));
    }
#pragma unroll
    for (int i = 0; i < 4; ++i) v[i] = vn[i];
  }
}

__device__ void phase_post(const Params& p, int l) {
  l = opq(l);
  const int tid = opaque_tid512(); const int wave = tid >> 6, lane = tid & 63;
  const u16* Y = (const u16*)(p.ws + OFF_PROJ);
  const float* mod = (const float*)(p.ws + OFF_MOD) + l * 3072;
  const float* modn = (const float*)(p.ws + OFF_MOD) + (l < 3 ? l + 1 : l) * 3072;
  const float* xold = (l == 0) ? p.x : p.out;
  u16* H = (u16*)(p.ws + OFF_H);
  float4 gg[4], hs[4], hh[4];
#pragma unroll
  for (int i = 0; i < 4; ++i) {
    const int col = (lane + 64 * i) * 4;
    const float4 g = *(const float4*)(p.norm_post + l * 1024 + col), gt = *(const float4*)(mod + 2048 + col);
    gg[i] = make_float4(g.x * gt.x, g.y * gt.y, g.z * gt.z, g.w * gt.w);
    const float4 gp = *(const float4*)(p.norm_pre + (l < 3 ? l + 1 : l) * 1024 + col), sc = *(const float4*)(modn + 1024 + col);
    hs[i] = make_float4(gp.x * (1.f + sc.x), gp.y * (1.f + sc.y), gp.z * (1.f + sc.z), gp.w * (1.f + sc.w));
    hh[i] = *(const float4*)(modn + col);
  }
  const int stride = gridDim.x * 8;
  int row = blockIdx.x * 8 + wave;
  uint2 yu[4]; float4 v[4];
#pragma unroll
  for (int i = 0; i < 4; ++i) { yu[i] = ((const uint2*)(Y + (size_t)row * 1024))[lane + 64 * i]; v[i] = ((const float4*)(xold + (size_t)row * 1024))[lane + 64 * i]; }
  for (; row < T_; row += stride) {
    const int nrow = (row + stride < T_) ? row + stride : row;
    uint2 yn[4]; float4 vn[4];
#pragma unroll
    for (int i = 0; i < 4; ++i) { yn[i] = ((const uint2*)(Y + (size_t)nrow * 1024))[lane + 64 * i]; vn[i] = ((const float4*)(xold + (size_t)nrow * 1024))[lane + 64 * i]; }
    float4 y[4];
    float ss = 0.f;
#pragma unroll
    for (int i = 0; i < 4; ++i) {
      y[i] = make_float4(bflo(yu[i].x), bfhi(yu[i].x), bflo(yu[i].y), bfhi(yu[i].y));
      ss += y[i].x * y[i].x + y[i].y * y[i].y + y[i].z * y[i].z + y[i].w * y[i].w;
    }
    ss = wave_sum(ss);
    const float rs = rsqrtf(ss * (1.f / 1024.f) + 1e-6f);
    float s2 = 0.f;
#pragma unroll
    for (int i = 0; i < 4; ++i) {
      const int col = (lane + 64 * i) * 4;
      v[i].x += gg[i].x * (y[i].x * rs);
      v[i].y += gg[i].y * (y[i].y * rs);
      v[i].z += gg[i].z * (y[i].z * rs);
      v[i].w += gg[i].w * (y[i].w * rs);
      *(float4*)(p.out + (size_t)row * 1024 + col) = v[i];
      s2 += v[i].x * v[i].x + v[i].y * v[i].y + v[i].z * v[i].z + v[i].w * v[i].w;
    }
    if (l < 3) {
      s2 = wave_sum(s2);
      const float r2 = rsqrtf(s2 * (1.f / 1024.f) + 1e-6f);
#pragma unroll
      for (int i = 0; i < 4; ++i) {
        const int col = (lane + 64 * i) * 4;
        const float h0 = v[i].x * r2 * hs[i].x + hh[i].x, h1 = v[i].y * r2 * hs[i].y + hh[i].y;
        const float h2 = v[i].z * r2 * hs[i].z + hh[i].z, h3 = v[i].w * r2 * hs[i].w + hh[i].w;
        *(uint2*)(H + (size_t)row * 1024 + col) = make_uint2(pack2(h0, h1), pack2(h2, h3));
      }
    }
#pragma unroll
    for (int i = 0; i < 4; ++i) { yu[i] = yn[i]; v[i] = vn[i]; }
  }
}

__device__ void attn_item(const Params& p, int l, int item, unsigned char* smem) {
  l = opq(l); item = opq(item);
  u16* Vt = (u16*)smem;
  const u16* PROJ = (const u16*)(p.ws + OFF_PROJ);
  u16* MIX = (u16*)(p.ws + OFF_MIX);
  const int tid = opaque_tid(), w = tid >> 6, lane = tid & 63, l31 = lane & 31, hf = lane >> 5;
  const int qb = item >> 3, head = item & 7, kvh = head >> 2;
  const int kpos0 = (qb - 1) * 128;
  {
    int kp = kpos0 + tid;
    if (kp < 0) kp = 0;
    const uint4* src = (const uint4*)(PROJ + (size_t)kp * NALL + 640 + kvh * 64);
#pragma unroll
    for (int c8 = 0; c8 < 8; ++c8) {
      uint4 v = src[c8];
      int d = c8 * 8;
      Vt[(d + 0) * 264 + tid] = (u16)(v.x & 0xffff);
      Vt[(d + 1) * 264 + tid] = (u16)(v.x >> 16);
      Vt[(d + 2) * 264 + tid] = (u16)(v.y & 0xffff);
      Vt[(d + 3) * 264 + tid] = (u16)(v.y >> 16);
      Vt[(d + 4) * 264 + tid] = (u16)(v.z & 0xffff);
      Vt[(d + 5) * 264 + tid] = (u16)(v.z >> 16);
      Vt[(d + 6) * 264 + tid] = (u16)(v.w & 0xffff);
      Vt[(d + 7) * 264 + tid] = (u16)(v.w >> 16);
    }
  }
  const int tq = qb * 128 + 32 * w + l31;
  bf16x8 qf[4], kc[4];
  {
    const u16* qp = PROJ + (size_t)tq * NALL + head * 64 + 8 * hf;
#pragma unroll
    for (int s = 0; s < 4; ++s) qf[s] = *(const bf16x8*)(qp + 16 * s);
    int kp = kpos0 + 32 * w + l31;
    if (kp < 0) kp = 0;
    const u16* kptr = PROJ + (size_t)kp * NALL + 512 + kvh * 64 + 8 * hf;
#pragma unroll
    for (int s = 0; s < 4; ++s) kc[s] = *(const bf16x8*)(kptr + 16 * s);
  }
  __syncthreads();
  const float slope = exp2f(-(float)(head + 1));
  const float sink = p.sinks[l * 8 + head];
  const int rq = 32 * w + l31;
  const u16* gp = PROJ + (size_t)tq * NALL + 768 + head * 64;
  uint2 gA[4], gB[4];
#pragma unroll
  for (int g = 0; g < 4; ++g) { gA[g] = *(const uint2*)(gp + 8 * g + 4 * hf); gB[g] = *(const uint2*)(gp + 32 + 8 * g + 4 * hf); }
  float mrun = -1e30f, lsum = 0.f;
  f32x16 o0, o1;
#pragma unroll
  for (int r = 0; r < 16; ++r) { o0[r] = 0.f; o1[r] = 0.f; }
#pragma unroll 1
  for (int i = 0; i < 5; ++i) {
    bf16x8 kn[4];
    {
      const int in_ = (i < 4) ? i + 1 : 4;
      int kp = kpos0 + 32 * w + 32 * in_ + l31;
      if (kp < 0) kp = 0;
      const u16* kptr = PROJ + (size_t)kp * NALL + 512 + kvh * 64 + 8 * hf;
#pragma unroll
      for (int s = 0; s < 4; ++s) kn[s] = *(const bf16x8*)(kptr + 16 * s);
    }
    f32x16 a;
#pragma unroll
    for (int r = 0; r < 16; ++r) a[r] = 0.f;
#pragma unroll
    for (int s = 0; s < 4; ++s) a = __builtin_amdgcn_mfma_f32_32x32x16_bf16(kc[s], qf[s], a, 0, 0, 0);
#pragma unroll
    for (int s = 0; s < 4; ++s) kc[s] = kn[s];
    float tmax = -1e30f;
    if (i >= 1 && i <= 3 && qb > 0) {
      const float c0 = -slope * (float)(128 + rq - 32 * w - 32 * i - 4 * hf);
#pragma unroll
      for (int r = 0; r < 16; ++r) {
        const float sv = a[r] * 0.125f + (c0 + slope * (float)((r & 3) + 8 * (r >> 2)));
        a[r] = sv;
        tmax = fmaxf(tmax, sv);
      }
    } else {
#pragma unroll
      for (int r = 0; r < 16; ++r) {
        int kj = 32 * w + 32 * i + (r & 3) + 8 * (r >> 2) + 4 * hf;
        int dist = 128 + rq - kj;
        bool valid = (dist >= 0) && (dist < 128) && (kpos0 + kj >= 0);
        float sv = a[r] * 0.125f - slope * (float)dist;
        sv = valid ? sv : -1e30f;
        a[r] = sv;
        tmax = fmaxf(tmax, sv);
      }
    }
    tmax = fmaxf(tmax, __shfl_xor(tmax, 32));
    const float mnew = fmaxf(mrun, tmax);
    const float alpha = __expf(mrun - mnew);
    float psum = 0.f;
#pragma unroll
    for (int r = 0; r < 16; ++r) {
      float e = (a[r] > -1e29f) ? __expf(a[r] - mnew) : 0.f;
      a[r] = e;
      psum += e;
    }
    lsum = lsum * alpha + psum;
    mrun = mnew;
#pragma unroll
    for (int r = 0; r < 16; ++r) { o0[r] *= alpha; o1[r] *= alpha; }
#pragma unroll
    for (int u = 0; u < 2; ++u) {
      const uint4 pfu = make_uint4(pack2(a[8 * u + 0], a[8 * u + 1]), pack2(a[8 * u + 2], a[8 * u + 3]), pack2(a[8 * u + 4], a[8 * u + 5]), pack2(a[8 * u + 6], a[8 * u + 7]));
      const bf16x8 pf = __builtin_bit_cast(bf16x8, pfu);
      const int kb = 32 * w + 32 * i + 16 * u + 4 * hf;
      const u16* v0 = Vt + l31 * 264 + kb;
      const u16* v1 = Vt + (32 + l31) * 264 + kb;
      uint2 a0 = *(const uint2*)(v0), a1 = *(const uint2*)(v0 + 8);
      uint2 b0 = *(const uint2*)(v1), b1 = *(const uint2*)(v1 + 8);
      uint4 A0 = make_uint4(a0.x, a0.y, a1.x, a1.y), A1 = make_uint4(b0.x, b0.y, b1.x, b1.y);
      o0 = __builtin_amdgcn_mfma_f32_32x32x16_bf16(__builtin_bit_cast(bf16x8, A0), pf, o0, 0, 0, 0);
      o1 = __builtin_amdgcn_mfma_f32_32x32x16_bf16(__builtin_bit_cast(bf16x8, A1), pf, o1, 0, 0, 0);
    }
  }
  {
    const float mf = fmaxf(mrun, sink);
    const float scl = __expf(mrun - mf);
    const float ltot = (lsum + __shfl_xor(lsum, 32)) * scl + __expf(sink - mf);
    const float fin = scl / ltot;
#pragma unroll
    for (int r = 0; r < 16; ++r) { o0[r] *= fin; o1[r] *= fin; }
  }
  u16* op = MIX + (size_t)tq * 1024 + head * 64;
#pragma unroll
  for (int g = 0; g < 4; ++g) {
    int d0 = 8 * g + 4 * hf;
    uint2 gg = gA[g];
    float r0 = o0[4 * g + 0] * silu(bflo(gg.x)), r1 = o0[4 * g + 1] * silu(bfhi(gg.x));
    float r2 = o0[4 * g + 2] * silu(bflo(gg.y)), r3 = o0[4 * g + 3] * silu(bfhi(gg.y));
    *(uint2*)(op + d0) = make_uint2(pack2(r0, r1), pack2(r2, r3));
    uint2 g2 = gB[g];
    r0 = o1[4 * g + 0] * silu(bflo(g2.x)); r1 = o1[4 * g + 1] * silu(bfhi(g2.x));
    r2 = o1[4 * g + 2] * silu(bflo(g2.y)); r3 = o1[4 * g + 3] * silu(bfhi(g2.y));
    *(uint2*)(op + 32 + d0) = make_uint2(pack2(r0, r1), pack2(r2, r3));
  }
  __syncthreads();
}

__device__ void rwkv_prep_item(const Params& p, int l, int item, unsigned char* smem) {
  l = opq(l); item = opq(item);
  u16* lwb = (u16*)smem;
  u16* lab = lwb + 16 * 72;
  const u16* PROJ = (const u16*)(p.ws + OFF_PROJ);
  const int tid = opaque_tid(), head = tid >> 6, lane = tid & 63, fr = lane & 15, fq = lane >> 4;
  const int t0 = item * 16;
  {
    const int which = tid >> 7, tt = (tid >> 3) & 15, j0 = (tid & 7) * 8;
    const int t = t0 + tt;
    const u16* pr = PROJ + (size_t)t * NALL;
    const u16* pq = (t > 0) ? pr - NALL : pr;
    const float pm = (t > 0) ? 1.f : 0.f;
    const uint4 cu = *(const uint4*)(pr + (which ? 3200 : 3072) + j0);
    const uint4 pu = *(const uint4*)(pq + (which ? 3264 : 3136) + j0);
    float sv[8];
    sv[0] = bflo(cu.x) + pm * bflo(pu.x); sv[1] = bfhi(cu.x) + pm * bfhi(pu.x);
    sv[2] = bflo(cu.y) + pm * bflo(pu.y); sv[3] = bfhi(cu.y) + pm * bfhi(pu.y);
    sv[4] = bflo(cu.z) + pm * bflo(pu.z); sv[5] = bfhi(cu.z) + pm * bfhi(pu.z);
    sv[6] = bflo(cu.w) + pm * bflo(pu.w); sv[7] = bfhi(cu.w) + pm * bfhi(pu.w);
    if (!which) {
#pragma unroll
      for (int q = 0; q < 8; ++q) sv[q] = tanh_fast(sv[q]);
    }
    *(uint4*)((which ? lab : lwb) + tt * 72 + j0) = make_uint4(pack2(sv[0], sv[1]), pack2(sv[2], sv[3]), pack2(sv[4], sv[5]), pack2(sv[6], sv[7]));
  }
  __syncthreads();
  f32x4 accw[4], acca[4];
#pragma unroll
  for (int nt = 0; nt < 4; ++nt) { accw[nt] = (f32x4){0.f, 0.f, 0.f, 0.f}; acca[nt] = (f32x4){0.f, 0.f, 0.f, 0.f}; }
  {
    const u16* W2T = (const u16*)(p.ws + OFF_W2T) + ((size_t)l * 256 + head * 64 + fr * 4) * 64 + fq * 8;
    const u16* A2T = (const u16*)(p.ws + OFF_A2T) + ((size_t)l * 256 + head * 64 + fr * 4) * 64 + fq * 8;
#pragma unroll
    for (int ks = 0; ks < 2; ++ks) {
      const bf16x8 aw = *(const bf16x8*)(lwb + fr * 72 + ks * 32 + fq * 8);
      const bf16x8 aa = *(const bf16x8*)(lab + fr * 72 + ks * 32 + fq * 8);
#pragma unroll
      for (int nt = 0; nt < 4; ++nt) {
        const bf16x8 bw = *(const bf16x8*)(W2T + nt * 64 + ks * 32);
        const bf16x8 ba = *(const bf16x8*)(A2T + nt * 64 + ks * 32);
        accw[nt] = __builtin_amdgcn_mfma_f32_16x16x32_bf16(aw, bw, accw[nt], 0, 0, 0);
        acca[nt] = __builtin_amdgcn_mfma_f32_16x16x32_bf16(aa, ba, acca[nt], 0, 0, 0);
      }
    }
  }
  const int c0 = head * 64 + fr * 4;
  const float4 mur = *(const float4*)(p.mu_rkv + l * 768 + c0), muk = *(const float4*)(p.mu_rkv + l * 768 + 256 + c0), muv = *(const float4*)(p.mu_rkv + l * 768 + 512 + c0);
  const float4 w0 = *(const float4*)(p.w0 + l * 256 + c0), a0 = *(const float4*)(p.a0 + l * 256 + c0);
  const float4 kkw = *(const float4*)(p.k_k + l * 256 + c0), kaw = *(const float4*)(p.k_a + l * 256 + c0), rkw = *(const float4*)(p.r_k + l * 256 + c0);
  float* RWW = (float*)(p.ws + OFF_RWW);
  u16* RWKK = (u16*)(p.ws + OFF_RWKK);
  u16* RB = (u16*)(p.ws + OFF_RWB);
  float* BON = (float*)(p.ws + OFF_BONUS);
#define F4E(v, i) ((i) == 0 ? v.x : (i) == 1 ? v.y : (i) == 2 ? v.z : v.w)
#pragma unroll
  for (int rg = 0; rg < 4; ++rg) {
    const int t = t0 + fq * 4 + rg;
    const u16* pr = PROJ + (size_t)t * NALL;
    const u16* pp = (t > 0) ? pr - NALL : pr;
    const float pm = (t > 0) ? 1.f : 0.f;
    const uint2 rcu = *(const uint2*)(pr + 1280 + c0), kcu = *(const uint2*)(pr + 1536 + c0), vcu = *(const uint2*)(pr + 1792 + c0);
    const uint2 rpu = *(const uint2*)(pp + 1280 + c0), kpu = *(const uint2*)(pp + 1536 + c0), vpu = *(const uint2*)(pp + 1792 + c0);
    const float rc[4] = {bflo(rcu.x), bfhi(rcu.x), bflo(rcu.y), bfhi(rcu.y)}, kc[4] = {bflo(kcu.x), bfhi(kcu.x), bflo(kcu.y), bfhi(kcu.y)};
    const float vc[4] = {bflo(vcu.x), bfhi(vcu.x), bflo(vcu.y), bfhi(vcu.y)};
    const float rp[4] = {bflo(rpu.x), bfhi(rpu.x), bflo(rpu.y), bfhi(rpu.y)}, kp[4] = {bflo(kpu.x), bfhi(kpu.x), bflo(kpu.y), bfhi(kpu.y)};
    const float vp[4] = {bflo(vpu.x), bfhi(vpu.x), bflo(vpu.y), bfhi(vpu.y)};
    float kkc[4], av[4], dec[4], rr[4], km[4], vv[4];
    float n2 = 0.f, bonus = 0.f;
#pragma unroll
    for (int nt = 0; nt < 4; ++nt) {
      const float r = rc[nt] + (pm * rp[nt] - rc[nt]) * F4E(mur, nt), k = kc[nt] + (pm * kp[nt] - kc[nt]) * F4E(muk, nt), v = vc[nt] + (pm * vp[nt] - vc[nt]) * F4E(muv, nt);
      const float wpre = F4E(w0, nt) + accw[nt][rg];
      const float wl = -softplusf_(-wpre) - 0.5f;
      dec[nt] = __expf(-__expf(wl));
      const float a = sigmoidf_(F4E(a0, nt) + acca[nt][rg]);
      const float kc2 = k * F4E(kkw, nt);
      const float kmod = k * (1.f + (a - 1.f) * F4E(kaw, nt));
      kkc[nt] = kc2; av[nt] = a; rr[nt] = r; km[nt] = kmod; vv[nt] = v;
      n2 += kc2 * kc2;
      bonus += r * kmod * F4E(rkw, nt);
    }
    n2 = row16_allsum(n2);
    bonus = row16_allsum(bonus);
    const float inv = __builtin_amdgcn_rsqf(fmaxf(n2, 1e-24f));
    const size_t o = (size_t)t * 256 + c0;
    *(float4*)(RWW + o) = make_float4(dec[0], dec[1], dec[2], dec[3]);
    *(uint2*)(RWKK + o) = make_uint2(pack2(-kkc[0] * inv, -kkc[1] * inv), pack2(-kkc[2] * inv, -kkc[3] * inv));
    *(uint2*)(RB + o) = make_uint2(pack2(rr[0], rr[1]), pack2(rr[2], rr[3]));
    *(uint2*)(RB + (size_t)T_ * 256 + o) = make_uint2(pack2(km[0], km[1]), pack2(km[2], km[3]));
    *(uint2*)(RB + (size_t)2 * T_ * 256 + o) = make_uint2(pack2(vv[0], vv[1]), pack2(vv[2], vv[3]));
    *(uint2*)(RB + (size_t)3 * T_ * 256 + o) = make_uint2(pack2(kkc[0] * inv * av[0], kkc[1] * inv * av[1]), pack2(kkc[2] * inv * av[2], kkc[3] * inv * av[3]));
    if (fr == 0) BON[t * 4 + head] = bonus;
  }
  __syncthreads();
}

__device__ __forceinline__ void gla_b(const Params& p, int l, int head, const u16* lgs, float* tot, float* bl) {
  const int tid = opaque_tid(), d = tid & 31, ig = tid >> 5;
  float g2[16];
#pragma unroll
  for (int m = 0; m < 16; ++m) g2[m] = p.gk2[(size_t)l * 16 * 128 + m * 128 + head * 32 + d];
  const float bias = p.gk_b[l * 128 + head * 32 + d];
  float run = 0.f;
#pragma unroll
  for (int ii = 0; ii < 8; ++ii) {
    const uint4* lp = (const uint4*)(lgs + (ig * 8 + ii) * 16);
    uint4 u0 = lp[0], u1 = lp[1];
    float z = bias;
    z += bflo(u0.x) * g2[0] + bfhi(u0.x) * g2[1] + bflo(u0.y) * g2[2] + bfhi(u0.y) * g2[3];
    z += bflo(u0.z) * g2[4] + bfhi(u0.z) * g2[5] + bflo(u0.w) * g2[6] + bfhi(u0.w) * g2[7];
    z += bflo(u1.x) * g2[8] + bfhi(u1.x) * g2[9] + bflo(u1.y) * g2[10] + bfhi(u1.y) * g2[11];
    z += bflo(u1.z) * g2[12] + bfhi(u1.z) * g2[13] + bflo(u1.w) * g2[14] + bfhi(u1.w) * g2[15];
    float g = (fminf(z, 0.f) - __logf(1.f + __expf(-fabsf(z)))) * (1.f / 16.f);
    run += g;
    bl[ii] = run;
  }
  tot[ig * 32 + d] = run;
  __syncthreads();
  float off = 0.f;
#pragma unroll
  for (int g = 0; g < 8; ++g) off += (g < ig) ? tot[g * 32 + d] : 0.f;
#pragma unroll
  for (int ii = 0; ii < 8; ++ii) bl[ii] += off;
}
__device__ __forceinline__ void st8f(float* dst, const uint4 u) {
  *(float4*)(dst) = make_float4(bflo(u.x), bfhi(u.x), bflo(u.y), bfhi(u.y));
  *(float4*)(dst + 4) = make_float4(bflo(u.z), bfhi(u.z), bflo(u.w), bfhi(u.w));
}

__device__ void gla_local_item(const Params& p, int l, int item, unsigned char* smem) {
  l = opq(l); item = opq(item);
  float* tot = (float*)smem;
  float* kf = tot + 256;
  u16* KpT = (u16*)(kf + 2304);
  u16* Vt = KpT + 2304;
  u16* lgs = Vt + 4608;
  const u16* PROJ = (const u16*)(p.ws + OFF_PROJ);
  const int tid = opaque_tid(), d = tid & 31, ig = tid >> 5;
  const int chunk = item >> 2, head = item & 3;
  {
    const u16* base = PROJ + (size_t)(chunk * 64) * NALL;
    const int ki = tid >> 2, kd0 = (tid & 3) * 8;
    const uint4 ku = *(const uint4*)(base + (size_t)ki * NALL + 2432 + head * 32 + kd0);
    const int g0 = tid, g1 = tid + 256;
    const uint4 vu0 = *(const uint4*)(base + (size_t)(g0 >> 3) * NALL + 2560 + head * 64 + (g0 & 7) * 8);
    const uint4 vu1 = *(const uint4*)(base + (size_t)(g1 >> 3) * NALL + 2560 + head * 64 + (g1 & 7) * 8);
    uint4 lu = make_uint4(0u, 0u, 0u, 0u);
    if (tid < 128) lu = *(const uint4*)(base + (size_t)(tid >> 1) * NALL + 3328 + (tid & 1) * 8);
    st8f(kf + ki * 36 + kd0, ku);
    {
      const int j0 = g0 >> 3, c0 = (g0 & 7) * 8, j1 = g1 >> 3, c1 = (g1 & 7) * 8;
      const unsigned w0[4] = {vu0.x, vu0.y, vu0.z, vu0.w}, w1[4] = {vu1.x, vu1.y, vu1.z, vu1.w};
#pragma unroll
      for (int q = 0; q < 4; ++q) {
        Vt[(c0 + 2 * q) * 72 + j0] = (u16)(w0[q] & 0xffff); Vt[(c0 + 2 * q + 1) * 72 + j0] = (u16)(w0[q] >> 16);
        Vt[(c1 + 2 * q) * 72 + j1] = (u16)(w1[q] & 0xffff); Vt[(c1 + 2 * q + 1) * 72 + j1] = (u16)(w1[q] >> 16);
      }
    }
    if (tid < 128) *(uint4*)(lgs + (tid >> 1) * 16 + (tid & 1) * 8) = lu;
  }
  __syncthreads();
  float bl[8];
  gla_b(p, l, head, lgs, tot, bl);
  float blast = 0.f;
#pragma unroll
  for (int g = 0; g < 8; ++g) blast += tot[g * 32 + d];
  {
    float kp[8];
#pragma unroll
    for (int ii = 0; ii < 8; ++ii) kp[ii] = kf[(ig * 8 + ii) * 36 + d] * __expf(blast - bl[ii]);
    *(uint4*)(KpT + d * 72 + ig * 8) = make_uint4(pack2(kp[0], kp[1]), pack2(kp[2], kp[3]), pack2(kp[4], kp[5]), pack2(kp[6], kp[7]));
  }
  __syncthreads();
  const int w = tid >> 6, lane = tid & 63, l31 = lane & 31, hf = lane >> 5;
  if (w < 2) {
    f32x16 c;
#pragma unroll
    for (int r = 0; r < 16; ++r) c[r] = 0.f;
#pragma unroll
    for (int ks = 0; ks < 4; ++ks) {
      const bf16x8 af = *(const bf16x8*)(KpT + l31 * 72 + 16 * ks + 8 * hf);
      const bf16x8 bfr = *(const bf16x8*)(Vt + (32 * w + l31) * 72 + 16 * ks + 8 * hf);
      c = __builtin_amdgcn_mfma_f32_32x32x16_bf16(af, bfr, c, 0, 0, 0);
    }
    float* GS = (float*)(p.ws + OFF_GLAS) + (size_t)(chunk * 4 + head) * 2048 + 32 * w + l31;
#pragma unroll
    for (int r = 0; r < 16; ++r) GS[((r & 3) + 8 * (r >> 2) + 4 * hf) * 64] = c[r];
  }
  float* GD = (float*)(p.ws + OFF_GLAD);
  if (tid < 32) GD[(chunk * 4 + head) * 32 + tid] = __expf(blast);
  __syncthreads();
}

#define GLA_STATE_LOAD(eb_) \
  const int gs_tid = opaque_tid512(); const int gs_ei = gs_tid & 31, gs_g = gs_tid >> 5; \
  const int gs_e = (eb_) * 32 + gs_ei; const int gs_head = gs_e >> 11, gs_d = (gs_e >> 6) & 31, gs_v = gs_e & 63; \
  float gs_ds[16], gs_dc[16]; \
  { float* GSl = (float*)(p.ws + OFF_GLAS); const float* GDl = (const float*)(p.ws + OFF_GLAD); \
    _Pragma("unroll") for (int i = 0; i < 16; ++i) { const int c = gs_g * 16 + i; \
      gs_ds[i] = GSl[((size_t)(c * 4 + gs_head) * 32 + gs_d) * 64 + gs_v]; gs_dc[i] = GDl[(c * 4 + gs_head) * 32 + gs_d]; } }
#define GLA_STATE_FINISH(dsm_) { \
    float* comp = (float*)(dsm_); float* GSl = (float*)(p.ws + OFF_GLAS); \
    float S = 0.f, P = 1.f; \
    _Pragma("unroll") for (int i = 0; i < 16; ++i) { S = gs_dc[i] * S + gs_ds[i]; P *= gs_dc[i]; } \
    comp[(gs_g * 32 + gs_ei) * 2] = P; comp[(gs_g * 32 + gs_ei) * 2 + 1] = S; \
    __syncthreads(); \
    float G = 0.f; \
    for (int gg = 0; gg < gs_g; ++gg) G = comp[(gg * 32 + gs_ei) * 2] * G + comp[(gg * 32 + gs_ei) * 2 + 1]; \
    _Pragma("unroll") for (int i = 0; i < 16; ++i) { const int c = gs_g * 16 + i; \
      GSl[((size_t)(c * 4 + gs_head) * 32 + gs_d) * 64 + gs_v] = G; G = gs_dc[i] * G + gs_ds[i]; } \
    __syncthreads(); }

__device__ void gla_out_item(const Params& p, int l, int item, unsigned char* smem) {
  l = opq(l); item = opq(item);
  float* tot = (float*)smem;
  float* red = tot + 256;
  float* qf = red + 128;
  float* kf = qf + 2304;
  u16* qt = (u16*)(kf + 2304);
  u16* kt = qt + 2560;
  u16* Vt = kt + 2560;
  u16* StT = Vt + 4608;
  u16* lgs = StT + 2560;
  const u16* PROJ = (const u16*)(p.ws + OFF_PROJ);
  u16* MIX = (u16*)(p.ws + OFF_MIX);
  const float* GS = (const float*)(p.ws + OFF_GLAS);
  const int tid = opaque_tid();
  const int chunk = item >> 2, head = item & 3;
  {
    const u16* base = PROJ + (size_t)(chunk * 64) * NALL;
    const int ki = tid >> 2, kd0 = (tid & 3) * 8;
    const uint4 qu = *(const uint4*)(base + (size_t)ki * NALL + 2304 + head * 32 + kd0);
    const uint4 ku = *(const uint4*)(base + (size_t)ki * NALL + 2432 + head * 32 + kd0);
    const int g0 = tid, g1 = tid + 256;
    const uint4 vu0 = *(const uint4*)(base + (size_t)(g0 >> 3) * NALL + 2560 + head * 64 + (g0 & 7) * 8);
    const uint4 vu1 = *(const uint4*)(base + (size_t)(g1 >> 3) * NALL + 2560 + head * 64 + (g1 & 7) * 8);
    const float4 s0 = ((const float4*)(GS + (size_t)(chunk * 4 + head) * 2048))[tid];
    const float4 s1 = ((const float4*)(GS + (size_t)(chunk * 4 + head) * 2048))[tid + 256];
    uint4 lu = make_uint4(0u, 0u, 0u, 0u);
    if (tid < 128) lu = *(const uint4*)(base + (size_t)(tid >> 1) * NALL + 3328 + (tid & 1) * 8);
    st8f(qf + ki * 36 + kd0, qu);
    st8f(kf + ki * 36 + kd0, ku);
    {
      const int j0 = g0 >> 3, c0 = (g0 & 7) * 8, j1 = g1 >> 3, c1 = (g1 & 7) * 8;
      const unsigned w0[4] = {vu0.x, vu0.y, vu0.z, vu0.w}, w1[4] = {vu1.x, vu1.y, vu1.z, vu1.w};
#pragma unroll
      for (int q = 0; q < 4; ++q) {
        Vt[(c0 + 2 * q) * 72 + j0] = (u16)(w0[q] & 0xffff); Vt[(c0 + 2 * q + 1) * 72 + j0] = (u16)(w0[q] >> 16);
        Vt[(c1 + 2 * q) * 72 + j1] = (u16)(w1[q] & 0xffff); Vt[(c1 + 2 * q + 1) * 72 + j1] = (u16)(w1[q] >> 16);
      }
    }
    {
      const int d0 = tid >> 4, v0 = (tid & 15) * 4, d1 = (tid + 256) >> 4;
      StT[(v0 + 0) * 40 + d0] = f2bf(s0.x); StT[(v0 + 1) * 40 + d0] = f2bf(s0.y); StT[(v0 + 2) * 40 + d0] = f2bf(s0.z); StT[(v0 + 3) * 40 + d0] = f2bf(s0.w);
      StT[(v0 + 0) * 40 + d1] = f2bf(s1.x); StT[(v0 + 1) * 40 + d1] = f2bf(s1.y); StT[(v0 + 2) * 40 + d1] = f2bf(s1.z); StT[(v0 + 3) * 40 + d1] = f2bf(s1.w);
    }
    if (tid < 128) *(uint4*)(lgs + (tid >> 1) * 16 + (tid & 1) * 8) = lu;
  }
  __syncthreads();
  {
    const int d = tid & 31, ig = tid >> 5;
    float bl[8];
    gla_b(p, l, head, lgs, tot, bl);
#pragma unroll
    for (int ii = 0; ii < 8; ++ii) {
      const int i = ig * 8 + ii;
      qt[i * 40 + d] = f2bf(qf[i * 36 + d] * 0.17677669529663687f * __expf(bl[ii]));
      kt[i * 40 + d] = f2bf(kf[i * 36 + d] * __expf(-bl[ii]));
    }
  }
  __syncthreads();
  const int w = tid >> 6, lane = tid & 63, l31 = lane & 31, hf = lane >> 5;
  const int it = w & 1, vt = w >> 1;
  const int t = chunk * 64 + 32 * it + l31;
  const u16* gp = PROJ + (size_t)t * NALL + 2816 + head * 64 + 32 * vt + 4 * hf;
  uint2 ggl[4];
#pragma unroll
  for (int g = 0; g < 4; ++g) ggl[g] = *(const uint2*)(gp + 8 * g);
  bf16x8 qfr[2];
#pragma unroll
  for (int ks = 0; ks < 2; ++ks) qfr[ks] = *(const bf16x8*)(qt + (32 * it + l31) * 40 + 16 * ks + 8 * hf);
  f32x16 o;
#pragma unroll
  for (int r = 0; r < 16; ++r) o[r] = 0.f;
#pragma unroll
  for (int jt = 0; jt < 2; ++jt) {
    if (jt <= it) {
      f32x16 c1;
#pragma unroll
      for (int r = 0; r < 16; ++r) c1[r] = 0.f;
#pragma unroll
      for (int ks = 0; ks < 2; ++ks) {
        const bf16x8 kfr = *(const bf16x8*)(kt + (32 * jt + l31) * 40 + 16 * ks + 8 * hf);
        c1 = __builtin_amdgcn_mfma_f32_32x32x16_bf16(kfr, qfr[ks], c1, 0, 0, 0);
      }
      if (jt == it) {
#pragma unroll
        for (int r = 0; r < 16; ++r) { const int jl = (r & 3) + 8 * (r >> 2) + 4 * hf; c1[r] = (jl <= l31) ? c1[r] : 0.f; }
      }
#pragma unroll
      for (int u = 0; u < 2; ++u) {
        const uint4 pfu = make_uint4(pack2(c1[8 * u + 0], c1[8 * u + 1]), pack2(c1[8 * u + 2], c1[8 * u + 3]), pack2(c1[8 * u + 4], c1[8 * u + 5]), pack2(c1[8 * u + 6], c1[8 * u + 7]));
        const bf16x8 pf = __builtin_bit_cast(bf16x8, pfu);
        const u16* vp = Vt + (32 * vt + l31) * 72 + 32 * jt + 16 * u + 4 * hf;
        const uint2 a0 = *(const uint2*)(vp), a1 = *(const uint2*)(vp + 8);
        const uint4 A0 = make_uint4(a0.x, a0.y, a1.x, a1.y);
        o = __builtin_amdgcn_mfma_f32_32x32x16_bf16(__builtin_bit_cast(bf16x8, A0), pf, o, 0, 0, 0);
      }
    }
  }
#pragma unroll
  for (int ks = 0; ks < 2; ++ks) {
    const bf16x8 sfr = *(const bf16x8*)(StT + (32 * vt + l31) * 40 + 16 * ks + 8 * hf);
    o = __builtin_amdgcn_mfma_f32_32x32x16_bf16(sfr, qfr[ks], o, 0, 0, 0);
  }
  float part = 0.f;
#pragma unroll
  for (int r = 0; r < 16; ++r) part += o[r] * o[r];
  part += __shfl_xor(part, 32);
  if (hf == 0) red[vt * 64 + 32 * it + l31] = part;
  __syncthreads();
  const float ms = (red[32 * it + l31] + red[64 + 32 * it + l31]) * (1.f / 64.f);
  const float rs = rsqrtf(ms + 1e-5f);
  u16* op = MIX + (size_t)t * 1024 + 768 + head * 64 + 32 * vt + 4 * hf;
#pragma unroll
  for (int g = 0; g < 4; ++g) {
    const float4 nw = *(const float4*)(p.gla_nw + l * 64 + 32 * vt + 8 * g + 4 * hf);
    const uint2 gg = ggl[g];
    const float r0 = o[4 * g + 0] * rs * nw.x * silu(bflo(gg.x)), r1 = o[4 * g + 1] * rs * nw.y * silu(bfhi(gg.x));
    const float r2 = o[4 * g + 2] * rs * nw.z * silu(bflo(gg.y)), r3 = o[4 * g + 3] * rs * nw.w * silu(bfhi(gg.y));
    *(uint2*)(op + 8 * g) = make_uint2(pack2(r0, r1), pack2(r2, r3));
  }
  __syncthreads();
}

typedef float f32x2 __attribute__((ext_vector_type(2)));
__device__ __forceinline__ float oct_allsum(float x) {
  x += dpp_f<0xB1>(x);
  x += dpp_f<0x4E>(x);
  x += dpp_f<0x141>(x);
  return x;
}
__device__ void rwkv_scan_item(const Params& p, int item, unsigned char* dsm_) {
  item = opq(item);
  float* st = (float*)dsm_;
  const int tid = opaque_tid512(), wv = tid >> 6, lane = tid & 63, rs = lane >> 3, kl = lane & 7;
  const int head = item & 3, seg = item >> 2;
  const bool ident = wv >= 4;
  const int R0 = wv * 16 + rs * 2;
  const int v0 = R0 & 63;
  const float* RWW = (const float*)(p.ws + OFF_RWW);
  const u16* RWKK = (const u16*)(p.ws + OFF_RWKK);
  const u16* RB = (const u16*)(p.ws + OFF_RWB);
  float* PF = (float*)(p.ws + OFF_PROJ);
  float* ZP = (float*)(p.ws + OFF_ZP);
  const int tbase = seg * SL;
  const int half = tid >> 8, ls = (tid & 255) >> 4, lc4 = (tid & 15) * 4;
  f32x2 S0[4], S1[4];
#pragma unroll
  for (int e = 0; e < 4; ++e) { S0[e] = (f32x2){0.f, 0.f}; S1[e] = (f32x2){0.f, 0.f}; }
  if (ident) {
#pragma unroll
    for (int e = 0; e < 4; ++e) {
      const int k0 = kl * 8 + 2 * e;
      S0[e] = (f32x2){(v0 == k0) ? 1.f : 0.f, (v0 == k0 + 1) ? 1.f : 0.f};
      S1[e] = (f32x2){(v0 + 1 == k0) ? 1.f : 0.f, (v0 + 1 == k0 + 1) ? 1.f : 0.f};
    }
  }
  float4 g0 = make_float4(0.f, 0.f, 0.f, 0.f);
  uint2 h0 = make_uint2(0u, 0u), h1 = h0, h2 = h0;
  const float* gp0 = RWW + (size_t)(tbase + ls) * 256 + head * 64 + lc4;
  const u16* gq0 = RWKK + (size_t)(tbase + ls) * 256 + head * 64 + lc4;
  const u16* hp = RB + (size_t)(tbase + ls) * 256 + head * 64 + lc4;
#define SCAN_GLOAD(ch) do { const size_t _o = (size_t)(ch) * 16 * 256; \
    if (half == 0) { g0 = *(const float4*)(gp0 + _o); h0 = *(const uint2*)(hp + _o); } \
    else { const uint2 _k = *(const uint2*)(gq0 + _o); g0 = make_float4(bflo(_k.x), bfhi(_k.x), bflo(_k.y), bfhi(_k.y)); \
           h0 = *(const uint2*)(hp + (size_t)T_ * 256 + _o); h1 = *(const uint2*)(hp + (size_t)3 * T_ * 256 + _o); h2 = *(const uint2*)(hp + (size_t)2 * T_ * 256 + _o); } } while (0)
#define SCAN_LSTORE(buf) do { float* _b = st + (buf) * 6144 + ls * 64 + lc4; \
    if (half == 0) { *(float4*)(_b) = g0; *(float4*)(_b + 2048) = make_float4(bflo(h0.x), bfhi(h0.x), bflo(h0.y), bfhi(h0.y)); } \
    else { *(float4*)(_b + 1024) = g0; *(float4*)(_b + 3072) = make_float4(bflo(h0.x), bfhi(h0.x), bflo(h0.y), bfhi(h0.y)); \
           *(float4*)(_b + 4096) = make_float4(bflo(h1.x), bfhi(h1.x), bflo(h1.y), bfhi(h1.y)); *(float4*)(_b + 5120) = make_float4(bflo(h2.x), bfhi(h2.x), bflo(h2.y), bfhi(h2.y)); } } while (0)
  if (tid < 16) st[2 * 6144 + tid] = 0.f;
  SCAN_GLOAD(0);
  SCAN_LSTORE(0);
  __syncthreads();
  const int nch = SL / 16;
  u16* yout = (u16*)(p.ws + OFF_PROJ) + (size_t)tbase * NALL + 1280 + (ident ? 256 : 0) + head * 64 + v0;
  const int voff = ident ? (2 * 6144) : (5120 + v0);
  const int vstep = ident ? 0 : 64, vbuf = ident ? 0 : 6144;
#define V2(a, i) ((f32x2){(i) ? a.z : a.x, (i) ? a.w : a.y})
#define SCAN_STEP(s_, IDENT) do { \
    const float* bp = b + (s_) * 64 + kl * 8; \
    const float4 wl = *(const float4*)(bp), wh = *(const float4*)(bp + 4); \
    const float4 kkl = *(const float4*)(bp + 1024), kkh = *(const float4*)(bp + 1028); \
    const float4 rl4 = *(const float4*)(bp + 2048), rh4 = *(const float4*)(bp + 2052); \
    float4 kl4 = make_float4(0.f, 0.f, 0.f, 0.f), kh4 = kl4; f32x2 vv = {0.f, 0.f}; \
    if (!(IDENT)) { kl4 = *(const float4*)(bp + 3072); kh4 = *(const float4*)(bp + 3076); vv = *(const f32x2*)(vsrc + (s_) * vstep); } \
    const float4 bl4 = *(const float4*)(bp + 4096), bh4 = *(const float4*)(bp + 4100); \
    const f32x2 W[4] = {V2(wl, 0), V2(wl, 1), V2(wh, 0), V2(wh, 1)}, KK[4] = {V2(kkl, 0), V2(kkl, 1), V2(kkh, 0), V2(kkh, 1)}; \
    const f32x2 RR[4] = {V2(rl4, 0), V2(rl4, 1), V2(rh4, 0), V2(rh4, 1)}, KV[4] = {V2(kl4, 0), V2(kl4, 1), V2(kh4, 0), V2(kh4, 1)}; \
    const f32x2 BB[4] = {V2(bl4, 0), V2(bl4, 1), V2(bh4, 0), V2(bh4, 1)}; \
    f32x2 t0 = S0[0] * KK[0] + S0[1] * KK[1] + S0[2] * KK[2] + S0[3] * KK[3]; \
    f32x2 t1 = S1[0] * KK[0] + S1[1] * KK[1] + S1[2] * KK[2] + S1[3] * KK[3]; \
    float sa0 = t0.x + t0.y, sa1 = t1.x + t1.y;     \
    sa0 += dpp_f<0xB1>(sa0); sa1 += dpp_f<0xB1>(sa1); sa0 += dpp_f<0x4E>(sa0); sa1 += dpp_f<0x4E>(sa1); sa0 += dpp_f<0x141>(sa0); sa1 += dpp_f<0x141>(sa1); \
    const f32x2 a0 = {sa0, sa0}, a1 = {sa1, sa1}, u0 = {vv.x, vv.x}, u1 = {vv.y, vv.y}; \
    if (IDENT) { _Pragma("unroll") for (int e = 0; e < 4; ++e) { S0[e] = S0[e] * W[e] + a0 * BB[e]; S1[e] = S1[e] * W[e] + a1 * BB[e]; } } \
    else { _Pragma("unroll") for (int e = 0; e < 4; ++e) { S0[e] = S0[e] * W[e] + a0 * BB[e] + u0 * KV[e]; S1[e] = S1[e] * W[e] + a1 * BB[e] + u1 * KV[e]; } } \
    f32x2 q0 = S0[0] * RR[0] + S0[1] * RR[1] + S0[2] * RR[2] + S0[3] * RR[3]; \
    f32x2 q1 = S1[0] * RR[0] + S1[1] * RR[1] + S1[2] * RR[2] + S1[3] * RR[3]; \
    float y0 = q0.x + q0.y, y1 = q1.x + q1.y; \
    y0 += dpp_f<0xB1>(y0); y1 += dpp_f<0xB1>(y1); y0 += dpp_f<0x4E>(y0); y1 += dpp_f<0x4E>(y1); y0 += dpp_f<0x141>(y0); y1 += dpp_f<0x141>(y1); \
    const bool mine = (kl == ((s_) & 7)); \
    if ((s_) < 8) { ya.x = mine ? y0 : ya.x; ya.y = mine ? y1 : ya.y; } else { yb.x = mine ? y0 : yb.x; yb.y = mine ? y1 : yb.y; } } while (0)
  for (int ch = 0; ch < nch; ++ch) {
    const int cur = ch & 1;
    if (ch + 1 < nch) SCAN_GLOAD(ch + 1);
    const float* b = st + cur * 6144;
    const float* vsrc = st + voff + cur * vbuf;
    f32x2 ya = {0.f, 0.f}, yb = {0.f, 0.f};
    if (ident) {
#pragma unroll 2
      for (int s = 0; s < 8; ++s) SCAN_STEP(s, true);
#pragma unroll 2
      for (int s = 8; s < 16; ++s) SCAN_STEP(s, true);
    } else {
#pragma unroll 2
      for (int s = 0; s < 8; ++s) SCAN_STEP(s, false);
#pragma unroll 2
      for (int s = 8; s < 16; ++s) SCAN_STEP(s, false);
    }
    *(unsigned*)(yout + (size_t)(ch * 16 + kl) * NALL) = pack2(ya.x, ya.y);
    *(unsigned*)(yout + (size_t)(ch * 16 + 8 + kl) * NALL) = pack2(yb.x, yb.y);
    if (ch + 1 < nch) SCAN_LSTORE(cur ^ 1);
    __syncthreads();
  }
#pragma unroll
  for (int j = 0; j < 2; ++j) {
    float* zp = ZP + ((size_t)((seg * 4 + head) * 128 + R0 + j)) * 64 + kl * 8;
    if (j == 0) { *(float4*)(zp) = make_float4(S0[0].x, S0[0].y, S0[1].x, S0[1].y); *(float4*)(zp + 4) = make_float4(S0[2].x, S0[2].y, S0[3].x, S0[3].y); }
    else { *(float4*)(zp) = make_float4(S1[0].x, S1[0].y, S1[1].x, S1[1].y); *(float4*)(zp + 4) = make_float4(S1[2].x, S1[2].y, S1[3].x, S1[3].y); }
  }
}

__device__ void rwkv_combine(const Params& p, unsigned char* dsm_) {
  float* ring = (float*)dsm_;
  float* sbuf = ring + 3 * 8704;
  float* ZP = (float*)(p.ws + OFF_ZP);
  const int tid = opaque_tid512(); const int lane = tid & 63, wv = tid >> 6;
  const int rowi = blockIdx.x * 8 + wv;
  const int head = rowi >> 6, v = rowi & 63;
  const int li = (tid & 15) + 16 * (wv & 3), m0 = ((tid >> 4) & 3) + 4 * (wv >> 2);
  float4 a0A, b0A, a1A, b1A, a0B, b0B, a1B, b1B, a0C, b0C, a1C, b1C;
  float z0A, z1A, z0B, z1B, z0C, z1C;
#define COMB_LOAD(X, stg_) do { \
      const float* base0 = ZP + (size_t)((((stg_) * 2 + 0) * 4 + head) * 128) * 64; \
      const float* base1 = ZP + (size_t)((((stg_) * 2 + 1) * 4 + head) * 128) * 64; \
      a0##X = *(const float4*)(base0 + 4096 + li * 64 + 4 * m0); b0##X = *(const float4*)(base0 + 4096 + li * 64 + 32 + 4 * m0); z0##X = base0[v * 64 + lane]; \
      a1##X = *(const float4*)(base1 + 4096 + li * 64 + 4 * m0); b1##X = *(const float4*)(base1 + 4096 + li * 64 + 32 + 4 * m0); z1##X = base1[v * 64 + lane]; } while (0)
#define COMB_PUT(dst, A4, B4) do { float* d_ = (dst) + li; \
      d_[(4 * m0 + 0) * 68] = A4.x; d_[(4 * m0 + 1) * 68] = A4.y; d_[(4 * m0 + 2) * 68] = A4.z; d_[(4 * m0 + 3) * 68] = A4.w; \
      d_[(32 + 4 * m0 + 0) * 68] = B4.x; d_[(32 + 4 * m0 + 1) * 68] = B4.y; d_[(32 + 4 * m0 + 2) * 68] = B4.z; d_[(32 + 4 * m0 + 3) * 68] = B4.w; } while (0)
#define COMB_SEG(q, ZC) do { const int seg = stg * 2 + q; \
      ZP[((size_t)((seg * 4 + head) * 128 + v)) * 64 + lane] = s; \
      sbuf[wv * 64 + lane] = s; \
      const float* PT = buf + q * 4352 + lane * 68; const float* sb = sbuf + wv * 64; \
        \
      float4 pv[16], sv[16]; \
      _Pragma("unroll") for (int i4 = 0; i4 < 16; ++i4) pv[i4] = *(const float4*)(PT + 4 * i4); \
      _Pragma("unroll") for (int i4 = 0; i4 < 16; ++i4) sv[i4] = *(const float4*)(sb + 4 * i4); \
      __builtin_amdgcn_sched_barrier(0); \
      f32x2 acc0 = {ZC, 0.f}, acc1 = {0.f, 0.f}, acc2 = {0.f, 0.f}, acc3 = {0.f, 0.f}; \
      _Pragma("unroll") for (int i4 = 0; i4 < 16; i4 += 2) { \
        acc0 += (f32x2){sv[i4].x, sv[i4].y} * (f32x2){pv[i4].x, pv[i4].y}; acc1 += (f32x2){sv[i4].z, sv[i4].w} * (f32x2){pv[i4].z, pv[i4].w}; \
        acc2 += (f32x2){sv[i4 + 1].x, sv[i4 + 1].y} * (f32x2){pv[i4 + 1].x, pv[i4 + 1].y}; acc3 += (f32x2){sv[i4 + 1].z, sv[i4 + 1].w} * (f32x2){pv[i4 + 1].z, pv[i4 + 1].w}; } \
      s = ((acc0.x + acc0.y) + (acc1.x + acc1.y)) + ((acc2.x + acc2.y) + (acc3.x + acc3.y)); } while (0)
#define COMB_STAGE(X, bi) do { \
      float* buf = ring + (bi) * 8704; \
      COMB_PUT(buf, a0##X, b0##X); COMB_PUT(buf + 4352, a1##X, b1##X); \
      const float c0 = z0##X, c1 = z1##X; \
      { const int nstg = (stg + 3 < NSEG / 2) ? stg + 3 : stg; COMB_LOAD(X, nstg); } \
      __syncthreads(); \
      COMB_SEG(0, c0); COMB_SEG(1, c1); ++stg; } while (0)
  COMB_LOAD(A, 0); COMB_LOAD(B, 1); COMB_LOAD(C, 2);
  float s = 0.f;
  int stg = 0;
#pragma unroll 1
  for (int it3 = 0; it3 < (NSEG / 2) / 3; ++it3) {
    COMB_STAGE(A, 0); COMB_STAGE(B, 1); COMB_STAGE(C, 2);
  }
  COMB_STAGE(A, 0); COMB_STAGE(B, 1);
  __syncthreads();
#undef COMB_LOAD
#undef COMB_PUT
#undef COMB_SEG
#undef COMB_STAGE
}

__device__ __forceinline__ bf16x8 pack8(const float4 a, const float4 b) {
  uint4 u = make_uint4(pack2(a.x, a.y), pack2(a.z, a.w), pack2(b.x, b.y), pack2(b.z, b.w));
  return __builtin_bit_cast(bf16x8, u);
}
__device__ void rwkv_final_item(const Params& p, int l, int item, unsigned char* smem) {
  l = opq(l); item = opq(item);
  const int tid = opaque_tid(), w = tid >> 6, lane = tid & 63, l31 = lane & 31, hf = lane >> 5;
  const int parts = SL / 128;
  const int q = item % parts, head = (item / parts) & 3, seg = item / (parts * 4);
  const int t = seg * SL + q * 128 + w * 32 + l31;
  const float* ZP = (const float*)(p.ws + OFF_ZP);
  const float* PF = (const float*)(p.ws + OFF_PROJ);
  const u16* PROJ = (const u16*)(p.ws + OFF_PROJ);
  const u16* RBv = (const u16*)(p.ws + OFF_RWB) + (size_t)2 * T_ * 256;
  const float* BON = (const float*)(p.ws + OFF_BONUS);
  u16* MIX = (u16*)(p.ws + OFF_MIX);
  f32x16 acc0, acc1;
#pragma unroll
  for (int r = 0; r < 16; ++r) { acc0[r] = 0.f; acc1[r] = 0.f; }
  const u16* y0p = PROJ + (size_t)t * NALL + 1280 + head * 64 + 4 * hf;
  const int cb = head * 64 + 4 * hf;
  float4 yA[4], yB[4];
  uint2 vvl[8], ggl[8];
#pragma unroll
  for (int g = 0; g < 4; ++g) {
    const uint2 ua = *(const uint2*)(y0p + 8 * g), ub = *(const uint2*)(y0p + 32 + 8 * g);
    yA[g] = make_float4(bflo(ua.x), bfhi(ua.x), bflo(ua.y), bfhi(ua.y)); yB[g] = make_float4(bflo(ub.x), bfhi(ub.x), bflo(ub.y), bfhi(ub.y));
  }
#pragma unroll
  for (int q8 = 0; q8 < 8; ++q8) {
    const int c = cb + (q8 >> 2) * 32 + 8 * (q8 & 3);
    vvl[q8] = *(const uint2*)(RBv + (size_t)t * 256 + c);
    ggl[q8] = *(const uint2*)(PROJ + (size_t)t * NALL + 2048 + c);
  }
  const float bon = BON[t * 4 + head];
  {
    const float* sp = ZP + ((size_t)((seg * 4 + head) * 128 + l31)) * 64 + 8 * hf;
    const u16* rp = PROJ + (size_t)t * NALL + 1280 + 256 + head * 64 + 8 * hf;
#pragma unroll
    for (int ks = 0; ks < 4; ++ks) {
      const bf16x8 bfrag = *(const bf16x8*)(rp + 16 * ks);
      const bf16x8 a0 = pack8(*(const float4*)(sp + 16 * ks), *(const float4*)(sp + 16 * ks + 4));
      const bf16x8 a1 = pack8(*(const float4*)(sp + 32 * 64 + 16 * ks), *(const float4*)(sp + 32 * 64 + 16 * ks + 4));
      acc0 = __builtin_amdgcn_mfma_f32_32x32x16_bf16(a0, bfrag, acc0, 0, 0, 0);
      acc1 = __builtin_amdgcn_mfma_f32_32x32x16_bf16(a1, bfrag, acc1, 0, 0, 0);
    }
  }
  float sum = 0.f;
#pragma unroll
  for (int g = 0; g < 4; ++g) {
    const float4 ya = yA[g], yb = yB[g];
    acc0[4 * g + 0] += ya.x; acc0[4 * g + 1] += ya.y; acc0[4 * g + 2] += ya.z; acc0[4 * g + 3] += ya.w;
    acc1[4 * g + 0] += yb.x; acc1[4 * g + 1] += yb.y; acc1[4 * g + 2] += yb.z; acc1[4 * g + 3] += yb.w;
  }
#pragma unroll
  for (int r = 0; r < 16; ++r) sum += acc0[r] + acc1[r];
  sum += __shfl_xor(sum, 32);
  const float mean = sum * (1.f / 64.f);
  float var = 0.f;
#pragma unroll
  for (int r = 0; r < 16; ++r) { const float d0 = acc0[r] - mean, d1 = acc1[r] - mean; var += d0 * d0 + d1 * d1; }
  var += __shfl_xor(var, 32);
  const float rstd = rsqrtf(var * (1.f / 64.f) + 64e-5f);
#pragma unroll
  for (int mt = 0; mt < 2; ++mt)
#pragma unroll
    for (int g = 0; g < 4; ++g) {
      const int c = cb + mt * 32 + 8 * g;
      const float4 lw = *(const float4*)(p.ln_w + l * 256 + c), lb = *(const float4*)(p.ln_b + l * 256 + c);
      const uint2 vv = vvl[mt * 4 + g];
      const uint2 gg = ggl[mt * 4 + g];
      float o0 = (mt ? acc1[4 * g + 0] : acc0[4 * g + 0]), o1 = (mt ? acc1[4 * g + 1] : acc0[4 * g + 1]);
      float o2 = (mt ? acc1[4 * g + 2] : acc0[4 * g + 2]), o3 = (mt ? acc1[4 * g + 3] : acc0[4 * g + 3]);
      o0 = (o0 - mean) * rstd * lw.x + lb.x + bon * bflo(vv.x);
      o1 = (o1 - mean) * rstd * lw.y + lb.y + bon * bfhi(vv.x);
      o2 = (o2 - mean) * rstd * lw.z + lb.z + bon * bflo(vv.y);
      o3 = (o3 - mean) * rstd * lw.w + lb.w + bon * bfhi(vv.y);
      o0 *= silu(bflo(gg.x)); o1 *= silu(bfhi(gg.x)); o2 *= silu(bflo(gg.y)); o3 *= silu(bfhi(gg.y));
      *(uint2*)(MIX + (size_t)t * 1024 + 512 + c) = make_uint2(pack2(o0, o1), pack2(o2, o3));
    }
}

#define LDS_BYTES (131072 + 16)
#ifndef REP_G1
#define REP_G1 1
#endif
#ifndef REP_G2
#define REP_G2 1
#endif
#ifndef REP_P3
#define REP_P3 1
#endif
#ifndef REP_SCAN
#define REP_SCAN 1
#endif
#ifndef REP_GO
#define REP_GO 1
#endif
#ifndef REP_FIN
#define REP_FIN 1
#endif
#define PAIR_LOOP(N, BODY) for (int _pr = blockIdx.x; _pr < (N) / 2; _pr += gridDim.x) { const int it = 2 * _pr + vb; BODY }
__global__ void __launch_bounds__(512) fwd_megakernel(Params p) {
  cg::grid_group grid = cg::this_grid();
  extern __shared__ __attribute__((aligned(16))) unsigned char dsm[];
  const int vb = __builtin_amdgcn_readfirstlane(threadIdx.x >> 8);
  unsigned char* smem = dsm + vb * 65536;
  if (threadIdx.x == 0) *(uint4*)(dsm + 131072) = make_uint4(0u, 0u, 0u, 0u);
  __syncthreads();
  const XcdBarrier xb = xcd_barrier_post((unsigned*)(p.ws + OFF_BAR), (volatile LAS unsigned*)(dsm + 131072));
#define GSYNC() xcd_barrier(xb)
#ifndef PH
#define PH 0xffff
#endif
  if (PH & 1) PAIR_LOOP(384, phase_mod_item(p, it, smem);)
  if (PH & 2) PAIR_LOOP(1120, { const int it2 = (it < 864) ? it : 3456 + (it - 864); phase_wconv_item(p, it2, smem); })
  if (PH & 2) PAIR_LOOP(8, phase_w2t_item(p, it);)
  if (p.ws == nullptr) grid.sync();
  GSYNC();
  if (PH & 4) phase_h0(p);
  GSYNC();
#pragma unroll 1
  for (int hl = 0; hl < 8; ++hl) {
    const int l = hl >> 1;
    const bool second = hl & 1;
    if (PH & 8) {
      pg8::Gemm g; g.M = T_; g.K = 1024;
      pg8::EpiU E; E.O = (void*)(p.ws + OFF_PROJ);
      if (!second) { g.A = (const u16*)(p.ws + OFF_H); g.Bt = (const u16*)(p.ws + OFF_WALL) + (size_t)l * NALL * 1024; g.N = 3584; E.ldc = NALL; E.ncols = 3344; E.f32out = 0; }
      else { g.A = (const u16*)(p.ws + OFF_MIX); g.Bt = (const u16*)(p.ws + OFF_WOUT) + (size_t)l * 1024 * 1024; g.N = 1024; E.ldc = 1024; E.ncols = 1024; E.f32out = 0; }
      pg8::StaticOrder S; S.init(T_, g.N, gridDim.x, blockIdx.x);
      const int nrep = second ? REP_G2 : REP_G1;
#pragma unroll 1
      for (int rep = 0; rep < nrep; ++rep)
      pg8::gemm_phase<pg8::EpiU, pg8::StaticOrder, false>((PG8_LAS unsigned char*)dsm, g, S, E, nullptr);
      if (!second && l < 3 && (PH & 2)) {
        const int G = gridDim.x, rem = 896 % G;
        if (rem != 0 && (int)blockIdx.x >= rem) {
          const int nidle = G - rem, me = blockIdx.x - rem;
          for (int _pr = me; _pr < 560; _pr += nidle) {
            const int it = 2 * _pr + vb;
            const int it2 = (it < 864) ? (l + 1) * 864 + it : 3456 + (l + 1) * 256 + (it - 864);
            phase_wconv_item(p, it2, smem);
          }
        } else if (rem == 0) {
          PAIR_LOOP(1120, { const int it2 = (it < 864) ? (l + 1) * 864 + it : 3456 + (l + 1) * 256 + (it - 864); phase_wconv_item(p, it2, smem); })
        }
      }
    }
    GSYNC();
    if (!second) {
#pragma unroll 1
      for (int rep = 0; rep < REP_P3; ++rep)
      PAIR_LOOP(2048,
        if (it < 1024) { if (PH & 32) rwkv_prep_item(p, l, it, smem); }
        else { if (PH & 64) gla_local_item(p, l, it - 1024, smem); }
      )
      GSYNC();
#pragma unroll 1
      for (int wi = blockIdx.x; wi < 256; wi += gridDim.x) {
        GLA_STATE_LOAD(wi)
#pragma unroll 1
        for (int rep = 0; rep < REP_SCAN; ++rep)
        if (PH & 256) rwkv_scan_item(p, wi, dsm);
        __syncthreads();
        if (PH & 128) GLA_STATE_FINISH(dsm)
      }
      GSYNC();
      if (blockIdx.x < 32) { if (PH & 512) rwkv_combine(p, dsm); }
#pragma unroll 1
      for (int rep = 0; rep < REP_GO; ++rep)
      if (PH & 1024) {
        unsigned* ctr = (unsigned*)(p.ws + OFF_BAR) + 32 + l;
        volatile unsigned* slot = (volatile unsigned*)(dsm + 131072) + 2;
        for (;;) {
          if (threadIdx.x == 0) *slot = atomicAdd(ctr, 1u);
          __syncthreads();
          const unsigned pr = (unsigned)__builtin_amdgcn_readfirstlane((int)*slot);
          __syncthreads();
          if (pr >= 1024u) break;
          if (pr < 512u) attn_item(p, l, 2 * (int)pr + vb, smem);
          else gla_out_item(p, l, 2 * (int)(pr - 512u) + vb, smem);
        }
      }
      GSYNC();
#pragma unroll 1
      for (int rep = 0; rep < REP_FIN; ++rep)
      if (PH & 2048) PAIR_LOOP(NSEG * 4 * (SL / 128), rwkv_final_item(p, l, it, smem);)
      GSYNC();
    } else {
      if (PH & 8192) phase_post(p, l);
      if (hl < 7) GSYNC();
    }
  }
}

extern "C" void kernel_launch(void* const* d_in, const int* in_sizes, int n_in, void* d_out, int out_size, void* d_ws, size_t ws_size,
                              hipStream_t stream) {
  static int grid_blocks = 0;
  if (!grid_blocks) {
    int dev = 0, cus = 0, per_cu = 0;
    (void)hipGetDevice(&dev);
    (void)hipDeviceGetAttribute(&cus, hipDeviceAttributeMultiprocessorCount, dev);
    (void)hipFuncSetAttribute((const void*)fwd_megakernel, hipFuncAttributeMaxDynamicSharedMemorySize, LDS_BYTES);
    (void)hipOccupancyMaxActiveBlocksPerMultiprocessor(&per_cu, fwd_megakernel, 512, LDS_BYTES);
    if (per_cu < 1) per_cu = 1;
    grid_blocks = cus;
    if (grid_blocks < 64) { fprintf(stderr, "kernel_launch: needs at least 64 CUs (got %d)\n", cus); grid_blocks = -1; }
  }
  if (grid_blocks < 0) return;
  if (n_in != 27 || ws_size < WS_END) {
    fprintf(stderr, "kernel_launch: unexpected n_in %d / ws %zu\n", n_in, ws_size);
    return;
  }
  Params p{};
  const float** pp = (const float**)&p;
  for (int i = 0; i < 27; ++i) pp[i] = (const float*)d_in[i];
  p.out = (float*)d_out;
  p.ws = (unsigned char*)d_ws;
  (void)hipMemsetAsync((unsigned char*)d_ws + OFF_BAR, 0, XCD_BAR_WORDS * 4, stream);
  void* args[] = {&p};
  hipError_t e = hipLaunchCooperativeKernel((void*)fwd_megakernel, dim3(grid_blocks), dim3(512), args, LDS_BYTES, stream);
  if (e != hipSuccess) fprintf(stderr, "cooperative launch failed: %s (grid %d)\n", hipGetErrorString(e), grid_blocks);
}
```

```cpp
#include <hip/hip_runtime.h>
#include <hip/hip_bf16.h>
#include <hip/hip_cooperative_groups.h>
#include <cstdio>
namespace cg = cooperative_groups;

typedef unsigned short u16;
using bf16x8 = __attribute__((ext_vector_type(8))) short;
using f32x4 = __attribute__((ext_vector_type(4))) float;
using f32x16 = __attribute__((ext_vector_type(16))) float;

#define T_ 16384
#define NALL 3456
#define NSEG 64
#define SL (T_ / NSEG)
#define PROJF 1728

#define OFF_WALL 0ull
#define OFF_WOUT 28311552ull
#define OFF_MOD 36700160ull
#define OFF_H 36749312ull
#define OFF_RWW OFF_H
#define OFF_RWKK (OFF_H + 16777216ull)
#define OFF_PROJ 70303744ull
#define OFF_MIX 183549952ull
#define OFF_RWB 217104384ull
#define OFF_GLAS 250658816ull
#define OFF_GLAD 259047424ull
#define OFF_BONUS 259178496ull
#define OFF_ZP 259440640ull
#define OFF_BAR 267829248ull
#define OFF_W2T 267845632ull
#define OFF_A2T 267976704ull
#define WS_END 268107776ull


struct Params {
  const float *x, *c, *ada_w, *ada_b, *norm_pre, *norm_post, *w_in, *w_out, *sinks, *mu_rkv, *mu_w, *mu_a, *w0, *w1, *w2,
      *a0, *a1, *a2, *k_k, *k_a, *r_k, *ln_w, *ln_b, *gk1, *gk2, *gk_b, *gla_nw;
  float* out;
  unsigned char* ws;
};

__device__ __forceinline__ unsigned cvt2(float lo, float hi) { unsigned r; asm("v_cvt_pk_bf16_f32 %0, %1, %2" : "=v"(r) : "v"(lo), "v"(hi)); return r; }
__device__ __forceinline__ u16 f2bf(float f) { return (u16)(cvt2(f, f) & 0xffffu); }
__device__ __forceinline__ float bf2f(u16 h) { return __uint_as_float(((unsigned)h) << 16); }
__device__ __forceinline__ unsigned pack2(float a, float b) { return cvt2(a, b); }
__device__ __forceinline__ float bflo(unsigned u) { return __uint_as_float(u << 16); }
__device__ __forceinline__ float bfhi(unsigned u) { return __uint_as_float(u & 0xffff0000u); }

__device__ __forceinline__ float frcp(float x) { return __builtin_amdgcn_rcpf(x); }
__device__ __forceinline__ float silu(float x) { return x * frcp(1.f + __expf(-x)); }
__device__ __forceinline__ float sigmoidf_(float x) { return frcp(1.f + __expf(-x)); }
__device__ __forceinline__ float softplusf_(float z) { return fmaxf(z, 0.f) + __logf(1.f + __expf(-fabsf(z))); }
__device__ __forceinline__ float tanh_fast(float x) { return 1.f - 2.f * frcp(1.f + __expf(2.f * x)); }

__device__ __forceinline__ int opq(int x) { asm volatile("" : "+s"(x)); return x; }
__device__ __forceinline__ int opaque_tid() { int t = threadIdx.x & 255; asm volatile("" : "+v"(t)); return t; }
__device__ __forceinline__ int opaque_tid512() { int t = threadIdx.x; asm volatile("" : "+v"(t)); return t; }
template <int CTRL>
__device__ __forceinline__ float dpp_f(float x) {
  return __builtin_bit_cast(float, __builtin_amdgcn_update_dpp(0, __builtin_bit_cast(int, x), CTRL, 0xf, 0xf, true));
}
__device__ __forceinline__ float row16_allsum(float x) {
  x += dpp_f<0x128>(x);
  x += dpp_f<0x124>(x);
  x += dpp_f<0x122>(x);
  x += dpp_f<0x121>(x);
  return x;
}
__device__ __forceinline__ float wave_sum(float v) {
  v = row16_allsum(v);
  const int iv = __builtin_bit_cast(int, v);
  const float a = __builtin_bit_cast(float, __builtin_amdgcn_readlane(iv, 0)), b = __builtin_bit_cast(float, __builtin_amdgcn_readlane(iv, 16));
  const float c = __builtin_bit_cast(float, __builtin_amdgcn_readlane(iv, 32)), d = __builtin_bit_cast(float, __builtin_amdgcn_readlane(iv, 48));
  return (a + b) + (c + d);
}

namespace pg8 {
#define PG8_LAS __attribute__((address_space(3)))
typedef unsigned short bf16_t;
typedef short bf16x8 __attribute__((ext_vector_type(8)));
typedef float f32x4 __attribute__((ext_vector_type(4)));
typedef unsigned u32x4 __attribute__((ext_vector_type(4)));
constexpr int BM = 256, BK = 64, HALF = 128, HTB = HALF * BK * 2  , STAGE_BYTES = 8 * HTB, NXCD = 8, WGM = 8;

__host__ __device__ __forceinline__ int lds_byte(int r, int c) { const int st = (r >> 4) * 2 + (c >> 5), rr = r & 15, cc = c & 31, ob = rr * 64 + cc * 2; return st * 1024 + (ob ^ (((ob >> 9) & 1) << 5)); }
__host__ __device__ __forceinline__ void stage_rc(int b, int& R, int& C) { const int st = b / 1024, sb = b % 1024, swz = sb ^ (((sb >> 9) & 1) << 5); R = (st >> 1) * 16 + swz / 64; C = (st & 1) * 32 + (swz % 64) / 2; }
__host__ __device__ __forceinline__ int perm32(int rho) { const int n = rho >> 4, i = rho & 15; return 8 * (i >> 2) + 4 * n + (i & 3); }

struct Unit { int pm, pn; };
struct Gemm { const bf16_t* A; const bf16_t* Bt; int M, N, K; };

struct StaticOrder {
    int nM, nN, nwg, G, c;
    __host__ __device__ void init(int M, int N, int G_, int c_) { nM = M / BM; nN = N / BM; nwg = nM * nN; G = G_; c = c_; }
    __host__ __device__ bool next(int i, Unit& u) const {
        const long L = (long)i * G + c; if (L >= nwg) return false;
        int wgid = (int)L; { const int q = nwg / NXCD, r = nwg % NXCD, xcd = wgid % NXCD, off = wgid / NXCD; wgid = (xcd < r ? xcd * (q + 1) : r * (q + 1) + (xcd - r) * q) + off; }
        const int nig = WGM * nN, gid = wgid / nig, fm = gid * WGM, gsz = (nM - fm) < WGM ? (nM - fm) : WGM;
        u.pm = fm + ((wgid % nig) % gsz); u.pn = (wgid % nig) / gsz; return true;
    }
    __device__ __forceinline__ void a_ready(const Unit&) const {}
    __device__ __forceinline__ void done(const Unit&) const {}
};
__device__ __forceinline__ unsigned cvt_pk_bf16(float lo, float hi) { unsigned r; asm volatile("v_cvt_pk_bf16_f32 %0, %1, %2" : "=v"(r) : "v"(lo), "v"(hi)); return r; }
template <class Epi, class Sched, bool STAMP = false>
__device__ __forceinline__ void gemm_phase(PG8_LAS unsigned char* lds, const Gemm g, const Sched& S, const Epi& E, unsigned long long* stamps) {
    const int tid = threadIdx.x, wid = __builtin_amdgcn_readfirstlane(tid >> 6), lane = tid & 63, wr = wid >> 2, wc = wid & 3, fr = lane & 15, fq = lane >> 4;
    const int K = g.K, nt = K / BK;
    int ts_lo = 0, ts_hi = 0, nts = 0; const unsigned long long rt_entry = STAMP ? (unsigned long long)wall_clock64() : 0ull;
#define PG8_STAMP() do { if (STAMP && wid == 0 && nts < 64) { const unsigned long long _c = (unsigned long long)clock64(); \
        ts_lo = (lane == nts) ? (int)(unsigned)_c : ts_lo; ts_hi = (lane == nts) ? (int)(unsigned)(_c >> 32) : ts_hi; ++nts; } } while (0)
    PG8_STAMP();
    unsigned voffA[2], voffB[2];
#pragma unroll
    for (int i = 0; i < 2; ++i) { int R, C; stage_rc(tid * 16 + i * 8192, R, C); const int Rb = Epi::PERM ? ((R & ~31) + perm32(R & 31)) : R;
        voffA[i] = (unsigned)(R * K + C) * 2u; voffB[i] = (unsigned)(Rb * K + C) * 2u; }
    const size_t kstep = (size_t)(BK * 2);
    const size_t hstep = (size_t)HALF * K * 2;
    const size_t tstep = 2 * hstep;
    const unsigned ldsw = (unsigned)wid * 1024u;
    const int aoff = lds_byte(wr * 64 + fr, fq * 8), boff = lds_byte(wc * 32 + fr, fq * 8);
#define PG8_SA(b, h) (((b) * 2 + (h)) * HTB)
#define PG8_SB(b, h) ((4 + (b) * 2 + (h)) * HTB)
#define PG8_STAGE(bufoff, gbase, voff) do { _Pragma("unroll") for (int _i = 0; _i < 2; ++_i) \
        __builtin_amdgcn_global_load_lds((const unsigned*)((const char*)(gbase) + (voff)[_i]), (PG8_LAS unsigned*)(lds + (bufoff) + ldsw + _i * 8192), 16, 0, 0); } while (0)
#define PG8_LDA(dst, b, h) do { _Pragma("unroll") for (int m = 0; m < 4; ++m) _Pragma("unroll") for (int k = 0; k < 2; ++k) dst[m][k] = *(const PG8_LAS bf16x8*)(lds + PG8_SA(b, h) + aoff + m * 2048 + k * 1024); } while (0)
#define PG8_LDB(dst, b, h) do { _Pragma("unroll") for (int n = 0; n < 2; ++n) _Pragma("unroll") for (int k = 0; k < 2; ++k) dst[n][k] = *(const PG8_LAS bf16x8*)(lds + PG8_SB(b, h) + boff + n * 2048 + k * 1024); } while (0)
#define PG8_MMA(ai, bj, At, Bt) do { __builtin_amdgcn_s_setprio(1); _Pragma("unroll") for (int m = 0; m < 4; ++m) _Pragma("unroll") for (int n = 0; n < 2; ++n) _Pragma("unroll") for (int k = 0; k < 2; ++k) \
        acc[ai][bj][m][n] = __builtin_amdgcn_mfma_f32_16x16x32_bf16(Bt[n][k], At[m][k], acc[ai][bj][m][n], 0, 0, 0); __builtin_amdgcn_s_setprio(0); } while (0)
#define PG8_WAIT_V(n) asm volatile("s_waitcnt vmcnt(" #n ")" ::: "memory")
#define PG8_WAIT_L(n) asm volatile("s_waitcnt lgkmcnt(" #n ")" ::: "memory")
#define PG8_BAR __builtin_amdgcn_s_barrier()
#define PG8_SCHED __builtin_amdgcn_sched_barrier(0)
    Unit cur, nxt; int ui = 0;
    if (!S.next(0, cur)) return;
    f32x4 acc[2][2][4][2];
#pragma unroll
    for (int a = 0; a < 2; ++a)
#pragma unroll
        for (int b = 0; b < 2; ++b)
#pragma unroll
            for (int m = 0; m < 4; ++m)
#pragma unroll
                for (int n = 0; n < 2; ++n) acc[a][b][m][n] = (f32x4){0.f, 0.f, 0.f, 0.f};
    bf16x8 At[4][2], B0[2][2], B1[2][2];
    const char* cA = (const char*)g.A + (size_t)cur.pm * tstep; const char* cB = (const char*)g.Bt + (size_t)cur.pn * tstep;
    S.a_ready(cur);
    PG8_STAGE(PG8_SB(0, 0), cB, voffB); PG8_STAGE(PG8_SA(0, 0), cA, voffA); PG8_STAGE(PG8_SB(0, 1), cB + hstep, voffB); PG8_STAGE(PG8_SA(0, 1), cA + hstep, voffA);
    if (wr == 1) PG8_BAR;
    PG8_WAIT_V(4); PG8_BAR;
    PG8_STAGE(PG8_SB(1, 0), cB + kstep, voffB); PG8_STAGE(PG8_SA(1, 0), cA + kstep, voffA); PG8_STAGE(PG8_SB(1, 1), cB + hstep + kstep, voffB);
    PG8_WAIT_V(6); PG8_BAR;
    PG8_STAMP();
    for (;;) {
        const bool has_next = S.next(ui + 1, nxt);
        const char* nA = has_next ? (const char*)g.A + (size_t)nxt.pm * tstep : cA; const char* nB = has_next ? (const char*)g.Bt + (size_t)nxt.pn * tstep : cB;
        for (int t = 0; t < nt; t += 2) {
            const bool last = (t == nt - 2);
            const char* a1 = cA + (size_t)(t + 1) * kstep;
            const char* a2 = last ? nA : cA + (size_t)(t + 2) * kstep; const char* b2 = last ? nB : cB + (size_t)(t + 2) * kstep;
            const char* a3 = a2 + kstep; const char* b3 = b2 + kstep;
            if (last && has_next) S.a_ready(nxt);
            PG8_LDB(B0, 0, 0); PG8_SCHED; PG8_LDA(At, 0, 0); PG8_STAGE(PG8_SA(1, 1), a1 + hstep, voffA);
            PG8_WAIT_L(8); PG8_BAR; PG8_WAIT_L(0); PG8_MMA(0, 0, At, B0); PG8_BAR; PG8_SCHED;
            PG8_LDB(B1, 0, 1); PG8_STAGE(PG8_SB(0, 0), b2, voffB);
            PG8_BAR; PG8_WAIT_L(0); PG8_MMA(0, 1, At, B1); PG8_BAR;
            PG8_LDA(At, 0, 1); PG8_STAGE(PG8_SA(0, 0), a2, voffA);
            PG8_BAR; PG8_WAIT_L(0); PG8_MMA(1, 0, At, B0); PG8_BAR; PG8_SCHED;
            PG8_STAGE(PG8_SB(0, 1), b2 + hstep, voffB);
            PG8_WAIT_V(6); PG8_BAR; PG8_MMA(1, 1, At, B1); PG8_BAR;
            PG8_LDB(B0, 1, 0); PG8_SCHED; PG8_LDA(At, 1, 0); PG8_STAGE(PG8_SA(0, 1), a2 + hstep, voffA);
            PG8_WAIT_L(8); PG8_BAR; PG8_WAIT_L(0); PG8_MMA(0, 0, At, B0); PG8_BAR; PG8_SCHED;
            PG8_LDB(B1, 1, 1); PG8_STAGE(PG8_SB(1, 0), b3, voffB);
            PG8_BAR; PG8_WAIT_L(0); PG8_MMA(0, 1, At, B1); PG8_BAR;
            PG8_LDA(At, 1, 1); PG8_STAGE(PG8_SA(1, 0), a3, voffA);
            PG8_BAR; PG8_WAIT_L(0); PG8_MMA(1, 0, At, B0); PG8_BAR; PG8_SCHED;
            PG8_STAGE(PG8_SB(1, 1), b3 + hstep, voffB);
            PG8_WAIT_V(6); PG8_BAR; PG8_MMA(1, 1, At, B1); PG8_BAR;
        }
        PG8_STAMP();
        if constexpr (!Epi::AFTER_DRAIN) { E(acc, cur, wr, wc, fr, fq); S.done(cur); }
        PG8_STAMP();
        if (!has_next) break;
#pragma unroll
        for (int a = 0; a < 2; ++a)
#pragma unroll
            for (int b = 0; b < 2; ++b)
#pragma unroll
                for (int m = 0; m < 4; ++m)
#pragma unroll
                    for (int n = 0; n < 2; ++n) acc[a][b][m][n] = (f32x4){0.f, 0.f, 0.f, 0.f};
        cur = nxt; cA = nA; cB = nB; ++ui;
    }
    PG8_WAIT_V(0);
    if (wr == 0) PG8_BAR;
    PG8_BAR;
    if constexpr (Epi::AFTER_DRAIN) { E.fused(acc, cur, wr, wc, fr, fq, lds, wid, lane); S.done(cur); }
    PG8_STAMP();
    if (STAMP && wid == 0) { stamps[lane] = lane < nts ? (((unsigned long long)(unsigned)ts_hi << 32) | (unsigned)ts_lo) : 0ull;
        if (lane == 62) stamps[62] = rt_entry; if (lane == 63) stamps[63] = (unsigned long long)wall_clock64(); }
#undef PG8_STAMP
#undef PG8_SA
#undef PG8_SB
#undef PG8_STAGE
#undef PG8_LDA
#undef PG8_LDB
#undef PG8_MMA
#undef PG8_WAIT_V
#undef PG8_WAIT_L
#undef PG8_BAR
#undef PG8_SCHED
}
}

namespace pg8 {
struct EpiProj {
    static constexpr bool PERM = true, AFTER_DRAIN = false;
    bf16_t* O; int ldc; int ncols;
    __device__ __forceinline__ void operator()(const f32x4 (&acc)[2][2][4][2], const Unit& u, int wr, int wc, int fr, int fq) const {
        const int row0 = u.pm * BM + wr * 64 + fr; const int col0 = u.pn * BM + wc * 32 + 8 * fq;
#pragma unroll
        for (int ai = 0; ai < 2; ++ai)
#pragma unroll
            for (int m = 0; m < 4; ++m) { bf16_t* rowp = O + (size_t)(row0 + ai * HALF + m * 16) * ldc + col0;
#pragma unroll
                for (int bj = 0; bj < 2; ++bj) { const f32x4 v0 = acc[ai][bj][m][0], v1 = acc[ai][bj][m][1];
                    u32x4 w; w.x = cvt_pk_bf16(v0[0], v0[1]); w.y = cvt_pk_bf16(v0[2], v0[3]); w.z = cvt_pk_bf16(v1[0], v1[1]); w.w = cvt_pk_bf16(v1[2], v1[3]);
                    if (col0 + bj * HALF < ncols) *(u32x4*)(rowp + bj * HALF) = w; } }
    }
};
struct EpiU {
    static constexpr bool PERM = true, AFTER_DRAIN = false;
    void* O; int ldc; int ncols; int f32out;
    __device__ __forceinline__ void operator()(const f32x4 (&acc)[2][2][4][2], const Unit& u, int wr, int wc, int fr, int fq) const {
        const int row0 = u.pm * BM + wr * 64 + fr; const int col0 = u.pn * BM + wc * 32 + 8 * fq;
        if (f32out) {
#pragma unroll
            for (int ai = 0; ai < 2; ++ai)
#pragma unroll
                for (int m = 0; m < 4; ++m) { float* rowp = (float*)O + (size_t)(row0 + ai * HALF + m * 16) * ldc + col0;
#pragma unroll
                    for (int bj = 0; bj < 2; ++bj) { *(f32x4*)(rowp + bj * HALF) = acc[ai][bj][m][0]; *(f32x4*)(rowp + bj * HALF + 4) = acc[ai][bj][m][1]; } }
        } else {
#pragma unroll
            for (int ai = 0; ai < 2; ++ai)
#pragma unroll
                for (int m = 0; m < 4; ++m) { bf16_t* rowp = (bf16_t*)O + (size_t)(row0 + ai * HALF + m * 16) * ldc + col0;
#pragma unroll
                    for (int bj = 0; bj < 2; ++bj) { const f32x4 v0 = acc[ai][bj][m][0], v1 = acc[ai][bj][m][1];
                        u32x4 w; w.x = cvt_pk_bf16(v0[0], v0[1]); w.y = cvt_pk_bf16(v0[2], v0[3]); w.z = cvt_pk_bf16(v1[0], v1[1]); w.w = cvt_pk_bf16(v1[2], v1[3]);
                        if (col0 + bj * HALF < ncols) *(u32x4*)(rowp + bj * HALF) = w; } }
        }
    }
};
}

#define XB_TMO      128
#define XB_XCNT(j)  (256  + 64 * (j))
#define XB_XSUB(j)  (1280 + 64 * (j))
#define XB_XGEN(j)  (2304 + 64 * (j))
#define XB_TOP      3328
#define XB_TOPGEN   3392
#define XCD_BAR_WORDS 3456
#define XB_SPIN_CAP (1u << 18)
#define LAS __attribute__((address_space(3)))

__device__ __forceinline__ unsigned xb_ld(unsigned* p)              { return __hip_atomic_load(p, __ATOMIC_RELAXED, __HIP_MEMORY_SCOPE_AGENT); }
__device__ __forceinline__ unsigned xb_add(unsigned* p, unsigned v) { return __hip_atomic_fetch_add(p, v, __ATOMIC_RELAXED, __HIP_MEMORY_SCOPE_AGENT); }
__device__ __forceinline__ unsigned xb_xcc_id() { return (unsigned)__builtin_amdgcn_s_getreg((3 << 11) | 20) & 0xFu; }
#define XB_SPIN(cond, bar) do { unsigned _sp = 0; while (cond) { __builtin_amdgcn_s_sleep(1); \
    if ((++_sp & 255u) == 0u) { if (xb_ld(&(bar)[XB_TMO])) break; if (_sp > XB_SPIN_CAP) { atomicAdd(&(bar)[XB_TMO], 1u); break; } } } } while (0)

struct XcdBarrier {
    unsigned* bar; unsigned x;
    volatile LAS unsigned* st;
};

__device__ __forceinline__ XcdBarrier xcd_barrier_post(unsigned* bar, volatile LAS unsigned* st) {
    XcdBarrier b; b.bar = bar; b.x = xb_xcc_id(); b.st = st;
    if (threadIdx.x == 0) (void)xb_add(&bar[XB_XCNT(b.x)], 1u);
    return b;
}
__device__ __forceinline__ void xcd_barrier_complete(unsigned* bar, unsigned x, unsigned& nloc, unsigned& nx) {
    const unsigned G = gridDim.x * gridDim.y * gridDim.z;
    unsigned sum, cnt, mine, sp = 0u;
    for (;;) {
        sum = 0u; cnt = 0u; mine = 0u;
#pragma unroll
        for (unsigned j = 0; j < 16; ++j) { const unsigned c = xb_ld(&bar[XB_XCNT(j)]); sum += c; cnt += (c > 0u) ? 1u : 0u; mine = (j == x) ? c : mine; }
        if (sum == G) break;
        __builtin_amdgcn_s_sleep(1);
        if ((++sp & 255u) == 0u) { if (xb_ld(&bar[XB_TMO])) break; if (sp > XB_SPIN_CAP) { atomicAdd(&bar[XB_TMO], 1u); break; } }
    }
    nloc = mine > 0u ? mine : 1u; nx = cnt > 0u ? cnt : 1u;
}

__device__ __forceinline__ void xcd_barrier(const XcdBarrier& b) {
    asm volatile("s_waitcnt vmcnt(0)" ::: "memory");
    __syncthreads();
    if (threadIdx.x == 0) {
        unsigned* bar = b.bar;
        __builtin_amdgcn_s_waitcnt(0);
        unsigned nloc = b.st[0], nx = b.st[1];
        if (nloc == 0u) { xcd_barrier_complete(bar, b.x, nloc, nx); b.st[0] = nloc; b.st[1] = nx; }
        const unsigned old = xb_add(&bar[XB_XSUB(b.x)], 1u);
        const unsigned gen = old / nloc;
        if (old + 1u == (gen + 1u) * nloc) {
            __builtin_amdgcn_fence(__ATOMIC_RELEASE, "agent");
            asm volatile("s_waitcnt vmcnt(0)" ::: "memory");
            const unsigned og = xb_add(&bar[XB_TOP], 1u);
            const unsigned tg = og / nx;
            if (og + 1u == (tg + 1u) * nx) xb_add(&bar[XB_TOPGEN], 1u);
            else XB_SPIN(xb_ld(&bar[XB_TOPGEN]) == tg, bar);
            __builtin_amdgcn_fence(__ATOMIC_ACQUIRE, "agent");
            xb_add(&bar[XB_XGEN(b.x)], 1u);
            asm volatile("s_waitcnt vmcnt(0)" ::: "memory");
        } else {
            XB_SPIN(xb_ld(&bar[XB_XGEN(b.x)]) == gen, bar);
            __builtin_amdgcn_fence(__ATOMIC_ACQUIRE, "agent");
            asm volatile("s_waitcnt vmcnt(0)" ::: "memory");
        }
    }
    __syncthreads();
}

__device__ void phase_mod_item(const Params& p, int it, unsigned char* smem) {
  float* red = (float*)smem;
  const int tid = opaque_tid(), tx = tid & 31, ty = tid >> 5;
  float* mod = (float*)(p.ws + OFF_MOD);
  it = opq(it);
  {
    int l = it / 96;
    int j = (it % 96) * 32 + tx;
    const float* W = p.ada_w + (size_t)l * 1024 * 3072;
    float* cs = red + 256;
#pragma unroll
    for (int i = 0; i < 4; ++i) cs[tid + 256 * i] = silu(p.c[tid + 256 * i]);
    __syncthreads();
    float acc = 0.f;
#pragma unroll 1
    for (int i0 = 0; i0 < 128; i0 += 16) {
      float wv[16];
#pragma unroll
      for (int i = 0; i < 16; ++i) wv[i] = W[(size_t)(ty * 128 + i0 + i) * 3072 + j];
#pragma unroll
      for (int i = 0; i < 16; ++i) acc += cs[ty * 128 + i0 + i] * wv[i];
    }
    red[ty * 32 + tx] = acc;
    __syncthreads();
    if (ty == 0) {
      float s = 0.f;
      for (int g = 0; g < 8; ++g) s += red[g * 32 + tx];
      mod[l * 3072 + j] = s + p.ada_b[l * 3072 + j];
    }
    __syncthreads();
  }
}

__device__ __forceinline__ float wall_src(const Params& p, int l, int k, int n) {
  size_t lk = (size_t)l * 1024 + k;
  if (n < 3072) return p.w_in[lk * 3072 + n];
  if (n < 3136) return (1.f - p.mu_w[lk]) * p.w1[lk * 64 + (n - 3072)];
  if (n < 3200) return p.mu_w[lk] * p.w1[lk * 64 + (n - 3136)];
  if (n < 3264) return (1.f - p.mu_a[lk]) * p.a1[lk * 64 + (n - 3200)];
  if (n < 3328) return p.mu_a[lk] * p.a1[lk * 64 + (n - 3264)];
  if (n < 3344) return p.gk1[lk * 16 + (n - 3328)];
  return 0.f;
}

__device__ void phase_wconv_item(const Params& p, int it, unsigned char* smem) {
  float* tile = (float*)smem;
  const int tid = opaque_tid();
  u16* WALL = (u16*)(p.ws + OFF_WALL);
  u16* WOUT = (u16*)(p.ws + OFF_WOUT);
  it = opq(it);
  {
    bool isout = it >= 3456;
    int l, nt, kt;
    if (!isout) { l = it / 864; int r = it % 864; nt = r >> 4; kt = r & 15; }
    else { int r = it - 3456; l = r >> 8; r &= 255; nt = r >> 4; kt = r & 15; }
    if (isout || nt < 48) {
      const float* src = isout ? p.w_out + (size_t)l * 1024 * 1024 : p.w_in + (size_t)l * 1024 * 3072;
      const int ld = isout ? 1024 : 3072;
      const int n4 = (tid & 15) * 4, k0 = tid >> 4;
      float4 v4[4];
#pragma unroll
      for (int i = 0; i < 4; ++i) v4[i] = *(const float4*)(src + (size_t)(kt * 64 + k0 + 16 * i) * ld + nt * 64 + n4);
#pragma unroll
      for (int i = 0; i < 4; ++i) {
        float* tp = tile + (k0 + 16 * i) * 65 + n4;
        tp[0] = v4[i].x; tp[1] = v4[i].y; tp[2] = v4[i].z; tp[3] = v4[i].w;
      }
    } else {
      int tx = tid & 63, ty = tid >> 6;
#pragma unroll
      for (int i = 0; i < 16; ++i) {
        int kl = ty + 4 * i;
        int k = kt * 64 + kl, n = nt * 64 + tx;
        tile[kl * 65 + tx] = wall_src(p, l, k, n);
      }
    }
    __syncthreads();
    int nl = tid >> 2, kq = tid & 3;
    unsigned w[8];
#pragma unroll
    for (int j = 0; j < 8; ++j) w[j] = pack2(tile[(kq * 16 + 2 * j) * 65 + nl], tile[(kq * 16 + 2 * j + 1) * 65 + nl]);
    u16* dst = (isout ? WOUT + ((size_t)l * 1024 + nt * 64 + nl) * 1024 : WALL + ((size_t)l * NALL + nt * 64 + nl) * 1024) + kt * 64 + kq * 16;
    ((uint4*)dst)[0] = make_uint4(w[0], w[1], w[2], w[3]);
    ((uint4*)dst)[1] = make_uint4(w[4], w[5], w[6], w[7]);
    __syncthreads();
  }
}

__device__ void phase_w2t_item(const Params& p, int it) {
  it = opq(it);
  const int c = opaque_tid();
  const int l = it >> 1, which = it & 1;
  const float* src = (which ? p.a2 : p.w2) + (size_t)l * 64 * 256 + c;
  u16* dst = (u16*)(p.ws + (which ? OFF_A2T : OFF_W2T)) + ((size_t)l * 256 + c) * 64;
#pragma unroll
  for (int j8 = 0; j8 < 8; ++j8) {
    float f[8];
#pragma unroll
    for (int q = 0; q < 8; ++q) f[q] = src[(j8 * 8 + q) * 256];
    *(uint4*)(dst + j8 * 8) = make_uint4(pack2(f[0], f[1]), pack2(f[2], f[3]), pack2(f[4], f[5]), pack2(f[6], f[7]));
  }
}

__device__ __forceinline__ float4 ldnt4(const float* p) { const f32x4 v = __builtin_nontemporal_load((const f32x4*)p); return make_float4(v[0], v[1], v[2], v[3]); }
__device__ void phase_h0(const Params& p) {
  const int tid = opaque_tid512(); const int wave = tid >> 6, lane = tid & 63;
  const float* mod = (const float*)(p.ws + OFF_MOD);
  u16* H = (u16*)(p.ws + OFF_H);
  float4 hs[4], hh[4];
#pragma unroll
  for (int i = 0; i < 4; ++i) {
    const int col = (lane + 64 * i) * 4;
    const float4 gp = *(const float4*)(p.norm_pre + col), sc = *(const float4*)(mod + 1024 + col);
    hs[i] = make_float4(gp.x * (1.f + sc.x), gp.y * (1.f + sc.y), gp.z * (1.f + sc.z), gp.w * (1.f + sc.w));
    hh[i] = *(const float4*)(mod + col);
  }
  const int stride = gridDim.x * 8;
  int row = blockIdx.x * 8 + wave;
  float4 v[4];
#pragma unroll
  for (int i = 0; i < 4; ++i) v[i] = ldnt4(p.x + (size_t)row * 1024 + 4 * (lane + 64 * i));
  for (; row < T_; row += stride) {
    const int nrow = (row + stride < T_) ? row + stride : row;
    float4 vn[4];
#pragma unroll
    for (int i = 0; i < 4; ++i) vn[i] = ldnt4(p.x + (size_t)nrow * 1024 + 4 * (lane + 64 * i));
    float ss = 0.f;
#pragma unroll
    for (int i = 0; i < 4; ++i) ss += v[i].x * v[i].x + v[i].y * v[i].y + v[i].z * v[i].z + v[i].w * v[i].w;
    ss = wave_sum(ss);
    const float r2 = rsqrtf(ss * (1.f / 1024.f) + 1e-6f);
#pragma unroll
    for (int i = 0; i < 4; ++i) {
      const int col = (lane + 64 * i) * 4;
      const float h0 = v[i].x * r2 * hs[i].x + hh[i].x, h1 = v[i].y * r2 * hs[i].y + hh[i].y;
      const float h2 = v[i].z * r2 * hs[i].z + hh[i].z, h3 = v[i].w * r2 * hs[i].w + hh[i].w;
      *(uint2*)(H + (size_t)row * 1024 + col) = make_uint2(pack2(h0, h1), pack2(h2, h3));
    }
#pragma unroll
    for (int i = 0; i < 4; ++i) v[i] = vn[i];
  }
}

__device__ void phase_post(const Params& p, int l) {
  l = opq(l);
  const int tid = opaque_tid512(); const int wave = tid >> 6, lane = tid & 63;
  const u16* Y = (const u16*)(p.ws + OFF_PROJ);
  const float* mod = (const float*)(p.ws + OFF_MOD) + l * 3072;
  const float* modn = (const float*)(p.ws + OFF_MOD) + (l < 3 ? l + 1 : l) * 3072;
  const float* xold = (l == 0) ? p.x : p.out;
  u16* H = (u16*)(p.ws + OFF_H);
  float4 gg[4], hs[4], hh[4];
#pragma unroll
  for (int i = 0; i < 4; ++i) {
    const int col = (lane + 64 * i) * 4;
    const float4 g = *(const float4*)(p.norm_post + l * 1024 + col), gt = *(const float4*)(mod + 2048 + col);
    gg[i] = make_float4(g.x * gt.x, g.y * gt.y, g.z * gt.z, g.w * gt.w);
    const float4 gp = *(const float4*)(p.norm_pre + (l < 3 ? l + 1 : l) * 1024 + col), sc = *(const float4*)(modn + 1024 + col);
    hs[i] = make_float4(gp.x * (1.f + sc.x), gp.y * (1.f + sc.y), gp.z * (1.f + sc.z), gp.w * (1.f + sc.w));
    hh[i] = *(const float4*)(modn + col);
  }
  const int stride = gridDim.x * 8;
  int row = blockIdx.x * 8 + wave;
  uint2 yu[4]; float4 v[4];
#pragma unroll
  for (int i = 0; i < 4; ++i) { yu[i] = ((const uint2*)(Y + (size_t)row * 1024))[lane + 64 * i]; v[i] = ldnt4(xold + (size_t)row * 1024 + 4 * (lane + 64 * i)); }
  for (; row < T_; row += stride) {
    const int nrow = (row + stride < T_) ? row + stride : row;
    uint2 yn[4]; float4 vn[4];
#pragma unroll
    for (int i = 0; i < 4; ++i) { yn[i] = ((const uint2*)(Y + (size_t)nrow * 1024))[lane + 64 * i]; vn[i] = ldnt4(xold + (size_t)nrow * 1024 + 4 * (lane + 64 * i)); }
    float4 y[4];
    float ss = 0.f;
#pragma unroll
    for (int i = 0; i < 4; ++i) {
      y[i] = make_float4(bflo(yu[i].x), bfhi(yu[i].x), bflo(yu[i].y), bfhi(yu[i].y));
      ss += y[i].x * y[i].x + y[i].y * y[i].y + y[i].z * y[i].z + y[i].w * y[i].w;
    }
    ss = wave_sum(ss);
    const float rs = rsqrtf(ss * (1.f / 1024.f) + 1e-6f);
    float s2 = 0.f;
#pragma unroll
    for (int i = 0; i < 4; ++i) {
      const int col = (lane + 64 * i) * 4;
      v[i].x += gg[i].x * (y[i].x * rs);
      v[i].y += gg[i].y * (y[i].y * rs);
      v[i].z += gg[i].z * (y[i].z * rs);
      v[i].w += gg[i].w * (y[i].w * rs);
      *(float4*)(p.out + (size_t)row * 1024 + col) = v[i];
      s2 += v[i].x * v[i].x + v[i].y * v[i].y + v[i].z * v[i].z + v[i].w * v[i].w;
    }
    if (l < 3) {
      s2 = wave_sum(s2);
      const float r2 = rsqrtf(s2 * (1.f / 1024.f) + 1e-6f);
#pragma unroll
      for (int i = 0; i < 4; ++i) {
        const int col = (lane + 64 * i) * 4;
        const float h0 = v[i].x * r2 * hs[i].x + hh[i].x, h1 = v[i].y * r2 * hs[i].y + hh[i].y;
        const float h2 = v[i].z * r2 * hs[i].z + hh[i].z, h3 = v[i].w * r2 * hs[i].w + hh[i].w;
        *(uint2*)(H + (size_t)row * 1024 + col) = make_uint2(pack2(h0, h1), pack2(h2, h3));
      }
    }
#pragma unroll
    for (int i = 0; i < 4; ++i) { yu[i] = yn[i]; v[i] = vn[i]; }
  }
}

__device__ void attn_item(const Params& p, int l, int item, unsigned char* smem) {
  l = opq(l); item = opq(item);
  u16* Vt = (u16*)smem;
  const u16* PROJ = (const u16*)(p.ws + OFF_PROJ);
  u16* MIX = (u16*)(p.ws + OFF_MIX);
  const int tid = opaque_tid(), w = tid >> 6, lane = tid & 63, l31 = lane & 31, hf = lane >> 5;
  const int qb = item >> 3, head = item & 7, kvh = head >> 2;
  const int kpos0 = (qb - 1) * 128;
  {
    int kp = kpos0 + tid;
    if (kp < 0) kp = 0;
    const uint4* src = (const uint4*)(PROJ + (size_t)kp * NALL + 640 + kvh * 64);
#pragma unroll
    for (int c8 = 0; c8 < 8; ++c8) {
      uint4 v = src[c8];
      int d = c8 * 8;
      Vt[(d + 0) * 264 + tid] = (u16)(v.x & 0xffff);
      Vt[(d + 1) * 264 + tid] = (u16)(v.x >> 16);
      Vt[(d + 2) * 264 + tid] = (u16)(v.y & 0xffff);
      Vt[(d + 3) * 264 + tid] = (u16)(v.y >> 16);
      Vt[(d + 4) * 264 + tid] = (u16)(v.z & 0xffff);
      Vt[(d + 5) * 264 + tid] = (u16)(v.z >> 16);
      Vt[(d + 6) * 264 + tid] = (u16)(v.w & 0xffff);
      Vt[(d + 7) * 264 + tid] = (u16)(v.w >> 16);
    }
  }
  const int tq = qb * 128 + 32 * w + l31;
  bf16x8 qf[4], kc[4];
  {
    const u16* qp = PROJ + (size_t)tq * NALL + head * 64 + 8 * hf;
#pragma unroll
    for (int s = 0; s < 4; ++s) qf[s] = *(const bf16x8*)(qp + 16 * s);
    int kp = kpos0 + 32 * w + l31;
    if (kp < 0) kp = 0;
    const u16* kptr = PROJ + (size_t)kp * NALL + 512 + kvh * 64 + 8 * hf;
#pragma unroll
    for (int s = 0; s < 4; ++s) kc[s] = *(const bf16x8*)(kptr + 16 * s);
  }
  __syncthreads();
  const float slope = exp2f(-(float)(head + 1));
  const float sink = p.sinks[l * 8 + head];
  const int rq = 32 * w + l31;
  const u16* gp = PROJ + (size_t)tq * NALL + 768 + head * 64;
  uint2 gA[4], gB[4];
#pragma unroll
  for (int g = 0; g < 4; ++g) { gA[g] = *(const uint2*)(gp + 8 * g + 4 * hf); gB[g] = *(const uint2*)(gp + 32 + 8 * g + 4 * hf); }
  float mrun = -1e30f, lsum = 0.f;
  f32x16 o0, o1;
#pragma unroll
  for (int r = 0; r < 16; ++r) { o0[r] = 0.f; o1[r] = 0.f; }
#pragma unroll 1
  for (int i = 0; i < 5; ++i) {
    bf16x8 kn[4];
    {
      const int in_ = (i < 4) ? i + 1 : 4;
      int kp = kpos0 + 32 * w + 32 * in_ + l31;
      if (kp < 0) kp = 0;
      const u16* kptr = PROJ + (size_t)kp * NALL + 512 + kvh * 64 + 8 * hf;
#pragma unroll
      for (int s = 0; s < 4; ++s) kn[s] = *(const bf16x8*)(kptr + 16 * s);
    }
    f32x16 a;
#pragma unroll
    for (int r = 0; r < 16; ++r) a[r] = 0.f;
#pragma unroll
    for (int s = 0; s < 4; ++s) a = __builtin_amdgcn_mfma_f32_32x32x16_bf16(kc[s], qf[s], a, 0, 0, 0);
#pragma unroll
    for (int s = 0; s < 4; ++s) kc[s] = kn[s];
    float tmax = -1e30f;
    if (i >= 1 && i <= 3 && qb > 0) {
      const float c0 = -slope * (float)(128 + rq - 32 * w - 32 * i - 4 * hf);
#pragma unroll
      for (int r = 0; r < 16; ++r) {
        const float sv = a[r] * 0.125f + (c0 + slope * (float)((r & 3) + 8 * (r >> 2)));
        a[r] = sv;
        tmax = fmaxf(tmax, sv);
      }
    } else {
#pragma unroll
      for (int r = 0; r < 16; ++r) {
        int kj = 32 * w + 32 * i + (r & 3) + 8 * (r >> 2) + 4 * hf;
        int dist = 128 + rq - kj;
        bool valid = (dist >= 0) && (dist < 128) && (kpos0 + kj >= 0);
        float sv = a[r] * 0.125f - slope * (float)dist;
        sv = valid ? sv : -1e30f;
        a[r] = sv;
        tmax = fmaxf(tmax, sv);
      }
    }
    tmax = fmaxf(tmax, __shfl_xor(tmax, 32));
    const float mnew = fmaxf(mrun, tmax);
    const float alpha = __expf(mrun - mnew);
    float psum = 0.f;
#pragma unroll
    for (int r = 0; r < 16; ++r) {
      float e = (a[r] > -1e29f) ? __expf(a[r] - mnew) : 0.f;
      a[r] = e;
      psum += e;
    }
    lsum = lsum * alpha + psum;
    mrun = mnew;
#pragma unroll
    for (int r = 0; r < 16; ++r) { o0[r] *= alpha; o1[r] *= alpha; }
#pragma unroll
    for (int u = 0; u < 2; ++u) {
      const uint4 pfu = make_uint4(pack2(a[8 * u + 0], a[8 * u + 1]), pack2(a[8 * u + 2], a[8 * u + 3]), pack2(a[8 * u + 4], a[8 * u + 5]), pack2(a[8 * u + 6], a[8 * u + 7]));
      const bf16x8 pf = __builtin_bit_cast(bf16x8, pfu);
      const int kb = 32 * w + 32 * i + 16 * u + 4 * hf;
      const u16* v0 = Vt + l31 * 264 + kb;
      const u16* v1 = Vt + (32 + l31) * 264 + kb;
      uint2 a0 = *(const uint2*)(v0), a1 = *(const uint2*)(v0 + 8);
      uint2 b0 = *(const uint2*)(v1), b1 = *(const uint2*)(v1 + 8);
      uint4 A0 = make_uint4(a0.x, a0.y, a1.x, a1.y), A1 = make_uint4(b0.x, b0.y, b1.x, b1.y);
      o0 = __builtin_amdgcn_mfma_f32_32x32x16_bf16(__builtin_bit_cast(bf16x8, A0), pf, o0, 0, 0, 0);
      o1 = __builtin_amdgcn_mfma_f32_32x32x16_bf16(__builtin_bit_cast(bf16x8, A1), pf, o1, 0, 0, 0);
    }
  }
  {
    const float mf = fmaxf(mrun, sink);
    const float scl = __expf(mrun - mf);
    const float ltot = (lsum + __shfl_xor(lsum, 32)) * scl + __expf(sink - mf);
    const float fin = scl / ltot;
#pragma unroll
    for (int r = 0; r < 16; ++r) { o0[r] *= fin; o1[r] *= fin; }
  }
  u16* op = MIX + (size_t)tq * 1024 + head * 64;
#pragma unroll
  for (int g = 0; g < 4; ++g) {
    int d0 = 8 * g + 4 * hf;
    uint2 gg = gA[g];
    float r0 = o0[4 * g + 0] * silu(bflo(gg.x)), r1 = o0[4 * g + 1] * silu(bfhi(gg.x));
    float r2 = o0[4 * g + 2] * silu(bflo(gg.y)), r3 = o0[4 * g + 3] * silu(bfhi(gg.y));
    *(uint2*)(op + d0) = make_uint2(pack2(r0, r1), pack2(r2, r3));
    uint2 g2 = gB[g];
    r0 = o1[4 * g + 0] * silu(bflo(g2.x)); r1 = o1[4 * g + 1] * silu(bfhi(g2.x));
    r2 = o1[4 * g + 2] * silu(bflo(g2.y)); r3 = o1[4 * g + 3] * silu(bfhi(g2.y));
    *(uint2*)(op + 32 + d0) = make_uint2(pack2(r0, r1), pack2(r2, r3));
  }
  __syncthreads();
}

__device__ void rwkv_prep_item(const Params& p, int l, int item, unsigned char* smem) {
  l = opq(l); item = opq(item);
  u16* lwb = (u16*)smem;
  u16* lab = lwb + 16 * 72;
  const u16* PROJ = (const u16*)(p.ws + OFF_PROJ);
  const int tid = opaque_tid(), head = tid >> 6, lane = tid & 63, fr = lane & 15, fq = lane >> 4;
  const int t0 = item * 16;
  {
    const int which = tid >> 7, tt = (tid >> 3) & 15, j0 = (tid & 7) * 8;
    const int t = t0 + tt;
    const u16* pr = PROJ + (size_t)t * NALL;
    const u16* pq = (t > 0) ? pr - NALL : pr;
    const float pm = (t > 0) ? 1.f : 0.f;
    const uint4 cu = *(const uint4*)(pr + (which ? 3200 : 3072) + j0);
    const uint4 pu = *(const uint4*)(pq + (which ? 3264 : 3136) + j0);
    float sv[8];
    sv[0] = bflo(cu.x) + pm * bflo(pu.x); sv[1] = bfhi(cu.x) + pm * bfhi(pu.x);
    sv[2] = bflo(cu.y) + pm * bflo(pu.y); sv[3] = bfhi(cu.y) + pm * bfhi(pu.y);
    sv[4] = bflo(cu.z) + pm * bflo(pu.z); sv[5] = bfhi(cu.z) + pm * bfhi(pu.z);
    sv[6] = bflo(cu.w) + pm * bflo(pu.w); sv[7] = bfhi(cu.w) + pm * bfhi(pu.w);
    if (!which) {
#pragma unroll
      for (int q = 0; q < 8; ++q) sv[q] = tanh_fast(sv[q]);
    }
    *(uint4*)((which ? lab : lwb) + tt * 72 + j0) = make_uint4(pack2(sv[0], sv[1]), pack2(sv[2], sv[3]), pack2(sv[4], sv[5]), pack2(sv[6], sv[7]));
  }
  __syncthreads();
  f32x4 accw[4], acca[4];
#pragma unroll
  for (int nt = 0; nt < 4; ++nt) { accw[nt] = (f32x4){0.f, 0.f, 0.f, 0.f}; acca[nt] = (f32x4){0.f, 0.f, 0.f, 0.f}; }
  {
    const u16* W2T = (const u16*)(p.ws + OFF_W2T) + ((size_t)l * 256 + head * 64 + fr * 4) * 64 + fq * 8;
    const u16* A2T = (const u16*)(p.ws + OFF_A2T) + ((size_t)l * 256 + head * 64 + fr * 4) * 64 + fq * 8;
#pragma unroll
    for (int ks = 0; ks < 2; ++ks) {
      const bf16x8 aw = *(const bf16x8*)(lwb + fr * 72 + ks * 32 + fq * 8);
      const bf16x8 aa = *(const bf16x8*)(lab + fr * 72 + ks * 32 + fq * 8);
#pragma unroll
      for (int nt = 0; nt < 4; ++nt) {
        const bf16x8 bw = *(const bf16x8*)(W2T + nt * 64 + ks * 32);
        const bf16x8 ba = *(const bf16x8*)(A2T + nt * 64 + ks * 32);
        accw[nt] = __builtin_amdgcn_mfma_f32_16x16x32_bf16(aw, bw, accw[nt], 0, 0, 0);
        acca[nt] = __builtin_amdgcn_mfma_f32_16x16x32_bf16(aa, ba, acca[nt], 0, 0, 0);
      }
    }
  }
  const int c0 = head * 64 + fr * 4;
  const float4 mur = *(const float4*)(p.mu_rkv + l * 768 + c0), muk = *(const float4*)(p.mu_rkv + l * 768 + 256 + c0), muv = *(const float4*)(p.mu_rkv + l * 768 + 512 + c0);
  const float4 w0 = *(const float4*)(p.w0 + l * 256 + c0), a0 = *(const float4*)(p.a0 + l * 256 + c0);
  const float4 kkw = *(const float4*)(p.k_k + l * 256 + c0), kaw = *(const float4*)(p.k_a + l * 256 + c0), rkw = *(const float4*)(p.r_k + l * 256 + c0);
  float* RWW = (float*)(p.ws + OFF_RWW);
  u16* RWKK = (u16*)(p.ws + OFF_RWKK);
  u16* RB = (u16*)(p.ws + OFF_RWB);
  float* BON = (float*)(p.ws + OFF_BONUS);
#define F4E(v, i) ((i) == 0 ? v.x : (i) == 1 ? v.y : (i) == 2 ? v.z : v.w)
#pragma unroll
  for (int rg = 0; rg < 4; ++rg) {
    const int t = t0 + fq * 4 + rg;
    const u16* pr = PROJ + (size_t)t * NALL;
    const u16* pp = (t > 0) ? pr - NALL : pr;
    const float pm = (t > 0) ? 1.f : 0.f;
    const uint2 rcu = *(const uint2*)(pr + 1280 + c0), kcu = *(const uint2*)(pr + 1536 + c0), vcu = *(const uint2*)(pr + 1792 + c0);
    const uint2 rpu = *(const uint2*)(pp + 1280 + c0), kpu = *(const uint2*)(pp + 1536 + c0), vpu = *(const uint2*)(pp + 1792 + c0);
    const float rc[4] = {bflo(rcu.x), bfhi(rcu.x), bflo(rcu.y), bfhi(rcu.y)}, kc[4] = {bflo(kcu.x), bfhi(kcu.x), bflo(kcu.y), bfhi(kcu.y)};
    const float vc[4] = {bflo(vcu.x), bfhi(vcu.x), bflo(vcu.y), bfhi(vcu.y)};
    const float rp[4] = {bflo(rpu.x), bfhi(rpu.x), bflo(rpu.y), bfhi(rpu.y)}, kp[4] = {bflo(kpu.x), bfhi(kpu.x), bflo(kpu.y), bfhi(kpu.y)};
    const float vp[4] = {bflo(vpu.x), bfhi(vpu.x), bflo(vpu.y), bfhi(vpu.y)};
    float kkc[4], av[4], dec[4], rr[4], km[4], vv[4];
    float n2 = 0.f, bonus = 0.f;
#pragma unroll
    for (int nt = 0; nt < 4; ++nt) {
      const float r = rc[nt] + (pm * rp[nt] - rc[nt]) * F4E(mur, nt), k = kc[nt] + (pm * kp[nt] - kc[nt]) * F4E(muk, nt), v = vc[nt] + (pm * vp[nt] - vc[nt]) * F4E(muv, nt);
      const float wpre = F4E(w0, nt) + accw[nt][rg];
      const float wl = -softplusf_(-wpre) - 0.5f;
      dec[nt] = __expf(-__expf(wl));
      const float a = sigmoidf_(F4E(a0, nt) + acca[nt][rg]);
      const float kc2 = k * F4E(kkw, nt);
      const float kmod = k * (1.f + (a - 1.f) * F4E(kaw, nt));
      kkc[nt] = kc2; av[nt] = a; rr[nt] = r; km[nt] = kmod; vv[nt] = v;
      n2 += kc2 * kc2;
      bonus += r * kmod * F4E(rkw, nt);
    }
    n2 = row16_allsum(n2);
    bonus = row16_allsum(bonus);
    const float inv = __builtin_amdgcn_rsqf(fmaxf(n2, 1e-24f));
    const size_t o = (size_t)t * 256 + c0;
    *(float4*)(RWW + o) = make_float4(dec[0], dec[1], dec[2], dec[3]);
    *(uint2*)(RWKK + o) = make_uint2(pack2(-kkc[0] * inv, -kkc[1] * inv), pack2(-kkc[2] * inv, -kkc[3] * inv));
    *(uint2*)(RB + o) = make_uint2(pack2(rr[0], rr[1]), pack2(rr[2], rr[3]));
    *(uint2*)(RB + (size_t)T_ * 256 + o) = make_uint2(pack2(km[0], km[1]), pack2(km[2], km[3]));
    *(uint2*)(RB + (size_t)2 * T_ * 256 + o) = make_uint2(pack2(vv[0], vv[1]), pack2(vv[2], vv[3]));
    *(uint2*)(RB + (size_t)3 * T_ * 256 + o) = make_uint2(pack2(kkc[0] * inv * av[0], kkc[1] * inv * av[1]), pack2(kkc[2] * inv * av[2], kkc[3] * inv * av[3]));
    if (fr == 0) BON[t * 4 + head] = bonus;
  }
  __syncthreads();
}

__device__ __forceinline__ void gla_b(const Params& p, int l, int head, const u16* lgs, float* tot, float* bl) {
  const int tid = opaque_tid(), d = tid & 31, ig = tid >> 5;
  float g2[16];
#pragma unroll
  for (int m = 0; m < 16; ++m) g2[m] = p.gk2[(size_t)l * 16 * 128 + m * 128 + head * 32 + d];
  const float bias = p.gk_b[l * 128 + head * 32 + d];
  float run = 0.f;
#pragma unroll
  for (int ii = 0; ii < 8; ++ii) {
    const uint4* lp = (const uint4*)(lgs + (ig * 8 + ii) * 16);
    uint4 u0 = lp[0], u1 = lp[1];
    float z = bias;
    z += bflo(u0.x) * g2[0] + bfhi(u0.x) * g2[1] + bflo(u0.y) * g2[2] + bfhi(u0.y) * g2[3];
    z += bflo(u0.z) * g2[4] + bfhi(u0.z) * g2[5] + bflo(u0.w) * g2[6] + bfhi(u0.w) * g2[7];
    z += bflo(u1.x) * g2[8] + bfhi(u1.x) * g2[9] + bflo(u1.y) * g2[10] + bfhi(u1.y) * g2[11];
    z += bflo(u1.z) * g2[12] + bfhi(u1.z) * g2[13] + bflo(u1.w) * g2[14] + bfhi(u1.w) * g2[15];
    float g = (fminf(z, 0.f) - __logf(1.f + __expf(-fabsf(z)))) * (1.f / 16.f);
    run += g;
    bl[ii] = run;
  }
  tot[ig * 32 + d] = run;
  __syncthreads();
  float off = 0.f;
#pragma unroll
  for (int g = 0; g < 8; ++g) off += (g < ig) ? tot[g * 32 + d] : 0.f;
#pragma unroll
  for (int ii = 0; ii < 8; ++ii) bl[ii] += off;
}
__device__ __forceinline__ void st8f(float* dst, const uint4 u) {
  *(float4*)(dst) = make_float4(bflo(u.x), bfhi(u.x), bflo(u.y), bfhi(u.y));
  *(float4*)(dst + 4) = make_float4(bflo(u.z), bfhi(u.z), bflo(u.w), bfhi(u.w));
}

__device__ void gla_local_item(const Params& p, int l, int item, unsigned char* smem) {
  l = opq(l); item = opq(item);
  float* tot = (float*)smem;
  float* kf = tot + 256;
  u16* KpT = (u16*)(kf + 2304);
  u16* Vt = KpT + 2304;
  u16* lgs = Vt + 4608;
  const u16* PROJ = (const u16*)(p.ws + OFF_PROJ);
  const int tid = opaque_tid(), d = tid & 31, ig = tid >> 5;
  const int chunk = item >> 2, head = item & 3;
  {
    const u16* base = PROJ + (size_t)(chunk * 64) * NALL;
    const int ki = tid >> 2, kd0 = (tid & 3) * 8;
    const uint4 ku = *(const uint4*)(base + (size_t)ki * NALL + 2432 + head * 32 + kd0);
    const int g0 = tid, g1 = tid + 256;
    const uint4 vu0 = *(const uint4*)(base + (size_t)(g0 >> 3) * NALL + 2560 + head * 64 + (g0 & 7) * 8);
    const uint4 vu1 = *(const uint4*)(base + (size_t)(g1 >> 3) * NALL + 2560 + head * 64 + (g1 & 7) * 8);
    uint4 lu = make_uint4(0u, 0u, 0u, 0u);
    if (tid < 128) lu = *(const uint4*)(base + (size_t)(tid >> 1) * NALL + 3328 + (tid & 1) * 8);
    st8f(kf + ki * 36 + kd0, ku);
    {
      const int j0 = g0 >> 3, c0 = (g0 & 7) * 8, j1 = g1 >> 3, c1 = (g1 & 7) * 8;
      const unsigned w0[4] = {vu0.x, vu0.y, vu0.z, vu0.w}, w1[4] = {vu1.x, vu1.y, vu1.z, vu1.w};
#pragma unroll
      for (int q = 0; q < 4; ++q) {
        Vt[(c0 + 2 * q) * 72 + j0] = (u16)(w0[q] & 0xffff); Vt[(c0 + 2 * q + 1) * 72 + j0] = (u16)(w0[q] >> 16);
        Vt[(c1 + 2 * q) * 72 + j1] = (u16)(w1[q] & 0xffff); Vt[(c1 + 2 * q + 1) * 72 + j1] = (u16)(w1[q] >> 16);
      }
    }
    if (tid < 128) *(uint4*)(lgs + (tid >> 1) * 16 + (tid & 1) * 8) = lu;
  }
  __syncthreads();
  float bl[8];
  gla_b(p, l, head, lgs, tot, bl);
  float blast = 0.f;
#pragma unroll
  for (int g = 0; g < 8; ++g) blast += tot[g * 32 + d];
  {
    float kp[8];
#pragma unroll
    for (int ii = 0; ii < 8; ++ii) kp[ii] = kf[(ig * 8 + ii) * 36 + d] * __expf(blast - bl[ii]);
    *(uint4*)(KpT + d * 72 + ig * 8) = make_uint4(pack2(kp[0], kp[1]), pack2(kp[2], kp[3]), pack2(kp[4], kp[5]), pack2(kp[6], kp[7]));
  }
  __syncthreads();
  const int w = tid >> 6, lane = tid & 63, l31 = lane & 31, hf = lane >> 5;
  if (w < 2) {
    f32x16 c;
#pragma unroll
    for (int r = 0; r < 16; ++r) c[r] = 0.f;
#pragma unroll
    for (int ks = 0; ks < 4; ++ks) {
      const bf16x8 af = *(const bf16x8*)(KpT + l31 * 72 + 16 * ks + 8 * hf);
      const bf16x8 bfr = *(const bf16x8*)(Vt + (32 * w + l31) * 72 + 16 * ks + 8 * hf);
      c = __builtin_amdgcn_mfma_f32_32x32x16_bf16(af, bfr, c, 0, 0, 0);
    }
    float* GS = (float*)(p.ws + OFF_GLAS) + (size_t)(chunk * 4 + head) * 2048 + 32 * w + l31;
#pragma unroll
    for (int r = 0; r < 16; ++r) GS[((r & 3) + 8 * (r >> 2) + 4 * hf) * 64] = c[r];
  }
  float* GD = (float*)(p.ws + OFF_GLAD);
  if (tid < 32) GD[(chunk * 4 + head) * 32 + tid] = __expf(blast);
  __syncthreads();
}

#define GLA_STATE_LOAD(eb_) \
  const int gs_tid = opaque_tid512(); const int gs_ei = gs_tid & 31, gs_g = gs_tid >> 5; \
  const int gs_e = (eb_) * 32 + gs_ei; const int gs_head = gs_e >> 11, gs_d = (gs_e >> 6) & 31, gs_v = gs_e & 63; \
  float gs_ds[16], gs_dc[16]; \
  { float* GSl = (float*)(p.ws + OFF_GLAS); const float* GDl = (const float*)(p.ws + OFF_GLAD); \
    _Pragma("unroll") for (int i = 0; i < 16; ++i) { const int c = gs_g * 16 + i; \
      gs_ds[i] = GSl[((size_t)(c * 4 + gs_head) * 32 + gs_d) * 64 + gs_v]; gs_dc[i] = GDl[(c * 4 + gs_head) * 32 + gs_d]; } }
#define GLA_STATE_FINISH(dsm_) { \
    float* comp = (float*)(dsm_); float* GSl = (float*)(p.ws + OFF_GLAS); \
    float S = 0.f, P = 1.f; \
    _Pragma("unroll") for (int i = 0; i < 16; ++i) { S = gs_dc[i] * S + gs_ds[i]; P *= gs_dc[i]; } \
    comp[(gs_g * 32 + gs_ei) * 2] = P; comp[(gs_g * 32 + gs_ei) * 2 + 1] = S; \
    __syncthreads(); \
    float G = 0.f; \
    for (int gg = 0; gg < gs_g; ++gg) G = comp[(gg * 32 + gs_ei) * 2] * G + comp[(gg * 32 + gs_ei) * 2 + 1]; \
    _Pragma("unroll") for (int i = 0; i < 16; ++i) { const int c = gs_g * 16 + i; \
      GSl[((size_t)(c * 4 + gs_head) * 32 + gs_d) * 64 + gs_v] = G; G = gs_dc[i] * G + gs_ds[i]; } \
    __syncthreads(); }

__device__ void gla_out_item(const Params& p, int l, int item, unsigned char* smem) {
  l = opq(l); item = opq(item);
  float* tot = (float*)smem;
  float* red = tot + 256;
  float* qf = red + 128;
  float* kf = qf + 2304;
  u16* qt = (u16*)(kf + 2304);
  u16* kt = qt + 2560;
  u16* Vt = kt + 2560;
  u16* StT = Vt + 4608;
  u16* lgs = StT + 2560;
  const u16* PROJ = (const u16*)(p.ws + OFF_PROJ);
  u16* MIX = (u16*)(p.ws + OFF_MIX);
  const float* GS = (const float*)(p.ws + OFF_GLAS);
  const int tid = opaque_tid();
  const int chunk = item >> 2, head = item & 3;
  {
    const u16* base = PROJ + (size_t)(chunk * 64) * NALL;
    const int ki = tid >> 2, kd0 = (tid & 3) * 8;
    const uint4 qu = *(const uint4*)(base + (size_t)ki * NALL + 2304 + head * 32 + kd0);
    const uint4 ku = *(const uint4*)(base + (size_t)ki * NALL + 2432 + head * 32 + kd0);
    const int g0 = tid, g1 = tid + 256;
    const uint4 vu0 = *(const uint4*)(base + (size_t)(g0 >> 3) * NALL + 2560 + head * 64 + (g0 & 7) * 8);
    const uint4 vu1 = *(const uint4*)(base + (size_t)(g1 >> 3) * NALL + 2560 + head * 64 + (g1 & 7) * 8);
    const float4 s0 = ((const float4*)(GS + (size_t)(chunk * 4 + head) * 2048))[tid];
    const float4 s1 = ((const float4*)(GS + (size_t)(chunk * 4 + head) * 2048))[tid + 256];
    uint4 lu = make_uint4(0u, 0u, 0u, 0u);
    if (tid < 128) lu = *(const uint4*)(base + (size_t)(tid >> 1) * NALL + 3328 + (tid & 1) * 8);
    st8f(qf + ki * 36 + kd0, qu);
    st8f(kf + ki * 36 + kd0, ku);
    {
      const int j0 = g0 >> 3, c0 = (g0 & 7) * 8, j1 = g1 >> 3, c1 = (g1 & 7) * 8;
      const unsigned w0[4] = {vu0.x, vu0.y, vu0.z, vu0.w}, w1[4] = {vu1.x, vu1.y, vu1.z, vu1.w};
#pragma unroll
      for (int q = 0; q < 4; ++q) {
        Vt[(c0 + 2 * q) * 72 + j0] = (u16)(w0[q] & 0xffff); Vt[(c0 + 2 * q + 1) * 72 + j0] = (u16)(w0[q] >> 16);
        Vt[(c1 + 2 * q) * 72 + j1] = (u16)(w1[q] & 0xffff); Vt[(c1 + 2 * q + 1) * 72 + j1] = (u16)(w1[q] >> 16);
      }
    }
    {
      const int d0 = tid >> 4, v0 = (tid & 15) * 4, d1 = (tid + 256) >> 4;
      StT[(v0 + 0) * 40 + d0] = f2bf(s0.x); StT[(v0 + 1) * 40 + d0] = f2bf(s0.y); StT[(v0 + 2) * 40 + d0] = f2bf(s0.z); StT[(v0 + 3) * 40 + d0] = f2bf(s0.w);
      StT[(v0 + 0) * 40 + d1] = f2bf(s1.x); StT[(v0 + 1) * 40 + d1] = f2bf(s1.y); StT[(v0 + 2) * 40 + d1] = f2bf(s1.z); StT[(v0 + 3) * 40 + d1] = f2bf(s1.w);
    }
    if (tid < 128) *(uint4*)(lgs + (tid >> 1) * 16 + (tid & 1) * 8) = lu;
  }
  __syncthreads();
  {
    const int d = tid & 31, ig = tid >> 5;
    float bl[8];
    gla_b(p, l, head, lgs, tot, bl);
#pragma unroll
    for (int ii = 0; ii < 8; ++ii) {
      const int i = ig * 8 + ii;
      qt[i * 40 + d] = f2bf(qf[i * 36 + d] * 0.17677669529663687f * __expf(bl[ii]));
      kt[i * 40 + d] = f2bf(kf[i * 36 + d] * __expf(-bl[ii]));
    }
  }
  __syncthreads();
  const int w = tid >> 6, lane = tid & 63, l31 = lane & 31, hf = lane >> 5;
  const int it = w & 1, vt = w >> 1;
  const int t = chunk * 64 + 32 * it + l31;
  const u16* gp = PROJ + (size_t)t * NALL + 2816 + head * 64 + 32 * vt + 4 * hf;
  uint2 ggl[4];
#pragma unroll
  for (int g = 0; g < 4; ++g) ggl[g] = *(const uint2*)(gp + 8 * g);
  bf16x8 qfr[2];
#pragma unroll
  for (int ks = 0; ks < 2; ++ks) qfr[ks] = *(const bf16x8*)(qt + (32 * it + l31) * 40 + 16 * ks + 8 * hf);
  f32x16 o;
#pragma unroll
  for (int r = 0; r < 16; ++r) o[r] = 0.f;
#pragma unroll
  for (int jt = 0; jt < 2; ++jt) {
    if (jt <= it) {
      f32x16 c1;
#pragma unroll
      for (int r = 0; r < 16; ++r) c1[r] = 0.f;
#pragma unroll
      for (int ks = 0; ks < 2; ++ks) {
        const bf16x8 kfr = *(const bf16x8*)(kt + (32 * jt + l31) * 40 + 16 * ks + 8 * hf);
        c1 = __builtin_amdgcn_mfma_f32_32x32x16_bf16(kfr, qfr[ks], c1, 0, 0, 0);
      }
      if (jt == it) {
#pragma unroll
        for (int r = 0; r < 16; ++r) { const int jl = (r & 3) + 8 * (r >> 2) + 4 * hf; c1[r] = (jl <= l31) ? c1[r] : 0.f; }
      }
#pragma unroll
      for (int u = 0; u < 2; ++u) {
        const uint4 pfu = make_uint4(pack2(c1[8 * u + 0], c1[8 * u + 1]), pack2(c1[8 * u + 2], c1[8 * u + 3]), pack2(c1[8 * u + 4], c1[8 * u + 5]), pack2(c1[8 * u + 6], c1[8 * u + 7]));
        const bf16x8 pf = __builtin_bit_cast(bf16x8, pfu);
        const u16* vp = Vt + (32 * vt + l31) * 72 + 32 * jt + 16 * u + 4 * hf;
        const uint2 a0 = *(const uint2*)(vp), a1 = *(const uint2*)(vp + 8);
        const uint4 A0 = make_uint4(a0.x, a0.y, a1.x, a1.y);
        o = __builtin_amdgcn_mfma_f32_32x32x16_bf16(__builtin_bit_cast(bf16x8, A0), pf, o, 0, 0, 0);
      }
    }
  }
#pragma unroll
  for (int ks = 0; ks < 2; ++ks) {
    const bf16x8 sfr = *(const bf16x8*)(StT + (32 * vt + l31) * 40 + 16 * ks + 8 * hf);
    o = __builtin_amdgcn_mfma_f32_32x32x16_bf16(sfr, qfr[ks], o, 0, 0, 0);
  }
  float part = 0.f;
#pragma unroll
  for (int r = 0; r < 16; ++r) part += o[r] * o[r];
  part += __shfl_xor(part, 32);
  if (hf == 0) red[vt * 64 + 32 * it + l31] = part;
  __syncthreads();
  const float ms = (red[32 * it + l31] + red[64 + 32 * it + l31]) * (1.f / 64.f);
  const float rs = rsqrtf(ms + 1e-5f);
  u16* op = MIX + (size_t)t * 1024 + 768 + head * 64 + 32 * vt + 4 * hf;
#pragma unroll
  for (int g = 0; g < 4; ++g) {
    const float4 nw = *(const float4*)(p.gla_nw + l * 64 + 32 * vt + 8 * g + 4 * hf);
    const uint2 gg = ggl[g];
    const float r0 = o[4 * g + 0] * rs * nw.x * silu(bflo(gg.x)), r1 = o[4 * g + 1] * rs * nw.y * silu(bfhi(gg.x));
    const float r2 = o[4 * g + 2] * rs * nw.z * silu(bflo(gg.y)), r3 = o[4 * g + 3] * rs * nw.w * silu(bfhi(gg.y));
    *(uint2*)(op + 8 * g) = make_uint2(pack2(r0, r1), pack2(r2, r3));
  }
  __syncthreads();
}

typedef float f32x2 __attribute__((ext_vector_type(2)));
__device__ __forceinline__ float oct_allsum(float x) {
  x += dpp_f<0xB1>(x);
  x += dpp_f<0x4E>(x);
  x += dpp_f<0x141>(x);
  return x;
}
__device__ void rwkv_scan_item(const Params& p, int item, unsigned char* dsm_) {
  item = opq(item);
  float* st = (float*)dsm_;
  const int tid = opaque_tid512(), wv = tid >> 6, lane = tid & 63, rs = lane >> 3, kl = lane & 7;
  const int head = item & 3, seg = item >> 2;
  const bool ident = wv >= 4;
  const int R0 = wv * 16 + rs * 2;
  const int v0 = R0 & 63;
  const float* RWW = (const float*)(p.ws + OFF_RWW);
  const u16* RWKK = (const u16*)(p.ws + OFF_RWKK);
  const u16* RB = (const u16*)(p.ws + OFF_RWB);
  float* PF = (float*)(p.ws + OFF_PROJ);
  float* ZP = (float*)(p.ws + OFF_ZP);
  const int tbase = seg * SL;
  const int half = tid >> 8, ls = (tid & 255) >> 4, lc4 = (tid & 15) * 4;
  f32x2 S0[4], S1[4];
#pragma unroll
  for (int e = 0; e < 4; ++e) { S0[e] = (f32x2){0.f, 0.f}; S1[e] = (f32x2){0.f, 0.f}; }
  if (ident) {
#pragma unroll
    for (int e = 0; e < 4; ++e) {
      const int k0 = kl * 8 + 2 * e;
      S0[e] = (f32x2){(v0 == k0) ? 1.f : 0.f, (v0 == k0 + 1) ? 1.f : 0.f};
      S1[e] = (f32x2){(v0 + 1 == k0) ? 1.f : 0.f, (v0 + 1 == k0 + 1) ? 1.f : 0.f};
    }
  }
  float4 g0 = make_float4(0.f, 0.f, 0.f, 0.f);
  uint2 h0 = make_uint2(0u, 0u), h1 = h0, h2 = h0;
  const float* gp0 = RWW + (size_t)(tbase + ls) * 256 + head * 64 + lc4;
  const u16* gq0 = RWKK + (size_t)(tbase + ls) * 256 + head * 64 + lc4;
  const u16* hp = RB + (size_t)(tbase + ls) * 256 + head * 64 + lc4;
#define SCAN_GLOAD(ch) do { const size_t _o = (size_t)(ch) * 16 * 256; \
    if (half == 0) { g0 = *(const float4*)(gp0 + _o); h0 = *(const uint2*)(hp + _o); } \
    else { const uint2 _k = *(const uint2*)(gq0 + _o); g0 = make_float4(bflo(_k.x), bfhi(_k.x), bflo(_k.y), bfhi(_k.y)); \
           h0 = *(const uint2*)(hp + (size_t)T_ * 256 + _o); h1 = *(const uint2*)(hp + (size_t)3 * T_ * 256 + _o); h2 = *(const uint2*)(hp + (size_t)2 * T_ * 256 + _o); } } while (0)
#define SCAN_LSTORE(buf) do { float* _b = st + (buf) * 6144 + ls * 64 + lc4; \
    if (half == 0) { *(float4*)(_b) = g0; *(float4*)(_b + 2048) = make_float4(bflo(h0.x), bfhi(h0.x), bflo(h0.y), bfhi(h0.y)); } \
    else { *(float4*)(_b + 1024) = g0; *(float4*)(_b + 3072) = make_float4(bflo(h0.x), bfhi(h0.x), bflo(h0.y), bfhi(h0.y)); \
           *(float4*)(_b + 4096) = make_float4(bflo(h1.x), bfhi(h1.x), bflo(h1.y), bfhi(h1.y)); *(float4*)(_b + 5120) = make_float4(bflo(h2.x), bfhi(h2.x), bflo(h2.y), bfhi(h2.y)); } } while (0)
  if (tid < 16) st[2 * 6144 + tid] = 0.f;
  SCAN_GLOAD(0);
  SCAN_LSTORE(0);
  __syncthreads();
  const int nch = SL / 16;
  u16* yout = (u16*)(p.ws + OFF_PROJ) + (size_t)tbase * NALL + 1280 + (ident ? 256 : 0) + head * 64 + v0;
  const int voff = ident ? (2 * 6144) : (5120 + v0);
  const int vstep = ident ? 0 : 64, vbuf = ident ? 0 : 6144;
#define V2(a, i) ((f32x2){(i) ? a.z : a.x, (i) ? a.w : a.y})
#define SCAN_STEP(s_, IDENT) do { \
    const float* bp = b + (s_) * 64 + kl * 8; \
    const float4 wl = *(const float4*)(bp), wh = *(const float4*)(bp + 4); \
    const float4 kkl = *(const float4*)(bp + 1024), kkh = *(const float4*)(bp + 1028); \
    const float4 rl4 = *(const float4*)(bp + 2048), rh4 = *(const float4*)(bp + 2052); \
    float4 kl4 = make_float4(0.f, 0.f, 0.f, 0.f), kh4 = kl4; f32x2 vv = {0.f, 0.f}; \
    if (!(IDENT)) { kl4 = *(const float4*)(bp + 3072); kh4 = *(const float4*)(bp + 3076); vv = *(const f32x2*)(vsrc + (s_) * vstep); } \
    const float4 bl4 = *(const float4*)(bp + 4096), bh4 = *(const float4*)(bp + 4100); \
    const f32x2 W[4] = {V2(wl, 0), V2(wl, 1), V2(wh, 0), V2(wh, 1)}, KK[4] = {V2(kkl, 0), V2(kkl, 1), V2(kkh, 0), V2(kkh, 1)}; \
    const f32x2 RR[4] = {V2(rl4, 0), V2(rl4, 1), V2(rh4, 0), V2(rh4, 1)}, KV[4] = {V2(kl4, 0), V2(kl4, 1), V2(kh4, 0), V2(kh4, 1)}; \
    const f32x2 BB[4] = {V2(bl4, 0), V2(bl4, 1), V2(bh4, 0), V2(bh4, 1)}; \
    f32x2 t0 = S0[0] * KK[0] + S0[1] * KK[1] + S0[2] * KK[2] + S0[3] * KK[3]; \
    f32x2 t1 = S1[0] * KK[0] + S1[1] * KK[1] + S1[2] * KK[2] + S1[3] * KK[3]; \
    float sa0 = t0.x + t0.y, sa1 = t1.x + t1.y;     \
    sa0 += dpp_f<0xB1>(sa0); sa1 += dpp_f<0xB1>(sa1); sa0 += dpp_f<0x4E>(sa0); sa1 += dpp_f<0x4E>(sa1); sa0 += dpp_f<0x141>(sa0); sa1 += dpp_f<0x141>(sa1); \
    const f32x2 a0 = {sa0, sa0}, a1 = {sa1, sa1}, u0 = {vv.x, vv.x}, u1 = {vv.y, vv.y}; \
    if (IDENT) { _Pragma("unroll") for (int e = 0; e < 4; ++e) { S0[e] = S0[e] * W[e] + a0 * BB[e]; S1[e] = S1[e] * W[e] + a1 * BB[e]; } } \
    else { _Pragma("unroll") for (int e = 0; e < 4; ++e) { S0[e] = S0[e] * W[e] + a0 * BB[e] + u0 * KV[e]; S1[e] = S1[e] * W[e] + a1 * BB[e] + u1 * KV[e]; } } \
    f32x2 q0 = S0[0] * RR[0] + S0[1] * RR[1] + S0[2] * RR[2] + S0[3] * RR[3]; \
    f32x2 q1 = S1[0] * RR[0] + S1[1] * RR[1] + S1[2] * RR[2] + S1[3] * RR[3]; \
    float y0 = q0.x + q0.y, y1 = q1.x + q1.y; \
    y0 += dpp_f<0xB1>(y0); y1 += dpp_f<0xB1>(y1); y0 += dpp_f<0x4E>(y0); y1 += dpp_f<0x4E>(y1); y0 += dpp_f<0x141>(y0); y1 += dpp_f<0x141>(y1); \
    const bool mine = (kl == ((s_) & 7)); \
    if ((s_) < 8) { ya.x = mine ? y0 : ya.x; ya.y = mine ? y1 : ya.y; } else { yb.x = mine ? y0 : yb.x; yb.y = mine ? y1 : yb.y; } } while (0)
  for (int ch = 0; ch < nch; ++ch) {
    const int cur = ch & 1;
    if (ch + 1 < nch) SCAN_GLOAD(ch + 1);
    const float* b = st + cur * 6144;
    const float* vsrc = st + voff + cur * vbuf;
    f32x2 ya = {0.f, 0.f}, yb = {0.f, 0.f};
    if (ident) {
#pragma unroll 2
      for (int s = 0; s < 8; ++s) SCAN_STEP(s, true);
#pragma unroll 2
      for (int s = 8; s < 16; ++s) SCAN_STEP(s, true);
    } else {
#pragma unroll 2
      for (int s = 0; s < 8; ++s) SCAN_STEP(s, false);
#pragma unroll 2
      for (int s = 8; s < 16; ++s) SCAN_STEP(s, false);
    }
    *(unsigned*)(yout + (size_t)(ch * 16 + kl) * NALL) = pack2(ya.x, ya.y);
    *(unsigned*)(yout + (size_t)(ch * 16 + 8 + kl) * NALL) = pack2(yb.x, yb.y);
    if (ch + 1 < nch) SCAN_LSTORE(cur ^ 1);
    __syncthreads();
  }
#pragma unroll
  for (int j = 0; j < 2; ++j) {
    float* zp = ZP + ((size_t)((seg * 4 + head) * 128 + R0 + j)) * 64 + kl * 8;
    if (j == 0) { *(float4*)(zp) = make_float4(S0[0].x, S0[0].y, S0[1].x, S0[1].y); *(float4*)(zp + 4) = make_float4(S0[2].x, S0[2].y, S0[3].x, S0[3].y); }
    else { *(float4*)(zp) = make_float4(S1[0].x, S1[0].y, S1[1].x, S1[1].y); *(float4*)(zp + 4) = make_float4(S1[2].x, S1[2].y, S1[3].x, S1[3].y); }
  }
}

__device__ void rwkv_combine(const Params& p, unsigned char* dsm_) {
  float* ring = (float*)dsm_;
  float* sbuf = ring + 3 * 8704;
  float* ZP = (float*)(p.ws + OFF_ZP);
  const int tid = opaque_tid512(); const int lane = tid & 63, wv = tid >> 6;
  const int rowi = blockIdx.x * 8 + wv;
  const int head = rowi >> 6, v = rowi & 63;
  const int li = (tid & 15) + 16 * (wv & 3), m0 = ((tid >> 4) & 3) + 4 * (wv >> 2);
  float4 a0A, b0A, a1A, b1A, a0B, b0B, a1B, b1B, a0C, b0C, a1C, b1C;
  float z0A, z1A, z0B, z1B, z0C, z1C;
#define COMB_LOAD(X, stg_) do { \
      const float* base0 = ZP + (size_t)((((stg_) * 2 + 0) * 4 + head) * 128) * 64; \
      const float* base1 = ZP + (size_t)((((stg_) * 2 + 1) * 4 + head) * 128) * 64; \
      a0##X = *(const float4*)(base0 + 4096 + li * 64 + 4 * m0); b0##X = *(const float4*)(base0 + 4096 + li * 64 + 32 + 4 * m0); z0##X = base0[v * 64 + lane]; \
      a1##X = *(const float4*)(base1 + 4096 + li * 64 + 4 * m0); b1##X = *(const float4*)(base1 + 4096 + li * 64 + 32 + 4 * m0); z1##X = base1[v * 64 + lane]; } while (0)
#define COMB_PUT(dst, A4, B4) do { float* d_ = (dst) + li; \
      d_[(4 * m0 + 0) * 68] = A4.x; d_[(4 * m0 + 1) * 68] = A4.y; d_[(4 * m0 + 2) * 68] = A4.z; d_[(4 * m0 + 3) * 68] = A4.w; \
      d_[(32 + 4 * m0 + 0) * 68] = B4.x; d_[(32 + 4 * m0 + 1) * 68] = B4.y; d_[(32 + 4 * m0 + 2) * 68] = B4.z; d_[(32 + 4 * m0 + 3) * 68] = B4.w; } while (0)
#define COMB_SEG(q, ZC) do { const int seg = stg * 2 + q; \
      ZP[((size_t)((seg * 4 + head) * 128 + v)) * 64 + lane] = s; \
      sbuf[wv * 64 + lane] = s; \
      const float* PT = buf + q * 4352 + lane * 68; const float* sb = sbuf + wv * 64; \
        \
      float4 pv[16], sv[16]; \
      _Pragma("unroll") for (int i4 = 0; i4 < 16; ++i4) pv[i4] = *(const float4*)(PT + 4 * i4); \
      _Pragma("unroll") for (int i4 = 0; i4 < 16; ++i4) sv[i4] = *(const float4*)(sb + 4 * i4); \
      __builtin_amdgcn_sched_barrier(0); \
      f32x2 acc0 = {ZC, 0.f}, acc1 = {0.f, 0.f}, acc2 = {0.f, 0.f}, acc3 = {0.f, 0.f}; \
      _Pragma("unroll") for (int i4 = 0; i4 < 16; i4 += 2) { \
        acc0 += (f32x2){sv[i4].x, sv[i4].y} * (f32x2){pv[i4].x, pv[i4].y}; acc1 += (f32x2){sv[i4].z, sv[i4].w} * (f32x2){pv[i4].z, pv[i4].w}; \
        acc2 += (f32x2){sv[i4 + 1].x, sv[i4 + 1].y} * (f32x2){pv[i4 + 1].x, pv[i4 + 1].y}; acc3 += (f32x2){sv[i4 + 1].z, sv[i4 + 1].w} * (f32x2){pv[i4 + 1].z, pv[i4 + 1].w}; } \
      s = ((acc0.x + acc0.y) + (acc1.x + acc1.y)) + ((acc2.x + acc2.y) + (acc3.x + acc3.y)); } while (0)
#define COMB_STAGE(X, bi) do { \
      float* buf = ring + (bi) * 8704; \
      COMB_PUT(buf, a0##X, b0##X); COMB_PUT(buf + 4352, a1##X, b1##X); \
      const float c0 = z0##X, c1 = z1##X; \
      { const int nstg = (stg + 3 < NSEG / 2) ? stg + 3 : stg; COMB_LOAD(X, nstg); } \
      __syncthreads(); \
      COMB_SEG(0, c0); COMB_SEG(1, c1); ++stg; } while (0)
  COMB_LOAD(A, 0); COMB_LOAD(B, 1); COMB_LOAD(C, 2);
  float s = 0.f;
  int stg = 0;
#pragma unroll 1
  for (int it3 = 0; it3 < (NSEG / 2) / 3; ++it3) {
    COMB_STAGE(A, 0); COMB_STAGE(B, 1); COMB_STAGE(C, 2);
  }
  COMB_STAGE(A, 0); COMB_STAGE(B, 1);
  __syncthreads();
#undef COMB_LOAD
#undef COMB_PUT
#undef COMB_SEG
#undef COMB_STAGE
}

__device__ __forceinline__ bf16x8 pack8(const float4 a, const float4 b) {
  uint4 u = make_uint4(pack2(a.x, a.y), pack2(a.z, a.w), pack2(b.x, b.y), pack2(b.z, b.w));
  return __builtin_bit_cast(bf16x8, u);
}
__device__ void rwkv_final_item(const Params& p, int l, int item, unsigned char* smem) {
  l = opq(l); item = opq(item);
  const int tid = opaque_tid(), w = tid >> 6, lane = tid & 63, l31 = lane & 31, hf = lane >> 5;
  const int parts = SL / 128;
  const int q = item % parts, head = (item / parts) & 3, seg = item / (parts * 4);
  const int t = seg * SL + q * 128 + w * 32 + l31;
  const float* ZP = (const float*)(p.ws + OFF_ZP);
  const float* PF = (const float*)(p.ws + OFF_PROJ);
  const u16* PROJ = (const u16*)(p.ws + OFF_PROJ);
  const u16* RBv = (const u16*)(p.ws + OFF_RWB) + (size_t)2 * T_ * 256;
  const float* BON = (const float*)(p.ws + OFF_BONUS);
  u16* MIX = (u16*)(p.ws + OFF_MIX);
  f32x16 acc0, acc1;
#pragma unroll
  for (int r = 0; r < 16; ++r) { acc0[r] = 0.f; acc1[r] = 0.f; }
  const u16* y0p = PROJ + (size_t)t * NALL + 1280 + head * 64 + 4 * hf;
  const int cb = head * 64 + 4 * hf;
  float4 yA[4], yB[4];
  uint2 vvl[8], ggl[8];
#pragma unroll
  for (int g = 0; g < 4; ++g) {
    const uint2 ua = *(const uint2*)(y0p + 8 * g), ub = *(const uint2*)(y0p + 32 + 8 * g);
    yA[g] = make_float4(bflo(ua.x), bfhi(ua.x), bflo(ua.y), bfhi(ua.y)); yB[g] = make_float4(bflo(ub.x), bfhi(ub.x), bflo(ub.y), bfhi(ub.y));
  }
#pragma unroll
  for (int q8 = 0; q8 < 8; ++q8) {
    const int c = cb + (q8 >> 2) * 32 + 8 * (q8 & 3);
    vvl[q8] = *(const uint2*)(RBv + (size_t)t * 256 + c);
    ggl[q8] = *(const uint2*)(PROJ + (size_t)t * NALL + 2048 + c);
  }
  const float bon = BON[t * 4 + head];
  {
    const float* sp = ZP + ((size_t)((seg * 4 + head) * 128 + l31)) * 64 + 8 * hf;
    const u16* rp = PROJ + (size_t)t * NALL + 1280 + 256 + head * 64 + 8 * hf;
#pragma unroll
    for (int ks = 0; ks < 4; ++ks) {
      const bf16x8 bfrag = *(const bf16x8*)(rp + 16 * ks);
      const bf16x8 a0 = pack8(*(const float4*)(sp + 16 * ks), *(const float4*)(sp + 16 * ks + 4));
      const bf16x8 a1 = pack8(*(const float4*)(sp + 32 * 64 + 16 * ks), *(const float4*)(sp + 32 * 64 + 16 * ks + 4));
      acc0 = __builtin_amdgcn_mfma_f32_32x32x16_bf16(a0, bfrag, acc0, 0, 0, 0);
      acc1 = __builtin_amdgcn_mfma_f32_32x32x16_bf16(a1, bfrag, acc1, 0, 0, 0);
    }
  }
  float sum = 0.f;
#pragma unroll
  for (int g = 0; g < 4; ++g) {
    const float4 ya = yA[g], yb = yB[g];
    acc0[4 * g + 0] += ya.x; acc0[4 * g + 1] += ya.y; acc0[4 * g + 2] += ya.z; acc0[4 * g + 3] += ya.w;
    acc1[4 * g + 0] += yb.x; acc1[4 * g + 1] += yb.y; acc1[4 * g + 2] += yb.z; acc1[4 * g + 3] += yb.w;
  }
#pragma unroll
  for (int r = 0; r < 16; ++r) sum += acc0[r] + acc1[r];
  sum += __shfl_xor(sum, 32);
  const float mean = sum * (1.f / 64.f);
  float var = 0.f;
#pragma unroll
  for (int r = 0; r < 16; ++r) { const float d0 = acc0[r] - mean, d1 = acc1[r] - mean; var += d0 * d0 + d1 * d1; }
  var += __shfl_xor(var, 32);
  const float rstd = rsqrtf(var * (1.f / 64.f) + 64e-5f);
#pragma unroll
  for (int mt = 0; mt < 2; ++mt)
#pragma unroll
    for (int g = 0; g < 4; ++g) {
      const int c = cb + mt * 32 + 8 * g;
      const float4 lw = *(const float4*)(p.ln_w + l * 256 + c), lb = *(const float4*)(p.ln_b + l * 256 + c);
      const uint2 vv = vvl[mt * 4 + g];
      const uint2 gg = ggl[mt * 4 + g];
      float o0 = (mt ? acc1[4 * g + 0] : acc0[4 * g + 0]), o1 = (mt ? acc1[4 * g + 1] : acc0[4 * g + 1]);
      float o2 = (mt ? acc1[4 * g + 2] : acc0[4 * g + 2]), o3 = (mt ? acc1[4 * g + 3] : acc0[4 * g + 3]);
      o0 = (o0 - mean) * rstd * lw.x + lb.x + bon * bflo(vv.x);
      o1 = (o1 - mean) * rstd * lw.y + lb.y + bon * bfhi(vv.x);
      o2 = (o2 - mean) * rstd * lw.z + lb.z + bon * bflo(vv.y);
      o3 = (o3 - mean) * rstd * lw.w + lb.w + bon * bfhi(vv.y);
      o0 *= silu(bflo(gg.x)); o1 *= silu(bfhi(gg.x)); o2 *= silu(bflo(gg.y)); o3 *= silu(bfhi(gg.y));
      *(uint2*)(MIX + (size_t)t * 1024 + 512 + c) = make_uint2(pack2(o0, o1), pack2(o2, o3));
    }
}

#define LDS_BYTES (131072 + 16)
#ifndef REP_G1
#define REP_G1 1
#endif
#ifndef REP_G2
#define REP_G2 1
#endif
#ifndef REP_P3
#define REP_P3 1
#endif
#ifndef REP_SCAN
#define REP_SCAN 1
#endif
#ifndef REP_GO
#define REP_GO 1
#endif
#ifndef REP_FIN
#define REP_FIN 1
#endif
#define PAIR_LOOP(N, BODY) for (int _pr = blockIdx.x; _pr < (N) / 2; _pr += gridDim.x) { const int it = 2 * _pr + vb; BODY }
__global__ void __launch_bounds__(512) fwd_megakernel(Params p) {
  cg::grid_group grid = cg::this_grid();
  extern __shared__ __attribute__((aligned(16))) unsigned char dsm[];
  const int vb = __builtin_amdgcn_readfirstlane(threadIdx.x >> 8);
  unsigned char* smem = dsm + vb * 65536;
  if (threadIdx.x == 0) *(uint4*)(dsm + 131072) = make_uint4(0u, 0u, 0u, 0u);
  __syncthreads();
  const XcdBarrier xb = xcd_barrier_post((unsigned*)(p.ws + OFF_BAR), (volatile LAS unsigned*)(dsm + 131072));
#define GSYNC() xcd_barrier(xb)
#ifndef PH
#define PH 0xffff
#endif
  if (PH & 1) PAIR_LOOP(384, phase_mod_item(p, it, smem);)
  if (PH & 2) PAIR_LOOP(1120, { const int it2 = (it < 864) ? it : 3456 + (it - 864); phase_wconv_item(p, it2, smem); })
  if (PH & 2) PAIR_LOOP(8, phase_w2t_item(p, it);)
  if (p.ws == nullptr) grid.sync();
  GSYNC();
  if (PH & 4) phase_h0(p);
  GSYNC();
#pragma unroll 1
  for (int hl = 0; hl < 8; ++hl) {
    const int l = hl >> 1;
    const bool second = hl & 1;
    if (PH & 8) {
      pg8::Gemm g; g.M = T_; g.K = 1024;
      pg8::EpiU E; E.O = (void*)(p.ws + OFF_PROJ);
      if (!second) { g.A = (const u16*)(p.ws + OFF_H); g.Bt = (const u16*)(p.ws + OFF_WALL) + (size_t)l * NALL * 1024; g.N = 3584; E.ldc = NALL; E.ncols = 3344; E.f32out = 0; }
      else { g.A = (const u16*)(p.ws + OFF_MIX); g.Bt = (const u16*)(p.ws + OFF_WOUT) + (size_t)l * 1024 * 1024; g.N = 1024; E.ldc = 1024; E.ncols = 1024; E.f32out = 0; }
      pg8::StaticOrder S; S.init(T_, g.N, gridDim.x, blockIdx.x);
      const int nrep = second ? REP_G2 : REP_G1;
#pragma unroll 1
      for (int rep = 0; rep < nrep; ++rep)
      pg8::gemm_phase<pg8::EpiU, pg8::StaticOrder, false>((PG8_LAS unsigned char*)dsm, g, S, E, nullptr);
      if (!second && l < 3 && (PH & 2)) {
        const int G = gridDim.x, rem = 896 % G;
        if (rem != 0 && (int)blockIdx.x >= rem) {
          const int nidle = G - rem, me = blockIdx.x - rem;
          for (int _pr = me; _pr < 560; _pr += nidle) {
            const int it = 2 * _pr + vb;
            const int it2 = (it < 864) ? (l + 1) * 864 + it : 3456 + (l + 1) * 256 + (it - 864);
            phase_wconv_item(p, it2, smem);
          }
        } else if (rem == 0) {
          PAIR_LOOP(1120, { const int it2 = (it < 864) ? (l + 1) * 864 + it : 3456 + (l + 1) * 256 + (it - 864); phase_wconv_item(p, it2, smem); })
        }
      }
    }
    GSYNC();
    if (!second) {
#pragma unroll 1
      for (int rep = 0; rep < REP_P3; ++rep)
      PAIR_LOOP(2048,
        if (it < 1024) { if (PH & 32) rwkv_prep_item(p, l, it, smem); }
        else { if (PH & 64) gla_local_item(p, l, it - 1024, smem); }
      )
      GSYNC();
#pragma unroll 1
      for (int wi = blockIdx.x; wi < 256; wi += gridDim.x) {
        GLA_STATE_LOAD(wi)
#pragma unroll 1
        for (int rep = 0; rep < REP_SCAN; ++rep)
        if (PH & 256) rwkv_scan_item(p, wi, dsm);
        __syncthreads();
        if (PH & 128) GLA_STATE_FINISH(dsm)
      }
      GSYNC();
      if (blockIdx.x < 32) { if (PH & 512) rwkv_combine(p, dsm); }
#pragma unroll 1
      for (int rep = 0; rep < REP_GO; ++rep)
      if (PH & 1024) {
        unsigned* ctr = (unsigned*)(p.ws + OFF_BAR) + 32 + l;
        volatile unsigned* slot = (volatile unsigned*)(dsm + 131072) + 2;
        for (;;) {
          if (threadIdx.x == 0) *slot = atomicAdd(ctr, 1u);
          __syncthreads();
          const unsigned pr = (unsigned)__builtin_amdgcn_readfirstlane((int)*slot);
          __syncthreads();
          if (pr >= 1024u) break;
          if (pr < 512u) attn_item(p, l, 2 * (int)pr + vb, smem);
          else gla_out_item(p, l, 2 * (int)(pr - 512u) + vb, smem);
        }
      }
      GSYNC();
#pragma unroll 1
      for (int rep = 0; rep < REP_FIN; ++rep)
      if (PH & 2048) PAIR_LOOP(NSEG * 4 * (SL / 128), rwkv_final_item(p, l, it, smem);)
      GSYNC();
    } else {
      if (PH & 8192) phase_post(p, l);
      if (hl < 7) GSYNC();
    }
  }
}

extern "C" void kernel_launch(void* const* d_in, const int* in_sizes, int n_in, void* d_out, int out_size, void* d_ws, size_t ws_size,
                              hipStream_t stream) {
  static int grid_blocks = 0;
  if (!grid_blocks) {
    int dev = 0, cus = 0, per_cu = 0;
    (void)hipGetDevice(&dev);
    (void)hipDeviceGetAttribute(&cus, hipDeviceAttributeMultiprocessorCount, dev);
    (void)hipFuncSetAttribute((const void*)fwd_megakernel, hipFuncAttributeMaxDynamicSharedMemorySize, LDS_BYTES);
    (void)hipOccupancyMaxActiveBlocksPerMultiprocessor(&per_cu, fwd_megakernel, 512, LDS_BYTES);
    if (per_cu < 1) per_cu = 1;
    grid_blocks = cus;
    if (grid_blocks < 64) { fprintf(stderr, "kernel_launch: needs at least 64 CUs (got %d)\n", cus); grid_blocks = -1; }
  }
  if (grid_blocks < 0) return;
  if (n_in != 27 || ws_size < WS_END) {
    fprintf(stderr, "kernel_launch: unexpected n_in %d / ws %zu\n", n_in, ws_size);
    return;
  }
  Params p{};
  const float** pp = (const float**)&p;
  for (int i = 0; i < 27; ++i) pp[i] = (const float*)d_in[i];
  p.out = (float*)d_out;
  p.ws = (unsigned char*)d_ws;
  (void)hipMemsetAsync((unsigned char*)d_ws + OFF_BAR, 0, XCD_BAR_WORDS * 4, stream);
  void* args[] = {&p};
  hipError_t e = hipLaunchCooperativeKernel((void*)fwd_megakernel, dim3(grid_blocks), dim3(512), args, LDS_BYTES, stream);
  if (e != hipSuccess) fprintf(stderr, "cooperative launch failed: %s (grid %d)\n", hipGetErrorString(e), grid_blocks);
}
```
